# Optimizing an MI355X kernel written in HIP

```python
import math
import jax, jax.numpy as jnp
from jax import lax
import numpy as np


D_MODEL = 1024
BATCH = 8
SEQ = 2048
DEPTH = 4

N_MEM = 256
HEAD_DIM = 64
BLOCK = 128
WINDOW = 128
WIN_HEADS = 4
WIN_KV_HEADS = 2
DIFF_HEADS = 4
DIFF_QK_DIM = 64
DIFF_V_DIM = 2 * DIFF_QK_DIM
RWKV_HEADS = 4
RWKV_HEAD = 64
W_LORA = 64
A_LORA = 64
G_LORA = 128
X_HEADS = 4
X_HEAD_DIM = 128
D_FF = -(-8 * D_MODEL // (3 * 256)) * 256
RMS_EPS = 1e-6
GN_EPS = 64e-5

WIN_WIDTH = WIN_HEADS * HEAD_DIM
DIFF_WIDTH = DIFF_HEADS * DIFF_V_DIM
RWKV_WIDTH = RWKV_HEADS * RWKV_HEAD
MIX_WIDTH = WIN_WIDTH + DIFF_WIDTH + RWKV_WIDTH
RWKV_IN = 3 * RWKV_WIDTH + W_LORA + A_LORA + G_LORA
IN_SIZES = (WIN_WIDTH, WIN_KV_HEADS * HEAD_DIM, WIN_KV_HEADS * HEAD_DIM,
            2 * DIFF_HEADS * DIFF_QK_DIM, 2 * DIFF_HEADS * DIFF_QK_DIM, DIFF_WIDTH, RWKV_IN)
IN_WIDTH = sum(IN_SIZES)
RWKV_SIZES = (RWKV_WIDTH, RWKV_WIDTH, RWKV_WIDTH, W_LORA, A_LORA, G_LORA)

kernel_name = 'hybrid_parallel_heads_bidir_encoder'

f32 = jnp.float32


def split_last(z, sizes):
    idx = [int(i) for i in np.cumsum(sizes)[:-1]]
    return jnp.split(z, idx, axis=-1)


def rmsnorm(z, g):
    z32 = z.astype(f32)
    return (z32 * lax.rsqrt(jnp.mean(z32 * z32, axis=-1, keepdims=True) + RMS_EPS)).astype(z.dtype) * g


def alibi_slopes():
    n = WIN_HEADS + DIFF_HEADS
    s = jnp.exp2(-8.0 * jnp.arange(1, n + 1, dtype=f32) / n)
    return s[0::2], s[1::2]


def window_gqa(q, k, v, sink, slopes):
    b, t = q.shape[:2]
    nb = t // BLOCK
    g = WIN_HEADS // WIN_KV_HEADS
    qb = q.reshape(b, nb, BLOCK, WIN_KV_HEADS, g, HEAD_DIM)

    def band(z):
        zp = jnp.pad(z, ((0, 0), (BLOCK, BLOCK), (0, 0), (0, 0)))
        zb = zp.reshape(b, nb + 2, BLOCK, WIN_KV_HEADS, HEAD_DIM)
        return jnp.concatenate([zb[:, :-2], zb[:, 1:-1], zb[:, 2:]], axis=2)

    kb, vb = band(k), band(v)
    s = jnp.einsum('bnqhgd,bnkhd->bnhgqk', qb, kb).astype(f32) * (HEAD_DIM ** -0.5)
    qi = jnp.arange(BLOCK)[:, None]
    ki = jnp.arange(3 * BLOCK)[None, :] - BLOCK
    delta = ki - qi
    key_pos = jnp.arange(nb)[:, None] * BLOCK + ki
    in_range = (key_pos >= 0) & (key_pos < t)
    valid = (jnp.abs(delta) <= WINDOW)[None] & in_range[:, None, :]
    bias = -slopes.reshape(WIN_KV_HEADS, g, 1, 1) * jnp.abs(delta).astype(f32)
    s = jnp.where(valid[None, :, None, None], s + bias, -jnp.inf)
    sink_col = jnp.broadcast_to(sink.astype(f32).reshape(WIN_KV_HEADS, g, 1, 1), s.shape[:-1] + (1,))
    p = jax.nn.softmax(jnp.concatenate([s, sink_col], axis=-1), axis=-1)[..., :-1]
    o = jnp.einsum('bnhgqk,bnkhd->bnqhgd', p.astype(v.dtype), vb)
    return o.reshape(b, t, WIN_WIDTH)


def diff_attention(q, k, v, lam, lam_init, subln_g, slopes):
    b, t = q.shape[:2]
    nb = t // BLOCK
    qb = jnp.moveaxis(q.reshape(b, nb, BLOCK, DIFF_HEADS, 2, DIFF_QK_DIM), 1, 0)
    kpos = jnp.arange(t)

    def block(args):
        qblk, i = args
        s = jnp.einsum('bqhcd,bkhcd->bhcqk', qblk, k).astype(f32) * (DIFF_QK_DIM ** -0.5)
        qpos = i * BLOCK + jnp.arange(BLOCK)
        dist = jnp.abs(kpos[None, :] - qpos[:, None]).astype(f32)
        s = s - slopes[None, :, None, None, None] * dist[None, None, None]
        p = jax.nn.softmax(s, axis=-1)
        a = p[:, :, 0] - lam * p[:, :, 1]
        return jnp.einsum('bhqk,bkhe->bqhe', a.astype(v.dtype), v)

    o = lax.map(block, (qb, jnp.arange(nb)))
    o = jnp.moveaxis(o, 0, 1).reshape(b, t, DIFF_HEADS, DIFF_V_DIM)
    o = rmsnorm(o, subln_g) * (1.0 - lam_init)
    return o.reshape(b, t, DIFF_WIDTH)


def heads(z):
    return z.reshape(z.shape[:-1] + (RWKV_HEADS, RWKV_HEAD))


def time_major(z):
    z = jnp.stack([z[0], jnp.flip(z[1], axis=1)])
    return jnp.moveaxis(z, 2, 0).astype(f32)


def rwkv7_bidir(c, conv, w0, w_up, a0, a_up, g_up, k_k, k_a, r_k, ln_g, ln_b):
    b, t, _ = c.shape
    dt = c.dtype
    cp = jnp.pad(c, ((0, 0), (1, 1), (0, 0)))
    c = cp[:, :-2] * conv[0] + cp[:, 1:-1] * conv[1] + cp[:, 2:] * conv[2]
    r, k, v, wd, ad, gd = split_last(c.astype(f32), RWKV_SIZES)
    w_log = -jax.nn.softplus(-(w0[:, None, None] + jnp.einsum('btl,dlc->dbtc', jnp.tanh(wd), w_up))) - 0.5
    decay = jnp.exp(-jnp.exp(w_log))
    a = jax.nn.sigmoid(a0[:, None, None] + jnp.einsum('btl,dlc->dbtc', ad, a_up))
    g = jax.nn.sigmoid(gd) @ g_up
    kk = heads(k * k_k)
    kk = kk / jnp.maximum(jnp.linalg.norm(kk, axis=-1, keepdims=True), 1e-12)
    kd = heads(k * (1.0 + (a - 1.0) * k_a))
    rh, vh = heads(r), heads(v)
    shp = kd.shape
    xs = tuple(time_major(z) for z in (heads(decay), jnp.broadcast_to(kk, shp), kk * heads(a), kd,
                                       jnp.broadcast_to(vh, shp), jnp.broadcast_to(rh, shp)))

    def step(S, inp):
        wt, kkt, kat, kt, vt, rt = inp
        S = (S * wt[..., None, :]
             - jnp.einsum('...vk,...k->...v', S, kkt)[..., :, None] * kat[..., None, :]
             + vt[..., :, None] * kt[..., None, :])
        return S, jnp.einsum('...vk,...k->...v', S, rt)

    S0 = jnp.zeros((2, b, RWKV_HEADS, RWKV_HEAD, RWKV_HEAD), f32)
    _, y = lax.scan(step, S0, xs)
    y = jnp.moveaxis(y, 0, 2)
    y = y[0] + jnp.flip(y[1], axis=1)
    mu = jnp.mean(y, axis=-1, keepdims=True)
    var = jnp.mean(jnp.square(y - mu), axis=-1, keepdims=True)
    yn = (y - mu) * lax.rsqrt(var + GN_EPS) * heads(ln_g.astype(f32)) + heads(ln_b.astype(f32))
    bonus = jnp.sum(jnp.sum(rh * kd * r_k, axis=-1, keepdims=True), axis=0) * vh
    return ((yn + bonus).reshape(b, t, RWKV_WIDTH) * g).astype(dt)


def cross_attn(h, mem_n, wq, wkv, wo):
    b, t, _ = h.shape
    m = mem_n.shape[1]
    q = (h @ wq).reshape(b, t, X_HEADS, X_HEAD_DIM)
    kv = (mem_n @ wkv).reshape(b, m, 2, X_HEADS, X_HEAD_DIM)
    s = jnp.einsum('bqhd,bkhd->bhqk', q, kv[:, :, 0]).astype(f32) * (X_HEAD_DIM ** -0.5)
    p = jax.nn.softmax(s, axis=-1)
    o = jnp.einsum('bhqk,bkhd->bqhd', p.astype(h.dtype), kv[:, :, 1]).reshape(b, t, X_HEADS * X_HEAD_DIM)
    return o @ wo


def setup_inputs(seed: int = 0) -> dict:
    key = jax.random.key(seed)
    ks = iter(jax.random.split(key, 40))
    L = DEPTH

    def nrm(shape, scale):
        return jax.random.normal(next(ks), shape, f32) * scale

    def gain(shape):
        return 1.0 + nrm(shape, 0.02)

    return {
        'x': nrm((BATCH, SEQ, D_MODEL), 1.0),
        'mem': nrm((BATCH, N_MEM, D_MODEL), 1.0),
        'norm_mix': gain((L, D_MODEL)),
        'w_in': nrm((L, D_MODEL, IN_WIDTH), D_MODEL ** -0.5),
        'win_sink': nrm((L, WIN_HEADS), 0.5),
        'diff_lq1': nrm((L, DIFF_QK_DIM), 0.1),
        'diff_lk1': nrm((L, DIFF_QK_DIM), 0.1),
        'diff_lq2': nrm((L, DIFF_QK_DIM), 0.1),
        'diff_lk2': nrm((L, DIFF_QK_DIM), 0.1),
        'diff_subln': gain((L, DIFF_V_DIM)),
        'rwkv_conv': jnp.array([0.3, 1.0, 0.3], f32)[None, :, None] + nrm((L, 3, RWKV_IN), 0.1),
        'rwkv_w0': jax.random.uniform(next(ks), (L, 2, RWKV_WIDTH), f32, -6.0, 1.0),
        'rwkv_w_up': nrm((L, 2, W_LORA, RWKV_WIDTH), 0.1),
        'rwkv_a0': nrm((L, 2, RWKV_WIDTH), 0.5),
        'rwkv_a_up': nrm((L, 2, A_LORA, RWKV_WIDTH), A_LORA ** -0.5),
        'rwkv_g_up': nrm((L, G_LORA, RWKV_WIDTH), G_LORA ** -0.5),
        'rwkv_k_k': 0.85 + nrm((L, RWKV_WIDTH), 0.05),
        'rwkv_k_a': 1.0 + nrm((L, RWKV_WIDTH), 0.05),
        'rwkv_r_k': nrm((L, RWKV_HEADS, RWKV_HEAD), 0.1),
        'rwkv_ln_g': gain((L, RWKV_WIDTH)),
        'rwkv_ln_b': nrm((L, RWKV_WIDTH), 0.02),
        'w_out': nrm((L, MIX_WIDTH, D_MODEL), MIX_WIDTH ** -0.5),
        'norm_cross': gain((L, D_MODEL)),
        'norm_mem': gain((D_MODEL,)),
        'x_wq': nrm((L, D_MODEL, X_HEADS * X_HEAD_DIM), D_MODEL ** -0.5),
        'x_wkv': nrm((L, D_MODEL, 2 * X_HEADS * X_HEAD_DIM), D_MODEL ** -0.5),
        'x_wo': nrm((L, X_HEADS * X_HEAD_DIM, D_MODEL), (X_HEADS * X_HEAD_DIM) ** -0.5),
        'norm_ffn': gain((L, D_MODEL)),
        'ffn_w_gu': nrm((L, D_MODEL, 2 * D_FF), D_MODEL ** -0.5),
        'ffn_w_down': nrm((L, D_FF, D_MODEL), D_FF ** -0.5),
        'norm_final': gain((D_MODEL,)),
    }


def reference(x, mem, norm_mix, w_in, win_sink, diff_lq1, diff_lk1, diff_lq2, diff_lk2, diff_subln,
              rwkv_conv, rwkv_w0, rwkv_w_up, rwkv_a0, rwkv_a_up, rwkv_g_up, rwkv_k_k, rwkv_k_a, rwkv_r_k,
              rwkv_ln_g, rwkv_ln_b, w_out, norm_cross, norm_mem, x_wq, x_wkv, x_wo, norm_ffn,
              ffn_w_gu, ffn_w_down, norm_final):
    b, t, _ = x.shape
    slopes_win, slopes_diff = alibi_slopes()
    mem_n = rmsnorm(mem, norm_mem)
    for l in range(DEPTH):
        h = rmsnorm(x, norm_mix[l])
        aq, ak, av, bq, bk, bv, cin = split_last(h @ w_in[l], IN_SIZES)
        o_win = window_gqa(aq.reshape(b, t, WIN_HEADS, HEAD_DIM),
                           ak.reshape(b, t, WIN_KV_HEADS, HEAD_DIM),
                           av.reshape(b, t, WIN_KV_HEADS, HEAD_DIM), win_sink[l], slopes_win)
        lam_init = 0.8 - 0.6 * math.exp(-0.3 * l)
        lam = (jnp.exp(jnp.sum((diff_lq1[l] * diff_lk1[l]).astype(f32)))
               - jnp.exp(jnp.sum((diff_lq2[l] * diff_lk2[l]).astype(f32))) + lam_init)
        o_diff = diff_attention(bq.reshape(b, t, DIFF_HEADS, 2, DIFF_QK_DIM),
                                bk.reshape(b, t, DIFF_HEADS, 2, DIFF_QK_DIM),
                                bv.reshape(b, t, DIFF_HEADS, DIFF_V_DIM),
                                lam, lam_init, diff_subln[l], slopes_diff)
        o_rwkv = rwkv7_bidir(cin, rwkv_conv[l], rwkv_w0[l], rwkv_w_up[l], rwkv_a0[l], rwkv_a_up[l],
                             rwkv_g_up[l], rwkv_k_k[l], rwkv_k_a[l], rwkv_r_k[l], rwkv_ln_g[l], rwkv_ln_b[l])
        x = x + jnp.concatenate([o_win, o_diff, o_rwkv], axis=-1) @ w_out[l]
        x = x + cross_attn(rmsnorm(x, norm_cross[l]), mem_n, x_wq[l], x_wkv[l], x_wo[l])
        gate, up = jnp.split(rmsnorm(x, norm_ffn[l]) @ ffn_w_gu[l], 2, axis=-1)
        x = x + (jax.nn.silu(gate) * up) @ ffn_w_down[l]
    return rmsnorm(x, norm_final)
```

```cpp
#include <hip/hip_runtime.h>
#include <hip/hip_cooperative_groups.h>
#include <cstdio>
#include <cstdint>
namespace cg = cooperative_groups;

#define LAS __attribute__((address_space(3)))
typedef unsigned short bf16_t;
typedef short bf16x8 __attribute__((ext_vector_type(8)));
typedef short s16x4 __attribute__((ext_vector_type(4)));
typedef short v4i16_t __attribute__((ext_vector_type(4)));
typedef float f32x4 __attribute__((ext_vector_type(4)));
typedef float f32x2 __attribute__((ext_vector_type(2)));
typedef float f32x16 __attribute__((ext_vector_type(16)));
typedef unsigned u32x4 __attribute__((ext_vector_type(4)));
typedef unsigned u32x2 __attribute__((ext_vector_type(2)));
typedef __bf16 bf16x2_t __attribute__((ext_vector_type(2)));

constexpr int DM = 1024, NB = 8, SEQ = 2048, NL = 4, MTOK = NB * SEQ;
constexpr int NMEM = 256, MMEM = NB * NMEM;
constexpr int INW = 3072, DFF = 2816, XW = 512;
constexpr float LOG2E = 1.4426950408889634f;

constexpr size_t MiB = 1u << 20;
constexpr size_t WS_CTL = 0, CTL_ZERO_BYTES = 1 * MiB;
constexpr size_t WS_W = 2 * MiB, W_STRIDE = 29 * MiB;
constexpr size_t WS_XB = 60 * MiB, WS_Z = 92 * MiB, WS_MIX = 188 * MiB;
constexpr size_t WS_OM = 220 * MiB, WS_KA = 236 * MiB, WS_KD = 252 * MiB, WS_KK = 268 * MiB, WS_V = 276 * MiB, WS_R = 284 * MiB;
constexpr size_t WS_GATE = 292 * MiB, WS_Y = 300 * MiB, WS_BON = 316 * MiB, WS_KV = 317 * MiB, WS_MEMN = 321 * MiB, WS_END = 338 * MiB;
constexpr size_t WS_RP = 325 * MiB;
constexpr size_t WS_Q = WS_Z, WS_O = WS_Z + 16 * MiB, WS_G = WS_Z;
constexpr size_t WO_IN = 0, WO_OUT = 3145728, WO_Q = 4194304, WO_KV = 4718592, WO_O = 5767168, WO_GU = 6291456, WO_DOWN = 12058624;
constexpr size_t WO_WUP = 14942208, WO_AUP = 14974976, WO_GUP = 15007744;
constexpr int CW_Q = 64;

constexpr int LDS_BYTES = 135168;

__device__ __forceinline__ float bf2f(unsigned b) { return __uint_as_float(b << 16); }
__device__ __forceinline__ unsigned pk2(float lo, float hi) { f32x2 v = {lo, hi}; bf16x2_t b = __builtin_convertvector(v, bf16x2_t); return __builtin_bit_cast(unsigned, b); }
__device__ __forceinline__ float bflo(unsigned u) { return __uint_as_float(u << 16); }
__device__ __forceinline__ float bfhi(unsigned u) { return __uint_as_float(u & 0xffff0000u); }
__device__ __forceinline__ float wave_sum(float v) {
#pragma unroll
    for (int o = 1; o < 64; o <<= 1) v += __shfl_xor(v, o);
    return v;
}
__device__ __forceinline__ float xhalf(float v) {
    return __shfl_xor(v, 32);
}
__device__ __forceinline__ float row_rstd(const float* rp, int row) {
    const f32x4* q = (const f32x4*)(rp + (size_t)row * 16); const f32x4 a = q[0], b = q[1], c = q[2], d = q[3];
    const float s = (((a[0] + a[1]) + (a[2] + a[3])) + ((b[0] + b[1]) + (b[2] + b[3]))) + (((c[0] + c[1]) + (c[2] + c[3])) + ((d[0] + d[1]) + (d[2] + d[3])));
    return rsqrtf(s * (1.f / 1024.f) + 1e-6f);
}
__device__ __forceinline__ float sigmoidf_(float x) { return 1.f / (1.f + __expf(-x)); }

namespace pg8 {
constexpr int BM = 256, BK = 64, HALF = 128, HTB = HALF * BK * 2, NXCD = 8, WGM = 8;
__host__ __device__ __forceinline__ int lds_byte(int r, int c) { const int st = (r >> 4) * 2 + (c >> 5), rr = r & 15, cc = c & 31, ob = rr * 64 + cc * 2; return st * 1024 + (ob ^ (((ob >> 9) & 1) << 5)); }
__host__ __device__ __forceinline__ void stage_rc(int b, int& R, int& C) { const int st = b / 1024, sb = b % 1024, swz = sb ^ (((sb >> 9) & 1) << 5); R = (st >> 1) * 16 + swz / 64; C = (st & 1) * 32 + (swz % 64) / 2; }
__host__ __device__ __forceinline__ int perm32(int rho) { const int n = rho >> 4, i = rho & 15; return 8 * (i >> 2) + 4 * n + (i & 3); }
struct Unit { int pm, pn; };
struct Gemm { const bf16_t* A; const bf16_t* Bt; int M, N, K; };
struct StaticOrder {
    int nM, nN, nwg, G, c;
    __device__ void init(int M, int N, int G_, int c_) { nM = M / BM; nN = N / BM; nwg = nM * nN; G = G_; c = c_; }
    __device__ bool next(int i, Unit& u) const {
        const long L = (long)i * G + c; if (L >= nwg) return false;
        int wgid = (int)L; { const int q = nwg / NXCD, r = nwg % NXCD, xcd = wgid % NXCD, off = wgid / NXCD; wgid = (xcd < r ? xcd * (q + 1) : r * (q + 1) + (xcd - r) * q) + off; }
        const int nig = WGM * nN, gid = wgid / nig, fm = gid * WGM, gsz = (nM - fm) < WGM ? (nM - fm) : WGM;
        u.pm = fm + ((wgid % nig) % gsz); u.pn = (wgid % nig) / gsz; return true;
    }
};
template <class Epi>
__device__ __forceinline__ void gemm_phase(LAS unsigned char* lds, const Gemm g, const StaticOrder& S, const Epi& E) {
    int tid_ = threadIdx.x; asm volatile("" : "+v"(tid_));
    const int tid = tid_, wid = __builtin_amdgcn_readfirstlane(tid >> 6), lane = tid & 63, wr = wid >> 2, wc = wid & 3, fr = lane & 15, fq = lane >> 4;
    const int K = g.K, nt = K / BK;
    unsigned voffA[2], voffB[2];
#pragma unroll
    for (int i = 0; i < 2; ++i) { int R, C; stage_rc(tid * 16 + i * 8192, R, C); const int Rb = (R & ~31) + perm32(R & 31);
        voffA[i] = (unsigned)(R * K + C) * 2u; voffB[i] = (unsigned)(Rb * K + C) * 2u; }
    const size_t kstep = (size_t)(BK * 2);
    const size_t hstep = (size_t)HALF * K * 2;
    const size_t tstep = 2 * hstep;
    const unsigned ldsw = (unsigned)wid * 1024u;
    const int aoff = lds_byte(wr * 64 + fr, fq * 8), boff = lds_byte(wc * 32 + fr, fq * 8);
#define PG8_SA(b, h) (((b) * 2 + (h)) * HTB)
#define PG8_SB(b, h) ((4 + (b) * 2 + (h)) * HTB)
#define PG8_STAGE(bufoff, gbase, voff) do { _Pragma("unroll") for (int _i = 0; _i < 2; ++_i) \
        __builtin_amdgcn_global_load_lds((const unsigned*)((const char*)(gbase) + (voff)[_i]), (LAS unsigned*)(lds + (bufoff) + ldsw + _i * 8192), 16, 0, 0); } while (0)
#define PG8_LDA(dst, b, h) do { _Pragma("unroll") for (int m = 0; m < 4; ++m) _Pragma("unroll") for (int k = 0; k < 2; ++k) dst[m][k] = *(const LAS bf16x8*)(lds + PG8_SA(b, h) + aoff + m * 2048 + k * 1024); } while (0)
#define PG8_LDB(dst, b, h) do { _Pragma("unroll") for (int n = 0; n < 2; ++n) _Pragma("unroll") for (int k = 0; k < 2; ++k) dst[n][k] = *(const LAS bf16x8*)(lds + PG8_SB(b, h) + boff + n * 2048 + k * 1024); } while (0)
#define PG8_MMA(ai, bj, At, Bt) do { __builtin_amdgcn_s_setprio(1); _Pragma("unroll") for (int m = 0; m < 4; ++m) _Pragma("unroll") for (int n = 0; n < 2; ++n) _Pragma("unroll") for (int k = 0; k < 2; ++k) \
        acc[ai][bj][m][n] = __builtin_amdgcn_mfma_f32_16x16x32_bf16(Bt[n][k], At[m][k], acc[ai][bj][m][n], 0, 0, 0); __builtin_amdgcn_s_setprio(0); } while (0)
#define PG8_WAIT_V(n) asm volatile("s_waitcnt vmcnt(" #n ")" ::: "memory")
#define PG8_WAIT_L(n) asm volatile("s_waitcnt lgkmcnt(" #n ")" ::: "memory")
#define PG8_BAR __builtin_amdgcn_s_barrier()
#define PG8_SCHED __builtin_amdgcn_sched_barrier(0)
    Unit cur, nxt; int ui = 0;
    if (!S.next(0, cur)) return;
    f32x4 acc[2][2][4][2];
#pragma unroll
    for (int a = 0; a < 2; ++a)
#pragma unroll
        for (int b = 0; b < 2; ++b)
#pragma unroll
            for (int m = 0; m < 4; ++m)
#pragma unroll
                for (int n = 0; n < 2; ++n) acc[a][b][m][n] = (f32x4){0.f, 0.f, 0.f, 0.f};
    bf16x8 At[4][2], B0[2][2], B1[2][2];
    const char* cA = (const char*)g.A + (size_t)cur.pm * tstep; const char* cB = (const char*)g.Bt + (size_t)cur.pn * tstep;
    {
        PG8_STAGE(PG8_SB(0, 0), cB, voffB); PG8_STAGE(PG8_SB(0, 1), cB + hstep, voffB); PG8_STAGE(PG8_SA(0, 0), cA, voffA); PG8_STAGE(PG8_SA(0, 1), cA + hstep, voffA);
        if (wr == 1) PG8_BAR;
        PG8_WAIT_V(2); PG8_BAR;
        PG8_STAGE(PG8_SB(1, 0), cB + kstep, voffB); PG8_STAGE(PG8_SA(1, 0), cA + kstep, voffA); PG8_STAGE(PG8_SB(1, 1), cB + hstep + kstep, voffB);
        PG8_WAIT_V(6); PG8_BAR;
    }
    for (;;) {
        const bool has_next = S.next(ui + 1, nxt);
        const char* nA = has_next ? (const char*)g.A + (size_t)nxt.pm * tstep : cA; const char* nB = has_next ? (const char*)g.Bt + (size_t)nxt.pn * tstep : cB;
        for (int t = 0; t < nt; t += 2) {
            const bool last = (t == nt - 2);
            const char* a1 = cA + (size_t)(t + 1) * kstep;
            const char* a2 = last ? nA : cA + (size_t)(t + 2) * kstep; const char* b2 = last ? nB : cB + (size_t)(t + 2) * kstep;
            const char* a3 = a2 + kstep; const char* b3 = b2 + kstep;
            PG8_LDB(B0, 0, 0); PG8_LDB(B1, 0, 1); PG8_SCHED; PG8_LDA(At, 0, 0); PG8_STAGE(PG8_SA(1, 1), a1 + hstep, voffA);
            PG8_WAIT_V(8); PG8_WAIT_L(0); PG8_BAR; PG8_MMA(0, 0, At, B0); PG8_MMA(0, 1, At, B1); PG8_BAR; PG8_SCHED;
            PG8_LDA(At, 0, 1); PG8_STAGE(PG8_SB(0, 0), b2, voffB); PG8_STAGE(PG8_SB(0, 1), b2 + hstep, voffB); PG8_STAGE(PG8_SA(0, 0), a2, voffA);
            PG8_WAIT_V(8); PG8_WAIT_L(0); PG8_BAR; PG8_MMA(1, 0, At, B0); PG8_MMA(1, 1, At, B1); PG8_BAR; PG8_SCHED;
            PG8_LDB(B0, 1, 0); PG8_LDB(B1, 1, 1); PG8_SCHED; PG8_LDA(At, 1, 0); PG8_STAGE(PG8_SA(0, 1), a2 + hstep, voffA);
            PG8_WAIT_V(8); PG8_WAIT_L(0); PG8_BAR; PG8_MMA(0, 0, At, B0); PG8_MMA(0, 1, At, B1); PG8_BAR; PG8_SCHED;
            PG8_LDA(At, 1, 1); PG8_STAGE(PG8_SB(1, 0), b3, voffB); PG8_STAGE(PG8_SB(1, 1), b3 + hstep, voffB); PG8_STAGE(PG8_SA(1, 0), a3, voffA);
            PG8_WAIT_V(8); PG8_WAIT_L(0); PG8_BAR; PG8_MMA(1, 0, At, B0); PG8_MMA(1, 1, At, B1); PG8_BAR; PG8_SCHED;
        }
        if (wr == 0) PG8_BAR;
        E(acc, cur, wr, wc, fr, fq);
        if (!has_next) break;
#pragma unroll
        for (int a = 0; a < 2; ++a)
#pragma unroll
            for (int b = 0; b < 2; ++b)
#pragma unroll
                for (int m = 0; m < 4; ++m)
#pragma unroll
                    for (int n = 0; n < 2; ++n) acc[a][b][m][n] = (f32x4){0.f, 0.f, 0.f, 0.f};
        cur = nxt; cA = nA; cB = nB; ++ui;
        if (wr == 1) PG8_BAR;
    }
    PG8_WAIT_V(0);
    PG8_BAR;
#undef PG8_SA
#undef PG8_SB
#undef PG8_STAGE
#undef PG8_LDA
#undef PG8_LDB
#undef PG8_MMA
#undef PG8_WAIT_V
#undef PG8_WAIT_L
#undef PG8_BAR
#undef PG8_SCHED
}

struct EpiScaleBf16 {
    bf16_t* O; int ldc; const float* rowss;
    __device__ __forceinline__ void operator()(const f32x4 (&acc)[2][2][4][2], const Unit& u, int wr, int wc, int fr, int fq) const {
        const int row0 = u.pm * BM + wr * 64 + fr, col0 = u.pn * BM + wc * 32 + 8 * fq;
#pragma unroll
        for (int ai = 0; ai < 2; ++ai)
#pragma unroll
            for (int m = 0; m < 4; ++m) { const int row = row0 + ai * HALF + m * 16;
                const float sc = rowss ? row_rstd(rowss, row) : 1.f;
                bf16_t* rowp = O + (size_t)row * ldc + col0;
#pragma unroll
                for (int bj = 0; bj < 2; ++bj) { const f32x4 v0 = acc[ai][bj][m][0] * sc, v1 = acc[ai][bj][m][1] * sc;
                    u32x4 w; w.x = pk2(v0[0], v0[1]); w.y = pk2(v0[2], v0[3]); w.z = pk2(v1[0], v1[1]); w.w = pk2(v1[2], v1[3]);
                    *(u32x4*)(rowp + bj * HALF) = w; } }
    }
};
struct EpiSwiGLU {
    bf16_t* O; const float* rowss;
    __device__ __forceinline__ void operator()(const f32x4 (&acc)[2][2][4][2], const Unit& u, int wr, int wc, int fr, int fq) const {
        const int row0 = u.pm * BM + wr * 64 + fr, col0 = u.pn * HALF + wc * 32 + 8 * fq;
#pragma unroll
        for (int ai = 0; ai < 2; ++ai)
#pragma unroll
            for (int m = 0; m < 4; ++m) { const int row = row0 + ai * HALF + m * 16;
                const float sc = row_rstd(rowss, row);
                float h[8];
#pragma unroll
                for (int n = 0; n < 2; ++n)
#pragma unroll
                    for (int j = 0; j < 4; ++j) { const float gt = acc[ai][0][m][n][j] * sc, up = acc[ai][1][m][n][j] * sc; h[n * 4 + j] = gt / (1.f + __expf(-gt)) * up; }
                u32x4 w; w.x = pk2(h[0], h[1]); w.y = pk2(h[2], h[3]); w.z = pk2(h[4], h[5]); w.w = pk2(h[6], h[7]);
                *(u32x4*)(O + (size_t)row * DFF + col0) = w; }
    }
};
struct EpiResid {
    float* X; bf16_t* XB; float* rowss_next;
    __device__ __forceinline__ void operator()(const f32x4 (&acc)[2][2][4][2], const Unit& u, int wr, int wc, int fr, int fq) const {
        const int row0 = u.pm * BM + wr * 64 + fr, col0 = u.pn * BM + wc * 32 + 8 * fq;
#pragma unroll
        for (int ai = 0; ai < 2; ++ai)
#pragma unroll
            for (int m = 0; m < 4; ++m) { const int row = row0 + ai * HALF + m * 16; float ss = 0.f;
                float* xp = X + (size_t)row * DM + col0; bf16_t* bp = XB + (size_t)row * DM + col0;
#pragma unroll
                for (int bj = 0; bj < 2; ++bj) {
                    f32x4 x0 = *(f32x4*)(xp + bj * HALF), x1 = *(f32x4*)(xp + bj * HALF + 4);
                    x0 = x0 + acc[ai][bj][m][0]; x1 = x1 + acc[ai][bj][m][1];
                    *(f32x4*)(xp + bj * HALF) = x0; *(f32x4*)(xp + bj * HALF + 4) = x1;
                    ss += (x0[0] * x0[0] + x0[1] * x0[1]) + (x0[2] * x0[2] + x0[3] * x0[3]) + (x1[0] * x1[0] + x1[1] * x1[1]) + (x1[2] * x1[2] + x1[3] * x1[3]);
                    u32x4 w; w.x = pk2(x0[0], x0[1]); w.y = pk2(x0[2], x0[3]); w.z = pk2(x1[0], x1[1]); w.w = pk2(x1[2], x1[3]);
                    *(u32x4*)(bp + bj * HALF) = w; }
                ss += __shfl_xor(ss, 16); ss += __shfl_xor(ss, 32);
                if (fq == 0) rowss_next[(size_t)row * 16 + u.pn * 4 + wc] = ss; }
    }
};
}

struct KArgs { const float* in[31]; float* out; unsigned char* ws; };
#define CAS __attribute__((address_space(4)))
struct InProxy { const CAS unsigned long long* k; __device__ __forceinline__ const float* operator[](int i) const { return (const float*)k[i]; } };
struct Params { InProxy in; float* out; unsigned char* ws; };
__device__ __forceinline__ Params make_params() {
    const CAS unsigned long long* k = (const CAS unsigned long long*)__builtin_amdgcn_kernarg_segment_ptr();
    asm volatile("" : "+s"(k));
    Params p; p.in.k = k; p.out = (float*)k[31]; p.ws = (unsigned char*)k[32]; return p;
}

struct Frame {
    LAS unsigned char* lds;
    int tid, lane, wave, G, bid;
};

#define REFRAME(F) do { int _t = threadIdx.x; asm volatile("" : "+v"(_t)); (F).tid = _t; (F).lane = _t & 63; (F).wave = __builtin_amdgcn_readfirstlane(_t >> 6); } while (0)
__device__ __forceinline__ void cvt_item(const float* W, int K, int ldn, int nblk, bf16_t* WT, const float* gain, bool perm_gu, LAS float* scr, int item, int lane) {
    const int kb = item / nblk, nb = item % nblk, k0 = 64 * kb, n0d = 32 * nb;
    const int n0s = perm_gu ? (((n0d & 255) >> 7) * DFF + (n0d >> 8) * 128 + (n0d & 127)) : n0d;
#pragma unroll 8
    for (int i = 0; i < 32; ++i) { const int kk = 2 * i + (lane >> 5); float v = W[(size_t)(k0 + kk) * ldn + n0s + (lane & 31)]; if (gain) v *= gain[k0 + kk]; scr[kk * 33 + (lane & 31)] = v; }
    asm volatile("s_waitcnt lgkmcnt(0)" ::: "memory");
    const int c = lane & 7;
#pragma unroll
    for (int j = 0; j < 4; ++j) { const int n = (lane >> 3) + 8 * j; const LAS float* s = scr + (8 * c) * 33 + n;
        u32x4 o; o.x = pk2(s[0 * 33], s[1 * 33]); o.y = pk2(s[2 * 33], s[3 * 33]); o.z = pk2(s[4 * 33], s[5 * 33]); o.w = pk2(s[6 * 33], s[7 * 33]);
        *(u32x4*)(WT + (size_t)(n0d + n) * K + k0 + 8 * c) = o; }
    asm volatile("s_waitcnt lgkmcnt(0)" ::: "memory");
}
constexpr int CV_IN = 1536, CV_OUT = 512, CV_Q = 256, CV_KV = 512, CV_O = 256, CV_GU = 2816, CV_DOWN = 1408, CV_L = 8;
constexpr int CV_TOTAL = CV_IN + CV_OUT + CV_Q + CV_KV + CV_O + CV_GU + CV_DOWN + 2 * CV_L + 2 * CV_L + 16;
constexpr int CV_BLOCK_UNITS = CV_TOTAL / 8;
static_assert(CV_TOTAL % 8 == 0, "conversion items per layer");
__device__ __forceinline__ void cvt_layer_item(const Params& p, int l, bf16_t* wb, LAS float* scr, int it, int lane) {
    int r = it;
    if (r < CV_IN) { cvt_item(p.in[3] + (size_t)l * DM * INW, DM, INW, INW / 32, wb + WO_IN, p.in[2] + l * DM, false, scr, r, lane); return; } r -= CV_IN;
    if (r < CV_OUT) { cvt_item(p.in[21] + (size_t)l * DM * DM, DM, DM, DM / 32, wb + WO_OUT, nullptr, false, scr, r, lane); return; } r -= CV_OUT;
    if (r < CV_Q) { cvt_item(p.in[24] + (size_t)l * DM * XW, DM, XW, XW / 32, wb + WO_Q, p.in[22] + l * DM, false, scr, r, lane); return; } r -= CV_Q;
    if (r < CV_KV) { cvt_item(p.in[25] + (size_t)l * DM * 1024, DM, 1024, 32, wb + WO_KV, nullptr, false, scr, r, lane); return; } r -= CV_KV;
    if (r < CV_O) { cvt_item(p.in[26] + (size_t)l * XW * DM, XW, DM, 32, wb + WO_O, nullptr, false, scr, r, lane); return; } r -= CV_O;
    if (r < CV_GU) { cvt_item(p.in[28] + (size_t)l * DM * 2 * DFF, DM, 2 * DFF, 2 * DFF / 32, wb + WO_GU, p.in[27] + l * DM, true, scr, r, lane); return; } r -= CV_GU;
    if (r < CV_DOWN) { cvt_item(p.in[29] + (size_t)l * DFF * DM, DFF, DM, 32, wb + WO_DOWN, nullptr, false, scr, r, lane); return; } r -= CV_DOWN;
    if (r < 2 * CV_L) { const int d = r / CV_L; cvt_item(p.in[12] + ((size_t)l * 2 + d) * 64 * 256, 64, 256, 8, wb + WO_WUP + d * 256 * 64, nullptr, false, scr, r % CV_L, lane); return; } r -= 2 * CV_L;
    if (r < 2 * CV_L) { const int d = r / CV_L; cvt_item(p.in[14] + ((size_t)l * 2 + d) * 64 * 256, 64, 256, 8, wb + WO_AUP + d * 256 * 64, nullptr, false, scr, r % CV_L, lane); return; } r -= 2 * CV_L;
    cvt_item(p.in[15] + (size_t)l * 128 * 256, 128, 256, 8, wb + WO_GUP, nullptr, false, scr, r, lane);
}

__device__ __forceinline__ s16x4 vtr(const LAS unsigned char* p) { return __builtin_bit_cast(s16x4, __builtin_amdgcn_ds_read_tr16_b64_v4i16((LAS v4i16_t*)p)); }
__device__ __forceinline__ int crow(int r, int hi) { return (r & 3) + 8 * (r >> 2) + 4 * hi; }

template <int W> __device__ __forceinline__ void tile_load(u32x4 (&r)[W / 64], const bf16_t* g, int pitch, int tid) {
#pragma unroll
    for (int i = 0; i < W / 64; ++i) { const int id = tid + i * 512, row = id / (W / 8), ch = id % (W / 8); r[i] = *(const u32x4*)(g + (size_t)row * pitch + ch * 8); }
}
template <int W, int STR> __device__ __forceinline__ void tile_store(const u32x4 (&r)[W / 64], LAS unsigned char* buf, int tid) {
#pragma unroll
    for (int i = 0; i < W / 64; ++i) { const int id = tid + i * 512, row = id / (W / 8), ch = id % (W / 8); *(LAS u32x4*)(buf + row * STR + ch * 16) = r[i]; }
}
template <int DQK> __device__ __forceinline__ void load_q(bf16x8 (&qf)[DQK / 16], const bf16_t* qrow, int h, float sc) {
#pragma unroll
    for (int ks = 0; ks < DQK / 16; ++ks) { const u32x4 v = *(const u32x4*)(qrow + 16 * ks + 8 * h);
        u32x4 o; o.x = pk2(bflo(v.x) * sc, bfhi(v.x) * sc); o.y = pk2(bflo(v.y) * sc, bfhi(v.y) * sc); o.z = pk2(bflo(v.z) * sc, bfhi(v.z) * sc); o.w = pk2(bflo(v.w) * sc, bfhi(v.w) * sc);
        qf[ks] = __builtin_bit_cast(bf16x8, o); }
}
template <int DQK, int KW, int DV, int MODE>
__device__ __forceinline__ void attn_loop(LAS unsigned char* lds, const bf16_t* Kg, int kpitch, const bf16_t* Vg, int vpitch, int ntiles,
                                          const bf16x8 (&qf)[DQK / 16], int koff, float nslope2, int qrel, float& m, float& lsum, f32x16 (&o)[DV / 32]) {
    constexpr int KSTR = (KW + 8) * 2, VSTR = DV * 2 + 64, KBUF = 64 * KSTR, VBUF = 64 * VSTR;
    int tid_ = threadIdx.x; asm volatile("" : "+v"(tid_));
    const int tid = tid_, lane = tid & 63, r = lane & 31, h = lane >> 5;
    LAS unsigned char* K0 = lds; LAS unsigned char* V0 = lds + 2 * KBUF;
    u32x4 kr[KW / 64], vr[DV / 64];
    tile_load<KW>(kr, Kg, kpitch, tid); tile_load<DV>(vr, Vg, vpitch, tid);
    tile_store<KW, KSTR>(kr, K0, tid); tile_store<DV, VSTR>(vr, V0, tid);
    __syncthreads();
    const int vlane = ((lane & 15) >> 2) * VSTR + (16 * ((lane >> 4) & 1) + 4 * (lane & 3)) * 2 + 4 * h * VSTR;
    for (int t = 0; t < ntiles; ++t) {
        const int cur = t & 1;
        if (t + 1 < ntiles) { tile_load<KW>(kr, Kg + (size_t)(t + 1) * 64 * kpitch, kpitch, tid); tile_load<DV>(vr, Vg + (size_t)(t + 1) * 64 * vpitch, vpitch, tid); }
        const LAS unsigned char* Kb = K0 + cur * KBUF + r * KSTR + (koff + 8 * h) * 2;
        const LAS unsigned char* Vb = V0 + cur * VBUF + vlane;
        f32x16 s0, s1;
#pragma unroll
        for (int i = 0; i < 16; ++i) { s0[i] = 0.f; s1[i] = 0.f; }
#pragma unroll
        for (int ks = 0; ks < DQK / 16; ++ks) {
            const bf16x8 k0 = *(const LAS bf16x8*)(Kb + ks * 32), k1 = *(const LAS bf16x8*)(Kb + 32 * KSTR + ks * 32);
            s0 = __builtin_amdgcn_mfma_f32_32x32x16_bf16(k0, qf[ks], s0, 0, 0, 0);
            s1 = __builtin_amdgcn_mfma_f32_32x32x16_bf16(k1, qf[ks], s1, 0, 0, 0);
        }
        if (MODE >= 1) {
            const float base = (float)(t * 64 + 4 * h - qrel);
#pragma unroll
            for (int i = 0; i < 16; ++i) {
                const float d0 = fabsf(base + (float)((i & 3) + 8 * (i >> 2))), d1 = fabsf(base + (float)(32 + (i & 3) + 8 * (i >> 2)));
                s0[i] = __builtin_fmaf(d0, nslope2, s0[i]); s1[i] = __builtin_fmaf(d1, nslope2, s1[i]);
                if (MODE == 2) { if (d0 > 128.f) s0[i] = -1e30f; if (d1 > 128.f) s1[i] = -1e30f; }
            }
        }
        float mx = fmaxf(s0[0], s1[0]);
#pragma unroll
        for (int i = 1; i < 16; ++i) mx = fmaxf(mx, fmaxf(s0[i], s1[i]));
        mx = fmaxf(mx, xhalf(mx));
        const float mnew = fmaxf(m, mx), alpha = __builtin_amdgcn_exp2f(m - mnew);
        m = mnew;
        float rs = 0.f;
#pragma unroll
        for (int i = 0; i < 16; ++i) { s0[i] = __builtin_amdgcn_exp2f(s0[i] - mnew); s1[i] = __builtin_amdgcn_exp2f(s1[i] - mnew); rs += s0[i] + s1[i]; }
        lsum = lsum * alpha + rs;
#pragma unroll
        for (int d = 0; d < DV / 32; ++d) o[d] = o[d] * alpha;
        bf16x8 pf[4];
#pragma unroll
        for (int s2 = 0; s2 < 2; ++s2) {
            u32x4 a, b;
            a.x = pk2(s0[8 * s2 + 0], s0[8 * s2 + 1]); a.y = pk2(s0[8 * s2 + 2], s0[8 * s2 + 3]); a.z = pk2(s0[8 * s2 + 4], s0[8 * s2 + 5]); a.w = pk2(s0[8 * s2 + 6], s0[8 * s2 + 7]);
            b.x = pk2(s1[8 * s2 + 0], s1[8 * s2 + 1]); b.y = pk2(s1[8 * s2 + 2], s1[8 * s2 + 3]); b.z = pk2(s1[8 * s2 + 4], s1[8 * s2 + 5]); b.w = pk2(s1[8 * s2 + 6], s1[8 * s2 + 7]);
            pf[s2] = __builtin_bit_cast(bf16x8, a); pf[2 + s2] = __builtin_bit_cast(bf16x8, b);
        }
#pragma unroll
        for (int d = 0; d < DV / 32; ++d) {
#pragma unroll
            for (int kk = 0; kk < 4; ++kk) {
                const s16x4 lo = vtr(Vb + (16 * kk) * VSTR + d * 64), hi = vtr(Vb + (16 * kk + 8) * VSTR + d * 64);
                const bf16x8 vf = {lo[0], lo[1], lo[2], lo[3], hi[0], hi[1], hi[2], hi[3]};
                o[d] = __builtin_amdgcn_mfma_f32_32x32x16_bf16(vf, pf[kk], o[d], 0, 0, 0);
            }
        }
        if (t + 1 < ntiles) { tile_store<KW, KSTR>(kr, K0 + (cur ^ 1) * KBUF, tid); tile_store<DV, VSTR>(vr, V0 + (cur ^ 1) * VBUF, tid); }
        __syncthreads();
    }
}
template <int DV> __device__ __forceinline__ void store_o(const f32x16 (&o)[DV / 32], float sc, bf16_t* orow, int h) {
#pragma unroll
    for (int d = 0; d < DV / 32; ++d)
#pragma unroll
        for (int g4 = 0; g4 < 4; ++g4) { u32x2 w; w.x = pk2(o[d][4 * g4] * sc, o[d][4 * g4 + 1] * sc); w.y = pk2(o[d][4 * g4 + 2] * sc, o[d][4 * g4 + 3] * sc);
            *(u32x2*)(orow + 32 * d + 8 * g4 + 4 * h) = w; }
}

__device__ __forceinline__ void win_unit(Frame& F, const Params& p, int l, int u) {
    REFRAME(F);
    const bf16_t* Z = (const bf16_t*)(p.ws + WS_Z); bf16_t* MIX = (bf16_t*)(p.ws + WS_MIX);
    const int b = u >> 5, kvh = (u >> 4) & 1, nb = u & 15, r = F.lane & 31, h = F.lane >> 5;
    const int g = F.wave >> 2, hq = kvh * 2 + g, qpos = nb * 128 + (F.wave & 3) * 32 + r;
    const size_t tok = (size_t)b * SEQ + qpos;
    bf16x8 qf[4]; load_q<64>(qf, Z + tok * INW + hq * 64, h, 0.125f * LOG2E);
    const int first = (2 * nb - 2 < 0) ? 0 : 2 * nb - 2, lastx = (2 * nb + 4 > 32) ? 32 : 2 * nb + 4, nt = lastx - first;
    const float slope = exp2f(-(float)(2 * hq + 1));
    float m = p.in[4][l * 4 + hq] * LOG2E, ls = (h == 0) ? 1.f : 0.f;
    f32x16 o[2];
#pragma unroll
    for (int d = 0; d < 2; ++d)
#pragma unroll
        for (int i = 0; i < 16; ++i) o[d][i] = 0.f;
    const bf16_t* Kg = Z + ((size_t)b * SEQ + first * 64) * INW + 256 + kvh * 64;
    attn_loop<64, 64, 64, 2>(F.lds, Kg, INW, Kg + 128, INW, nt, qf, 0, -slope * LOG2E, qpos - first * 64, m, ls, o);
    const float lt = ls + xhalf(ls);
    store_o<64>(o, 1.f / lt, MIX + tok * DM + hq * 64, h);
}
__device__ __forceinline__ void diff_unit(Frame& F, const Params& p, int l, int u) {
    REFRAME(F);
    const bf16_t* Z = (const bf16_t*)(p.ws + WS_Z); bf16_t* MIX = (bf16_t*)(p.ws + WS_MIX);
    const int b = u >> 6, hh = (u >> 4) & 3, qb = u & 15, r = F.lane & 31, h = F.lane >> 5;
    const int c = F.wave >> 2, qpos = qb * 128 + (F.wave & 3) * 32 + r;
    const size_t tok = (size_t)b * SEQ + qpos;
    float lam, lam_init;
    {
        const float a1 = wave_sum(p.in[5][l * 64 + F.lane] * p.in[6][l * 64 + F.lane]), a2 = wave_sum(p.in[7][l * 64 + F.lane] * p.in[8][l * 64 + F.lane]);
        lam_init = 0.8f - 0.6f * expf(-0.3f * (float)l);
        lam = expf(a1) - expf(a2) + lam_init;
    }
    bf16x8 qf[4]; load_q<64>(qf, Z + tok * INW + 512 + hh * 128 + c * 64, h, 0.125f * LOG2E);
    const float slope = exp2f(-(float)(2 * hh + 2));
    float m = -1e30f, ls = 0.f;
    f32x16 o[4];
#pragma unroll
    for (int d = 0; d < 4; ++d)
#pragma unroll
        for (int i = 0; i < 16; ++i) o[d][i] = 0.f;
    const bf16_t* Kg = Z + ((size_t)b * SEQ) * INW + 1024 + hh * 128;
    attn_loop<64, 128, 128, 1>(F.lds, Kg, INW, Kg + 512, INW, 32, qf, c * 64, -slope * LOG2E, qpos, m, ls, o);
    const float inv = 1.f / (ls + xhalf(ls));
    LAS float* comb = (LAS float*)F.lds + (size_t)(F.wave & 3) * 64 * 64 + F.lane;
    if (c == 1) {
#pragma unroll
        for (int d = 0; d < 4; ++d)
#pragma unroll
            for (int i = 0; i < 16; ++i) comb[(d * 16 + i) * 64] = o[d][i] * inv;
    }
    __syncthreads();
    if (c == 0) {
        float ss = 0.f;
#pragma unroll
        for (int d = 0; d < 4; ++d)
#pragma unroll
            for (int i = 0; i < 16; ++i) { const float a = o[d][i] * inv - lam * comb[(d * 16 + i) * 64]; o[d][i] = a; ss += a * a; }
        ss += xhalf(ss);
        const float rn = rsqrtf(ss * (1.f / 128.f) + 1e-6f) * (1.f - lam_init);
        const float* sg = p.in[9] + l * 128;
        bf16_t* orow = MIX + tok * DM + 256 + hh * 128;
#pragma unroll
        for (int d = 0; d < 4; ++d)
#pragma unroll
            for (int g4 = 0; g4 < 4; ++g4) { const int dv = 32 * d + 8 * g4 + 4 * h; const f32x4 gg = *(const f32x4*)(sg + dv);
                u32x2 w; w.x = pk2(o[d][4 * g4] * rn * gg[0], o[d][4 * g4 + 1] * rn * gg[1]); w.y = pk2(o[d][4 * g4 + 2] * rn * gg[2], o[d][4 * g4 + 3] * rn * gg[3]);
                *(u32x2*)(orow + dv) = w; }
    }
    __syncthreads();
}
__device__ __forceinline__ void cross_unit(Frame& F, const Params& p, int u) {
    REFRAME(F);
    const bf16_t* Q = (const bf16_t*)(p.ws + WS_Q); const bf16_t* KV = (const bf16_t*)(p.ws + WS_KV); bf16_t* O = (bf16_t*)(p.ws + WS_O);
    const int b = u >> 5, hd = (u >> 3) & 3, qb = u & 7, r = F.lane & 31, h = F.lane >> 5;
    const size_t tok = (size_t)b * SEQ + qb * 256 + F.wave * 32 + r;
    bf16x8 qf[8]; load_q<128>(qf, Q + tok * XW + hd * 128, h, 0.08838834764831845f * LOG2E);
    float m = -1e30f, ls = 0.f;
    f32x16 o[4];
#pragma unroll
    for (int d = 0; d < 4; ++d)
#pragma unroll
        for (int i = 0; i < 16; ++i) o[d][i] = 0.f;
    const bf16_t* Kg = KV + ((size_t)b * NMEM) * 1024 + hd * 128;
    attn_loop<128, 128, 128, 0>(F.lds, Kg, 1024, Kg + 512, 1024, 4, qf, 0, 0.f, 0, m, ls, o);
    const float lt = ls + xhalf(ls);
    store_o<128>(o, 1.f / lt, O + tok * XW + hd * 128, h);
}

constexpr int CF_STR = 772, PREP_AW = 32 * CF_STR * 4, PREP_AA = PREP_AW + 32 * 72 * 2, PREP_AG = PREP_AA + 32 * 72 * 2;
__device__ __forceinline__ void prep_unit(Frame& F, const Params& p, int l, const bf16_t* wb, int u) {
    REFRAME(F);
    const bf16_t* Z = (const bf16_t*)(p.ws + WS_Z);
    const int t0 = u * 32, b = t0 / SEQ;
    LAS float* CF = (LAS float*)F.lds; LAS bf16_t* AW = (LAS bf16_t*)(F.lds + PREP_AW); LAS bf16_t* AA = (LAS bf16_t*)(F.lds + PREP_AA); LAS bf16_t* AG = (LAS bf16_t*)(F.lds + PREP_AG);
    const float* conv = p.in[10] + (size_t)l * 3 * 1024;
#pragma unroll 2
    for (int i = 0; i < 8; ++i) {
        const int id = F.tid + i * 512, tk = id >> 7, ch = id & 127, tg = t0 + tk, tpos = tg - b * SEQ;
        const bf16_t* zp = Z + (size_t)tg * INW + 2048 + ch * 8;
        const u32x4 zc = *(const u32x4*)zp;
        u32x4 zl = {0u, 0u, 0u, 0u}, zr = {0u, 0u, 0u, 0u};
        if (tpos > 0) zl = *(const u32x4*)(zp - INW);
        if (tpos < SEQ - 1) zr = *(const u32x4*)(zp + INW);
        float v[8];
#pragma unroll
        for (int q = 0; q < 4; ++q) {
            const f32x2 c0 = *(const f32x2*)(conv + ch * 8 + 2 * q), c1 = *(const f32x2*)(conv + 1024 + ch * 8 + 2 * q), c2 = *(const f32x2*)(conv + 2048 + ch * 8 + 2 * q);
            v[2 * q] = bflo(zl[q]) * c0[0] + bflo(zc[q]) * c1[0] + bflo(zr[q]) * c2[0];
            v[2 * q + 1] = bfhi(zl[q]) * c0[1] + bfhi(zc[q]) * c1[1] + bfhi(zr[q]) * c2[1];
        }
        if (ch < 96) { *(LAS f32x4*)(CF + tk * CF_STR + ch * 8) = (f32x4){v[0], v[1], v[2], v[3]}; *(LAS f32x4*)(CF + tk * CF_STR + ch * 8 + 4) = (f32x4){v[4], v[5], v[6], v[7]}; }
        else {
            u32x4 w;
            if (ch < 104) {
#pragma unroll
                for (int q = 0; q < 8; ++q) v[q] = 1.f - 2.f / (__expf(2.f * v[q]) + 1.f);
                w.x = pk2(v[0], v[1]); w.y = pk2(v[2], v[3]); w.z = pk2(v[4], v[5]); w.w = pk2(v[6], v[7]);
                *(LAS u32x4*)(AW + tk * 72 + (ch - 96) * 8) = w;
            } else if (ch < 112) {
                w.x = pk2(v[0], v[1]); w.y = pk2(v[2], v[3]); w.z = pk2(v[4], v[5]); w.w = pk2(v[6], v[7]);
                *(LAS u32x4*)(AA + tk * 72 + (ch - 104) * 8) = w;
            } else {
#pragma unroll
                for (int q = 0; q < 8; ++q) v[q] = sigmoidf_(v[q]);
                w.x = pk2(v[0], v[1]); w.y = pk2(v[2], v[3]); w.z = pk2(v[4], v[5]); w.w = pk2(v[6], v[7]);
                *(LAS u32x4*)(AG + tk * 136 + (ch - 112) * 8) = w;
            }
        }
    }
    __syncthreads();
    const int hh = F.wave & 3, dir = F.wave >> 2, tk = F.lane & 31, h2 = F.lane >> 5;
    const size_t tok = (size_t)t0 + tk;
    const bf16_t* Wup = wb + WO_WUP + (size_t)(dir * 256 + hh * 64) * 64;
    const bf16_t* Aup = wb + WO_AUP + (size_t)(dir * 256 + hh * 64) * 64;
    f32x16 aw[2], aa[2];
#pragma unroll
    for (int rb = 0; rb < 2; ++rb)
#pragma unroll
        for (int i = 0; i < 16; ++i) { aw[rb][i] = 0.f; aa[rb][i] = 0.f; }
#pragma unroll
    for (int ks = 0; ks < 4; ++ks) {
        const bf16x8 bw = *(const LAS bf16x8*)(AW + tk * 72 + 16 * ks + 8 * h2), ba = *(const LAS bf16x8*)(AA + tk * 72 + 16 * ks + 8 * h2);
#pragma unroll
        for (int rb = 0; rb < 2; ++rb) {
            const bf16x8 fw = *(const bf16x8*)(Wup + (size_t)(rb * 32 + tk) * 64 + 16 * ks + 8 * h2), fa = *(const bf16x8*)(Aup + (size_t)(rb * 32 + tk) * 64 + 16 * ks + 8 * h2);
            aw[rb] = __builtin_amdgcn_mfma_f32_32x32x16_bf16(fw, bw, aw[rb], 0, 0, 0);
            aa[rb] = __builtin_amdgcn_mfma_f32_32x32x16_bf16(fa, ba, aa[rb], 0, 0, 0);
        }
    }
    const float* k_k = p.in[16] + l * 256 + hh * 64; const float* k_a = p.in[17] + l * 256 + hh * 64; const float* r_k = p.in[18] + l * 256 + hh * 64;
    const float* w0 = p.in[11] + (size_t)(l * 2 + dir) * 256 + hh * 64; const float* a0 = p.in[13] + (size_t)(l * 2 + dir) * 256 + hh * 64;
    float ssq = 0.f;
#pragma unroll
    for (int rb = 0; rb < 2; ++rb)
#pragma unroll
        for (int g4 = 0; g4 < 4; ++g4) { const int c0 = rb * 32 + 8 * g4 + 4 * h2;
            const f32x4 kv = *(const LAS f32x4*)(CF + tk * CF_STR + 256 + hh * 64 + c0), kkw = *(const f32x4*)(k_k + c0);
            const f32x4 q = kv * kkw; ssq += (q[0] * q[0] + q[1] * q[1]) + (q[2] * q[2] + q[3] * q[3]); }
    ssq += xhalf(ssq);
    const float kinv = 1.f / fmaxf(sqrtf(ssq), 1e-12f);
    float bon = 0.f;
    bf16_t* OM = (bf16_t*)(p.ws + WS_OM) + ((size_t)dir * MTOK + tok) * 256 + hh * 64;
    bf16_t* KA = (bf16_t*)(p.ws + WS_KA) + ((size_t)dir * MTOK + tok) * 256 + hh * 64;
    bf16_t* KD = (bf16_t*)(p.ws + WS_KD) + ((size_t)dir * MTOK + tok) * 256 + hh * 64;
    bf16_t* KK = (bf16_t*)(p.ws + WS_KK) + tok * 256 + hh * 64;
    bf16_t* VV = (bf16_t*)(p.ws + WS_V) + tok * 256 + hh * 64;
    bf16_t* RR = (bf16_t*)(p.ws + WS_R) + tok * 256 + hh * 64;
#pragma unroll
    for (int rb = 0; rb < 2; ++rb)
#pragma unroll
        for (int g4 = 0; g4 < 4; ++g4) { const int c0 = rb * 32 + 8 * g4 + 4 * h2;
            const f32x4 kv = *(const LAS f32x4*)(CF + tk * CF_STR + 256 + hh * 64 + c0), rv = *(const LAS f32x4*)(CF + tk * CF_STR + hh * 64 + c0);
            const f32x4 kkw = *(const f32x4*)(k_k + c0), kaw = *(const f32x4*)(k_a + c0), rkw = *(const f32x4*)(r_k + c0), w0v = *(const f32x4*)(w0 + c0), a0v = *(const f32x4*)(a0 + c0);
            float om[4], ka[4], kd[4], kk[4];
#pragma unroll
            for (int j = 0; j < 4; ++j) {
                const float wp = aw[rb][4 * g4 + j] + w0v[j], ap = aa[rb][4 * g4 + j] + a0v[j];
                om[j] = 1.f - __expf(-0.6065306597126334f * sigmoidf_(wp));
                const float a = sigmoidf_(ap);
                kk[j] = kv[j] * kkw[j] * kinv; ka[j] = kk[j] * a; kd[j] = kv[j] * (1.f + (a - 1.f) * kaw[j]);
                bon += rv[j] * kd[j] * rkw[j];
            }
            u32x2 w; w.x = pk2(om[0], om[1]); w.y = pk2(om[2], om[3]); *(u32x2*)(OM + c0) = w;
            w.x = pk2(ka[0], ka[1]); w.y = pk2(ka[2], ka[3]); *(u32x2*)(KA + c0) = w;
            w.x = pk2(kd[0], kd[1]); w.y = pk2(kd[2], kd[3]); *(u32x2*)(KD + c0) = w;
            if (dir == 0) {
                const f32x4 vv = *(const LAS f32x4*)(CF + tk * CF_STR + 512 + hh * 64 + c0);
                w.x = pk2(kk[0], kk[1]); w.y = pk2(kk[2], kk[3]); *(u32x2*)(KK + c0) = w;
                w.x = pk2(vv[0], vv[1]); w.y = pk2(vv[2], vv[3]); *(u32x2*)(VV + c0) = w;
                w.x = pk2(rv[0], rv[1]); w.y = pk2(rv[2], rv[3]); *(u32x2*)(RR + c0) = w;
            }
        }
    bon += xhalf(bon);
    if (h2 == 0) ((float*)(p.ws + WS_BON))[((size_t)dir * MTOK + tok) * 4 + hh] = bon;
    {
        const bf16_t* Gup = wb + WO_GUP + (size_t)(F.wave * 32 + tk) * 128;
        f32x16 ag;
#pragma unroll
        for (int i = 0; i < 16; ++i) ag[i] = 0.f;
#pragma unroll
        for (int ks = 0; ks < 8; ++ks) {
            const bf16x8 bg = *(const LAS bf16x8*)(AG + tk * 136 + 16 * ks + 8 * h2), fg = *(const bf16x8*)(Gup + 16 * ks + 8 * h2);
            ag = __builtin_amdgcn_mfma_f32_32x32x16_bf16(fg, bg, ag, 0, 0, 0);
        }
        bf16_t* GT = (bf16_t*)(p.ws + WS_GATE) + tok * 256 + F.wave * 32;
#pragma unroll
        for (int g4 = 0; g4 < 4; ++g4) { u32x2 w; w.x = pk2(ag[4 * g4], ag[4 * g4 + 1]); w.y = pk2(ag[4 * g4 + 2], ag[4 * g4 + 3]); *(u32x2*)(GT + 8 * g4 + 4 * h2) = w; }
    }
    __syncthreads();
}

template <int CTRL> __device__ __forceinline__ float dpp_f(float x) { const int xi = __builtin_bit_cast(int, x); return __builtin_bit_cast(float, __builtin_amdgcn_update_dpp(xi, xi, CTRL, 0xf, 0xf, false)); }
template <int L> __device__ __forceinline__ float allred(float x) {
    if (L == 16) x += dpp_f<0x140>(x);
    x += dpp_f<0x141>(x);
    x += dpp_f<0xB1>(x);
    x += dpp_f<0x4E>(x);
    return x;
}
constexpr int SC_T = 32;
template <int L>
__device__ __forceinline__ void scan_unit(Frame& F, const Params& p, int u) {
    REFRAME(F);
    constexpr int E = 64 / L, RPW = 64 / L, RPB = 8 * RPW, NSPLIT = 64 / RPB;
    const int dbh = u / NSPLIT, part = u % NSPLIT, dir = dbh >> 5, b = (dbh >> 2) & 7, hh = dbh & 3;
    const int j = F.lane % L, row = part * RPB + F.wave * RPW + F.lane / L;
    LAS float* buf = (LAS float*)F.lds;
    const bf16_t* src[6];
    src[0] = (const bf16_t*)(p.ws + WS_OM) + (size_t)dir * MTOK * 256; src[1] = (const bf16_t*)(p.ws + WS_KK); src[2] = (const bf16_t*)(p.ws + WS_KA) + (size_t)dir * MTOK * 256;
    src[3] = (const bf16_t*)(p.ws + WS_KD) + (size_t)dir * MTOK * 256; src[4] = (const bf16_t*)(p.ws + WS_R); src[5] = (const bf16_t*)(p.ws + WS_V);
    bf16_t* Y = (bf16_t*)(p.ws + WS_Y) + (size_t)dir * MTOK * 256;
    const int st_hi = F.tid >> 8, st_step = (F.tid & 255) >> 3, st_ch = F.tid & 7;
    u32x4 sr[3];
    float S[E];
#pragma unroll
    for (int e = 0; e < E; ++e) S[e] = 0.f;
#define SC_LOAD(chunk) do { _Pragma("unroll") for (int i = 0; i < 3; ++i) { const int tt = (chunk) * SC_T + st_step, t = dir ? (SEQ - 1 - tt) : tt; \
        const bf16_t* sp = st_hi ? src[2 * i + 1] : src[2 * i]; sr[i] = *(const u32x4*)(sp + ((size_t)b * SEQ + t) * 256 + hh * 64 + st_ch * 8); } } while (0)
#define SC_STORE(bi) do { _Pragma("unroll") for (int i = 0; i < 3; ++i) { LAS float* d = buf + (bi) * 6 * 2048 + (2 * i + st_hi) * 2048 + st_step * 64 + st_ch * 8; \
        f32x4 a = {bflo(sr[i].x), bfhi(sr[i].x), bflo(sr[i].y), bfhi(sr[i].y)}, c = {bflo(sr[i].z), bfhi(sr[i].z), bflo(sr[i].w), bfhi(sr[i].w)}; \
        if (i == 0 && st_hi == 0) { a = 1.f - a; c = 1.f - c; } *(LAS f32x4*)d = a; *(LAS f32x4*)(d + 4) = c; } } while (0)
    SC_LOAD(0); SC_STORE(0);
    __syncthreads();
    for (int ck = 0; ck < SEQ / SC_T; ++ck) {
        const int cur = ck & 1;
        if (ck + 1 < SEQ / SC_T) SC_LOAD(ck + 1);
        const LAS float* cb = buf + cur * 6 * 2048;
#pragma unroll 4
        for (int i = 0; i < SC_T; ++i) {
            const LAS float* bp = cb + i * 64 + j * E;
            float w[E], kk[E], ka[E], kd[E], rr[E];
#pragma unroll
            for (int e = 0; e < E; e += 4) {
                const f32x4 a0 = *(const LAS f32x4*)(bp + e), a1 = *(const LAS f32x4*)(bp + 2048 + e), a2 = *(const LAS f32x4*)(bp + 4096 + e), a3 = *(const LAS f32x4*)(bp + 6144 + e), a4 = *(const LAS f32x4*)(bp + 8192 + e);
#pragma unroll
                for (int q = 0; q < 4; ++q) { w[e + q] = a0[q]; kk[e + q] = a1[q]; ka[e + q] = a2[q]; kd[e + q] = a3[q]; rr[e + q] = a4[q]; }
            }
            const float v = cb[5 * 2048 + i * 64 + row];
            float uu = 0.f;
#pragma unroll
            for (int e = 0; e < E; ++e) uu = __builtin_fmaf(S[e], kk[e], uu);
            uu = allred<L>(uu);
            float yy = 0.f;
#pragma unroll
            for (int e = 0; e < E; ++e) { S[e] = __builtin_fmaf(S[e], w[e], __builtin_fmaf(v, kd[e], -uu * ka[e])); yy = __builtin_fmaf(S[e], rr[e], yy); }
            yy = allred<L>(yy);
            if (j == 0) { const int tt = ck * SC_T + i, t = dir ? (SEQ - 1 - tt) : tt; Y[((size_t)b * SEQ + t) * 256 + hh * 64 + row] = (bf16_t)(pk2(yy, 0.f) & 0xffffu); }
        }
        if (ck + 1 < SEQ / SC_T) SC_STORE(cur ^ 1);
        __syncthreads();
    }
#undef SC_LOAD
#undef SC_STORE
}

__device__ __forceinline__ void post_phase(Frame& F, const Params& p, int l) {
    REFRAME(F);
    const int gw = F.bid * 8 + F.wave, NGW = F.G * 8;
    const bf16_t* Y0 = (const bf16_t*)(p.ws + WS_Y); const bf16_t* Y1 = Y0 + (size_t)MTOK * 256;
    const bf16_t* VV = (const bf16_t*)(p.ws + WS_V); const bf16_t* GT = (const bf16_t*)(p.ws + WS_GATE);
    const float* BON = (const float*)(p.ws + WS_BON); bf16_t* MIX = (bf16_t*)(p.ws + WS_MIX);
    const f32x4 lg = *(const f32x4*)(p.in[19] + l * 256 + 4 * F.lane), lb = *(const f32x4*)(p.in[20] + l * 256 + 4 * F.lane);
    for (int tok = gw; tok < MTOK; tok += NGW) {
        const u32x2 a = *(const u32x2*)(Y0 + (size_t)tok * 256 + 4 * F.lane), c = *(const u32x2*)(Y1 + (size_t)tok * 256 + 4 * F.lane);
        const u32x2 vv = *(const u32x2*)(VV + (size_t)tok * 256 + 4 * F.lane), gg = *(const u32x2*)(GT + (size_t)tok * 256 + 4 * F.lane);
        float y[4] = {bflo(a.x) + bflo(c.x), bfhi(a.x) + bfhi(c.x), bflo(a.y) + bflo(c.y), bfhi(a.y) + bfhi(c.y)};
        float s = (y[0] + y[1]) + (y[2] + y[3]);
#pragma unroll
        for (int o = 1; o < 16; o <<= 1) s += __shfl_xor(s, o);
        const float mu = s * (1.f / 64.f);
        float q = 0.f;
#pragma unroll
        for (int i = 0; i < 4; ++i) { y[i] -= mu; q += y[i] * y[i]; }
#pragma unroll
        for (int o = 1; o < 16; o <<= 1) q += __shfl_xor(q, o);
        const float rstd = rsqrtf(q * (1.f / 64.f) + 64e-5f);
        const int hh = F.lane >> 4;
        const float bon = BON[(size_t)tok * 4 + hh] + BON[((size_t)MTOK + tok) * 4 + hh];
        const float v4[4] = {bflo(vv.x), bfhi(vv.x), bflo(vv.y), bfhi(vv.y)}, g4[4] = {bflo(gg.x), bfhi(gg.x), bflo(gg.y), bfhi(gg.y)};
        float o4[4];
#pragma unroll
        for (int i = 0; i < 4; ++i) o4[i] = (y[i] * rstd * lg[i] + lb[i] + bon * v4[i]) * g4[i];
        u32x2 w; w.x = pk2(o4[0], o4[1]); w.y = pk2(o4[2], o4[3]);
        *(u32x2*)(MIX + (size_t)tok * DM + 768 + 4 * F.lane) = w;
    }
}

__device__ __forceinline__ void prologue(Frame& F, const Params& p) {
    REFRAME(F);
    LAS float* scr = (LAS float*)(F.lds + F.wave * 16384);
    const int gw = F.bid * 8 + F.wave, NGW = F.G * 8;
    bf16_t* wb = (bf16_t*)(p.ws + WS_W);
    for (int it = gw; it < CV_TOTAL; it += NGW) cvt_layer_item(p, 0, wb, scr, it, F.lane);
    const float* x = p.in[0]; float* X = p.out; bf16_t* XB = (bf16_t*)(p.ws + WS_XB); float* rowss = (float*)(p.ws + WS_RP);
    for (int m = gw; m < MTOK; m += NGW) {
        const f32x4* xr = (const f32x4*)(x + (size_t)m * DM) + F.lane; f32x4* xo = (f32x4*)(X + (size_t)m * DM) + F.lane; u32x2* bo = (u32x2*)(XB + (size_t)m * DM) + F.lane;
        float s = 0.f;
#pragma unroll
        for (int jj = 0; jj < 4; ++jj) { const f32x4 v = xr[64 * jj]; xo[64 * jj] = v; s += (v[0] * v[0] + v[1] * v[1]) + (v[2] * v[2] + v[3] * v[3]);
            u32x2 w; w.x = pk2(v[0], v[1]); w.y = pk2(v[2], v[3]); bo[64 * jj] = w; }
        s = wave_sum(s);
        if (F.lane < 16) rowss[(size_t)m * 16 + F.lane] = (F.lane == 0) ? s : 0.f;
    }
    const float* mem = p.in[1]; const float* gm = p.in[23]; bf16_t* MN = (bf16_t*)(p.ws + WS_MEMN);
    for (int m = gw; m < MMEM; m += NGW) {
        const f32x4* xr = (const f32x4*)(mem + (size_t)m * DM) + F.lane; u32x2* bo = (u32x2*)(MN + (size_t)m * DM) + F.lane;
        f32x4 v[4]; float s = 0.f;
#pragma unroll
        for (int jj = 0; jj < 4; ++jj) { v[jj] = xr[64 * jj]; s += (v[jj][0] * v[jj][0] + v[jj][1] * v[jj][1]) + (v[jj][2] * v[jj][2] + v[jj][3] * v[jj][3]); }
        const float rstd = rsqrtf(wave_sum(s) * (1.f / 1024.f) + 1e-6f);
#pragma unroll
        for (int jj = 0; jj < 4; ++jj) { const f32x4 g = *((const f32x4*)gm + F.lane + 64 * jj); const f32x4 t = v[jj] * rstd * g;
            u32x2 w; w.x = pk2(t[0], t[1]); w.y = pk2(t[2], t[3]); bo[64 * jj] = w; }
    }
}
__device__ __forceinline__ void final_norm(Frame& F, const Params& p) {
    REFRAME(F);
    const int gw = F.bid * 8 + F.wave, NGW = F.G * 8;
    const float* rowss = (const float*)(p.ws + WS_RP) + (size_t)12 * MTOK * 16; const float* gf = p.in[30];
    for (int m = gw; m < MTOK; m += NGW) {
        f32x4* xo = (f32x4*)(p.out + (size_t)m * DM) + F.lane;
        const float rstd = row_rstd(rowss, m);
#pragma unroll
        for (int jj = 0; jj < 4; ++jj) { const f32x4 g = *((const f32x4*)gf + F.lane + 64 * jj); xo[64 * jj] = xo[64 * jj] * rstd * g; }
    }
}

__device__ __forceinline__ void gsync(int idx) {
    const CAS unsigned long long* k = (const CAS unsigned long long*)__builtin_amdgcn_kernarg_segment_ptr();
    unsigned* bar = (unsigned*)((unsigned char*)k[32] + WS_CTL) + 1024 + idx * 64;
    __builtin_amdgcn_fence(__ATOMIC_RELEASE, "agent");
    __syncthreads();
    if (threadIdx.x == 0) {
        __hip_atomic_fetch_add(bar, 1u, __ATOMIC_RELEASE, __HIP_MEMORY_SCOPE_AGENT);
        while (__hip_atomic_load(bar, __ATOMIC_ACQUIRE, __HIP_MEMORY_SCOPE_AGENT) < gridDim.x) __builtin_amdgcn_s_sleep(2);
    }
    __syncthreads();
    __builtin_amdgcn_fence(__ATOMIC_ACQUIRE, "agent");
}
#ifndef PH_MASK
#define PH_MASK 0xFFFF
#endif
constexpr int SCAN_L = 16;
constexpr int NSCAN = 64 * (SCAN_L / 8);
__global__ void __launch_bounds__(512, 2) fwd_megakernel(KArgs kargs_unused) {
    extern __shared__ __attribute__((aligned(16))) unsigned char lds_raw[];
    cg::grid_group grid = cg::this_grid();
    Frame F; F.lds = (LAS unsigned char*)lds_raw; F.tid = threadIdx.x; F.lane = F.tid & 63; F.wave = __builtin_amdgcn_readfirstlane(F.tid >> 6); F.G = gridDim.x; F.bid = blockIdx.x;
    LAS int* qslot = (LAS int*)(F.lds + 131072);
#define PHASE_VARS() const Params p = make_params(); unsigned* ctl = (unsigned*)(p.ws + WS_CTL); float* rowss = (float*)(p.ws + WS_RP); \
    bf16_t* XB = (bf16_t*)(p.ws + WS_XB); bf16_t* Z = (bf16_t*)(p.ws + WS_Z); bf16_t* MIX = (bf16_t*)(p.ws + WS_MIX); \
    bf16_t* wb = (bf16_t*)(p.ws + WS_W + (size_t)(l & 1) * W_STRIDE); (void)ctl; (void)rowss; (void)XB; (void)Z; (void)MIX; (void)wb

    if (PH_MASK & 1) { const Params p = make_params(); prologue(F, p); }
    grid.sync();

    for (int l = 0; l < NL; ++l) {
        if (PH_MASK & 2) {
            PHASE_VARS();
            pg8::StaticOrder S; S.init(MTOK, INW, F.G, F.bid);
            pg8::gemm_phase(F.lds, pg8::Gemm{XB, wb + WO_IN, MTOK, INW, DM}, S, pg8::EpiScaleBf16{Z, INW, rowss + (size_t)(3 * l) * MTOK * 16});
            pg8::StaticOrder S2; S2.init(MMEM, 1024, F.G, F.bid);
            pg8::gemm_phase(F.lds, pg8::Gemm{(const bf16_t*)(p.ws + WS_MEMN), wb + WO_KV, MMEM, 1024, DM}, S2, pg8::EpiScaleBf16{(bf16_t*)(p.ws + WS_KV), 1024, nullptr});
        }
        gsync(l * 10 + 0);
        for (int u = F.bid; u < 768; u += F.G) {
            PHASE_VARS();
            if (u < 512) { if (PH_MASK & 4) prep_unit(F, p, l, wb, u); } else if (PH_MASK & 8) win_unit(F, p, l, u - 512);
        }
        gsync(l * 10 + 1);
        {
            PHASE_VARS();
            const int ncv = (l + 1 < NL) ? CV_BLOCK_UNITS : 0, ntot = NSCAN + 512 + ncv;
            bf16_t* wbn = (bf16_t*)(p.ws + WS_W + (size_t)((l + 1) & 1) * W_STRIDE);
            for (;;) {
                __syncthreads();
                if (F.tid == 0) *qslot = (int)atomicAdd(ctl + CW_Q + 16 * l, 1u);
                __syncthreads();
                const int u = *qslot;
                if (u >= ntot) break;
                if (u < NSCAN) { if (PH_MASK & 16) scan_unit<SCAN_L>(F, p, u); }
                else if (u < NSCAN + 512) { if (PH_MASK & 32) diff_unit(F, p, l, u - NSCAN); }
                else if (PH_MASK & 1) { REFRAME(F); cvt_layer_item(p, l + 1, wbn, (LAS float*)(F.lds + F.wave * 16384), (u - NSCAN - 512) * 8 + F.wave, F.lane); }
            }
        }
        gsync(l * 10 + 2);
        if (PH_MASK & 64) { PHASE_VARS(); post_phase(F, p, l); }
        gsync(l * 10 + 3);
        if (PH_MASK & 128) {
            PHASE_VARS();
            pg8::StaticOrder S; S.init(MTOK, DM, F.G, F.bid);
            pg8::gemm_phase(F.lds, pg8::Gemm{MIX, wb + WO_OUT, MTOK, DM, DM}, S, pg8::EpiResid{p.out, XB, rowss + (size_t)(3 * l + 1) * MTOK * 16});
        }
        gsync(l * 10 + 4);
        if (PH_MASK & 256) {
            PHASE_VARS();
            pg8::StaticOrder S; S.init(MTOK, XW, F.G, F.bid);
            pg8::gemm_phase(F.lds, pg8::Gemm{XB, wb + WO_Q, MTOK, XW, DM}, S, pg8::EpiScaleBf16{(bf16_t*)(p.ws + WS_Q), XW, rowss + (size_t)(3 * l + 1) * MTOK * 16});
        }
        gsync(l * 10 + 5);
        if (PH_MASK & 512) for (int u = F.bid; u < 256; u += F.G) { PHASE_VARS(); cross_unit(F, p, u); }
        gsync(l * 10 + 6);
        if (PH_MASK & 1024) {
            PHASE_VARS();
            pg8::StaticOrder S; S.init(MTOK, DM, F.G, F.bid);
            pg8::gemm_phase(F.lds, pg8::Gemm{(const bf16_t*)(p.ws + WS_O), wb + WO_O, MTOK, DM, XW}, S, pg8::EpiResid{p.out, XB, rowss + (size_t)(3 * l + 2) * MTOK * 16});
        }
        gsync(l * 10 + 7);
        if (PH_MASK & 2048) {
            PHASE_VARS();
            pg8::StaticOrder S; S.init(MTOK, 2 * DFF, F.G, F.bid);
            pg8::gemm_phase(F.lds, pg8::Gemm{XB, wb + WO_GU, MTOK, 2 * DFF, DM}, S, pg8::EpiSwiGLU{(bf16_t*)(p.ws + WS_G), rowss + (size_t)(3 * l + 2) * MTOK * 16});
        }
        gsync(l * 10 + 8);
        if (PH_MASK & 4096) {
            PHASE_VARS();
            pg8::StaticOrder S; S.init(MTOK, DM, F.G, F.bid);
            pg8::gemm_phase(F.lds, pg8::Gemm{(const bf16_t*)(p.ws + WS_G), wb + WO_DOWN, MTOK, DM, DFF}, S, pg8::EpiResid{p.out, XB, rowss + (size_t)(3 * l + 3) * MTOK * 16});
        }
        gsync(l * 10 + 9);
    }
    if (PH_MASK & 8192) { const Params p = make_params(); final_norm(F, p); }
}

extern "C" void kernel_launch(void* const* d_in, const int* in_sizes, int n_in, void* d_out, int out_size, void* d_ws, size_t ws_size, hipStream_t stream) {
    static int grid = 0;
    if (grid == 0) {
        if (n_in != 31 || out_size != MTOK * DM || ws_size < WS_END) { fprintf(stderr, "kernel_launch: unexpected problem shape (n_in %d out %d ws %zu)\n", n_in, out_size, ws_size); grid = -1; return; }
        int dev = 0, cus = 0, per_cu = 0;
        hipGetDevice(&dev);
        hipDeviceGetAttribute(&cus, hipDeviceAttributeMultiprocessorCount, dev);
        hipFuncSetAttribute((const void*)fwd_megakernel, hipFuncAttributeMaxDynamicSharedMemorySize, LDS_BYTES);
        hipOccupancyMaxActiveBlocksPerMultiprocessor(&per_cu, (const void*)fwd_megakernel, 512, LDS_BYTES);
        if (per_cu < 1) { fprintf(stderr, "kernel_launch: occupancy query returned %d\n", per_cu); per_cu = 1; }
        (void)hipGetLastError();
        grid = cus * per_cu;
    }
    if (grid < 0) return;
    hipMemsetAsync((char*)d_ws + WS_CTL, 0, CTL_ZERO_BYTES, stream);
    KArgs p{};
    for (int i = 0; i < 31; ++i) p.in[i] = (const float*)d_in[i];
    p.out = (float*)d_out; p.ws = (unsigned char*)d_ws;
    void* args[] = {&p};
    hipError_t e = hipLaunchCooperativeKernel((const void*)fwd_megakernel, dim3(grid), dim3(512), args, LDS_BYTES, stream);
    if (e != hipSuccess) fprintf(stderr, "cooperative launch failed: %s (grid %d)\n", hipGetErrorString(e), grid);
}
```

```cpp
#include <hip/hip_runtime.h>
#include <hip/hip_cooperative_groups.h>
#include <cstdio>
#include <cstdint>
namespace cg = cooperative_groups;

#define LAS __attribute__((address_space(3)))
#define GAS __attribute__((address_space(1)))
typedef unsigned short bf16_t;
typedef short bf16x8 __attribute__((ext_vector_type(8)));
typedef short s16x4 __attribute__((ext_vector_type(4)));
typedef short v4i16_t __attribute__((ext_vector_type(4)));
typedef float f32x4 __attribute__((ext_vector_type(4)));
typedef float f32x2 __attribute__((ext_vector_type(2)));
typedef float f32x16 __attribute__((ext_vector_type(16)));
typedef unsigned u32x4 __attribute__((ext_vector_type(4)));
typedef unsigned u32x2 __attribute__((ext_vector_type(2)));
typedef __bf16 bf16x2_t __attribute__((ext_vector_type(2)));

constexpr int DM = 1024, NB = 8, SEQ = 2048, NL = 4, MTOK = NB * SEQ;
constexpr int NMEM = 256, MMEM = NB * NMEM;
constexpr int INW = 3072, DFF = 2816, XW = 512;
constexpr float LOG2E = 1.4426950408889634f;

constexpr size_t MiB = 1u << 20;
constexpr size_t WS_CTL = 0, CTL_ZERO_BYTES = 1 * MiB;
constexpr size_t WS_W = 1 * MiB;
constexpr size_t WS_Z = 30 * MiB;
constexpr size_t WS_ZC = 94 * MiB;
constexpr size_t WS_XB = 126 * MiB;
constexpr size_t WS_FQR = 94 * MiB, WS_FWY = 126 * MiB, WS_FNA = 158 * MiB, WS_FKH = 174 * MiB, WS_FP15 = 190 * MiB;
constexpr size_t WS_MIX = 192 * MiB;
constexpr size_t WS_OM = 224 * MiB, WS_KA = 240 * MiB, WS_KD = 256 * MiB, WS_KK = 272 * MiB, WS_V = 280 * MiB, WS_R = 288 * MiB;
constexpr size_t WS_GATE = 296 * MiB, WS_Y = 304 * MiB, WS_BON = 320 * MiB, WS_KV = 321 * MiB, WS_MEMN = 325 * MiB;
constexpr size_t WS_RP = 329 * MiB;
constexpr size_t WS_END = 342 * MiB;
constexpr size_t WS_Q = WS_Z, WS_O = WS_Z + 16 * MiB, WS_G = WS_Z;
constexpr int ZP = 1024;
constexpr size_t WS_KD2 = WS_Z + 32 * MiB, WS_VD2 = WS_Z + 48 * MiB;
constexpr size_t WO_IN = 0, WO_OUT = 3145728, WO_Q = 4194304, WO_KV = 4718592, WO_O = 5767168, WO_GU = 6291456, WO_DOWN = 12058624;
constexpr size_t WO_WUP = 14942208, WO_AUP = 14974976, WO_GUP = 15007744;
constexpr int CW_Q = 64;

constexpr int LDS_BYTES = 135168;

__device__ __forceinline__ float bf2f(unsigned b) { return __uint_as_float(b << 16); }
__device__ __forceinline__ unsigned pk2(float lo, float hi) { f32x2 v = {lo, hi}; bf16x2_t b = __builtin_convertvector(v, bf16x2_t); return __builtin_bit_cast(unsigned, b); }
__device__ __forceinline__ float bflo(unsigned u) { return __uint_as_float(u << 16); }
__device__ __forceinline__ float bfhi(unsigned u) { return __uint_as_float(u & 0xffff0000u); }
__device__ __forceinline__ float wave_sum(float v) {
#pragma unroll
    for (int o = 1; o < 64; o <<= 1) v += __shfl_xor(v, o);
    return v;
}
__device__ __forceinline__ float xhalf(float v) {
    return __shfl_xor(v, 32);
}
__device__ __forceinline__ float row_rstd(const float* rp, int row) {
    const f32x4* q = (const f32x4*)(rp + (size_t)row * 16); const f32x4 a = q[0], b = q[1], c = q[2], d = q[3];
    const float s = (((a[0] + a[1]) + (a[2] + a[3])) + ((b[0] + b[1]) + (b[2] + b[3]))) + (((c[0] + c[1]) + (c[2] + c[3])) + ((d[0] + d[1]) + (d[2] + d[3])));
    return rsqrtf(s * (1.f / 1024.f) + 1e-6f);
}
__device__ __forceinline__ float sigmoidf_(float x) { return 1.f / (1.f + __expf(-x)); }

__device__ __forceinline__ int hw_lane() { int l = (int)__builtin_amdgcn_mbcnt_hi(~0u, __builtin_amdgcn_mbcnt_lo(~0u, 0u)); asm volatile("" : "+v"(l)); return l; }
namespace pg8 {
constexpr int BM = 256, BK = 64, HALF = 128, HTB = HALF * BK * 2, NXCD = 8, WGM = 8;
__host__ __device__ __forceinline__ int lds_byte(int r, int c) { const int st = (r >> 4) * 2 + (c >> 5), rr = r & 15, cc = c & 31, ob = rr * 64 + cc * 2; return st * 1024 + (ob ^ (((ob >> 9) & 1) << 5)); }
__host__ __device__ __forceinline__ void stage_rc(int b, int& R, int& C) { const int st = b / 1024, sb = b % 1024, swz = sb ^ (((sb >> 9) & 1) << 5); R = (st >> 1) * 16 + swz / 64; C = (st & 1) * 32 + (swz % 64) / 2; }
__host__ __device__ __forceinline__ int perm32(int rho) { const int n = rho >> 4, i = rho & 15; return 8 * (i >> 2) + 4 * n + (i & 3); }
struct Unit { int pm, pn; };
struct Gemm { const bf16_t* A; const bf16_t* Bt; int M, N, K; };
struct StaticOrder {
    int nM, nN, nwg, G, c;
    __device__ void init(int M, int N, int G_, int c_) { nM = M / BM; nN = N / BM; nwg = nM * nN; G = G_; c = c_; }
    __device__ bool next(int i, Unit& u) const {
        const long L = (long)i * G + c; if (L >= nwg) return false;
        int wgid = (int)L; { const int q = nwg / NXCD, r = nwg % NXCD, xcd = wgid % NXCD, off = wgid / NXCD; wgid = (xcd < r ? xcd * (q + 1) : r * (q + 1) + (xcd - r) * q) + off; }
        const int nig = WGM * nN, gid = wgid / nig, fm = gid * WGM, gsz = (nM - fm) < WGM ? (nM - fm) : WGM;
        u.pm = fm + ((wgid % nig) % gsz); u.pn = (wgid % nig) / gsz; return true;
    }
};
template <class Epi>
__device__ __forceinline__ void gemm_phase(LAS unsigned char* lds, const Gemm g, const StaticOrder& S, const Epi& E) {
    int tid_ = threadIdx.x; asm volatile("" : "+v"(tid_));
    const int tid = tid_, wid = __builtin_amdgcn_readfirstlane(tid >> 6), lane = tid & 63, wr = wid >> 2, wc = wid & 3, fr = lane & 15, fq = lane >> 4;
    const int K = g.K, nt = K / BK;
    unsigned voffA[2], voffB[2];
#pragma unroll
    for (int i = 0; i < 2; ++i) { int R, C; stage_rc(tid * 16 + i * 8192, R, C); const int Rb = (R & ~31) + perm32(R & 31);
        voffA[i] = (unsigned)(R * K + C) * 2u; voffB[i] = (unsigned)(Rb * K + C) * 2u; }
    const size_t kstep = (size_t)(BK * 2);
    const size_t hstep = (size_t)HALF * K * 2;
    const size_t tstep = 2 * hstep;
    const unsigned ldsw = (unsigned)wid * 1024u;
    const int aoff = lds_byte(wr * 64 + fr, fq * 8), boff = lds_byte(wc * 32 + fr, fq * 8);
#define PG8_SA(b, h) (((b) * 2 + (h)) * HTB)
#define PG8_SB(b, h) ((4 + (b) * 2 + (h)) * HTB)
#define PG8_STAGE(bufoff, gbase, voff) do { _Pragma("unroll") for (int _i = 0; _i < 2; ++_i) \
        __builtin_amdgcn_global_load_lds((const unsigned*)((const char*)(gbase) + (voff)[_i]), (LAS unsigned*)(lds + (bufoff) + ldsw + _i * 8192), 16, 0, 0); } while (0)
#define PG8_LDA(dst, b, h) do { _Pragma("unroll") for (int m = 0; m < 4; ++m) _Pragma("unroll") for (int k = 0; k < 2; ++k) dst[m][k] = *(const LAS bf16x8*)(lds + PG8_SA(b, h) + aoff + m * 2048 + k * 1024); } while (0)
#define PG8_LDB(dst, b, h) do { _Pragma("unroll") for (int n = 0; n < 2; ++n) _Pragma("unroll") for (int k = 0; k < 2; ++k) dst[n][k] = *(const LAS bf16x8*)(lds + PG8_SB(b, h) + boff + n * 2048 + k * 1024); } while (0)
#define PG8_MMA(ai, bj, At, Bt) do { __builtin_amdgcn_s_setprio(1); _Pragma("unroll") for (int m = 0; m < 4; ++m) _Pragma("unroll") for (int n = 0; n < 2; ++n) _Pragma("unroll") for (int k = 0; k < 2; ++k) \
        acc[ai][bj][m][n] = __builtin_amdgcn_mfma_f32_16x16x32_bf16(Bt[n][k], At[m][k], acc[ai][bj][m][n], 0, 0, 0); __builtin_amdgcn_s_setprio(0); } while (0)
#define PG8_WAIT_V(n) asm volatile("s_waitcnt vmcnt(" #n ")" ::: "memory")
#define PG8_WAIT_L(n) asm volatile("s_waitcnt lgkmcnt(" #n ")" ::: "memory")
#define PG8_BAR __builtin_amdgcn_s_barrier()
#define PG8_SCHED __builtin_amdgcn_sched_barrier(0)
    Unit cur, nxt; int ui = 0;
    if (!S.next(0, cur)) return;
    f32x4 acc[2][2][4][2];
#pragma unroll
    for (int a = 0; a < 2; ++a)
#pragma unroll
        for (int b = 0; b < 2; ++b)
#pragma unroll
            for (int m = 0; m < 4; ++m)
#pragma unroll
                for (int n = 0; n < 2; ++n) acc[a][b][m][n] = (f32x4){0.f, 0.f, 0.f, 0.f};
    bf16x8 At[4][2], B0[2][2], B1[2][2];
    const char* cA = (const char*)g.A + (size_t)cur.pm * tstep; const char* cB = (const char*)g.Bt + (size_t)cur.pn * tstep;
    {
        PG8_STAGE(PG8_SB(0, 0), cB, voffB); PG8_STAGE(PG8_SB(0, 1), cB + hstep, voffB); PG8_STAGE(PG8_SA(0, 0), cA, voffA); PG8_STAGE(PG8_SA(0, 1), cA + hstep, voffA);
        if (wr == 1) PG8_BAR;
        PG8_WAIT_V(2); PG8_BAR;
        PG8_STAGE(PG8_SB(1, 0), cB + kstep, voffB); PG8_STAGE(PG8_SA(1, 0), cA + kstep, voffA); PG8_STAGE(PG8_SB(1, 1), cB + hstep + kstep, voffB);
        PG8_WAIT_V(6); PG8_BAR;
    }
    for (;;) {
        const bool has_next = S.next(ui + 1, nxt);
        const char* nA = has_next ? (const char*)g.A + (size_t)nxt.pm * tstep : cA; const char* nB = has_next ? (const char*)g.Bt + (size_t)nxt.pn * tstep : cB;
        for (int t = 0; t < nt; t += 2) {
            const bool last = (t == nt - 2);
            const char* a1 = cA + (size_t)(t + 1) * kstep;
            const char* a2 = last ? nA : cA + (size_t)(t + 2) * kstep; const char* b2 = last ? nB : cB + (size_t)(t + 2) * kstep;
            const char* a3 = a2 + kstep; const char* b3 = b2 + kstep;
            PG8_LDB(B0, 0, 0); PG8_LDB(B1, 0, 1); PG8_SCHED; PG8_LDA(At, 0, 0); PG8_STAGE(PG8_SA(1, 1), a1 + hstep, voffA);
            PG8_WAIT_V(8); PG8_WAIT_L(0); PG8_BAR; PG8_MMA(0, 0, At, B0); PG8_MMA(0, 1, At, B1); PG8_BAR; PG8_SCHED;
            PG8_LDA(At, 0, 1); PG8_STAGE(PG8_SB(0, 0), b2, voffB); PG8_STAGE(PG8_SB(0, 1), b2 + hstep, voffB); PG8_STAGE(PG8_SA(0, 0), a2, voffA);
            PG8_WAIT_V(8); PG8_WAIT_L(0); PG8_BAR; PG8_MMA(1, 0, At, B0); PG8_MMA(1, 1, At, B1); PG8_BAR; PG8_SCHED;
            PG8_LDB(B0, 1, 0); PG8_LDB(B1, 1, 1); PG8_SCHED; PG8_LDA(At, 1, 0); PG8_STAGE(PG8_SA(0, 1), a2 + hstep, voffA);
            PG8_WAIT_V(8); PG8_WAIT_L(0); PG8_BAR; PG8_MMA(0, 0, At, B0); PG8_MMA(0, 1, At, B1); PG8_BAR; PG8_SCHED;
            PG8_LDA(At, 1, 1); PG8_STAGE(PG8_SB(1, 0), b3, voffB); PG8_STAGE(PG8_SB(1, 1), b3 + hstep, voffB); PG8_STAGE(PG8_SA(1, 0), a3, voffA);
            PG8_WAIT_V(8); PG8_WAIT_L(0); PG8_BAR; PG8_MMA(1, 0, At, B0); PG8_MMA(1, 1, At, B1); PG8_BAR; PG8_SCHED;
        }
        if (wr == 0) PG8_BAR;
        E(acc, cur, wr, wc, fr, fq);
        if (!has_next) break;
#pragma unroll
        for (int a = 0; a < 2; ++a)
#pragma unroll
            for (int b = 0; b < 2; ++b)
#pragma unroll
                for (int m = 0; m < 4; ++m)
#pragma unroll
                    for (int n = 0; n < 2; ++n) acc[a][b][m][n] = (f32x4){0.f, 0.f, 0.f, 0.f};
        cur = nxt; cA = nA; cB = nB; ++ui;
        if (wr == 1) PG8_BAR;
    }
    PG8_WAIT_V(0);
    PG8_BAR;
#undef PG8_SA
#undef PG8_SB
#undef PG8_STAGE
#undef PG8_LDA
#undef PG8_LDB
#undef PG8_MMA
#undef PG8_WAIT_V
#undef PG8_WAIT_L
#undef PG8_BAR
#undef PG8_SCHED
}

struct EpiScaleBf16 {
    bf16_t* O; int ldc; const float* rowss; bf16_t* O2; int ldc2; int split_tile; bf16_t* KD2;
    __device__ __forceinline__ void operator()(const f32x4 (&acc)[2][2][4][2], const Unit& u, int wr, int wc, int fr, int fq) const {
        const bool hi = u.pn >= split_tile, mid = (split_tile == 8) && u.pn >= 4 && u.pn < 8;
        const int row0 = u.pm * BM + wr * 64 + fr, col0 = (hi ? u.pn - split_tile : u.pn) * BM + wc * 32 + 8 * fq;
        bf16_t* const Ob = hi ? O2 : O; const int ld = hi ? ldc2 : ldc;
#pragma unroll
        for (int ai = 0; ai < 2; ++ai)
#pragma unroll
            for (int m = 0; m < 4; ++m) { const int row = row0 + ai * HALF + m * 16;
                const float sc = rowss ? row_rstd(rowss, row) : 1.f;
                bf16_t* rowp = Ob + (size_t)row * ld + col0;
#pragma unroll
                for (int bj = 0; bj < 2; ++bj) { const f32x4 v0 = acc[ai][bj][m][0] * sc, v1 = acc[ai][bj][m][1] * sc;
                    u32x4 w; w.x = pk2(v0[0], v0[1]); w.y = pk2(v0[2], v0[3]); w.z = pk2(v1[0], v1[1]); w.w = pk2(v1[2], v1[3]);
                    bf16_t* dst = rowp + bj * HALF;
                    if (mid) dst = KD2 + (u.pn >= 6 ? (size_t)8388608 : (size_t)0) + ((size_t)(((row >> 11) * 4 + 2 * (u.pn & 1) + bj) * 2048 + (row & 2047))) * 128 + wc * 32 + 8 * fq;
                    *(u32x4*)dst = w; } }
    }
};
struct EpiSwiGLU {
    bf16_t* O; const float* rowss;
    __device__ __forceinline__ void operator()(const f32x4 (&acc)[2][2][4][2], const Unit& u, int wr, int wc, int fr, int fq) const {
        const int row0 = u.pm * BM + wr * 64 + fr, col0 = u.pn * HALF + wc * 32 + 8 * fq;
#pragma unroll
        for (int ai = 0; ai < 2; ++ai)
#pragma unroll
            for (int m = 0; m < 4; ++m) { const int row = row0 + ai * HALF + m * 16;
                const float sc = row_rstd(rowss, row);
                float h[8];
#pragma unroll
                for (int n = 0; n < 2; ++n)
#pragma unroll
                    for (int j = 0; j < 4; ++j) { const float gt = acc[ai][0][m][n][j] * sc, up = acc[ai][1][m][n][j] * sc; h[n * 4 + j] = gt / (1.f + __expf(-gt)) * up; }
                u32x4 w; w.x = pk2(h[0], h[1]); w.y = pk2(h[2], h[3]); w.z = pk2(h[4], h[5]); w.w = pk2(h[6], h[7]);
                *(u32x4*)(O + (size_t)row * DFF + col0) = w; }
    }
};
struct EpiResid {
    float* X; bf16_t* XB; float* rowss_next;
    __device__ __forceinline__ void operator()(const f32x4 (&acc)[2][2][4][2], const Unit& u, int wr, int wc, int fr, int fq) const {
        const int row0 = u.pm * BM + wr * 64 + fr, col0 = u.pn * BM + wc * 32 + 8 * fq;
#pragma unroll
        for (int ai = 0; ai < 2; ++ai)
#pragma unroll
            for (int m = 0; m < 4; ++m) { const int row = row0 + ai * HALF + m * 16; float ss = 0.f;
                float* xp = X + (size_t)row * DM + col0; bf16_t* bp = XB + (size_t)row * DM + col0;
#pragma unroll
                for (int bj = 0; bj < 2; ++bj) {
                    f32x4 x0 = *(f32x4*)(xp + bj * HALF), x1 = *(f32x4*)(xp + bj * HALF + 4);
                    x0 = x0 + acc[ai][bj][m][0]; x1 = x1 + acc[ai][bj][m][1];
                    *(f32x4*)(xp + bj * HALF) = x0; *(f32x4*)(xp + bj * HALF + 4) = x1;
                    ss += (x0[0] * x0[0] + x0[1] * x0[1]) + (x0[2] * x0[2] + x0[3] * x0[3]) + (x1[0] * x1[0] + x1[1] * x1[1]) + (x1[2] * x1[2] + x1[3] * x1[3]);
                    u32x4 w; w.x = pk2(x0[0], x0[1]); w.y = pk2(x0[2], x0[3]); w.z = pk2(x1[0], x1[1]); w.w = pk2(x1[2], x1[3]);
                    *(u32x4*)(bp + bj * HALF) = w; }
                ss += __shfl_xor(ss, 16); ss += __shfl_xor(ss, 32);
                if (fq == 0) rowss_next[(size_t)row * 16 + u.pn * 4 + wc] = ss; }
    }
};
}

struct KArgs { const float* in[31]; float* out; unsigned char* ws; };
#define CAS __attribute__((address_space(4)))
struct InProxy { const CAS unsigned long long* k; __device__ __forceinline__ const float* operator[](int i) const { return (const float*)k[i]; } };
struct Params { InProxy in; float* out; unsigned char* ws; };
__device__ __forceinline__ Params make_params() {
    unsigned long long kv = (unsigned long long)__builtin_amdgcn_kernarg_segment_ptr();
    asm volatile("" : "+s"(kv));
    const CAS unsigned long long* k = (const CAS unsigned long long*)kv;
    Params p; p.in.k = k; p.out = (float*)k[31]; p.ws = (unsigned char*)k[32]; return p;
}

struct Frame {
    LAS unsigned char* lds;
    int tid, lane, wave, G, bid;
};

#define REFRAME(F) do { int _t = threadIdx.x; asm volatile("" : "+v"(_t)); (F).tid = _t; (F).lane = _t & 63; (F).wave = __builtin_amdgcn_readfirstlane(_t >> 6); } while (0)
__device__ __forceinline__ void cvt_item(const float* W_, int K, int ldn, int nblk, bf16_t* WT_, const float* gain_, bool perm_gu, LAS float* scr, int item, int lane) {
    const GAS float* W = (const GAS float*)W_; const GAS float* gain = (const GAS float*)gain_; GAS bf16_t* WT = (GAS bf16_t*)WT_;
    const int kb = item / nblk, nb = item % nblk, k0 = 64 * kb, n0d = 32 * nb;
    const int n0s = perm_gu ? (((n0d & 255) >> 7) * DFF + (n0d >> 8) * 128 + (n0d & 127)) : n0d;
    float v[32];
#pragma unroll
    for (int i = 0; i < 32; ++i) v[i] = W[(size_t)(k0 + 2 * i + (lane >> 5)) * ldn + n0s + (lane & 31)];
    if (gain_) {
#pragma unroll
        for (int i = 0; i < 32; ++i) v[i] *= gain[k0 + 2 * i + (lane >> 5)];
    }
#pragma unroll
    for (int i = 0; i < 32; ++i) scr[(2 * i + (lane >> 5)) * 33 + (lane & 31)] = v[i];
    asm volatile("s_waitcnt lgkmcnt(0)" ::: "memory");
    const int c = lane & 7;
#pragma unroll
    for (int j = 0; j < 4; ++j) { const int n = (lane >> 3) + 8 * j; const LAS float* sp = scr + (8 * c) * 33 + n;
        u32x4 o; o.x = pk2(sp[0 * 33], sp[1 * 33]); o.y = pk2(sp[2 * 33], sp[3 * 33]); o.z = pk2(sp[4 * 33], sp[5 * 33]); o.w = pk2(sp[6 * 33], sp[7 * 33]);
        *(GAS u32x4*)(WT + (size_t)(n0d + n) * K + k0 + 8 * c) = o; }
    asm volatile("s_waitcnt lgkmcnt(0)" ::: "memory");
}
constexpr int CV_IN = 1536, CV_OUT = 512, CV_Q = 256, CV_KV = 512, CV_O = 256, CV_GU = 2816, CV_DOWN = 1408, CV_L = 8;
constexpr int CV_TOTAL = CV_IN + CV_OUT + CV_Q + CV_KV + CV_O + CV_GU + CV_DOWN + 2 * CV_L + 2 * CV_L + 16;

static_assert(CV_TOTAL % 8 == 0, "conversion items per layer");
constexpr int CV_A = CV_IN + 2 * CV_L + 2 * CV_L + 16, CV_B = CV_KV + CV_OUT + CV_Q + CV_O + CV_GU + CV_DOWN;
static_assert(CV_A % 8 == 0 && CV_B % 8 == 0 && CV_A + CV_B == CV_TOTAL, "conversion lists");
__device__ __forceinline__ void cvt_item_a(const Params& p, int l, bf16_t* wb, LAS float* scr, int it, int lane) {
    int r = it;
    if (r < CV_IN) { cvt_item(p.in[3] + (size_t)l * DM * INW, DM, INW, INW / 32, wb + WO_IN, p.in[2] + l * DM, false, scr, r, lane); return; } r -= CV_IN;
    if (r < 2 * CV_L) { const int d = r / CV_L; cvt_item(p.in[12] + ((size_t)l * 2 + d) * 64 * 256, 64, 256, 8, wb + WO_WUP + d * 256 * 64, nullptr, false, scr, r % CV_L, lane); return; } r -= 2 * CV_L;
    if (r < 2 * CV_L) { const int d = r / CV_L; cvt_item(p.in[14] + ((size_t)l * 2 + d) * 64 * 256, 64, 256, 8, wb + WO_AUP + d * 256 * 64, nullptr, false, scr, r % CV_L, lane); return; } r -= 2 * CV_L;
    cvt_item(p.in[15] + (size_t)l * 128 * 256, 128, 256, 8, wb + WO_GUP, nullptr, false, scr, r, lane);
}
__device__ __forceinline__ void cvt_item_b(const Params& p, int l, bf16_t* wb, LAS float* scr, int it, int lane) {
    int r = it;
    if (r < CV_KV) { cvt_item(p.in[25] + (size_t)l * DM * 1024, DM, 1024, 32, wb + WO_KV, nullptr, false, scr, r, lane); return; } r -= CV_KV;
    if (r < CV_OUT) { cvt_item(p.in[21] + (size_t)l * DM * DM, DM, DM, DM / 32, wb + WO_OUT, nullptr, false, scr, r, lane); return; } r -= CV_OUT;
    if (r < CV_Q) { cvt_item(p.in[24] + (size_t)l * DM * XW, DM, XW, XW / 32, wb + WO_Q, p.in[22] + l * DM, false, scr, r, lane); return; } r -= CV_Q;
    if (r < CV_O) { cvt_item(p.in[26] + (size_t)l * XW * DM, XW, DM, 32, wb + WO_O, nullptr, false, scr, r, lane); return; } r -= CV_O;
    if (r < CV_GU) { cvt_item(p.in[28] + (size_t)l * DM * 2 * DFF, DM, 2 * DFF, 2 * DFF / 32, wb + WO_GU, p.in[27] + l * DM, true, scr, r, lane); return; } r -= CV_GU;
    cvt_item(p.in[29] + (size_t)l * DFF * DM, DFF, DM, 32, wb + WO_DOWN, nullptr, false, scr, r, lane);
}

__device__ __forceinline__ s16x4 vtr(const LAS unsigned char* p) { return __builtin_bit_cast(s16x4, __builtin_amdgcn_ds_read_tr16_b64_v4i16((LAS v4i16_t*)p)); }
__device__ __forceinline__ int crow(int r, int hi) { return (r & 3) + 8 * (r >> 2) + 4 * hi; }

template <int W> __device__ __forceinline__ void tile_load(u32x4 (&r)[W / 64], const bf16_t* g, int pitch, int tid) {
#pragma unroll
    for (int i = 0; i < W / 64; ++i) { const int id = tid + i * 512, row = id / (W / 8), ch = id % (W / 8); r[i] = *(const GAS u32x4*)((const GAS bf16_t*)g + (size_t)row * pitch + ch * 8); }
}
template <int W, int STR> __device__ __forceinline__ void tile_store(const u32x4 (&r)[W / 64], LAS unsigned char* buf, int tid) {
#pragma unroll
    for (int i = 0; i < W / 64; ++i) { const int id = tid + i * 512, row = id / (W / 8), ch = id % (W / 8); *(LAS u32x4*)(buf + row * STR + ch * 16) = r[i]; }
}
template <int DQK> __device__ __forceinline__ void load_q(bf16x8 (&qf)[DQK / 16], const bf16_t* qrow, int h, float sc) {
#pragma unroll
    for (int ks = 0; ks < DQK / 16; ++ks) { const u32x4 v = *(const GAS u32x4*)((const GAS bf16_t*)qrow + 16 * ks + 8 * h);
        u32x4 o; o.x = pk2(bflo(v.x) * sc, bfhi(v.x) * sc); o.y = pk2(bflo(v.y) * sc, bfhi(v.y) * sc); o.z = pk2(bflo(v.z) * sc, bfhi(v.z) * sc); o.w = pk2(bflo(v.w) * sc, bfhi(v.w) * sc);
        qf[ks] = __builtin_bit_cast(bf16x8, o); }
}
template <int DQK, int KW, int DV, int MODE>
__device__ __forceinline__ void attn_loop(LAS unsigned char* lds, const bf16_t* Kg, int kpitch, const bf16_t* Vg, int vpitch, int ntiles,
                                          const bf16x8 (&qf)[DQK / 16], int koff, float nslope2, int qrel, float& m, float& lsum, f32x16 (&o)[DV / 32]) {
    constexpr int KSTR = (KW + 8) * 2, VSTR = DV * 2 + 64, KBUF = 64 * KSTR, VBUF = 64 * VSTR;
    int tid_ = threadIdx.x; asm volatile("" : "+v"(tid_));
    const int tid = tid_, lane = tid & 63, r = lane & 31, h = lane >> 5;
    LAS unsigned char* K0 = lds; LAS unsigned char* V0 = lds + 2 * KBUF;
    u32x4 kr[KW / 64], vr[DV / 64];
    tile_load<KW>(kr, Kg, kpitch, tid); tile_load<DV>(vr, Vg, vpitch, tid);
    tile_store<KW, KSTR>(kr, K0, tid); tile_store<DV, VSTR>(vr, V0, tid);
    __syncthreads();
    const int vlane = ((lane & 15) >> 2) * VSTR + (16 * ((lane >> 4) & 1) + 4 * (lane & 3)) * 2 + 4 * h * VSTR;
    for (int t = 0; t < ntiles; ++t) {
        const int cur = t & 1;
        if (t + 1 < ntiles) { tile_load<KW>(kr, Kg + (size_t)(t + 1) * 64 * kpitch, kpitch, tid); tile_load<DV>(vr, Vg + (size_t)(t + 1) * 64 * vpitch, vpitch, tid); }
        const LAS unsigned char* Kb = K0 + cur * KBUF + r * KSTR + (koff + 8 * h) * 2;
        const LAS unsigned char* Vb = V0 + cur * VBUF + vlane;
        f32x16 s0, s1;
#pragma unroll
        for (int i = 0; i < 16; ++i) { s0[i] = 0.f; s1[i] = 0.f; }
#pragma unroll
        for (int ks = 0; ks < DQK / 16; ++ks) {
            const bf16x8 k0 = *(const LAS bf16x8*)(Kb + ks * 32), k1 = *(const LAS bf16x8*)(Kb + 32 * KSTR + ks * 32);
            s0 = __builtin_amdgcn_mfma_f32_32x32x16_bf16(k0, qf[ks], s0, 0, 0, 0);
            s1 = __builtin_amdgcn_mfma_f32_32x32x16_bf16(k1, qf[ks], s1, 0, 0, 0);
        }
        float Aoff = 0.f;
        if (MODE >= 1) {
            const int qrel0 = __builtin_amdgcn_readfirstlane(qrel - r);
            const int T0 = t * 64;
            if (MODE == 1 && (T0 + 64 <= qrel0 || T0 > qrel0 + 31)) {
                const bool left = (T0 + 64 <= qrel0);
                const float sl = left ? -nslope2 : nslope2;
                Aoff = left ? nslope2 * (float)(qrel - T0 - 4 * h) : nslope2 * (float)(T0 + 4 * h - qrel);
#pragma unroll
                for (int i = 0; i < 16; ++i) { s0[i] = __builtin_fmaf(sl, (float)((i & 3) + 8 * (i >> 2)), s0[i]); s1[i] = __builtin_fmaf(sl, (float)(32 + (i & 3) + 8 * (i >> 2)), s1[i]); }
            } else {
                const float base = (float)(T0 + 4 * h - qrel);
#pragma unroll
                for (int i = 0; i < 16; ++i) {
                    const float d0 = fabsf(base + (float)((i & 3) + 8 * (i >> 2))), d1 = fabsf(base + (float)(32 + (i & 3) + 8 * (i >> 2)));
                    s0[i] = __builtin_fmaf(d0, nslope2, s0[i]); s1[i] = __builtin_fmaf(d1, nslope2, s1[i]);
                    if (MODE == 2) { if (d0 > 128.f) s0[i] = -1e30f; if (d1 > 128.f) s1[i] = -1e30f; }
                }
            }
        }
        float mx = fmaxf(s0[0], s1[0]);
#pragma unroll
        for (int i = 1; i < 16; ++i) mx = fmaxf(fmaxf(mx, s0[i]), s1[i]);
        mx += Aoff;
        mx = fmaxf(mx, xhalf(mx));
        const float mnew = fmaxf(m, mx);
        if (__builtin_amdgcn_ballot_w64(mnew > m) != 0ull) {
            const float alpha = __builtin_amdgcn_exp2f(m - mnew);
            lsum *= alpha;
#pragma unroll
            for (int d = 0; d < DV / 32; ++d) o[d] = o[d] * alpha;
        }
        m = mnew;
        const float mm = mnew - Aoff;
        float rs = 0.f;
#pragma unroll
        for (int i = 0; i < 16; ++i) { s0[i] = __builtin_amdgcn_exp2f(s0[i] - mm); s1[i] = __builtin_amdgcn_exp2f(s1[i] - mm); rs += s0[i] + s1[i]; }
        lsum += rs;
        bf16x8 pf[4];
#pragma unroll
        for (int s2 = 0; s2 < 2; ++s2) {
            u32x4 a, b;
            a.x = pk2(s0[8 * s2 + 0], s0[8 * s2 + 1]); a.y = pk2(s0[8 * s2 + 2], s0[8 * s2 + 3]); a.z = pk2(s0[8 * s2 + 4], s0[8 * s2 + 5]); a.w = pk2(s0[8 * s2 + 6], s0[8 * s2 + 7]);
            b.x = pk2(s1[8 * s2 + 0], s1[8 * s2 + 1]); b.y = pk2(s1[8 * s2 + 2], s1[8 * s2 + 3]); b.z = pk2(s1[8 * s2 + 4], s1[8 * s2 + 5]); b.w = pk2(s1[8 * s2 + 6], s1[8 * s2 + 7]);
            pf[s2] = __builtin_bit_cast(bf16x8, a); pf[2 + s2] = __builtin_bit_cast(bf16x8, b);
        }
#pragma unroll
        for (int d = 0; d < DV / 32; ++d) {
#pragma unroll
            for (int kk = 0; kk < 4; ++kk) {
                const s16x4 lo = vtr(Vb + (16 * kk) * VSTR + d * 64), hi = vtr(Vb + (16 * kk + 8) * VSTR + d * 64);
                const bf16x8 vf = {lo[0], lo[1], lo[2], lo[3], hi[0], hi[1], hi[2], hi[3]};
                o[d] = __builtin_amdgcn_mfma_f32_32x32x16_bf16(vf, pf[kk], o[d], 0, 0, 0);
            }
        }
        if (t + 1 < ntiles) { tile_store<KW, KSTR>(kr, K0 + (cur ^ 1) * KBUF, tid); tile_store<DV, VSTR>(vr, V0 + (cur ^ 1) * VBUF, tid); }
        __syncthreads();
    }
}
__device__ __forceinline__ int swz(int row) { return ((row & 3) << 2) | ((row >> 2) & 3); }
template <int DQK, int MODE, int pitch, int voff>
__device__ __forceinline__ void attn_loop_dma(LAS unsigned char* lds, const int wave, const bf16_t* Kg, int ntiles,
                                              const bf16x8 (&qf)[DQK / 16], int koff, float nslope2, int qrel, float& m, float& lsum, f32x16 (&o)[4]) {
    constexpr int DV = 128, STAGE = 32768, VOFFB = 16384;
    const int lane = hw_lane(), r = lane & 31, h = lane >> 5;
    unsigned gk[2];
#pragma unroll
    for (int i = 0; i < 2; ++i) { const int row = 4 * (2 * wave + i) + (lane >> 4), c = (lane & 15) ^ swz(row); gk[i] = (unsigned)(row * pitch + c * 8); }
    unsigned kad[DQK / 16], vad[4][2];
#pragma unroll
    for (int ks = 0; ks < DQK / 16; ++ks) kad[ks] = (unsigned)(r * 256 + 16 * (((koff >> 3) + 2 * ks + h) ^ swz(r)));
    { const int q_ = (lane & 15) >> 2, pp = lane & 3, g1 = (lane >> 4) & 1;
#pragma unroll
      for (int d = 0; d < 4; ++d)
#pragma unroll
          for (int hi = 0; hi < 2; ++hi) { const int f = (q_ << 2) | ((2 * hi + h) & 3), c = (4 * d + 2 * g1 + (pp >> 1)) ^ f;
              vad[d][hi] = (unsigned)(VOFFB + (4 * h + q_) * 256 + 16 * c + 8 * (pp & 1) + hi * 2048); } }
#define ATT_DMA(tt, st) do { const bf16_t* kg_ = Kg + (size_t)(tt) * 64 * pitch; _Pragma("unroll") for (int i_ = 0; i_ < 2; ++i_) { \
        __builtin_amdgcn_global_load_lds((const unsigned*)(kg_ + gk[i_]), (LAS unsigned*)(lds + (st) * STAGE + (2 * wave + i_) * 1024), 16, 0, 0); \
        __builtin_amdgcn_global_load_lds((const unsigned*)(kg_ + voff + gk[i_]), (LAS unsigned*)(lds + (st) * STAGE + VOFFB + (2 * wave + i_) * 1024), 16, 0, 0); } } while (0)
    ATT_DMA(0, 0);
    if (ntiles > 1) ATT_DMA(1, 1);
    if (ntiles > 2) { ATT_DMA(2, 2); asm volatile("s_waitcnt vmcnt(4)" ::: "memory"); } else asm volatile("s_waitcnt vmcnt(0)" ::: "memory");
    __builtin_amdgcn_s_barrier();
    f32x16 s0, s1;
#pragma unroll
    for (int i = 0; i < 16; ++i) { s0[i] = 0.f; s1[i] = 0.f; }
#pragma unroll
    for (int ks = 0; ks < DQK / 16; ++ks) {
        const bf16x8 k0 = *(const LAS bf16x8*)(lds + kad[ks]), k1 = *(const LAS bf16x8*)(lds + kad[ks] + 8192);
        s0 = __builtin_amdgcn_mfma_f32_32x32x16_bf16(k0, qf[ks], s0, 0, 0, 0);
        s1 = __builtin_amdgcn_mfma_f32_32x32x16_bf16(k1, qf[ks], s1, 0, 0, 0);
    }
#define LDS_RD128(dst, addr, off) asm volatile("ds_read_b128 %0, %1 offset:%c2" : "=&v"(dst) : "v"(addr), "i"(off) : "memory")
#define LDS_RDTR(dst, addr, off) asm volatile("ds_read_b64_tr_b16 %0, %1 offset:%c2" : "=&v"(dst) : "v"(addr), "i"(off) : "memory")
#define LDS_WAIT0() do { asm volatile("s_waitcnt lgkmcnt(0)" ::: "memory"); __builtin_amdgcn_sched_barrier(0); } while (0)
    for (int t = 0; t < ntiles; ++t) {
        if (t + 3 < ntiles) ATT_DMA(t + 3, (t + 3) & 3);
        const unsigned sba = (unsigned)(size_t)(lds + (t & 3) * STAGE), sna = (unsigned)(size_t)(lds + ((t + 1) & 3) * STAGE);
        constexpr int KH = (DQK == 64) ? 4 : 4;
        bf16x8 kf0[KH], kf1[KH];
        s16x4 va_lo[4], va_hi[4], vb_lo[4], vb_hi[4];
        if (DQK == 64) {
#pragma unroll
            for (int ks = 0; ks < KH; ++ks) { const unsigned ka = sna + kad[ks]; LDS_RD128(kf0[ks], ka, 0); } }
        __builtin_amdgcn_sched_barrier(0);
        float Aoff = 0.f;
        if (MODE >= 1) {
            const int qrel0 = __builtin_amdgcn_readfirstlane(qrel - r);
            const int T0 = t * 64;
            if (MODE == 1 && (T0 + 64 <= qrel0 || T0 > qrel0 + 31)) {
                const bool left = (T0 + 64 <= qrel0);
                const float sl = left ? -nslope2 : nslope2;
                Aoff = left ? nslope2 * (float)(qrel - T0 - 4 * h) : nslope2 * (float)(T0 + 4 * h - qrel);
#pragma unroll
                for (int i = 0; i < 16; ++i) { s0[i] = __builtin_fmaf(sl, (float)((i & 3) + 8 * (i >> 2)), s0[i]); s1[i] = __builtin_fmaf(sl, (float)(32 + (i & 3) + 8 * (i >> 2)), s1[i]); }
            } else {
                const float base = (float)(T0 + 4 * h - qrel);
#pragma unroll
                for (int i = 0; i < 16; ++i) {
                    const float d0 = fabsf(base + (float)((i & 3) + 8 * (i >> 2))), d1 = fabsf(base + (float)(32 + (i & 3) + 8 * (i >> 2)));
                    s0[i] = __builtin_fmaf(d0, nslope2, s0[i]); s1[i] = __builtin_fmaf(d1, nslope2, s1[i]);
                    if (MODE == 2) { if (d0 > 128.f) s0[i] = -1e30f; if (d1 > 128.f) s1[i] = -1e30f; }
                }
            }
        }
        float mx = fmaxf(s0[0], s1[0]);
#pragma unroll
        for (int i = 1; i < 16; ++i) mx = fmaxf(fmaxf(mx, s0[i]), s1[i]);
        mx += Aoff;
        mx = fmaxf(mx, xhalf(mx));
        const float mnew = fmaxf(m, mx);
        if (__builtin_amdgcn_ballot_w64(mnew > m) != 0ull) {
            const float alpha = __builtin_amdgcn_exp2f(m - mnew);
            lsum *= alpha;
#pragma unroll
            for (int d = 0; d < DV / 32; ++d) o[d] = o[d] * alpha;
        }
        m = mnew;
        const float mm = mnew - Aoff;
        float rs = 0.f;
#pragma unroll
        for (int i = 0; i < 16; ++i) { s0[i] = __builtin_amdgcn_exp2f(s0[i] - mm); s1[i] = __builtin_amdgcn_exp2f(s1[i] - mm); rs += s0[i] + s1[i]; }
        lsum += rs;
        bf16x8 pf[4];
#pragma unroll
        for (int s2 = 0; s2 < 2; ++s2) {
            u32x4 a, b;
            a.x = pk2(s0[8 * s2 + 0], s0[8 * s2 + 1]); a.y = pk2(s0[8 * s2 + 2], s0[8 * s2 + 3]); a.z = pk2(s0[8 * s2 + 4], s0[8 * s2 + 5]); a.w = pk2(s0[8 * s2 + 6], s0[8 * s2 + 7]);
            b.x = pk2(s1[8 * s2 + 0], s1[8 * s2 + 1]); b.y = pk2(s1[8 * s2 + 2], s1[8 * s2 + 3]); b.z = pk2(s1[8 * s2 + 4], s1[8 * s2 + 5]); b.w = pk2(s1[8 * s2 + 6], s1[8 * s2 + 7]);
            pf[s2] = __builtin_bit_cast(bf16x8, a); pf[2 + s2] = __builtin_bit_cast(bf16x8, b);
        }
        LDS_WAIT0();
        if (DQK == 64) {
#pragma unroll
            for (int ks = 0; ks < KH; ++ks) { const unsigned ka = sna + kad[ks]; LDS_RD128(kf1[ks], ka, 8192); } }
        { const unsigned alo = sba + vad[0][0], ahi = sba + vad[0][1];
#pragma unroll
          for (int kk = 0; kk < 4; ++kk) { LDS_RDTR(va_lo[kk], alo, kk * 4096); LDS_RDTR(va_hi[kk], ahi, kk * 4096); } }
        __builtin_amdgcn_sched_barrier(0);
        f32x16 n0, n1;
#pragma unroll
        for (int i = 0; i < 16; ++i) { n0[i] = 0.f; n1[i] = 0.f; }
#pragma unroll
        for (int g = 0; g < DQK / 64; ++g) {
            if (DQK != 64) {
#pragma unroll
                for (int ks = 0; ks < KH; ++ks) { const unsigned ka = sna + kad[g * KH + ks]; LDS_RD128(kf0[ks], ka, 0); LDS_RD128(kf1[ks], ka, 8192); }
                LDS_WAIT0(); }
#pragma unroll
            for (int ks = 0; ks < KH; ++ks) n0 = __builtin_amdgcn_mfma_f32_32x32x16_bf16(kf0[ks], qf[g * KH + ks], n0, 0, 0, 0);
            if (DQK == 64) LDS_WAIT0();
#pragma unroll
            for (int ks = 0; ks < KH; ++ks) n1 = __builtin_amdgcn_mfma_f32_32x32x16_bf16(kf1[ks], qf[g * KH + ks], n1, 0, 0, 0);
        }
#define PV_BLOCK(d, lo, hi) do { _Pragma("unroll") for (int kk = 0; kk < 4; ++kk) { const bf16x8 vf = {lo[kk][0], lo[kk][1], lo[kk][2], lo[kk][3], hi[kk][0], hi[kk][1], hi[kk][2], hi[kk][3]}; \
            o[d] = __builtin_amdgcn_mfma_f32_32x32x16_bf16(vf, pf[kk], o[d], 0, 0, 0); } } while (0)
#define V_ISSUE(d, lo, hi) do { const unsigned alo_ = sba + vad[d][0], ahi_ = sba + vad[d][1]; _Pragma("unroll") for (int kk = 0; kk < 4; ++kk) { LDS_RDTR(lo[kk], alo_, kk * 4096); LDS_RDTR(hi[kk], ahi_, kk * 4096); } } while (0)
        LDS_WAIT0();
        V_ISSUE(1, vb_lo, vb_hi); __builtin_amdgcn_sched_barrier(0);
        PV_BLOCK(0, va_lo, va_hi);
        LDS_WAIT0();
        V_ISSUE(2, va_lo, va_hi); __builtin_amdgcn_sched_barrier(0);
        PV_BLOCK(1, vb_lo, vb_hi);
        LDS_WAIT0();
        V_ISSUE(3, vb_lo, vb_hi); __builtin_amdgcn_sched_barrier(0);
        PV_BLOCK(2, va_lo, va_hi);
        LDS_WAIT0();
        PV_BLOCK(3, vb_lo, vb_hi);
#undef PV_BLOCK
#undef V_ISSUE
        s0 = n0; s1 = n1;
        if (t + 3 < ntiles) asm volatile("s_waitcnt vmcnt(4)" ::: "memory"); else asm volatile("s_waitcnt vmcnt(0)" ::: "memory");
        __builtin_amdgcn_s_barrier();
    }
#undef LDS_RD128
#undef LDS_RDTR
#undef LDS_WAIT0
#undef ATT_DMA
}
template <int DV> __device__ __forceinline__ void store_o(const f32x16 (&o)[DV / 32], float sc, bf16_t* orow, int h) {
#pragma unroll
    for (int d = 0; d < DV / 32; ++d)
#pragma unroll
        for (int g4 = 0; g4 < 4; ++g4) { u32x2 w; w.x = pk2(o[d][4 * g4] * sc, o[d][4 * g4 + 1] * sc); w.y = pk2(o[d][4 * g4 + 2] * sc, o[d][4 * g4 + 3] * sc);
            *(GAS u32x2*)((GAS bf16_t*)orow + 32 * d + 8 * g4 + 4 * h) = w; }
}

__device__ __forceinline__ void win_unit(Frame& F, const Params& p, int l, int u) {
    REFRAME(F);
    const bf16_t* Z = (const bf16_t*)(p.ws + WS_Z); bf16_t* MIX = (bf16_t*)(p.ws + WS_MIX);
    const int b = u >> 5, kvh = (u >> 4) & 1, nb = u & 15, r = F.lane & 31, h = F.lane >> 5;
    const int g = F.wave >> 2, hq = kvh * 2 + g, qpos = nb * 128 + (F.wave & 3) * 32 + r;
    const size_t tok = (size_t)b * SEQ + qpos;
    bf16x8 qf[4]; load_q<64>(qf, Z + tok * ZP + hq * 64, h, 0.125f * LOG2E);
    const int first = (2 * nb - 2 < 0) ? 0 : 2 * nb - 2, lastx = (2 * nb + 4 > 32) ? 32 : 2 * nb + 4, nt = lastx - first;
    const float slope = exp2f(-(float)(2 * hq + 1));
    float m = p.in[4][l * 4 + hq] * LOG2E, ls = (h == 0) ? 1.f : 0.f;
    f32x16 o[2];
#pragma unroll
    for (int d = 0; d < 2; ++d)
#pragma unroll
        for (int i = 0; i < 16; ++i) o[d][i] = 0.f;
    const bf16_t* Kg = Z + ((size_t)b * SEQ + first * 64) * ZP + 256 + kvh * 64;
    attn_loop<64, 64, 64, 2>(F.lds, Kg, ZP, Kg + 128, ZP, nt, qf, 0, -slope * LOG2E, qpos - first * 64, m, ls, o);
    const float lt = ls + xhalf(ls);
    store_o<64>(o, 1.f / lt, MIX + tok * DM + hq * 64, h);
}
__device__ __forceinline__ void diff_unit(Frame& F, const Params& p, int l, int u) {
    REFRAME(F);
    const bf16_t* Z = (const bf16_t*)(p.ws + WS_Z); bf16_t* MIX = (bf16_t*)(p.ws + WS_MIX);
    const int b = u >> 6, hh = (u >> 4) & 3, qb = u & 15, r = F.lane & 31, h = F.lane >> 5;
    const int c = F.wave >> 2, qpos = qb * 128 + (F.wave & 3) * 32 + r;
    const size_t tok = (size_t)b * SEQ + qpos;
    float lam, lam_init;
    {
        const float a1 = wave_sum(p.in[5][l * 64 + F.lane] * p.in[6][l * 64 + F.lane]), a2 = wave_sum(p.in[7][l * 64 + F.lane] * p.in[8][l * 64 + F.lane]);
        lam_init = 0.8f - 0.6f * expf(-0.3f * (float)l);
        lam = expf(a1) - expf(a2) + lam_init;
    }
    bf16x8 qf[4]; load_q<64>(qf, Z + tok * ZP + 512 + hh * 128 + c * 64, h, 0.125f * LOG2E);
    const float slope = exp2f(-(float)(2 * hh + 2));
    float m = -1e30f, ls = 0.f;
    f32x16 o[4];
#pragma unroll
    for (int d = 0; d < 4; ++d)
#pragma unroll
        for (int i = 0; i < 16; ++i) o[d][i] = 0.f;
    const bf16_t* Kg = (const bf16_t*)(p.ws + WS_KD2) + (size_t)(b * 4 + hh) * 2048 * 128;
    attn_loop_dma<64, 1, 128, 8388608>(F.lds, F.wave, Kg, 32, qf, c * 64, -slope * LOG2E, qpos, m, ls, o);
    const float inv = 1.f / (ls + xhalf(ls));
    LAS float* comb = (LAS float*)F.lds + (size_t)(F.wave & 3) * 64 * 64 + F.lane;
    if (c == 1) {
#pragma unroll
        for (int d = 0; d < 4; ++d)
#pragma unroll
            for (int i = 0; i < 16; ++i) comb[(d * 16 + i) * 64] = o[d][i] * inv;
    }
    __syncthreads();
    if (c == 0) {
        float ss = 0.f;
#pragma unroll
        for (int d = 0; d < 4; ++d)
#pragma unroll
            for (int i = 0; i < 16; ++i) { const float a = o[d][i] * inv - lam * comb[(d * 16 + i) * 64]; o[d][i] = a; ss += a * a; }
        ss += xhalf(ss);
        const float rn = rsqrtf(ss * (1.f / 128.f) + 1e-6f) * (1.f - lam_init);
        const float* sg = p.in[9] + l * 128;
        bf16_t* orow = MIX + tok * DM + 256 + hh * 128;
#pragma unroll
        for (int d = 0; d < 4; ++d)
#pragma unroll
            for (int g4 = 0; g4 < 4; ++g4) { const int dv = 32 * d + 8 * g4 + 4 * h; const f32x4 gg = *(const GAS f32x4*)((const GAS float*)sg + dv);
                u32x2 w; w.x = pk2(o[d][4 * g4] * rn * gg[0], o[d][4 * g4 + 1] * rn * gg[1]); w.y = pk2(o[d][4 * g4 + 2] * rn * gg[2], o[d][4 * g4 + 3] * rn * gg[3]);
                *(GAS u32x2*)((GAS bf16_t*)orow + dv) = w; }
    }
    __syncthreads();
}
__device__ __forceinline__ void cross_unit(Frame& F, const Params& p, int u) {
    REFRAME(F);
    const bf16_t* Q = (const bf16_t*)(p.ws + WS_Q); const bf16_t* KV = (const bf16_t*)(p.ws + WS_KV); bf16_t* O = (bf16_t*)(p.ws + WS_O);
    const int b = u >> 5, hd = (u >> 3) & 3, qb = u & 7, r = F.lane & 31, h = F.lane >> 5;
    const size_t tok = (size_t)b * SEQ + qb * 256 + F.wave * 32 + r;
    bf16x8 qf[8]; load_q<128>(qf, Q + tok * XW + hd * 128, h, 0.08838834764831845f * LOG2E);
    float m = -1e30f, ls = 0.f;
    f32x16 o[4];
#pragma unroll
    for (int d = 0; d < 4; ++d)
#pragma unroll
        for (int i = 0; i < 16; ++i) o[d][i] = 0.f;
    const bf16_t* Kg = KV + ((size_t)b * NMEM) * 1024 + hd * 128;
    attn_loop_dma<128, 0, 1024, 512>(F.lds, F.wave, Kg, 4, qf, 0, 0.f, 0, m, ls, o);
    const float lt = ls + xhalf(ls);
    store_o<128>(o, 1.f / lt, O + tok * XW + hd * 128, h);
}

constexpr int CF_STR = 772, PREP_AW = 32 * CF_STR * 4, PREP_AA = PREP_AW + 32 * 72 * 2, PREP_AG = PREP_AA + 32 * 72 * 2;
__device__ __forceinline__ void prep_unit(Frame& F, const Params& p, int l, const bf16_t* wb, int u) {
    REFRAME(F);
    const bf16_t* ZC = (const bf16_t*)(p.ws + WS_ZC);
    const int t0 = u * 32, b = t0 / SEQ;
    LAS float* CF = (LAS float*)F.lds; LAS bf16_t* AW = (LAS bf16_t*)(F.lds + PREP_AW); LAS bf16_t* AA = (LAS bf16_t*)(F.lds + PREP_AA); LAS bf16_t* AG = (LAS bf16_t*)(F.lds + PREP_AG);
    const float* conv = p.in[10] + (size_t)l * 3 * 1024;
#pragma unroll 4
    for (int i = 0; i < 8; ++i) {
        const int id = F.tid + i * 512, tk = id >> 7, ch = id & 127, tg = t0 + tk, tpos = tg - b * SEQ;
        const GAS bf16_t* zp = (const GAS bf16_t*)ZC + (size_t)tg * 1024 + ch * 8;
        const u32x4 zc = *(const GAS u32x4*)zp;
        u32x4 zl = {0u, 0u, 0u, 0u}, zr = {0u, 0u, 0u, 0u};
        if (tpos > 0) zl = *(const GAS u32x4*)(zp - 1024);
        if (tpos < SEQ - 1) zr = *(const GAS u32x4*)(zp + 1024);
        float v[8];
#pragma unroll
        for (int q = 0; q < 4; ++q) {
            const f32x2 c0 = *(const GAS f32x2*)((const GAS float*)conv + ch * 8 + 2 * q), c1 = *(const GAS f32x2*)((const GAS float*)conv + 1024 + ch * 8 + 2 * q), c2 = *(const GAS f32x2*)((const GAS float*)conv + 2048 + ch * 8 + 2 * q);
            v[2 * q] = bflo(zl[q]) * c0[0] + bflo(zc[q]) * c1[0] + bflo(zr[q]) * c2[0];
            v[2 * q + 1] = bfhi(zl[q]) * c0[1] + bfhi(zc[q]) * c1[1] + bfhi(zr[q]) * c2[1];
        }
        if (ch < 96) { *(LAS f32x4*)(CF + tk * CF_STR + ch * 8) = (f32x4){v[0], v[1], v[2], v[3]}; *(LAS f32x4*)(CF + tk * CF_STR + ch * 8 + 4) = (f32x4){v[4], v[5], v[6], v[7]}; }
        else {
            u32x4 w;
            if (ch < 104) {
#pragma unroll
                for (int q = 0; q < 8; ++q) v[q] = 1.f - 2.f / (__expf(2.f * v[q]) + 1.f);
                w.x = pk2(v[0], v[1]); w.y = pk2(v[2], v[3]); w.z = pk2(v[4], v[5]); w.w = pk2(v[6], v[7]);
                *(LAS u32x4*)(AW + tk * 72 + (ch - 96) * 8) = w;
            } else if (ch < 112) {
                w.x = pk2(v[0], v[1]); w.y = pk2(v[2], v[3]); w.z = pk2(v[4], v[5]); w.w = pk2(v[6], v[7]);
                *(LAS u32x4*)(AA + tk * 72 + (ch - 104) * 8) = w;
            } else {
#pragma unroll
                for (int q = 0; q < 8; ++q) v[q] = sigmoidf_(v[q]);
                w.x = pk2(v[0], v[1]); w.y = pk2(v[2], v[3]); w.z = pk2(v[4], v[5]); w.w = pk2(v[6], v[7]);
                *(LAS u32x4*)(AG + tk * 136 + (ch - 112) * 8) = w;
            }
        }
    }
    __syncthreads();
    const int hh = F.wave & 3, dir = F.wave >> 2, tk = F.lane & 31, h2 = F.lane >> 5;
    const size_t tok = (size_t)t0 + tk;
    const GAS bf16_t* Wup = (const GAS bf16_t*)wb + WO_WUP + (size_t)(dir * 256 + hh * 64) * 64;
    const GAS bf16_t* Aup = (const GAS bf16_t*)wb + WO_AUP + (size_t)(dir * 256 + hh * 64) * 64;
    f32x16 aw[2], aa[2];
#pragma unroll
    for (int rb = 0; rb < 2; ++rb)
#pragma unroll
        for (int i = 0; i < 16; ++i) { aw[rb][i] = 0.f; aa[rb][i] = 0.f; }
#pragma unroll
    for (int ks = 0; ks < 4; ++ks) {
        const bf16x8 bw = *(const LAS bf16x8*)(AW + tk * 72 + 16 * ks + 8 * h2), ba = *(const LAS bf16x8*)(AA + tk * 72 + 16 * ks + 8 * h2);
#pragma unroll
        for (int rb = 0; rb < 2; ++rb) {
            const bf16x8 fw = *(const GAS bf16x8*)(Wup + (size_t)(rb * 32 + tk) * 64 + 16 * ks + 8 * h2), fa = *(const GAS bf16x8*)(Aup + (size_t)(rb * 32 + tk) * 64 + 16 * ks + 8 * h2);
            aw[rb] = __builtin_amdgcn_mfma_f32_32x32x16_bf16(fw, bw, aw[rb], 0, 0, 0);
            aa[rb] = __builtin_amdgcn_mfma_f32_32x32x16_bf16(fa, ba, aa[rb], 0, 0, 0);
        }
    }
    const GAS float* k_k = (const GAS float*)p.in[16] + l * 256 + hh * 64; const GAS float* k_a = (const GAS float*)p.in[17] + l * 256 + hh * 64; const GAS float* r_k = (const GAS float*)p.in[18] + l * 256 + hh * 64;
    const GAS float* w0 = (const GAS float*)p.in[11] + (size_t)(l * 2 + dir) * 256 + hh * 64; const GAS float* a0 = (const GAS float*)p.in[13] + (size_t)(l * 2 + dir) * 256 + hh * 64;
    float ssq = 0.f;
#pragma unroll
    for (int rb = 0; rb < 2; ++rb)
#pragma unroll
        for (int g4 = 0; g4 < 4; ++g4) { const int c0 = rb * 32 + 8 * g4 + 4 * h2;
            const f32x4 kv = *(const LAS f32x4*)(CF + tk * CF_STR + 256 + hh * 64 + c0), kkw = *(const GAS f32x4*)(k_k + c0);
            const f32x4 q = kv * kkw; ssq += (q[0] * q[0] + q[1] * q[1]) + (q[2] * q[2] + q[3] * q[3]); }
    ssq += xhalf(ssq);
    const float kinv = 1.f / fmaxf(sqrtf(ssq), 1e-12f);
    float bon = 0.f;
    GAS bf16_t* OM = (GAS bf16_t*)(p.ws + WS_OM) + ((size_t)dir * MTOK + tok) * 256 + hh * 64;
    GAS bf16_t* KA = (GAS bf16_t*)(p.ws + WS_KA) + ((size_t)dir * MTOK + tok) * 256 + hh * 64;
    GAS bf16_t* KD = (GAS bf16_t*)(p.ws + WS_KD) + ((size_t)dir * MTOK + tok) * 256 + hh * 64;
    GAS bf16_t* KK = (GAS bf16_t*)(p.ws + WS_KK) + tok * 256 + hh * 64;
    GAS bf16_t* VV = (GAS bf16_t*)(p.ws + WS_V) + tok * 256 + hh * 64;
    GAS bf16_t* RR = (GAS bf16_t*)(p.ws + WS_R) + tok * 256 + hh * 64;
#pragma unroll
    for (int rb = 0; rb < 2; ++rb)
#pragma unroll
        for (int g4 = 0; g4 < 4; ++g4) { const int c0 = rb * 32 + 8 * g4 + 4 * h2;
            const f32x4 kv = *(const LAS f32x4*)(CF + tk * CF_STR + 256 + hh * 64 + c0), rv = *(const LAS f32x4*)(CF + tk * CF_STR + hh * 64 + c0);
            const f32x4 kkw = *(const GAS f32x4*)(k_k + c0), kaw = *(const GAS f32x4*)(k_a + c0), rkw = *(const GAS f32x4*)(r_k + c0), w0v = *(const GAS f32x4*)(w0 + c0), a0v = *(const GAS f32x4*)(a0 + c0);
            float om[4], ka[4], kd[4], kk[4];
#pragma unroll
            for (int j = 0; j < 4; ++j) {
                const float wp = aw[rb][4 * g4 + j] + w0v[j], ap = aa[rb][4 * g4 + j] + a0v[j];
                om[j] = 1.f - __expf(-0.6065306597126334f * sigmoidf_(wp));
                const float a = sigmoidf_(ap);
                kk[j] = kv[j] * kkw[j] * kinv; ka[j] = kk[j] * a; kd[j] = kv[j] * (1.f + (a - 1.f) * kaw[j]);
                bon += rv[j] * kd[j] * rkw[j];
            }
            u32x2 w; w.x = pk2(om[0], om[1]); w.y = pk2(om[2], om[3]); *(GAS u32x2*)(OM + c0) = w;
            w.x = pk2(ka[0], ka[1]); w.y = pk2(ka[2], ka[3]); *(GAS u32x2*)(KA + c0) = w;
            w.x = pk2(kd[0], kd[1]); w.y = pk2(kd[2], kd[3]); *(GAS u32x2*)(KD + c0) = w;
            if (dir == 0) {
                const f32x4 vv = *(const LAS f32x4*)(CF + tk * CF_STR + 512 + hh * 64 + c0);
                w.x = pk2(kk[0], kk[1]); w.y = pk2(kk[2], kk[3]); *(GAS u32x2*)(KK + c0) = w;
                w.x = pk2(vv[0], vv[1]); w.y = pk2(vv[2], vv[3]); *(GAS u32x2*)(VV + c0) = w;
                w.x = pk2(rv[0], rv[1]); w.y = pk2(rv[2], rv[3]); *(GAS u32x2*)(RR + c0) = w;
            }
        }
    bon += xhalf(bon);
    if (h2 == 0) ((GAS float*)(p.ws + WS_BON))[((size_t)dir * MTOK + tok) * 4 + hh] = bon;
    {
        const GAS bf16_t* Gup = (const GAS bf16_t*)wb + WO_GUP + (size_t)(F.wave * 32 + tk) * 128;
        f32x16 ag;
#pragma unroll
        for (int i = 0; i < 16; ++i) ag[i] = 0.f;
#pragma unroll
        for (int ks = 0; ks < 8; ++ks) {
            const bf16x8 bg = *(const LAS bf16x8*)(AG + tk * 136 + 16 * ks + 8 * h2), fg = *(const GAS bf16x8*)(Gup + 16 * ks + 8 * h2);
            ag = __builtin_amdgcn_mfma_f32_32x32x16_bf16(fg, bg, ag, 0, 0, 0);
        }
        GAS bf16_t* GT = (GAS bf16_t*)(p.ws + WS_GATE) + tok * 256 + F.wave * 32;
#pragma unroll
        for (int g4 = 0; g4 < 4; ++g4) { u32x2 w; w.x = pk2(ag[4 * g4], ag[4 * g4 + 1]); w.y = pk2(ag[4 * g4 + 2], ag[4 * g4 + 3]); *(GAS u32x2*)(GT + 8 * g4 + 4 * h2) = w; }
    }
    __syncthreads();
}

#define CBAR() asm volatile("" ::: "memory")
#define LROW(M, i, r) do { const LAS f32x4* _q = (const LAS f32x4*)((M) + (i) * 16); const f32x4 _a = _q[0], _b = _q[1], _c = _q[2], _d = _q[3]; \
        r[0] = _a[0]; r[1] = _a[1]; r[2] = _a[2]; r[3] = _a[3]; r[4] = _b[0]; r[5] = _b[1]; r[6] = _b[2]; r[7] = _b[3]; \
        r[8] = _c[0]; r[9] = _c[1]; r[10] = _c[2]; r[11] = _c[3]; r[12] = _d[0]; r[13] = _d[1]; r[14] = _d[2]; r[15] = _d[3]; } while (0)
template <int DIR> __device__ __forceinline__ void chunkprep_wave(Frame& F, const Params& p, int task) {
    const int dbh = task >> 7, ct = task & 127, b = (dbh >> 2) & 7, hh = dbh & 3, ch = F.lane, r32 = F.lane & 31, h = F.lane >> 5;
    LAS unsigned char* wl = F.lds + F.wave * 16384;
    LAS bf16_t* X = (LAS bf16_t*)wl;
    LAS bf16_t* Yt = (LAS bf16_t*)(wl + 4608);
    LAS float* MTt = (LAS float*)(wl + 9216);
    LAS float* MBt = MTt + 256;
    LAS float* MC = MTt + 512; LAS float* MD = MTt + 768; LAS float* MT = MTt + 1024; LAS float* MA = MTt + 1280;
    constexpr int step = DIR ? -256 : 256;
    typedef const __attribute__((address_space(1))) bf16_t* gbf;
    const size_t ou = ((size_t)b * SEQ + ct * 16 + (DIR ? 15 : 0)) * 256 + hh * 64;
    const gbf OM = (gbf)(p.ws + WS_OM) + (size_t)DIR * MTOK * 256 + ou + ch; const gbf KA = (gbf)(p.ws + WS_KA) + (size_t)DIR * MTOK * 256 + ou + ch;
    const gbf KD = (gbf)(p.ws + WS_KD) + (size_t)DIR * MTOK * 256 + ou + ch; const gbf KK = (gbf)(p.ws + WS_KK) + ou + ch;
    const gbf RR = (gbf)(p.ws + WS_R) + ou + ch; const gbf VV = (gbf)(p.ws + WS_V) + ou + ch;
    float pc = 1.f;
    float qt[16], rt[16], at[16], kt[16], vv[16];
    {
        unsigned short rw[16], rk[16], ra_[16], rd[16], rr_[16], rv[16];
#pragma unroll
        for (int i = 0; i < 16; ++i) { rw[i] = OM[i * step]; rk[i] = KK[i * step]; ra_[i] = KA[i * step]; rd[i] = KD[i * step]; rr_[i] = RR[i * step]; rv[i] = VV[i * step]; }
#pragma unroll
        for (int i = 0; i < 16; ++i) {
            const float w = 1.f - bf2f(rw[i]);
            qt[i] = bf2f(rk[i]) * pc; pc *= w; const float ip = __builtin_amdgcn_rcpf(pc);
            rt[i] = bf2f(rr_[i]) * pc; at[i] = bf2f(ra_[i]) * ip; kt[i] = bf2f(rd[i]) * ip; vv[i] = bf2f(rv[i]);
            X[i * 72 + ch] = (bf16_t)(pk2(qt[i], 0.f) & 0xffffu); X[(16 + i) * 72 + ch] = (bf16_t)(pk2(rt[i], 0.f) & 0xffffu);
            Yt[i * 72 + ch] = (bf16_t)(pk2(at[i], 0.f) & 0xffffu); Yt[(16 + i) * 72 + ch] = (bf16_t)(pk2(kt[i], 0.f) & 0xffffu);
        }
    }
    const float p15 = pc;
    asm volatile("s_waitcnt lgkmcnt(0)" ::: "memory");
    {
        f32x16 g;
#pragma unroll
        for (int i = 0; i < 16; ++i) g[i] = 0.f;
#pragma unroll
        for (int ks = 0; ks < 4; ++ks) {
            const bf16x8 a = *(const LAS bf16x8*)(X + r32 * 72 + 16 * ks + 8 * h), bb = *(const LAS bf16x8*)(Yt + r32 * 72 + 16 * ks + 8 * h);
            g = __builtin_amdgcn_mfma_f32_32x32x16_bf16(a, bb, g, 0, 0, 0);
        }
        const int sidx = r32 & 15;
#pragma unroll
        for (int reg = 0; reg < 8; ++reg) { const int i = (reg & 3) + 8 * (reg >> 2) + 4 * h;
            const float lo = (sidx < i) ? g[reg] : 0.f, hi2 = (sidx <= i) ? g[8 + reg] : 0.f;
            if (r32 < 16) { MA[i * 16 + sidx] = lo; MD[i * 16 + sidx] = hi2; } else { MBt[sidx * 16 + i] = lo; MC[i * 16 + sidx] = hi2; } }
    }
    asm volatile("s_waitcnt lgkmcnt(0)" ::: "memory");
    {
        const int c = F.lane & 15; float Tc[16];
#pragma unroll
        for (int i = 0; i < 16; ++i) { float acc = (i == c) ? 1.f : 0.f; float ra[16]; LROW(MA, i, ra);
#pragma unroll
            for (int s2 = 0; s2 < i; ++s2) acc -= ra[s2] * Tc[s2];
            Tc[i] = acc; MT[i * 16 + c] = acc; MTt[c * 16 + i] = acc; CBAR(); }
    }
    asm volatile("s_waitcnt lgkmcnt(0)" ::: "memory");
    float Qh[16], W2[16];
    {
        float BV[16];
#pragma unroll
        for (int i = 0; i < 16; ++i) { Qh[i] = 0.f; BV[i] = 0.f; }
#pragma unroll
        for (int s2 = 0; s2 < 16; ++s2) {
            float ct_[16], cb_[16]; LROW(MTt, s2, ct_); LROW(MBt, s2, cb_);
#pragma unroll
            for (int i = s2; i < 16; ++i) { Qh[i] += ct_[i] * qt[s2]; if (i > s2) BV[i] += cb_[i] * vv[s2]; }
            CBAR();
        }
#pragma unroll
        for (int i = 0; i < 16; ++i) { float aw = 0.f; float rt_[16]; LROW(MT, i, rt_);
#pragma unroll
            for (int s2 = 0; s2 <= i; ++s2) aw += rt_[s2] * BV[s2];
            W2[i] = aw; CBAR(); }
    }
    GAS bf16_t* FQR = (GAS bf16_t*)(p.ws + WS_FQR) + (size_t)task * 2048;
    GAS bf16_t* FWY = (GAS bf16_t*)(p.ws + WS_FWY) + (size_t)task * 2048;
    {
        const int ks = ch >> 4, w16 = ch & 15, jq = (w16 >> 3) * 4 + (w16 & 3), hq = (w16 >> 2) & 1;
        GAS bf16_t* qrp = FQR + (size_t)(ks * 64 + hq * 32) * 8 + jq;
        GAS bf16_t* wyp = FWY + (size_t)(((ch >> 5) * 64 + r32) * 16);
#pragma unroll
        for (int i = 0; i < 16; ++i) {
            float ar = rt[i], ay = 0.f; float rd_[16], rc_[16]; LROW(MD, i, rd_); LROW(MC, i, rc_);
#pragma unroll
            for (int s2 = 0; s2 <= i; ++s2) { ar -= rd_[s2] * Qh[s2]; ay += rc_[s2] * vv[s2] - rd_[s2] * W2[s2]; }
            qrp[i * 8] = (bf16_t)(pk2(Qh[i], 0.f) & 0xffffu); qrp[(16 + i) * 8] = (bf16_t)(pk2(ar, 0.f) & 0xffffu);
            wyp[512 * ((i >> 2) & 1) + (i & 3) + 4 * (i >> 3)] = (bf16_t)(pk2(W2[i], 0.f) & 0xffffu);
            wyp[512 * ((i >> 2) & 1) + (i & 3) + 4 * ((16 + i) >> 3)] = (bf16_t)(pk2(ay, 0.f) & 0xffffu);
            CBAR(); }
    }
    {
        GAS bf16_t* nap = (GAS bf16_t*)(p.ws + WS_FNA) + (size_t)task * 1024 + (size_t)(((ch >> 5) * 64 + r32) * 8);
        GAS bf16_t* khp = (GAS bf16_t*)(p.ws + WS_FKH) + (size_t)task * 1024 + (size_t)(((ch >> 5) * 64 + r32) * 8);
#pragma unroll
        for (int s2 = 0; s2 < 16; ++s2) {
            const int off = 256 * ((s2 >> 2) & 1) + (s2 >> 3) * 4 + (s2 & 3);
            nap[off] = (bf16_t)(pk2(-at[s2] * p15, 0.f) & 0xffffu); khp[off] = (bf16_t)(pk2(kt[s2] * p15, 0.f) & 0xffffu); }
        ((GAS float*)(p.ws + WS_FP15))[(size_t)task * 64 + ch] = p15;
    }
    asm volatile("s_waitcnt lgkmcnt(0)" ::: "memory");
}
constexpr int PB_SLOT = 15360, PB_NSLOT = 4, PB_QR = 0, PB_WY = 4096, PB_NA = 8192, PB_KH = 10240, PB_P15 = 12288, PB_V = 13312;
__device__ __forceinline__ unsigned lds_ld_u32(unsigned addr) { unsigned v; asm volatile("ds_read_b32 %0, %1\n\ts_waitcnt lgkmcnt(0)" : "=v"(v) : "v"(addr) : "memory"); return v; }
__device__ __forceinline__ void lds_st_u32(unsigned addr, unsigned v) { asm volatile("ds_write_b32 %0, %1" :: "v"(addr), "v"(v) : "memory"); }
__device__ __forceinline__ void pb_dma(const Params& p, int dbh, int ct, int lane, LAS unsigned char* slot) {
    const size_t task = (size_t)dbh * 128 + ct; const int b = (dbh >> 2) & 7, hh = dbh & 3;
    const unsigned char* q = (const unsigned char*)((const bf16_t*)(p.ws + WS_FQR) + task * 2048) + lane * 16; const unsigned char* w = (const unsigned char*)((const bf16_t*)(p.ws + WS_FWY) + task * 2048) + lane * 16;
    const unsigned char* na = (const unsigned char*)((const bf16_t*)(p.ws + WS_FNA) + task * 1024) + lane * 16; const unsigned char* kh = (const unsigned char*)((const bf16_t*)(p.ws + WS_FKH) + task * 1024) + lane * 16;
#pragma unroll
    for (int i = 0; i < 4; ++i) {
        __builtin_amdgcn_global_load_lds((const unsigned*)(q + 1024 * i), (LAS unsigned*)(slot + PB_QR + 1024 * i), 16, 0, 0);
        __builtin_amdgcn_global_load_lds((const unsigned*)(w + 1024 * i), (LAS unsigned*)(slot + PB_WY + 1024 * i), 16, 0, 0); }
    __builtin_amdgcn_global_load_lds((const unsigned*)na, (LAS unsigned*)(slot + PB_NA), 16, 0, 0); __builtin_amdgcn_global_load_lds((const unsigned*)(na + 1024), (LAS unsigned*)(slot + PB_NA + 1024), 16, 0, 0);
    __builtin_amdgcn_global_load_lds((const unsigned*)kh, (LAS unsigned*)(slot + PB_KH), 16, 0, 0); __builtin_amdgcn_global_load_lds((const unsigned*)(kh + 1024), (LAS unsigned*)(slot + PB_KH + 1024), 16, 0, 0);
    __builtin_amdgcn_global_load_lds((const unsigned*)((const unsigned char*)((const float*)(p.ws + WS_FP15) + task * 64) + lane * 16), (LAS unsigned*)(slot + PB_P15), 16, 0, 0);
    const unsigned char* V = (const unsigned char*)((const bf16_t*)(p.ws + WS_V) + ((size_t)b * SEQ + ct * 16) * 256 + hh * 64) + (size_t)(lane >> 3) * 512 + (lane & 7) * 16;
    __builtin_amdgcn_global_load_lds((const unsigned*)V, (LAS unsigned*)(slot + PB_V), 16, 0, 0); __builtin_amdgcn_global_load_lds((const unsigned*)(V + 8 * 512), (LAS unsigned*)(slot + PB_V + 1024), 16, 0, 0);
}
__device__ __forceinline__ void phaseb_unit(Frame& F, const Params& p, int u) {
    const unsigned flag_base = (unsigned)(size_t)(F.lds + 131072 + 128);
    if (F.tid < 8) lds_st_u32(flag_base + 4 * F.tid, 0u);
    __syncthreads();
    const int pair = F.wave & 3;
    if (pair >= 2) return;
    const int dbh = u * 2 + pair, dir = dbh >> 5;
    LAS unsigned char* ring = F.lds + pair * (PB_NSLOT * PB_SLOT);
    const unsigned f_pub = flag_base + 8 * pair, f_con = f_pub + 4;
    if (F.wave >= 4) {
        for (int c = 0; c < 128; ++c) {
            while ((int)lds_ld_u32(f_con) < c - (PB_NSLOT - 1)) __builtin_amdgcn_s_sleep(1);
            pb_dma(p, dbh, dir ? 127 - c : c, F.lane, ring + (c & (PB_NSLOT - 1)) * PB_SLOT);
            if (c >= 3) { asm volatile("s_waitcnt vmcnt(45)" ::: "memory"); if (F.lane == 0) lds_st_u32(f_pub, (unsigned)(c - 2)); }
        }
        asm volatile("s_waitcnt vmcnt(30)" ::: "memory"); if (F.lane == 0) lds_st_u32(f_pub, 126u);
        asm volatile("s_waitcnt vmcnt(15)" ::: "memory"); if (F.lane == 0) lds_st_u32(f_pub, 127u);
        asm volatile("s_waitcnt vmcnt(0)" ::: "memory"); if (F.lane == 0) lds_st_u32(f_pub, 128u);
        return;
    }
    const int b = (dbh >> 2) & 7, hh = dbh & 3, r = F.lane & 31, h = F.lane >> 5;
    GAS bf16_t* Y = (GAS bf16_t*)(p.ws + WS_Y) + ((size_t)dir * MTOK + (size_t)b * SEQ) * 256 + hh * 64 + r;
    f32x16 accS[2][2];
#pragma unroll
    for (int rb = 0; rb < 2; ++rb)
#pragma unroll
        for (int cb = 0; cb < 2; ++cb)
#pragma unroll
            for (int i = 0; i < 16; ++i) accS[rb][cb][i] = 0.f;
    for (int cc = 0; cc < 128; ++cc) {
        const int ct = dir ? 127 - cc : cc;
        const LAS unsigned char* slot = ring + (cc & (PB_NSLOT - 1)) * PB_SLOT;
        bf16x8 sb[4][2];
#pragma unroll
        for (int rb = 0; rb < 2; ++rb)
#pragma unroll
            for (int s2 = 0; s2 < 2; ++s2)
#pragma unroll
                for (int cb = 0; cb < 2; ++cb) { const f32x16& a = accS[rb][cb]; u32x4 w;
                    w.x = pk2(a[8 * s2 + 0], a[8 * s2 + 1]); w.y = pk2(a[8 * s2 + 2], a[8 * s2 + 3]); w.z = pk2(a[8 * s2 + 4], a[8 * s2 + 5]); w.w = pk2(a[8 * s2 + 6], a[8 * s2 + 7]);
                    sb[2 * rb + s2][cb] = __builtin_bit_cast(bf16x8, w); }
        while ((int)lds_ld_u32(f_pub) < cc + 1) __builtin_amdgcn_s_sleep(1);
        asm volatile("" ::: "memory");
        f32x16 D[2];
#pragma unroll
        for (int cb = 0; cb < 2; ++cb) { const LAS u32x4* wp = (const LAS u32x4*)(slot + PB_WY + (cb * 64 + F.lane) * 32); const u32x4 w0 = wp[0], w1 = wp[1];
            D[cb][0] = bflo(w0.x); D[cb][1] = bfhi(w0.x); D[cb][2] = bflo(w0.y); D[cb][3] = bfhi(w0.y); D[cb][4] = bflo(w0.z); D[cb][5] = bfhi(w0.z); D[cb][6] = bflo(w0.w); D[cb][7] = bfhi(w0.w);
            D[cb][8] = bflo(w1.x); D[cb][9] = bfhi(w1.x); D[cb][10] = bflo(w1.y); D[cb][11] = bfhi(w1.y); D[cb][12] = bflo(w1.z); D[cb][13] = bfhi(w1.z); D[cb][14] = bflo(w1.w); D[cb][15] = bfhi(w1.w); }
#pragma unroll
        for (int ks = 0; ks < 4; ++ks) { const bf16x8 qa = *(const LAS bf16x8*)(slot + PB_QR + (ks * 64 + F.lane) * 16);
            D[0] = __builtin_amdgcn_mfma_f32_32x32x16_bf16(qa, sb[ks][0], D[0], 0, 0, 0);
            D[1] = __builtin_amdgcn_mfma_f32_32x32x16_bf16(qa, sb[ks][1], D[1], 0, 0, 0); }
#pragma unroll
        for (int rb = 0; rb < 2; ++rb)
#pragma unroll
            for (int g4 = 0; g4 < 4; ++g4) { const f32x4 pv = *(const LAS f32x4*)(slot + PB_P15 + (32 * rb + 8 * g4 + 4 * h) * 4);
#pragma unroll
                for (int cb = 0; cb < 2; ++cb)
#pragma unroll
                    for (int q = 0; q < 4; ++q) accS[rb][cb][4 * g4 + q] *= pv[q]; }
        bf16x8 ub[2], vb[2];
#pragma unroll
        for (int cb = 0; cb < 2; ++cb) {
            unsigned short vt[8];
#pragma unroll
            for (int j = 0; j < 8; ++j) { const int s2 = 8 * (j >> 2) + 4 * h + (j & 3); const int tau = dir ? 15 - s2 : s2;
                vt[j] = *(const LAS unsigned short*)(slot + PB_V + tau * 128 + (32 * cb + r) * 2);
                Y[(size_t)(ct * 16 + tau) * 256 + 32 * cb] = (bf16_t)(pk2(D[cb][8 + j], 0.f) & 0xffffu); }
            vb[cb] = (bf16x8){(short)vt[0], (short)vt[1], (short)vt[2], (short)vt[3], (short)vt[4], (short)vt[5], (short)vt[6], (short)vt[7]};
            u32x4 w; w.x = pk2(D[cb][0], D[cb][1]); w.y = pk2(D[cb][2], D[cb][3]); w.z = pk2(D[cb][4], D[cb][5]); w.w = pk2(D[cb][6], D[cb][7]);
            ub[cb] = __builtin_bit_cast(bf16x8, w);
        }
        bf16x8 na[2], kh[2];
#pragma unroll
        for (int rb = 0; rb < 2; ++rb) { na[rb] = *(const LAS bf16x8*)(slot + PB_NA + (rb * 64 + F.lane) * 16); kh[rb] = *(const LAS bf16x8*)(slot + PB_KH + (rb * 64 + F.lane) * 16); }
        asm volatile("s_waitcnt lgkmcnt(0)" ::: "memory");
        if (F.lane == 0) lds_st_u32(f_con, (unsigned)(cc + 1));
#pragma unroll
        for (int rb = 0; rb < 2; ++rb)
#pragma unroll
            for (int cb = 0; cb < 2; ++cb) {
                accS[rb][cb] = __builtin_amdgcn_mfma_f32_32x32x16_bf16(na[rb], ub[cb], accS[rb][cb], 0, 0, 0);
                accS[rb][cb] = __builtin_amdgcn_mfma_f32_32x32x16_bf16(kh[rb], vb[cb], accS[rb][cb], 0, 0, 0);
            }
    }
}

__device__ __forceinline__ void post_unit(Frame& F, const Params& p, int l, int u) {
    REFRAME(F);
    const bf16_t* Y0 = (const bf16_t*)(p.ws + WS_Y); const bf16_t* Y1 = Y0 + (size_t)MTOK * 256;
    const bf16_t* VV = (const bf16_t*)(p.ws + WS_V); const bf16_t* GT = (const bf16_t*)(p.ws + WS_GATE);
    const float* BON = (const float*)(p.ws + WS_BON); bf16_t* MIX = (bf16_t*)(p.ws + WS_MIX);
    const f32x4 lg = *(const f32x4*)(p.in[19] + l * 256 + 4 * F.lane), lb = *(const f32x4*)(p.in[20] + l * 256 + 4 * F.lane);
    for (int tok = u * 64 + F.wave * 8, te = tok + 8; tok < te; ++tok) {
        const u32x2 a = *(const GAS u32x2*)((const GAS bf16_t*)Y0 + (size_t)tok * 256 + 4 * F.lane), c = *(const GAS u32x2*)((const GAS bf16_t*)Y1 + (size_t)tok * 256 + 4 * F.lane);
        const u32x2 vv = *(const GAS u32x2*)((const GAS bf16_t*)VV + (size_t)tok * 256 + 4 * F.lane), gg = *(const GAS u32x2*)((const GAS bf16_t*)GT + (size_t)tok * 256 + 4 * F.lane);
        float y[4] = {bflo(a.x) + bflo(c.x), bfhi(a.x) + bfhi(c.x), bflo(a.y) + bflo(c.y), bfhi(a.y) + bfhi(c.y)};
        float s = (y[0] + y[1]) + (y[2] + y[3]);
#pragma unroll
        for (int o = 1; o < 16; o <<= 1) s += __shfl_xor(s, o);
        const float mu = s * (1.f / 64.f);
        float q = 0.f;
#pragma unroll
        for (int i = 0; i < 4; ++i) { y[i] -= mu; q += y[i] * y[i]; }
#pragma unroll
        for (int o = 1; o < 16; o <<= 1) q += __shfl_xor(q, o);
        const float rstd = rsqrtf(q * (1.f / 64.f) + 64e-5f);
        const int hh = F.lane >> 4;
        const float bon = ((const GAS float*)BON)[(size_t)tok * 4 + hh] + ((const GAS float*)BON)[((size_t)MTOK + tok) * 4 + hh];
        const float v4[4] = {bflo(vv.x), bfhi(vv.x), bflo(vv.y), bfhi(vv.y)}, g4[4] = {bflo(gg.x), bfhi(gg.x), bflo(gg.y), bfhi(gg.y)};
        float o4[4];
#pragma unroll
        for (int i = 0; i < 4; ++i) o4[i] = (y[i] * rstd * lg[i] + lb[i] + bon * v4[i]) * g4[i];
        u32x2 w; w.x = pk2(o4[0], o4[1]); w.y = pk2(o4[2], o4[3]);
        *(GAS u32x2*)((GAS bf16_t*)MIX + (size_t)tok * DM + 768 + 4 * F.lane) = w;
    }
}

__device__ __forceinline__ void prologue(Frame& F, const Params& p) {
    REFRAME(F);
    LAS float* scr = (LAS float*)(F.lds + F.wave * 16384);
    const int gw = F.bid * 8 + F.wave, NGW = F.G * 8;
    bf16_t* wb = (bf16_t*)(p.ws + WS_W);
    for (int it = gw; it < CV_TOTAL; it += NGW) { if (it < CV_A) cvt_item_a(p, 0, wb, scr, it, F.lane); else cvt_item_b(p, 0, wb, scr, it - CV_A, F.lane); }
    const float* x = p.in[0]; float* X = p.out; bf16_t* XB = (bf16_t*)(p.ws + WS_XB); float* rowss = (float*)(p.ws + WS_RP);
    for (int m = gw; m < MTOK; m += NGW) {
        const f32x4* xr = (const f32x4*)(x + (size_t)m * DM) + F.lane; f32x4* xo = (f32x4*)(X + (size_t)m * DM) + F.lane; u32x2* bo = (u32x2*)(XB + (size_t)m * DM) + F.lane;
        float s = 0.f;
#pragma unroll
        for (int jj = 0; jj < 4; ++jj) { const f32x4 v = xr[64 * jj]; xo[64 * jj] = v; s += (v[0] * v[0] + v[1] * v[1]) + (v[2] * v[2] + v[3] * v[3]);
            u32x2 w; w.x = pk2(v[0], v[1]); w.y = pk2(v[2], v[3]); bo[64 * jj] = w; }
        s = wave_sum(s);
        if (F.lane < 16) rowss[(size_t)m * 16 + F.lane] = (F.lane == 0) ? s : 0.f;
    }
    const float* mem = p.in[1]; const float* gm = p.in[23]; bf16_t* MN = (bf16_t*)(p.ws + WS_MEMN);
    for (int m = gw; m < MMEM; m += NGW) {
        const f32x4* xr = (const f32x4*)(mem + (size_t)m * DM) + F.lane; u32x2* bo = (u32x2*)(MN + (size_t)m * DM) + F.lane;
        f32x4 v[4]; float s = 0.f;
#pragma unroll
        for (int jj = 0; jj < 4; ++jj) { v[jj] = xr[64 * jj]; s += (v[jj][0] * v[jj][0] + v[jj][1] * v[jj][1]) + (v[jj][2] * v[jj][2] + v[jj][3] * v[jj][3]); }
        const float rstd = rsqrtf(wave_sum(s) * (1.f / 1024.f) + 1e-6f);
#pragma unroll
        for (int jj = 0; jj < 4; ++jj) { const f32x4 g = *((const f32x4*)gm + F.lane + 64 * jj); const f32x4 t = v[jj] * rstd * g;
            u32x2 w; w.x = pk2(t[0], t[1]); w.y = pk2(t[2], t[3]); bo[64 * jj] = w; }
    }
}
__device__ __forceinline__ void final_norm(Frame& F, const Params& p) {
    REFRAME(F);
    const int gw = F.bid * 8 + F.wave, NGW = F.G * 8;
    const float* rowss = (const float*)(p.ws + WS_RP) + (size_t)12 * MTOK * 16; const float* gf = p.in[30];
    for (int m = gw; m < MTOK; m += NGW) {
        f32x4* xo = (f32x4*)(p.out + (size_t)m * DM) + F.lane;
        const float rstd = row_rstd(rowss, m);
#pragma unroll
        for (int jj = 0; jj < 4; ++jj) { const f32x4 g = *((const f32x4*)gf + F.lane + 64 * jj); xo[64 * jj] = xo[64 * jj] * rstd * g; }
#ifdef TPROBE
        { const unsigned* c_ = (const unsigned*)(p.ws + WS_CTL); const float A_ = (float)c_[32] * 1e-4f, B_ = (float)c_[33] * 1e-4f;
          if (m >= 1024 && m < 2048) {
#pragma unroll
              for (int jj = 0; jj < 4; ++jj) xo[64 * jj] = xo[64 * jj] + B_; }
          if (m == 0 && F.lane == 0) { f32x4 v = xo[0]; v[0] += A_; xo[0] = v; } }
#endif
    }
}

#define XB_TMO      128
#define XB_XCNT(j)  (256  + 64 * (j))
#define XB_XSUB(j)  (1280 + 64 * (j))
#define XB_XGEN(j)  (2304 + 64 * (j))
#define XB_TOP      3328
#define XB_TOPGEN   3392
#define XB_SPIN_CAP (1u << 22)
constexpr int CW_BAR = 4096;
__device__ __forceinline__ unsigned xb_ld(unsigned* p)              { return __hip_atomic_load(p, __ATOMIC_RELAXED, __HIP_MEMORY_SCOPE_AGENT); }
__device__ __forceinline__ unsigned xb_add(unsigned* p, unsigned v) { return __hip_atomic_fetch_add(p, v, __ATOMIC_RELAXED, __HIP_MEMORY_SCOPE_AGENT); }
__device__ __forceinline__ unsigned xb_xcc_id() { return (unsigned)__builtin_amdgcn_s_getreg((3 << 11) | 20) & 0xFu; }
#define XB_SPIN(cond, bar) do { unsigned _sp = 0; while (cond) { __builtin_amdgcn_s_sleep(1); \
    if ((++_sp & 255u) == 0u) { if (xb_ld(&(bar)[XB_TMO])) break; if (_sp > XB_SPIN_CAP) { atomicAdd(&(bar)[XB_TMO], 1u); break; } } } } while (0)
__device__ __forceinline__ void xcd_barrier_complete(unsigned* bar, unsigned x, unsigned& nloc, unsigned& nx) {
    const unsigned G = gridDim.x;
    unsigned sum, cnt, mine, sp = 0u;
    for (;;) {
        sum = 0u; cnt = 0u; mine = 0u;
#pragma unroll
        for (unsigned j = 0; j < 16; ++j) { const unsigned c = xb_ld(&bar[XB_XCNT(j)]); sum += c; cnt += (c > 0u) ? 1u : 0u; mine = (j == x) ? c : mine; }
        if (sum == G) break;
        __builtin_amdgcn_s_sleep(1);
        if ((++sp & 255u) == 0u) { if (xb_ld(&bar[XB_TMO])) break; if (sp > XB_SPIN_CAP) { atomicAdd(&bar[XB_TMO], 1u); break; } }
    }
    nloc = mine > 0u ? mine : 1u; nx = cnt > 0u ? cnt : 1u;
}
__device__ __forceinline__ void gsync(volatile LAS unsigned* st) {
    unsigned* bar = (unsigned*)(make_params().ws + WS_CTL) + CW_BAR;
    asm volatile("s_waitcnt vmcnt(0)" ::: "memory");
    __syncthreads();
    if (threadIdx.x == 0) {
        const unsigned x = xb_xcc_id();
        __builtin_amdgcn_s_waitcnt(0);
        unsigned nloc = st[0], nx = st[1];
        if (nloc == 0u) { xcd_barrier_complete(bar, x, nloc, nx); st[0] = nloc; st[1] = nx; }
        const unsigned old = xb_add(&bar[XB_XSUB(x)], 1u);
        const unsigned gen = old / nloc;
        if (old + 1u == (gen + 1u) * nloc) {
            __builtin_amdgcn_fence(__ATOMIC_RELEASE, "agent");
            asm volatile("s_waitcnt vmcnt(0)" ::: "memory");
            const unsigned og = xb_add(&bar[XB_TOP], 1u);
            const unsigned tg = og / nx;
            if (og + 1u == (tg + 1u) * nx) xb_add(&bar[XB_TOPGEN], 1u);
            else XB_SPIN(xb_ld(&bar[XB_TOPGEN]) == tg, bar);
            __builtin_amdgcn_fence(__ATOMIC_ACQUIRE, "agent");
            xb_add(&bar[XB_XGEN(x)], 1u);
            asm volatile("s_waitcnt vmcnt(0)" ::: "memory");
        } else {
            XB_SPIN(xb_ld(&bar[XB_XGEN(x)]) == gen, bar);
            __builtin_amdgcn_fence(__ATOMIC_ACQUIRE, "agent");
            asm volatile("s_waitcnt vmcnt(0)" ::: "memory");
        }
    }
    __syncthreads();
}
#ifdef TPROBE
#define STAMP(id) do { if (blockIdx.x == 0 && threadIdx.x == 0) { LAS unsigned long long* ts_ = (LAS unsigned long long*)(F.lds + 131072 + 64); const unsigned long long now_ = __builtin_amdgcn_s_memrealtime(); \
    const unsigned long long dt_ = now_ - ts_[0]; ts_[0] = now_; if ((TA_MASK >> (id)) & 1) ts_[1] += dt_; if ((TB_MASK >> (id)) & 1) ts_[2] += dt_; } } while (0)
#else
#define STAMP(id) do { } while (0)
#endif
#ifndef PH_MASK
#define PH_MASK 0xFFFF
#endif
#ifndef REP_MASK
#define REP_MASK 0
#endif
#define NREP(k) ((((REP_MASK) >> (k)) & 1) ? 2 : 1)
constexpr int NCP = 1024, NDIFF_A = 0, NPB = 32;
__global__ void __launch_bounds__(512, 2) fwd_megakernel(KArgs kargs_unused) {
    extern __shared__ __attribute__((aligned(16))) unsigned char lds_raw[];
    cg::grid_group grid = cg::this_grid();
    Frame F; F.lds = (LAS unsigned char*)lds_raw; F.tid = threadIdx.x; F.lane = F.tid & 63; F.wave = __builtin_amdgcn_readfirstlane(F.tid >> 6); F.G = gridDim.x; F.bid = blockIdx.x;
    LAS int* qslot = (LAS int*)(F.lds + 131072);
    volatile LAS unsigned* bst = (volatile LAS unsigned*)(F.lds + 131072 + 32);
    { unsigned* bar0 = (unsigned*)(make_params().ws + WS_CTL) + CW_BAR;
      if (threadIdx.x == 0) { bst[0] = 0u; bst[1] = 0u; (void)xb_add(bar0 + XB_XCNT(xb_xcc_id()), 1u); } }
    __syncthreads();
#define PHASE_VARS() const Params p = make_params(); unsigned* ctl = (unsigned*)(p.ws + WS_CTL); float* rowss = (float*)(p.ws + WS_RP); \
    bf16_t* XB = (bf16_t*)(p.ws + WS_XB); bf16_t* Z = (bf16_t*)(p.ws + WS_Z); bf16_t* MIX = (bf16_t*)(p.ws + WS_MIX); \
    bf16_t* wb = (bf16_t*)(p.ws + WS_W); int bid_ = F.bid, G_ = F.G; asm volatile("" : "+s"(bid_), "+s"(G_)); (void)bid_; (void)G_; (void)ctl; (void)rowss; (void)XB; (void)Z; (void)MIX; (void)wb

#ifdef TPROBE
    if (blockIdx.x == 0 && threadIdx.x == 0) { LAS unsigned long long* ts_ = (LAS unsigned long long*)(F.lds + 131072 + 64); ts_[0] = __builtin_amdgcn_s_memrealtime(); ts_[1] = 0; ts_[2] = 0; }
#endif
    if (PH_MASK & 1) { const Params p = make_params(); prologue(F, p); }
    grid.sync();
    STAMP(0);

    for (int l = 0; l < NL; ++l) {
        for (int rep = 0; rep < NREP(1); ++rep) {
        if (PH_MASK & 2) {
            PHASE_VARS();
            pg8::StaticOrder S; S.init(MTOK, INW, G_, bid_);
            pg8::gemm_phase(F.lds, pg8::Gemm{XB, wb + WO_IN, MTOK, INW, DM}, S, pg8::EpiScaleBf16{Z, ZP, rowss + (size_t)(3 * l) * MTOK * 16, (bf16_t*)(p.ws + WS_ZC), 1024, 8, (bf16_t*)(p.ws + WS_KD2)});
        }
        gsync(bst); STAMP(1);
        }
        for (int rep = 0; rep < NREP(2); ++rep) {
        for (int u = F.bid; u < 768; u += F.G) {
            PHASE_VARS();
            if (u < 512) { if (PH_MASK & 4) prep_unit(F, p, l, wb, u); } else if (PH_MASK & 8) win_unit(F, p, l, u - 512);
        }
        gsync(bst); STAMP(2);
        }
        for (int rep = 0; rep < NREP(3); ++rep) {
        {
            PHASE_VARS();
            const int ntot = NCP + NDIFF_A;
            for (;;) {
                __syncthreads();
                if (F.tid == 0) *qslot = (int)atomicAdd(ctl + CW_Q + 16 * l + 4 * rep, 1u);
                __syncthreads();
                const int u = *qslot;
                if (u >= ntot) break;
                if (u < NCP) { if (PH_MASK & 16) { REFRAME(F); if (u >= NCP / 2) chunkprep_wave<1>(F, p, u * 8 + F.wave); else chunkprep_wave<0>(F, p, u * 8 + F.wave); } }
                else if (PH_MASK & 32) diff_unit(F, p, l, u - NCP);
            }
        }
        gsync(bst); STAMP(11);
        }
        for (int rep = 0; rep < NREP(4); ++rep) {
        {
            PHASE_VARS();
            const int ncva = (l + 1 < NL) ? CV_A / 8 : 0, ncvb = (l > 0) ? CV_B / 8 : 0, ncv = NPB + ncva + ncvb, ntot = ncv + 256;
            unsigned* pbdone = ctl + 3072 + (l * 2 + rep) * 16;
            unsigned* gq = ctl + CW_Q + 16 * l + 8 + 4 * rep; unsigned* dq = ctl + 2048 + (l * 2 + rep) * 16;
            const int myx = (int)(xb_xcc_id() & 7u);
            int stage = 0, pend = -1, xi = 0;
            for (;;) {
                __syncthreads();
                if (F.tid == 0) {
                    int code = -1;
                    if (stage == 0) { const int g = (int)atomicAdd(gq, 1u); if (g < NPB) code = g; else { pend = g; stage = 1; } }
                    if (stage == 1) {
                        while (xi < 8) { const int x = (myx + xi) & 7; const int tk = (int)atomicAdd(dq + x, 1u); if (tk < 64) { code = -2 - ((4 * x + (tk >> 4)) * 16 + (tk & 15)); break; } ++xi; }
                        if (xi >= 8) stage = 2;
                    }
                    if (stage == 2 && code == -1) { int g = pend; pend = -1; if (g < 0) g = (int)atomicAdd(gq, 1u); if (g < ntot) code = g; }
                    *qslot = code;
                }
                __syncthreads();
                const int u = *qslot;
                if (u == -1) break;
                if (u <= -2) { if (PH_MASK & 32) diff_unit(F, p, l, -2 - u); }
                else if (u < NPB) { if (PH_MASK & 16) { REFRAME(F); phaseb_unit(F, p, u); }
                    __threadfence(); __syncthreads();
                    if (F.tid == 0) __hip_atomic_fetch_add(pbdone, 1u, __ATOMIC_RELEASE, __HIP_MEMORY_SCOPE_AGENT); }
                else if (u >= ncv) {
                    if (F.tid == 0) { while (__hip_atomic_load(pbdone, __ATOMIC_RELAXED, __HIP_MEMORY_SCOPE_AGENT) < (unsigned)NPB) __builtin_amdgcn_s_sleep(8); }
                    __syncthreads(); __builtin_amdgcn_fence(__ATOMIC_ACQUIRE, "agent");
                    if (PH_MASK & 64) post_unit(F, p, l, u - ncv); }
                else if (u < NPB + ncva) { REFRAME(F); cvt_item_a(p, l + 1, wb, (LAS float*)(F.lds + F.wave * 16384), (u - NPB) * 8 + F.wave, F.lane); }
                else { REFRAME(F); cvt_item_b(p, l, wb, (LAS float*)(F.lds + F.wave * 16384), (u - NPB - ncva) * 8 + F.wave, F.lane); }
            }
        }
        gsync(bst); STAMP(3);
        }
        if (PH_MASK & 128) {
            PHASE_VARS();
            pg8::StaticOrder S; S.init(MTOK, DM, G_, bid_);
            pg8::gemm_phase(F.lds, pg8::Gemm{MIX, wb + WO_OUT, MTOK, DM, DM}, S, pg8::EpiResid{p.out, XB, rowss + (size_t)(3 * l + 1) * MTOK * 16});
        }
        gsync(bst); STAMP(5);
        for (int rep = 0; rep < NREP(6); ++rep) {
        if (PH_MASK & 256) {
            PHASE_VARS();
            pg8::StaticOrder S; S.init(MTOK, XW, G_, bid_);
            if (F.bid < 128) {
                pg8::gemm_phase(F.lds, pg8::Gemm{XB, wb + WO_Q, MTOK, XW, DM}, S, pg8::EpiScaleBf16{(bf16_t*)(p.ws + WS_Q), XW, rowss + (size_t)(3 * l + 1) * MTOK * 16, nullptr, 0, 1 << 30, nullptr});
            } else {
                pg8::StaticOrder S2; S2.init(MMEM, 1024, 128, F.bid - 128);
                pg8::gemm_phase(F.lds, pg8::Gemm{(const bf16_t*)(p.ws + WS_MEMN), wb + WO_KV, MMEM, 1024, DM}, S2, pg8::EpiScaleBf16{(bf16_t*)(p.ws + WS_KV), 1024, nullptr, nullptr, 0, 1 << 30, nullptr});
            }
        }
        gsync(bst); STAMP(6);
        }
        for (int rep = 0; rep < NREP(7); ++rep) {
        if (PH_MASK & 512) for (int u = F.bid; u < 256; u += F.G) { PHASE_VARS(); cross_unit(F, p, u); }
        gsync(bst); STAMP(7);
        }
        if (PH_MASK & 1024) {
            PHASE_VARS();
            pg8::StaticOrder S; S.init(MTOK, DM, G_, bid_);
            pg8::gemm_phase(F.lds, pg8::Gemm{(const bf16_t*)(p.ws + WS_O), wb + WO_O, MTOK, DM, XW}, S, pg8::EpiResid{p.out, XB, rowss + (size_t)(3 * l + 2) * MTOK * 16});
        }
        gsync(bst); STAMP(8);
        for (int rep = 0; rep < NREP(9); ++rep) {
        if (PH_MASK & 2048) {
            PHASE_VARS();
            pg8::StaticOrder S; S.init(MTOK, 2 * DFF, G_, bid_);
            pg8::gemm_phase(F.lds, pg8::Gemm{XB, wb + WO_GU, MTOK, 2 * DFF, DM}, S, pg8::EpiSwiGLU{(bf16_t*)(p.ws + WS_G), rowss + (size_t)(3 * l + 2) * MTOK * 16});
        }
        gsync(bst); STAMP(9);
        }
        if (PH_MASK & 4096) {
            PHASE_VARS();
            pg8::StaticOrder S; S.init(MTOK, DM, G_, bid_);
            pg8::gemm_phase(F.lds, pg8::Gemm{(const bf16_t*)(p.ws + WS_G), wb + WO_DOWN, MTOK, DM, DFF}, S, pg8::EpiResid{p.out, XB, rowss + (size_t)(3 * l + 3) * MTOK * 16});
        }

#ifdef TPROBE
        STAMP(10);
        { const Params p = make_params(); if (l == NL - 1 && blockIdx.x == 0 && threadIdx.x == 0) { LAS unsigned long long* ts_ = (LAS unsigned long long*)(F.lds + 131072 + 64); unsigned* c_ = (unsigned*)(p.ws + WS_CTL); c_[32] = (unsigned)ts_[1]; c_[33] = (unsigned)ts_[2]; } }
#endif
        gsync(bst);
    }
    if (PH_MASK & 8192) { const Params p = make_params(); final_norm(F, p); }
}

extern "C" void kernel_launch(void* const* d_in, const int* in_sizes, int n_in, void* d_out, int out_size, void* d_ws, size_t ws_size, hipStream_t stream) {
    static int grid = 0;
    if (grid == 0) {
        if (n_in != 31 || out_size != MTOK * DM || ws_size < WS_END) { fprintf(stderr, "kernel_launch: unexpected problem shape (n_in %d out %d ws %zu)\n", n_in, out_size, ws_size); grid = -1; return; }
        int dev = 0, cus = 0, per_cu = 0;
        hipGetDevice(&dev);
        hipDeviceGetAttribute(&cus, hipDeviceAttributeMultiprocessorCount, dev);
        hipFuncSetAttribute((const void*)fwd_megakernel, hipFuncAttributeMaxDynamicSharedMemorySize, LDS_BYTES);
        hipOccupancyMaxActiveBlocksPerMultiprocessor(&per_cu, (const void*)fwd_megakernel, 512, LDS_BYTES);
        if (per_cu < 1) { fprintf(stderr, "kernel_launch: occupancy query returned %d\n", per_cu); per_cu = 1; }
        (void)hipGetLastError();
        grid = cus * per_cu;
    }
    if (grid < 0) return;
    hipMemsetAsync((char*)d_ws + WS_CTL, 0, CTL_ZERO_BYTES, stream);
    KArgs p{};
    for (int i = 0; i < 31; ++i) p.in[i] = (const float*)d_in[i];
    p.out = (float*)d_out; p.ws = (unsigned char*)d_ws;
    void* args[] = {&p};
    hipError_t e = hipLaunchCooperativeKernel((const void*)fwd_megakernel, dim3(grid), dim3(512), args, LDS_BYTES, stream);
    if (e != hipSuccess) fprintf(stderr, "cooperative launch failed: %s (grid %d)\n", hipGetErrorString(e), grid);
}
```

```cpp
#include <hip/hip_runtime.h>
#include <hip/hip_cooperative_groups.h>
#include <cstdio>
#include <cstdint>
namespace cg = cooperative_groups;

#define LAS __attribute__((address_space(3)))
#define GAS __attribute__((address_space(1)))
typedef unsigned short bf16_t;
typedef short bf16x8 __attribute__((ext_vector_type(8)));
typedef short s16x4 __attribute__((ext_vector_type(4)));
typedef short v4i16_t __attribute__((ext_vector_type(4)));
typedef float f32x4 __attribute__((ext_vector_type(4)));
typedef float f32x2 __attribute__((ext_vector_type(2)));
typedef float f32x16 __attribute__((ext_vector_type(16)));
typedef unsigned u32x4 __attribute__((ext_vector_type(4)));
typedef unsigned u32x2 __attribute__((ext_vector_type(2)));
typedef __bf16 bf16x2_t __attribute__((ext_vector_type(2)));

constexpr int DM = 1024, NB = 8, SEQ = 2048, NL = 4, MTOK = NB * SEQ;
constexpr int NMEM = 256, MMEM = NB * NMEM;
constexpr int INW = 3072, DFF = 2816, XW = 512;
constexpr float LOG2E = 1.4426950408889634f;

constexpr size_t MiB = 1u << 20;
constexpr size_t WS_CTL = 0, CTL_ZERO_BYTES = 1 * MiB;
constexpr size_t WS_W = 1 * MiB;
constexpr size_t WS_Z = 30 * MiB;
constexpr size_t WS_ZC = 94 * MiB;
constexpr size_t WS_XB = 126 * MiB;
constexpr size_t WS_FQR = 94 * MiB, WS_FWY = 126 * MiB, WS_FNA = 158 * MiB, WS_FKH = 174 * MiB, WS_FP15 = 190 * MiB;
constexpr size_t WS_MIX = 192 * MiB;
constexpr size_t WS_OM = 224 * MiB, WS_KA = 240 * MiB, WS_KD = 256 * MiB, WS_KK = 272 * MiB, WS_V = 280 * MiB, WS_R = 288 * MiB;
constexpr size_t WS_GATE = 296 * MiB, WS_Y = 304 * MiB, WS_BON = 320 * MiB, WS_KV = 321 * MiB, WS_MEMN = 325 * MiB;
constexpr size_t WS_RP = 329 * MiB;
constexpr size_t WS_END = 342 * MiB;
constexpr size_t WS_Q = WS_Z, WS_O = WS_Z + 16 * MiB, WS_G = WS_Z;
constexpr int ZP = 1024;
constexpr size_t WS_KD2 = WS_Z + 32 * MiB, WS_VD2 = WS_Z + 48 * MiB;
constexpr size_t WO_IN = 0, WO_OUT = 3145728, WO_Q = 4194304, WO_KV = 4718592, WO_O = 5767168, WO_GU = 6291456, WO_DOWN = 12058624;
constexpr size_t WO_WUP = 14942208, WO_AUP = 14974976, WO_GUP = 15007744;
constexpr int CW_Q = 64;

constexpr int LDS_BYTES = 135168;

__device__ __forceinline__ float bf2f(unsigned b) { return __uint_as_float(b << 16); }
__device__ __forceinline__ unsigned pk2(float lo, float hi) { f32x2 v = {lo, hi}; bf16x2_t b = __builtin_convertvector(v, bf16x2_t); return __builtin_bit_cast(unsigned, b); }
__device__ __forceinline__ float bflo(unsigned u) { return __uint_as_float(u << 16); }
__device__ __forceinline__ float bfhi(unsigned u) { return __uint_as_float(u & 0xffff0000u); }
__device__ __forceinline__ float wave_sum(float v) {
#pragma unroll
    for (int o = 1; o < 64; o <<= 1) v += __shfl_xor(v, o);
    return v;
}
__device__ __forceinline__ float xhalf(float v) {
    return __shfl_xor(v, 32);
}
__device__ __forceinline__ float row_rstd(const float* rp, int row) {
    const f32x4* q = (const f32x4*)(rp + (size_t)row * 16); const f32x4 a = q[0], b = q[1], c = q[2], d = q[3];
    const float s = (((a[0] + a[1]) + (a[2] + a[3])) + ((b[0] + b[1]) + (b[2] + b[3]))) + (((c[0] + c[1]) + (c[2] + c[3])) + ((d[0] + d[1]) + (d[2] + d[3])));
    return rsqrtf(s * (1.f / 1024.f) + 1e-6f);
}
__device__ __forceinline__ float sigmoidf_(float x) { return 1.f / (1.f + __expf(-x)); }

__device__ __forceinline__ int hw_lane() { int l = (int)__builtin_amdgcn_mbcnt_hi(~0u, __builtin_amdgcn_mbcnt_lo(~0u, 0u)); asm volatile("" : "+v"(l)); return l; }
namespace pg8 {
constexpr int BM = 256, BK = 64, HALF = 128, HTB = HALF * BK * 2, NXCD = 8, WGM = 8;
__host__ __device__ __forceinline__ int lds_byte(int r, int c) { const int st = (r >> 4) * 2 + (c >> 5), rr = r & 15, cc = c & 31, ob = rr * 64 + cc * 2; return st * 1024 + (ob ^ (((ob >> 9) & 1) << 5)); }
__host__ __device__ __forceinline__ void stage_rc(int b, int& R, int& C) { const int st = b / 1024, sb = b % 1024, swz = sb ^ (((sb >> 9) & 1) << 5); R = (st >> 1) * 16 + swz / 64; C = (st & 1) * 32 + (swz % 64) / 2; }
__host__ __device__ __forceinline__ int perm32(int rho) { const int n = rho >> 4, i = rho & 15; return 8 * (i >> 2) + 4 * n + (i & 3); }
struct Unit { int pm, pn; };
struct Gemm { const bf16_t* A; const bf16_t* Bt; int M, N, K; };
struct StaticOrder {
    int nM, nN, nwg, G, c;
    __device__ void init(int M, int N, int G_, int c_) { nM = M / BM; nN = N / BM; nwg = nM * nN; G = G_; c = c_; }
    __device__ bool next(int i, Unit& u) const {
        const long L = (long)i * G + c; if (L >= nwg) return false;
        int wgid = (int)L; { const int q = nwg / NXCD, r = nwg % NXCD, xcd = wgid % NXCD, off = wgid / NXCD; wgid = (xcd < r ? xcd * (q + 1) : r * (q + 1) + (xcd - r) * q) + off; }
        const int nig = WGM * nN, gid = wgid / nig, fm = gid * WGM, gsz = (nM - fm) < WGM ? (nM - fm) : WGM;
        u.pm = fm + ((wgid % nig) % gsz); u.pn = (wgid % nig) / gsz; return true;
    }
};
template <class Epi>
__device__ __forceinline__ void gemm_phase(LAS unsigned char* lds, const Gemm g, const StaticOrder& S, const Epi& E) {
    int tid_ = threadIdx.x; asm volatile("" : "+v"(tid_));
    const int tid = tid_, wid = __builtin_amdgcn_readfirstlane(tid >> 6), lane = tid & 63, wr = wid >> 2, wc = wid & 3, fr = lane & 15, fq = lane >> 4;
    const int K = g.K, nt = K / BK;
    unsigned voffA[2], voffB[2];
#pragma unroll
    for (int i = 0; i < 2; ++i) { int R, C; stage_rc(tid * 16 + i * 8192, R, C); const int Rb = (R & ~31) + perm32(R & 31);
        voffA[i] = (unsigned)(R * K + C) * 2u; voffB[i] = (unsigned)(Rb * K + C) * 2u; }
    const size_t kstep = (size_t)(BK * 2);
    const size_t hstep = (size_t)HALF * K * 2;
    const size_t tstep = 2 * hstep;
    const unsigned ldsw = (unsigned)wid * 1024u;
    const int aoff = lds_byte(wr * 64 + fr, fq * 8), boff = lds_byte(wc * 32 + fr, fq * 8);
#define PG8_SA(b, h) (((b) * 2 + (h)) * HTB)
#define PG8_SB(b, h) ((4 + (b) * 2 + (h)) * HTB)
#define PG8_STAGE(bufoff, gbase, voff) do { _Pragma("unroll") for (int _i = 0; _i < 2; ++_i) \
        __builtin_amdgcn_global_load_lds((const unsigned*)((const char*)(gbase) + (voff)[_i]), (LAS unsigned*)(lds + (bufoff) + ldsw + _i * 8192), 16, 0, 0); } while (0)
#define PG8_LDA(dst, b, h) do { _Pragma("unroll") for (int m = 0; m < 4; ++m) _Pragma("unroll") for (int k = 0; k < 2; ++k) dst[m][k] = *(const LAS bf16x8*)(lds + PG8_SA(b, h) + aoff + m * 2048 + k * 1024); } while (0)
#define PG8_LDB(dst, b, h) do { _Pragma("unroll") for (int n = 0; n < 2; ++n) _Pragma("unroll") for (int k = 0; k < 2; ++k) dst[n][k] = *(const LAS bf16x8*)(lds + PG8_SB(b, h) + boff + n * 2048 + k * 1024); } while (0)
#define PG8_MMA(ai, bj, At, Bt) do { __builtin_amdgcn_s_setprio(1); _Pragma("unroll") for (int m = 0; m < 4; ++m) _Pragma("unroll") for (int n = 0; n < 2; ++n) _Pragma("unroll") for (int k = 0; k < 2; ++k) \
        acc[ai][bj][m][n] = __builtin_amdgcn_mfma_f32_16x16x32_bf16(Bt[n][k], At[m][k], acc[ai][bj][m][n], 0, 0, 0); __builtin_amdgcn_s_setprio(0); } while (0)
#define PG8_WAIT_V(n) asm volatile("s_waitcnt vmcnt(" #n ")" ::: "memory")
#define PG8_WAIT_L(n) asm volatile("s_waitcnt lgkmcnt(" #n ")" ::: "memory")
#define PG8_BAR __builtin_amdgcn_s_barrier()
#define PG8_SCHED __builtin_amdgcn_sched_barrier(0)
    Unit cur, nxt; int ui = 0;
    if (!S.next(0, cur)) return;
    f32x4 acc[2][2][4][2];
#pragma unroll
    for (int a = 0; a < 2; ++a)
#pragma unroll
        for (int b = 0; b < 2; ++b)
#pragma unroll
            for (int m = 0; m < 4; ++m)
#pragma unroll
                for (int n = 0; n < 2; ++n) acc[a][b][m][n] = (f32x4){0.f, 0.f, 0.f, 0.f};
    bf16x8 At[4][2], B0[2][2], B1[2][2];
    const char* cA = (const char*)g.A + (size_t)cur.pm * tstep; const char* cB = (const char*)g.Bt + (size_t)cur.pn * tstep;
    {
        PG8_STAGE(PG8_SB(0, 0), cB, voffB); PG8_STAGE(PG8_SB(0, 1), cB + hstep, voffB); PG8_STAGE(PG8_SA(0, 0), cA, voffA); PG8_STAGE(PG8_SA(0, 1), cA + hstep, voffA);
        if (wr == 1) PG8_BAR;
        PG8_WAIT_V(2); PG8_BAR;
        PG8_STAGE(PG8_SB(1, 0), cB + kstep, voffB); PG8_STAGE(PG8_SA(1, 0), cA + kstep, voffA); PG8_STAGE(PG8_SB(1, 1), cB + hstep + kstep, voffB);
        PG8_WAIT_V(6); PG8_BAR;
    }
    for (;;) {
        const bool has_next = S.next(ui + 1, nxt);
        const char* nA = has_next ? (const char*)g.A + (size_t)nxt.pm * tstep : cA; const char* nB = has_next ? (const char*)g.Bt + (size_t)nxt.pn * tstep : cB;
        for (int t = 0; t < nt; t += 2) {
            const bool last = (t == nt - 2);
            const char* a1 = cA + (size_t)(t + 1) * kstep;
            const char* a2 = last ? nA : cA + (size_t)(t + 2) * kstep; const char* b2 = last ? nB : cB + (size_t)(t + 2) * kstep;
            const char* a3 = a2 + kstep; const char* b3 = b2 + kstep;
            PG8_LDB(B0, 0, 0); PG8_LDB(B1, 0, 1); PG8_SCHED; PG8_LDA(At, 0, 0); PG8_STAGE(PG8_SA(1, 1), a1 + hstep, voffA);
            PG8_WAIT_V(8); PG8_WAIT_L(0); PG8_BAR; PG8_MMA(0, 0, At, B0); PG8_MMA(0, 1, At, B1); PG8_BAR; PG8_SCHED;
            PG8_LDA(At, 0, 1); PG8_STAGE(PG8_SB(0, 0), b2, voffB); PG8_STAGE(PG8_SB(0, 1), b2 + hstep, voffB); PG8_STAGE(PG8_SA(0, 0), a2, voffA);
            PG8_WAIT_V(8); PG8_WAIT_L(0); PG8_BAR; PG8_MMA(1, 0, At, B0); PG8_MMA(1, 1, At, B1); PG8_BAR; PG8_SCHED;
            PG8_LDB(B0, 1, 0); PG8_LDB(B1, 1, 1); PG8_SCHED; PG8_LDA(At, 1, 0); PG8_STAGE(PG8_SA(0, 1), a2 + hstep, voffA);
            PG8_WAIT_V(8); PG8_WAIT_L(0); PG8_BAR; PG8_MMA(0, 0, At, B0); PG8_MMA(0, 1, At, B1); PG8_BAR; PG8_SCHED;
            PG8_LDA(At, 1, 1); PG8_STAGE(PG8_SB(1, 0), b3, voffB); PG8_STAGE(PG8_SB(1, 1), b3 + hstep, voffB); PG8_STAGE(PG8_SA(1, 0), a3, voffA);
            PG8_WAIT_V(8); PG8_WAIT_L(0); PG8_BAR; PG8_MMA(1, 0, At, B0); PG8_MMA(1, 1, At, B1); PG8_BAR; PG8_SCHED;
        }
        if (wr == 0) PG8_BAR;
        E(acc, cur, wr, wc, fr, fq);
        if (!has_next) break;
#pragma unroll
        for (int a = 0; a < 2; ++a)
#pragma unroll
            for (int b = 0; b < 2; ++b)
#pragma unroll
                for (int m = 0; m < 4; ++m)
#pragma unroll
                    for (int n = 0; n < 2; ++n) acc[a][b][m][n] = (f32x4){0.f, 0.f, 0.f, 0.f};
        cur = nxt; cA = nA; cB = nB; ++ui;
        if (wr == 1) PG8_BAR;
    }
    PG8_WAIT_V(0);
    PG8_BAR;
#undef PG8_SA
#undef PG8_SB
#undef PG8_STAGE
#undef PG8_LDA
#undef PG8_LDB
#undef PG8_MMA
#undef PG8_WAIT_V
#undef PG8_WAIT_L
#undef PG8_BAR
#undef PG8_SCHED
}

struct EpiScaleBf16 {
    bf16_t* O; int ldc; const float* rowss; bf16_t* O2; int ldc2; int split_tile; bf16_t* KD2;
    __device__ __forceinline__ void operator()(const f32x4 (&acc)[2][2][4][2], const Unit& u, int wr, int wc, int fr, int fq) const {
        const bool hi = u.pn >= split_tile, mid = (split_tile == 8) && u.pn >= 4 && u.pn < 8;
        const int row0 = u.pm * BM + wr * 64 + fr, col0 = (hi ? u.pn - split_tile : u.pn) * BM + wc * 32 + 8 * fq;
        bf16_t* const Ob = hi ? O2 : O; const int ld = hi ? ldc2 : ldc;
#pragma unroll
        for (int ai = 0; ai < 2; ++ai)
#pragma unroll
            for (int m = 0; m < 4; ++m) { const int row = row0 + ai * HALF + m * 16;
                const float sc = rowss ? row_rstd(rowss, row) : 1.f;
                bf16_t* rowp = Ob + (size_t)row * ld + col0;
#pragma unroll
                for (int bj = 0; bj < 2; ++bj) { const f32x4 v0 = acc[ai][bj][m][0] * sc, v1 = acc[ai][bj][m][1] * sc;
                    u32x4 w; w.x = pk2(v0[0], v0[1]); w.y = pk2(v0[2], v0[3]); w.z = pk2(v1[0], v1[1]); w.w = pk2(v1[2], v1[3]);
                    bf16_t* dst = rowp + bj * HALF;
                    if (mid) dst = KD2 + (u.pn >= 6 ? (size_t)8388608 : (size_t)0) + ((size_t)(((row >> 11) * 4 + 2 * (u.pn & 1) + bj) * 2048 + (row & 2047))) * 128 + wc * 32 + 8 * fq;
                    *(u32x4*)dst = w; } }
    }
};
struct EpiSwiGLU {
    bf16_t* O; const float* rowss;
    __device__ __forceinline__ void operator()(const f32x4 (&acc)[2][2][4][2], const Unit& u, int wr, int wc, int fr, int fq) const {
        const int row0 = u.pm * BM + wr * 64 + fr, col0 = u.pn * HALF + wc * 32 + 8 * fq;
#pragma unroll
        for (int ai = 0; ai < 2; ++ai)
#pragma unroll
            for (int m = 0; m < 4; ++m) { const int row = row0 + ai * HALF + m * 16;
                const float sc = row_rstd(rowss, row);
                float h[8];
#pragma unroll
                for (int n = 0; n < 2; ++n)
#pragma unroll
                    for (int j = 0; j < 4; ++j) { const float gt = acc[ai][0][m][n][j] * sc, up = acc[ai][1][m][n][j] * sc; h[n * 4 + j] = gt / (1.f + __expf(-gt)) * up; }
                u32x4 w; w.x = pk2(h[0], h[1]); w.y = pk2(h[2], h[3]); w.z = pk2(h[4], h[5]); w.w = pk2(h[6], h[7]);
                *(u32x4*)(O + (size_t)row * DFF + col0) = w; }
    }
};
struct EpiResid {
    float* X; bf16_t* XB; float* rowss_next;
    __device__ __forceinline__ void operator()(const f32x4 (&acc)[2][2][4][2], const Unit& u, int wr, int wc, int fr, int fq) const {
        const int row0 = u.pm * BM + wr * 64 + fr, col0 = u.pn * BM + wc * 32 + 8 * fq;
#pragma unroll
        for (int ai = 0; ai < 2; ++ai)
#pragma unroll
            for (int m = 0; m < 4; ++m) { const int row = row0 + ai * HALF + m * 16; float ss = 0.f;
                float* xp = X + (size_t)row * DM + col0; bf16_t* bp = XB + (size_t)row * DM + col0;
#pragma unroll
                for (int bj = 0; bj < 2; ++bj) {
                    f32x4 x0 = *(f32x4*)(xp + bj * HALF), x1 = *(f32x4*)(xp + bj * HALF + 4);
                    x0 = x0 + acc[ai][bj][m][0]; x1 = x1 + acc[ai][bj][m][1];
                    *(f32x4*)(xp + bj * HALF) = x0; *(f32x4*)(xp + bj * HALF + 4) = x1;
                    ss += (x0[0] * x0[0] + x0[1] * x0[1]) + (x0[2] * x0[2] + x0[3] * x0[3]) + (x1[0] * x1[0] + x1[1] * x1[1]) + (x1[2] * x1[2] + x1[3] * x1[3]);
                    u32x4 w; w.x = pk2(x0[0], x0[1]); w.y = pk2(x0[2], x0[3]); w.z = pk2(x1[0], x1[1]); w.w = pk2(x1[2], x1[3]);
                    *(u32x4*)(bp + bj * HALF) = w; }
                ss += __shfl_xor(ss, 16); ss += __shfl_xor(ss, 32);
                if (fq == 0) rowss_next[(size_t)row * 16 + u.pn * 4 + wc] = ss; }
    }
};
}

struct KArgs { const float* in[31]; float* out; unsigned char* ws; };
#define CAS __attribute__((address_space(4)))
struct InProxy { const CAS unsigned long long* k; __device__ __forceinline__ const float* operator[](int i) const { return (const float*)k[i]; } };
struct Params { InProxy in; float* out; unsigned char* ws; };
__device__ __forceinline__ Params make_params() {
    unsigned long long kv = (unsigned long long)__builtin_amdgcn_kernarg_segment_ptr();
    asm volatile("" : "+s"(kv));
    const CAS unsigned long long* k = (const CAS unsigned long long*)kv;
    Params p; p.in.k = k; p.out = (float*)k[31]; p.ws = (unsigned char*)k[32]; return p;
}

struct Frame {
    LAS unsigned char* lds;
    int tid, lane, wave, G, bid;
};

#define REFRAME(F) do { int _t = threadIdx.x; asm volatile("" : "+v"(_t)); (F).tid = _t; (F).lane = _t & 63; (F).wave = __builtin_amdgcn_readfirstlane(_t >> 6); } while (0)
__device__ __forceinline__ void cvt_item(const float* W_, int K, int ldn, int nblk, bf16_t* WT_, const float* gain_, bool perm_gu, LAS float* scr, int item, int lane) {
    const GAS float* W = (const GAS float*)W_; const GAS float* gain = (const GAS float*)gain_; GAS bf16_t* WT = (GAS bf16_t*)WT_;
    const int kb = item / nblk, nb = item % nblk, k0 = 64 * kb, n0d = 32 * nb;
    const int n0s = perm_gu ? (((n0d & 255) >> 7) * DFF + (n0d >> 8) * 128 + (n0d & 127)) : n0d;
    float v[32];
#pragma unroll
    for (int i = 0; i < 32; ++i) v[i] = W[(size_t)(k0 + 2 * i + (lane >> 5)) * ldn + n0s + (lane & 31)];
    if (gain_) {
#pragma unroll
        for (int i = 0; i < 32; ++i) v[i] *= gain[k0 + 2 * i + (lane >> 5)];
    }
#pragma unroll
    for (int i = 0; i < 32; ++i) scr[(2 * i + (lane >> 5)) * 33 + (lane & 31)] = v[i];
    asm volatile("s_waitcnt lgkmcnt(0)" ::: "memory");
    const int c = lane & 7;
#pragma unroll
    for (int j = 0; j < 4; ++j) { const int n = (lane >> 3) + 8 * j; const LAS float* sp = scr + (8 * c) * 33 + n;
        u32x4 o; o.x = pk2(sp[0 * 33], sp[1 * 33]); o.y = pk2(sp[2 * 33], sp[3 * 33]); o.z = pk2(sp[4 * 33], sp[5 * 33]); o.w = pk2(sp[6 * 33], sp[7 * 33]);
        *(GAS u32x4*)(WT + (size_t)(n0d + n) * K + k0 + 8 * c) = o; }
    asm volatile("s_waitcnt lgkmcnt(0)" ::: "memory");
}
constexpr int CV_IN = 1536, CV_OUT = 512, CV_Q = 256, CV_KV = 512, CV_O = 256, CV_GU = 2816, CV_DOWN = 1408, CV_L = 8;
constexpr int CV_TOTAL = CV_IN + CV_OUT + CV_Q + CV_KV + CV_O + CV_GU + CV_DOWN + 2 * CV_L + 2 * CV_L + 16;

static_assert(CV_TOTAL % 8 == 0, "conversion items per layer");
constexpr int CV_A = CV_IN + 2 * CV_L + 2 * CV_L + 16, CV_B = CV_KV + CV_OUT + CV_Q + CV_O + CV_GU + CV_DOWN;
static_assert(CV_A % 8 == 0 && CV_B % 8 == 0 && CV_A + CV_B == CV_TOTAL, "conversion lists");
__device__ __forceinline__ void cvt_item_a(const Params& p, int l, bf16_t* wb, LAS float* scr, int it, int lane) {
    int r = it;
    if (r < CV_IN) { cvt_item(p.in[3] + (size_t)l * DM * INW, DM, INW, INW / 32, wb + WO_IN, p.in[2] + l * DM, false, scr, r, lane); return; } r -= CV_IN;
    if (r < 2 * CV_L) { const int d = r / CV_L; cvt_item(p.in[12] + ((size_t)l * 2 + d) * 64 * 256, 64, 256, 8, wb + WO_WUP + d * 256 * 64, nullptr, false, scr, r % CV_L, lane); return; } r -= 2 * CV_L;
    if (r < 2 * CV_L) { const int d = r / CV_L; cvt_item(p.in[14] + ((size_t)l * 2 + d) * 64 * 256, 64, 256, 8, wb + WO_AUP + d * 256 * 64, nullptr, false, scr, r % CV_L, lane); return; } r -= 2 * CV_L;
    cvt_item(p.in[15] + (size_t)l * 128 * 256, 128, 256, 8, wb + WO_GUP, nullptr, false, scr, r, lane);
}
__device__ __forceinline__ void cvt_item_b(const Params& p, int l, bf16_t* wb, LAS float* scr, int it, int lane) {
    int r = it;
    if (r < CV_KV) { cvt_item(p.in[25] + (size_t)l * DM * 1024, DM, 1024, 32, wb + WO_KV, nullptr, false, scr, r, lane); return; } r -= CV_KV;
    if (r < CV_OUT) { cvt_item(p.in[21] + (size_t)l * DM * DM, DM, DM, DM / 32, wb + WO_OUT, nullptr, false, scr, r, lane); return; } r -= CV_OUT;
    if (r < CV_Q) { cvt_item(p.in[24] + (size_t)l * DM * XW, DM, XW, XW / 32, wb + WO_Q, p.in[22] + l * DM, false, scr, r, lane); return; } r -= CV_Q;
    if (r < CV_O) { cvt_item(p.in[26] + (size_t)l * XW * DM, XW, DM, 32, wb + WO_O, nullptr, false, scr, r, lane); return; } r -= CV_O;
    if (r < CV_GU) { cvt_item(p.in[28] + (size_t)l * DM * 2 * DFF, DM, 2 * DFF, 2 * DFF / 32, wb + WO_GU, p.in[27] + l * DM, true, scr, r, lane); return; } r -= CV_GU;
    cvt_item(p.in[29] + (size_t)l * DFF * DM, DFF, DM, 32, wb + WO_DOWN, nullptr, false, scr, r, lane);
}

__device__ __forceinline__ s16x4 vtr(const LAS unsigned char* p) { return __builtin_bit_cast(s16x4, __builtin_amdgcn_ds_read_tr16_b64_v4i16((LAS v4i16_t*)p)); }
__device__ __forceinline__ int crow(int r, int hi) { return (r & 3) + 8 * (r >> 2) + 4 * hi; }

template <int W> __device__ __forceinline__ void tile_load(u32x4 (&r)[W / 64], const bf16_t* g, int pitch, int tid) {
#pragma unroll
    for (int i = 0; i < W / 64; ++i) { const int id = tid + i * 512, row = id / (W / 8), ch = id % (W / 8); r[i] = *(const GAS u32x4*)((const GAS bf16_t*)g + (size_t)row * pitch + ch * 8); }
}
template <int W, int STR> __device__ __forceinline__ void tile_store(const u32x4 (&r)[W / 64], LAS unsigned char* buf, int tid) {
#pragma unroll
    for (int i = 0; i < W / 64; ++i) { const int id = tid + i * 512, row = id / (W / 8), ch = id % (W / 8); *(LAS u32x4*)(buf + row * STR + ch * 16) = r[i]; }
}
template <int DQK> __device__ __forceinline__ void load_q(bf16x8 (&qf)[DQK / 16], const bf16_t* qrow, int h, float sc) {
#pragma unroll
    for (int ks = 0; ks < DQK / 16; ++ks) { const u32x4 v = *(const GAS u32x4*)((const GAS bf16_t*)qrow + 16 * ks + 8 * h);
        u32x4 o; o.x = pk2(bflo(v.x) * sc, bfhi(v.x) * sc); o.y = pk2(bflo(v.y) * sc, bfhi(v.y) * sc); o.z = pk2(bflo(v.z) * sc, bfhi(v.z) * sc); o.w = pk2(bflo(v.w) * sc, bfhi(v.w) * sc);
        qf[ks] = __builtin_bit_cast(bf16x8, o); }
}
template <int DQK, int KW, int DV, int MODE>
__device__ __forceinline__ void attn_loop(LAS unsigned char* lds, const bf16_t* Kg, int kpitch, const bf16_t* Vg, int vpitch, int ntiles,
                                          const bf16x8 (&qf)[DQK / 16], int koff, float nslope2, int qrel, float& m, float& lsum, f32x16 (&o)[DV / 32]) {
    constexpr int KSTR = (KW + 8) * 2, VSTR = DV * 2 + 64, KBUF = 64 * KSTR, VBUF = 64 * VSTR;
    int tid_ = threadIdx.x; asm volatile("" : "+v"(tid_));
    const int tid = tid_, lane = tid & 63, r = lane & 31, h = lane >> 5;
    LAS unsigned char* K0 = lds; LAS unsigned char* V0 = lds + 2 * KBUF;
    u32x4 kr[KW / 64], vr[DV / 64];
    tile_load<KW>(kr, Kg, kpitch, tid); tile_load<DV>(vr, Vg, vpitch, tid);
    tile_store<KW, KSTR>(kr, K0, tid); tile_store<DV, VSTR>(vr, V0, tid);
    __syncthreads();
    const int vlane = ((lane & 15) >> 2) * VSTR + (16 * ((lane >> 4) & 1) + 4 * (lane & 3)) * 2 + 4 * h * VSTR;
    for (int t = 0; t < ntiles; ++t) {
        const int cur = t & 1;
        if (t + 1 < ntiles) { tile_load<KW>(kr, Kg + (size_t)(t + 1) * 64 * kpitch, kpitch, tid); tile_load<DV>(vr, Vg + (size_t)(t + 1) * 64 * vpitch, vpitch, tid); }
        const LAS unsigned char* Kb = K0 + cur * KBUF + r * KSTR + (koff + 8 * h) * 2;
        const LAS unsigned char* Vb = V0 + cur * VBUF + vlane;
        f32x16 s0, s1;
#pragma unroll
        for (int i = 0; i < 16; ++i) { s0[i] = 0.f; s1[i] = 0.f; }
#pragma unroll
        for (int ks = 0; ks < DQK / 16; ++ks) {
            const bf16x8 k0 = *(const LAS bf16x8*)(Kb + ks * 32), k1 = *(const LAS bf16x8*)(Kb + 32 * KSTR + ks * 32);
            s0 = __builtin_amdgcn_mfma_f32_32x32x16_bf16(k0, qf[ks], s0, 0, 0, 0);
            s1 = __builtin_amdgcn_mfma_f32_32x32x16_bf16(k1, qf[ks], s1, 0, 0, 0);
        }
        float Aoff = 0.f;
        if (MODE >= 1) {
            const int qrel0 = __builtin_amdgcn_readfirstlane(qrel - r);
            const int T0 = t * 64;
            if (MODE == 1 && (T0 + 64 <= qrel0 || T0 > qrel0 + 31)) {
                const bool left = (T0 + 64 <= qrel0);
                const float sl = left ? -nslope2 : nslope2;
                Aoff = left ? nslope2 * (float)(qrel - T0 - 4 * h) : nslope2 * (float)(T0 + 4 * h - qrel);
#pragma unroll
                for (int i = 0; i < 16; ++i) { s0[i] = __builtin_fmaf(sl, (float)((i & 3) + 8 * (i >> 2)), s0[i]); s1[i] = __builtin_fmaf(sl, (float)(32 + (i & 3) + 8 * (i >> 2)), s1[i]); }
            } else {
                const float base = (float)(T0 + 4 * h - qrel);
#pragma unroll
                for (int i = 0; i < 16; ++i) {
                    const float d0 = fabsf(base + (float)((i & 3) + 8 * (i >> 2))), d1 = fabsf(base + (float)(32 + (i & 3) + 8 * (i >> 2)));
                    s0[i] = __builtin_fmaf(d0, nslope2, s0[i]); s1[i] = __builtin_fmaf(d1, nslope2, s1[i]);
                    if (MODE == 2) { if (d0 > 128.f) s0[i] = -1e30f; if (d1 > 128.f) s1[i] = -1e30f; }
                }
            }
        }
        float mx = fmaxf(s0[0], s1[0]);
#pragma unroll
        for (int i = 1; i < 16; ++i) mx = fmaxf(fmaxf(mx, s0[i]), s1[i]);
        mx += Aoff;
        mx = fmaxf(mx, xhalf(mx));
        const float mnew = fmaxf(m, mx);
        if (__builtin_amdgcn_ballot_w64(mnew > m) != 0ull) {
            const float alpha = __builtin_amdgcn_exp2f(m - mnew);
            lsum *= alpha;
#pragma unroll
            for (int d = 0; d < DV / 32; ++d) o[d] = o[d] * alpha;
        }
        m = mnew;
        const float mm = mnew - Aoff;
        float rs = 0.f;
#pragma unroll
        for (int i = 0; i < 16; ++i) { s0[i] = __builtin_amdgcn_exp2f(s0[i] - mm); s1[i] = __builtin_amdgcn_exp2f(s1[i] - mm); rs += s0[i] + s1[i]; }
        lsum += rs;
        bf16x8 pf[4];
#pragma unroll
        for (int s2 = 0; s2 < 2; ++s2) {
            u32x4 a, b;
            a.x = pk2(s0[8 * s2 + 0], s0[8 * s2 + 1]); a.y = pk2(s0[8 * s2 + 2], s0[8 * s2 + 3]); a.z = pk2(s0[8 * s2 + 4], s0[8 * s2 + 5]); a.w = pk2(s0[8 * s2 + 6], s0[8 * s2 + 7]);
            b.x = pk2(s1[8 * s2 + 0], s1[8 * s2 + 1]); b.y = pk2(s1[8 * s2 + 2], s1[8 * s2 + 3]); b.z = pk2(s1[8 * s2 + 4], s1[8 * s2 + 5]); b.w = pk2(s1[8 * s2 + 6], s1[8 * s2 + 7]);
            pf[s2] = __builtin_bit_cast(bf16x8, a); pf[2 + s2] = __builtin_bit_cast(bf16x8, b);
        }
#pragma unroll
        for (int d = 0; d < DV / 32; ++d) {
#pragma unroll
            for (int kk = 0; kk < 4; ++kk) {
                const s16x4 lo = vtr(Vb + (16 * kk) * VSTR + d * 64), hi = vtr(Vb + (16 * kk + 8) * VSTR + d * 64);
                const bf16x8 vf = {lo[0], lo[1], lo[2], lo[3], hi[0], hi[1], hi[2], hi[3]};
                o[d] = __builtin_amdgcn_mfma_f32_32x32x16_bf16(vf, pf[kk], o[d], 0, 0, 0);
            }
        }
        if (t + 1 < ntiles) { tile_store<KW, KSTR>(kr, K0 + (cur ^ 1) * KBUF, tid); tile_store<DV, VSTR>(vr, V0 + (cur ^ 1) * VBUF, tid); }
        __syncthreads();
    }
}
__device__ __forceinline__ int swz(int row) { return ((row & 3) << 2) | ((row >> 2) & 3); }
template <int DQK, int MODE, int pitch, int voff>
__device__ __forceinline__ void attn_loop_dma(LAS unsigned char* lds, const int wave, const bf16_t* Kg, int ntiles,
                                              const bf16x8 (&qf)[DQK / 16], int koff, float nslope2, int qrel, float& m, float& lsum, f32x16 (&o)[4]) {
    constexpr int DV = 128, STAGE = 32768, VOFFB = 16384;
    const int lane = hw_lane(), r = lane & 31, h = lane >> 5;
    unsigned gk[2];
#pragma unroll
    for (int i = 0; i < 2; ++i) { const int row = 4 * (2 * wave + i) + (lane >> 4), c = (lane & 15) ^ swz(row); gk[i] = (unsigned)(row * pitch + c * 8); }
    unsigned kad[DQK / 16], vad[4][2];
#pragma unroll
    for (int ks = 0; ks < DQK / 16; ++ks) kad[ks] = (unsigned)(r * 256 + 16 * (((koff >> 3) + 2 * ks + h) ^ swz(r)));
    { const int q_ = (lane & 15) >> 2, pp = lane & 3, g1 = (lane >> 4) & 1;
#pragma unroll
      for (int d = 0; d < 4; ++d)
#pragma unroll
          for (int hi = 0; hi < 2; ++hi) { const int f = (q_ << 2) | ((2 * hi + h) & 3), c = (4 * d + 2 * g1 + (pp >> 1)) ^ f;
              vad[d][hi] = (unsigned)(VOFFB + (4 * h + q_) * 256 + 16 * c + 8 * (pp & 1) + hi * 2048); } }
#define ATT_DMA(tt, st) do { const bf16_t* kg_ = Kg + (size_t)(tt) * 64 * pitch; _Pragma("unroll") for (int i_ = 0; i_ < 2; ++i_) { \
        __builtin_amdgcn_global_load_lds((const unsigned*)(kg_ + gk[i_]), (LAS unsigned*)(lds + (st) * STAGE + (2 * wave + i_) * 1024), 16, 0, 0); \
        __builtin_amdgcn_global_load_lds((const unsigned*)(kg_ + voff + gk[i_]), (LAS unsigned*)(lds + (st) * STAGE + VOFFB + (2 * wave + i_) * 1024), 16, 0, 0); } } while (0)
    ATT_DMA(0, 0);
    if (ntiles > 1) ATT_DMA(1, 1);
    if (ntiles > 2) { ATT_DMA(2, 2); asm volatile("s_waitcnt vmcnt(4)" ::: "memory"); } else asm volatile("s_waitcnt vmcnt(0)" ::: "memory");
    __builtin_amdgcn_s_barrier();
    f32x16 s0, s1;
#pragma unroll
    for (int i = 0; i < 16; ++i) { s0[i] = 0.f; s1[i] = 0.f; }
#pragma unroll
    for (int ks = 0; ks < DQK / 16; ++ks) {
        const bf16x8 k0 = *(const LAS bf16x8*)(lds + kad[ks]), k1 = *(const LAS bf16x8*)(lds + kad[ks] + 8192);
        s0 = __builtin_amdgcn_mfma_f32_32x32x16_bf16(k0, qf[ks], s0, 0, 0, 0);
        s1 = __builtin_amdgcn_mfma_f32_32x32x16_bf16(k1, qf[ks], s1, 0, 0, 0);
    }
#define LDS_RD128(dst, addr, off) asm volatile("ds_read_b128 %0, %1 offset:%c2" : "=&v"(dst) : "v"(addr), "i"(off) : "memory")
#define LDS_RDTR(dst, addr, off) asm volatile("ds_read_b64_tr_b16 %0, %1 offset:%c2" : "=&v"(dst) : "v"(addr), "i"(off) : "memory")
#define LDS_WAIT0() do { asm volatile("s_waitcnt lgkmcnt(0)" ::: "memory"); __builtin_amdgcn_sched_barrier(0); } while (0)
    for (int t = 0; t < ntiles; ++t) {
        if (t + 3 < ntiles) ATT_DMA(t + 3, (t + 3) & 3);
        const unsigned sba = (unsigned)(size_t)(lds + (t & 3) * STAGE), sna = (unsigned)(size_t)(lds + ((t + 1) & 3) * STAGE);
        constexpr int KH = (DQK == 64) ? 4 : 4;
        bf16x8 kf0[KH], kf1[KH];
        s16x4 va_lo[4], va_hi[4], vb_lo[4], vb_hi[4];
        if (DQK == 64) {
#pragma unroll
            for (int ks = 0; ks < KH; ++ks) { const unsigned ka = sna + kad[ks]; LDS_RD128(kf0[ks], ka, 0); } }
        __builtin_amdgcn_sched_barrier(0);
        float Aoff = 0.f;
        if (MODE >= 1) {
            const int qrel0 = __builtin_amdgcn_readfirstlane(qrel - r);
            const int T0 = t * 64;
            if (MODE == 1 && (T0 + 64 <= qrel0 || T0 > qrel0 + 31)) {
                const bool left = (T0 + 64 <= qrel0);
                const float sl = left ? -nslope2 : nslope2;
                Aoff = left ? nslope2 * (float)(qrel - T0 - 4 * h) : nslope2 * (float)(T0 + 4 * h - qrel);
#pragma unroll
                for (int i = 0; i < 16; ++i) { s0[i] = __builtin_fmaf(sl, (float)((i & 3) + 8 * (i >> 2)), s0[i]); s1[i] = __builtin_fmaf(sl, (float)(32 + (i & 3) + 8 * (i >> 2)), s1[i]); }
            } else {
                const float base = (float)(T0 + 4 * h - qrel);
#pragma unroll
                for (int i = 0; i < 16; ++i) {
                    const float d0 = fabsf(base + (float)((i & 3) + 8 * (i >> 2))), d1 = fabsf(base + (float)(32 + (i & 3) + 8 * (i >> 2)));
                    s0[i] = __builtin_fmaf(d0, nslope2, s0[i]); s1[i] = __builtin_fmaf(d1, nslope2, s1[i]);
                    if (MODE == 2) { if (d0 > 128.f) s0[i] = -1e30f; if (d1 > 128.f) s1[i] = -1e30f; }
                }
            }
        }
        float mx = fmaxf(s0[0], s1[0]);
#pragma unroll
        for (int i = 1; i < 16; ++i) mx = fmaxf(fmaxf(mx, s0[i]), s1[i]);
        mx += Aoff;
        mx = fmaxf(mx, xhalf(mx));
        const float mnew = fmaxf(m, mx);
        if (__builtin_amdgcn_ballot_w64(mnew > m) != 0ull) {
            const float alpha = __builtin_amdgcn_exp2f(m - mnew);
            lsum *= alpha;
#pragma unroll
            for (int d = 0; d < DV / 32; ++d) o[d] = o[d] * alpha;
        }
        m = mnew;
        const float mm = mnew - Aoff;
        float rs = 0.f;
#pragma unroll
        for (int i = 0; i < 16; ++i) { s0[i] = __builtin_amdgcn_exp2f(s0[i] - mm); s1[i] = __builtin_amdgcn_exp2f(s1[i] - mm); rs += s0[i] + s1[i]; }
        lsum += rs;
        bf16x8 pf[4];
#pragma unroll
        for (int s2 = 0; s2 < 2; ++s2) {
            u32x4 a, b;
            a.x = pk2(s0[8 * s2 + 0], s0[8 * s2 + 1]); a.y = pk2(s0[8 * s2 + 2], s0[8 * s2 + 3]); a.z = pk2(s0[8 * s2 + 4], s0[8 * s2 + 5]); a.w = pk2(s0[8 * s2 + 6], s0[8 * s2 + 7]);
            b.x = pk2(s1[8 * s2 + 0], s1[8 * s2 + 1]); b.y = pk2(s1[8 * s2 + 2], s1[8 * s2 + 3]); b.z = pk2(s1[8 * s2 + 4], s1[8 * s2 + 5]); b.w = pk2(s1[8 * s2 + 6], s1[8 * s2 + 7]);
            pf[s2] = __builtin_bit_cast(bf16x8, a); pf[2 + s2] = __builtin_bit_cast(bf16x8, b);
        }
        LDS_WAIT0();
        if (DQK == 64) {
#pragma unroll
            for (int ks = 0; ks < KH; ++ks) { const unsigned ka = sna + kad[ks]; LDS_RD128(kf1[ks], ka, 8192); } }
        { const unsigned alo = sba + vad[0][0], ahi = sba + vad[0][1];
#pragma unroll
          for (int kk = 0; kk < 4; ++kk) { LDS_RDTR(va_lo[kk], alo, kk * 4096); LDS_RDTR(va_hi[kk], ahi, kk * 4096); } }
        __builtin_amdgcn_sched_barrier(0);
        f32x16 n0, n1;
#pragma unroll
        for (int i = 0; i < 16; ++i) { n0[i] = 0.f; n1[i] = 0.f; }
#pragma unroll
        for (int g = 0; g < DQK / 64; ++g) {
            if (DQK != 64) {
#pragma unroll
                for (int ks = 0; ks < KH; ++ks) { const unsigned ka = sna + kad[g * KH + ks]; LDS_RD128(kf0[ks], ka, 0); LDS_RD128(kf1[ks], ka, 8192); }
                LDS_WAIT0(); }
#pragma unroll
            for (int ks = 0; ks < KH; ++ks) n0 = __builtin_amdgcn_mfma_f32_32x32x16_bf16(kf0[ks], qf[g * KH + ks], n0, 0, 0, 0);
            if (DQK == 64) LDS_WAIT0();
#pragma unroll
            for (int ks = 0; ks < KH; ++ks) n1 = __builtin_amdgcn_mfma_f32_32x32x16_bf16(kf1[ks], qf[g * KH + ks], n1, 0, 0, 0);
        }
#define PV_BLOCK(d, lo, hi) do { _Pragma("unroll") for (int kk = 0; kk < 4; ++kk) { const bf16x8 vf = {lo[kk][0], lo[kk][1], lo[kk][2], lo[kk][3], hi[kk][0], hi[kk][1], hi[kk][2], hi[kk][3]}; \
            o[d] = __builtin_amdgcn_mfma_f32_32x32x16_bf16(vf, pf[kk], o[d], 0, 0, 0); } } while (0)
#define V_ISSUE(d, lo, hi) do { const unsigned alo_ = sba + vad[d][0], ahi_ = sba + vad[d][1]; _Pragma("unroll") for (int kk = 0; kk < 4; ++kk) { LDS_RDTR(lo[kk], alo_, kk * 4096); LDS_RDTR(hi[kk], ahi_, kk * 4096); } } while (0)
        LDS_WAIT0();
        V_ISSUE(1, vb_lo, vb_hi); __builtin_amdgcn_sched_barrier(0);
        PV_BLOCK(0, va_lo, va_hi);
        LDS_WAIT0();
        V_ISSUE(2, va_lo, va_hi); __builtin_amdgcn_sched_barrier(0);
        PV_BLOCK(1, vb_lo, vb_hi);
        LDS_WAIT0();
        V_ISSUE(3, vb_lo, vb_hi); __builtin_amdgcn_sched_barrier(0);
        PV_BLOCK(2, va_lo, va_hi);
        LDS_WAIT0();
        PV_BLOCK(3, vb_lo, vb_hi);
#undef PV_BLOCK
#undef V_ISSUE
        s0 = n0; s1 = n1;
        if (t + 3 < ntiles) asm volatile("s_waitcnt vmcnt(4)" ::: "memory"); else asm volatile("s_waitcnt vmcnt(0)" ::: "memory");
        __builtin_amdgcn_s_barrier();
    }
#undef LDS_RD128
#undef LDS_RDTR
#undef LDS_WAIT0
#undef ATT_DMA
}
template <int DV> __device__ __forceinline__ void store_o(const f32x16 (&o)[DV / 32], float sc, bf16_t* orow, int h) {
#pragma unroll
    for (int d = 0; d < DV / 32; ++d)
#pragma unroll
        for (int g4 = 0; g4 < 4; ++g4) { u32x2 w; w.x = pk2(o[d][4 * g4] * sc, o[d][4 * g4 + 1] * sc); w.y = pk2(o[d][4 * g4 + 2] * sc, o[d][4 * g4 + 3] * sc);
            *(GAS u32x2*)((GAS bf16_t*)orow + 32 * d + 8 * g4 + 4 * h) = w; }
}

__device__ __forceinline__ void win_unit(Frame& F, const Params& p, int l, int u) {
    REFRAME(F);
    const bf16_t* Z = (const bf16_t*)(p.ws + WS_Z); bf16_t* MIX = (bf16_t*)(p.ws + WS_MIX);
    const int b = u >> 5, kvh = (u >> 4) & 1, nb = u & 15, r = F.lane & 31, h = F.lane >> 5;
    const int g = F.wave >> 2, hq = kvh * 2 + g, qpos = nb * 128 + (F.wave & 3) * 32 + r;
    const size_t tok = (size_t)b * SEQ + qpos;
    bf16x8 qf[4]; load_q<64>(qf, Z + tok * ZP + hq * 64, h, 0.125f * LOG2E);
    const int first = (2 * nb - 2 < 0) ? 0 : 2 * nb - 2, lastx = (2 * nb + 4 > 32) ? 32 : 2 * nb + 4, nt = lastx - first;
    const float slope = exp2f(-(float)(2 * hq + 1));
    float m = p.in[4][l * 4 + hq] * LOG2E, ls = (h == 0) ? 1.f : 0.f;
    f32x16 o[2];
#pragma unroll
    for (int d = 0; d < 2; ++d)
#pragma unroll
        for (int i = 0; i < 16; ++i) o[d][i] = 0.f;
    const bf16_t* Kg = Z + ((size_t)b * SEQ + first * 64) * ZP + 256 + kvh * 64;
    attn_loop<64, 64, 64, 2>(F.lds, Kg, ZP, Kg + 128, ZP, nt, qf, 0, -slope * LOG2E, qpos - first * 64, m, ls, o);
    const float lt = ls + xhalf(ls);
    store_o<64>(o, 1.f / lt, MIX + tok * DM + hq * 64, h);
}
__device__ __forceinline__ void diff_unit(Frame& F, const Params& p, int l, int u) {
    REFRAME(F);
    const bf16_t* Z = (const bf16_t*)(p.ws + WS_Z); bf16_t* MIX = (bf16_t*)(p.ws + WS_MIX);
    const int b = u >> 6, hh = (u >> 4) & 3, qb = u & 15, r = F.lane & 31, h = F.lane >> 5;
    const int c = F.wave >> 2, qpos = qb * 128 + (F.wave & 3) * 32 + r;
    const size_t tok = (size_t)b * SEQ + qpos;
    float lam, lam_init;
    {
        const float a1 = wave_sum(p.in[5][l * 64 + F.lane] * p.in[6][l * 64 + F.lane]), a2 = wave_sum(p.in[7][l * 64 + F.lane] * p.in[8][l * 64 + F.lane]);
        lam_init = 0.8f - 0.6f * expf(-0.3f * (float)l);
        lam = expf(a1) - expf(a2) + lam_init;
    }
    bf16x8 qf[4]; load_q<64>(qf, Z + tok * ZP + 512 + hh * 128 + c * 64, h, 0.125f * LOG2E);
    const float slope = exp2f(-(float)(2 * hh + 2));
    float m = -1e30f, ls = 0.f;
    f32x16 o[4];
#pragma unroll
    for (int d = 0; d < 4; ++d)
#pragma unroll
        for (int i = 0; i < 16; ++i) o[d][i] = 0.f;
    const bf16_t* Kg = (const bf16_t*)(p.ws + WS_KD2) + (size_t)(b * 4 + hh) * 2048 * 128;
    attn_loop_dma<64, 1, 128, 8388608>(F.lds, F.wave, Kg, 32, qf, c * 64, -slope * LOG2E, qpos, m, ls, o);
    const float inv = 1.f / (ls + xhalf(ls));
    LAS float* comb = (LAS float*)F.lds + (size_t)(F.wave & 3) * 64 * 64 + F.lane;
    if (c == 1) {
#pragma unroll
        for (int d = 0; d < 4; ++d)
#pragma unroll
            for (int i = 0; i < 16; ++i) comb[(d * 16 + i) * 64] = o[d][i] * inv;
    }
    __syncthreads();
    if (c == 0) {
        float ss = 0.f;
#pragma unroll
        for (int d = 0; d < 4; ++d)
#pragma unroll
            for (int i = 0; i < 16; ++i) { const float a = o[d][i] * inv - lam * comb[(d * 16 + i) * 64]; o[d][i] = a; ss += a * a; }
        ss += xhalf(ss);
        const float rn = rsqrtf(ss * (1.f / 128.f) + 1e-6f) * (1.f - lam_init);
        const float* sg = p.in[9] + l * 128;
        bf16_t* orow = MIX + tok * DM + 256 + hh * 128;
        f32x4 ggv[4][4];
#pragma unroll
        for (int d = 0; d < 4; ++d)
#pragma unroll
            for (int g4 = 0; g4 < 4; ++g4) ggv[d][g4] = *(const GAS f32x4*)((const GAS float*)sg + 32 * d + 8 * g4 + 4 * h);
#pragma unroll
        for (int d = 0; d < 4; ++d)
#pragma unroll
            for (int g4 = 0; g4 < 4; ++g4) { const int dv = 32 * d + 8 * g4 + 4 * h; const f32x4 gg = ggv[d][g4];
                u32x2 w; w.x = pk2(o[d][4 * g4] * rn * gg[0], o[d][4 * g4 + 1] * rn * gg[1]); w.y = pk2(o[d][4 * g4 + 2] * rn * gg[2], o[d][4 * g4 + 3] * rn * gg[3]);
                *(GAS u32x2*)((GAS bf16_t*)orow + dv) = w; }
    }
    __syncthreads();
}
__device__ __forceinline__ void cross_unit(Frame& F, const Params& p, int u) {
    REFRAME(F);
    const bf16_t* Q = (const bf16_t*)(p.ws + WS_Q); const bf16_t* KV = (const bf16_t*)(p.ws + WS_KV); bf16_t* O = (bf16_t*)(p.ws + WS_O);
    const int b = u >> 5, hd = (u >> 3) & 3, qb = u & 7, r = F.lane & 31, h = F.lane >> 5;
    const size_t tok = (size_t)b * SEQ + qb * 256 + F.wave * 32 + r;
    bf16x8 qf[8]; load_q<128>(qf, Q + tok * XW + hd * 128, h, 0.08838834764831845f * LOG2E);
    float m = -1e30f, ls = 0.f;
    f32x16 o[4];
#pragma unroll
    for (int d = 0; d < 4; ++d)
#pragma unroll
        for (int i = 0; i < 16; ++i) o[d][i] = 0.f;
    const bf16_t* Kg = KV + ((size_t)b * NMEM) * 1024 + hd * 128;
    attn_loop_dma<128, 0, 1024, 512>(F.lds, F.wave, Kg, 4, qf, 0, 0.f, 0, m, ls, o);
    const float lt = ls + xhalf(ls);
    store_o<128>(o, 1.f / lt, O + tok * XW + hd * 128, h);
}

constexpr int CF_STR = 772, PREP_AW = 32 * CF_STR * 4, PREP_AA = PREP_AW + 32 * 72 * 2, PREP_AG = PREP_AA + 32 * 72 * 2;
__device__ __forceinline__ void prep_unit(Frame& F, const Params& p, int l, const bf16_t* wb, int u) {
    REFRAME(F);
    const bf16_t* ZC = (const bf16_t*)(p.ws + WS_ZC);
    const int t0 = u * 32, b = t0 / SEQ;
    LAS float* CF = (LAS float*)F.lds; LAS bf16_t* AW = (LAS bf16_t*)(F.lds + PREP_AW); LAS bf16_t* AA = (LAS bf16_t*)(F.lds + PREP_AA); LAS bf16_t* AG = (LAS bf16_t*)(F.lds + PREP_AG);
    const float* conv = p.in[10] + (size_t)l * 3 * 1024;
    LAS float* PAR = (LAS float*)(F.lds + PREP_AG + 32 * 136 * 2);
    if (F.tid < 448) { const int i = F.tid; const GAS f32x4* src;
        if (i < 64) src = (const GAS f32x4*)((const GAS float*)p.in[16] + l * 256) + i;
        else if (i < 128) src = (const GAS f32x4*)((const GAS float*)p.in[17] + l * 256) + (i - 64);
        else if (i < 192) src = (const GAS f32x4*)((const GAS float*)p.in[18] + l * 256) + (i - 128);
        else if (i < 320) src = (const GAS f32x4*)((const GAS float*)p.in[11] + l * 512) + (i - 192);
        else src = (const GAS f32x4*)((const GAS float*)p.in[13] + l * 512) + (i - 320);
        ((LAS f32x4*)PAR)[i] = *src; }
#pragma unroll 4
    for (int i = 0; i < 8; ++i) {
        const int id = F.tid + i * 512, tk = id >> 7, ch = id & 127, tg = t0 + tk, tpos = tg - b * SEQ;
        const GAS bf16_t* zp = (const GAS bf16_t*)ZC + (size_t)tg * 1024 + ch * 8;
        const u32x4 zc = *(const GAS u32x4*)zp;
        u32x4 zl = {0u, 0u, 0u, 0u}, zr = {0u, 0u, 0u, 0u};
        if (tpos > 0) zl = *(const GAS u32x4*)(zp - 1024);
        if (tpos < SEQ - 1) zr = *(const GAS u32x4*)(zp + 1024);
        float v[8];
#pragma unroll
        for (int q = 0; q < 4; ++q) {
            const f32x2 c0 = *(const GAS f32x2*)((const GAS float*)conv + ch * 8 + 2 * q), c1 = *(const GAS f32x2*)((const GAS float*)conv + 1024 + ch * 8 + 2 * q), c2 = *(const GAS f32x2*)((const GAS float*)conv + 2048 + ch * 8 + 2 * q);
            v[2 * q] = bflo(zl[q]) * c0[0] + bflo(zc[q]) * c1[0] + bflo(zr[q]) * c2[0];
            v[2 * q + 1] = bfhi(zl[q]) * c0[1] + bfhi(zc[q]) * c1[1] + bfhi(zr[q]) * c2[1];
        }
        if (ch < 96) { *(LAS f32x4*)(CF + tk * CF_STR + ch * 8) = (f32x4){v[0], v[1], v[2], v[3]}; *(LAS f32x4*)(CF + tk * CF_STR + ch * 8 + 4) = (f32x4){v[4], v[5], v[6], v[7]}; }
        else {
            u32x4 w;
            if (ch < 104) {
#pragma unroll
                for (int q = 0; q < 8; ++q) v[q] = 1.f - 2.f / (__expf(2.f * v[q]) + 1.f);
                w.x = pk2(v[0], v[1]); w.y = pk2(v[2], v[3]); w.z = pk2(v[4], v[5]); w.w = pk2(v[6], v[7]);
                *(LAS u32x4*)(AW + tk * 72 + (ch - 96) * 8) = w;
            } else if (ch < 112) {
                w.x = pk2(v[0], v[1]); w.y = pk2(v[2], v[3]); w.z = pk2(v[4], v[5]); w.w = pk2(v[6], v[7]);
                *(LAS u32x4*)(AA + tk * 72 + (ch - 104) * 8) = w;
            } else {
#pragma unroll
                for (int q = 0; q < 8; ++q) v[q] = sigmoidf_(v[q]);
                w.x = pk2(v[0], v[1]); w.y = pk2(v[2], v[3]); w.z = pk2(v[4], v[5]); w.w = pk2(v[6], v[7]);
                *(LAS u32x4*)(AG + tk * 136 + (ch - 112) * 8) = w;
            }
        }
    }
    __syncthreads();
    const int hh = F.wave & 3, dir = F.wave >> 2, tk = F.lane & 31, h2 = F.lane >> 5;
    const size_t tok = (size_t)t0 + tk;
    const GAS bf16_t* Wup = (const GAS bf16_t*)wb + WO_WUP + (size_t)(dir * 256 + hh * 64) * 64;
    const GAS bf16_t* Aup = (const GAS bf16_t*)wb + WO_AUP + (size_t)(dir * 256 + hh * 64) * 64;
    f32x16 aw[2], aa[2];
#pragma unroll
    for (int rb = 0; rb < 2; ++rb)
#pragma unroll
        for (int i = 0; i < 16; ++i) { aw[rb][i] = 0.f; aa[rb][i] = 0.f; }
#pragma unroll
    for (int ks = 0; ks < 4; ++ks) {
        const bf16x8 bw = *(const LAS bf16x8*)(AW + tk * 72 + 16 * ks + 8 * h2), ba = *(const LAS bf16x8*)(AA + tk * 72 + 16 * ks + 8 * h2);
#pragma unroll
        for (int rb = 0; rb < 2; ++rb) {
            const bf16x8 fw = *(const GAS bf16x8*)(Wup + (size_t)(rb * 32 + tk) * 64 + 16 * ks + 8 * h2), fa = *(const GAS bf16x8*)(Aup + (size_t)(rb * 32 + tk) * 64 + 16 * ks + 8 * h2);
            aw[rb] = __builtin_amdgcn_mfma_f32_32x32x16_bf16(fw, bw, aw[rb], 0, 0, 0);
            aa[rb] = __builtin_amdgcn_mfma_f32_32x32x16_bf16(fa, ba, aa[rb], 0, 0, 0);
        }
    }
    const LAS float* k_k = PAR + hh * 64; const LAS float* k_a = PAR + 256 + hh * 64; const LAS float* r_k = PAR + 512 + hh * 64;
    const LAS float* w0 = PAR + 768 + dir * 256 + hh * 64; const LAS float* a0 = PAR + 1280 + dir * 256 + hh * 64;
    float ssq = 0.f;
#pragma unroll
    for (int rb = 0; rb < 2; ++rb)
#pragma unroll
        for (int g4 = 0; g4 < 4; ++g4) { const int c0 = rb * 32 + 8 * g4 + 4 * h2;
            const f32x4 kv = *(const LAS f32x4*)(CF + tk * CF_STR + 256 + hh * 64 + c0), kkw = *(const LAS f32x4*)(k_k + c0);
            const f32x4 q = kv * kkw; ssq += (q[0] * q[0] + q[1] * q[1]) + (q[2] * q[2] + q[3] * q[3]); }
    ssq += xhalf(ssq);
    const float kinv = 1.f / fmaxf(sqrtf(ssq), 1e-12f);
    float bon = 0.f;
    GAS bf16_t* OM = (GAS bf16_t*)(p.ws + WS_OM) + ((size_t)dir * MTOK + tok) * 256 + hh * 64;
    GAS bf16_t* KA = (GAS bf16_t*)(p.ws + WS_KA) + ((size_t)dir * MTOK + tok) * 256 + hh * 64;
    GAS bf16_t* KD = (GAS bf16_t*)(p.ws + WS_KD) + ((size_t)dir * MTOK + tok) * 256 + hh * 64;
    GAS bf16_t* KK = (GAS bf16_t*)(p.ws + WS_KK) + tok * 256 + hh * 64;
    GAS bf16_t* VV = (GAS bf16_t*)(p.ws + WS_V) + tok * 256 + hh * 64;
    GAS bf16_t* RR = (GAS bf16_t*)(p.ws + WS_R) + tok * 256 + hh * 64;
#pragma unroll
    for (int rb = 0; rb < 2; ++rb)
#pragma unroll
        for (int g4 = 0; g4 < 4; ++g4) { const int c0 = rb * 32 + 8 * g4 + 4 * h2;
            const f32x4 kv = *(const LAS f32x4*)(CF + tk * CF_STR + 256 + hh * 64 + c0), rv = *(const LAS f32x4*)(CF + tk * CF_STR + hh * 64 + c0);
            const f32x4 kkw = *(const LAS f32x4*)(k_k + c0), kaw = *(const LAS f32x4*)(k_a + c0), rkw = *(const LAS f32x4*)(r_k + c0), w0v = *(const LAS f32x4*)(w0 + c0), a0v = *(const LAS f32x4*)(a0 + c0);
            float om[4], ka[4], kd[4], kk[4];
#pragma unroll
            for (int j = 0; j < 4; ++j) {
                const float wp = aw[rb][4 * g4 + j] + w0v[j], ap = aa[rb][4 * g4 + j] + a0v[j];
                om[j] = 1.f - __expf(-0.6065306597126334f * sigmoidf_(wp));
                const float a = sigmoidf_(ap);
                kk[j] = kv[j] * kkw[j] * kinv; ka[j] = kk[j] * a; kd[j] = kv[j] * (1.f + (a - 1.f) * kaw[j]);
                bon += rv[j] * kd[j] * rkw[j];
            }
            u32x2 w; w.x = pk2(om[0], om[1]); w.y = pk2(om[2], om[3]); *(GAS u32x2*)(OM + c0) = w;
            w.x = pk2(ka[0], ka[1]); w.y = pk2(ka[2], ka[3]); *(GAS u32x2*)(KA + c0) = w;
            w.x = pk2(kd[0], kd[1]); w.y = pk2(kd[2], kd[3]); *(GAS u32x2*)(KD + c0) = w;
            if (dir == 0) {
                const f32x4 vv = *(const LAS f32x4*)(CF + tk * CF_STR + 512 + hh * 64 + c0);
                w.x = pk2(kk[0], kk[1]); w.y = pk2(kk[2], kk[3]); *(GAS u32x2*)(KK + c0) = w;
                w.x = pk2(vv[0], vv[1]); w.y = pk2(vv[2], vv[3]); *(GAS u32x2*)(VV + c0) = w;
                w.x = pk2(rv[0], rv[1]); w.y = pk2(rv[2], rv[3]); *(GAS u32x2*)(RR + c0) = w;
            }
        }
    bon += xhalf(bon);
    if (h2 == 0) ((GAS float*)(p.ws + WS_BON))[((size_t)dir * MTOK + tok) * 4 + hh] = bon;
    {
        const GAS bf16_t* Gup = (const GAS bf16_t*)wb + WO_GUP + (size_t)(F.wave * 32 + tk) * 128;
        f32x16 ag;
#pragma unroll
        for (int i = 0; i < 16; ++i) ag[i] = 0.f;
#pragma unroll
        for (int ks = 0; ks < 8; ++ks) {
            const bf16x8 bg = *(const LAS bf16x8*)(AG + tk * 136 + 16 * ks + 8 * h2), fg = *(const GAS bf16x8*)(Gup + 16 * ks + 8 * h2);
            ag = __builtin_amdgcn_mfma_f32_32x32x16_bf16(fg, bg, ag, 0, 0, 0);
        }
        GAS bf16_t* GT = (GAS bf16_t*)(p.ws + WS_GATE) + tok * 256 + F.wave * 32;
#pragma unroll
        for (int g4 = 0; g4 < 4; ++g4) { u32x2 w; w.x = pk2(ag[4 * g4], ag[4 * g4 + 1]); w.y = pk2(ag[4 * g4 + 2], ag[4 * g4 + 3]); *(GAS u32x2*)(GT + 8 * g4 + 4 * h2) = w; }
    }
    __syncthreads();
}

#define CBAR() asm volatile("" ::: "memory")
#define LROW(M, i, r) do { const LAS f32x4* _q = (const LAS f32x4*)((M) + (i) * 16); const f32x4 _a = _q[0], _b = _q[1], _c = _q[2], _d = _q[3]; \
        r[0] = _a[0]; r[1] = _a[1]; r[2] = _a[2]; r[3] = _a[3]; r[4] = _b[0]; r[5] = _b[1]; r[6] = _b[2]; r[7] = _b[3]; \
        r[8] = _c[0]; r[9] = _c[1]; r[10] = _c[2]; r[11] = _c[3]; r[12] = _d[0]; r[13] = _d[1]; r[14] = _d[2]; r[15] = _d[3]; } while (0)
template <int DIR> __device__ __forceinline__ void chunkprep_wave(Frame& F, const Params& p, int task) {
    const int dbh = task >> 7, ct = task & 127, b = (dbh >> 2) & 7, hh = dbh & 3, ch = F.lane, r32 = F.lane & 31, h = F.lane >> 5;
    LAS unsigned char* wl = F.lds + F.wave * 16384;
    LAS bf16_t* X = (LAS bf16_t*)wl;
    LAS bf16_t* Yt = (LAS bf16_t*)(wl + 4608);
    LAS float* MTt = (LAS float*)(wl + 9216);
    LAS float* MBt = MTt + 256;
    LAS float* MC = MTt + 512; LAS float* MD = MTt + 768; LAS float* MT = MTt + 1024; LAS float* MA = MTt + 1280;
    constexpr int step = DIR ? -256 : 256;
    typedef const __attribute__((address_space(1))) bf16_t* gbf;
    const size_t ou = ((size_t)b * SEQ + ct * 16 + (DIR ? 15 : 0)) * 256 + hh * 64;
    const gbf OM = (gbf)(p.ws + WS_OM) + (size_t)DIR * MTOK * 256 + ou + ch; const gbf KA = (gbf)(p.ws + WS_KA) + (size_t)DIR * MTOK * 256 + ou + ch;
    const gbf KD = (gbf)(p.ws + WS_KD) + (size_t)DIR * MTOK * 256 + ou + ch; const gbf KK = (gbf)(p.ws + WS_KK) + ou + ch;
    const gbf RR = (gbf)(p.ws + WS_R) + ou + ch; const gbf VV = (gbf)(p.ws + WS_V) + ou + ch;
    float pc = 1.f;
    float qt[16], rt[16], at[16], kt[16], vv[16];
    {
        unsigned short rw[16], rk[16], ra_[16], rd[16], rr_[16], rv[16];
#pragma unroll
        for (int i = 0; i < 16; ++i) { rw[i] = OM[i * step]; rk[i] = KK[i * step]; ra_[i] = KA[i * step]; rd[i] = KD[i * step]; rr_[i] = RR[i * step]; rv[i] = VV[i * step]; }
#pragma unroll
        for (int i = 0; i < 16; ++i) {
            const float w = 1.f - bf2f(rw[i]);
            qt[i] = bf2f(rk[i]) * pc; pc *= w; const float ip = __builtin_amdgcn_rcpf(pc);
            rt[i] = bf2f(rr_[i]) * pc; at[i] = bf2f(ra_[i]) * ip; kt[i] = bf2f(rd[i]) * ip; vv[i] = bf2f(rv[i]);
            X[i * 72 + ch] = (bf16_t)(pk2(qt[i], 0.f) & 0xffffu); X[(16 + i) * 72 + ch] = (bf16_t)(pk2(rt[i], 0.f) & 0xffffu);
            Yt[i * 72 + ch] = (bf16_t)(pk2(at[i], 0.f) & 0xffffu); Yt[(16 + i) * 72 + ch] = (bf16_t)(pk2(kt[i], 0.f) & 0xffffu);
        }
    }
    const float p15 = pc;
    asm volatile("s_waitcnt lgkmcnt(0)" ::: "memory");
    {
        f32x16 g;
#pragma unroll
        for (int i = 0; i < 16; ++i) g[i] = 0.f;
#pragma unroll
        for (int ks = 0; ks < 4; ++ks) {
            const bf16x8 a = *(const LAS bf16x8*)(X + r32 * 72 + 16 * ks + 8 * h), bb = *(const LAS bf16x8*)(Yt + r32 * 72 + 16 * ks + 8 * h);
            g = __builtin_amdgcn_mfma_f32_32x32x16_bf16(a, bb, g, 0, 0, 0);
        }
        const int sidx = r32 & 15;
#pragma unroll
        for (int reg = 0; reg < 8; ++reg) { const int i = (reg & 3) + 8 * (reg >> 2) + 4 * h;
            const float lo = (sidx < i) ? g[reg] : 0.f, hi2 = (sidx <= i) ? g[8 + reg] : 0.f;
            if (r32 < 16) { MA[i * 16 + sidx] = lo; MD[i * 16 + sidx] = hi2; } else { MBt[sidx * 16 + i] = lo; MC[i * 16 + sidx] = hi2; } }
    }
    asm volatile("s_waitcnt lgkmcnt(0)" ::: "memory");
    {
        const int c = F.lane & 15; float Tc[16];
#pragma unroll
        for (int i = 0; i < 16; ++i) { float acc = (i == c) ? 1.f : 0.f; float ra[16]; LROW(MA, i, ra);
#pragma unroll
            for (int s2 = 0; s2 < i; ++s2) acc -= ra[s2] * Tc[s2];
            Tc[i] = acc; MT[i * 16 + c] = acc; MTt[c * 16 + i] = acc; CBAR(); }
    }
    asm volatile("s_waitcnt lgkmcnt(0)" ::: "memory");
    float Qh[16], W2[16];
    {
        float BV[16];
#pragma unroll
        for (int i = 0; i < 16; ++i) { Qh[i] = 0.f; BV[i] = 0.f; }
#pragma unroll
        for (int s2 = 0; s2 < 16; ++s2) {
            float ct_[16], cb_[16]; LROW(MTt, s2, ct_); LROW(MBt, s2, cb_);
#pragma unroll
            for (int i = s2; i < 16; ++i) { Qh[i] += ct_[i] * qt[s2]; if (i > s2) BV[i] += cb_[i] * vv[s2]; }
            CBAR();
        }
#pragma unroll
        for (int i = 0; i < 16; ++i) { float aw = 0.f; float rt_[16]; LROW(MT, i, rt_);
#pragma unroll
            for (int s2 = 0; s2 <= i; ++s2) aw += rt_[s2] * BV[s2];
            W2[i] = aw; CBAR(); }
    }
    GAS bf16_t* FQR = (GAS bf16_t*)(p.ws + WS_FQR) + (size_t)task * 2048;
    GAS bf16_t* FWY = (GAS bf16_t*)(p.ws + WS_FWY) + (size_t)task * 2048;
    {
        const int ks = ch >> 4, w16 = ch & 15, jq = (w16 >> 3) * 4 + (w16 & 3), hq = (w16 >> 2) & 1;
        GAS bf16_t* qrp = FQR + (size_t)(ks * 64 + hq * 32) * 8 + jq;
        GAS bf16_t* wyp = FWY + (size_t)(((ch >> 5) * 64 + r32) * 16);
#pragma unroll
        for (int i = 0; i < 16; ++i) {
            float ar = rt[i], ay = 0.f; float rd_[16], rc_[16]; LROW(MD, i, rd_); LROW(MC, i, rc_);
#pragma unroll
            for (int s2 = 0; s2 <= i; ++s2) { ar -= rd_[s2] * Qh[s2]; ay += rc_[s2] * vv[s2] - rd_[s2] * W2[s2]; }
            qrp[i * 8] = (bf16_t)(pk2(Qh[i], 0.f) & 0xffffu); qrp[(16 + i) * 8] = (bf16_t)(pk2(ar, 0.f) & 0xffffu);
            wyp[512 * ((i >> 2) & 1) + (i & 3) + 4 * (i >> 3)] = (bf16_t)(pk2(W2[i], 0.f) & 0xffffu);
            wyp[512 * ((i >> 2) & 1) + (i & 3) + 4 * ((16 + i) >> 3)] = (bf16_t)(pk2(ay, 0.f) & 0xffffu);
            CBAR(); }
    }
    {
        GAS bf16_t* nap = (GAS bf16_t*)(p.ws + WS_FNA) + (size_t)task * 1024 + (size_t)(((ch >> 5) * 64 + r32) * 8);
        GAS bf16_t* khp = (GAS bf16_t*)(p.ws + WS_FKH) + (size_t)task * 1024 + (size_t)(((ch >> 5) * 64 + r32) * 8);
#pragma unroll
        for (int s2 = 0; s2 < 16; ++s2) {
            const int off = 256 * ((s2 >> 2) & 1) + (s2 >> 3) * 4 + (s2 & 3);
            nap[off] = (bf16_t)(pk2(-at[s2] * p15, 0.f) & 0xffffu); khp[off] = (bf16_t)(pk2(kt[s2] * p15, 0.f) & 0xffffu); }
        ((GAS float*)(p.ws + WS_FP15))[(size_t)task * 64 + ch] = p15;
    }
    asm volatile("s_waitcnt lgkmcnt(0)" ::: "memory");
}
constexpr int PB_SLOT = 15360, PB_NSLOT = 4, PB_QR = 0, PB_WY = 4096, PB_NA = 8192, PB_KH = 10240, PB_P15 = 12288, PB_V = 13312;
__device__ __forceinline__ unsigned lds_ld_u32(unsigned addr) { unsigned v; asm volatile("ds_read_b32 %0, %1\n\ts_waitcnt lgkmcnt(0)" : "=v"(v) : "v"(addr) : "memory"); return v; }
__device__ __forceinline__ void lds_st_u32(unsigned addr, unsigned v) { asm volatile("ds_write_b32 %0, %1" :: "v"(addr), "v"(v) : "memory"); }
__device__ __forceinline__ void pb_dma(const Params& p, int dbh, int ct, int lane, LAS unsigned char* slot) {
    const size_t task = (size_t)dbh * 128 + ct; const int b = (dbh >> 2) & 7, hh = dbh & 3;
    const unsigned char* q = (const unsigned char*)((const bf16_t*)(p.ws + WS_FQR) + task * 2048) + lane * 16; const unsigned char* w = (const unsigned char*)((const bf16_t*)(p.ws + WS_FWY) + task * 2048) + lane * 16;
    const unsigned char* na = (const unsigned char*)((const bf16_t*)(p.ws + WS_FNA) + task * 1024) + lane * 16; const unsigned char* kh = (const unsigned char*)((const bf16_t*)(p.ws + WS_FKH) + task * 1024) + lane * 16;
#pragma unroll
    for (int i = 0; i < 4; ++i) {
        __builtin_amdgcn_global_load_lds((const unsigned*)(q + 1024 * i), (LAS unsigned*)(slot + PB_QR + 1024 * i), 16, 0, 0);
        __builtin_amdgcn_global_load_lds((const unsigned*)(w + 1024 * i), (LAS unsigned*)(slot + PB_WY + 1024 * i), 16, 0, 0); }
    __builtin_amdgcn_global_load_lds((const unsigned*)na, (LAS unsigned*)(slot + PB_NA), 16, 0, 0); __builtin_amdgcn_global_load_lds((const unsigned*)(na + 1024), (LAS unsigned*)(slot + PB_NA + 1024), 16, 0, 0);
    __builtin_amdgcn_global_load_lds((const unsigned*)kh, (LAS unsigned*)(slot + PB_KH), 16, 0, 0); __builtin_amdgcn_global_load_lds((const unsigned*)(kh + 1024), (LAS unsigned*)(slot + PB_KH + 1024), 16, 0, 0);
    __builtin_amdgcn_global_load_lds((const unsigned*)((const unsigned char*)((const float*)(p.ws + WS_FP15) + task * 64) + lane * 16), (LAS unsigned*)(slot + PB_P15), 16, 0, 0);
    const unsigned char* V = (const unsigned char*)((const bf16_t*)(p.ws + WS_V) + ((size_t)b * SEQ + ct * 16) * 256 + hh * 64) + (size_t)(lane >> 3) * 512 + (lane & 7) * 16;
    __builtin_amdgcn_global_load_lds((const unsigned*)V, (LAS unsigned*)(slot + PB_V), 16, 0, 0); __builtin_amdgcn_global_load_lds((const unsigned*)(V + 8 * 512), (LAS unsigned*)(slot + PB_V + 1024), 16, 0, 0);
}
__device__ __forceinline__ void phaseb_unit(Frame& F, const Params& p, int u) {
    const unsigned flag_base = (unsigned)(size_t)(F.lds + 131072 + 128);
    if (F.tid < 8) lds_st_u32(flag_base + 4 * F.tid, 0u);
    __syncthreads();
    const int pair = F.wave & 3;
    if (pair >= 2) return;
    const int dbh = u * 2 + pair, dir = dbh >> 5;
    LAS unsigned char* ring = F.lds + pair * (PB_NSLOT * PB_SLOT);
    const unsigned f_pub = flag_base + 8 * pair, f_con = f_pub + 4;
    if (F.wave >= 4) {
        for (int c = 0; c < 128; ++c) {
            while ((int)lds_ld_u32(f_con) < c - (PB_NSLOT - 1)) __builtin_amdgcn_s_sleep(1);
            pb_dma(p, dbh, dir ? 127 - c : c, F.lane, ring + (c & (PB_NSLOT - 1)) * PB_SLOT);
            if (c >= 3) { asm volatile("s_waitcnt vmcnt(45)" ::: "memory"); if (F.lane == 0) lds_st_u32(f_pub, (unsigned)(c - 2)); }
        }
        asm volatile("s_waitcnt vmcnt(30)" ::: "memory"); if (F.lane == 0) lds_st_u32(f_pub, 126u);
        asm volatile("s_waitcnt vmcnt(15)" ::: "memory"); if (F.lane == 0) lds_st_u32(f_pub, 127u);
        asm volatile("s_waitcnt vmcnt(0)" ::: "memory"); if (F.lane == 0) lds_st_u32(f_pub, 128u);
        return;
    }
    const int b = (dbh >> 2) & 7, hh = dbh & 3, r = F.lane & 31, h = F.lane >> 5;
    GAS bf16_t* Y = (GAS bf16_t*)(p.ws + WS_Y) + ((size_t)dir * MTOK + (size_t)b * SEQ) * 256 + hh * 64 + r;
    f32x16 accS[2][2];
#pragma unroll
    for (int rb = 0; rb < 2; ++rb)
#pragma unroll
        for (int cb = 0; cb < 2; ++cb)
#pragma unroll
            for (int i = 0; i < 16; ++i) accS[rb][cb][i] = 0.f;
    for (int cc = 0; cc < 128; ++cc) {
        const int ct = dir ? 127 - cc : cc;
        const LAS unsigned char* slot = ring + (cc & (PB_NSLOT - 1)) * PB_SLOT;
        bf16x8 sb[4][2];
#pragma unroll
        for (int rb = 0; rb < 2; ++rb)
#pragma unroll
            for (int s2 = 0; s2 < 2; ++s2)
#pragma unroll
                for (int cb = 0; cb < 2; ++cb) { const f32x16& a = accS[rb][cb]; u32x4 w;
                    w.x = pk2(a[8 * s2 + 0], a[8 * s2 + 1]); w.y = pk2(a[8 * s2 + 2], a[8 * s2 + 3]); w.z = pk2(a[8 * s2 + 4], a[8 * s2 + 5]); w.w = pk2(a[8 * s2 + 6], a[8 * s2 + 7]);
                    sb[2 * rb + s2][cb] = __builtin_bit_cast(bf16x8, w); }
        while ((int)lds_ld_u32(f_pub) < cc + 1) __builtin_amdgcn_s_sleep(1);
        asm volatile("" ::: "memory");
        f32x16 D[2];
#pragma unroll
        for (int cb = 0; cb < 2; ++cb) { const LAS u32x4* wp = (const LAS u32x4*)(slot + PB_WY + (cb * 64 + F.lane) * 32); const u32x4 w0 = wp[0], w1 = wp[1];
            D[cb][0] = bflo(w0.x); D[cb][1] = bfhi(w0.x); D[cb][2] = bflo(w0.y); D[cb][3] = bfhi(w0.y); D[cb][4] = bflo(w0.z); D[cb][5] = bfhi(w0.z); D[cb][6] = bflo(w0.w); D[cb][7] = bfhi(w0.w);
            D[cb][8] = bflo(w1.x); D[cb][9] = bfhi(w1.x); D[cb][10] = bflo(w1.y); D[cb][11] = bfhi(w1.y); D[cb][12] = bflo(w1.z); D[cb][13] = bfhi(w1.z); D[cb][14] = bflo(w1.w); D[cb][15] = bfhi(w1.w); }
#pragma unroll
        for (int ks = 0; ks < 4; ++ks) { const bf16x8 qa = *(const LAS bf16x8*)(slot + PB_QR + (ks * 64 + F.lane) * 16);
            D[0] = __builtin_amdgcn_mfma_f32_32x32x16_bf16(qa, sb[ks][0], D[0], 0, 0, 0);
            D[1] = __builtin_amdgcn_mfma_f32_32x32x16_bf16(qa, sb[ks][1], D[1], 0, 0, 0); }
#pragma unroll
        for (int rb = 0; rb < 2; ++rb)
#pragma unroll
            for (int g4 = 0; g4 < 4; ++g4) { const f32x4 pv = *(const LAS f32x4*)(slot + PB_P15 + (32 * rb + 8 * g4 + 4 * h) * 4);
#pragma unroll
                for (int cb = 0; cb < 2; ++cb)
#pragma unroll
                    for (int q = 0; q < 4; ++q) accS[rb][cb][4 * g4 + q] *= pv[q]; }
        bf16x8 ub[2], vb[2];
#pragma unroll
        for (int cb = 0; cb < 2; ++cb) {
            unsigned short vt[8];
#pragma unroll
            for (int j = 0; j < 8; ++j) { const int s2 = 8 * (j >> 2) + 4 * h + (j & 3); const int tau = dir ? 15 - s2 : s2;
                vt[j] = *(const LAS unsigned short*)(slot + PB_V + tau * 128 + (32 * cb + r) * 2);
                Y[(size_t)(ct * 16 + tau) * 256 + 32 * cb] = (bf16_t)(pk2(D[cb][8 + j], 0.f) & 0xffffu); }
            vb[cb] = (bf16x8){(short)vt[0], (short)vt[1], (short)vt[2], (short)vt[3], (short)vt[4], (short)vt[5], (short)vt[6], (short)vt[7]};
            u32x4 w; w.x = pk2(D[cb][0], D[cb][1]); w.y = pk2(D[cb][2], D[cb][3]); w.z = pk2(D[cb][4], D[cb][5]); w.w = pk2(D[cb][6], D[cb][7]);
            ub[cb] = __builtin_bit_cast(bf16x8, w);
        }
        bf16x8 na[2], kh[2];
#pragma unroll
        for (int rb = 0; rb < 2; ++rb) { na[rb] = *(const LAS bf16x8*)(slot + PB_NA + (rb * 64 + F.lane) * 16); kh[rb] = *(const LAS bf16x8*)(slot + PB_KH + (rb * 64 + F.lane) * 16); }
        asm volatile("s_waitcnt lgkmcnt(0)" ::: "memory");
        if (F.lane == 0) lds_st_u32(f_con, (unsigned)(cc + 1));
#pragma unroll
        for (int rb = 0; rb < 2; ++rb)
#pragma unroll
            for (int cb = 0; cb < 2; ++cb) {
                accS[rb][cb] = __builtin_amdgcn_mfma_f32_32x32x16_bf16(na[rb], ub[cb], accS[rb][cb], 0, 0, 0);
                accS[rb][cb] = __builtin_amdgcn_mfma_f32_32x32x16_bf16(kh[rb], vb[cb], accS[rb][cb], 0, 0, 0);
            }
    }
}

__device__ __forceinline__ void post_unit(Frame& F, const Params& p, int l, int u) {
    REFRAME(F);
    const bf16_t* Y0 = (const bf16_t*)(p.ws + WS_Y); const bf16_t* Y1 = Y0 + (size_t)MTOK * 256;
    const bf16_t* VV = (const bf16_t*)(p.ws + WS_V); const bf16_t* GT = (const bf16_t*)(p.ws + WS_GATE);
    const float* BON = (const float*)(p.ws + WS_BON); bf16_t* MIX = (bf16_t*)(p.ws + WS_MIX);
    const f32x4 lg = *(const f32x4*)(p.in[19] + l * 256 + 4 * F.lane), lb = *(const f32x4*)(p.in[20] + l * 256 + 4 * F.lane);
    for (int tok = u * 64 + F.wave * 8, te = tok + 8; tok < te; ++tok) {
        const u32x2 a = *(const GAS u32x2*)((const GAS bf16_t*)Y0 + (size_t)tok * 256 + 4 * F.lane), c = *(const GAS u32x2*)((const GAS bf16_t*)Y1 + (size_t)tok * 256 + 4 * F.lane);
        const u32x2 vv = *(const GAS u32x2*)((const GAS bf16_t*)VV + (size_t)tok * 256 + 4 * F.lane), gg = *(const GAS u32x2*)((const GAS bf16_t*)GT + (size_t)tok * 256 + 4 * F.lane);
        float y[4] = {bflo(a.x) + bflo(c.x), bfhi(a.x) + bfhi(c.x), bflo(a.y) + bflo(c.y), bfhi(a.y) + bfhi(c.y)};
        float s = (y[0] + y[1]) + (y[2] + y[3]);
#pragma unroll
        for (int o = 1; o < 16; o <<= 1) s += __shfl_xor(s, o);
        const float mu = s * (1.f / 64.f);
        float q = 0.f;
#pragma unroll
        for (int i = 0; i < 4; ++i) { y[i] -= mu; q += y[i] * y[i]; }
#pragma unroll
        for (int o = 1; o < 16; o <<= 1) q += __shfl_xor(q, o);
        const float rstd = rsqrtf(q * (1.f / 64.f) + 64e-5f);
        const int hh = F.lane >> 4;
        const float bon = ((const GAS float*)BON)[(size_t)tok * 4 + hh] + ((const GAS float*)BON)[((size_t)MTOK + tok) * 4 + hh];
        const float v4[4] = {bflo(vv.x), bfhi(vv.x), bflo(vv.y), bfhi(vv.y)}, g4[4] = {bflo(gg.x), bfhi(gg.x), bflo(gg.y), bfhi(gg.y)};
        float o4[4];
#pragma unroll
        for (int i = 0; i < 4; ++i) o4[i] = (y[i] * rstd * lg[i] + lb[i] + bon * v4[i]) * g4[i];
        u32x2 w; w.x = pk2(o4[0], o4[1]); w.y = pk2(o4[2], o4[3]);
        *(GAS u32x2*)((GAS bf16_t*)MIX + (size_t)tok * DM + 768 + 4 * F.lane) = w;
    }
}

__device__ __forceinline__ void prologue(Frame& F, const Params& p) {
    REFRAME(F);
    LAS float* scr = (LAS float*)(F.lds + F.wave * 16384);
    const int gw = F.bid * 8 + F.wave, NGW = F.G * 8;
    bf16_t* wb = (bf16_t*)(p.ws + WS_W);
    for (int it = gw; it < CV_TOTAL; it += NGW) { if (it < CV_A) cvt_item_a(p, 0, wb, scr, it, F.lane); else cvt_item_b(p, 0, wb, scr, it - CV_A, F.lane); }
    const float* x = p.in[0]; float* X = p.out; bf16_t* XB = (bf16_t*)(p.ws + WS_XB); float* rowss = (float*)(p.ws + WS_RP);
    for (int m = gw; m < MTOK; m += NGW) {
        const f32x4* xr = (const f32x4*)(x + (size_t)m * DM) + F.lane; f32x4* xo = (f32x4*)(X + (size_t)m * DM) + F.lane; u32x2* bo = (u32x2*)(XB + (size_t)m * DM) + F.lane;
        float s = 0.f;
#pragma unroll
        for (int jj = 0; jj < 4; ++jj) { const f32x4 v = xr[64 * jj]; xo[64 * jj] = v; s += (v[0] * v[0] + v[1] * v[1]) + (v[2] * v[2] + v[3] * v[3]);
            u32x2 w; w.x = pk2(v[0], v[1]); w.y = pk2(v[2], v[3]); bo[64 * jj] = w; }
        s = wave_sum(s);
        if (F.lane < 16) rowss[(size_t)m * 16 + F.lane] = (F.lane == 0) ? s : 0.f;
    }
    const float* mem = p.in[1]; const float* gm = p.in[23]; bf16_t* MN = (bf16_t*)(p.ws + WS_MEMN);
    for (int m = gw; m < MMEM; m += NGW) {
        const f32x4* xr = (const f32x4*)(mem + (size_t)m * DM) + F.lane; u32x2* bo = (u32x2*)(MN + (size_t)m * DM) + F.lane;
        f32x4 v[4]; float s = 0.f;
#pragma unroll
        for (int jj = 0; jj < 4; ++jj) { v[jj] = xr[64 * jj]; s += (v[jj][0] * v[jj][0] + v[jj][1] * v[jj][1]) + (v[jj][2] * v[jj][2] + v[jj][3] * v[jj][3]); }
        const float rstd = rsqrtf(wave_sum(s) * (1.f / 1024.f) + 1e-6f);
#pragma unroll
        for (int jj = 0; jj < 4; ++jj) { const f32x4 g = *((const f32x4*)gm + F.lane + 64 * jj); const f32x4 t = v[jj] * rstd * g;
            u32x2 w; w.x = pk2(t[0], t[1]); w.y = pk2(t[2], t[3]); bo[64 * jj] = w; }
    }
}
__device__ __forceinline__ void final_norm(Frame& F, const Params& p) {
    REFRAME(F);
    const int gw = F.bid * 8 + F.wave, NGW = F.G * 8;
    const float* rowss = (const float*)(p.ws + WS_RP) + (size_t)12 * MTOK * 16; const float* gf = p.in[30];
    for (int m = gw; m < MTOK; m += NGW) {
        f32x4* xo = (f32x4*)(p.out + (size_t)m * DM) + F.lane;
        const float rstd = row_rstd(rowss, m);
#pragma unroll
        for (int jj = 0; jj < 4; ++jj) { const f32x4 g = *((const f32x4*)gf + F.lane + 64 * jj); xo[64 * jj] = xo[64 * jj] * rstd * g; }
#ifdef TPROBE
        { const unsigned* c_ = (const unsigned*)(p.ws + WS_CTL); const float A_ = (float)c_[32] * 1e-4f, B_ = (float)c_[33] * 1e-4f;
          if (m >= 1024 && m < 2048) {
#pragma unroll
              for (int jj = 0; jj < 4; ++jj) xo[64 * jj] = xo[64 * jj] + B_; }
          if (m == 0 && F.lane == 0) { f32x4 v = xo[0]; v[0] += A_; xo[0] = v; } }
#endif
    }
}

#define XB_TMO      128
#define XB_XCNT(j)  (256  + 64 * (j))
#define XB_XSUB(j)  (1280 + 64 * (j))
#define XB_XGEN(j)  (2304 + 64 * (j))
#define XB_TOP      3328
#define XB_TOPGEN   3392
#define XB_SPIN_CAP (1u << 22)
constexpr int CW_BAR = 4096;
__device__ __forceinline__ unsigned xb_ld(unsigned* p)              { return __hip_atomic_load(p, __ATOMIC_RELAXED, __HIP_MEMORY_SCOPE_AGENT); }
__device__ __forceinline__ unsigned xb_add(unsigned* p, unsigned v) { return __hip_atomic_fetch_add(p, v, __ATOMIC_RELAXED, __HIP_MEMORY_SCOPE_AGENT); }
__device__ __forceinline__ unsigned xb_xcc_id() { return (unsigned)__builtin_amdgcn_s_getreg((3 << 11) | 20) & 0xFu; }
#define XB_SPIN(cond, bar) do { unsigned _sp = 0; while (cond) { __builtin_amdgcn_s_sleep(1); \
    if ((++_sp & 255u) == 0u) { if (xb_ld(&(bar)[XB_TMO])) break; if (_sp > XB_SPIN_CAP) { atomicAdd(&(bar)[XB_TMO], 1u); break; } } } } while (0)
__device__ __forceinline__ void xcd_barrier_complete(unsigned* bar, unsigned x, unsigned& nloc, unsigned& nx) {
    const unsigned G = gridDim.x;
    unsigned sum, cnt, mine, sp = 0u;
    for (;;) {
        sum = 0u; cnt = 0u; mine = 0u;
#pragma unroll
        for (unsigned j = 0; j < 16; ++j) { const unsigned c = xb_ld(&bar[XB_XCNT(j)]); sum += c; cnt += (c > 0u) ? 1u : 0u; mine = (j == x) ? c : mine; }
        if (sum == G) break;
        __builtin_amdgcn_s_sleep(1);
        if ((++sp & 255u) == 0u) { if (xb_ld(&bar[XB_TMO])) break; if (sp > XB_SPIN_CAP) { atomicAdd(&bar[XB_TMO], 1u); break; } }
    }
    nloc = mine > 0u ? mine : 1u; nx = cnt > 0u ? cnt : 1u;
}
__device__ __forceinline__ void gsync(volatile LAS unsigned* st) {
    unsigned* bar = (unsigned*)(make_params().ws + WS_CTL) + CW_BAR;
    asm volatile("s_waitcnt vmcnt(0)" ::: "memory");
    __syncthreads();
    if (threadIdx.x == 0) {
        const unsigned x = xb_xcc_id();
        __builtin_amdgcn_s_waitcnt(0);
        unsigned nloc = st[0], nx = st[1];
        if (nloc == 0u) { xcd_barrier_complete(bar, x, nloc, nx); st[0] = nloc; st[1] = nx; }
        const unsigned old = xb_add(&bar[XB_XSUB(x)], 1u);
        const unsigned gen = old / nloc;
        if (old + 1u == (gen + 1u) * nloc) {
            __builtin_amdgcn_fence(__ATOMIC_RELEASE, "agent");
            asm volatile("s_waitcnt vmcnt(0)" ::: "memory");
            const unsigned og = xb_add(&bar[XB_TOP], 1u);
            const unsigned tg = og / nx;
            if (og + 1u == (tg + 1u) * nx) xb_add(&bar[XB_TOPGEN], 1u);
            else XB_SPIN(xb_ld(&bar[XB_TOPGEN]) == tg, bar);
            __builtin_amdgcn_fence(__ATOMIC_ACQUIRE, "agent");
            xb_add(&bar[XB_XGEN(x)], 1u);
            asm volatile("s_waitcnt vmcnt(0)" ::: "memory");
        } else {
            XB_SPIN(xb_ld(&bar[XB_XGEN(x)]) == gen, bar);
            __builtin_amdgcn_fence(__ATOMIC_ACQUIRE, "agent");
            asm volatile("s_waitcnt vmcnt(0)" ::: "memory");
        }
    }
    __syncthreads();
}
#ifdef TPROBE
#define STAMP(id) do { if (blockIdx.x == 0 && threadIdx.x == 0) { LAS unsigned long long* ts_ = (LAS unsigned long long*)(F.lds + 131072 + 64); const unsigned long long now_ = __builtin_amdgcn_s_memrealtime(); \
    const unsigned long long dt_ = now_ - ts_[0]; ts_[0] = now_; if ((TA_MASK >> (id)) & 1) ts_[1] += dt_; if ((TB_MASK >> (id)) & 1) ts_[2] += dt_; } } while (0)
#else
#define STAMP(id) do { } while (0)
#endif
#ifndef PH_MASK
#define PH_MASK 0xFFFF
#endif
#ifndef REP_MASK
#define REP_MASK 0
#endif
#define NREP(k) ((((REP_MASK) >> (k)) & 1) ? 2 : 1)
constexpr int NCP = 1024, NDIFF_A = 0, NPB = 32;
__global__ void __launch_bounds__(512, 2) fwd_megakernel(KArgs kargs_unused) {
    extern __shared__ __attribute__((aligned(16))) unsigned char lds_raw[];
    cg::grid_group grid = cg::this_grid();
    Frame F; F.lds = (LAS unsigned char*)lds_raw; F.tid = threadIdx.x; F.lane = F.tid & 63; F.wave = __builtin_amdgcn_readfirstlane(F.tid >> 6); F.G = gridDim.x; F.bid = blockIdx.x;
    LAS int* qslot = (LAS int*)(F.lds + 131072);
    volatile LAS unsigned* bst = (volatile LAS unsigned*)(F.lds + 131072 + 32);
    { unsigned* bar0 = (unsigned*)(make_params().ws + WS_CTL) + CW_BAR;
      if (threadIdx.x == 0) { bst[0] = 0u; bst[1] = 0u; (void)xb_add(bar0 + XB_XCNT(xb_xcc_id()), 1u); } }
    __syncthreads();
#define PHASE_VARS() const Params p = make_params(); unsigned* ctl = (unsigned*)(p.ws + WS_CTL); float* rowss = (float*)(p.ws + WS_RP); \
    bf16_t* XB = (bf16_t*)(p.ws + WS_XB); bf16_t* Z = (bf16_t*)(p.ws + WS_Z); bf16_t* MIX = (bf16_t*)(p.ws + WS_MIX); \
    bf16_t* wb = (bf16_t*)(p.ws + WS_W); int bid_ = F.bid, G_ = F.G; asm volatile("" : "+s"(bid_), "+s"(G_)); (void)bid_; (void)G_; (void)ctl; (void)rowss; (void)XB; (void)Z; (void)MIX; (void)wb

#ifdef TPROBE
    if (blockIdx.x == 0 && threadIdx.x == 0) { LAS unsigned long long* ts_ = (LAS unsigned long long*)(F.lds + 131072 + 64); ts_[0] = __builtin_amdgcn_s_memrealtime(); ts_[1] = 0; ts_[2] = 0; }
#endif
    if (PH_MASK & 1) { const Params p = make_params(); prologue(F, p); }
    grid.sync();
    STAMP(0);

    for (int l = 0; l < NL; ++l) {
        for (int rep = 0; rep < NREP(1); ++rep) {
        if (PH_MASK & 2) {
            PHASE_VARS();
            pg8::StaticOrder S; S.init(MTOK, INW, G_, bid_);
            pg8::gemm_phase(F.lds, pg8::Gemm{XB, wb + WO_IN, MTOK, INW, DM}, S, pg8::EpiScaleBf16{Z, ZP, rowss + (size_t)(3 * l) * MTOK * 16, (bf16_t*)(p.ws + WS_ZC), 1024, 8, (bf16_t*)(p.ws + WS_KD2)});
        }
        gsync(bst); STAMP(1);
        }
        for (int rep = 0; rep < NREP(2); ++rep) {
        for (int u = F.bid; u < 768; u += F.G) {
            PHASE_VARS();
            if (u < 512) { if (PH_MASK & 4) prep_unit(F, p, l, wb, u); } else if (PH_MASK & 8) win_unit(F, p, l, u - 512);
        }
        gsync(bst); STAMP(2);
        }
        for (int rep = 0; rep < NREP(3); ++rep) {
        {
            PHASE_VARS();
            const int ntot = NCP + NDIFF_A;
            for (;;) {
                __syncthreads();
                if (F.tid == 0) *qslot = (int)atomicAdd(ctl + CW_Q + 16 * l + 4 * rep, 1u);
                __syncthreads();
                const int u = *qslot;
                if (u >= ntot) break;
                if (u < NCP) { if (PH_MASK & 16) { REFRAME(F); if (u >= NCP / 2) chunkprep_wave<1>(F, p, u * 8 + F.wave); else chunkprep_wave<0>(F, p, u * 8 + F.wave); } }
                else if (PH_MASK & 32) diff_unit(F, p, l, u - NCP);
            }
        }
        gsync(bst); STAMP(11);
        }
        for (int rep = 0; rep < NREP(4); ++rep) {
        {
            PHASE_VARS();
            const int ncva = (l + 1 < NL) ? CV_A / 8 : 0, ncvb = (l > 0) ? CV_B / 8 : 0, ncv = NPB + ncva + ncvb, ntot = ncv + 256;
            unsigned* pbdone = ctl + 3072 + (l * 2 + rep) * 16;
            unsigned* gq = ctl + CW_Q + 16 * l + 8 + 4 * rep; unsigned* dq = ctl + 2048 + (l * 2 + rep) * 16;
            const int myx = (int)(xb_xcc_id() & 7u);
            int stage = 0, pend = -1, xi = 0;
            for (;;) {
                __syncthreads();
                if (F.tid == 0) {
                    int code = -1;
                    if (stage == 0) { const int g = (int)atomicAdd(gq, 1u); if (g < NPB) code = g; else { pend = g; stage = 1; } }
                    if (stage == 1) {
                        while (xi < 8) { const int x = (myx + xi) & 7; const int tk = (int)atomicAdd(dq + x, 1u); if (tk < 64) { code = -2 - ((4 * x + (tk >> 4)) * 16 + (tk & 15)); break; } ++xi; }
                        if (xi >= 8) stage = 2;
                    }
                    if (stage == 2 && code == -1) { int g = pend; pend = -1; if (g < 0) g = (int)atomicAdd(gq, 1u); if (g < ntot) code = g; }
                    *qslot = code;
                }
                __syncthreads();
                const int u = *qslot;
                if (u == -1) break;
                if (u <= -2) { if (PH_MASK & 32) diff_unit(F, p, l, -2 - u); }
                else if (u < NPB) { if (PH_MASK & 16) { REFRAME(F); phaseb_unit(F, p, u); }
                    __threadfence(); __syncthreads();
                    if (F.tid == 0) __hip_atomic_fetch_add(pbdone, 1u, __ATOMIC_RELEASE, __HIP_MEMORY_SCOPE_AGENT); }
                else if (u >= ncv) {
                    if (F.tid == 0) { while (__hip_atomic_load(pbdone, __ATOMIC_RELAXED, __HIP_MEMORY_SCOPE_AGENT) < (unsigned)NPB) __builtin_amdgcn_s_sleep(8); }
                    __syncthreads(); __builtin_amdgcn_fence(__ATOMIC_ACQUIRE, "agent");
                    if (PH_MASK & 64) post_unit(F, p, l, u - ncv); }
                else if (u < NPB + ncva) { REFRAME(F); cvt_item_a(p, l + 1, wb, (LAS float*)(F.lds + F.wave * 16384), (u - NPB) * 8 + F.wave, F.lane); }
                else { REFRAME(F); cvt_item_b(p, l, wb, (LAS float*)(F.lds + F.wave * 16384), (u - NPB - ncva) * 8 + F.wave, F.lane); }
            }
        }
        gsync(bst); STAMP(3);
        }
        if (PH_MASK & 128) {
            PHASE_VARS();
            pg8::StaticOrder S; S.init(MTOK, DM, G_, bid_);
            pg8::gemm_phase(F.lds, pg8::Gemm{MIX, wb + WO_OUT, MTOK, DM, DM}, S, pg8::EpiResid{p.out, XB, rowss + (size_t)(3 * l + 1) * MTOK * 16});
        }
        gsync(bst); STAMP(5);
        for (int rep = 0; rep < NREP(6); ++rep) {
        if (PH_MASK & 256) {
            PHASE_VARS();
            pg8::StaticOrder S; S.init(MTOK, XW, G_, bid_);
            if (F.bid < 128) {
                pg8::gemm_phase(F.lds, pg8::Gemm{XB, wb + WO_Q, MTOK, XW, DM}, S, pg8::EpiScaleBf16{(bf16_t*)(p.ws + WS_Q), XW, rowss + (size_t)(3 * l + 1) * MTOK * 16, nullptr, 0, 1 << 30, nullptr});
            } else {
                pg8::StaticOrder S2; S2.init(MMEM, 1024, 128, F.bid - 128);
                pg8::gemm_phase(F.lds, pg8::Gemm{(const bf16_t*)(p.ws + WS_MEMN), wb + WO_KV, MMEM, 1024, DM}, S2, pg8::EpiScaleBf16{(bf16_t*)(p.ws + WS_KV), 1024, nullptr, nullptr, 0, 1 << 30, nullptr});
            }
        }
        gsync(bst); STAMP(6);
        }
        for (int rep = 0; rep < NREP(7); ++rep) {
        if (PH_MASK & 512) for (int u = F.bid; u < 256; u += F.G) { PHASE_VARS(); cross_unit(F, p, u); }
        gsync(bst); STAMP(7);
        }
        if (PH_MASK & 1024) {
            PHASE_VARS();
            pg8::StaticOrder S; S.init(MTOK, DM, G_, bid_);
            pg8::gemm_phase(F.lds, pg8::Gemm{(const bf16_t*)(p.ws + WS_O), wb + WO_O, MTOK, DM, XW}, S, pg8::EpiResid{p.out, XB, rowss + (size_t)(3 * l + 2) * MTOK * 16});
        }
        gsync(bst); STAMP(8);
        for (int rep = 0; rep < NREP(9); ++rep) {
        if (PH_MASK & 2048) {
            PHASE_VARS();
            pg8::StaticOrder S; S.init(MTOK, 2 * DFF, G_, bid_);
            pg8::gemm_phase(F.lds, pg8::Gemm{XB, wb + WO_GU, MTOK, 2 * DFF, DM}, S, pg8::EpiSwiGLU{(bf16_t*)(p.ws + WS_G), rowss + (size_t)(3 * l + 2) * MTOK * 16});
        }
        gsync(bst); STAMP(9);
        }
        if (PH_MASK & 4096) {
            PHASE_VARS();
            pg8::StaticOrder S; S.init(MTOK, DM, G_, bid_);
            pg8::gemm_phase(F.lds, pg8::Gemm{(const bf16_t*)(p.ws + WS_G), wb + WO_DOWN, MTOK, DM, DFF}, S, pg8::EpiResid{p.out, XB, rowss + (size_t)(3 * l + 3) * MTOK * 16});
        }

#ifdef TPROBE
        STAMP(10);
        { const Params p = make_params(); if (l == NL - 1 && blockIdx.x == 0 && threadIdx.x == 0) { LAS unsigned long long* ts_ = (LAS unsigned long long*)(F.lds + 131072 + 64); unsigned* c_ = (unsigned*)(p.ws + WS_CTL); c_[32] = (unsigned)ts_[1]; c_[33] = (unsigned)ts_[2]; } }
#endif
        gsync(bst);
    }
    if (PH_MASK & 8192) { const Params p = make_params(); final_norm(F, p); }
}

extern "C" void kernel_launch(void* const* d_in, const int* in_sizes, int n_in, void* d_out, int out_size, void* d_ws, size_t ws_size, hipStream_t stream) {
    static int grid = 0;
    if (grid == 0) {
        if (n_in != 31 || out_size != MTOK * DM || ws_size < WS_END) { fprintf(stderr, "kernel_launch: unexpected problem shape (n_in %d out %d ws %zu)\n", n_in, out_size, ws_size); grid = -1; return; }
        int dev = 0, cus = 0, per_cu = 0;
        hipGetDevice(&dev);
        hipDeviceGetAttribute(&cus, hipDeviceAttributeMultiprocessorCount, dev);
        hipFuncSetAttribute((const void*)fwd_megakernel, hipFuncAttributeMaxDynamicSharedMemorySize, LDS_BYTES);
        hipOccupancyMaxActiveBlocksPerMultiprocessor(&per_cu, (const void*)fwd_megakernel, 512, LDS_BYTES);
        if (per_cu < 1) { fprintf(stderr, "kernel_launch: occupancy query returned %d\n", per_cu); per_cu = 1; }
        (void)hipGetLastError();
        grid = cus * per_cu;
    }
    if (grid < 0) return;
    hipMemsetAsync((char*)d_ws + WS_CTL, 0, CTL_ZERO_BYTES, stream);
    KArgs p{};
    for (int i = 0; i < 31; ++i) p.in[i] = (const float*)d_in[i];
    p.out = (float*)d_out; p.ws = (unsigned char*)d_ws;
    void* args[] = {&p};
    hipError_t e = hipLaunchCooperativeKernel((const void*)fwd_megakernel, dim3(grid), dim3(512), args, LDS_BYTES, stream);
    if (e != hipSuccess) fprintf(stderr, "cooperative launch failed: %s (grid %d)\n", hipGetErrorString(e), grid);
}
```

```cpp
#include <hip/hip_runtime.h>
#include <hip/hip_cooperative_groups.h>
#include <cstdio>
#include <cstdint>
namespace cg = cooperative_groups;

#define LAS __attribute__((address_space(3)))
#define GAS __attribute__((address_space(1)))
typedef unsigned short bf16_t;
typedef short bf16x8 __attribute__((ext_vector_type(8)));
typedef short s16x4 __attribute__((ext_vector_type(4)));
typedef short v4i16_t __attribute__((ext_vector_type(4)));
typedef float f32x4 __attribute__((ext_vector_type(4)));
typedef float f32x2 __attribute__((ext_vector_type(2)));
typedef float f32x16 __attribute__((ext_vector_type(16)));
typedef unsigned u32x4 __attribute__((ext_vector_type(4)));
typedef unsigned u32x2 __attribute__((ext_vector_type(2)));
typedef __bf16 bf16x2_t __attribute__((ext_vector_type(2)));

constexpr int DM = 1024, NB = 8, SEQ = 2048, NL = 4, MTOK = NB * SEQ;
constexpr int NMEM = 256, MMEM = NB * NMEM;
constexpr int INW = 3072, DFF = 2816, XW = 512;
constexpr float LOG2E = 1.4426950408889634f;

constexpr size_t MiB = 1u << 20;
constexpr size_t WS_CTL = 0, CTL_ZERO_BYTES = 1 * MiB;
constexpr size_t WS_W = 1 * MiB;
constexpr size_t WS_Z = 30 * MiB;
constexpr size_t WS_ZC = 94 * MiB;
constexpr size_t WS_XB = 126 * MiB;
constexpr size_t WS_FQR = 94 * MiB, WS_FWY = 126 * MiB, WS_FNA = 158 * MiB, WS_FKH = 174 * MiB, WS_FP15 = 190 * MiB;
constexpr size_t WS_MIX = 192 * MiB;
constexpr size_t WS_OM = 224 * MiB, WS_KA = 240 * MiB, WS_KD = 256 * MiB, WS_KK = 272 * MiB, WS_V = 280 * MiB, WS_R = 288 * MiB;
constexpr size_t WS_GATE = 296 * MiB, WS_Y = 304 * MiB, WS_BON = 320 * MiB, WS_KV = 321 * MiB, WS_MEMN = 325 * MiB;
constexpr size_t WS_RP = 329 * MiB;
constexpr size_t WS_END = 342 * MiB;
constexpr size_t WS_Q = WS_Z, WS_O = WS_Z + 16 * MiB, WS_G = WS_Z;
constexpr int ZP = 1024;
constexpr size_t WS_KD2 = WS_Z + 32 * MiB, WS_VD2 = WS_Z + 48 * MiB;
constexpr size_t WO_IN = 0, WO_OUT = 3145728, WO_Q = 4194304, WO_KV = 4718592, WO_O = 5767168, WO_GU = 6291456, WO_DOWN = 12058624;
constexpr size_t WO_WUP = 14942208, WO_AUP = 14974976, WO_GUP = 15007744;
constexpr int CW_Q = 64;

constexpr int LDS_BYTES = 135168;

__device__ __forceinline__ float bf2f(unsigned b) { return __uint_as_float(b << 16); }
__device__ __forceinline__ unsigned pk2(float lo, float hi) { f32x2 v = {lo, hi}; bf16x2_t b = __builtin_convertvector(v, bf16x2_t); return __builtin_bit_cast(unsigned, b); }
__device__ __forceinline__ float bflo(unsigned u) { return __uint_as_float(u << 16); }
__device__ __forceinline__ float bfhi(unsigned u) { return __uint_as_float(u & 0xffff0000u); }
__device__ __forceinline__ float wave_sum(float v) {
#pragma unroll
    for (int o = 1; o < 64; o <<= 1) v += __shfl_xor(v, o);
    return v;
}
__device__ __forceinline__ float xhalf(float v) {
    return __shfl_xor(v, 32);
}
__device__ __forceinline__ float row_rstd(const float* rp, int row) {
    const f32x4* q = (const f32x4*)(rp + (size_t)row * 16); const f32x4 a = q[0], b = q[1], c = q[2], d = q[3];
    const float s = (((a[0] + a[1]) + (a[2] + a[3])) + ((b[0] + b[1]) + (b[2] + b[3]))) + (((c[0] + c[1]) + (c[2] + c[3])) + ((d[0] + d[1]) + (d[2] + d[3])));
    return rsqrtf(s * (1.f / 1024.f) + 1e-6f);
}
__device__ __forceinline__ float sigmoidf_(float x) { return __builtin_amdgcn_rcpf(1.f + __expf(-x)); }

__device__ __forceinline__ int hw_lane() { int l = (int)__builtin_amdgcn_mbcnt_hi(~0u, __builtin_amdgcn_mbcnt_lo(~0u, 0u)); asm volatile("" : "+v"(l)); return l; }
namespace pg8 {
constexpr int BM = 256, BK = 64, HALF = 128, HTB = HALF * BK * 2, NXCD = 8, WGM = 8;
__host__ __device__ __forceinline__ int lds_byte(int r, int c) { const int st = (r >> 4) * 2 + (c >> 5), rr = r & 15, cc = c & 31, ob = rr * 64 + cc * 2; return st * 1024 + (ob ^ (((ob >> 9) & 1) << 5)); }
__host__ __device__ __forceinline__ void stage_rc(int b, int& R, int& C) { const int st = b / 1024, sb = b % 1024, swz = sb ^ (((sb >> 9) & 1) << 5); R = (st >> 1) * 16 + swz / 64; C = (st & 1) * 32 + (swz % 64) / 2; }
__host__ __device__ __forceinline__ int perm32(int rho) { const int n = rho >> 4, i = rho & 15; return 8 * (i >> 2) + 4 * n + (i & 3); }
struct Unit { int pm, pn; };
struct Gemm { const bf16_t* A; const bf16_t* Bt; int M, N, K; };
struct StaticOrder {
    int nM, nN, nwg, G, c;
    __device__ void init(int M, int N, int G_, int c_) { nM = M / BM; nN = N / BM; nwg = nM * nN; G = G_; c = c_; }
    __device__ bool next(int i, Unit& u) const {
        const long L = (long)i * G + c; if (L >= nwg) return false;
        int wgid = (int)L; { const int q = nwg / NXCD, r = nwg % NXCD, xcd = wgid % NXCD, off = wgid / NXCD; wgid = (xcd < r ? xcd * (q + 1) : r * (q + 1) + (xcd - r) * q) + off; }
        const int nig = WGM * nN, gid = wgid / nig, fm = gid * WGM, gsz = (nM - fm) < WGM ? (nM - fm) : WGM;
        u.pm = fm + ((wgid % nig) % gsz); u.pn = (wgid % nig) / gsz; return true;
    }
};
template <class Epi>
__device__ __forceinline__ void gemm_phase(LAS unsigned char* lds, const Gemm g, const StaticOrder& S, const Epi& E) {
    int tid_ = threadIdx.x; asm volatile("" : "+v"(tid_));
    const int tid = tid_, wid = __builtin_amdgcn_readfirstlane(tid >> 6), lane = tid & 63, wr = wid >> 2, wc = wid & 3, fr = lane & 15, fq = lane >> 4;
    const int K = g.K, nt = K / BK;
    unsigned voffA[2], voffB[2];
#pragma unroll
    for (int i = 0; i < 2; ++i) { int R, C; stage_rc(tid * 16 + i * 8192, R, C); const int Rb = (R & ~31) + perm32(R & 31);
        voffA[i] = (unsigned)(R * K + C) * 2u; voffB[i] = (unsigned)(Rb * K + C) * 2u; }
    const size_t kstep = (size_t)(BK * 2);
    const size_t hstep = (size_t)HALF * K * 2;
    const size_t tstep = 2 * hstep;
    const unsigned ldsw = (unsigned)wid * 1024u;
    const int aoff = lds_byte(wr * 64 + fr, fq * 8), boff = lds_byte(wc * 32 + fr, fq * 8);
#define PG8_SA(b, h) (((b) * 2 + (h)) * HTB)
#define PG8_SB(b, h) ((4 + (b) * 2 + (h)) * HTB)
#define PG8_STAGE(bufoff, gbase, voff) do { _Pragma("unroll") for (int _i = 0; _i < 2; ++_i) \
        __builtin_amdgcn_global_load_lds((const unsigned*)((const char*)(gbase) + (voff)[_i]), (LAS unsigned*)(lds + (bufoff) + ldsw + _i * 8192), 16, 0, 0); } while (0)
#define PG8_LDA(dst, b, h) do { _Pragma("unroll") for (int m = 0; m < 4; ++m) _Pragma("unroll") for (int k = 0; k < 2; ++k) dst[m][k] = *(const LAS bf16x8*)(lds + PG8_SA(b, h) + aoff + m * 2048 + k * 1024); } while (0)
#define PG8_LDB(dst, b, h) do { _Pragma("unroll") for (int n = 0; n < 2; ++n) _Pragma("unroll") for (int k = 0; k < 2; ++k) dst[n][k] = *(const LAS bf16x8*)(lds + PG8_SB(b, h) + boff + n * 2048 + k * 1024); } while (0)
#define PG8_MMA(ai, bj, At, Bt) do { __builtin_amdgcn_s_setprio(1); _Pragma("unroll") for (int m = 0; m < 4; ++m) _Pragma("unroll") for (int n = 0; n < 2; ++n) _Pragma("unroll") for (int k = 0; k < 2; ++k) \
        acc[ai][bj][m][n] = __builtin_amdgcn_mfma_f32_16x16x32_bf16(Bt[n][k], At[m][k], acc[ai][bj][m][n], 0, 0, 0); __builtin_amdgcn_s_setprio(0); } while (0)
#define PG8_WAIT_V(n) asm volatile("s_waitcnt vmcnt(" #n ")" ::: "memory")
#define PG8_WAIT_L(n) asm volatile("s_waitcnt lgkmcnt(" #n ")" ::: "memory")
#define PG8_BAR __builtin_amdgcn_s_barrier()
#define PG8_SCHED __builtin_amdgcn_sched_barrier(0)
    Unit cur, nxt; int ui = 0;
    if (!S.next(0, cur)) return;
    f32x4 acc[2][2][4][2];
#pragma unroll
    for (int a = 0; a < 2; ++a)
#pragma unroll
        for (int b = 0; b < 2; ++b)
#pragma unroll
            for (int m = 0; m < 4; ++m)
#pragma unroll
                for (int n = 0; n < 2; ++n) acc[a][b][m][n] = (f32x4){0.f, 0.f, 0.f, 0.f};
    bf16x8 At[4][2], B0[2][2], B1[2][2];
    const char* cA = (const char*)g.A + (size_t)cur.pm * tstep; const char* cB = (const char*)g.Bt + (size_t)cur.pn * tstep;
    {
        PG8_STAGE(PG8_SB(0, 0), cB, voffB); PG8_STAGE(PG8_SB(0, 1), cB + hstep, voffB); PG8_STAGE(PG8_SA(0, 0), cA, voffA); PG8_STAGE(PG8_SA(0, 1), cA + hstep, voffA);
        if (wr == 1) PG8_BAR;
        PG8_WAIT_V(2); PG8_BAR;
        PG8_STAGE(PG8_SB(1, 0), cB + kstep, voffB); PG8_STAGE(PG8_SA(1, 0), cA + kstep, voffA); PG8_STAGE(PG8_SB(1, 1), cB + hstep + kstep, voffB);
        PG8_WAIT_V(6); PG8_BAR;
    }
    for (;;) {
        const bool has_next = S.next(ui + 1, nxt);
        const char* nA = has_next ? (const char*)g.A + (size_t)nxt.pm * tstep : cA; const char* nB = has_next ? (const char*)g.Bt + (size_t)nxt.pn * tstep : cB;
        for (int t = 0; t < nt; t += 2) {
            const bool last = (t == nt - 2);
            const char* a1 = cA + (size_t)(t + 1) * kstep;
            const char* a2 = last ? nA : cA + (size_t)(t + 2) * kstep; const char* b2 = last ? nB : cB + (size_t)(t + 2) * kstep;
            const char* a3 = a2 + kstep; const char* b3 = b2 + kstep;
            PG8_LDB(B0, 0, 0); PG8_LDB(B1, 0, 1); PG8_SCHED; PG8_LDA(At, 0, 0); PG8_STAGE(PG8_SA(1, 1), a1 + hstep, voffA);
            PG8_WAIT_V(8); PG8_WAIT_L(0); PG8_BAR; PG8_MMA(0, 0, At, B0); PG8_MMA(0, 1, At, B1); PG8_BAR; PG8_SCHED;
            PG8_LDA(At, 0, 1); PG8_STAGE(PG8_SB(0, 0), b2, voffB); PG8_STAGE(PG8_SB(0, 1), b2 + hstep, voffB); PG8_STAGE(PG8_SA(0, 0), a2, voffA);
            PG8_WAIT_V(8); PG8_WAIT_L(0); PG8_BAR; PG8_MMA(1, 0, At, B0); PG8_MMA(1, 1, At, B1); PG8_BAR; PG8_SCHED;
            PG8_LDB(B0, 1, 0); PG8_LDB(B1, 1, 1); PG8_SCHED; PG8_LDA(At, 1, 0); PG8_STAGE(PG8_SA(0, 1), a2 + hstep, voffA);
            PG8_WAIT_V(8); PG8_WAIT_L(0); PG8_BAR; PG8_MMA(0, 0, At, B0); PG8_MMA(0, 1, At, B1); PG8_BAR; PG8_SCHED;
            PG8_LDA(At, 1, 1); PG8_STAGE(PG8_SB(1, 0), b3, voffB); PG8_STAGE(PG8_SB(1, 1), b3 + hstep, voffB); PG8_STAGE(PG8_SA(1, 0), a3, voffA);
            PG8_WAIT_V(8); PG8_WAIT_L(0); PG8_BAR; PG8_MMA(1, 0, At, B0); PG8_MMA(1, 1, At, B1); PG8_BAR; PG8_SCHED;
        }
        if (wr == 0) PG8_BAR;
        E(acc, cur, wr, wc, fr, fq);
        if (!has_next) break;
#pragma unroll
        for (int a = 0; a < 2; ++a)
#pragma unroll
            for (int b = 0; b < 2; ++b)
#pragma unroll
                for (int m = 0; m < 4; ++m)
#pragma unroll
                    for (int n = 0; n < 2; ++n) acc[a][b][m][n] = (f32x4){0.f, 0.f, 0.f, 0.f};
        cur = nxt; cA = nA; cB = nB; ++ui;
        if (wr == 1) PG8_BAR;
    }
    PG8_WAIT_V(0);
    PG8_BAR;
#undef PG8_SA
#undef PG8_SB
#undef PG8_STAGE
#undef PG8_LDA
#undef PG8_LDB
#undef PG8_MMA
#undef PG8_WAIT_V
#undef PG8_WAIT_L
#undef PG8_BAR
#undef PG8_SCHED
}

struct EpiScaleBf16 {
    bf16_t* O; int ldc; const float* rowss; bf16_t* O2; int ldc2; int split_tile; bf16_t* KD2;
    __device__ __forceinline__ void operator()(const f32x4 (&acc)[2][2][4][2], const Unit& u, int wr, int wc, int fr, int fq) const {
        const bool hi = u.pn >= split_tile, mid = (split_tile == 8) && u.pn >= 4 && u.pn < 8;
        const int row0 = u.pm * BM + wr * 64 + fr, col0 = (hi ? u.pn - split_tile : u.pn) * BM + wc * 32 + 8 * fq;
        bf16_t* const Ob = hi ? O2 : O; const int ld = hi ? ldc2 : ldc;
#pragma unroll
        for (int ai = 0; ai < 2; ++ai)
#pragma unroll
            for (int m = 0; m < 4; ++m) { const int row = row0 + ai * HALF + m * 16;
                const float sc = rowss ? row_rstd(rowss, row) : 1.f;
                bf16_t* rowp = Ob + (size_t)row * ld + col0;
#pragma unroll
                for (int bj = 0; bj < 2; ++bj) { const f32x4 v0 = acc[ai][bj][m][0] * sc, v1 = acc[ai][bj][m][1] * sc;
                    u32x4 w; w.x = pk2(v0[0], v0[1]); w.y = pk2(v0[2], v0[3]); w.z = pk2(v1[0], v1[1]); w.w = pk2(v1[2], v1[3]);
                    bf16_t* dst = rowp + bj * HALF;
                    if (mid) dst = KD2 + (u.pn >= 6 ? (size_t)8388608 : (size_t)0) + ((size_t)(((row >> 11) * 4 + 2 * (u.pn & 1) + bj) * 2048 + (row & 2047))) * 128 + wc * 32 + 8 * fq;
                    *(u32x4*)dst = w; } }
    }
};
struct EpiSwiGLU {
    bf16_t* O; const float* rowss;
    __device__ __forceinline__ void operator()(const f32x4 (&acc)[2][2][4][2], const Unit& u, int wr, int wc, int fr, int fq) const {
        const int row0 = u.pm * BM + wr * 64 + fr, col0 = u.pn * HALF + wc * 32 + 8 * fq;
#pragma unroll
        for (int ai = 0; ai < 2; ++ai)
#pragma unroll
            for (int m = 0; m < 4; ++m) { const int row = row0 + ai * HALF + m * 16;
                const float sc = row_rstd(rowss, row);
                float h[8];
#pragma unroll
                for (int n = 0; n < 2; ++n)
#pragma unroll
                    for (int j = 0; j < 4; ++j) { const float gt = acc[ai][0][m][n][j] * sc, up = acc[ai][1][m][n][j] * sc; h[n * 4 + j] = gt * __builtin_amdgcn_rcpf(1.f + __expf(-gt)) * up; }
                u32x4 w; w.x = pk2(h[0], h[1]); w.y = pk2(h[2], h[3]); w.z = pk2(h[4], h[5]); w.w = pk2(h[6], h[7]);
                *(u32x4*)(O + (size_t)row * DFF + col0) = w; }
    }
};
struct EpiResid {
    float* X; bf16_t* XB; float* rowss_next;
    __device__ __forceinline__ void operator()(const f32x4 (&acc)[2][2][4][2], const Unit& u, int wr, int wc, int fr, int fq) const {
        const int row0 = u.pm * BM + wr * 64 + fr, col0 = u.pn * BM + wc * 32 + 8 * fq;
#pragma unroll
        for (int ai = 0; ai < 2; ++ai)
#pragma unroll
            for (int m = 0; m < 4; ++m) { const int row = row0 + ai * HALF + m * 16; float ss = 0.f;
                float* xp = X + (size_t)row * DM + col0; bf16_t* bp = XB + (size_t)row * DM + col0;
#pragma unroll
                for (int bj = 0; bj < 2; ++bj) {
                    f32x4 x0 = *(f32x4*)(xp + bj * HALF), x1 = *(f32x4*)(xp + bj * HALF + 4);
                    x0 = x0 + acc[ai][bj][m][0]; x1 = x1 + acc[ai][bj][m][1];
                    *(f32x4*)(xp + bj * HALF) = x0; *(f32x4*)(xp + bj * HALF + 4) = x1;
                    ss += (x0[0] * x0[0] + x0[1] * x0[1]) + (x0[2] * x0[2] + x0[3] * x0[3]) + (x1[0] * x1[0] + x1[1] * x1[1]) + (x1[2] * x1[2] + x1[3] * x1[3]);
                    u32x4 w; w.x = pk2(x0[0], x0[1]); w.y = pk2(x0[2], x0[3]); w.z = pk2(x1[0], x1[1]); w.w = pk2(x1[2], x1[3]);
                    *(u32x4*)(bp + bj * HALF) = w; }
                ss += __shfl_xor(ss, 16); ss += __shfl_xor(ss, 32);
                if (fq == 0) rowss_next[(size_t)row * 16 + u.pn * 4 + wc] = ss; }
    }
};
}

struct KArgs { const float* in[31]; float* out; unsigned char* ws; };
#define CAS __attribute__((address_space(4)))
struct InProxy { const CAS unsigned long long* k; __device__ __forceinline__ const float* operator[](int i) const { return (const float*)k[i]; } };
struct Params { InProxy in; float* out; unsigned char* ws; };
__device__ __forceinline__ Params make_params() {
    unsigned long long kv = (unsigned long long)__builtin_amdgcn_kernarg_segment_ptr();
    asm volatile("" : "+s"(kv));
    const CAS unsigned long long* k = (const CAS unsigned long long*)kv;
    Params p; p.in.k = k; p.out = (float*)k[31]; p.ws = (unsigned char*)k[32]; return p;
}

struct Frame {
    LAS unsigned char* lds;
    int tid, lane, wave, G, bid;
};

#define REFRAME(F) do { int _t = threadIdx.x; asm volatile("" : "+v"(_t)); (F).tid = _t; (F).lane = _t & 63; (F).wave = __builtin_amdgcn_readfirstlane(_t >> 6); } while (0)
__device__ __forceinline__ void cvt_item(const float* W_, int K, int ldn, int nblk, bf16_t* WT_, const float* gain_, bool perm_gu, LAS float* scr, int item, int lane) {
    const GAS float* W = (const GAS float*)W_; const GAS float* gain = (const GAS float*)gain_; GAS bf16_t* WT = (GAS bf16_t*)WT_;
    const int kb = item / nblk, nb = item % nblk, k0 = 64 * kb, n0d = 32 * nb;
    const int n0s = perm_gu ? (((n0d & 255) >> 7) * DFF + (n0d >> 8) * 128 + (n0d & 127)) : n0d;
    float v[32];
#pragma unroll
    for (int i = 0; i < 32; ++i) v[i] = W[(size_t)(k0 + 2 * i + (lane >> 5)) * ldn + n0s + (lane & 31)];
    if (gain_) {
#pragma unroll
        for (int i = 0; i < 32; ++i) v[i] *= gain[k0 + 2 * i + (lane >> 5)];
    }
#pragma unroll
    for (int i = 0; i < 32; ++i) scr[(2 * i + (lane >> 5)) * 33 + (lane & 31)] = v[i];
    asm volatile("s_waitcnt lgkmcnt(0)" ::: "memory");
    const int c = lane & 7;
#pragma unroll
    for (int j = 0; j < 4; ++j) { const int n = (lane >> 3) + 8 * j; const LAS float* sp = scr + (8 * c) * 33 + n;
        u32x4 o; o.x = pk2(sp[0 * 33], sp[1 * 33]); o.y = pk2(sp[2 * 33], sp[3 * 33]); o.z = pk2(sp[4 * 33], sp[5 * 33]); o.w = pk2(sp[6 * 33], sp[7 * 33]);
        *(GAS u32x4*)(WT + (size_t)(n0d + n) * K + k0 + 8 * c) = o; }
    asm volatile("s_waitcnt lgkmcnt(0)" ::: "memory");
}
constexpr int CV_IN = 1536, CV_OUT = 512, CV_Q = 256, CV_KV = 512, CV_O = 256, CV_GU = 2816, CV_DOWN = 1408, CV_L = 8;
constexpr int CV_TOTAL = CV_IN + CV_OUT + CV_Q + CV_KV + CV_O + CV_GU + CV_DOWN + 2 * CV_L + 2 * CV_L + 16;

static_assert(CV_TOTAL % 8 == 0, "conversion items per layer");
constexpr int CV_A = CV_IN + 2 * CV_L + 2 * CV_L + 16, CV_B = CV_KV + CV_OUT + CV_Q + CV_O + CV_GU + CV_DOWN;
static_assert(CV_A % 8 == 0 && CV_B % 8 == 0 && CV_A + CV_B == CV_TOTAL, "conversion lists");
__device__ __forceinline__ void cvt_item_a(const Params& p, int l, bf16_t* wb, LAS float* scr, int it, int lane) {
    int r = it;
    if (r < CV_IN) { cvt_item(p.in[3] + (size_t)l * DM * INW, DM, INW, INW / 32, wb + WO_IN, p.in[2] + l * DM, false, scr, r, lane); return; } r -= CV_IN;
    if (r < 2 * CV_L) { const int d = r / CV_L; cvt_item(p.in[12] + ((size_t)l * 2 + d) * 64 * 256, 64, 256, 8, wb + WO_WUP + d * 256 * 64, nullptr, false, scr, r % CV_L, lane); return; } r -= 2 * CV_L;
    if (r < 2 * CV_L) { const int d = r / CV_L; cvt_item(p.in[14] + ((size_t)l * 2 + d) * 64 * 256, 64, 256, 8, wb + WO_AUP + d * 256 * 64, nullptr, false, scr, r % CV_L, lane); return; } r -= 2 * CV_L;
    cvt_item(p.in[15] + (size_t)l * 128 * 256, 128, 256, 8, wb + WO_GUP, nullptr, false, scr, r, lane);
}
__device__ __forceinline__ void cvt_item_b(const Params& p, int l, bf16_t* wb, LAS float* scr, int it, int lane) {
    int r = it;
    if (r < CV_KV) { cvt_item(p.in[25] + (size_t)l * DM * 1024, DM, 1024, 32, wb + WO_KV, nullptr, false, scr, r, lane); return; } r -= CV_KV;
    if (r < CV_OUT) { cvt_item(p.in[21] + (size_t)l * DM * DM, DM, DM, DM / 32, wb + WO_OUT, nullptr, false, scr, r, lane); return; } r -= CV_OUT;
    if (r < CV_Q) { cvt_item(p.in[24] + (size_t)l * DM * XW, DM, XW, XW / 32, wb + WO_Q, p.in[22] + l * DM, false, scr, r, lane); return; } r -= CV_Q;
    if (r < CV_O) { cvt_item(p.in[26] + (size_t)l * XW * DM, XW, DM, 32, wb + WO_O, nullptr, false, scr, r, lane); return; } r -= CV_O;
    if (r < CV_GU) { cvt_item(p.in[28] + (size_t)l * DM * 2 * DFF, DM, 2 * DFF, 2 * DFF / 32, wb + WO_GU, p.in[27] + l * DM, true, scr, r, lane); return; } r -= CV_GU;
    cvt_item(p.in[29] + (size_t)l * DFF * DM, DFF, DM, 32, wb + WO_DOWN, nullptr, false, scr, r, lane);
}

__device__ __forceinline__ s16x4 vtr(const LAS unsigned char* p) { return __builtin_bit_cast(s16x4, __builtin_amdgcn_ds_read_tr16_b64_v4i16((LAS v4i16_t*)p)); }
__device__ __forceinline__ int crow(int r, int hi) { return (r & 3) + 8 * (r >> 2) + 4 * hi; }

template <int W> __device__ __forceinline__ void tile_load(u32x4 (&r)[W / 64], const bf16_t* g, int pitch, int tid) {
#pragma unroll
    for (int i = 0; i < W / 64; ++i) { const int id = tid + i * 512, row = id / (W / 8), ch = id % (W / 8); r[i] = *(const GAS u32x4*)((const GAS bf16_t*)g + (size_t)row * pitch + ch * 8); }
}
template <int W, int STR> __device__ __forceinline__ void tile_store(const u32x4 (&r)[W / 64], LAS unsigned char* buf, int tid) {
#pragma unroll
    for (int i = 0; i < W / 64; ++i) { const int id = tid + i * 512, row = id / (W / 8), ch = id % (W / 8); *(LAS u32x4*)(buf + row * STR + ch * 16) = r[i]; }
}
template <int DQK> __device__ __forceinline__ void load_q(bf16x8 (&qf)[DQK / 16], const bf16_t* qrow, int h, float sc) {
#pragma unroll
    for (int ks = 0; ks < DQK / 16; ++ks) { const u32x4 v = *(const GAS u32x4*)((const GAS bf16_t*)qrow + 16 * ks + 8 * h);
        u32x4 o; o.x = pk2(bflo(v.x) * sc, bfhi(v.x) * sc); o.y = pk2(bflo(v.y) * sc, bfhi(v.y) * sc); o.z = pk2(bflo(v.z) * sc, bfhi(v.z) * sc); o.w = pk2(bflo(v.w) * sc, bfhi(v.w) * sc);
        qf[ks] = __builtin_bit_cast(bf16x8, o); }
}
template <int DQK, int KW, int DV, int MODE>
__device__ __forceinline__ void attn_loop(LAS unsigned char* lds, const bf16_t* Kg, int kpitch, const bf16_t* Vg, int vpitch, int ntiles,
                                          const bf16x8 (&qf)[DQK / 16], int koff, float nslope2, int qrel, float& m, float& lsum, f32x16 (&o)[DV / 32]) {
    constexpr int KSTR = (KW + 8) * 2, VSTR = DV * 2 + 64, KBUF = 64 * KSTR, VBUF = 64 * VSTR;
    int tid_ = threadIdx.x; asm volatile("" : "+v"(tid_));
    const int tid = tid_, lane = tid & 63, r = lane & 31, h = lane >> 5;
    LAS unsigned char* K0 = lds; LAS unsigned char* V0 = lds + 2 * KBUF;
    u32x4 kr[KW / 64], vr[DV / 64];
    tile_load<KW>(kr, Kg, kpitch, tid); tile_load<DV>(vr, Vg, vpitch, tid);
    tile_store<KW, KSTR>(kr, K0, tid); tile_store<DV, VSTR>(vr, V0, tid);
    __syncthreads();
    const int vlane = ((lane & 15) >> 2) * VSTR + (16 * ((lane >> 4) & 1) + 4 * (lane & 3)) * 2 + 4 * h * VSTR;
    for (int t = 0; t < ntiles; ++t) {
        const int cur = t & 1;
        if (t + 1 < ntiles) { tile_load<KW>(kr, Kg + (size_t)(t + 1) * 64 * kpitch, kpitch, tid); tile_load<DV>(vr, Vg + (size_t)(t + 1) * 64 * vpitch, vpitch, tid); }
        const LAS unsigned char* Kb = K0 + cur * KBUF + r * KSTR + (koff + 8 * h) * 2;
        const LAS unsigned char* Vb = V0 + cur * VBUF + vlane;
        f32x16 s0, s1;
#pragma unroll
        for (int i = 0; i < 16; ++i) { s0[i] = 0.f; s1[i] = 0.f; }
#pragma unroll
        for (int ks = 0; ks < DQK / 16; ++ks) {
            const bf16x8 k0 = *(const LAS bf16x8*)(Kb + ks * 32), k1 = *(const LAS bf16x8*)(Kb + 32 * KSTR + ks * 32);
            s0 = __builtin_amdgcn_mfma_f32_32x32x16_bf16(k0, qf[ks], s0, 0, 0, 0);
            s1 = __builtin_amdgcn_mfma_f32_32x32x16_bf16(k1, qf[ks], s1, 0, 0, 0);
        }
        float Aoff = 0.f;
        if (MODE >= 1) {
            const int qrel0 = __builtin_amdgcn_readfirstlane(qrel - r);
            const int T0 = t * 64;
            if (MODE == 1 && (T0 + 64 <= qrel0 || T0 > qrel0 + 31)) {
                const bool left = (T0 + 64 <= qrel0);
                const float sl = left ? -nslope2 : nslope2;
                Aoff = left ? nslope2 * (float)(qrel - T0 - 4 * h) : nslope2 * (float)(T0 + 4 * h - qrel);
#pragma unroll
                for (int i = 0; i < 16; ++i) { s0[i] = __builtin_fmaf(sl, (float)((i & 3) + 8 * (i >> 2)), s0[i]); s1[i] = __builtin_fmaf(sl, (float)(32 + (i & 3) + 8 * (i >> 2)), s1[i]); }
            } else {
                const float base = (float)(T0 + 4 * h - qrel);
#pragma unroll
                for (int i = 0; i < 16; ++i) {
                    const float d0 = fabsf(base + (float)((i & 3) + 8 * (i >> 2))), d1 = fabsf(base + (float)(32 + (i & 3) + 8 * (i >> 2)));
                    s0[i] = __builtin_fmaf(d0, nslope2, s0[i]); s1[i] = __builtin_fmaf(d1, nslope2, s1[i]);
                    if (MODE == 2) { if (d0 > 128.f) s0[i] = -1e30f; if (d1 > 128.f) s1[i] = -1e30f; }
                }
            }
        }
        float mx = fmaxf(s0[0], s1[0]);
#pragma unroll
        for (int i = 1; i < 16; ++i) mx = fmaxf(fmaxf(mx, s0[i]), s1[i]);
        mx += Aoff;
        mx = fmaxf(mx, xhalf(mx));
        const float mnew = fmaxf(m, mx);
        if (__builtin_amdgcn_ballot_w64(mnew > m) != 0ull) {
            const float alpha = __builtin_amdgcn_exp2f(m - mnew);
            lsum *= alpha;
#pragma unroll
            for (int d = 0; d < DV / 32; ++d) o[d] = o[d] * alpha;
        }
        m = mnew;
        const float mm = mnew - Aoff;
        float rs = 0.f;
#pragma unroll
        for (int i = 0; i < 16; ++i) { s0[i] = __builtin_amdgcn_exp2f(s0[i] - mm); s1[i] = __builtin_amdgcn_exp2f(s1[i] - mm); rs += s0[i] + s1[i]; }
        lsum += rs;
        bf16x8 pf[4];
#pragma unroll
        for (int s2 = 0; s2 < 2; ++s2) {
            u32x4 a, b;
            a.x = pk2(s0[8 * s2 + 0], s0[8 * s2 + 1]); a.y = pk2(s0[8 * s2 + 2], s0[8 * s2 + 3]); a.z = pk2(s0[8 * s2 + 4], s0[8 * s2 + 5]); a.w = pk2(s0[8 * s2 + 6], s0[8 * s2 + 7]);
            b.x = pk2(s1[8 * s2 + 0], s1[8 * s2 + 1]); b.y = pk2(s1[8 * s2 + 2], s1[8 * s2 + 3]); b.z = pk2(s1[8 * s2 + 4], s1[8 * s2 + 5]); b.w = pk2(s1[8 * s2 + 6], s1[8 * s2 + 7]);
            pf[s2] = __builtin_bit_cast(bf16x8, a); pf[2 + s2] = __builtin_bit_cast(bf16x8, b);
        }
#pragma unroll
        for (int d = 0; d < DV / 32; ++d) {
#pragma unroll
            for (int kk = 0; kk < 4; ++kk) {
                const s16x4 lo = vtr(Vb + (16 * kk) * VSTR + d * 64), hi = vtr(Vb + (16 * kk + 8) * VSTR + d * 64);
                const bf16x8 vf = {lo[0], lo[1], lo[2], lo[3], hi[0], hi[1], hi[2], hi[3]};
                o[d] = __builtin_amdgcn_mfma_f32_32x32x16_bf16(vf, pf[kk], o[d], 0, 0, 0);
            }
        }
        if (t + 1 < ntiles) { tile_store<KW, KSTR>(kr, K0 + (cur ^ 1) * KBUF, tid); tile_store<DV, VSTR>(vr, V0 + (cur ^ 1) * VBUF, tid); }
        __syncthreads();
    }
}
__device__ __forceinline__ int swz(int row) { return ((row & 3) << 2) | ((row >> 2) & 3); }
template <int DQK, int MODE, int pitch, int voff>
__device__ __forceinline__ void attn_loop_dma(LAS unsigned char* lds, const int wave, const bf16_t* Kg, int ntiles,
                                              const bf16x8 (&qf)[DQK / 16], int koff, float nslope2, int qrel, float& m, float& lsum, f32x16 (&o)[4]) {
    constexpr int DV = 128, STAGE = 32768, VOFFB = 16384;
    const int lane = hw_lane(), r = lane & 31, h = lane >> 5;
    unsigned gk[2];
#pragma unroll
    for (int i = 0; i < 2; ++i) { const int row = 4 * (2 * wave + i) + (lane >> 4), c = (lane & 15) ^ swz(row); gk[i] = (unsigned)(row * pitch + c * 8); }
    unsigned kad[DQK / 16], vad[4][2];
#pragma unroll
    for (int ks = 0; ks < DQK / 16; ++ks) kad[ks] = (unsigned)(r * 256 + 16 * (((koff >> 3) + 2 * ks + h) ^ swz(r)));
    { const int q_ = (lane & 15) >> 2, pp = lane & 3, g1 = (lane >> 4) & 1;
#pragma unroll
      for (int d = 0; d < 4; ++d)
#pragma unroll
          for (int hi = 0; hi < 2; ++hi) { const int f = (q_ << 2) | ((2 * hi + h) & 3), c = (4 * d + 2 * g1 + (pp >> 1)) ^ f;
              vad[d][hi] = (unsigned)(VOFFB + (4 * h + q_) * 256 + 16 * c + 8 * (pp & 1) + hi * 2048); } }
#define ATT_DMA(tt, st) do { const bf16_t* kg_ = Kg + (size_t)(tt) * 64 * pitch; _Pragma("unroll") for (int i_ = 0; i_ < 2; ++i_) { \
        __builtin_amdgcn_global_load_lds((const unsigned*)(kg_ + gk[i_]), (LAS unsigned*)(lds + (st) * STAGE + (2 * wave + i_) * 1024), 16, 0, 0); \
        __builtin_amdgcn_global_load_lds((const unsigned*)(kg_ + voff + gk[i_]), (LAS unsigned*)(lds + (st) * STAGE + VOFFB + (2 * wave + i_) * 1024), 16, 0, 0); } } while (0)
    ATT_DMA(0, 0);
    if (ntiles > 1) ATT_DMA(1, 1);
    if (ntiles > 2) { ATT_DMA(2, 2); asm volatile("s_waitcnt vmcnt(4)" ::: "memory"); } else asm volatile("s_waitcnt vmcnt(0)" ::: "memory");
    __builtin_amdgcn_s_barrier();
    f32x16 s0, s1;
#pragma unroll
    for (int i = 0; i < 16; ++i) { s0[i] = 0.f; s1[i] = 0.f; }
#pragma unroll
    for (int ks = 0; ks < DQK / 16; ++ks) {
        const bf16x8 k0 = *(const LAS bf16x8*)(lds + kad[ks]), k1 = *(const LAS bf16x8*)(lds + kad[ks] + 8192);
        s0 = __builtin_amdgcn_mfma_f32_32x32x16_bf16(k0, qf[ks], s0, 0, 0, 0);
        s1 = __builtin_amdgcn_mfma_f32_32x32x16_bf16(k1, qf[ks], s1, 0, 0, 0);
    }
#define LDS_RD128(dst, addr, off) asm volatile("ds_read_b128 %0, %1 offset:%c2" : "=&v"(dst) : "v"(addr), "i"(off) : "memory")
#define LDS_RDTR(dst, addr, off) asm volatile("ds_read_b64_tr_b16 %0, %1 offset:%c2" : "=&v"(dst) : "v"(addr), "i"(off) : "memory")
#define LDS_WAIT0() do { asm volatile("s_waitcnt lgkmcnt(0)" ::: "memory"); __builtin_amdgcn_sched_barrier(0); } while (0)
    for (int t = 0; t < ntiles; ++t) {
        if (t + 3 < ntiles) ATT_DMA(t + 3, (t + 3) & 3);
        const unsigned sba = (unsigned)(size_t)(lds + (t & 3) * STAGE), sna = (unsigned)(size_t)(lds + ((t + 1) & 3) * STAGE);
        constexpr int KH = (DQK == 64) ? 4 : 4;
        bf16x8 kf0[KH], kf1[KH];
        s16x4 va_lo[4], va_hi[4], vb_lo[4], vb_hi[4];
        if (DQK == 64) {
#pragma unroll
            for (int ks = 0; ks < KH; ++ks) { const unsigned ka = sna + kad[ks]; LDS_RD128(kf0[ks], ka, 0); } }
        __builtin_amdgcn_sched_barrier(0);
        float Aoff = 0.f;
        if (MODE >= 1) {
            const int qrel0 = __builtin_amdgcn_readfirstlane(qrel - r);
            const int T0 = t * 64;
            if (MODE == 1 && (T0 + 64 <= qrel0 || T0 > qrel0 + 31)) {
                const bool left = (T0 + 64 <= qrel0);
                const float sl = left ? -nslope2 : nslope2;
                Aoff = left ? nslope2 * (float)(qrel - T0 - 4 * h) : nslope2 * (float)(T0 + 4 * h - qrel);
#pragma unroll
                for (int i = 0; i < 16; ++i) { s0[i] = __builtin_fmaf(sl, (float)((i & 3) + 8 * (i >> 2)), s0[i]); s1[i] = __builtin_fmaf(sl, (float)(32 + (i & 3) + 8 * (i >> 2)), s1[i]); }
            } else {
                const float base = (float)(T0 + 4 * h - qrel);
#pragma unroll
                for (int i = 0; i < 16; ++i) {
                    const float d0 = fabsf(base + (float)((i & 3) + 8 * (i >> 2))), d1 = fabsf(base + (float)(32 + (i & 3) + 8 * (i >> 2)));
                    s0[i] = __builtin_fmaf(d0, nslope2, s0[i]); s1[i] = __builtin_fmaf(d1, nslope2, s1[i]);
                    if (MODE == 2) { if (d0 > 128.f) s0[i] = -1e30f; if (d1 > 128.f) s1[i] = -1e30f; }
                }
            }
        }
        float mx = fmaxf(s0[0], s1[0]);
#pragma unroll
        for (int i = 1; i < 16; ++i) mx = fmaxf(fmaxf(mx, s0[i]), s1[i]);
        mx += Aoff;
        mx = fmaxf(mx, xhalf(mx));
        const float mnew = fmaxf(m, mx);
        if (__builtin_amdgcn_ballot_w64(mnew > m) != 0ull) {
            const float alpha = __builtin_amdgcn_exp2f(m - mnew);
            lsum *= alpha;
#pragma unroll
            for (int d = 0; d < DV / 32; ++d) o[d] = o[d] * alpha;
        }
        m = mnew;
        const float mm = mnew - Aoff;
        float rs = 0.f;
#pragma unroll
        for (int i = 0; i < 16; ++i) { s0[i] = __builtin_amdgcn_exp2f(s0[i] - mm); s1[i] = __builtin_amdgcn_exp2f(s1[i] - mm); rs += s0[i] + s1[i]; }
        lsum += rs;
        bf16x8 pf[4];
#pragma unroll
        for (int s2 = 0; s2 < 2; ++s2) {
            u32x4 a, b;
            a.x = pk2(s0[8 * s2 + 0], s0[8 * s2 + 1]); a.y = pk2(s0[8 * s2 + 2], s0[8 * s2 + 3]); a.z = pk2(s0[8 * s2 + 4], s0[8 * s2 + 5]); a.w = pk2(s0[8 * s2 + 6], s0[8 * s2 + 7]);
            b.x = pk2(s1[8 * s2 + 0], s1[8 * s2 + 1]); b.y = pk2(s1[8 * s2 + 2], s1[8 * s2 + 3]); b.z = pk2(s1[8 * s2 + 4], s1[8 * s2 + 5]); b.w = pk2(s1[8 * s2 + 6], s1[8 * s2 + 7]);
            pf[s2] = __builtin_bit_cast(bf16x8, a); pf[2 + s2] = __builtin_bit_cast(bf16x8, b);
        }
        LDS_WAIT0();
        if (DQK == 64) {
#pragma unroll
            for (int ks = 0; ks < KH; ++ks) { const unsigned ka = sna + kad[ks]; LDS_RD128(kf1[ks], ka, 8192); } }
        { const unsigned alo = sba + vad[0][0], ahi = sba + vad[0][1];
#pragma unroll
          for (int kk = 0; kk < 4; ++kk) { LDS_RDTR(va_lo[kk], alo, kk * 4096); LDS_RDTR(va_hi[kk], ahi, kk * 4096); } }
        __builtin_amdgcn_sched_barrier(0);
        f32x16 n0, n1;
#pragma unroll
        for (int i = 0; i < 16; ++i) { n0[i] = 0.f; n1[i] = 0.f; }
#pragma unroll
        for (int g = 0; g < DQK / 64; ++g) {
            if (DQK != 64) {
#pragma unroll
                for (int ks = 0; ks < KH; ++ks) { const unsigned ka = sna + kad[g * KH + ks]; LDS_RD128(kf0[ks], ka, 0); LDS_RD128(kf1[ks], ka, 8192); }
                LDS_WAIT0(); }
#pragma unroll
            for (int ks = 0; ks < KH; ++ks) n0 = __builtin_amdgcn_mfma_f32_32x32x16_bf16(kf0[ks], qf[g * KH + ks], n0, 0, 0, 0);
            if (DQK == 64) LDS_WAIT0();
#pragma unroll
            for (int ks = 0; ks < KH; ++ks) n1 = __builtin_amdgcn_mfma_f32_32x32x16_bf16(kf1[ks], qf[g * KH + ks], n1, 0, 0, 0);
        }
#define PV_BLOCK(d, lo, hi) do { _Pragma("unroll") for (int kk = 0; kk < 4; ++kk) { const bf16x8 vf = {lo[kk][0], lo[kk][1], lo[kk][2], lo[kk][3], hi[kk][0], hi[kk][1], hi[kk][2], hi[kk][3]}; \
            o[d] = __builtin_amdgcn_mfma_f32_32x32x16_bf16(vf, pf[kk], o[d], 0, 0, 0); } } while (0)
#define V_ISSUE(d, lo, hi) do { const unsigned alo_ = sba + vad[d][0], ahi_ = sba + vad[d][1]; _Pragma("unroll") for (int kk = 0; kk < 4; ++kk) { LDS_RDTR(lo[kk], alo_, kk * 4096); LDS_RDTR(hi[kk], ahi_, kk * 4096); } } while (0)
        LDS_WAIT0();
        V_ISSUE(1, vb_lo, vb_hi); __builtin_amdgcn_sched_barrier(0);
        PV_BLOCK(0, va_lo, va_hi);
        LDS_WAIT0();
        V_ISSUE(2, va_lo, va_hi); __builtin_amdgcn_sched_barrier(0);
        PV_BLOCK(1, vb_lo, vb_hi);
        LDS_WAIT0();
        V_ISSUE(3, vb_lo, vb_hi); __builtin_amdgcn_sched_barrier(0);
        PV_BLOCK(2, va_lo, va_hi);
        LDS_WAIT0();
        PV_BLOCK(3, vb_lo, vb_hi);
#undef PV_BLOCK
#undef V_ISSUE
        s0 = n0; s1 = n1;
        if (t + 3 < ntiles) asm volatile("s_waitcnt vmcnt(4)" ::: "memory"); else asm volatile("s_waitcnt vmcnt(0)" ::: "memory");
        __builtin_amdgcn_s_barrier();
    }
#undef LDS_RD128
#undef LDS_RDTR
#undef LDS_WAIT0
#undef ATT_DMA
}
template <int DV> __device__ __forceinline__ void store_o(const f32x16 (&o)[DV / 32], float sc, bf16_t* orow, int h) {
#pragma unroll
    for (int d = 0; d < DV / 32; ++d)
#pragma unroll
        for (int g4 = 0; g4 < 4; ++g4) { u32x2 w; w.x = pk2(o[d][4 * g4] * sc, o[d][4 * g4 + 1] * sc); w.y = pk2(o[d][4 * g4 + 2] * sc, o[d][4 * g4 + 3] * sc);
            *(GAS u32x2*)((GAS bf16_t*)orow + 32 * d + 8 * g4 + 4 * h) = w; }
}

__device__ __forceinline__ void win_unit(Frame& F, const Params& p, int l, int u) {
    REFRAME(F);
    const bf16_t* Z = (const bf16_t*)(p.ws + WS_Z); bf16_t* MIX = (bf16_t*)(p.ws + WS_MIX);
    const int b = u >> 5, kvh = (u >> 4) & 1, nb = u & 15, r = F.lane & 31, h = F.lane >> 5;
    const int g = F.wave >> 2, hq = kvh * 2 + g, qpos = nb * 128 + (F.wave & 3) * 32 + r;
    const size_t tok = (size_t)b * SEQ + qpos;
    bf16x8 qf[4]; load_q<64>(qf, Z + tok * ZP + hq * 64, h, 0.125f * LOG2E);
    const int first = (2 * nb - 2 < 0) ? 0 : 2 * nb - 2, lastx = (2 * nb + 4 > 32) ? 32 : 2 * nb + 4, nt = lastx - first;
    const float slope = exp2f(-(float)(2 * hq + 1));
    float m = p.in[4][l * 4 + hq] * LOG2E, ls = (h == 0) ? 1.f : 0.f;
    f32x16 o[2];
#pragma unroll
    for (int d = 0; d < 2; ++d)
#pragma unroll
        for (int i = 0; i < 16; ++i) o[d][i] = 0.f;
    const bf16_t* Kg = Z + ((size_t)b * SEQ + first * 64) * ZP + 256 + kvh * 64;
    attn_loop<64, 64, 64, 2>(F.lds, Kg, ZP, Kg + 128, ZP, nt, qf, 0, -slope * LOG2E, qpos - first * 64, m, ls, o);
    const float lt = ls + xhalf(ls);
    store_o<64>(o, 1.f / lt, MIX + tok * DM + hq * 64, h);
}
__device__ __forceinline__ void diff_unit(Frame& F, const Params& p, int l, int u) {
    REFRAME(F);
    const bf16_t* Z = (const bf16_t*)(p.ws + WS_Z); bf16_t* MIX = (bf16_t*)(p.ws + WS_MIX);
    const int b = u >> 6, hh = (u >> 4) & 3, qb = u & 15, r = F.lane & 31, h = F.lane >> 5;
    const int c = F.wave >> 2, qpos = qb * 128 + (F.wave & 3) * 32 + r;
    const size_t tok = (size_t)b * SEQ + qpos;
    float lam, lam_init;
    {
        const float a1 = wave_sum(p.in[5][l * 64 + F.lane] * p.in[6][l * 64 + F.lane]), a2 = wave_sum(p.in[7][l * 64 + F.lane] * p.in[8][l * 64 + F.lane]);
        lam_init = 0.8f - 0.6f * expf(-0.3f * (float)l);
        lam = expf(a1) - expf(a2) + lam_init;
    }
    bf16x8 qf[4]; load_q<64>(qf, Z + tok * ZP + 512 + hh * 128 + c * 64, h, 0.125f * LOG2E);
    const float slope = exp2f(-(float)(2 * hh + 2));
    float m = -1e30f, ls = 0.f;
    f32x16 o[4];
#pragma unroll
    for (int d = 0; d < 4; ++d)
#pragma unroll
        for (int i = 0; i < 16; ++i) o[d][i] = 0.f;
    const bf16_t* Kg = (const bf16_t*)(p.ws + WS_KD2) + (size_t)(b * 4 + hh) * 2048 * 128;
    attn_loop_dma<64, 1, 128, 8388608>(F.lds, F.wave, Kg, 32, qf, c * 64, -slope * LOG2E, qpos, m, ls, o);
    const float inv = 1.f / (ls + xhalf(ls));
    LAS float* comb = (LAS float*)F.lds + (size_t)(F.wave & 3) * 64 * 64 + F.lane;
    if (c == 1) {
#pragma unroll
        for (int d = 0; d < 4; ++d)
#pragma unroll
            for (int i = 0; i < 16; ++i) comb[(d * 16 + i) * 64] = o[d][i] * inv;
    }
    __syncthreads();
    if (c == 0) {
        float ss = 0.f;
#pragma unroll
        for (int d = 0; d < 4; ++d)
#pragma unroll
            for (int i = 0; i < 16; ++i) { const float a = o[d][i] * inv - lam * comb[(d * 16 + i) * 64]; o[d][i] = a; ss += a * a; }
        ss += xhalf(ss);
        const float rn = rsqrtf(ss * (1.f / 128.f) + 1e-6f) * (1.f - lam_init);
        const float* sg = p.in[9] + l * 128;
        bf16_t* orow = MIX + tok * DM + 256 + hh * 128;
        f32x4 ggv[4][4];
#pragma unroll
        for (int d = 0; d < 4; ++d)
#pragma unroll
            for (int g4 = 0; g4 < 4; ++g4) ggv[d][g4] = *(const GAS f32x4*)((const GAS float*)sg + 32 * d + 8 * g4 + 4 * h);
#pragma unroll
        for (int d = 0; d < 4; ++d)
#pragma unroll
            for (int g4 = 0; g4 < 4; ++g4) { const int dv = 32 * d + 8 * g4 + 4 * h; const f32x4 gg = ggv[d][g4];
                u32x2 w; w.x = pk2(o[d][4 * g4] * rn * gg[0], o[d][4 * g4 + 1] * rn * gg[1]); w.y = pk2(o[d][4 * g4 + 2] * rn * gg[2], o[d][4 * g4 + 3] * rn * gg[3]);
                *(GAS u32x2*)((GAS bf16_t*)orow + dv) = w; }
    }
    __syncthreads();
}
__device__ __forceinline__ void cross_unit(Frame& F, const Params& p, int u) {
    REFRAME(F);
    const bf16_t* Q = (const bf16_t*)(p.ws + WS_Q); const bf16_t* KV = (const bf16_t*)(p.ws + WS_KV); bf16_t* O = (bf16_t*)(p.ws + WS_O);
    const int b = u >> 5, hd = (u >> 3) & 3, qb = u & 7, r = F.lane & 31, h = F.lane >> 5;
    const size_t tok = (size_t)b * SEQ + qb * 256 + F.wave * 32 + r;
    bf16x8 qf[8]; load_q<128>(qf, Q + tok * XW + hd * 128, h, 0.08838834764831845f * LOG2E);
    float m = -1e30f, ls = 0.f;
    f32x16 o[4];
#pragma unroll
    for (int d = 0; d < 4; ++d)
#pragma unroll
        for (int i = 0; i < 16; ++i) o[d][i] = 0.f;
    const bf16_t* Kg = KV + ((size_t)b * NMEM) * 1024 + hd * 128;
    attn_loop_dma<128, 0, 1024, 512>(F.lds, F.wave, Kg, 4, qf, 0, 0.f, 0, m, ls, o);
    const float lt = ls + xhalf(ls);
    store_o<128>(o, 1.f / lt, O + tok * XW + hd * 128, h);
}

constexpr int CF_STR = 772, PREP_AW = 32 * CF_STR * 4, PREP_AA = PREP_AW + 32 * 72 * 2, PREP_AG = PREP_AA + 32 * 72 * 2;
__device__ __forceinline__ void prep_unit(Frame& F, const Params& p, int l, const bf16_t* wb, int u) {
    REFRAME(F);
    const bf16_t* ZC = (const bf16_t*)(p.ws + WS_ZC);
    const int t0 = u * 32, b = t0 / SEQ;
    LAS float* CF = (LAS float*)F.lds; LAS bf16_t* AW = (LAS bf16_t*)(F.lds + PREP_AW); LAS bf16_t* AA = (LAS bf16_t*)(F.lds + PREP_AA); LAS bf16_t* AG = (LAS bf16_t*)(F.lds + PREP_AG);
    const float* conv = p.in[10] + (size_t)l * 3 * 1024;
    LAS float* PAR = (LAS float*)(F.lds + PREP_AG + 32 * 136 * 2);
    if (F.tid < 448) { const int i = F.tid; const GAS f32x4* src;
        if (i < 64) src = (const GAS f32x4*)((const GAS float*)p.in[16] + l * 256) + i;
        else if (i < 128) src = (const GAS f32x4*)((const GAS float*)p.in[17] + l * 256) + (i - 64);
        else if (i < 192) src = (const GAS f32x4*)((const GAS float*)p.in[18] + l * 256) + (i - 128);
        else if (i < 320) src = (const GAS f32x4*)((const GAS float*)p.in[11] + l * 512) + (i - 192);
        else src = (const GAS f32x4*)((const GAS float*)p.in[13] + l * 512) + (i - 320);
        ((LAS f32x4*)PAR)[i] = *src; }
#pragma unroll 4
    for (int i = 0; i < 8; ++i) {
        const int id = F.tid + i * 512, tk = id >> 7, ch = id & 127, tg = t0 + tk, tpos = tg - b * SEQ;
        const GAS bf16_t* zp = (const GAS bf16_t*)ZC + (size_t)tg * 1024 + ch * 8;
        const u32x4 zc = *(const GAS u32x4*)zp;
        u32x4 zl = {0u, 0u, 0u, 0u}, zr = {0u, 0u, 0u, 0u};
        if (tpos > 0) zl = *(const GAS u32x4*)(zp - 1024);
        if (tpos < SEQ - 1) zr = *(const GAS u32x4*)(zp + 1024);
        float v[8];
#pragma unroll
        for (int q = 0; q < 4; ++q) {
            const f32x2 c0 = *(const GAS f32x2*)((const GAS float*)conv + ch * 8 + 2 * q), c1 = *(const GAS f32x2*)((const GAS float*)conv + 1024 + ch * 8 + 2 * q), c2 = *(const GAS f32x2*)((const GAS float*)conv + 2048 + ch * 8 + 2 * q);
            v[2 * q] = bflo(zl[q]) * c0[0] + bflo(zc[q]) * c1[0] + bflo(zr[q]) * c2[0];
            v[2 * q + 1] = bfhi(zl[q]) * c0[1] + bfhi(zc[q]) * c1[1] + bfhi(zr[q]) * c2[1];
        }
        if (ch < 96) { *(LAS f32x4*)(CF + tk * CF_STR + ch * 8) = (f32x4){v[0], v[1], v[2], v[3]}; *(LAS f32x4*)(CF + tk * CF_STR + ch * 8 + 4) = (f32x4){v[4], v[5], v[6], v[7]}; }
        else {
            u32x4 w;
            if (ch < 104) {
#pragma unroll
                for (int q = 0; q < 8; ++q) v[q] = 1.f - 2.f / (__expf(2.f * v[q]) + 1.f);
                w.x = pk2(v[0], v[1]); w.y = pk2(v[2], v[3]); w.z = pk2(v[4], v[5]); w.w = pk2(v[6], v[7]);
                *(LAS u32x4*)(AW + tk * 72 + (ch - 96) * 8) = w;
            } else if (ch < 112) {
                w.x = pk2(v[0], v[1]); w.y = pk2(v[2], v[3]); w.z = pk2(v[4], v[5]); w.w = pk2(v[6], v[7]);
                *(LAS u32x4*)(AA + tk * 72 + (ch - 104) * 8) = w;
            } else {
#pragma unroll
                for (int q = 0; q < 8; ++q) v[q] = sigmoidf_(v[q]);
                w.x = pk2(v[0], v[1]); w.y = pk2(v[2], v[3]); w.z = pk2(v[4], v[5]); w.w = pk2(v[6], v[7]);
                *(LAS u32x4*)(AG + tk * 136 + (ch - 112) * 8) = w;
            }
        }
    }
    __syncthreads();
    const int hh = F.wave & 3, dir = F.wave >> 2, tk = F.lane & 31, h2 = F.lane >> 5;
    const size_t tok = (size_t)t0 + tk;
    const GAS bf16_t* Wup = (const GAS bf16_t*)wb + WO_WUP + (size_t)(dir * 256 + hh * 64) * 64;
    const GAS bf16_t* Aup = (const GAS bf16_t*)wb + WO_AUP + (size_t)(dir * 256 + hh * 64) * 64;
    f32x16 aw[2], aa[2];
#pragma unroll
    for (int rb = 0; rb < 2; ++rb)
#pragma unroll
        for (int i = 0; i < 16; ++i) { aw[rb][i] = 0.f; aa[rb][i] = 0.f; }
#pragma unroll
    for (int ks = 0; ks < 4; ++ks) {
        const bf16x8 bw = *(const LAS bf16x8*)(AW + tk * 72 + 16 * ks + 8 * h2), ba = *(const LAS bf16x8*)(AA + tk * 72 + 16 * ks + 8 * h2);
#pragma unroll
        for (int rb = 0; rb < 2; ++rb) {
            const bf16x8 fw = *(const GAS bf16x8*)(Wup + (size_t)(rb * 32 + tk) * 64 + 16 * ks + 8 * h2), fa = *(const GAS bf16x8*)(Aup + (size_t)(rb * 32 + tk) * 64 + 16 * ks + 8 * h2);
            aw[rb] = __builtin_amdgcn_mfma_f32_32x32x16_bf16(fw, bw, aw[rb], 0, 0, 0);
            aa[rb] = __builtin_amdgcn_mfma_f32_32x32x16_bf16(fa, ba, aa[rb], 0, 0, 0);
        }
    }
    const LAS float* k_k = PAR + hh * 64; const LAS float* k_a = PAR + 256 + hh * 64; const LAS float* r_k = PAR + 512 + hh * 64;
    const LAS float* w0 = PAR + 768 + dir * 256 + hh * 64; const LAS float* a0 = PAR + 1280 + dir * 256 + hh * 64;
    float ssq = 0.f;
#pragma unroll
    for (int rb = 0; rb < 2; ++rb)
#pragma unroll
        for (int g4 = 0; g4 < 4; ++g4) { const int c0 = rb * 32 + 8 * g4 + 4 * h2;
            const f32x4 kv = *(const LAS f32x4*)(CF + tk * CF_STR + 256 + hh * 64 + c0), kkw = *(const LAS f32x4*)(k_k + c0);
            const f32x4 q = kv * kkw; ssq += (q[0] * q[0] + q[1] * q[1]) + (q[2] * q[2] + q[3] * q[3]); }
    ssq += xhalf(ssq);
    const float kinv = 1.f / fmaxf(sqrtf(ssq), 1e-12f);
    float bon = 0.f;
    GAS bf16_t* OM = (GAS bf16_t*)(p.ws + WS_OM) + ((size_t)dir * MTOK + tok) * 256 + hh * 64;
    GAS bf16_t* KA = (GAS bf16_t*)(p.ws + WS_KA) + ((size_t)dir * MTOK + tok) * 256 + hh * 64;
    GAS bf16_t* KD = (GAS bf16_t*)(p.ws + WS_KD) + ((size_t)dir * MTOK + tok) * 256 + hh * 64;
    GAS bf16_t* KK = (GAS bf16_t*)(p.ws + WS_KK) + tok * 256 + hh * 64;
    GAS bf16_t* VV = (GAS bf16_t*)(p.ws + WS_V) + tok * 256 + hh * 64;
    GAS bf16_t* RR = (GAS bf16_t*)(p.ws + WS_R) + tok * 256 + hh * 64;
#pragma unroll
    for (int rb = 0; rb < 2; ++rb)
#pragma unroll
        for (int g4 = 0; g4 < 4; ++g4) { const int c0 = rb * 32 + 8 * g4 + 4 * h2;
            const f32x4 kv = *(const LAS f32x4*)(CF + tk * CF_STR + 256 + hh * 64 + c0), rv = *(const LAS f32x4*)(CF + tk * CF_STR + hh * 64 + c0);
            const f32x4 kkw = *(const LAS f32x4*)(k_k + c0), kaw = *(const LAS f32x4*)(k_a + c0), rkw = *(const LAS f32x4*)(r_k + c0), w0v = *(const LAS f32x4*)(w0 + c0), a0v = *(const LAS f32x4*)(a0 + c0);
            float om[4], ka[4], kd[4], kk[4];
#pragma unroll
            for (int j = 0; j < 4; ++j) {
                const float wp = aw[rb][4 * g4 + j] + w0v[j], ap = aa[rb][4 * g4 + j] + a0v[j];
                om[j] = 1.f - __expf(-0.6065306597126334f * sigmoidf_(wp));
                const float a = sigmoidf_(ap);
                kk[j] = kv[j] * kkw[j] * kinv; ka[j] = kk[j] * a; kd[j] = kv[j] * (1.f + (a - 1.f) * kaw[j]);
                bon += rv[j] * kd[j] * rkw[j];
            }
            u32x2 w; w.x = pk2(om[0], om[1]); w.y = pk2(om[2], om[3]); *(GAS u32x2*)(OM + c0) = w;
            w.x = pk2(ka[0], ka[1]); w.y = pk2(ka[2], ka[3]); *(GAS u32x2*)(KA + c0) = w;
            w.x = pk2(kd[0], kd[1]); w.y = pk2(kd[2], kd[3]); *(GAS u32x2*)(KD + c0) = w;
            if (dir == 0) {
                const f32x4 vv = *(const LAS f32x4*)(CF + tk * CF_STR + 512 + hh * 64 + c0);
                w.x = pk2(kk[0], kk[1]); w.y = pk2(kk[2], kk[3]); *(GAS u32x2*)(KK + c0) = w;
                w.x = pk2(vv[0], vv[1]); w.y = pk2(vv[2], vv[3]); *(GAS u32x2*)(VV + c0) = w;
                w.x = pk2(rv[0], rv[1]); w.y = pk2(rv[2], rv[3]); *(GAS u32x2*)(RR + c0) = w;
            }
        }
    bon += xhalf(bon);
    if (h2 == 0) ((GAS float*)(p.ws + WS_BON))[((size_t)dir * MTOK + tok) * 4 + hh] = bon;
    {
        const GAS bf16_t* Gup = (const GAS bf16_t*)wb + WO_GUP + (size_t)(F.wave * 32 + tk) * 128;
        f32x16 ag;
#pragma unroll
        for (int i = 0; i < 16; ++i) ag[i] = 0.f;
#pragma unroll
        for (int ks = 0; ks < 8; ++ks) {
            const bf16x8 bg = *(const LAS bf16x8*)(AG + tk * 136 + 16 * ks + 8 * h2), fg = *(const GAS bf16x8*)(Gup + 16 * ks + 8 * h2);
            ag = __builtin_amdgcn_mfma_f32_32x32x16_bf16(fg, bg, ag, 0, 0, 0);
        }
        GAS bf16_t* GT = (GAS bf16_t*)(p.ws + WS_GATE) + tok * 256 + F.wave * 32;
#pragma unroll
        for (int g4 = 0; g4 < 4; ++g4) { u32x2 w; w.x = pk2(ag[4 * g4], ag[4 * g4 + 1]); w.y = pk2(ag[4 * g4 + 2], ag[4 * g4 + 3]); *(GAS u32x2*)(GT + 8 * g4 + 4 * h2) = w; }
    }
    __syncthreads();
}

#define CBAR() asm volatile("" ::: "memory")
#define LROW(M, i, r) do { const LAS f32x4* _q = (const LAS f32x4*)((M) + (i) * 16); const f32x4 _a = _q[0], _b = _q[1], _c = _q[2], _d = _q[3]; \
        r[0] = _a[0]; r[1] = _a[1]; r[2] = _a[2]; r[3] = _a[3]; r[4] = _b[0]; r[5] = _b[1]; r[6] = _b[2]; r[7] = _b[3]; \
        r[8] = _c[0]; r[9] = _c[1]; r[10] = _c[2]; r[11] = _c[3]; r[12] = _d[0]; r[13] = _d[1]; r[14] = _d[2]; r[15] = _d[3]; } while (0)
template <int DIR> __device__ __forceinline__ void chunkprep_wave(Frame& F, const Params& p, int task) {
    const int dbh = task >> 7, ct = task & 127, b = (dbh >> 2) & 7, hh = dbh & 3, ch = F.lane, r32 = F.lane & 31, h = F.lane >> 5;
    LAS unsigned char* wl = F.lds + F.wave * 16384;
    LAS bf16_t* X = (LAS bf16_t*)wl;
    LAS bf16_t* Yt = (LAS bf16_t*)(wl + 4608);
    LAS float* MTt = (LAS float*)(wl + 9216);
    LAS float* MBt = MTt + 256;
    LAS float* MC = MTt + 512; LAS float* MD = MTt + 768; LAS float* MT = MTt + 1024; LAS float* MA = MTt + 1280;
    constexpr int step = DIR ? -256 : 256;
    typedef const __attribute__((address_space(1))) bf16_t* gbf;
    const size_t ou = ((size_t)b * SEQ + ct * 16 + (DIR ? 15 : 0)) * 256 + hh * 64;
    const gbf OM = (gbf)(p.ws + WS_OM) + (size_t)DIR * MTOK * 256 + ou + ch; const gbf KA = (gbf)(p.ws + WS_KA) + (size_t)DIR * MTOK * 256 + ou + ch;
    const gbf KD = (gbf)(p.ws + WS_KD) + (size_t)DIR * MTOK * 256 + ou + ch; const gbf KK = (gbf)(p.ws + WS_KK) + ou + ch;
    const gbf RR = (gbf)(p.ws + WS_R) + ou + ch; const gbf VV = (gbf)(p.ws + WS_V) + ou + ch;
    float pc = 1.f;
    float qt[16], rt[16], at[16], kt[16], vv[16];
    {
        unsigned short rw[16], rk[16], ra_[16], rd[16], rr_[16], rv[16];
#pragma unroll
        for (int i = 0; i < 16; ++i) { rw[i] = OM[i * step]; rk[i] = KK[i * step]; ra_[i] = KA[i * step]; rd[i] = KD[i * step]; rr_[i] = RR[i * step]; rv[i] = VV[i * step]; }
#pragma unroll
        for (int i = 0; i < 16; ++i) {
            const float w = 1.f - bf2f(rw[i]);
            qt[i] = bf2f(rk[i]) * pc; pc *= w; const float ip = __builtin_amdgcn_rcpf(pc);
            rt[i] = bf2f(rr_[i]) * pc; at[i] = bf2f(ra_[i]) * ip; kt[i] = bf2f(rd[i]) * ip; vv[i] = bf2f(rv[i]);
            X[i * 72 + ch] = (bf16_t)(pk2(qt[i], 0.f) & 0xffffu); X[(16 + i) * 72 + ch] = (bf16_t)(pk2(rt[i], 0.f) & 0xffffu);
            Yt[i * 72 + ch] = (bf16_t)(pk2(at[i], 0.f) & 0xffffu); Yt[(16 + i) * 72 + ch] = (bf16_t)(pk2(kt[i], 0.f) & 0xffffu);
        }
    }
    const float p15 = pc;
    asm volatile("s_waitcnt lgkmcnt(0)" ::: "memory");
    {
        f32x16 g;
#pragma unroll
        for (int i = 0; i < 16; ++i) g[i] = 0.f;
#pragma unroll
        for (int ks = 0; ks < 4; ++ks) {
            const bf16x8 a = *(const LAS bf16x8*)(X + r32 * 72 + 16 * ks + 8 * h), bb = *(const LAS bf16x8*)(Yt + r32 * 72 + 16 * ks + 8 * h);
            g = __builtin_amdgcn_mfma_f32_32x32x16_bf16(a, bb, g, 0, 0, 0);
        }
        const int sidx = r32 & 15;
#pragma unroll
        for (int reg = 0; reg < 8; ++reg) { const int i = (reg & 3) + 8 * (reg >> 2) + 4 * h;
            const float lo = (sidx < i) ? g[reg] : 0.f, hi2 = (sidx <= i) ? g[8 + reg] : 0.f;
            if (r32 < 16) { MA[i * 16 + sidx] = lo; MD[i * 16 + sidx] = hi2; } else { MBt[sidx * 16 + i] = lo; MC[i * 16 + sidx] = hi2; } }
    }
    asm volatile("s_waitcnt lgkmcnt(0)" ::: "memory");
    {
        const int c = F.lane & 15; float Tc[16];
#pragma unroll
        for (int i = 0; i < 16; ++i) { float acc = (i == c) ? 1.f : 0.f; float ra[16]; LROW(MA, i, ra);
#pragma unroll
            for (int s2 = 0; s2 < i; ++s2) acc -= ra[s2] * Tc[s2];
            Tc[i] = acc; MT[i * 16 + c] = acc; MTt[c * 16 + i] = acc; CBAR(); }
    }
    asm volatile("s_waitcnt lgkmcnt(0)" ::: "memory");
    float Qh[16], W2[16];
    {
        float BV[16];
#pragma unroll
        for (int i = 0; i < 16; ++i) { Qh[i] = 0.f; BV[i] = 0.f; }
#pragma unroll
        for (int s2 = 0; s2 < 16; ++s2) {
            float ct_[16], cb_[16]; LROW(MTt, s2, ct_); LROW(MBt, s2, cb_);
#pragma unroll
            for (int i = s2; i < 16; ++i) { Qh[i] += ct_[i] * qt[s2]; if (i > s2) BV[i] += cb_[i] * vv[s2]; }
            CBAR();
        }
#pragma unroll
        for (int i = 0; i < 16; ++i) { float aw = 0.f; float rt_[16]; LROW(MT, i, rt_);
#pragma unroll
            for (int s2 = 0; s2 <= i; ++s2) aw += rt_[s2] * BV[s2];
            W2[i] = aw; CBAR(); }
    }
    GAS bf16_t* FQR = (GAS bf16_t*)(p.ws + WS_FQR) + (size_t)task * 2048;
    GAS bf16_t* FWY = (GAS bf16_t*)(p.ws + WS_FWY) + (size_t)task * 2048;
    {
        const int ks = ch >> 4, w16 = ch & 15, jq = (w16 >> 3) * 4 + (w16 & 3), hq = (w16 >> 2) & 1;
        GAS bf16_t* qrp = FQR + (size_t)(ks * 64 + hq * 32) * 8 + jq;
        GAS bf16_t* wyp = FWY + (size_t)(((ch >> 5) * 64 + r32) * 16);
#pragma unroll
        for (int i = 0; i < 16; ++i) {
            float ar = rt[i], ay = 0.f; float rd_[16], rc_[16]; LROW(MD, i, rd_); LROW(MC, i, rc_);
#pragma unroll
            for (int s2 = 0; s2 <= i; ++s2) { ar -= rd_[s2] * Qh[s2]; ay += rc_[s2] * vv[s2] - rd_[s2] * W2[s2]; }
            qrp[i * 8] = (bf16_t)(pk2(Qh[i], 0.f) & 0xffffu); qrp[(16 + i) * 8] = (bf16_t)(pk2(ar, 0.f) & 0xffffu);
            wyp[512 * ((i >> 2) & 1) + (i & 3) + 4 * (i >> 3)] = (bf16_t)(pk2(W2[i], 0.f) & 0xffffu);
            wyp[512 * ((i >> 2) & 1) + (i & 3) + 4 * ((16 + i) >> 3)] = (bf16_t)(pk2(ay, 0.f) & 0xffffu);
            CBAR(); }
    }
    {
        GAS bf16_t* nap = (GAS bf16_t*)(p.ws + WS_FNA) + (size_t)task * 1024 + (size_t)(((ch >> 5) * 64 + r32) * 8);
        GAS bf16_t* khp = (GAS bf16_t*)(p.ws + WS_FKH) + (size_t)task * 1024 + (size_t)(((ch >> 5) * 64 + r32) * 8);
#pragma unroll
        for (int s2 = 0; s2 < 16; ++s2) {
            const int off = 256 * ((s2 >> 2) & 1) + (s2 >> 3) * 4 + (s2 & 3);
            nap[off] = (bf16_t)(pk2(-at[s2] * p15, 0.f) & 0xffffu); khp[off] = (bf16_t)(pk2(kt[s2] * p15, 0.f) & 0xffffu); }
        ((GAS float*)(p.ws + WS_FP15))[(size_t)task * 64 + ch] = p15;
    }
    asm volatile("s_waitcnt lgkmcnt(0)" ::: "memory");
}
constexpr int PB_SLOT = 15360, PB_NSLOT = 4, PB_QR = 0, PB_WY = 4096, PB_NA = 8192, PB_KH = 10240, PB_P15 = 12288, PB_V = 13312;
__device__ __forceinline__ unsigned lds_ld_u32(unsigned addr) { unsigned v; asm volatile("ds_read_b32 %0, %1\n\ts_waitcnt lgkmcnt(0)" : "=v"(v) : "v"(addr) : "memory"); return v; }
__device__ __forceinline__ void lds_st_u32(unsigned addr, unsigned v) { asm volatile("ds_write_b32 %0, %1" :: "v"(addr), "v"(v) : "memory"); }
__device__ __forceinline__ void pb_dma(const Params& p, int dbh, int ct, int lane, LAS unsigned char* slot) {
    const size_t task = (size_t)dbh * 128 + ct; const int b = (dbh >> 2) & 7, hh = dbh & 3;
    const unsigned char* q = (const unsigned char*)((const bf16_t*)(p.ws + WS_FQR) + task * 2048) + lane * 16; const unsigned char* w = (const unsigned char*)((const bf16_t*)(p.ws + WS_FWY) + task * 2048) + lane * 16;
    const unsigned char* na = (const unsigned char*)((const bf16_t*)(p.ws + WS_FNA) + task * 1024) + lane * 16; const unsigned char* kh = (const unsigned char*)((const bf16_t*)(p.ws + WS_FKH) + task * 1024) + lane * 16;
#pragma unroll
    for (int i = 0; i < 4; ++i) {
        __builtin_amdgcn_global_load_lds((const unsigned*)(q + 1024 * i), (LAS unsigned*)(slot + PB_QR + 1024 * i), 16, 0, 0);
        __builtin_amdgcn_global_load_lds((const unsigned*)(w + 1024 * i), (LAS unsigned*)(slot + PB_WY + 1024 * i), 16, 0, 0); }
    __builtin_amdgcn_global_load_lds((const unsigned*)na, (LAS unsigned*)(slot + PB_NA), 16, 0, 0); __builtin_amdgcn_global_load_lds((const unsigned*)(na + 1024), (LAS unsigned*)(slot + PB_NA + 1024), 16, 0, 0);
    __builtin_amdgcn_global_load_lds((const unsigned*)kh, (LAS unsigned*)(slot + PB_KH), 16, 0, 0); __builtin_amdgcn_global_load_lds((const unsigned*)(kh + 1024), (LAS unsigned*)(slot + PB_KH + 1024), 16, 0, 0);
    __builtin_amdgcn_global_load_lds((const unsigned*)((const unsigned char*)((const float*)(p.ws + WS_FP15) + task * 64) + lane * 16), (LAS unsigned*)(slot + PB_P15), 16, 0, 0);
    const unsigned char* V = (const unsigned char*)((const bf16_t*)(p.ws + WS_V) + ((size_t)b * SEQ + ct * 16) * 256 + hh * 64) + (size_t)(lane >> 3) * 512 + (lane & 7) * 16;
    __builtin_amdgcn_global_load_lds((const unsigned*)V, (LAS unsigned*)(slot + PB_V), 16, 0, 0); __builtin_amdgcn_global_load_lds((const unsigned*)(V + 8 * 512), (LAS unsigned*)(slot + PB_V + 1024), 16, 0, 0);
}
__device__ __forceinline__ void phaseb_unit(Frame& F, const Params& p, int u) {
    const unsigned flag_base = (unsigned)(size_t)(F.lds + 131072 + 128);
    if (F.tid < 8) lds_st_u32(flag_base + 4 * F.tid, 0u);
    __syncthreads();
    const int pair = F.wave & 3;
    if (pair >= 2) return;
    const int dbh = u * 2 + pair, dir = dbh >> 5;
    LAS unsigned char* ring = F.lds + pair * (PB_NSLOT * PB_SLOT);
    const unsigned f_pub = flag_base + 8 * pair, f_con = f_pub + 4;
    if (F.wave >= 4) {
        for (int c = 0; c < 128; ++c) {
            while ((int)lds_ld_u32(f_con) < c - (PB_NSLOT - 1)) __builtin_amdgcn_s_sleep(1);
            pb_dma(p, dbh, dir ? 127 - c : c, F.lane, ring + (c & (PB_NSLOT - 1)) * PB_SLOT);
            if (c >= 3) { asm volatile("s_waitcnt vmcnt(45)" ::: "memory"); if (F.lane == 0) lds_st_u32(f_pub, (unsigned)(c - 2)); }
        }
        asm volatile("s_waitcnt vmcnt(30)" ::: "memory"); if (F.lane == 0) lds_st_u32(f_pub, 126u);
        asm volatile("s_waitcnt vmcnt(15)" ::: "memory"); if (F.lane == 0) lds_st_u32(f_pub, 127u);
        asm volatile("s_waitcnt vmcnt(0)" ::: "memory"); if (F.lane == 0) lds_st_u32(f_pub, 128u);
        return;
    }
    const int b = (dbh >> 2) & 7, hh = dbh & 3, r = F.lane & 31, h = F.lane >> 5;
    GAS bf16_t* Y = (GAS bf16_t*)(p.ws + WS_Y) + ((size_t)dir * MTOK + (size_t)b * SEQ) * 256 + hh * 64 + r;
    f32x16 accS[2][2];
#pragma unroll
    for (int rb = 0; rb < 2; ++rb)
#pragma unroll
        for (int cb = 0; cb < 2; ++cb)
#pragma unroll
            for (int i = 0; i < 16; ++i) accS[rb][cb][i] = 0.f;
    for (int cc = 0; cc < 128; ++cc) {
        const int ct = dir ? 127 - cc : cc;
        const LAS unsigned char* slot = ring + (cc & (PB_NSLOT - 1)) * PB_SLOT;
        bf16x8 sb[4][2];
#pragma unroll
        for (int rb = 0; rb < 2; ++rb)
#pragma unroll
            for (int s2 = 0; s2 < 2; ++s2)
#pragma unroll
                for (int cb = 0; cb < 2; ++cb) { const f32x16& a = accS[rb][cb]; u32x4 w;
                    w.x = pk2(a[8 * s2 + 0], a[8 * s2 + 1]); w.y = pk2(a[8 * s2 + 2], a[8 * s2 + 3]); w.z = pk2(a[8 * s2 + 4], a[8 * s2 + 5]); w.w = pk2(a[8 * s2 + 6], a[8 * s2 + 7]);
                    sb[2 * rb + s2][cb] = __builtin_bit_cast(bf16x8, w); }
        while ((int)lds_ld_u32(f_pub) < cc + 1) __builtin_amdgcn_s_sleep(1);
        asm volatile("" ::: "memory");
        f32x16 D[2];
#pragma unroll
        for (int cb = 0; cb < 2; ++cb) { const LAS u32x4* wp = (const LAS u32x4*)(slot + PB_WY + (cb * 64 + F.lane) * 32); const u32x4 w0 = wp[0], w1 = wp[1];
            D[cb][0] = bflo(w0.x); D[cb][1] = bfhi(w0.x); D[cb][2] = bflo(w0.y); D[cb][3] = bfhi(w0.y); D[cb][4] = bflo(w0.z); D[cb][5] = bfhi(w0.z); D[cb][6] = bflo(w0.w); D[cb][7] = bfhi(w0.w);
            D[cb][8] = bflo(w1.x); D[cb][9] = bfhi(w1.x); D[cb][10] = bflo(w1.y); D[cb][11] = bfhi(w1.y); D[cb][12] = bflo(w1.z); D[cb][13] = bfhi(w1.z); D[cb][14] = bflo(w1.w); D[cb][15] = bfhi(w1.w); }
#pragma unroll
        for (int ks = 0; ks < 4; ++ks) { const bf16x8 qa = *(const LAS bf16x8*)(slot + PB_QR + (ks * 64 + F.lane) * 16);
            D[0] = __builtin_amdgcn_mfma_f32_32x32x16_bf16(qa, sb[ks][0], D[0], 0, 0, 0);
            D[1] = __builtin_amdgcn_mfma_f32_32x32x16_bf16(qa, sb[ks][1], D[1], 0, 0, 0); }
#pragma unroll
        for (int rb = 0; rb < 2; ++rb)
#pragma unroll
            for (int g4 = 0; g4 < 4; ++g4) { const f32x4 pv = *(const LAS f32x4*)(slot + PB_P15 + (32 * rb + 8 * g4 + 4 * h) * 4);
#pragma unroll
                for (int cb = 0; cb < 2; ++cb)
#pragma unroll
                    for (int q = 0; q < 4; ++q) accS[rb][cb][4 * g4 + q] *= pv[q]; }
        bf16x8 ub[2], vb[2];
#pragma unroll
        for (int cb = 0; cb < 2; ++cb) {
            unsigned short vt[8];
#pragma unroll
            for (int j = 0; j < 8; ++j) { const int s2 = 8 * (j >> 2) + 4 * h + (j & 3); const int tau = dir ? 15 - s2 : s2;
                vt[j] = *(const LAS unsigned short*)(slot + PB_V + tau * 128 + (32 * cb + r) * 2);
                Y[(size_t)(ct * 16 + tau) * 256 + 32 * cb] = (bf16_t)(pk2(D[cb][8 + j], 0.f) & 0xffffu); }
            vb[cb] = (bf16x8){(short)vt[0], (short)vt[1], (short)vt[2], (short)vt[3], (short)vt[4], (short)vt[5], (short)vt[6], (short)vt[7]};
            u32x4 w; w.x = pk2(D[cb][0], D[cb][1]); w.y = pk2(D[cb][2], D[cb][3]); w.z = pk2(D[cb][4], D[cb][5]); w.w = pk2(D[cb][6], D[cb][7]);
            ub[cb] = __builtin_bit_cast(bf16x8, w);
        }
        bf16x8 na[2], kh[2];
#pragma unroll
        for (int rb = 0; rb < 2; ++rb) { na[rb] = *(const LAS bf16x8*)(slot + PB_NA + (rb * 64 + F.lane) * 16); kh[rb] = *(const LAS bf16x8*)(slot + PB_KH + (rb * 64 + F.lane) * 16); }
        asm volatile("s_waitcnt lgkmcnt(0)" ::: "memory");
        if (F.lane == 0) lds_st_u32(f_con, (unsigned)(cc + 1));
#pragma unroll
        for (int rb = 0; rb < 2; ++rb)
#pragma unroll
            for (int cb = 0; cb < 2; ++cb) {
                accS[rb][cb] = __builtin_amdgcn_mfma_f32_32x32x16_bf16(na[rb], ub[cb], accS[rb][cb], 0, 0, 0);
                accS[rb][cb] = __builtin_amdgcn_mfma_f32_32x32x16_bf16(kh[rb], vb[cb], accS[rb][cb], 0, 0, 0);
            }
    }
}

__device__ __forceinline__ void post_unit(Frame& F, const Params& p, int l, int u) {
    REFRAME(F);
    const bf16_t* Y0 = (const bf16_t*)(p.ws + WS_Y); const bf16_t* Y1 = Y0 + (size_t)MTOK * 256;
    const bf16_t* VV = (const bf16_t*)(p.ws + WS_V); const bf16_t* GT = (const bf16_t*)(p.ws + WS_GATE);
    const float* BON = (const float*)(p.ws + WS_BON); bf16_t* MIX = (bf16_t*)(p.ws + WS_MIX);
    const f32x4 lg = *(const f32x4*)(p.in[19] + l * 256 + 4 * F.lane), lb = *(const f32x4*)(p.in[20] + l * 256 + 4 * F.lane);
    for (int tok = u * 64 + F.wave * 8, te = tok + 8; tok < te; ++tok) {
        const u32x2 a = *(const GAS u32x2*)((const GAS bf16_t*)Y0 + (size_t)tok * 256 + 4 * F.lane), c = *(const GAS u32x2*)((const GAS bf16_t*)Y1 + (size_t)tok * 256 + 4 * F.lane);
        const u32x2 vv = *(const GAS u32x2*)((const GAS bf16_t*)VV + (size_t)tok * 256 + 4 * F.lane), gg = *(const GAS u32x2*)((const GAS bf16_t*)GT + (size_t)tok * 256 + 4 * F.lane);
        float y[4] = {bflo(a.x) + bflo(c.x), bfhi(a.x) + bfhi(c.x), bflo(a.y) + bflo(c.y), bfhi(a.y) + bfhi(c.y)};
        float s = (y[0] + y[1]) + (y[2] + y[3]);
#pragma unroll
        for (int o = 1; o < 16; o <<= 1) s += __shfl_xor(s, o);
        const float mu = s * (1.f / 64.f);
        float q = 0.f;
#pragma unroll
        for (int i = 0; i < 4; ++i) { y[i] -= mu; q += y[i] * y[i]; }
#pragma unroll
        for (int o = 1; o < 16; o <<= 1) q += __shfl_xor(q, o);
        const float rstd = rsqrtf(q * (1.f / 64.f) + 64e-5f);
        const int hh = F.lane >> 4;
        const float bon = ((const GAS float*)BON)[(size_t)tok * 4 + hh] + ((const GAS float*)BON)[((size_t)MTOK + tok) * 4 + hh];
        const float v4[4] = {bflo(vv.x), bfhi(vv.x), bflo(vv.y), bfhi(vv.y)}, g4[4] = {bflo(gg.x), bfhi(gg.x), bflo(gg.y), bfhi(gg.y)};
        float o4[4];
#pragma unroll
        for (int i = 0; i < 4; ++i) o4[i] = (y[i] * rstd * lg[i] + lb[i] + bon * v4[i]) * g4[i];
        u32x2 w; w.x = pk2(o4[0], o4[1]); w.y = pk2(o4[2], o4[3]);
        *(GAS u32x2*)((GAS bf16_t*)MIX + (size_t)tok * DM + 768 + 4 * F.lane) = w;
    }
}

__device__ __forceinline__ void prologue(Frame& F, const Params& p) {
    REFRAME(F);
    LAS float* scr = (LAS float*)(F.lds + F.wave * 16384);
    const int gw = F.bid * 8 + F.wave, NGW = F.G * 8;
    bf16_t* wb = (bf16_t*)(p.ws + WS_W);
    for (int it = gw; it < CV_TOTAL; it += NGW) { if (it < CV_A) cvt_item_a(p, 0, wb, scr, it, F.lane); else cvt_item_b(p, 0, wb, scr, it - CV_A, F.lane); }
    const float* x = p.in[0]; float* X = p.out; bf16_t* XB = (bf16_t*)(p.ws + WS_XB); float* rowss = (float*)(p.ws + WS_RP);
    for (int m = gw; m < MTOK; m += NGW) {
        const f32x4* xr = (const f32x4*)(x + (size_t)m * DM) + F.lane; f32x4* xo = (f32x4*)(X + (size_t)m * DM) + F.lane; u32x2* bo = (u32x2*)(XB + (size_t)m * DM) + F.lane;
        float s = 0.f;
#pragma unroll
        for (int jj = 0; jj < 4; ++jj) { const f32x4 v = xr[64 * jj]; xo[64 * jj] = v; s += (v[0] * v[0] + v[1] * v[1]) + (v[2] * v[2] + v[3] * v[3]);
            u32x2 w; w.x = pk2(v[0], v[1]); w.y = pk2(v[2], v[3]); bo[64 * jj] = w; }
        s = wave_sum(s);
        if (F.lane < 16) rowss[(size_t)m * 16 + F.lane] = (F.lane == 0) ? s : 0.f;
    }
    const float* mem = p.in[1]; const float* gm = p.in[23]; bf16_t* MN = (bf16_t*)(p.ws + WS_MEMN);
    for (int m = gw; m < MMEM; m += NGW) {
        const f32x4* xr = (const f32x4*)(mem + (size_t)m * DM) + F.lane; u32x2* bo = (u32x2*)(MN + (size_t)m * DM) + F.lane;
        f32x4 v[4]; float s = 0.f;
#pragma unroll
        for (int jj = 0; jj < 4; ++jj) { v[jj] = xr[64 * jj]; s += (v[jj][0] * v[jj][0] + v[jj][1] * v[jj][1]) + (v[jj][2] * v[jj][2] + v[jj][3] * v[jj][3]); }
        const float rstd = rsqrtf(wave_sum(s) * (1.f / 1024.f) + 1e-6f);
#pragma unroll
        for (int jj = 0; jj < 4; ++jj) { const f32x4 g = *((const f32x4*)gm + F.lane + 64 * jj); const f32x4 t = v[jj] * rstd * g;
            u32x2 w; w.x = pk2(t[0], t[1]); w.y = pk2(t[2], t[3]); bo[64 * jj] = w; }
    }
}
__device__ __forceinline__ void final_norm(Frame& F, const Params& p) {
    REFRAME(F);
    const int gw = F.bid * 8 + F.wave, NGW = F.G * 8;
    const float* rowss = (const float*)(p.ws + WS_RP) + (size_t)12 * MTOK * 16; const float* gf = p.in[30];
    for (int m = gw; m < MTOK; m += NGW) {
        f32x4* xo = (f32x4*)(p.out + (size_t)m * DM) + F.lane;
        const float rstd = row_rstd(rowss, m);
#pragma unroll
        for (int jj = 0; jj < 4; ++jj) { const f32x4 g = *((const f32x4*)gf + F.lane + 64 * jj); xo[64 * jj] = xo[64 * jj] * rstd * g; }
#ifdef TPROBE
        { const unsigned* c_ = (const unsigned*)(p.ws + WS_CTL); const float A_ = (float)c_[32] * 1e-4f, B_ = (float)c_[33] * 1e-4f;
          if (m >= 1024 && m < 2048) {
#pragma unroll
              for (int jj = 0; jj < 4; ++jj) xo[64 * jj] = xo[64 * jj] + B_; }
          if (m == 0 && F.lane == 0) { f32x4 v = xo[0]; v[0] += A_; xo[0] = v; } }
#endif
    }
}

#define XB_TMO      128
#define XB_XCNT(j)  (256  + 64 * (j))
#define XB_XSUB(j)  (1280 + 64 * (j))
#define XB_XGEN(j)  (2304 + 64 * (j))
#define XB_TOP      3328
#define XB_TOPGEN   3392
#define XB_SPIN_CAP (1u << 22)
constexpr int CW_BAR = 4096;
__device__ __forceinline__ unsigned xb_ld(unsigned* p)              { return __hip_atomic_load(p, __ATOMIC_RELAXED, __HIP_MEMORY_SCOPE_AGENT); }
__device__ __forceinline__ unsigned xb_add(unsigned* p, unsigned v) { return __hip_atomic_fetch_add(p, v, __ATOMIC_RELAXED, __HIP_MEMORY_SCOPE_AGENT); }
__device__ __forceinline__ unsigned xb_xcc_id() { return (unsigned)__builtin_amdgcn_s_getreg((3 << 11) | 20) & 0xFu; }
#define XB_SPIN(cond, bar) do { unsigned _sp = 0; while (cond) { __builtin_amdgcn_s_sleep(1); \
    if ((++_sp & 255u) == 0u) { if (xb_ld(&(bar)[XB_TMO])) break; if (_sp > XB_SPIN_CAP) { atomicAdd(&(bar)[XB_TMO], 1u); break; } } } } while (0)
__device__ __forceinline__ void xcd_barrier_complete(unsigned* bar, unsigned x, unsigned& nloc, unsigned& nx) {
    const unsigned G = gridDim.x;
    unsigned sum, cnt, mine, sp = 0u;
    for (;;) {
        sum = 0u; cnt = 0u; mine = 0u;
#pragma unroll
        for (unsigned j = 0; j < 16; ++j) { const unsigned c = xb_ld(&bar[XB_XCNT(j)]); sum += c; cnt += (c > 0u) ? 1u : 0u; mine = (j == x) ? c : mine; }
        if (sum == G) break;
        __builtin_amdgcn_s_sleep(1);
        if ((++sp & 255u) == 0u) { if (xb_ld(&bar[XB_TMO])) break; if (sp > XB_SPIN_CAP) { atomicAdd(&bar[XB_TMO], 1u); break; } }
    }
    nloc = mine > 0u ? mine : 1u; nx = cnt > 0u ? cnt : 1u;
}
__device__ __forceinline__ void gsync(volatile LAS unsigned* st) {
    unsigned* bar = (unsigned*)(make_params().ws + WS_CTL) + CW_BAR;
    asm volatile("s_waitcnt vmcnt(0)" ::: "memory");
    __syncthreads();
    if (threadIdx.x == 0) {
        const unsigned x = xb_xcc_id();
        __builtin_amdgcn_s_waitcnt(0);
        unsigned nloc = st[0], nx = st[1];
        if (nloc == 0u) { xcd_barrier_complete(bar, x, nloc, nx); st[0] = nloc; st[1] = nx; }
        const unsigned old = xb_add(&bar[XB_XSUB(x)], 1u);
        const unsigned gen = old / nloc;
        if (old + 1u == (gen + 1u) * nloc) {
            __builtin_amdgcn_fence(__ATOMIC_RELEASE, "agent");
            asm volatile("s_waitcnt vmcnt(0)" ::: "memory");
            const unsigned og = xb_add(&bar[XB_TOP], 1u);
            const unsigned tg = og / nx;
            if (og + 1u == (tg + 1u) * nx) xb_add(&bar[XB_TOPGEN], 1u);
            else XB_SPIN(xb_ld(&bar[XB_TOPGEN]) == tg, bar);
            __builtin_amdgcn_fence(__ATOMIC_ACQUIRE, "agent");
            xb_add(&bar[XB_XGEN(x)], 1u);
            asm volatile("s_waitcnt vmcnt(0)" ::: "memory");
        } else {
            XB_SPIN(xb_ld(&bar[XB_XGEN(x)]) == gen, bar);
            __builtin_amdgcn_fence(__ATOMIC_ACQUIRE, "agent");
            asm volatile("s_waitcnt vmcnt(0)" ::: "memory");
        }
    }
    __syncthreads();
}
#ifdef TPROBE
#define STAMP(id) do { if (blockIdx.x == 0 && threadIdx.x == 0) { LAS unsigned long long* ts_ = (LAS unsigned long long*)(F.lds + 131072 + 64); const unsigned long long now_ = __builtin_amdgcn_s_memrealtime(); \
    const unsigned long long dt_ = now_ - ts_[0]; ts_[0] = now_; if ((TA_MASK >> (id)) & 1) ts_[1] += dt_; if ((TB_MASK >> (id)) & 1) ts_[2] += dt_; } } while (0)
#else
#define STAMP(id) do { } while (0)
#endif
#ifndef PH_MASK
#define PH_MASK 0xFFFF
#endif
#ifndef REP_MASK
#define REP_MASK 0
#endif
#define NREP(k) ((((REP_MASK) >> (k)) & 1) ? 2 : 1)
constexpr int NCP = 1024, NDIFF_A = 0, NPB = 32;
__global__ void __launch_bounds__(512, 2) fwd_megakernel(KArgs kargs_unused) {
    extern __shared__ __attribute__((aligned(16))) unsigned char lds_raw[];
    cg::grid_group grid = cg::this_grid();
    Frame F; F.lds = (LAS unsigned char*)lds_raw; F.tid = threadIdx.x; F.lane = F.tid & 63; F.wave = __builtin_amdgcn_readfirstlane(F.tid >> 6); F.G = gridDim.x; F.bid = blockIdx.x;
    LAS int* qslot = (LAS int*)(F.lds + 131072);
    volatile LAS unsigned* bst = (volatile LAS unsigned*)(F.lds + 131072 + 32);
    { unsigned* bar0 = (unsigned*)(make_params().ws + WS_CTL) + CW_BAR;
      if (threadIdx.x == 0) { bst[0] = 0u; bst[1] = 0u; (void)xb_add(bar0 + XB_XCNT(xb_xcc_id()), 1u); } }
    __syncthreads();
#define PHASE_VARS() const Params p = make_params(); unsigned* ctl = (unsigned*)(p.ws + WS_CTL); float* rowss = (float*)(p.ws + WS_RP); \
    bf16_t* XB = (bf16_t*)(p.ws + WS_XB); bf16_t* Z = (bf16_t*)(p.ws + WS_Z); bf16_t* MIX = (bf16_t*)(p.ws + WS_MIX); \
    bf16_t* wb = (bf16_t*)(p.ws + WS_W); int bid_ = F.bid, G_ = F.G; asm volatile("" : "+s"(bid_), "+s"(G_)); (void)bid_; (void)G_; (void)ctl; (void)rowss; (void)XB; (void)Z; (void)MIX; (void)wb

#ifdef TPROBE
    if (blockIdx.x == 0 && threadIdx.x == 0) { LAS unsigned long long* ts_ = (LAS unsigned long long*)(F.lds + 131072 + 64); ts_[0] = __builtin_amdgcn_s_memrealtime(); ts_[1] = 0; ts_[2] = 0; }
#endif
    if (PH_MASK & 1) { const Params p = make_params(); prologue(F, p); }
    grid.sync();
    STAMP(0);

    for (int l = 0; l < NL; ++l) {
        for (int rep = 0; rep < NREP(1); ++rep) {
        if (PH_MASK & 2) {
            PHASE_VARS();
            pg8::StaticOrder S; S.init(MTOK, INW, G_, bid_);
            pg8::gemm_phase(F.lds, pg8::Gemm{XB, wb + WO_IN, MTOK, INW, DM}, S, pg8::EpiScaleBf16{Z, ZP, rowss + (size_t)(3 * l) * MTOK * 16, (bf16_t*)(p.ws + WS_ZC), 1024, 8, (bf16_t*)(p.ws + WS_KD2)});
        }
        gsync(bst); STAMP(1);
        }
        for (int rep = 0; rep < NREP(2); ++rep) {
        for (int u = F.bid; u < 768; u += F.G) {
            PHASE_VARS();
            if (u < 512) { if (PH_MASK & 4) prep_unit(F, p, l, wb, u); } else if (PH_MASK & 8) win_unit(F, p, l, u - 512);
        }
        gsync(bst); STAMP(2);
        }
        for (int rep = 0; rep < NREP(3); ++rep) {
        {
            PHASE_VARS();
            const int ntot = NCP + NDIFF_A;
            for (;;) {
                __syncthreads();
                if (F.tid == 0) *qslot = (int)atomicAdd(ctl + CW_Q + 16 * l + 4 * rep, 1u);
                __syncthreads();
                const int u = *qslot;
                if (u >= ntot) break;
                if (u < NCP) { if (PH_MASK & 16) { REFRAME(F); if (u >= NCP / 2) chunkprep_wave<1>(F, p, u * 8 + F.wave); else chunkprep_wave<0>(F, p, u * 8 + F.wave); } }
                else if (PH_MASK & 32) diff_unit(F, p, l, u - NCP);
            }
        }
        gsync(bst); STAMP(11);
        }
        for (int rep = 0; rep < NREP(4); ++rep) {
        {
            PHASE_VARS();
            const int ncva = (l + 1 < NL) ? CV_A / 8 : 0, ncvb = (l > 0) ? CV_B / 8 : 0, ncv = NPB + ncva + ncvb, ntot = ncv + 256;
            unsigned* pbdone = ctl + 3072 + (l * 2 + rep) * 16;
            unsigned* gq = ctl + CW_Q + 16 * l + 8 + 4 * rep; unsigned* dq = ctl + 2048 + (l * 2 + rep) * 16;
            const int myx = (int)(xb_xcc_id() & 7u);
            int stage = 0, pend = -1, xi = 0;
            for (;;) {
                __syncthreads();
                if (F.tid == 0) {
                    int code = -1;
                    if (stage == 0) { const int g = (int)atomicAdd(gq, 1u); if (g < NPB) code = g; else { pend = g; stage = 1; } }
                    if (stage == 1) {
                        while (xi < 8) { const int x = (myx + xi) & 7; const int tk = (int)atomicAdd(dq + x, 1u); if (tk < 64) { code = -2 - ((4 * x + (tk >> 4)) * 16 + (tk & 15)); break; } ++xi; }
                        if (xi >= 8) stage = 2;
                    }
                    if (stage == 2 && code == -1) { int g = pend; pend = -1; if (g < 0) g = (int)atomicAdd(gq, 1u); if (g < ntot) code = g; }
                    *qslot = code;
                }
                __syncthreads();
                const int u = *qslot;
                if (u == -1) break;
                if (u <= -2) { if (PH_MASK & 32) diff_unit(F, p, l, -2 - u); }
                else if (u < NPB) { if (PH_MASK & 16) { REFRAME(F); phaseb_unit(F, p, u); }
                    __threadfence(); __syncthreads();
                    if (F.tid == 0) __hip_atomic_fetch_add(pbdone, 1u, __ATOMIC_RELEASE, __HIP_MEMORY_SCOPE_AGENT); }
                else if (u >= ncv) {
                    if (F.tid == 0) { while (__hip_atomic_load(pbdone, __ATOMIC_RELAXED, __HIP_MEMORY_SCOPE_AGENT) < (unsigned)NPB) __builtin_amdgcn_s_sleep(8); }
                    __syncthreads(); __builtin_amdgcn_fence(__ATOMIC_ACQUIRE, "agent");
                    if (PH_MASK & 64) post_unit(F, p, l, u - ncv); }
                else if (u < NPB + ncva) { REFRAME(F); cvt_item_a(p, l + 1, wb, (LAS float*)(F.lds + F.wave * 16384), (u - NPB) * 8 + F.wave, F.lane); }
                else { REFRAME(F); cvt_item_b(p, l, wb, (LAS float*)(F.lds + F.wave * 16384), (u - NPB - ncva) * 8 + F.wave, F.lane); }
            }
        }
        gsync(bst); STAMP(3);
        }
        if (PH_MASK & 128) {
            PHASE_VARS();
            pg8::StaticOrder S; S.init(MTOK, DM, G_, bid_);
            pg8::gemm_phase(F.lds, pg8::Gemm{MIX, wb + WO_OUT, MTOK, DM, DM}, S, pg8::EpiResid{p.out, XB, rowss + (size_t)(3 * l + 1) * MTOK * 16});
        }
        gsync(bst); STAMP(5);
        for (int rep = 0; rep < NREP(6); ++rep) {
        if (PH_MASK & 256) {
            PHASE_VARS();
            pg8::StaticOrder S; S.init(MTOK, XW, G_, bid_);
            if (F.bid < 128) {
                pg8::gemm_phase(F.lds, pg8::Gemm{XB, wb + WO_Q, MTOK, XW, DM}, S, pg8::EpiScaleBf16{(bf16_t*)(p.ws + WS_Q), XW, rowss + (size_t)(3 * l + 1) * MTOK * 16, nullptr, 0, 1 << 30, nullptr});
            } else {
                pg8::StaticOrder S2; S2.init(MMEM, 1024, 128, F.bid - 128);
                pg8::gemm_phase(F.lds, pg8::Gemm{(const bf16_t*)(p.ws + WS_MEMN), wb + WO_KV, MMEM, 1024, DM}, S2, pg8::EpiScaleBf16{(bf16_t*)(p.ws + WS_KV), 1024, nullptr, nullptr, 0, 1 << 30, nullptr});
            }
        }
        gsync(bst); STAMP(6);
        }
        for (int rep = 0; rep < NREP(7); ++rep) {
        if (PH_MASK & 512) for (int u = F.bid; u < 256; u += F.G) { PHASE_VARS(); cross_unit(F, p, u); }
        gsync(bst); STAMP(7);
        }
        if (PH_MASK & 1024) {
            PHASE_VARS();
            pg8::StaticOrder S; S.init(MTOK, DM, G_, bid_);
            pg8::gemm_phase(F.lds, pg8::Gemm{(const bf16_t*)(p.ws + WS_O), wb + WO_O, MTOK, DM, XW}, S, pg8::EpiResid{p.out, XB, rowss + (size_t)(3 * l + 2) * MTOK * 16});
        }
        gsync(bst); STAMP(8);
        for (int rep = 0; rep < NREP(9); ++rep) {
        if (PH_MASK & 2048) {
            PHASE_VARS();
            pg8::StaticOrder S; S.init(MTOK, 2 * DFF, G_, bid_);
            pg8::gemm_phase(F.lds, pg8::Gemm{XB, wb + WO_GU, MTOK, 2 * DFF, DM}, S, pg8::EpiSwiGLU{(bf16_t*)(p.ws + WS_G), rowss + (size_t)(3 * l + 2) * MTOK * 16});
        }
        gsync(bst); STAMP(9);
        }
        if (PH_MASK & 4096) {
            PHASE_VARS();
            pg8::StaticOrder S; S.init(MTOK, DM, G_, bid_);
            pg8::gemm_phase(F.lds, pg8::Gemm{(const bf16_t*)(p.ws + WS_G), wb + WO_DOWN, MTOK, DM, DFF}, S, pg8::EpiResid{p.out, XB, rowss + (size_t)(3 * l + 3) * MTOK * 16});
        }

#ifdef TPROBE
        STAMP(10);
        { const Params p = make_params(); if (l == NL - 1 && blockIdx.x == 0 && threadIdx.x == 0) { LAS unsigned long long* ts_ = (LAS unsigned long long*)(F.lds + 131072 + 64); unsigned* c_ = (unsigned*)(p.ws + WS_CTL); c_[32] = (unsigned)ts_[1]; c_[33] = (unsigned)ts_[2]; } }
#endif
        gsync(bst);
    }
    if (PH_MASK & 8192) { const Params p = make_params(); final_norm(F, p); }
}

extern "C" void kernel_launch(void* const* d_in, const int* in_sizes, int n_in, void* d_out, int out_size, void* d_ws, size_t ws_size, hipStream_t stream) {
    static int grid = 0;
    if (grid == 0) {
        if (n_in != 31 || out_size != MTOK * DM || ws_size < WS_END) { fprintf(stderr, "kernel_launch: unexpected problem shape (n_in %d out %d ws %zu)\n", n_in, out_size, ws_size); grid = -1; return; }
        int dev = 0, cus = 0, per_cu = 0;
        hipGetDevice(&dev);
        hipDeviceGetAttribute(&cus, hipDeviceAttributeMultiprocessorCount, dev);
        hipFuncSetAttribute((const void*)fwd_megakernel, hipFuncAttributeMaxDynamicSharedMemorySize, LDS_BYTES);
        hipOccupancyMaxActiveBlocksPerMultiprocessor(&per_cu, (const void*)fwd_megakernel, 512, LDS_BYTES);
        if (per_cu < 1) { fprintf(stderr, "kernel_launch: occupancy query returned %d\n", per_cu); per_cu = 1; }
        (void)hipGetLastError();
        grid = cus * per_cu;
    }
    if (grid < 0) return;
    hipMemsetAsync((char*)d_ws + WS_CTL, 0, CTL_ZERO_BYTES, stream);
    KArgs p{};
    for (int i = 0; i < 31; ++i) p.in[i] = (const float*)d_in[i];
    p.out = (float*)d_out; p.ws = (unsigned char*)d_ws;
    void* args[] = {&p};
    hipError_t e = hipLaunchCooperativeKernel((const void*)fwd_megakernel, dim3(grid), dim3(512), args, LDS_BYTES, stream);
    if (e != hipSuccess) fprintf(stderr, "cooperative launch failed: %s (grid %d)\n", hipGetErrorString(e), grid);
}
```

```cpp
#include <hip/hip_runtime.h>
#include <hip/hip_cooperative_groups.h>
#include <cstdio>
#include <cstdint>
namespace cg = cooperative_groups;

#define LAS __attribute__((address_space(3)))
#define GAS __attribute__((address_space(1)))
typedef unsigned short bf16_t;
typedef short bf16x8 __attribute__((ext_vector_type(8)));
typedef short s16x4 __attribute__((ext_vector_type(4)));
typedef short v4i16_t __attribute__((ext_vector_type(4)));
typedef float f32x4 __attribute__((ext_vector_type(4)));
typedef float f32x2 __attribute__((ext_vector_type(2)));
typedef float f32x16 __attribute__((ext_vector_type(16)));
typedef unsigned u32x4 __attribute__((ext_vector_type(4)));
typedef unsigned u32x2 __attribute__((ext_vector_type(2)));
typedef __bf16 bf16x2_t __attribute__((ext_vector_type(2)));

constexpr int DM = 1024, NB = 8, SEQ = 2048, NL = 4, MTOK = NB * SEQ;
constexpr int NMEM = 256, MMEM = NB * NMEM;
constexpr int INW = 3072, DFF = 2816, XW = 512;
constexpr float LOG2E = 1.4426950408889634f;

constexpr size_t MiB = 1u << 20;
constexpr size_t WS_CTL = 0, CTL_ZERO_BYTES = 1 * MiB;
constexpr size_t WS_W = 1 * MiB;
constexpr size_t WS_Z = 30 * MiB;
constexpr size_t WS_ZC = 94 * MiB;
constexpr size_t WS_XB = 126 * MiB;
constexpr size_t WS_FQR = 94 * MiB, WS_FWY = 126 * MiB, WS_FNA = 158 * MiB, WS_FKH = 174 * MiB, WS_FP15 = 190 * MiB;
constexpr size_t WS_MIX = 192 * MiB;
constexpr size_t WS_OM = 224 * MiB, WS_KA = 240 * MiB, WS_KD = 256 * MiB, WS_KK = 272 * MiB, WS_V = 280 * MiB, WS_R = 288 * MiB;
constexpr size_t WS_GATE = 296 * MiB, WS_Y = 304 * MiB, WS_BON = 320 * MiB, WS_KV = 321 * MiB, WS_MEMN = 325 * MiB;
constexpr size_t WS_RP = 329 * MiB;
constexpr size_t WS_END = 342 * MiB;
constexpr size_t WS_Q = WS_Z, WS_O = WS_Z + 16 * MiB, WS_G = WS_Z;
constexpr int ZP = 1024;
constexpr size_t WS_KD2 = WS_Z + 32 * MiB, WS_VD2 = WS_Z + 48 * MiB;
constexpr size_t WO_IN = 0, WO_OUT = 3145728, WO_Q = 4194304, WO_KV = 4718592, WO_O = 5767168, WO_GU = 6291456, WO_DOWN = 12058624;
constexpr size_t WO_WUP = 14942208, WO_AUP = 14974976, WO_GUP = 15007744;
constexpr int CW_Q = 64;

constexpr int LDS_BYTES = 135168;

__device__ __forceinline__ float bf2f(unsigned b) { return __uint_as_float(b << 16); }
__device__ __forceinline__ unsigned pk2(float lo, float hi) { f32x2 v = {lo, hi}; bf16x2_t b = __builtin_convertvector(v, bf16x2_t); return __builtin_bit_cast(unsigned, b); }
__device__ __forceinline__ float bflo(unsigned u) { return __uint_as_float(u << 16); }
__device__ __forceinline__ float bfhi(unsigned u) { return __uint_as_float(u & 0xffff0000u); }
__device__ __forceinline__ float wave_sum(float v) {
#pragma unroll
    for (int o = 1; o < 64; o <<= 1) v += __shfl_xor(v, o);
    return v;
}
__device__ __forceinline__ float xhalf(float v) {
    return __shfl_xor(v, 32);
}
__device__ __forceinline__ float row_rstd(const float* rp, int row) {
    const f32x4* q = (const f32x4*)(rp + (size_t)row * 16); const f32x4 a = q[0], b = q[1], c = q[2], d = q[3];
    const float s = (((a[0] + a[1]) + (a[2] + a[3])) + ((b[0] + b[1]) + (b[2] + b[3]))) + (((c[0] + c[1]) + (c[2] + c[3])) + ((d[0] + d[1]) + (d[2] + d[3])));
    return rsqrtf(s * (1.f / 1024.f) + 1e-6f);
}
__device__ __forceinline__ float sigmoidf_(float x) { return __builtin_amdgcn_rcpf(1.f + __expf(-x)); }

__device__ __forceinline__ int hw_lane() { int l = (int)__builtin_amdgcn_mbcnt_hi(~0u, __builtin_amdgcn_mbcnt_lo(~0u, 0u)); asm volatile("" : "+v"(l)); return l; }
namespace pg8 {
constexpr int BM = 256, BK = 64, HALF = 128, HTB = HALF * BK * 2, NXCD = 8, WGM = 8;
__host__ __device__ __forceinline__ int lds_byte(int r, int c) { const int st = (r >> 4) * 2 + (c >> 5), rr = r & 15, cc = c & 31, ob = rr * 64 + cc * 2; return st * 1024 + (ob ^ (((ob >> 9) & 1) << 5)); }
__host__ __device__ __forceinline__ void stage_rc(int b, int& R, int& C) { const int st = b / 1024, sb = b % 1024, swz = sb ^ (((sb >> 9) & 1) << 5); R = (st >> 1) * 16 + swz / 64; C = (st & 1) * 32 + (swz % 64) / 2; }
__host__ __device__ __forceinline__ int perm32(int rho) { const int n = rho >> 4, i = rho & 15; return 8 * (i >> 2) + 4 * n + (i & 3); }
struct Unit { int pm, pn; };
struct Gemm { const bf16_t* A; const bf16_t* Bt; int M, N, K; };
struct StaticOrder {
    int nM, nN, nwg, G, c;
    __device__ void init(int M, int N, int G_, int c_) { nM = M / BM; nN = N / BM; nwg = nM * nN; G = G_; c = c_; }
    __device__ bool next(int i, Unit& u) const {
        const long L = (long)i * G + c; if (L >= nwg) return false;
        int wgid = (int)L; { const int q = nwg / NXCD, r = nwg % NXCD, xcd = wgid % NXCD, off = wgid / NXCD; wgid = (xcd < r ? xcd * (q + 1) : r * (q + 1) + (xcd - r) * q) + off; }
        const int nig = WGM * nN, gid = wgid / nig, fm = gid * WGM, gsz = (nM - fm) < WGM ? (nM - fm) : WGM;
        u.pm = fm + ((wgid % nig) % gsz); u.pn = (wgid % nig) / gsz; return true;
    }
};
template <class Epi>
__device__ __forceinline__ void gemm_phase(LAS unsigned char* lds, const Gemm g, const StaticOrder& S, const Epi& E) {
    int tid_ = threadIdx.x; asm volatile("" : "+v"(tid_));
    const int tid = tid_, wid = __builtin_amdgcn_readfirstlane(tid >> 6), lane = tid & 63, wr = wid >> 2, wc = wid & 3, fr = lane & 15, fq = lane >> 4;
    const int K = g.K, nt = K / BK;
    unsigned voffA[2], voffB[2];
#pragma unroll
    for (int i = 0; i < 2; ++i) { int R, C; stage_rc(tid * 16 + i * 8192, R, C); const int Rb = (R & ~31) + perm32(R & 31);
        voffA[i] = (unsigned)(R * K + C) * 2u; voffB[i] = (unsigned)(Rb * K + C) * 2u; }
    const size_t kstep = (size_t)(BK * 2);
    const size_t hstep = (size_t)HALF * K * 2;
    const size_t tstep = 2 * hstep;
    const unsigned ldsw = (unsigned)wid * 1024u;
    const int aoff = lds_byte(wr * 64 + fr, fq * 8), boff = lds_byte(wc * 32 + fr, fq * 8);
#define PG8_SA(b, h) (((b) * 2 + (h)) * HTB)
#define PG8_SB(b, h) ((4 + (b) * 2 + (h)) * HTB)
#define PG8_STAGE(bufoff, gbase, voff) do { _Pragma("unroll") for (int _i = 0; _i < 2; ++_i) \
        __builtin_amdgcn_global_load_lds((const unsigned*)((const char*)(gbase) + (voff)[_i]), (LAS unsigned*)(lds + (bufoff) + ldsw + _i * 8192), 16, 0, 0); } while (0)
#define PG8_LDA(dst, b, h) do { _Pragma("unroll") for (int m = 0; m < 4; ++m) _Pragma("unroll") for (int k = 0; k < 2; ++k) dst[m][k] = *(const LAS bf16x8*)(lds + PG8_SA(b, h) + aoff + m * 2048 + k * 1024); } while (0)
#define PG8_LDB(dst, b, h) do { _Pragma("unroll") for (int n = 0; n < 2; ++n) _Pragma("unroll") for (int k = 0; k < 2; ++k) dst[n][k] = *(const LAS bf16x8*)(lds + PG8_SB(b, h) + boff + n * 2048 + k * 1024); } while (0)
#define PG8_MMA(ai, bj, At, Bt) do { __builtin_amdgcn_s_setprio(1); _Pragma("unroll") for (int m = 0; m < 4; ++m) _Pragma("unroll") for (int n = 0; n < 2; ++n) _Pragma("unroll") for (int k = 0; k < 2; ++k) \
        acc[ai][bj][m][n] = __builtin_amdgcn_mfma_f32_16x16x32_bf16(Bt[n][k], At[m][k], acc[ai][bj][m][n], 0, 0, 0); __builtin_amdgcn_s_setprio(0); } while (0)
#define PG8_WAIT_V(n) asm volatile("s_waitcnt vmcnt(" #n ")" ::: "memory")
#define PG8_WAIT_L(n) asm volatile("s_waitcnt lgkmcnt(" #n ")" ::: "memory")
#define PG8_BAR __builtin_amdgcn_s_barrier()
#define PG8_SCHED __builtin_amdgcn_sched_barrier(0)
    Unit cur, nxt; int ui = 0;
    if (!S.next(0, cur)) return;
    f32x4 acc[2][2][4][2];
#pragma unroll
    for (int a = 0; a < 2; ++a)
#pragma unroll
        for (int b = 0; b < 2; ++b)
#pragma unroll
            for (int m = 0; m < 4; ++m)
#pragma unroll
                for (int n = 0; n < 2; ++n) acc[a][b][m][n] = (f32x4){0.f, 0.f, 0.f, 0.f};
    bf16x8 At[4][2], B0[2][2], B1[2][2];
    const char* cA = (const char*)g.A + (size_t)cur.pm * tstep; const char* cB = (const char*)g.Bt + (size_t)cur.pn * tstep;
    {
        PG8_STAGE(PG8_SB(0, 0), cB, voffB); PG8_STAGE(PG8_SB(0, 1), cB + hstep, voffB); PG8_STAGE(PG8_SA(0, 0), cA, voffA); PG8_STAGE(PG8_SA(0, 1), cA + hstep, voffA);
        if (wr == 1) PG8_BAR;
        PG8_WAIT_V(2); PG8_BAR;
        PG8_STAGE(PG8_SB(1, 0), cB + kstep, voffB); PG8_STAGE(PG8_SA(1, 0), cA + kstep, voffA); PG8_STAGE(PG8_SB(1, 1), cB + hstep + kstep, voffB);
        PG8_WAIT_V(6); PG8_BAR;
    }
    for (;;) {
        const bool has_next = S.next(ui + 1, nxt);
        const char* nA = has_next ? (const char*)g.A + (size_t)nxt.pm * tstep : cA; const char* nB = has_next ? (const char*)g.Bt + (size_t)nxt.pn * tstep : cB;
        for (int t = 0; t < nt; t += 2) {
            const bool last = (t == nt - 2);
            const char* a1 = cA + (size_t)(t + 1) * kstep;
            const char* a2 = last ? nA : cA + (size_t)(t + 2) * kstep; const char* b2 = last ? nB : cB + (size_t)(t + 2) * kstep;
            const char* a3 = a2 + kstep; const char* b3 = b2 + kstep;
            PG8_LDB(B0, 0, 0); PG8_LDB(B1, 0, 1); PG8_SCHED; PG8_LDA(At, 0, 0); PG8_STAGE(PG8_SA(1, 1), a1 + hstep, voffA);
            PG8_WAIT_V(8); PG8_WAIT_L(0); PG8_BAR; PG8_MMA(0, 0, At, B0); PG8_MMA(0, 1, At, B1); PG8_BAR; PG8_SCHED;
            PG8_LDA(At, 0, 1); PG8_STAGE(PG8_SB(0, 0), b2, voffB); PG8_STAGE(PG8_SB(0, 1), b2 + hstep, voffB); PG8_STAGE(PG8_SA(0, 0), a2, voffA);
            PG8_WAIT_V(8); PG8_WAIT_L(0); PG8_BAR; PG8_MMA(1, 0, At, B0); PG8_MMA(1, 1, At, B1); PG8_BAR; PG8_SCHED;
            PG8_LDB(B0, 1, 0); PG8_LDB(B1, 1, 1); PG8_SCHED; PG8_LDA(At, 1, 0); PG8_STAGE(PG8_SA(0, 1), a2 + hstep, voffA);
            PG8_WAIT_V(8); PG8_WAIT_L(0); PG8_BAR; PG8_MMA(0, 0, At, B0); PG8_MMA(0, 1, At, B1); PG8_BAR; PG8_SCHED;
            PG8_LDA(At, 1, 1); PG8_STAGE(PG8_SB(1, 0), b3, voffB); PG8_STAGE(PG8_SB(1, 1), b3 + hstep, voffB); PG8_STAGE(PG8_SA(1, 0), a3, voffA);
            PG8_WAIT_V(8); PG8_WAIT_L(0); PG8_BAR; PG8_MMA(1, 0, At, B0); PG8_MMA(1, 1, At, B1); PG8_BAR; PG8_SCHED;
        }
        if (wr == 0) PG8_BAR;
        E(acc, cur, wr, wc, fr, fq);
        if (!has_next) break;
#pragma unroll
        for (int a = 0; a < 2; ++a)
#pragma unroll
            for (int b = 0; b < 2; ++b)
#pragma unroll
                for (int m = 0; m < 4; ++m)
#pragma unroll
                    for (int n = 0; n < 2; ++n) acc[a][b][m][n] = (f32x4){0.f, 0.f, 0.f, 0.f};
        cur = nxt; cA = nA; cB = nB; ++ui;
        if (wr == 1) PG8_BAR;
    }
    PG8_WAIT_V(0);
    PG8_BAR;
#undef PG8_SA
#undef PG8_SB
#undef PG8_STAGE
#undef PG8_LDA
#undef PG8_LDB
#undef PG8_MMA
#undef PG8_WAIT_V
#undef PG8_WAIT_L
#undef PG8_BAR
#undef PG8_SCHED
}

struct EpiScaleBf16 {
    bf16_t* O; int ldc; const float* rowss; bf16_t* O2; int ldc2; int split_tile; bf16_t* KD2;
    __device__ __forceinline__ void operator()(const f32x4 (&acc)[2][2][4][2], const Unit& u, int wr, int wc, int fr, int fq) const {
        const bool hi = u.pn >= split_tile, mid = (split_tile == 8) && u.pn >= 4 && u.pn < 8;
        const int row0 = u.pm * BM + wr * 64 + fr, col0 = (hi ? u.pn - split_tile : u.pn) * BM + wc * 32 + 8 * fq;
        bf16_t* const Ob = hi ? O2 : O; const int ld = hi ? ldc2 : ldc;
#pragma unroll
        for (int ai = 0; ai < 2; ++ai)
#pragma unroll
            for (int m = 0; m < 4; ++m) { const int row = row0 + ai * HALF + m * 16;
                const float sc = rowss ? row_rstd(rowss, row) : 1.f;
                bf16_t* rowp = Ob + (size_t)row * ld + col0;
#pragma unroll
                for (int bj = 0; bj < 2; ++bj) { const f32x4 v0 = acc[ai][bj][m][0] * sc, v1 = acc[ai][bj][m][1] * sc;
                    u32x4 w; w.x = pk2(v0[0], v0[1]); w.y = pk2(v0[2], v0[3]); w.z = pk2(v1[0], v1[1]); w.w = pk2(v1[2], v1[3]);
                    bf16_t* dst = rowp + bj * HALF;
                    if (mid) dst = KD2 + (u.pn >= 6 ? (size_t)8388608 : (size_t)0) + ((size_t)(((row >> 11) * 4 + 2 * (u.pn & 1) + bj) * 2048 + (row & 2047))) * 128 + wc * 32 + 8 * fq;
                    *(u32x4*)dst = w; } }
    }
};
struct EpiSwiGLU {
    bf16_t* O; const float* rowss;
    __device__ __forceinline__ void operator()(const f32x4 (&acc)[2][2][4][2], const Unit& u, int wr, int wc, int fr, int fq) const {
        const int row0 = u.pm * BM + wr * 64 + fr, col0 = u.pn * HALF + wc * 32 + 8 * fq;
#pragma unroll
        for (int ai = 0; ai < 2; ++ai)
#pragma unroll
            for (int m = 0; m < 4; ++m) { const int row = row0 + ai * HALF + m * 16;
                const float sc = row_rstd(rowss, row);
                float h[8];
#pragma unroll
                for (int n = 0; n < 2; ++n)
#pragma unroll
                    for (int j = 0; j < 4; ++j) { const float gt = acc[ai][0][m][n][j] * sc, up = acc[ai][1][m][n][j] * sc; h[n * 4 + j] = gt * __builtin_amdgcn_rcpf(1.f + __expf(-gt)) * up; }
                u32x4 w; w.x = pk2(h[0], h[1]); w.y = pk2(h[2], h[3]); w.z = pk2(h[4], h[5]); w.w = pk2(h[6], h[7]);
                *(u32x4*)(O + (size_t)row * DFF + col0) = w; }
    }
};
struct EpiResid {
    float* X; bf16_t* XB; float* rowss_next;
    __device__ __forceinline__ void operator()(const f32x4 (&acc)[2][2][4][2], const Unit& u, int wr, int wc, int fr, int fq) const {
        const int row0 = u.pm * BM + wr * 64 + fr, col0 = u.pn * BM + wc * 32 + 8 * fq;
#pragma unroll
        for (int ai = 0; ai < 2; ++ai)
#pragma unroll
            for (int m = 0; m < 4; ++m) { const int row = row0 + ai * HALF + m * 16; float ss = 0.f;
                float* xp = X + (size_t)row * DM + col0; bf16_t* bp = XB + (size_t)row * DM + col0;
#pragma unroll
                for (int bj = 0; bj < 2; ++bj) {
                    f32x4 x0 = *(f32x4*)(xp + bj * HALF), x1 = *(f32x4*)(xp + bj * HALF + 4);
                    x0 = x0 + acc[ai][bj][m][0]; x1 = x1 + acc[ai][bj][m][1];
                    *(f32x4*)(xp + bj * HALF) = x0; *(f32x4*)(xp + bj * HALF + 4) = x1;
                    ss += (x0[0] * x0[0] + x0[1] * x0[1]) + (x0[2] * x0[2] + x0[3] * x0[3]) + (x1[0] * x1[0] + x1[1] * x1[1]) + (x1[2] * x1[2] + x1[3] * x1[3]);
                    u32x4 w; w.x = pk2(x0[0], x0[1]); w.y = pk2(x0[2], x0[3]); w.z = pk2(x1[0], x1[1]); w.w = pk2(x1[2], x1[3]);
                    *(u32x4*)(bp + bj * HALF) = w; }
                ss += __shfl_xor(ss, 16); ss += __shfl_xor(ss, 32);
                if (fq == 0) rowss_next[(size_t)row * 16 + u.pn * 4 + wc] = ss; }
    }
};
}

struct KArgs { const float* in[31]; float* out; unsigned char* ws; };
#define CAS __attribute__((address_space(4)))
struct InProxy { const CAS unsigned long long* k; __device__ __forceinline__ const float* operator[](int i) const { return (const float*)k[i]; } };
struct Params { InProxy in; float* out; unsigned char* ws; };
__device__ __forceinline__ Params make_params() {
    unsigned long long kv = (unsigned long long)__builtin_amdgcn_kernarg_segment_ptr();
    asm volatile("" : "+s"(kv));
    const CAS unsigned long long* k = (const CAS unsigned long long*)kv;
    Params p; p.in.k = k; p.out = (float*)k[31]; p.ws = (unsigned char*)k[32]; return p;
}

struct Frame {
    LAS unsigned char* lds;
    int tid, lane, wave, G, bid;
};

#define REFRAME(F) do { int _t = threadIdx.x; asm volatile("" : "+v"(_t)); (F).tid = _t; (F).lane = _t & 63; (F).wave = __builtin_amdgcn_readfirstlane(_t >> 6); } while (0)
__device__ __forceinline__ void cvt_item(const float* W_, int K, int ldn, int nblk, bf16_t* WT_, const float* gain_, bool perm_gu, LAS float* scr, int item, int lane) {
    const GAS float* W = (const GAS float*)W_; const GAS float* gain = (const GAS float*)gain_; GAS bf16_t* WT = (GAS bf16_t*)WT_;
    const int kb = item / nblk, nb = item % nblk, k0 = 64 * kb, n0d = 32 * nb;
    const int n0s = perm_gu ? (((n0d & 255) >> 7) * DFF + (n0d >> 8) * 128 + (n0d & 127)) : n0d;
    float v[32];
#pragma unroll
    for (int i = 0; i < 32; ++i) v[i] = W[(size_t)(k0 + 2 * i + (lane >> 5)) * ldn + n0s + (lane & 31)];
    if (gain_) {
#pragma unroll
        for (int i = 0; i < 32; ++i) v[i] *= gain[k0 + 2 * i + (lane >> 5)];
    }
#pragma unroll
    for (int i = 0; i < 32; ++i) scr[(2 * i + (lane >> 5)) * 33 + (lane & 31)] = v[i];
    asm volatile("s_waitcnt lgkmcnt(0)" ::: "memory");
    const int c = lane & 7;
#pragma unroll
    for (int j = 0; j < 4; ++j) { const int n = (lane >> 3) + 8 * j; const LAS float* sp = scr + (8 * c) * 33 + n;
        u32x4 o; o.x = pk2(sp[0 * 33], sp[1 * 33]); o.y = pk2(sp[2 * 33], sp[3 * 33]); o.z = pk2(sp[4 * 33], sp[5 * 33]); o.w = pk2(sp[6 * 33], sp[7 * 33]);
        *(GAS u32x4*)(WT + (size_t)(n0d + n) * K + k0 + 8 * c) = o; }
    asm volatile("s_waitcnt lgkmcnt(0)" ::: "memory");
}
constexpr int CV_IN = 1536, CV_OUT = 512, CV_Q = 256, CV_KV = 512, CV_O = 256, CV_GU = 2816, CV_DOWN = 1408, CV_L = 8;
constexpr int CV_TOTAL = CV_IN + CV_OUT + CV_Q + CV_KV + CV_O + CV_GU + CV_DOWN + 2 * CV_L + 2 * CV_L + 16;

static_assert(CV_TOTAL % 8 == 0, "conversion items per layer");
constexpr int CV_A = CV_IN + 2 * CV_L + 2 * CV_L + 16, CV_B = CV_KV + CV_OUT + CV_Q + CV_O + CV_GU + CV_DOWN;
static_assert(CV_A % 8 == 0 && CV_B % 8 == 0 && CV_A + CV_B == CV_TOTAL, "conversion lists");
__device__ __forceinline__ void cvt_item_a(const Params& p, int l, bf16_t* wb, LAS float* scr, int it, int lane) {
    int r = it;
    if (r < CV_IN) { cvt_item(p.in[3] + (size_t)l * DM * INW, DM, INW, INW / 32, wb + WO_IN, p.in[2] + l * DM, false, scr, r, lane); return; } r -= CV_IN;
    if (r < 2 * CV_L) { const int d = r / CV_L; cvt_item(p.in[12] + ((size_t)l * 2 + d) * 64 * 256, 64, 256, 8, wb + WO_WUP + d * 256 * 64, nullptr, false, scr, r % CV_L, lane); return; } r -= 2 * CV_L;
    if (r < 2 * CV_L) { const int d = r / CV_L; cvt_item(p.in[14] + ((size_t)l * 2 + d) * 64 * 256, 64, 256, 8, wb + WO_AUP + d * 256 * 64, nullptr, false, scr, r % CV_L, lane); return; } r -= 2 * CV_L;
    cvt_item(p.in[15] + (size_t)l * 128 * 256, 128, 256, 8, wb + WO_GUP, nullptr, false, scr, r, lane);
}
__device__ __forceinline__ void cvt_item_b(const Params& p, int l, bf16_t* wb, LAS float* scr, int it, int lane) {
    int r = it;
    if (r < CV_KV) { cvt_item(p.in[25] + (size_t)l * DM * 1024, DM, 1024, 32, wb + WO_KV, nullptr, false, scr, r, lane); return; } r -= CV_KV;
    if (r < CV_OUT) { cvt_item(p.in[21] + (size_t)l * DM * DM, DM, DM, DM / 32, wb + WO_OUT, nullptr, false, scr, r, lane); return; } r -= CV_OUT;
    if (r < CV_Q) { cvt_item(p.in[24] + (size_t)l * DM * XW, DM, XW, XW / 32, wb + WO_Q, p.in[22] + l * DM, false, scr, r, lane); return; } r -= CV_Q;
    if (r < CV_O) { cvt_item(p.in[26] + (size_t)l * XW * DM, XW, DM, 32, wb + WO_O, nullptr, false, scr, r, lane); return; } r -= CV_O;
    if (r < CV_GU) { cvt_item(p.in[28] + (size_t)l * DM * 2 * DFF, DM, 2 * DFF, 2 * DFF / 32, wb + WO_GU, p.in[27] + l * DM, true, scr, r, lane); return; } r -= CV_GU;
    cvt_item(p.in[29] + (size_t)l * DFF * DM, DFF, DM, 32, wb + WO_DOWN, nullptr, false, scr, r, lane);
}

__device__ __forceinline__ s16x4 vtr(const LAS unsigned char* p) { return __builtin_bit_cast(s16x4, __builtin_amdgcn_ds_read_tr16_b64_v4i16((LAS v4i16_t*)p)); }
__device__ __forceinline__ int crow(int r, int hi) { return (r & 3) + 8 * (r >> 2) + 4 * hi; }

template <int W> __device__ __forceinline__ void tile_load(u32x4 (&r)[W / 64], const bf16_t* g, int pitch, int tid) {
#pragma unroll
    for (int i = 0; i < W / 64; ++i) { const int id = tid + i * 512, row = id / (W / 8), ch = id % (W / 8); r[i] = *(const GAS u32x4*)((const GAS bf16_t*)g + (size_t)row * pitch + ch * 8); }
}
template <int W, int STR> __device__ __forceinline__ void tile_store(const u32x4 (&r)[W / 64], LAS unsigned char* buf, int tid) {
#pragma unroll
    for (int i = 0; i < W / 64; ++i) { const int id = tid + i * 512, row = id / (W / 8), ch = id % (W / 8); *(LAS u32x4*)(buf + row * STR + ch * 16) = r[i]; }
}
template <int DQK> __device__ __forceinline__ void load_q(bf16x8 (&qf)[DQK / 16], const bf16_t* qrow, int h, float sc) {
#pragma unroll
    for (int ks = 0; ks < DQK / 16; ++ks) { const u32x4 v = *(const GAS u32x4*)((const GAS bf16_t*)qrow + 16 * ks + 8 * h);
        u32x4 o; o.x = pk2(bflo(v.x) * sc, bfhi(v.x) * sc); o.y = pk2(bflo(v.y) * sc, bfhi(v.y) * sc); o.z = pk2(bflo(v.z) * sc, bfhi(v.z) * sc); o.w = pk2(bflo(v.w) * sc, bfhi(v.w) * sc);
        qf[ks] = __builtin_bit_cast(bf16x8, o); }
}
template <int DQK, int KW, int DV, int MODE>
__device__ __forceinline__ void attn_loop(LAS unsigned char* lds, const bf16_t* Kg, int kpitch, const bf16_t* Vg, int vpitch, int ntiles,
                                          const bf16x8 (&qf)[DQK / 16], int koff, float nslope2, int qrel, float& m, float& lsum, f32x16 (&o)[DV / 32]) {
    constexpr int KSTR = (KW + 8) * 2, VSTR = DV * 2 + 64, KBUF = 64 * KSTR, VBUF = 64 * VSTR;
    int tid_ = threadIdx.x; asm volatile("" : "+v"(tid_));
    const int tid = tid_, lane = tid & 63, r = lane & 31, h = lane >> 5;
    LAS unsigned char* K0 = lds; LAS unsigned char* V0 = lds + 2 * KBUF;
    u32x4 kr[KW / 64], vr[DV / 64];
    tile_load<KW>(kr, Kg, kpitch, tid); tile_load<DV>(vr, Vg, vpitch, tid);
    tile_store<KW, KSTR>(kr, K0, tid); tile_store<DV, VSTR>(vr, V0, tid);
    __syncthreads();
    const int vlane = ((lane & 15) >> 2) * VSTR + (16 * ((lane >> 4) & 1) + 4 * (lane & 3)) * 2 + 4 * h * VSTR;
    for (int t = 0; t < ntiles; ++t) {
        const int cur = t & 1;
        if (t + 1 < ntiles) { tile_load<KW>(kr, Kg + (size_t)(t + 1) * 64 * kpitch, kpitch, tid); tile_load<DV>(vr, Vg + (size_t)(t + 1) * 64 * vpitch, vpitch, tid); }
        const LAS unsigned char* Kb = K0 + cur * KBUF + r * KSTR + (koff + 8 * h) * 2;
        const LAS unsigned char* Vb = V0 + cur * VBUF + vlane;
        f32x16 s0, s1;
#pragma unroll
        for (int i = 0; i < 16; ++i) { s0[i] = 0.f; s1[i] = 0.f; }
#pragma unroll
        for (int ks = 0; ks < DQK / 16; ++ks) {
            const bf16x8 k0 = *(const LAS bf16x8*)(Kb + ks * 32), k1 = *(const LAS bf16x8*)(Kb + 32 * KSTR + ks * 32);
            s0 = __builtin_amdgcn_mfma_f32_32x32x16_bf16(k0, qf[ks], s0, 0, 0, 0);
            s1 = __builtin_amdgcn_mfma_f32_32x32x16_bf16(k1, qf[ks], s1, 0, 0, 0);
        }
        float Aoff = 0.f;
        if (MODE >= 1) {
            const int qrel0 = __builtin_amdgcn_readfirstlane(qrel - r);
            const int T0 = t * 64;
            if (MODE == 1 && (T0 + 64 <= qrel0 || T0 > qrel0 + 31)) {
                const bool left = (T0 + 64 <= qrel0);
                const float sl = left ? -nslope2 : nslope2;
                Aoff = left ? nslope2 * (float)(qrel - T0 - 4 * h) : nslope2 * (float)(T0 + 4 * h - qrel);
#pragma unroll
                for (int i = 0; i < 16; ++i) { s0[i] = __builtin_fmaf(sl, (float)((i & 3) + 8 * (i >> 2)), s0[i]); s1[i] = __builtin_fmaf(sl, (float)(32 + (i & 3) + 8 * (i >> 2)), s1[i]); }
            } else {
                const float base = (float)(T0 + 4 * h - qrel);
#pragma unroll
                for (int i = 0; i < 16; ++i) {
                    const float d0 = fabsf(base + (float)((i & 3) + 8 * (i >> 2))), d1 = fabsf(base + (float)(32 + (i & 3) + 8 * (i >> 2)));
                    s0[i] = __builtin_fmaf(d0, nslope2, s0[i]); s1[i] = __builtin_fmaf(d1, nslope2, s1[i]);
                    if (MODE == 2) { if (d0 > 128.f) s0[i] = -1e30f; if (d1 > 128.f) s1[i] = -1e30f; }
                }
            }
        }
        float mx = fmaxf(s0[0], s1[0]);
#pragma unroll
        for (int i = 1; i < 16; ++i) mx = fmaxf(fmaxf(mx, s0[i]), s1[i]);
        mx += Aoff;
        mx = fmaxf(mx, xhalf(mx));
        const float mnew = fmaxf(m, mx);
        if (__builtin_amdgcn_ballot_w64(mnew > m) != 0ull) {
            const float alpha = __builtin_amdgcn_exp2f(m - mnew);
            lsum *= alpha;
#pragma unroll
            for (int d = 0; d < DV / 32; ++d) o[d] = o[d] * alpha;
        }
        m = mnew;
        const float mm = mnew - Aoff;
        float rs = 0.f;
#pragma unroll
        for (int i = 0; i < 16; ++i) { s0[i] = __builtin_amdgcn_exp2f(s0[i] - mm); s1[i] = __builtin_amdgcn_exp2f(s1[i] - mm); rs += s0[i] + s1[i]; }
        lsum += rs;
        bf16x8 pf[4];
#pragma unroll
        for (int s2 = 0; s2 < 2; ++s2) {
            u32x4 a, b;
            a.x = pk2(s0[8 * s2 + 0], s0[8 * s2 + 1]); a.y = pk2(s0[8 * s2 + 2], s0[8 * s2 + 3]); a.z = pk2(s0[8 * s2 + 4], s0[8 * s2 + 5]); a.w = pk2(s0[8 * s2 + 6], s0[8 * s2 + 7]);
            b.x = pk2(s1[8 * s2 + 0], s1[8 * s2 + 1]); b.y = pk2(s1[8 * s2 + 2], s1[8 * s2 + 3]); b.z = pk2(s1[8 * s2 + 4], s1[8 * s2 + 5]); b.w = pk2(s1[8 * s2 + 6], s1[8 * s2 + 7]);
            pf[s2] = __builtin_bit_cast(bf16x8, a); pf[2 + s2] = __builtin_bit_cast(bf16x8, b);
        }
#pragma unroll
        for (int d = 0; d < DV / 32; ++d) {
#pragma unroll
            for (int kk = 0; kk < 4; ++kk) {
                const s16x4 lo = vtr(Vb + (16 * kk) * VSTR + d * 64), hi = vtr(Vb + (16 * kk + 8) * VSTR + d * 64);
                const bf16x8 vf = {lo[0], lo[1], lo[2], lo[3], hi[0], hi[1], hi[2], hi[3]};
                o[d] = __builtin_amdgcn_mfma_f32_32x32x16_bf16(vf, pf[kk], o[d], 0, 0, 0);
            }
        }
        if (t + 1 < ntiles) { tile_store<KW, KSTR>(kr, K0 + (cur ^ 1) * KBUF, tid); tile_store<DV, VSTR>(vr, V0 + (cur ^ 1) * VBUF, tid); }
        __syncthreads();
    }
}
__device__ __forceinline__ int swz(int row) { return ((row & 3) << 2) | ((row >> 2) & 3); }
template <int DQK, int MODE, int pitch, int voff>
__device__ __forceinline__ void attn_loop_dma(LAS unsigned char* lds, const int wave, const bf16_t* Kg, int ntiles,
                                              const bf16x8 (&qf)[DQK / 16], int koff, float nslope2, int qrel, float& m, float& lsum, f32x16 (&o)[4]) {
    constexpr int DV = 128, STAGE = 32768, VOFFB = 16384;
    const int lane = hw_lane(), r = lane & 31, h = lane >> 5;
    unsigned gk[2];
#pragma unroll
    for (int i = 0; i < 2; ++i) { const int row = 4 * (2 * wave + i) + (lane >> 4), c = (lane & 15) ^ swz(row); gk[i] = (unsigned)(row * pitch + c * 8); }
    unsigned kad[DQK / 16], vad[4][2];
#pragma unroll
    for (int ks = 0; ks < DQK / 16; ++ks) kad[ks] = (unsigned)(r * 256 + 16 * (((koff >> 3) + 2 * ks + h) ^ swz(r)));
    { const int q_ = (lane & 15) >> 2, pp = lane & 3, g1 = (lane >> 4) & 1;
#pragma unroll
      for (int d = 0; d < 4; ++d)
#pragma unroll
          for (int hi = 0; hi < 2; ++hi) { const int f = (q_ << 2) | ((2 * hi + h) & 3), c = (4 * d + 2 * g1 + (pp >> 1)) ^ f;
              vad[d][hi] = (unsigned)(VOFFB + (4 * h + q_) * 256 + 16 * c + 8 * (pp & 1) + hi * 2048); } }
#define ATT_DMA(tt, st) do { const bf16_t* kg_ = Kg + (size_t)(tt) * 64 * pitch; _Pragma("unroll") for (int i_ = 0; i_ < 2; ++i_) { \
        __builtin_amdgcn_global_load_lds((const unsigned*)(kg_ + gk[i_]), (LAS unsigned*)(lds + (st) * STAGE + (2 * wave + i_) * 1024), 16, 0, 0); \
        __builtin_amdgcn_global_load_lds((const unsigned*)(kg_ + voff + gk[i_]), (LAS unsigned*)(lds + (st) * STAGE + VOFFB + (2 * wave + i_) * 1024), 16, 0, 0); } } while (0)
    ATT_DMA(0, 0);
    if (ntiles > 1) ATT_DMA(1, 1);
    if (ntiles > 2) { ATT_DMA(2, 2); asm volatile("s_waitcnt vmcnt(4)" ::: "memory"); } else asm volatile("s_waitcnt vmcnt(0)" ::: "memory");
    __builtin_amdgcn_s_barrier();
    f32x16 s0, s1;
#pragma unroll
    for (int i = 0; i < 16; ++i) { s0[i] = 0.f; s1[i] = 0.f; }
#pragma unroll
    for (int ks = 0; ks < DQK / 16; ++ks) {
        const bf16x8 k0 = *(const LAS bf16x8*)(lds + kad[ks]), k1 = *(const LAS bf16x8*)(lds + kad[ks] + 8192);
        s0 = __builtin_amdgcn_mfma_f32_32x32x16_bf16(k0, qf[ks], s0, 0, 0, 0);
        s1 = __builtin_amdgcn_mfma_f32_32x32x16_bf16(k1, qf[ks], s1, 0, 0, 0);
    }
#define LDS_RD128(dst, addr, off) asm volatile("ds_read_b128 %0, %1 offset:%c2" : "=&v"(dst) : "v"(addr), "i"(off) : "memory")
#define LDS_RDTR(dst, addr, off) asm volatile("ds_read_b64_tr_b16 %0, %1 offset:%c2" : "=&v"(dst) : "v"(addr), "i"(off) : "memory")
#define LDS_WAIT0() do { asm volatile("s_waitcnt lgkmcnt(0)" ::: "memory"); __builtin_amdgcn_sched_barrier(0); } while (0)
    for (int t = 0; t < ntiles; ++t) {
        if (t + 3 < ntiles) ATT_DMA(t + 3, (t + 3) & 3);
        const unsigned sba = (unsigned)(size_t)(lds + (t & 3) * STAGE), sna = (unsigned)(size_t)(lds + ((t + 1) & 3) * STAGE);
        constexpr int KH = (DQK == 64) ? 4 : 4;
        bf16x8 kf0[KH], kf1[KH];
        s16x4 va_lo[4], va_hi[4], vb_lo[4], vb_hi[4];
        if (DQK == 64) {
#pragma unroll
            for (int ks = 0; ks < KH; ++ks) { const unsigned ka = sna + kad[ks]; LDS_RD128(kf0[ks], ka, 0); } }
        __builtin_amdgcn_sched_barrier(0);
        float Aoff = 0.f;
        if (MODE >= 1) {
            const int qrel0 = __builtin_amdgcn_readfirstlane(qrel - r);
            const int T0 = t * 64;
            if (MODE == 1 && (T0 + 64 <= qrel0 || T0 > qrel0 + 31)) {
                const bool left = (T0 + 64 <= qrel0);
                const float sl = left ? -nslope2 : nslope2;
                Aoff = left ? nslope2 * (float)(qrel - T0 - 4 * h) : nslope2 * (float)(T0 + 4 * h - qrel);
#pragma unroll
                for (int i = 0; i < 16; ++i) { s0[i] = __builtin_fmaf(sl, (float)((i & 3) + 8 * (i >> 2)), s0[i]); s1[i] = __builtin_fmaf(sl, (float)(32 + (i & 3) + 8 * (i >> 2)), s1[i]); }
            } else {
                const float base = (float)(T0 + 4 * h - qrel);
#pragma unroll
                for (int i = 0; i < 16; ++i) {
                    const float d0 = fabsf(base + (float)((i & 3) + 8 * (i >> 2))), d1 = fabsf(base + (float)(32 + (i & 3) + 8 * (i >> 2)));
                    s0[i] = __builtin_fmaf(d0, nslope2, s0[i]); s1[i] = __builtin_fmaf(d1, nslope2, s1[i]);
                    if (MODE == 2) { if (d0 > 128.f) s0[i] = -1e30f; if (d1 > 128.f) s1[i] = -1e30f; }
                }
            }
        }
        float mx = fmaxf(s0[0], s1[0]);
#pragma unroll
        for (int i = 1; i < 16; ++i) mx = fmaxf(fmaxf(mx, s0[i]), s1[i]);
        mx += Aoff;
        mx = fmaxf(mx, xhalf(mx));
        const float mnew = fmaxf(m, mx);
        if (__builtin_amdgcn_ballot_w64(mnew > m) != 0ull) {
            const float alpha = __builtin_amdgcn_exp2f(m - mnew);
            lsum *= alpha;
#pragma unroll
            for (int d = 0; d < DV / 32; ++d) o[d] = o[d] * alpha;
        }
        m = mnew;
        const float mm = mnew - Aoff;
        float rs = 0.f;
#pragma unroll
        for (int i = 0; i < 16; ++i) { s0[i] = __builtin_amdgcn_exp2f(s0[i] - mm); s1[i] = __builtin_amdgcn_exp2f(s1[i] - mm); rs += s0[i] + s1[i]; }
        lsum += rs;
        bf16x8 pf[4];
#pragma unroll
        for (int s2 = 0; s2 < 2; ++s2) {
            u32x4 a, b;
            a.x = pk2(s0[8 * s2 + 0], s0[8 * s2 + 1]); a.y = pk2(s0[8 * s2 + 2], s0[8 * s2 + 3]); a.z = pk2(s0[8 * s2 + 4], s0[8 * s2 + 5]); a.w = pk2(s0[8 * s2 + 6], s0[8 * s2 + 7]);
            b.x = pk2(s1[8 * s2 + 0], s1[8 * s2 + 1]); b.y = pk2(s1[8 * s2 + 2], s1[8 * s2 + 3]); b.z = pk2(s1[8 * s2 + 4], s1[8 * s2 + 5]); b.w = pk2(s1[8 * s2 + 6], s1[8 * s2 + 7]);
            pf[s2] = __builtin_bit_cast(bf16x8, a); pf[2 + s2] = __builtin_bit_cast(bf16x8, b);
        }
        LDS_WAIT0();
        if (DQK == 64) {
#pragma unroll
            for (int ks = 0; ks < KH; ++ks) { const unsigned ka = sna + kad[ks]; LDS_RD128(kf1[ks], ka, 8192); } }
        { const unsigned alo = sba + vad[0][0], ahi = sba + vad[0][1];
#pragma unroll
          for (int kk = 0; kk < 4; ++kk) { LDS_RDTR(va_lo[kk], alo, kk * 4096); LDS_RDTR(va_hi[kk], ahi, kk * 4096); } }
        __builtin_amdgcn_sched_barrier(0);
        f32x16 n0, n1;
#pragma unroll
        for (int i = 0; i < 16; ++i) { n0[i] = 0.f; n1[i] = 0.f; }
#pragma unroll
        for (int g = 0; g < DQK / 64; ++g) {
            if (DQK != 64) {
#pragma unroll
                for (int ks = 0; ks < KH; ++ks) { const unsigned ka = sna + kad[g * KH + ks]; LDS_RD128(kf0[ks], ka, 0); LDS_RD128(kf1[ks], ka, 8192); }
                LDS_WAIT0(); }
#pragma unroll
            for (int ks = 0; ks < KH; ++ks) n0 = __builtin_amdgcn_mfma_f32_32x32x16_bf16(kf0[ks], qf[g * KH + ks], n0, 0, 0, 0);
            if (DQK == 64) LDS_WAIT0();
#pragma unroll
            for (int ks = 0; ks < KH; ++ks) n1 = __builtin_amdgcn_mfma_f32_32x32x16_bf16(kf1[ks], qf[g * KH + ks], n1, 0, 0, 0);
        }
#define PV_BLOCK(d, lo, hi) do { _Pragma("unroll") for (int kk = 0; kk < 4; ++kk) { const bf16x8 vf = {lo[kk][0], lo[kk][1], lo[kk][2], lo[kk][3], hi[kk][0], hi[kk][1], hi[kk][2], hi[kk][3]}; \
            o[d] = __builtin_amdgcn_mfma_f32_32x32x16_bf16(vf, pf[kk], o[d], 0, 0, 0); } } while (0)
#define V_ISSUE(d, lo, hi) do { const unsigned alo_ = sba + vad[d][0], ahi_ = sba + vad[d][1]; _Pragma("unroll") for (int kk = 0; kk < 4; ++kk) { LDS_RDTR(lo[kk], alo_, kk * 4096); LDS_RDTR(hi[kk], ahi_, kk * 4096); } } while (0)
        LDS_WAIT0();
        V_ISSUE(1, vb_lo, vb_hi); __builtin_amdgcn_sched_barrier(0);
        PV_BLOCK(0, va_lo, va_hi);
        LDS_WAIT0();
        V_ISSUE(2, va_lo, va_hi); __builtin_amdgcn_sched_barrier(0);
        PV_BLOCK(1, vb_lo, vb_hi);
        LDS_WAIT0();
        V_ISSUE(3, vb_lo, vb_hi); __builtin_amdgcn_sched_barrier(0);
        PV_BLOCK(2, va_lo, va_hi);
        LDS_WAIT0();
        PV_BLOCK(3, vb_lo, vb_hi);
#undef PV_BLOCK
#undef V_ISSUE
        s0 = n0; s1 = n1;
        if (t + 3 < ntiles) asm volatile("s_waitcnt vmcnt(4)" ::: "memory"); else asm volatile("s_waitcnt vmcnt(0)" ::: "memory");
        __builtin_amdgcn_s_barrier();
    }
#undef LDS_RD128
#undef LDS_RDTR
#undef LDS_WAIT0
#undef ATT_DMA
}
template <int DV> __device__ __forceinline__ void store_o(const f32x16 (&o)[DV / 32], float sc, bf16_t* orow, int h) {
#pragma unroll
    for (int d = 0; d < DV / 32; ++d)
#pragma unroll
        for (int g4 = 0; g4 < 4; ++g4) { u32x2 w; w.x = pk2(o[d][4 * g4] * sc, o[d][4 * g4 + 1] * sc); w.y = pk2(o[d][4 * g4 + 2] * sc, o[d][4 * g4 + 3] * sc);
            *(GAS u32x2*)((GAS bf16_t*)orow + 32 * d + 8 * g4 + 4 * h) = w; }
}

__device__ __forceinline__ void win_unit(Frame& F, const Params& p, int l, int u) {
    REFRAME(F);
    const bf16_t* Z = (const bf16_t*)(p.ws + WS_Z); bf16_t* MIX = (bf16_t*)(p.ws + WS_MIX);
    const int b = u >> 5, kvh = (u >> 4) & 1, nb = u & 15, r = F.lane & 31, h = F.lane >> 5;
    const int g = F.wave >> 2, hq = kvh * 2 + g, qpos = nb * 128 + (F.wave & 3) * 32 + r;
    const size_t tok = (size_t)b * SEQ + qpos;
    bf16x8 qf[4]; load_q<64>(qf, Z + tok * ZP + hq * 64, h, 0.125f * LOG2E);
    const int first = (2 * nb - 2 < 0) ? 0 : 2 * nb - 2, lastx = (2 * nb + 4 > 32) ? 32 : 2 * nb + 4, nt = lastx - first;
    const float slope = exp2f(-(float)(2 * hq + 1));
    float m = p.in[4][l * 4 + hq] * LOG2E, ls = (h == 0) ? 1.f : 0.f;
    f32x16 o[2];
#pragma unroll
    for (int d = 0; d < 2; ++d)
#pragma unroll
        for (int i = 0; i < 16; ++i) o[d][i] = 0.f;
    const bf16_t* Kg = Z + ((size_t)b * SEQ + first * 64) * ZP + 256 + kvh * 64;
    attn_loop<64, 64, 64, 2>(F.lds, Kg, ZP, Kg + 128, ZP, nt, qf, 0, -slope * LOG2E, qpos - first * 64, m, ls, o);
    const float lt = ls + xhalf(ls);
    store_o<64>(o, 1.f / lt, MIX + tok * DM + hq * 64, h);
}
__device__ __forceinline__ void diff_unit(Frame& F, const Params& p, int l, int u) {
    REFRAME(F);
    const bf16_t* Z = (const bf16_t*)(p.ws + WS_Z); bf16_t* MIX = (bf16_t*)(p.ws + WS_MIX);
    const int b = u >> 6, hh = (u >> 4) & 3, qb = u & 15, r = F.lane & 31, h = F.lane >> 5;
    const int c = F.wave >> 2, qpos = qb * 128 + (F.wave & 3) * 32 + r;
    const size_t tok = (size_t)b * SEQ + qpos;
    float lam, lam_init;
    {
        const float a1 = wave_sum(p.in[5][l * 64 + F.lane] * p.in[6][l * 64 + F.lane]), a2 = wave_sum(p.in[7][l * 64 + F.lane] * p.in[8][l * 64 + F.lane]);
        lam_init = 0.8f - 0.6f * expf(-0.3f * (float)l);
        lam = expf(a1) - expf(a2) + lam_init;
    }
    bf16x8 qf[4]; load_q<64>(qf, Z + tok * ZP + 512 + hh * 128 + c * 64, h, 0.125f * LOG2E);
    const float slope = exp2f(-(float)(2 * hh + 2));
    float m = -1e30f, ls = 0.f;
    f32x16 o[4];
#pragma unroll
    for (int d = 0; d < 4; ++d)
#pragma unroll
        for (int i = 0; i < 16; ++i) o[d][i] = 0.f;
    const bf16_t* Kg = (const bf16_t*)(p.ws + WS_KD2) + (size_t)(b * 4 + hh) * 2048 * 128;
    attn_loop_dma<64, 1, 128, 8388608>(F.lds, F.wave, Kg, 32, qf, c * 64, -slope * LOG2E, qpos, m, ls, o);
    const float inv = 1.f / (ls + xhalf(ls));
    LAS float* comb = (LAS float*)F.lds + (size_t)(F.wave & 3) * 64 * 64 + F.lane;
    if (c == 1) {
#pragma unroll
        for (int d = 0; d < 4; ++d)
#pragma unroll
            for (int i = 0; i < 16; ++i) comb[(d * 16 + i) * 64] = o[d][i] * inv;
    }
    __syncthreads();
    if (c == 0) {
        float ss = 0.f;
#pragma unroll
        for (int d = 0; d < 4; ++d)
#pragma unroll
            for (int i = 0; i < 16; ++i) { const float a = o[d][i] * inv - lam * comb[(d * 16 + i) * 64]; o[d][i] = a; ss += a * a; }
        ss += xhalf(ss);
        const float rn = rsqrtf(ss * (1.f / 128.f) + 1e-6f) * (1.f - lam_init);
        const float* sg = p.in[9] + l * 128;
        bf16_t* orow = MIX + tok * DM + 256 + hh * 128;
        f32x4 ggv[4][4];
#pragma unroll
        for (int d = 0; d < 4; ++d)
#pragma unroll
            for (int g4 = 0; g4 < 4; ++g4) ggv[d][g4] = *(const GAS f32x4*)((const GAS float*)sg + 32 * d + 8 * g4 + 4 * h);
#pragma unroll
        for (int d = 0; d < 4; ++d)
#pragma unroll
            for (int g4 = 0; g4 < 4; ++g4) { const int dv = 32 * d + 8 * g4 + 4 * h; const f32x4 gg = ggv[d][g4];
                u32x2 w; w.x = pk2(o[d][4 * g4] * rn * gg[0], o[d][4 * g4 + 1] * rn * gg[1]); w.y = pk2(o[d][4 * g4 + 2] * rn * gg[2], o[d][4 * g4 + 3] * rn * gg[3]);
                *(GAS u32x2*)((GAS bf16_t*)orow + dv) = w; }
    }
    __syncthreads();
}
__device__ __forceinline__ void cross_unit(Frame& F, const Params& p, int u) {
    REFRAME(F);
    const bf16_t* Q = (const bf16_t*)(p.ws + WS_Q); const bf16_t* KV = (const bf16_t*)(p.ws + WS_KV); bf16_t* O = (bf16_t*)(p.ws + WS_O);
    const int b = u >> 5, hd = (u >> 3) & 3, qb = u & 7, r = F.lane & 31, h = F.lane >> 5;
    const size_t tok = (size_t)b * SEQ + qb * 256 + F.wave * 32 + r;
    bf16x8 qf[8]; load_q<128>(qf, Q + tok * XW + hd * 128, h, 0.08838834764831845f * LOG2E);
    float m = -1e30f, ls = 0.f;
    f32x16 o[4];
#pragma unroll
    for (int d = 0; d < 4; ++d)
#pragma unroll
        for (int i = 0; i < 16; ++i) o[d][i] = 0.f;
    const bf16_t* Kg = KV + ((size_t)b * NMEM) * 1024 + hd * 128;
    attn_loop_dma<128, 0, 1024, 512>(F.lds, F.wave, Kg, 4, qf, 0, 0.f, 0, m, ls, o);
    const float lt = ls + xhalf(ls);
    store_o<128>(o, 1.f / lt, O + tok * XW + hd * 128, h);
}

constexpr int CF_STR = 772, PREP_AW = 32 * CF_STR * 4, PREP_AA = PREP_AW + 32 * 72 * 2, PREP_AG = PREP_AA + 32 * 72 * 2;
__device__ __forceinline__ void prep_unit(Frame& F, const Params& p, int l, const bf16_t* wb, int u) {
    REFRAME(F);
    const bf16_t* ZC = (const bf16_t*)(p.ws + WS_ZC);
    const int t0 = u * 32, b = t0 / SEQ;
    LAS float* CF = (LAS float*)F.lds; LAS bf16_t* AW = (LAS bf16_t*)(F.lds + PREP_AW); LAS bf16_t* AA = (LAS bf16_t*)(F.lds + PREP_AA); LAS bf16_t* AG = (LAS bf16_t*)(F.lds + PREP_AG);
    const float* conv = p.in[10] + (size_t)l * 3 * 1024;
    LAS float* PAR = (LAS float*)(F.lds + PREP_AG + 32 * 136 * 2);
    if (F.tid < 448) { const int i = F.tid; const GAS f32x4* src;
        if (i < 64) src = (const GAS f32x4*)((const GAS float*)p.in[16] + l * 256) + i;
        else if (i < 128) src = (const GAS f32x4*)((const GAS float*)p.in[17] + l * 256) + (i - 64);
        else if (i < 192) src = (const GAS f32x4*)((const GAS float*)p.in[18] + l * 256) + (i - 128);
        else if (i < 320) src = (const GAS f32x4*)((const GAS float*)p.in[11] + l * 512) + (i - 192);
        else src = (const GAS f32x4*)((const GAS float*)p.in[13] + l * 512) + (i - 320);
        ((LAS f32x4*)PAR)[i] = *src; }
#pragma unroll 4
    for (int i = 0; i < 8; ++i) {
        const int id = F.tid + i * 512, tk = id >> 7, ch = id & 127, tg = t0 + tk, tpos = tg - b * SEQ;
        const GAS bf16_t* zp = (const GAS bf16_t*)ZC + (size_t)tg * 1024 + ch * 8;
        const u32x4 zc = *(const GAS u32x4*)zp;
        u32x4 zl = {0u, 0u, 0u, 0u}, zr = {0u, 0u, 0u, 0u};
        if (tpos > 0) zl = *(const GAS u32x4*)(zp - 1024);
        if (tpos < SEQ - 1) zr = *(const GAS u32x4*)(zp + 1024);
        float v[8];
#pragma unroll
        for (int q = 0; q < 4; ++q) {
            const f32x2 c0 = *(const GAS f32x2*)((const GAS float*)conv + ch * 8 + 2 * q), c1 = *(const GAS f32x2*)((const GAS float*)conv + 1024 + ch * 8 + 2 * q), c2 = *(const GAS f32x2*)((const GAS float*)conv + 2048 + ch * 8 + 2 * q);
            v[2 * q] = bflo(zl[q]) * c0[0] + bflo(zc[q]) * c1[0] + bflo(zr[q]) * c2[0];
            v[2 * q + 1] = bfhi(zl[q]) * c0[1] + bfhi(zc[q]) * c1[1] + bfhi(zr[q]) * c2[1];
        }
        if (ch < 96) { *(LAS f32x4*)(CF + tk * CF_STR + ch * 8) = (f32x4){v[0], v[1], v[2], v[3]}; *(LAS f32x4*)(CF + tk * CF_STR + ch * 8 + 4) = (f32x4){v[4], v[5], v[6], v[7]}; }
        else {
            u32x4 w;
            if (ch < 104) {
#pragma unroll
                for (int q = 0; q < 8; ++q) v[q] = 1.f - 2.f * __builtin_amdgcn_rcpf(__expf(2.f * v[q]) + 1.f);
                w.x = pk2(v[0], v[1]); w.y = pk2(v[2], v[3]); w.z = pk2(v[4], v[5]); w.w = pk2(v[6], v[7]);
                *(LAS u32x4*)(AW + tk * 72 + (ch - 96) * 8) = w;
            } else if (ch < 112) {
                w.x = pk2(v[0], v[1]); w.y = pk2(v[2], v[3]); w.z = pk2(v[4], v[5]); w.w = pk2(v[6], v[7]);
                *(LAS u32x4*)(AA + tk * 72 + (ch - 104) * 8) = w;
            } else {
#pragma unroll
                for (int q = 0; q < 8; ++q) v[q] = sigmoidf_(v[q]);
                w.x = pk2(v[0], v[1]); w.y = pk2(v[2], v[3]); w.z = pk2(v[4], v[5]); w.w = pk2(v[6], v[7]);
                *(LAS u32x4*)(AG + tk * 136 + (ch - 112) * 8) = w;
            }
        }
    }
    __syncthreads();
    const int hh = F.wave & 3, dir = F.wave >> 2, tk = F.lane & 31, h2 = F.lane >> 5;
    const size_t tok = (size_t)t0 + tk;
    const GAS bf16_t* Wup = (const GAS bf16_t*)wb + WO_WUP + (size_t)(dir * 256 + hh * 64) * 64;
    const GAS bf16_t* Aup = (const GAS bf16_t*)wb + WO_AUP + (size_t)(dir * 256 + hh * 64) * 64;
    f32x16 aw[2], aa[2];
#pragma unroll
    for (int rb = 0; rb < 2; ++rb)
#pragma unroll
        for (int i = 0; i < 16; ++i) { aw[rb][i] = 0.f; aa[rb][i] = 0.f; }
#pragma unroll
    for (int ks = 0; ks < 4; ++ks) {
        const bf16x8 bw = *(const LAS bf16x8*)(AW + tk * 72 + 16 * ks + 8 * h2), ba = *(const LAS bf16x8*)(AA + tk * 72 + 16 * ks + 8 * h2);
#pragma unroll
        for (int rb = 0; rb < 2; ++rb) {
            const bf16x8 fw = *(const GAS bf16x8*)(Wup + (size_t)(rb * 32 + tk) * 64 + 16 * ks + 8 * h2), fa = *(const GAS bf16x8*)(Aup + (size_t)(rb * 32 + tk) * 64 + 16 * ks + 8 * h2);
            aw[rb] = __builtin_amdgcn_mfma_f32_32x32x16_bf16(fw, bw, aw[rb], 0, 0, 0);
            aa[rb] = __builtin_amdgcn_mfma_f32_32x32x16_bf16(fa, ba, aa[rb], 0, 0, 0);
        }
    }
    const LAS float* k_k = PAR + hh * 64; const LAS float* k_a = PAR + 256 + hh * 64; const LAS float* r_k = PAR + 512 + hh * 64;
    const LAS float* w0 = PAR + 768 + dir * 256 + hh * 64; const LAS float* a0 = PAR + 1280 + dir * 256 + hh * 64;
    float ssq = 0.f;
#pragma unroll
    for (int rb = 0; rb < 2; ++rb)
#pragma unroll
        for (int g4 = 0; g4 < 4; ++g4) { const int c0 = rb * 32 + 8 * g4 + 4 * h2;
            const f32x4 kv = *(const LAS f32x4*)(CF + tk * CF_STR + 256 + hh * 64 + c0), kkw = *(const LAS f32x4*)(k_k + c0);
            const f32x4 q = kv * kkw; ssq += (q[0] * q[0] + q[1] * q[1]) + (q[2] * q[2] + q[3] * q[3]); }
    ssq += xhalf(ssq);
    const float kinv = 1.f / fmaxf(sqrtf(ssq), 1e-12f);
    float bon = 0.f;
    GAS bf16_t* OM = (GAS bf16_t*)(p.ws + WS_OM) + ((size_t)dir * MTOK + tok) * 256 + hh * 64;
    GAS bf16_t* KA = (GAS bf16_t*)(p.ws + WS_KA) + ((size_t)dir * MTOK + tok) * 256 + hh * 64;
    GAS bf16_t* KD = (GAS bf16_t*)(p.ws + WS_KD) + ((size_t)dir * MTOK + tok) * 256 + hh * 64;
    GAS bf16_t* KK = (GAS bf16_t*)(p.ws + WS_KK) + tok * 256 + hh * 64;
    GAS bf16_t* VV = (GAS bf16_t*)(p.ws + WS_V) + tok * 256 + hh * 64;
    GAS bf16_t* RR = (GAS bf16_t*)(p.ws + WS_R) + tok * 256 + hh * 64;
#pragma unroll
    for (int rb = 0; rb < 2; ++rb)
#pragma unroll
        for (int g4 = 0; g4 < 4; ++g4) { const int c0 = rb * 32 + 8 * g4 + 4 * h2;
            const f32x4 kv = *(const LAS f32x4*)(CF + tk * CF_STR + 256 + hh * 64 + c0), rv = *(const LAS f32x4*)(CF + tk * CF_STR + hh * 64 + c0);
            const f32x4 kkw = *(const LAS f32x4*)(k_k + c0), kaw = *(const LAS f32x4*)(k_a + c0), rkw = *(const LAS f32x4*)(r_k + c0), w0v = *(const LAS f32x4*)(w0 + c0), a0v = *(const LAS f32x4*)(a0 + c0);
            float om[4], ka[4], kd[4], kk[4];
#pragma unroll
            for (int j = 0; j < 4; ++j) {
                const float wp = aw[rb][4 * g4 + j] + w0v[j], ap = aa[rb][4 * g4 + j] + a0v[j];
                om[j] = 1.f - __expf(-0.6065306597126334f * sigmoidf_(wp));
                const float a = sigmoidf_(ap);
                kk[j] = kv[j] * kkw[j] * kinv; ka[j] = kk[j] * a; kd[j] = kv[j] * (1.f + (a - 1.f) * kaw[j]);
                bon += rv[j] * kd[j] * rkw[j];
            }
            u32x2 w; w.x = pk2(om[0], om[1]); w.y = pk2(om[2], om[3]); *(GAS u32x2*)(OM + c0) = w;
            w.x = pk2(ka[0], ka[1]); w.y = pk2(ka[2], ka[3]); *(GAS u32x2*)(KA + c0) = w;
            w.x = pk2(kd[0], kd[1]); w.y = pk2(kd[2], kd[3]); *(GAS u32x2*)(KD + c0) = w;
            if (dir == 0) {
                const f32x4 vv = *(const LAS f32x4*)(CF + tk * CF_STR + 512 + hh * 64 + c0);
                w.x = pk2(kk[0], kk[1]); w.y = pk2(kk[2], kk[3]); *(GAS u32x2*)(KK + c0) = w;
                w.x = pk2(vv[0], vv[1]); w.y = pk2(vv[2], vv[3]); *(GAS u32x2*)(VV + c0) = w;
                w.x = pk2(rv[0], rv[1]); w.y = pk2(rv[2], rv[3]); *(GAS u32x2*)(RR + c0) = w;
            }
        }
    bon += xhalf(bon);
    if (h2 == 0) ((GAS float*)(p.ws + WS_BON))[((size_t)dir * MTOK + tok) * 4 + hh] = bon;
    {
        const GAS bf16_t* Gup = (const GAS bf16_t*)wb + WO_GUP + (size_t)(F.wave * 32 + tk) * 128;
        f32x16 ag;
#pragma unroll
        for (int i = 0; i < 16; ++i) ag[i] = 0.f;
#pragma unroll
        for (int ks = 0; ks < 8; ++ks) {
            const bf16x8 bg = *(const LAS bf16x8*)(AG + tk * 136 + 16 * ks + 8 * h2), fg = *(const GAS bf16x8*)(Gup + 16 * ks + 8 * h2);
            ag = __builtin_amdgcn_mfma_f32_32x32x16_bf16(fg, bg, ag, 0, 0, 0);
        }
        GAS bf16_t* GT = (GAS bf16_t*)(p.ws + WS_GATE) + tok * 256 + F.wave * 32;
#pragma unroll
        for (int g4 = 0; g4 < 4; ++g4) { u32x2 w; w.x = pk2(ag[4 * g4], ag[4 * g4 + 1]); w.y = pk2(ag[4 * g4 + 2], ag[4 * g4 + 3]); *(GAS u32x2*)(GT + 8 * g4 + 4 * h2) = w; }
    }
    __syncthreads();
}

#define CBAR() asm volatile("" ::: "memory")
#define LROW(M, i, r) do { const LAS f32x4* _q = (const LAS f32x4*)((M) + (i) * 16); const f32x4 _a = _q[0], _b = _q[1], _c = _q[2], _d = _q[3]; \
        r[0] = _a[0]; r[1] = _a[1]; r[2] = _a[2]; r[3] = _a[3]; r[4] = _b[0]; r[5] = _b[1]; r[6] = _b[2]; r[7] = _b[3]; \
        r[8] = _c[0]; r[9] = _c[1]; r[10] = _c[2]; r[11] = _c[3]; r[12] = _d[0]; r[13] = _d[1]; r[14] = _d[2]; r[15] = _d[3]; } while (0)
template <int DIR> __device__ __forceinline__ void chunkprep_wave(Frame& F, const Params& p, int task) {
    const int dbh = task >> 7, ct = task & 127, b = (dbh >> 2) & 7, hh = dbh & 3, ch = F.lane, r32 = F.lane & 31, h = F.lane >> 5;
    LAS unsigned char* wl = F.lds + F.wave * 16384;
    LAS bf16_t* X = (LAS bf16_t*)wl;
    LAS bf16_t* Yt = (LAS bf16_t*)(wl + 4608);
    LAS float* MTt = (LAS float*)(wl + 9216);
    LAS float* MBt = MTt + 256;
    LAS float* MC = MTt + 512; LAS float* MD = MTt + 768; LAS float* MT = MTt + 1024; LAS float* MA = MTt + 1280;
    constexpr int step = DIR ? -256 : 256;
    typedef const __attribute__((address_space(1))) bf16_t* gbf;
    const size_t ou = ((size_t)b * SEQ + ct * 16 + (DIR ? 15 : 0)) * 256 + hh * 64;
    const gbf OM = (gbf)(p.ws + WS_OM) + (size_t)DIR * MTOK * 256 + ou + ch; const gbf KA = (gbf)(p.ws + WS_KA) + (size_t)DIR * MTOK * 256 + ou + ch;
    const gbf KD = (gbf)(p.ws + WS_KD) + (size_t)DIR * MTOK * 256 + ou + ch; const gbf KK = (gbf)(p.ws + WS_KK) + ou + ch;
    const gbf RR = (gbf)(p.ws + WS_R) + ou + ch; const gbf VV = (gbf)(p.ws + WS_V) + ou + ch;
    float pc = 1.f;
    float qt[16], rt[16], at[16], kt[16], vv[16];
    {
        unsigned short rw[16], rk[16], ra_[16], rd[16], rr_[16], rv[16];
#pragma unroll
        for (int i = 0; i < 16; ++i) { rw[i] = OM[i * step]; rk[i] = KK[i * step]; ra_[i] = KA[i * step]; rd[i] = KD[i * step]; rr_[i] = RR[i * step]; rv[i] = VV[i * step]; }
#pragma unroll
        for (int i = 0; i < 16; ++i) {
            const float w = 1.f - bf2f(rw[i]);
            qt[i] = bf2f(rk[i]) * pc; pc *= w; const float ip = __builtin_amdgcn_rcpf(pc);
            rt[i] = bf2f(rr_[i]) * pc; at[i] = bf2f(ra_[i]) * ip; kt[i] = bf2f(rd[i]) * ip; vv[i] = bf2f(rv[i]);
            X[i * 72 + ch] = (bf16_t)(pk2(qt[i], 0.f) & 0xffffu); X[(16 + i) * 72 + ch] = (bf16_t)(pk2(rt[i], 0.f) & 0xffffu);
            Yt[i * 72 + ch] = (bf16_t)(pk2(at[i], 0.f) & 0xffffu); Yt[(16 + i) * 72 + ch] = (bf16_t)(pk2(kt[i], 0.f) & 0xffffu);
        }
    }
    const float p15 = pc;
    asm volatile("s_waitcnt lgkmcnt(0)" ::: "memory");
    {
        f32x16 g;
#pragma unroll
        for (int i = 0; i < 16; ++i) g[i] = 0.f;
#pragma unroll
        for (int ks = 0; ks < 4; ++ks) {
            const bf16x8 a = *(const LAS bf16x8*)(X + r32 * 72 + 16 * ks + 8 * h), bb = *(const LAS bf16x8*)(Yt + r32 * 72 + 16 * ks + 8 * h);
            g = __builtin_amdgcn_mfma_f32_32x32x16_bf16(a, bb, g, 0, 0, 0);
        }
        const int sidx = r32 & 15;
#pragma unroll
        for (int reg = 0; reg < 8; ++reg) { const int i = (reg & 3) + 8 * (reg >> 2) + 4 * h;
            const float lo = (sidx < i) ? g[reg] : 0.f, hi2 = (sidx <= i) ? g[8 + reg] : 0.f;
            if (r32 < 16) { MA[i * 16 + sidx] = lo; MD[i * 16 + sidx] = hi2; } else { MBt[sidx * 16 + i] = lo; MC[i * 16 + sidx] = hi2; } }
    }
    asm volatile("s_waitcnt lgkmcnt(0)" ::: "memory");
    {
        const int c = F.lane & 15; float Tc[16];
#pragma unroll
        for (int i = 0; i < 16; ++i) { float acc = (i == c) ? 1.f : 0.f; float ra[16]; LROW(MA, i, ra);
#pragma unroll
            for (int s2 = 0; s2 < i; ++s2) acc -= ra[s2] * Tc[s2];
            Tc[i] = acc; MT[i * 16 + c] = acc; MTt[c * 16 + i] = acc; CBAR(); }
    }
    asm volatile("s_waitcnt lgkmcnt(0)" ::: "memory");
    float Qh[16], W2[16];
    {
        float BV[16];
#pragma unroll
        for (int i = 0; i < 16; ++i) { Qh[i] = 0.f; BV[i] = 0.f; }
#pragma unroll
        for (int s2 = 0; s2 < 16; ++s2) {
            float ct_[16], cb_[16]; LROW(MTt, s2, ct_); LROW(MBt, s2, cb_);
#pragma unroll
            for (int i = s2; i < 16; ++i) { Qh[i] += ct_[i] * qt[s2]; if (i > s2) BV[i] += cb_[i] * vv[s2]; }
            CBAR();
        }
#pragma unroll
        for (int i = 0; i < 16; ++i) { float aw = 0.f; float rt_[16]; LROW(MT, i, rt_);
#pragma unroll
            for (int s2 = 0; s2 <= i; ++s2) aw += rt_[s2] * BV[s2];
            W2[i] = aw; CBAR(); }
    }
    GAS bf16_t* FQR = (GAS bf16_t*)(p.ws + WS_FQR) + (size_t)task * 2048;
    GAS bf16_t* FWY = (GAS bf16_t*)(p.ws + WS_FWY) + (size_t)task * 2048;
    {
        const int ks = ch >> 4, w16 = ch & 15, jq = (w16 >> 3) * 4 + (w16 & 3), hq = (w16 >> 2) & 1;
        GAS bf16_t* qrp = FQR + (size_t)(ks * 64 + hq * 32) * 8 + jq;
        GAS bf16_t* wyp = FWY + (size_t)(((ch >> 5) * 64 + r32) * 16);
#pragma unroll
        for (int i = 0; i < 16; ++i) {
            float ar = rt[i], ay = 0.f; float rd_[16], rc_[16]; LROW(MD, i, rd_); LROW(MC, i, rc_);
#pragma unroll
            for (int s2 = 0; s2 <= i; ++s2) { ar -= rd_[s2] * Qh[s2]; ay += rc_[s2] * vv[s2] - rd_[s2] * W2[s2]; }
            qrp[i * 8] = (bf16_t)(pk2(Qh[i], 0.f) & 0xffffu); qrp[(16 + i) * 8] = (bf16_t)(pk2(ar, 0.f) & 0xffffu);
            wyp[512 * ((i >> 2) & 1) + (i & 3) + 4 * (i >> 3)] = (bf16_t)(pk2(W2[i], 0.f) & 0xffffu);
            wyp[512 * ((i >> 2) & 1) + (i & 3) + 4 * ((16 + i) >> 3)] = (bf16_t)(pk2(ay, 0.f) & 0xffffu);
            CBAR(); }
    }
    {
        GAS bf16_t* nap = (GAS bf16_t*)(p.ws + WS_FNA) + (size_t)task * 1024 + (size_t)(((ch >> 5) * 64 + r32) * 8);
        GAS bf16_t* khp = (GAS bf16_t*)(p.ws + WS_FKH) + (size_t)task * 1024 + (size_t)(((ch >> 5) * 64 + r32) * 8);
#pragma unroll
        for (int s2 = 0; s2 < 16; ++s2) {
            const int off = 256 * ((s2 >> 2) & 1) + (s2 >> 3) * 4 + (s2 & 3);
            nap[off] = (bf16_t)(pk2(-at[s2] * p15, 0.f) & 0xffffu); khp[off] = (bf16_t)(pk2(kt[s2] * p15, 0.f) & 0xffffu); }
        ((GAS float*)(p.ws + WS_FP15))[(size_t)task * 64 + ch] = p15;
    }
    asm volatile("s_waitcnt lgkmcnt(0)" ::: "memory");
}
constexpr int PB_SLOT = 15360, PB_NSLOT = 4, PB_QR = 0, PB_WY = 4096, PB_NA = 8192, PB_KH = 10240, PB_P15 = 12288, PB_V = 13312;
__device__ __forceinline__ unsigned lds_ld_u32(unsigned addr) { unsigned v; asm volatile("ds_read_b32 %0, %1\n\ts_waitcnt lgkmcnt(0)" : "=v"(v) : "v"(addr) : "memory"); return v; }
__device__ __forceinline__ void lds_st_u32(unsigned addr, unsigned v) { asm volatile("ds_write_b32 %0, %1" :: "v"(addr), "v"(v) : "memory"); }
__device__ __forceinline__ void pb_dma(const Params& p, int dbh, int ct, int lane, LAS unsigned char* slot) {
    const size_t task = (size_t)dbh * 128 + ct; const int b = (dbh >> 2) & 7, hh = dbh & 3;
    const unsigned char* q = (const unsigned char*)((const bf16_t*)(p.ws + WS_FQR) + task * 2048) + lane * 16; const unsigned char* w = (const unsigned char*)((const bf16_t*)(p.ws + WS_FWY) + task * 2048) + lane * 16;
    const unsigned char* na = (const unsigned char*)((const bf16_t*)(p.ws + WS_FNA) + task * 1024) + lane * 16; const unsigned char* kh = (const unsigned char*)((const bf16_t*)(p.ws + WS_FKH) + task * 1024) + lane * 16;
#pragma unroll
    for (int i = 0; i < 4; ++i) {
        __builtin_amdgcn_global_load_lds((const unsigned*)(q + 1024 * i), (LAS unsigned*)(slot + PB_QR + 1024 * i), 16, 0, 0);
        __builtin_amdgcn_global_load_lds((const unsigned*)(w + 1024 * i), (LAS unsigned*)(slot + PB_WY + 1024 * i), 16, 0, 0); }
    __builtin_amdgcn_global_load_lds((const unsigned*)na, (LAS unsigned*)(slot + PB_NA), 16, 0, 0); __builtin_amdgcn_global_load_lds((const unsigned*)(na + 1024), (LAS unsigned*)(slot + PB_NA + 1024), 16, 0, 0);
    __builtin_amdgcn_global_load_lds((const unsigned*)kh, (LAS unsigned*)(slot + PB_KH), 16, 0, 0); __builtin_amdgcn_global_load_lds((const unsigned*)(kh + 1024), (LAS unsigned*)(slot + PB_KH + 1024), 16, 0, 0);
    __builtin_amdgcn_global_load_lds((const unsigned*)((const unsigned char*)((const float*)(p.ws + WS_FP15) + task * 64) + lane * 16), (LAS unsigned*)(slot + PB_P15), 16, 0, 0);
    const unsigned char* V = (const unsigned char*)((const bf16_t*)(p.ws + WS_V) + ((size_t)b * SEQ + ct * 16) * 256 + hh * 64) + (size_t)(lane >> 3) * 512 + (lane & 7) * 16;
    __builtin_amdgcn_global_load_lds((const unsigned*)V, (LAS unsigned*)(slot + PB_V), 16, 0, 0); __builtin_amdgcn_global_load_lds((const unsigned*)(V + 8 * 512), (LAS unsigned*)(slot + PB_V + 1024), 16, 0, 0);
}
__device__ __forceinline__ void phaseb_unit(Frame& F, const Params& p, int u) {
    const unsigned flag_base = (unsigned)(size_t)(F.lds + 131072 + 128);
    if (F.tid < 8) lds_st_u32(flag_base + 4 * F.tid, 0u);
    __syncthreads();
    const int pair = F.wave & 3;
    if (pair >= 2) return;
    const int dbh = u * 2 + pair, dir = dbh >> 5;
    LAS unsigned char* ring = F.lds + pair * (PB_NSLOT * PB_SLOT);
    const unsigned f_pub = flag_base + 8 * pair, f_con = f_pub + 4;
    if (F.wave >= 4) {
        for (int c = 0; c < 128; ++c) {
            while ((int)lds_ld_u32(f_con) < c - (PB_NSLOT - 1)) __builtin_amdgcn_s_sleep(1);
            pb_dma(p, dbh, dir ? 127 - c : c, F.lane, ring + (c & (PB_NSLOT - 1)) * PB_SLOT);
            if (c >= 3) { asm volatile("s_waitcnt vmcnt(45)" ::: "memory"); if (F.lane == 0) lds_st_u32(f_pub, (unsigned)(c - 2)); }
        }
        asm volatile("s_waitcnt vmcnt(30)" ::: "memory"); if (F.lane == 0) lds_st_u32(f_pub, 126u);
        asm volatile("s_waitcnt vmcnt(15)" ::: "memory"); if (F.lane == 0) lds_st_u32(f_pub, 127u);
        asm volatile("s_waitcnt vmcnt(0)" ::: "memory"); if (F.lane == 0) lds_st_u32(f_pub, 128u);
        return;
    }
    const int b = (dbh >> 2) & 7, hh = dbh & 3, r = F.lane & 31, h = F.lane >> 5;
    GAS bf16_t* Y = (GAS bf16_t*)(p.ws + WS_Y) + ((size_t)dir * MTOK + (size_t)b * SEQ) * 256 + hh * 64 + r;
    f32x16 accS[2][2];
#pragma unroll
    for (int rb = 0; rb < 2; ++rb)
#pragma unroll
        for (int cb = 0; cb < 2; ++cb)
#pragma unroll
            for (int i = 0; i < 16; ++i) accS[rb][cb][i] = 0.f;
    for (int cc = 0; cc < 128; ++cc) {
        const int ct = dir ? 127 - cc : cc;
        const LAS unsigned char* slot = ring + (cc & (PB_NSLOT - 1)) * PB_SLOT;
        bf16x8 sb[4][2];
#pragma unroll
        for (int rb = 0; rb < 2; ++rb)
#pragma unroll
            for (int s2 = 0; s2 < 2; ++s2)
#pragma unroll
                for (int cb = 0; cb < 2; ++cb) { const f32x16& a = accS[rb][cb]; u32x4 w;
                    w.x = pk2(a[8 * s2 + 0], a[8 * s2 + 1]); w.y = pk2(a[8 * s2 + 2], a[8 * s2 + 3]); w.z = pk2(a[8 * s2 + 4], a[8 * s2 + 5]); w.w = pk2(a[8 * s2 + 6], a[8 * s2 + 7]);
                    sb[2 * rb + s2][cb] = __builtin_bit_cast(bf16x8, w); }
        while ((int)lds_ld_u32(f_pub) < cc + 1) __builtin_amdgcn_s_sleep(1);
        asm volatile("" ::: "memory");
        f32x16 D[2];
#pragma unroll
        for (int cb = 0; cb < 2; ++cb) { const LAS u32x4* wp = (const LAS u32x4*)(slot + PB_WY + (cb * 64 + F.lane) * 32); const u32x4 w0 = wp[0], w1 = wp[1];
            D[cb][0] = bflo(w0.x); D[cb][1] = bfhi(w0.x); D[cb][2] = bflo(w0.y); D[cb][3] = bfhi(w0.y); D[cb][4] = bflo(w0.z); D[cb][5] = bfhi(w0.z); D[cb][6] = bflo(w0.w); D[cb][7] = bfhi(w0.w);
            D[cb][8] = bflo(w1.x); D[cb][9] = bfhi(w1.x); D[cb][10] = bflo(w1.y); D[cb][11] = bfhi(w1.y); D[cb][12] = bflo(w1.z); D[cb][13] = bfhi(w1.z); D[cb][14] = bflo(w1.w); D[cb][15] = bfhi(w1.w); }
#pragma unroll
        for (int ks = 0; ks < 4; ++ks) { const bf16x8 qa = *(const LAS bf16x8*)(slot + PB_QR + (ks * 64 + F.lane) * 16);
            D[0] = __builtin_amdgcn_mfma_f32_32x32x16_bf16(qa, sb[ks][0], D[0], 0, 0, 0);
            D[1] = __builtin_amdgcn_mfma_f32_32x32x16_bf16(qa, sb[ks][1], D[1], 0, 0, 0); }
#pragma unroll
        for (int rb = 0; rb < 2; ++rb)
#pragma unroll
            for (int g4 = 0; g4 < 4; ++g4) { const f32x4 pv = *(const LAS f32x4*)(slot + PB_P15 + (32 * rb + 8 * g4 + 4 * h) * 4);
#pragma unroll
                for (int cb = 0; cb < 2; ++cb)
#pragma unroll
                    for (int q = 0; q < 4; ++q) accS[rb][cb][4 * g4 + q] *= pv[q]; }
        bf16x8 ub[2], vb[2];
#pragma unroll
        for (int cb = 0; cb < 2; ++cb) {
            unsigned short vt[8];
#pragma unroll
            for (int j = 0; j < 8; ++j) { const int s2 = 8 * (j >> 2) + 4 * h + (j & 3); const int tau = dir ? 15 - s2 : s2;
                vt[j] = *(const LAS unsigned short*)(slot + PB_V + tau * 128 + (32 * cb + r) * 2);
                Y[(size_t)(ct * 16 + tau) * 256 + 32 * cb] = (bf16_t)(pk2(D[cb][8 + j], 0.f) & 0xffffu); }
            vb[cb] = (bf16x8){(short)vt[0], (short)vt[1], (short)vt[2], (short)vt[3], (short)vt[4], (short)vt[5], (short)vt[6], (short)vt[7]};
            u32x4 w; w.x = pk2(D[cb][0], D[cb][1]); w.y = pk2(D[cb][2], D[cb][3]); w.z = pk2(D[cb][4], D[cb][5]); w.w = pk2(D[cb][6], D[cb][7]);
            ub[cb] = __builtin_bit_cast(bf16x8, w);
        }
        bf16x8 na[2], kh[2];
#pragma unroll
        for (int rb = 0; rb < 2; ++rb) { na[rb] = *(const LAS bf16x8*)(slot + PB_NA + (rb * 64 + F.lane) * 16); kh[rb] = *(const LAS bf16x8*)(slot + PB_KH + (rb * 64 + F.lane) * 16); }
        asm volatile("s_waitcnt lgkmcnt(0)" ::: "memory");
        if (F.lane == 0) lds_st_u32(f_con, (unsigned)(cc + 1));
#pragma unroll
        for (int rb = 0; rb < 2; ++rb)
#pragma unroll
            for (int cb = 0; cb < 2; ++cb) {
                accS[rb][cb] = __builtin_amdgcn_mfma_f32_32x32x16_bf16(na[rb], ub[cb], accS[rb][cb], 0, 0, 0);
                accS[rb][cb] = __builtin_amdgcn_mfma_f32_32x32x16_bf16(kh[rb], vb[cb], accS[rb][cb], 0, 0, 0);
            }
    }
}

__device__ __forceinline__ void post_unit(Frame& F, const Params& p, int l, int u) {
    REFRAME(F);
    const bf16_t* Y0 = (const bf16_t*)(p.ws + WS_Y); const bf16_t* Y1 = Y0 + (size_t)MTOK * 256;
    const bf16_t* VV = (const bf16_t*)(p.ws + WS_V); const bf16_t* GT = (const bf16_t*)(p.ws + WS_GATE);
    const float* BON = (const float*)(p.ws + WS_BON); bf16_t* MIX = (bf16_t*)(p.ws + WS_MIX);
    const f32x4 lg = *(const f32x4*)(p.in[19] + l * 256 + 4 * F.lane), lb = *(const f32x4*)(p.in[20] + l * 256 + 4 * F.lane);
    for (int tok = u * 64 + F.wave * 8, te = tok + 8; tok < te; ++tok) {
        const u32x2 a = *(const GAS u32x2*)((const GAS bf16_t*)Y0 + (size_t)tok * 256 + 4 * F.lane), c = *(const GAS u32x2*)((const GAS bf16_t*)Y1 + (size_t)tok * 256 + 4 * F.lane);
        const u32x2 vv = *(const GAS u32x2*)((const GAS bf16_t*)VV + (size_t)tok * 256 + 4 * F.lane), gg = *(const GAS u32x2*)((const GAS bf16_t*)GT + (size_t)tok * 256 + 4 * F.lane);
        float y[4] = {bflo(a.x) + bflo(c.x), bfhi(a.x) + bfhi(c.x), bflo(a.y) + bflo(c.y), bfhi(a.y) + bfhi(c.y)};
        float s = (y[0] + y[1]) + (y[2] + y[3]);
#pragma unroll
        for (int o = 1; o < 16; o <<= 1) s += __shfl_xor(s, o);
        const float mu = s * (1.f / 64.f);
        float q = 0.f;
#pragma unroll
        for (int i = 0; i < 4; ++i) { y[i] -= mu; q += y[i] * y[i]; }
#pragma unroll
        for (int o = 1; o < 16; o <<= 1) q += __shfl_xor(q, o);
        const float rstd = rsqrtf(q * (1.f / 64.f) + 64e-5f);
        const int hh = F.lane >> 4;
        const float bon = ((const GAS float*)BON)[(size_t)tok * 4 + hh] + ((const GAS float*)BON)[((size_t)MTOK + tok) * 4 + hh];
        const float v4[4] = {bflo(vv.x), bfhi(vv.x), bflo(vv.y), bfhi(vv.y)}, g4[4] = {bflo(gg.x), bfhi(gg.x), bflo(gg.y), bfhi(gg.y)};
        float o4[4];
#pragma unroll
        for (int i = 0; i < 4; ++i) o4[i] = (y[i] * rstd * lg[i] + lb[i] + bon * v4[i]) * g4[i];
        u32x2 w; w.x = pk2(o4[0], o4[1]); w.y = pk2(o4[2], o4[3]);
        *(GAS u32x2*)((GAS bf16_t*)MIX + (size_t)tok * DM + 768 + 4 * F.lane) = w;
    }
}

__device__ __forceinline__ void prologue(Frame& F, const Params& p) {
    REFRAME(F);
    LAS float* scr = (LAS float*)(F.lds + F.wave * 16384);
    const int gw = F.bid * 8 + F.wave, NGW = F.G * 8;
    bf16_t* wb = (bf16_t*)(p.ws + WS_W);
    for (int it = gw; it < CV_TOTAL; it += NGW) { if (it < CV_A) cvt_item_a(p, 0, wb, scr, it, F.lane); else cvt_item_b(p, 0, wb, scr, it - CV_A, F.lane); }
    const float* x = p.in[0]; float* X = p.out; bf16_t* XB = (bf16_t*)(p.ws + WS_XB); float* rowss = (float*)(p.ws + WS_RP);
    for (int m = gw; m < MTOK; m += NGW) {
        const f32x4* xr = (const f32x4*)(x + (size_t)m * DM) + F.lane; f32x4* xo = (f32x4*)(X + (size_t)m * DM) + F.lane; u32x2* bo = (u32x2*)(XB + (size_t)m * DM) + F.lane;
        float s = 0.f;
#pragma unroll
        for (int jj = 0; jj < 4; ++jj) { const f32x4 v = xr[64 * jj]; xo[64 * jj] = v; s += (v[0] * v[0] + v[1] * v[1]) + (v[2] * v[2] + v[3] * v[3]);
            u32x2 w; w.x = pk2(v[0], v[1]); w.y = pk2(v[2], v[3]); bo[64 * jj] = w; }
        s = wave_sum(s);
        if (F.lane < 16) rowss[(size_t)m * 16 + F.lane] = (F.lane == 0) ? s : 0.f;
    }
    const float* mem = p.in[1]; const float* gm = p.in[23]; bf16_t* MN = (bf16_t*)(p.ws + WS_MEMN);
    for (int m = gw; m < MMEM; m += NGW) {
        const f32x4* xr = (const f32x4*)(mem + (size_t)m * DM) + F.lane; u32x2* bo = (u32x2*)(MN + (size_t)m * DM) + F.lane;
        f32x4 v[4]; float s = 0.f;
#pragma unroll
        for (int jj = 0; jj < 4; ++jj) { v[jj] = xr[64 * jj]; s += (v[jj][0] * v[jj][0] + v[jj][1] * v[jj][1]) + (v[jj][2] * v[jj][2] + v[jj][3] * v[jj][3]); }
        const float rstd = rsqrtf(wave_sum(s) * (1.f / 1024.f) + 1e-6f);
#pragma unroll
        for (int jj = 0; jj < 4; ++jj) { const f32x4 g = *((const f32x4*)gm + F.lane + 64 * jj); const f32x4 t = v[jj] * rstd * g;
            u32x2 w; w.x = pk2(t[0], t[1]); w.y = pk2(t[2], t[3]); bo[64 * jj] = w; }
    }
}
__device__ __forceinline__ void final_norm(Frame& F, const Params& p) {
    REFRAME(F);
    const int gw = F.bid * 8 + F.wave, NGW = F.G * 8;
    const float* rowss = (const float*)(p.ws + WS_RP) + (size_t)12 * MTOK * 16; const float* gf = p.in[30];
    for (int m = gw; m < MTOK; m += NGW) {
        f32x4* xo = (f32x4*)(p.out + (size_t)m * DM) + F.lane;
        const float rstd = row_rstd(rowss, m);
#pragma unroll
        for (int jj = 0; jj < 4; ++jj) { const f32x4 g = *((const f32x4*)gf + F.lane + 64 * jj); xo[64 * jj] = xo[64 * jj] * rstd * g; }
#ifdef TPROBE
        { const unsigned* c_ = (const unsigned*)(p.ws + WS_CTL); const float A_ = (float)c_[32] * 1e-4f, B_ = (float)c_[33] * 1e-4f;
          if (m >= 1024 && m < 2048) {
#pragma unroll
              for (int jj = 0; jj < 4; ++jj) xo[64 * jj] = xo[64 * jj] + B_; }
          if (m == 0 && F.lane == 0) { f32x4 v = xo[0]; v[0] += A_; xo[0] = v; } }
#endif
    }
}

#define XB_TMO      128
#define XB_XCNT(j)  (256  + 64 * (j))
#define XB_XSUB(j)  (1280 + 64 * (j))
#define XB_XGEN(j)  (2304 + 64 * (j))
#define XB_TOP      3328
#define XB_TOPGEN   3392
#define XB_SPIN_CAP (1u << 22)
constexpr int CW_BAR = 4096;
__device__ __forceinline__ unsigned xb_ld(unsigned* p)              { return __hip_atomic_load(p, __ATOMIC_RELAXED, __HIP_MEMORY_SCOPE_AGENT); }
__device__ __forceinline__ unsigned xb_add(unsigned* p, unsigned v) { return __hip_atomic_fetch_add(p, v, __ATOMIC_RELAXED, __HIP_MEMORY_SCOPE_AGENT); }
__device__ __forceinline__ unsigned xb_xcc_id() { return (unsigned)__builtin_amdgcn_s_getreg((3 << 11) | 20) & 0xFu; }
#define XB_SPIN(cond, bar) do { unsigned _sp = 0; while (cond) { __builtin_amdgcn_s_sleep(1); \
    if ((++_sp & 255u) == 0u) { if (xb_ld(&(bar)[XB_TMO])) break; if (_sp > XB_SPIN_CAP) { atomicAdd(&(bar)[XB_TMO], 1u); break; } } } } while (0)
__device__ __forceinline__ void xcd_barrier_complete(unsigned* bar, unsigned x, unsigned& nloc, unsigned& nx) {
    const unsigned G = gridDim.x;
    unsigned sum, cnt, mine, sp = 0u;
    for (;;) {
        sum = 0u; cnt = 0u; mine = 0u;
#pragma unroll
        for (unsigned j = 0; j < 16; ++j) { const unsigned c = xb_ld(&bar[XB_XCNT(j)]); sum += c; cnt += (c > 0u) ? 1u : 0u; mine = (j == x) ? c : mine; }
        if (sum == G) break;
        __builtin_amdgcn_s_sleep(1);
        if ((++sp & 255u) == 0u) { if (xb_ld(&bar[XB_TMO])) break; if (sp > XB_SPIN_CAP) { atomicAdd(&bar[XB_TMO], 1u); break; } }
    }
    nloc = mine > 0u ? mine : 1u; nx = cnt > 0u ? cnt : 1u;
}
__device__ __forceinline__ void gsync(volatile LAS unsigned* st) {
    unsigned* bar = (unsigned*)(make_params().ws + WS_CTL) + CW_BAR;
    asm volatile("s_waitcnt vmcnt(0)" ::: "memory");
    __syncthreads();
    if (threadIdx.x == 0) {
        const unsigned x = xb_xcc_id();
        __builtin_amdgcn_s_waitcnt(0);
        unsigned nloc = st[0], nx = st[1];
        if (nloc == 0u) { xcd_barrier_complete(bar, x, nloc, nx); st[0] = nloc; st[1] = nx; }
        const unsigned old = xb_add(&bar[XB_XSUB(x)], 1u);
        const unsigned gen = old / nloc;
        if (old + 1u == (gen + 1u) * nloc) {
            __builtin_amdgcn_fence(__ATOMIC_RELEASE, "agent");
            asm volatile("s_waitcnt vmcnt(0)" ::: "memory");
            const unsigned og = xb_add(&bar[XB_TOP], 1u);
            const unsigned tg = og / nx;
            if (og + 1u == (tg + 1u) * nx) xb_add(&bar[XB_TOPGEN], 1u);
            else XB_SPIN(xb_ld(&bar[XB_TOPGEN]) == tg, bar);
            __builtin_amdgcn_fence(__ATOMIC_ACQUIRE, "agent");
            xb_add(&bar[XB_XGEN(x)], 1u);
            asm volatile("s_waitcnt vmcnt(0)" ::: "memory");
        } else {
            XB_SPIN(xb_ld(&bar[XB_XGEN(x)]) == gen, bar);
            __builtin_amdgcn_fence(__ATOMIC_ACQUIRE, "agent");
            asm volatile("s_waitcnt vmcnt(0)" ::: "memory");
        }
    }
    __syncthreads();
}
#ifdef TPROBE
#define STAMP(id) do { if (blockIdx.x == 0 && threadIdx.x == 0) { LAS unsigned long long* ts_ = (LAS unsigned long long*)(F.lds + 131072 + 64); const unsigned long long now_ = __builtin_amdgcn_s_memrealtime(); \
    const unsigned long long dt_ = now_ - ts_[0]; ts_[0] = now_; if ((TA_MASK >> (id)) & 1) ts_[1] += dt_; if ((TB_MASK >> (id)) & 1) ts_[2] += dt_; } } while (0)
#else
#define STAMP(id) do { } while (0)
#endif
#ifndef PH_MASK
#define PH_MASK 0xFFFF
#endif
#ifndef REP_MASK
#define REP_MASK 0
#endif
#define NREP(k) ((((REP_MASK) >> (k)) & 1) ? 2 : 1)
constexpr int NCP = 1024, NDIFF_A = 0, NPB = 32;
__global__ void __launch_bounds__(512, 2) fwd_megakernel(KArgs kargs_unused) {
    extern __shared__ __attribute__((aligned(16))) unsigned char lds_raw[];
    cg::grid_group grid = cg::this_grid();
    Frame F; F.lds = (LAS unsigned char*)lds_raw; F.tid = threadIdx.x; F.lane = F.tid & 63; F.wave = __builtin_amdgcn_readfirstlane(F.tid >> 6); F.G = gridDim.x; F.bid = blockIdx.x;
    LAS int* qslot = (LAS int*)(F.lds + 131072);
    volatile LAS unsigned* bst = (volatile LAS unsigned*)(F.lds + 131072 + 32);
    { unsigned* bar0 = (unsigned*)(make_params().ws + WS_CTL) + CW_BAR;
      if (threadIdx.x == 0) { bst[0] = 0u; bst[1] = 0u; (void)xb_add(bar0 + XB_XCNT(xb_xcc_id()), 1u); } }
    __syncthreads();
#define PHASE_VARS() const Params p = make_params(); unsigned* ctl = (unsigned*)(p.ws + WS_CTL); float* rowss = (float*)(p.ws + WS_RP); \
    bf16_t* XB = (bf16_t*)(p.ws + WS_XB); bf16_t* Z = (bf16_t*)(p.ws + WS_Z); bf16_t* MIX = (bf16_t*)(p.ws + WS_MIX); \
    bf16_t* wb = (bf16_t*)(p.ws + WS_W); int bid_ = F.bid, G_ = F.G; asm volatile("" : "+s"(bid_), "+s"(G_)); (void)bid_; (void)G_; (void)ctl; (void)rowss; (void)XB; (void)Z; (void)MIX; (void)wb

#ifdef TPROBE
    if (blockIdx.x == 0 && threadIdx.x == 0) { LAS unsigned long long* ts_ = (LAS unsigned long long*)(F.lds + 131072 + 64); ts_[0] = __builtin_amdgcn_s_memrealtime(); ts_[1] = 0; ts_[2] = 0; }
#endif
    if (PH_MASK & 1) { const Params p = make_params(); prologue(F, p); }
    grid.sync();
    STAMP(0);

    for (int l = 0; l < NL; ++l) {
        for (int rep = 0; rep < NREP(1); ++rep) {
        if (PH_MASK & 2) {
            PHASE_VARS();
            pg8::StaticOrder S; S.init(MTOK, INW, G_, bid_);
            pg8::gemm_phase(F.lds, pg8::Gemm{XB, wb + WO_IN, MTOK, INW, DM}, S, pg8::EpiScaleBf16{Z, ZP, rowss + (size_t)(3 * l) * MTOK * 16, (bf16_t*)(p.ws + WS_ZC), 1024, 8, (bf16_t*)(p.ws + WS_KD2)});
        }
        gsync(bst); STAMP(1);
        }
        for (int rep = 0; rep < NREP(2); ++rep) {
        for (int u = F.bid; u < 768; u += F.G) {
            PHASE_VARS();
            if (u < 512) { if (PH_MASK & 4) prep_unit(F, p, l, wb, u); } else if (PH_MASK & 8) win_unit(F, p, l, u - 512);
        }
        gsync(bst); STAMP(2);
        }
        for (int rep = 0; rep < NREP(3); ++rep) {
        {
            PHASE_VARS();
            const int ntot = NCP + NDIFF_A;
            for (;;) {
                __syncthreads();
                if (F.tid == 0) *qslot = (int)atomicAdd(ctl + CW_Q + 16 * l + 4 * rep, 1u);
                __syncthreads();
                const int u = *qslot;
                if (u >= ntot) break;
                if (u < NCP) { if (PH_MASK & 16) { REFRAME(F); if (u >= NCP / 2) chunkprep_wave<1>(F, p, u * 8 + F.wave); else chunkprep_wave<0>(F, p, u * 8 + F.wave); } }
                else if (PH_MASK & 32) diff_unit(F, p, l, u - NCP);
            }
        }
        gsync(bst); STAMP(11);
        }
        for (int rep = 0; rep < NREP(4); ++rep) {
        {
            PHASE_VARS();
            const int ncva = (l + 1 < NL) ? CV_A / 8 : 0, ncvb = (l > 0) ? CV_B / 8 : 0, ncv = NPB + ncva + ncvb, ntot = ncv + 256;
            unsigned* pbdone = ctl + 3072 + (l * 2 + rep) * 16;
            unsigned* gq = ctl + CW_Q + 16 * l + 8 + 4 * rep; unsigned* dq = ctl + 2048 + (l * 2 + rep) * 16;
            const int myx = (int)(xb_xcc_id() & 7u);
            int stage = 0, pend = -1, xi = 0;
            for (;;) {
                __syncthreads();
                if (F.tid == 0) {
                    int code = -1;
                    if (stage == 0) { const int g = (int)atomicAdd(gq, 1u); if (g < NPB) code = g; else { pend = g; stage = 1; } }
                    if (stage == 1) {
                        while (xi < 8) { const int x = (myx + xi) & 7; const int tk = (int)atomicAdd(dq + x, 1u); if (tk < 64) { code = -2 - ((4 * x + (tk >> 4)) * 16 + (tk & 15)); break; } ++xi; }
                        if (xi >= 8) stage = 2;
                    }
                    if (stage == 2 && code == -1) { int g = pend; pend = -1; if (g < 0) g = (int)atomicAdd(gq, 1u); if (g < ntot) code = g; }
                    *qslot = code;
                }
                __syncthreads();
                const int u = *qslot;
                if (u == -1) break;
                if (u <= -2) { if (PH_MASK & 32) diff_unit(F, p, l, -2 - u); }
                else if (u < NPB) { if (PH_MASK & 16) { REFRAME(F); phaseb_unit(F, p, u); }
                    __threadfence(); __syncthreads();
                    if (F.tid == 0) __hip_atomic_fetch_add(pbdone, 1u, __ATOMIC_RELEASE, __HIP_MEMORY_SCOPE_AGENT); }
                else if (u >= ncv) {
                    if (F.tid == 0) { while (__hip_atomic_load(pbdone, __ATOMIC_RELAXED, __HIP_MEMORY_SCOPE_AGENT) < (unsigned)NPB) __builtin_amdgcn_s_sleep(8); }
                    __syncthreads(); __builtin_amdgcn_fence(__ATOMIC_ACQUIRE, "agent");
                    if (PH_MASK & 64) post_unit(F, p, l, u - ncv); }
                else if (u < NPB + ncva) { REFRAME(F); cvt_item_a(p, l + 1, wb, (LAS float*)(F.lds + F.wave * 16384), (u - NPB) * 8 + F.wave, F.lane); }
                else { REFRAME(F); cvt_item_b(p, l, wb, (LAS float*)(F.lds + F.wave * 16384), (u - NPB - ncva) * 8 + F.wave, F.lane); }
            }
        }
        gsync(bst); STAMP(3);
        }
        if (PH_MASK & 128) {
            PHASE_VARS();
            pg8::StaticOrder S; S.init(MTOK, DM, G_, bid_);
            pg8::gemm_phase(F.lds, pg8::Gemm{MIX, wb + WO_OUT, MTOK, DM, DM}, S, pg8::EpiResid{p.out, XB, rowss + (size_t)(3 * l + 1) * MTOK * 16});
        }
        gsync(bst); STAMP(5);
        for (int rep = 0; rep < NREP(6); ++rep) {
        if (PH_MASK & 256) {
            PHASE_VARS();
            pg8::StaticOrder S; S.init(MTOK, XW, G_, bid_);
            if (F.bid < 128) {
                pg8::gemm_phase(F.lds, pg8::Gemm{XB, wb + WO_Q, MTOK, XW, DM}, S, pg8::EpiScaleBf16{(bf16_t*)(p.ws + WS_Q), XW, rowss + (size_t)(3 * l + 1) * MTOK * 16, nullptr, 0, 1 << 30, nullptr});
            } else {
                pg8::StaticOrder S2; S2.init(MMEM, 1024, 128, F.bid - 128);
                pg8::gemm_phase(F.lds, pg8::Gemm{(const bf16_t*)(p.ws + WS_MEMN), wb + WO_KV, MMEM, 1024, DM}, S2, pg8::EpiScaleBf16{(bf16_t*)(p.ws + WS_KV), 1024, nullptr, nullptr, 0, 1 << 30, nullptr});
            }
        }
        gsync(bst); STAMP(6);
        }
        for (int rep = 0; rep < NREP(7); ++rep) {
        if (PH_MASK & 512) for (int u = F.bid; u < 256; u += F.G) { PHASE_VARS(); cross_unit(F, p, u); }
        gsync(bst); STAMP(7);
        }
        if (PH_MASK & 1024) {
            PHASE_VARS();
            pg8::StaticOrder S; S.init(MTOK, DM, G_, bid_);
            pg8::gemm_phase(F.lds, pg8::Gemm{(const bf16_t*)(p.ws + WS_O), wb + WO_O, MTOK, DM, XW}, S, pg8::EpiResid{p.out, XB, rowss + (size_t)(3 * l + 2) * MTOK * 16});
        }
        gsync(bst); STAMP(8);
        for (int rep = 0; rep < NREP(9); ++rep) {
        if (PH_MASK & 2048) {
            PHASE_VARS();
            pg8::StaticOrder S; S.init(MTOK, 2 * DFF, G_, bid_);
            pg8::gemm_phase(F.lds, pg8::Gemm{XB, wb + WO_GU, MTOK, 2 * DFF, DM}, S, pg8::EpiSwiGLU{(bf16_t*)(p.ws + WS_G), rowss + (size_t)(3 * l + 2) * MTOK * 16});
        }
        gsync(bst); STAMP(9);
        }
        if (PH_MASK & 4096) {
            PHASE_VARS();
            pg8::StaticOrder S; S.init(MTOK, DM, G_, bid_);
            pg8::gemm_phase(F.lds, pg8::Gemm{(const bf16_t*)(p.ws + WS_G), wb + WO_DOWN, MTOK, DM, DFF}, S, pg8::EpiResid{p.out, XB, rowss + (size_t)(3 * l + 3) * MTOK * 16});
        }

#ifdef TPROBE
        STAMP(10);
        { const Params p = make_params(); if (l == NL - 1 && blockIdx.x == 0 && threadIdx.x == 0) { LAS unsigned long long* ts_ = (LAS unsigned long long*)(F.lds + 131072 + 64); unsigned* c_ = (unsigned*)(p.ws + WS_CTL); c_[32] = (unsigned)ts_[1]; c_[33] = (unsigned)ts_[2]; } }
#endif
        gsync(bst);
    }
    if (PH_MASK & 8192) { const Params p = make_params(); final_norm(F, p); }
}

extern "C" void kernel_launch(void* const* d_in, const int* in_sizes, int n_in, void* d_out, int out_size, void* d_ws, size_t ws_size, hipStream_t stream) {
    static int grid = 0;
    if (grid == 0) {
        if (n_in != 31 || out_size != MTOK * DM || ws_size < WS_END) { fprintf(stderr, "kernel_launch: unexpected problem shape (n_in %d out %d ws %zu)\n", n_in, out_size, ws_size); grid = -1; return; }
        int dev = 0, cus = 0, per_cu = 0;
        hipGetDevice(&dev);
        hipDeviceGetAttribute(&cus, hipDeviceAttributeMultiprocessorCount, dev);
        hipFuncSetAttribute((const void*)fwd_megakernel, hipFuncAttributeMaxDynamicSharedMemorySize, LDS_BYTES);
        hipOccupancyMaxActiveBlocksPerMultiprocessor(&per_cu, (const void*)fwd_megakernel, 512, LDS_BYTES);
        if (per_cu < 1) { fprintf(stderr, "kernel_launch: occupancy query returned %d\n", per_cu); per_cu = 1; }
        (void)hipGetLastError();
        grid = cus * per_cu;
    }
    if (grid < 0) return;
    hipMemsetAsync((char*)d_ws + WS_CTL, 0, CTL_ZERO_BYTES, stream);
    KArgs p{};
    for (int i = 0; i < 31; ++i) p.in[i] = (const float*)d_in[i];
    p.out = (float*)d_out; p.ws = (unsigned char*)d_ws;
    void* args[] = {&p};
    hipError_t e = hipLaunchCooperativeKernel((const void*)fwd_megakernel, dim3(grid), dim3(512), args, LDS_BYTES, stream);
    if (e != hipSuccess) fprintf(stderr, "cooperative launch failed: %s (grid %d)\n", hipGetErrorString(e), grid);
}
```

```cpp
#include <hip/hip_runtime.h>
#include <hip/hip_cooperative_groups.h>
#include <cstdio>
#include <cstdint>
namespace cg = cooperative_groups;

#define LAS __attribute__((address_space(3)))
#define GAS __attribute__((address_space(1)))
typedef unsigned short bf16_t;
typedef short bf16x8 __attribute__((ext_vector_type(8)));
typedef short s16x4 __attribute__((ext_vector_type(4)));
typedef short v4i16_t __attribute__((ext_vector_type(4)));
typedef float f32x4 __attribute__((ext_vector_type(4)));
typedef float f32x2 __attribute__((ext_vector_type(2)));
typedef float f32x16 __attribute__((ext_vector_type(16)));
typedef unsigned u32x4 __attribute__((ext_vector_type(4)));
typedef unsigned u32x2 __attribute__((ext_vector_type(2)));
typedef __bf16 bf16x2_t __attribute__((ext_vector_type(2)));

constexpr int DM = 1024, NB = 8, SEQ = 2048, NL = 4, MTOK = NB * SEQ;
constexpr int NMEM = 256, MMEM = NB * NMEM;
constexpr int INW = 3072, DFF = 2816, XW = 512;
constexpr float LOG2E = 1.4426950408889634f;

constexpr size_t MiB = 1u << 20;
constexpr size_t WS_CTL = 0, CTL_ZERO_BYTES = 1 * MiB;
constexpr size_t WS_W = 1 * MiB;
constexpr size_t WS_Z = 30 * MiB;
constexpr size_t WS_ZC = 94 * MiB;
constexpr size_t WS_XB = 126 * MiB;
constexpr size_t WS_FQR = 94 * MiB, WS_FWY = 126 * MiB, WS_FNA = 158 * MiB, WS_FKH = 174 * MiB, WS_FP15 = 190 * MiB;
constexpr size_t WS_MIX = 192 * MiB;
constexpr size_t WS_OM = 224 * MiB, WS_KA = 240 * MiB, WS_KD = 256 * MiB, WS_KK = 272 * MiB, WS_V = 280 * MiB, WS_R = 288 * MiB;
constexpr size_t WS_GATE = 296 * MiB, WS_Y = 304 * MiB, WS_BON = 320 * MiB, WS_KV = 321 * MiB, WS_MEMN = 325 * MiB;
constexpr size_t WS_RP = 329 * MiB;
constexpr size_t WS_END = 342 * MiB;
constexpr size_t WS_Q = WS_Z, WS_O = WS_Z + 16 * MiB, WS_G = WS_Z;
constexpr int ZP = 1024;
constexpr size_t WS_KD2 = WS_Z + 32 * MiB, WS_VD2 = WS_Z + 48 * MiB;
constexpr size_t WO_IN = 0, WO_OUT = 3145728, WO_Q = 4194304, WO_KV = 4718592, WO_O = 5767168, WO_GU = 6291456, WO_DOWN = 12058624;
constexpr size_t WO_WUP = 14942208, WO_AUP = 14974976, WO_GUP = 15007744;
constexpr int CW_Q = 64;

constexpr int LDS_BYTES = 135168;

__device__ __forceinline__ float bf2f(unsigned b) { return __uint_as_float(b << 16); }
__device__ __forceinline__ unsigned pk2(float lo, float hi) { f32x2 v = {lo, hi}; bf16x2_t b = __builtin_convertvector(v, bf16x2_t); return __builtin_bit_cast(unsigned, b); }
__device__ __forceinline__ float bflo(unsigned u) { return __uint_as_float(u << 16); }
__device__ __forceinline__ float bfhi(unsigned u) { return __uint_as_float(u & 0xffff0000u); }
__device__ __forceinline__ float wave_sum(float v) {
#pragma unroll
    for (int o = 1; o < 64; o <<= 1) v += __shfl_xor(v, o);
    return v;
}
__device__ __forceinline__ float xhalf(float v) {
    return __shfl_xor(v, 32);
}
__device__ __forceinline__ float row_rstd(const float* rp, int row) {
    const f32x4* q = (const f32x4*)(rp + (size_t)row * 16); const f32x4 a = q[0], b = q[1], c = q[2], d = q[3];
    const float s = (((a[0] + a[1]) + (a[2] + a[3])) + ((b[0] + b[1]) + (b[2] + b[3]))) + (((c[0] + c[1]) + (c[2] + c[3])) + ((d[0] + d[1]) + (d[2] + d[3])));
    return rsqrtf(s * (1.f / 1024.f) + 1e-6f);
}
__device__ __forceinline__ float sigmoidf_(float x) { return __builtin_amdgcn_rcpf(1.f + __expf(-x)); }

__device__ __forceinline__ int hw_lane() { int l = (int)__builtin_amdgcn_mbcnt_hi(~0u, __builtin_amdgcn_mbcnt_lo(~0u, 0u)); asm volatile("" : "+v"(l)); return l; }
namespace pg8 {
constexpr int BM = 256, BK = 64, HALF = 128, HTB = HALF * BK * 2, NXCD = 8, WGM = 8;
__host__ __device__ __forceinline__ int lds_byte(int r, int c) { const int st = (r >> 4) * 2 + (c >> 5), rr = r & 15, cc = c & 31, ob = rr * 64 + cc * 2; return st * 1024 + (ob ^ (((ob >> 9) & 1) << 5)); }
__host__ __device__ __forceinline__ void stage_rc(int b, int& R, int& C) { const int st = b / 1024, sb = b % 1024, swz = sb ^ (((sb >> 9) & 1) << 5); R = (st >> 1) * 16 + swz / 64; C = (st & 1) * 32 + (swz % 64) / 2; }
__host__ __device__ __forceinline__ int perm32(int rho) { const int n = rho >> 4, i = rho & 15; return 8 * (i >> 2) + 4 * n + (i & 3); }
struct Unit { int pm, pn; };
struct Gemm { const bf16_t* A; const bf16_t* Bt; int M, N, K; };
struct StaticOrder {
    int nM, nN, nwg, G, c;
    __device__ void init(int M, int N, int G_, int c_) { nM = M / BM; nN = N / BM; nwg = nM * nN; G = G_; c = c_; }
    __device__ bool next(int i, Unit& u) const {
        const long L = (long)i * G + c; if (L >= nwg) return false;
        int wgid = (int)L; { const int q = nwg / NXCD, r = nwg % NXCD, xcd = wgid % NXCD, off = wgid / NXCD; wgid = (xcd < r ? xcd * (q + 1) : r * (q + 1) + (xcd - r) * q) + off; }
        const int nig = WGM * nN, gid = wgid / nig, fm = gid * WGM, gsz = (nM - fm) < WGM ? (nM - fm) : WGM;
        u.pm = fm + ((wgid % nig) % gsz); u.pn = (wgid % nig) / gsz; return true;
    }
};
template <class Epi>
__device__ __forceinline__ void gemm_phase(LAS unsigned char* lds, const Gemm g, const StaticOrder& S, const Epi& E) {
    int tid_ = threadIdx.x; asm volatile("" : "+v"(tid_));
    const int tid = tid_, wid = __builtin_amdgcn_readfirstlane(tid >> 6), lane = tid & 63, wr = wid >> 2, wc = wid & 3, fr = lane & 15, fq = lane >> 4;
    const int K = g.K, nt = K / BK;
    unsigned voffA[2], voffB[2];
#pragma unroll
    for (int i = 0; i < 2; ++i) { int R, C; stage_rc(tid * 16 + i * 8192, R, C); const int Rb = (R & ~31) + perm32(R & 31);
        voffA[i] = (unsigned)(R * K + C) * 2u; voffB[i] = (unsigned)(Rb * K + C) * 2u; }
    const size_t kstep = (size_t)(BK * 2);
    const size_t hstep = (size_t)HALF * K * 2;
    const size_t tstep = 2 * hstep;
    const unsigned ldsw = (unsigned)wid * 1024u;
    const int aoff = lds_byte(wr * 64 + fr, fq * 8), boff = lds_byte(wc * 32 + fr, fq * 8);
#define PG8_SA(b, h) (((b) * 2 + (h)) * HTB)
#define PG8_SB(b, h) ((4 + (b) * 2 + (h)) * HTB)
#define PG8_STAGE(bufoff, gbase, voff) do { _Pragma("unroll") for (int _i = 0; _i < 2; ++_i) \
        __builtin_amdgcn_global_load_lds((const unsigned*)((const char*)(gbase) + (voff)[_i]), (LAS unsigned*)(lds + (bufoff) + ldsw + _i * 8192), 16, 0, 0); } while (0)
#define PG8_LDA(dst, b, h) do { _Pragma("unroll") for (int m = 0; m < 4; ++m) _Pragma("unroll") for (int k = 0; k < 2; ++k) dst[m][k] = *(const LAS bf16x8*)(lds + PG8_SA(b, h) + aoff + m * 2048 + k * 1024); } while (0)
#define PG8_LDB(dst, b, h) do { _Pragma("unroll") for (int n = 0; n < 2; ++n) _Pragma("unroll") for (int k = 0; k < 2; ++k) dst[n][k] = *(const LAS bf16x8*)(lds + PG8_SB(b, h) + boff + n * 2048 + k * 1024); } while (0)
#define PG8_MMA(ai, bj, At, Bt) do { __builtin_amdgcn_s_setprio(1); _Pragma("unroll") for (int m = 0; m < 4; ++m) _Pragma("unroll") for (int n = 0; n < 2; ++n) _Pragma("unroll") for (int k = 0; k < 2; ++k) \
        acc[ai][bj][m][n] = __builtin_amdgcn_mfma_f32_16x16x32_bf16(Bt[n][k], At[m][k], acc[ai][bj][m][n], 0, 0, 0); __builtin_amdgcn_s_setprio(0); } while (0)
#define PG8_WAIT_V(n) asm volatile("s_waitcnt vmcnt(" #n ")" ::: "memory")
#define PG8_WAIT_L(n) asm volatile("s_waitcnt lgkmcnt(" #n ")" ::: "memory")
#define PG8_BAR __builtin_amdgcn_s_barrier()
#define PG8_SCHED __builtin_amdgcn_sched_barrier(0)
    Unit cur, nxt; int ui = 0;
    if (!S.next(0, cur)) return;
    f32x4 acc[2][2][4][2];
#pragma unroll
    for (int a = 0; a < 2; ++a)
#pragma unroll
        for (int b = 0; b < 2; ++b)
#pragma unroll
            for (int m = 0; m < 4; ++m)
#pragma unroll
                for (int n = 0; n < 2; ++n) acc[a][b][m][n] = (f32x4){0.f, 0.f, 0.f, 0.f};
    bf16x8 At[4][2], B0[2][2], B1[2][2];
    const char* cA = (const char*)g.A + (size_t)cur.pm * tstep; const char* cB = (const char*)g.Bt + (size_t)cur.pn * tstep;
    {
        PG8_STAGE(PG8_SB(0, 0), cB, voffB); PG8_STAGE(PG8_SB(0, 1), cB + hstep, voffB); PG8_STAGE(PG8_SA(0, 0), cA, voffA); PG8_STAGE(PG8_SA(0, 1), cA + hstep, voffA);
        if (wr == 1) PG8_BAR;
        PG8_WAIT_V(2); PG8_BAR;
        PG8_STAGE(PG8_SB(1, 0), cB + kstep, voffB); PG8_STAGE(PG8_SA(1, 0), cA + kstep, voffA); PG8_STAGE(PG8_SB(1, 1), cB + hstep + kstep, voffB);
        PG8_WAIT_V(6); PG8_BAR;
    }
    for (;;) {
        const bool has_next = S.next(ui + 1, nxt);
        const char* nA = has_next ? (const char*)g.A + (size_t)nxt.pm * tstep : cA; const char* nB = has_next ? (const char*)g.Bt + (size_t)nxt.pn * tstep : cB;
        for (int t = 0; t < nt; t += 2) {
            const bool last = (t == nt - 2);
            const char* a1 = cA + (size_t)(t + 1) * kstep;
            const char* a2 = last ? nA : cA + (size_t)(t + 2) * kstep; const char* b2 = last ? nB : cB + (size_t)(t + 2) * kstep;
            const char* a3 = a2 + kstep; const char* b3 = b2 + kstep;
            PG8_LDB(B0, 0, 0); PG8_LDB(B1, 0, 1); PG8_SCHED; PG8_LDA(At, 0, 0); PG8_STAGE(PG8_SA(1, 1), a1 + hstep, voffA);
            PG8_WAIT_V(8); PG8_WAIT_L(0); PG8_BAR; PG8_MMA(0, 0, At, B0); PG8_MMA(0, 1, At, B1); PG8_BAR; PG8_SCHED;
            PG8_LDA(At, 0, 1); PG8_STAGE(PG8_SB(0, 0), b2, voffB); PG8_STAGE(PG8_SB(0, 1), b2 + hstep, voffB); PG8_STAGE(PG8_SA(0, 0), a2, voffA);
            PG8_WAIT_V(8); PG8_WAIT_L(0); PG8_BAR; PG8_MMA(1, 0, At, B0); PG8_MMA(1, 1, At, B1); PG8_BAR; PG8_SCHED;
            PG8_LDB(B0, 1, 0); PG8_LDB(B1, 1, 1); PG8_SCHED; PG8_LDA(At, 1, 0); PG8_STAGE(PG8_SA(0, 1), a2 + hstep, voffA);
            PG8_WAIT_V(8); PG8_WAIT_L(0); PG8_BAR; PG8_MMA(0, 0, At, B0); PG8_MMA(0, 1, At, B1); PG8_BAR; PG8_SCHED;
            PG8_LDA(At, 1, 1); PG8_STAGE(PG8_SB(1, 0), b3, voffB); PG8_STAGE(PG8_SB(1, 1), b3 + hstep, voffB); PG8_STAGE(PG8_SA(1, 0), a3, voffA);
            PG8_WAIT_V(8); PG8_WAIT_L(0); PG8_BAR; PG8_MMA(1, 0, At, B0); PG8_MMA(1, 1, At, B1); PG8_BAR; PG8_SCHED;
        }
        if (wr == 0) PG8_BAR;
        E(acc, cur, wr, wc, fr, fq);
        if (!has_next) break;
#pragma unroll
        for (int a = 0; a < 2; ++a)
#pragma unroll
            for (int b = 0; b < 2; ++b)
#pragma unroll
                for (int m = 0; m < 4; ++m)
#pragma unroll
                    for (int n = 0; n < 2; ++n) acc[a][b][m][n] = (f32x4){0.f, 0.f, 0.f, 0.f};
        cur = nxt; cA = nA; cB = nB; ++ui;
        if (wr == 1) PG8_BAR;
    }
    PG8_WAIT_V(0);
    PG8_BAR;
#undef PG8_SA
#undef PG8_SB
#undef PG8_STAGE
#undef PG8_LDA
#undef PG8_LDB
#undef PG8_MMA
#undef PG8_WAIT_V
#undef PG8_WAIT_L
#undef PG8_BAR
#undef PG8_SCHED
}

struct EpiScaleBf16 {
    bf16_t* O; int ldc; const float* rowss; bf16_t* O2; int ldc2; int split_tile; bf16_t* KD2;
    __device__ __forceinline__ void operator()(const f32x4 (&acc)[2][2][4][2], const Unit& u, int wr, int wc, int fr, int fq) const {
        const bool hi = u.pn >= split_tile, mid = (split_tile == 8) && u.pn >= 4 && u.pn < 8;
        const int row0 = u.pm * BM + wr * 64 + fr, col0 = (hi ? u.pn - split_tile : u.pn) * BM + wc * 32 + 8 * fq;
        bf16_t* const Ob = hi ? O2 : O; const int ld = hi ? ldc2 : ldc;
#pragma unroll
        for (int ai = 0; ai < 2; ++ai)
#pragma unroll
            for (int m = 0; m < 4; ++m) { const int row = row0 + ai * HALF + m * 16;
                const float sc = rowss ? row_rstd(rowss, row) : 1.f;
                bf16_t* rowp = Ob + (size_t)row * ld + col0;
#pragma unroll
                for (int bj = 0; bj < 2; ++bj) { const f32x4 v0 = acc[ai][bj][m][0] * sc, v1 = acc[ai][bj][m][1] * sc;
                    u32x4 w; w.x = pk2(v0[0], v0[1]); w.y = pk2(v0[2], v0[3]); w.z = pk2(v1[0], v1[1]); w.w = pk2(v1[2], v1[3]);
                    bf16_t* dst = rowp + bj * HALF;
                    if (mid) dst = KD2 + (u.pn >= 6 ? (size_t)8388608 : (size_t)0) + ((size_t)(((row >> 11) * 4 + 2 * (u.pn & 1) + bj) * 2048 + (row & 2047))) * 128 + wc * 32 + 8 * fq;
                    *(u32x4*)dst = w; } }
    }
};
struct EpiSwiGLU {
    bf16_t* O; const float* rowss;
    __device__ __forceinline__ void operator()(const f32x4 (&acc)[2][2][4][2], const Unit& u, int wr, int wc, int fr, int fq) const {
        const int row0 = u.pm * BM + wr * 64 + fr, col0 = u.pn * HALF + wc * 32 + 8 * fq;
#pragma unroll
        for (int ai = 0; ai < 2; ++ai)
#pragma unroll
            for (int m = 0; m < 4; ++m) { const int row = row0 + ai * HALF + m * 16;
                const float sc = row_rstd(rowss, row);
                float h[8];
#pragma unroll
                for (int n = 0; n < 2; ++n)
#pragma unroll
                    for (int j = 0; j < 4; ++j) { const float gt = acc[ai][0][m][n][j] * sc, up = acc[ai][1][m][n][j] * sc; h[n * 4 + j] = gt * __builtin_amdgcn_rcpf(1.f + __expf(-gt)) * up; }
                u32x4 w; w.x = pk2(h[0], h[1]); w.y = pk2(h[2], h[3]); w.z = pk2(h[4], h[5]); w.w = pk2(h[6], h[7]);
                *(u32x4*)(O + (size_t)row * DFF + col0) = w; }
    }
};
struct EpiResid {
    float* X; bf16_t* XB; float* rowss_next;
    __device__ __forceinline__ void operator()(const f32x4 (&acc)[2][2][4][2], const Unit& u, int wr, int wc, int fr, int fq) const {
        const int row0 = u.pm * BM + wr * 64 + fr, col0 = u.pn * BM + wc * 32 + 8 * fq;
#pragma unroll
        for (int ai = 0; ai < 2; ++ai)
#pragma unroll
            for (int m = 0; m < 4; ++m) { const int row = row0 + ai * HALF + m * 16; float ss = 0.f;
                float* xp = X + (size_t)row * DM + col0; bf16_t* bp = XB + (size_t)row * DM + col0;
#pragma unroll
                for (int bj = 0; bj < 2; ++bj) {
                    f32x4 x0 = *(f32x4*)(xp + bj * HALF), x1 = *(f32x4*)(xp + bj * HALF + 4);
                    x0 = x0 + acc[ai][bj][m][0]; x1 = x1 + acc[ai][bj][m][1];
                    *(f32x4*)(xp + bj * HALF) = x0; *(f32x4*)(xp + bj * HALF + 4) = x1;
                    ss += (x0[0] * x0[0] + x0[1] * x0[1]) + (x0[2] * x0[2] + x0[3] * x0[3]) + (x1[0] * x1[0] + x1[1] * x1[1]) + (x1[2] * x1[2] + x1[3] * x1[3]);
                    u32x4 w; w.x = pk2(x0[0], x0[1]); w.y = pk2(x0[2], x0[3]); w.z = pk2(x1[0], x1[1]); w.w = pk2(x1[2], x1[3]);
                    *(u32x4*)(bp + bj * HALF) = w; }
                ss += __shfl_xor(ss, 16); ss += __shfl_xor(ss, 32);
                if (fq == 0) rowss_next[(size_t)row * 16 + u.pn * 4 + wc] = ss; }
    }
};
}

struct KArgs { const float* in[31]; float* out; unsigned char* ws; };
#define CAS __attribute__((address_space(4)))
struct InProxy { const CAS unsigned long long* k; __device__ __forceinline__ const float* operator[](int i) const { return (const float*)k[i]; } };
struct Params { InProxy in; float* out; unsigned char* ws; };
__device__ __forceinline__ Params make_params() {
    unsigned long long kv = (unsigned long long)__builtin_amdgcn_kernarg_segment_ptr();
    asm volatile("" : "+s"(kv));
    const CAS unsigned long long* k = (const CAS unsigned long long*)kv;
    Params p; p.in.k = k; p.out = (float*)k[31]; p.ws = (unsigned char*)k[32]; return p;
}

struct Frame {
    LAS unsigned char* lds;
    int tid, lane, wave, G, bid;
};

#define REFRAME(F) do { int _t = threadIdx.x; asm volatile("" : "+v"(_t)); (F).tid = _t; (F).lane = _t & 63; (F).wave = __builtin_amdgcn_readfirstlane(_t >> 6); } while (0)
__device__ __forceinline__ void cvt_item(const float* W_, int K, int ldn, int nblk, bf16_t* WT_, const float* gain_, bool perm_gu, LAS float* scr, int item, int lane) {
    const GAS float* W = (const GAS float*)W_; const GAS float* gain = (const GAS float*)gain_; GAS bf16_t* WT = (GAS bf16_t*)WT_;
    const int kb = item / nblk, nb = item % nblk, k0 = 64 * kb, n0d = 32 * nb;
    const int n0s = perm_gu ? (((n0d & 255) >> 7) * DFF + (n0d >> 8) * 128 + (n0d & 127)) : n0d;
    float v[32];
#pragma unroll
    for (int i = 0; i < 32; ++i) v[i] = W[(size_t)(k0 + 2 * i + (lane >> 5)) * ldn + n0s + (lane & 31)];
    if (gain_) {
#pragma unroll
        for (int i = 0; i < 32; ++i) v[i] *= gain[k0 + 2 * i + (lane >> 5)];
    }
#pragma unroll
    for (int i = 0; i < 32; ++i) scr[(2 * i + (lane >> 5)) * 33 + (lane & 31)] = v[i];
    asm volatile("s_waitcnt lgkmcnt(0)" ::: "memory");
    const int c = lane & 7;
#pragma unroll
    for (int j = 0; j < 4; ++j) { const int n = (lane >> 3) + 8 * j; const LAS float* sp = scr + (8 * c) * 33 + n;
        u32x4 o; o.x = pk2(sp[0 * 33], sp[1 * 33]); o.y = pk2(sp[2 * 33], sp[3 * 33]); o.z = pk2(sp[4 * 33], sp[5 * 33]); o.w = pk2(sp[6 * 33], sp[7 * 33]);
        *(GAS u32x4*)(WT + (size_t)(n0d + n) * K + k0 + 8 * c) = o; }
    asm volatile("s_waitcnt lgkmcnt(0)" ::: "memory");
}
constexpr int CV_IN = 1536, CV_OUT = 512, CV_Q = 256, CV_KV = 512, CV_O = 256, CV_GU = 2816, CV_DOWN = 1408, CV_L = 8;
constexpr int CV_TOTAL = CV_IN + CV_OUT + CV_Q + CV_KV + CV_O + CV_GU + CV_DOWN + 2 * CV_L + 2 * CV_L + 16;

static_assert(CV_TOTAL % 8 == 0, "conversion items per layer");
constexpr int CV_A = CV_IN + 2 * CV_L + 2 * CV_L + 16, CV_B = CV_KV + CV_OUT + CV_Q + CV_O + CV_GU + CV_DOWN;
static_assert(CV_A % 8 == 0 && CV_B % 8 == 0 && CV_A + CV_B == CV_TOTAL, "conversion lists");
__device__ __forceinline__ void cvt_item_a(const Params& p, int l, bf16_t* wb, LAS float* scr, int it, int lane) {
    int r = it;
    if (r < CV_IN) { cvt_item(p.in[3] + (size_t)l * DM * INW, DM, INW, INW / 32, wb + WO_IN, p.in[2] + l * DM, false, scr, r, lane); return; } r -= CV_IN;
    if (r < 2 * CV_L) { const int d = r / CV_L; cvt_item(p.in[12] + ((size_t)l * 2 + d) * 64 * 256, 64, 256, 8, wb + WO_WUP + d * 256 * 64, nullptr, false, scr, r % CV_L, lane); return; } r -= 2 * CV_L;
    if (r < 2 * CV_L) { const int d = r / CV_L; cvt_item(p.in[14] + ((size_t)l * 2 + d) * 64 * 256, 64, 256, 8, wb + WO_AUP + d * 256 * 64, nullptr, false, scr, r % CV_L, lane); return; } r -= 2 * CV_L;
    cvt_item(p.in[15] + (size_t)l * 128 * 256, 128, 256, 8, wb + WO_GUP, nullptr, false, scr, r, lane);
}
__device__ __forceinline__ void cvt_item_b(const Params& p, int l, bf16_t* wb, LAS float* scr, int it, int lane) {
    int r = it;
    if (r < CV_KV) { cvt_item(p.in[25] + (size_t)l * DM * 1024, DM, 1024, 32, wb + WO_KV, nullptr, false, scr, r, lane); return; } r -= CV_KV;
    if (r < CV_OUT) { cvt_item(p.in[21] + (size_t)l * DM * DM, DM, DM, DM / 32, wb + WO_OUT, nullptr, false, scr, r, lane); return; } r -= CV_OUT;
    if (r < CV_Q) { cvt_item(p.in[24] + (size_t)l * DM * XW, DM, XW, XW / 32, wb + WO_Q, p.in[22] + l * DM, false, scr, r, lane); return; } r -= CV_Q;
    if (r < CV_O) { cvt_item(p.in[26] + (size_t)l * XW * DM, XW, DM, 32, wb + WO_O, nullptr, false, scr, r, lane); return; } r -= CV_O;
    if (r < CV_GU) { cvt_item(p.in[28] + (size_t)l * DM * 2 * DFF, DM, 2 * DFF, 2 * DFF / 32, wb + WO_GU, p.in[27] + l * DM, true, scr, r, lane); return; } r -= CV_GU;
    cvt_item(p.in[29] + (size_t)l * DFF * DM, DFF, DM, 32, wb + WO_DOWN, nullptr, false, scr, r, lane);
}

__device__ __forceinline__ s16x4 vtr(const LAS unsigned char* p) { return __builtin_bit_cast(s16x4, __builtin_amdgcn_ds_read_tr16_b64_v4i16((LAS v4i16_t*)p)); }
__device__ __forceinline__ int crow(int r, int hi) { return (r & 3) + 8 * (r >> 2) + 4 * hi; }

template <int W> __device__ __forceinline__ void tile_load(u32x4 (&r)[W / 64], const bf16_t* g, int pitch, int tid) {
#pragma unroll
    for (int i = 0; i < W / 64; ++i) { const int id = tid + i * 512, row = id / (W / 8), ch = id % (W / 8); r[i] = *(const GAS u32x4*)((const GAS bf16_t*)g + (size_t)row * pitch + ch * 8); }
}
template <int W, int STR> __device__ __forceinline__ void tile_store(const u32x4 (&r)[W / 64], LAS unsigned char* buf, int tid) {
#pragma unroll
    for (int i = 0; i < W / 64; ++i) { const int id = tid + i * 512, row = id / (W / 8), ch = id % (W / 8); *(LAS u32x4*)(buf + row * STR + ch * 16) = r[i]; }
}
template <int DQK> __device__ __forceinline__ void load_q(bf16x8 (&qf)[DQK / 16], const bf16_t* qrow, int h, float sc) {
#pragma unroll
    for (int ks = 0; ks < DQK / 16; ++ks) { const u32x4 v = *(const GAS u32x4*)((const GAS bf16_t*)qrow + 16 * ks + 8 * h);
        u32x4 o; o.x = pk2(bflo(v.x) * sc, bfhi(v.x) * sc); o.y = pk2(bflo(v.y) * sc, bfhi(v.y) * sc); o.z = pk2(bflo(v.z) * sc, bfhi(v.z) * sc); o.w = pk2(bflo(v.w) * sc, bfhi(v.w) * sc);
        qf[ks] = __builtin_bit_cast(bf16x8, o); }
}
template <int DQK, int KW, int DV, int MODE>
__device__ __forceinline__ void attn_loop(LAS unsigned char* lds, const bf16_t* Kg, int kpitch, const bf16_t* Vg, int vpitch, int ntiles,
                                          const bf16x8 (&qf)[DQK / 16], int koff, float nslope2, int qrel, float& m, float& lsum, f32x16 (&o)[DV / 32]) {
    constexpr int KSTR = (KW + 8) * 2, VSTR = DV * 2 + 64, KBUF = 64 * KSTR, VBUF = 64 * VSTR;
    int tid_ = threadIdx.x; asm volatile("" : "+v"(tid_));
    const int tid = tid_, lane = tid & 63, r = lane & 31, h = lane >> 5;
    LAS unsigned char* K0 = lds; LAS unsigned char* V0 = lds + 2 * KBUF;
    u32x4 kr[KW / 64], vr[DV / 64];
    tile_load<KW>(kr, Kg, kpitch, tid); tile_load<DV>(vr, Vg, vpitch, tid);
    tile_store<KW, KSTR>(kr, K0, tid); tile_store<DV, VSTR>(vr, V0, tid);
    __syncthreads();
    const int vlane = ((lane & 15) >> 2) * VSTR + (16 * ((lane >> 4) & 1) + 4 * (lane & 3)) * 2 + 4 * h * VSTR;
    for (int t = 0; t < ntiles; ++t) {
        const int cur = t & 1;
        if (t + 1 < ntiles) { tile_load<KW>(kr, Kg + (size_t)(t + 1) * 64 * kpitch, kpitch, tid); tile_load<DV>(vr, Vg + (size_t)(t + 1) * 64 * vpitch, vpitch, tid); }
        const LAS unsigned char* Kb = K0 + cur * KBUF + r * KSTR + (koff + 8 * h) * 2;
        const LAS unsigned char* Vb = V0 + cur * VBUF + vlane;
        f32x16 s0, s1;
#pragma unroll
        for (int i = 0; i < 16; ++i) { s0[i] = 0.f; s1[i] = 0.f; }
#pragma unroll
        for (int ks = 0; ks < DQK / 16; ++ks) {
            const bf16x8 k0 = *(const LAS bf16x8*)(Kb + ks * 32), k1 = *(const LAS bf16x8*)(Kb + 32 * KSTR + ks * 32);
            s0 = __builtin_amdgcn_mfma_f32_32x32x16_bf16(k0, qf[ks], s0, 0, 0, 0);
            s1 = __builtin_amdgcn_mfma_f32_32x32x16_bf16(k1, qf[ks], s1, 0, 0, 0);
        }
        float Aoff = 0.f;
        if (MODE >= 1) {
            const int qrel0 = __builtin_amdgcn_readfirstlane(qrel - r);
            const int T0 = t * 64;
            if (MODE == 1 && (T0 + 64 <= qrel0 || T0 > qrel0 + 31)) {
                const bool left = (T0 + 64 <= qrel0);
                const float sl = left ? -nslope2 : nslope2;
                Aoff = left ? nslope2 * (float)(qrel - T0 - 4 * h) : nslope2 * (float)(T0 + 4 * h - qrel);
#pragma unroll
                for (int i = 0; i < 16; ++i) { s0[i] = __builtin_fmaf(sl, (float)((i & 3) + 8 * (i >> 2)), s0[i]); s1[i] = __builtin_fmaf(sl, (float)(32 + (i & 3) + 8 * (i >> 2)), s1[i]); }
            } else {
                const float base = (float)(T0 + 4 * h - qrel);
#pragma unroll
                for (int i = 0; i < 16; ++i) {
                    const float d0 = fabsf(base + (float)((i & 3) + 8 * (i >> 2))), d1 = fabsf(base + (float)(32 + (i & 3) + 8 * (i >> 2)));
                    s0[i] = __builtin_fmaf(d0, nslope2, s0[i]); s1[i] = __builtin_fmaf(d1, nslope2, s1[i]);
                    if (MODE == 2) { if (d0 > 128.f) s0[i] = -1e30f; if (d1 > 128.f) s1[i] = -1e30f; }
                }
            }
        }
        float mx = fmaxf(s0[0], s1[0]);
#pragma unroll
        for (int i = 1; i < 16; ++i) mx = fmaxf(fmaxf(mx, s0[i]), s1[i]);
        mx += Aoff;
        mx = fmaxf(mx, xhalf(mx));
        const float mnew = fmaxf(m, mx);
        if (__builtin_amdgcn_ballot_w64(mnew > m) != 0ull) {
            const float alpha = __builtin_amdgcn_exp2f(m - mnew);
            lsum *= alpha;
#pragma unroll
            for (int d = 0; d < DV / 32; ++d) o[d] = o[d] * alpha;
        }
        m = mnew;
        const float mm = mnew - Aoff;
        float rs = 0.f;
#pragma unroll
        for (int i = 0; i < 16; ++i) { s0[i] = __builtin_amdgcn_exp2f(s0[i] - mm); s1[i] = __builtin_amdgcn_exp2f(s1[i] - mm); rs += s0[i] + s1[i]; }
        lsum += rs;
        bf16x8 pf[4];
#pragma unroll
        for (int s2 = 0; s2 < 2; ++s2) {
            u32x4 a, b;
            a.x = pk2(s0[8 * s2 + 0], s0[8 * s2 + 1]); a.y = pk2(s0[8 * s2 + 2], s0[8 * s2 + 3]); a.z = pk2(s0[8 * s2 + 4], s0[8 * s2 + 5]); a.w = pk2(s0[8 * s2 + 6], s0[8 * s2 + 7]);
            b.x = pk2(s1[8 * s2 + 0], s1[8 * s2 + 1]); b.y = pk2(s1[8 * s2 + 2], s1[8 * s2 + 3]); b.z = pk2(s1[8 * s2 + 4], s1[8 * s2 + 5]); b.w = pk2(s1[8 * s2 + 6], s1[8 * s2 + 7]);
            pf[s2] = __builtin_bit_cast(bf16x8, a); pf[2 + s2] = __builtin_bit_cast(bf16x8, b);
        }
#pragma unroll
        for (int d = 0; d < DV / 32; ++d) {
#pragma unroll
            for (int kk = 0; kk < 4; ++kk) {
                const s16x4 lo = vtr(Vb + (16 * kk) * VSTR + d * 64), hi = vtr(Vb + (16 * kk + 8) * VSTR + d * 64);
                const bf16x8 vf = {lo[0], lo[1], lo[2], lo[3], hi[0], hi[1], hi[2], hi[3]};
                o[d] = __builtin_amdgcn_mfma_f32_32x32x16_bf16(vf, pf[kk], o[d], 0, 0, 0);
            }
        }
        if (t + 1 < ntiles) { tile_store<KW, KSTR>(kr, K0 + (cur ^ 1) * KBUF, tid); tile_store<DV, VSTR>(vr, V0 + (cur ^ 1) * VBUF, tid); }
        __syncthreads();
    }
}
__device__ __forceinline__ int swz(int row) { return ((row & 3) << 2) | ((row >> 2) & 3); }
template <int DQK, int MODE, int pitch, int voff>
__device__ __forceinline__ void attn_loop_dma(LAS unsigned char* lds, const int wave, const bf16_t* Kg, int ntiles,
                                              const bf16x8 (&qf)[DQK / 16], int koff, float nslope2, int qrel, float& m, float& lsum, f32x16 (&o)[4]) {
    constexpr int DV = 128, STAGE = 32768, VOFFB = 16384;
    const int lane = hw_lane(), r = lane & 31, h = lane >> 5;
    unsigned gk[2];
#pragma unroll
    for (int i = 0; i < 2; ++i) { const int row = 4 * (2 * wave + i) + (lane >> 4), c = (lane & 15) ^ swz(row); gk[i] = (unsigned)(row * pitch + c * 8); }
    unsigned kad[DQK / 16], vad[4][2];
#pragma unroll
    for (int ks = 0; ks < DQK / 16; ++ks) kad[ks] = (unsigned)(r * 256 + 16 * (((koff >> 3) + 2 * ks + h) ^ swz(r)));
    { const int q_ = (lane & 15) >> 2, pp = lane & 3, g1 = (lane >> 4) & 1;
#pragma unroll
      for (int d = 0; d < 4; ++d)
#pragma unroll
          for (int hi = 0; hi < 2; ++hi) { const int f = (q_ << 2) | ((2 * hi + h) & 3), c = (4 * d + 2 * g1 + (pp >> 1)) ^ f;
              vad[d][hi] = (unsigned)(VOFFB + (4 * h + q_) * 256 + 16 * c + 8 * (pp & 1) + hi * 2048); } }
#define ATT_DMA(tt, st) do { const bf16_t* kg_ = Kg + (size_t)(tt) * 64 * pitch; _Pragma("unroll") for (int i_ = 0; i_ < 2; ++i_) { \
        __builtin_amdgcn_global_load_lds((const unsigned*)(kg_ + gk[i_]), (LAS unsigned*)(lds + (st) * STAGE + (2 * wave + i_) * 1024), 16, 0, 0); \
        __builtin_amdgcn_global_load_lds((const unsigned*)(kg_ + voff + gk[i_]), (LAS unsigned*)(lds + (st) * STAGE + VOFFB + (2 * wave + i_) * 1024), 16, 0, 0); } } while (0)
    ATT_DMA(0, 0);
    if (ntiles > 1) ATT_DMA(1, 1);
    if (ntiles > 2) { ATT_DMA(2, 2); asm volatile("s_waitcnt vmcnt(4)" ::: "memory"); } else asm volatile("s_waitcnt vmcnt(0)" ::: "memory");
    __builtin_amdgcn_s_barrier();
    f32x16 s0, s1;
#pragma unroll
    for (int i = 0; i < 16; ++i) { s0[i] = 0.f; s1[i] = 0.f; }
#pragma unroll
    for (int ks = 0; ks < DQK / 16; ++ks) {
        const bf16x8 k0 = *(const LAS bf16x8*)(lds + kad[ks]), k1 = *(const LAS bf16x8*)(lds + kad[ks] + 8192);
        s0 = __builtin_amdgcn_mfma_f32_32x32x16_bf16(k0, qf[ks], s0, 0, 0, 0);
        s1 = __builtin_amdgcn_mfma_f32_32x32x16_bf16(k1, qf[ks], s1, 0, 0, 0);
    }
#define LDS_RD128(dst, addr, off) asm volatile("ds_read_b128 %0, %1 offset:%c2" : "=&v"(dst) : "v"(addr), "i"(off) : "memory")
#define LDS_RDTR(dst, addr, off) asm volatile("ds_read_b64_tr_b16 %0, %1 offset:%c2" : "=&v"(dst) : "v"(addr), "i"(off) : "memory")
#define LDS_WAIT0() do { asm volatile("s_waitcnt lgkmcnt(0)" ::: "memory"); __builtin_amdgcn_sched_barrier(0); } while (0)
    for (int t = 0; t < ntiles; ++t) {
        if (t + 3 < ntiles) ATT_DMA(t + 3, (t + 3) & 3);
        const unsigned sba = (unsigned)(size_t)(lds + (t & 3) * STAGE), sna = (unsigned)(size_t)(lds + ((t + 1) & 3) * STAGE);
        constexpr int KH = (DQK == 64) ? 4 : 4;
        bf16x8 kf0[KH], kf1[KH];
        s16x4 va_lo[4], va_hi[4], vb_lo[4], vb_hi[4];
        if (DQK == 64) {
#pragma unroll
            for (int ks = 0; ks < KH; ++ks) { const unsigned ka = sna + kad[ks]; LDS_RD128(kf0[ks], ka, 0); } }
        __builtin_amdgcn_sched_barrier(0);
        float Aoff = 0.f;
        if (MODE >= 1) {
            const int qrel0 = __builtin_amdgcn_readfirstlane(qrel - r);
            const int T0 = t * 64;
            if (MODE == 1 && (T0 + 64 <= qrel0 || T0 > qrel0 + 31)) {
                const bool left = (T0 + 64 <= qrel0);
                const float sl = left ? -nslope2 : nslope2;
                Aoff = left ? nslope2 * (float)(qrel - T0 - 4 * h) : nslope2 * (float)(T0 + 4 * h - qrel);
#pragma unroll
                for (int i = 0; i < 16; ++i) { s0[i] = __builtin_fmaf(sl, (float)((i & 3) + 8 * (i >> 2)), s0[i]); s1[i] = __builtin_fmaf(sl, (float)(32 + (i & 3) + 8 * (i >> 2)), s1[i]); }
            } else {
                const float base = (float)(T0 + 4 * h - qrel);
#pragma unroll
                for (int i = 0; i < 16; ++i) {
                    const float d0 = fabsf(base + (float)((i & 3) + 8 * (i >> 2))), d1 = fabsf(base + (float)(32 + (i & 3) + 8 * (i >> 2)));
                    s0[i] = __builtin_fmaf(d0, nslope2, s0[i]); s1[i] = __builtin_fmaf(d1, nslope2, s1[i]);
                    if (MODE == 2) { if (d0 > 128.f) s0[i] = -1e30f; if (d1 > 128.f) s1[i] = -1e30f; }
                }
            }
        }
        float mx = fmaxf(s0[0], s1[0]);
#pragma unroll
        for (int i = 1; i < 16; ++i) mx = fmaxf(fmaxf(mx, s0[i]), s1[i]);
        mx += Aoff;
        mx = fmaxf(mx, xhalf(mx));
        const float mnew = fmaxf(m, mx);
        if (__builtin_amdgcn_ballot_w64(mnew > m) != 0ull) {
            const float alpha = __builtin_amdgcn_exp2f(m - mnew);
            lsum *= alpha;
#pragma unroll
            for (int d = 0; d < DV / 32; ++d) o[d] = o[d] * alpha;
        }
        m = mnew;
        const float mm = mnew - Aoff;
        float rs = 0.f;
#pragma unroll
        for (int i = 0; i < 16; ++i) { s0[i] = __builtin_amdgcn_exp2f(s0[i] - mm); s1[i] = __builtin_amdgcn_exp2f(s1[i] - mm); rs += s0[i] + s1[i]; }
        lsum += rs;
        bf16x8 pf[4];
#pragma unroll
        for (int s2 = 0; s2 < 2; ++s2) {
            u32x4 a, b;
            a.x = pk2(s0[8 * s2 + 0], s0[8 * s2 + 1]); a.y = pk2(s0[8 * s2 + 2], s0[8 * s2 + 3]); a.z = pk2(s0[8 * s2 + 4], s0[8 * s2 + 5]); a.w = pk2(s0[8 * s2 + 6], s0[8 * s2 + 7]);
            b.x = pk2(s1[8 * s2 + 0], s1[8 * s2 + 1]); b.y = pk2(s1[8 * s2 + 2], s1[8 * s2 + 3]); b.z = pk2(s1[8 * s2 + 4], s1[8 * s2 + 5]); b.w = pk2(s1[8 * s2 + 6], s1[8 * s2 + 7]);
            pf[s2] = __builtin_bit_cast(bf16x8, a); pf[2 + s2] = __builtin_bit_cast(bf16x8, b);
        }
        LDS_WAIT0();
        if (DQK == 64) {
#pragma unroll
            for (int ks = 0; ks < KH; ++ks) { const unsigned ka = sna + kad[ks]; LDS_RD128(kf1[ks], ka, 8192); } }
        { const unsigned alo = sba + vad[0][0], ahi = sba + vad[0][1];
#pragma unroll
          for (int kk = 0; kk < 4; ++kk) { LDS_RDTR(va_lo[kk], alo, kk * 4096); LDS_RDTR(va_hi[kk], ahi, kk * 4096); } }
        __builtin_amdgcn_sched_barrier(0);
        f32x16 n0, n1;
#pragma unroll
        for (int i = 0; i < 16; ++i) { n0[i] = 0.f; n1[i] = 0.f; }
#pragma unroll
        for (int g = 0; g < DQK / 64; ++g) {
            if (DQK != 64) {
#pragma unroll
                for (int ks = 0; ks < KH; ++ks) { const unsigned ka = sna + kad[g * KH + ks]; LDS_RD128(kf0[ks], ka, 0); LDS_RD128(kf1[ks], ka, 8192); }
                LDS_WAIT0(); }
#pragma unroll
            for (int ks = 0; ks < KH; ++ks) n0 = __builtin_amdgcn_mfma_f32_32x32x16_bf16(kf0[ks], qf[g * KH + ks], n0, 0, 0, 0);
            if (DQK == 64) LDS_WAIT0();
#pragma unroll
            for (int ks = 0; ks < KH; ++ks) n1 = __builtin_amdgcn_mfma_f32_32x32x16_bf16(kf1[ks], qf[g * KH + ks], n1, 0, 0, 0);
        }
#define PV_BLOCK(d, lo, hi) do { _Pragma("unroll") for (int kk = 0; kk < 4; ++kk) { const bf16x8 vf = {lo[kk][0], lo[kk][1], lo[kk][2], lo[kk][3], hi[kk][0], hi[kk][1], hi[kk][2], hi[kk][3]}; \
            o[d] = __builtin_amdgcn_mfma_f32_32x32x16_bf16(vf, pf[kk], o[d], 0, 0, 0); } } while (0)
#define V_ISSUE(d, lo, hi) do { const unsigned alo_ = sba + vad[d][0], ahi_ = sba + vad[d][1]; _Pragma("unroll") for (int kk = 0; kk < 4; ++kk) { LDS_RDTR(lo[kk], alo_, kk * 4096); LDS_RDTR(hi[kk], ahi_, kk * 4096); } } while (0)
        LDS_WAIT0();
        V_ISSUE(1, vb_lo, vb_hi); __builtin_amdgcn_sched_barrier(0);
        PV_BLOCK(0, va_lo, va_hi);
        LDS_WAIT0();
        V_ISSUE(2, va_lo, va_hi); __builtin_amdgcn_sched_barrier(0);
        PV_BLOCK(1, vb_lo, vb_hi);
        LDS_WAIT0();
        V_ISSUE(3, vb_lo, vb_hi); __builtin_amdgcn_sched_barrier(0);
        PV_BLOCK(2, va_lo, va_hi);
        LDS_WAIT0();
        PV_BLOCK(3, vb_lo, vb_hi);
#undef PV_BLOCK
#undef V_ISSUE
        s0 = n0; s1 = n1;
        if (t + 3 < ntiles) asm volatile("s_waitcnt vmcnt(4)" ::: "memory"); else asm volatile("s_waitcnt vmcnt(0)" ::: "memory");
        __builtin_amdgcn_s_barrier();
    }
#undef LDS_RD128
#undef LDS_RDTR
#undef LDS_WAIT0
#undef ATT_DMA
}
template <int DV> __device__ __forceinline__ void store_o(const f32x16 (&o)[DV / 32], float sc, bf16_t* orow, int h) {
#pragma unroll
    for (int d = 0; d < DV / 32; ++d)
#pragma unroll
        for (int g4 = 0; g4 < 4; ++g4) { u32x2 w; w.x = pk2(o[d][4 * g4] * sc, o[d][4 * g4 + 1] * sc); w.y = pk2(o[d][4 * g4 + 2] * sc, o[d][4 * g4 + 3] * sc);
            *(GAS u32x2*)((GAS bf16_t*)orow + 32 * d + 8 * g4 + 4 * h) = w; }
}

__device__ __forceinline__ void win_unit(Frame& F, const Params& p, int l, int u) {
    REFRAME(F);
    const bf16_t* Z = (const bf16_t*)(p.ws + WS_Z); bf16_t* MIX = (bf16_t*)(p.ws + WS_MIX);
    const int b = u >> 5, kvh = (u >> 4) & 1, nb = u & 15, r = F.lane & 31, h = F.lane >> 5;
    const int g = F.wave >> 2, hq = kvh * 2 + g, qpos = nb * 128 + (F.wave & 3) * 32 + r;
    const size_t tok = (size_t)b * SEQ + qpos;
    bf16x8 qf[4]; load_q<64>(qf, Z + tok * ZP + hq * 64, h, 0.125f * LOG2E);
    const int first = (2 * nb - 2 < 0) ? 0 : 2 * nb - 2, lastx = (2 * nb + 4 > 32) ? 32 : 2 * nb + 4, nt = lastx - first;
    const float slope = exp2f(-(float)(2 * hq + 1));
    float m = p.in[4][l * 4 + hq] * LOG2E, ls = (h == 0) ? 1.f : 0.f;
    f32x16 o[2];
#pragma unroll
    for (int d = 0; d < 2; ++d)
#pragma unroll
        for (int i = 0; i < 16; ++i) o[d][i] = 0.f;
    const bf16_t* Kg = Z + ((size_t)b * SEQ + first * 64) * ZP + 256 + kvh * 64;
    attn_loop<64, 64, 64, 2>(F.lds, Kg, ZP, Kg + 128, ZP, nt, qf, 0, -slope * LOG2E, qpos - first * 64, m, ls, o);
    const float lt = ls + xhalf(ls);
    store_o<64>(o, 1.f / lt, MIX + tok * DM + hq * 64, h);
}
__device__ __forceinline__ void diff_unit(Frame& F, const Params& p, int l, int u) {
    REFRAME(F);
    const bf16_t* Z = (const bf16_t*)(p.ws + WS_Z); bf16_t* MIX = (bf16_t*)(p.ws + WS_MIX);
    const int b = u >> 6, hh = (u >> 4) & 3, qb = u & 15, r = F.lane & 31, h = F.lane >> 5;
    const int c = F.wave >> 2, qpos = qb * 128 + (F.wave & 3) * 32 + r;
    const size_t tok = (size_t)b * SEQ + qpos;
    float lam, lam_init;
    {
        const float a1 = wave_sum(p.in[5][l * 64 + F.lane] * p.in[6][l * 64 + F.lane]), a2 = wave_sum(p.in[7][l * 64 + F.lane] * p.in[8][l * 64 + F.lane]);
        lam_init = 0.8f - 0.6f * expf(-0.3f * (float)l);
        lam = expf(a1) - expf(a2) + lam_init;
    }
    bf16x8 qf[4]; load_q<64>(qf, Z + tok * ZP + 512 + hh * 128 + c * 64, h, 0.125f * LOG2E);
    const float slope = exp2f(-(float)(2 * hh + 2));
    float m = -1e30f, ls = 0.f;
    f32x16 o[4];
#pragma unroll
    for (int d = 0; d < 4; ++d)
#pragma unroll
        for (int i = 0; i < 16; ++i) o[d][i] = 0.f;
    const bf16_t* Kg = (const bf16_t*)(p.ws + WS_KD2) + (size_t)(b * 4 + hh) * 2048 * 128;
    attn_loop_dma<64, 1, 128, 8388608>(F.lds, F.wave, Kg, 32, qf, c * 64, -slope * LOG2E, qpos, m, ls, o);
    const float inv = 1.f / (ls + xhalf(ls));
    LAS float* comb = (LAS float*)F.lds + (size_t)(F.wave & 3) * 64 * 64 + F.lane;
    if (c == 1) {
#pragma unroll
        for (int d = 0; d < 4; ++d)
#pragma unroll
            for (int i = 0; i < 16; ++i) comb[(d * 16 + i) * 64] = o[d][i] * inv;
    }
    __syncthreads();
    if (c == 0) {
        float ss = 0.f;
#pragma unroll
        for (int d = 0; d < 4; ++d)
#pragma unroll
            for (int i = 0; i < 16; ++i) { const float a = o[d][i] * inv - lam * comb[(d * 16 + i) * 64]; o[d][i] = a; ss += a * a; }
        ss += xhalf(ss);
        const float rn = rsqrtf(ss * (1.f / 128.f) + 1e-6f) * (1.f - lam_init);
        const float* sg = p.in[9] + l * 128;
        bf16_t* orow = MIX + tok * DM + 256 + hh * 128;
        f32x4 ggv[4][4];
#pragma unroll
        for (int d = 0; d < 4; ++d)
#pragma unroll
            for (int g4 = 0; g4 < 4; ++g4) ggv[d][g4] = *(const GAS f32x4*)((const GAS float*)sg + 32 * d + 8 * g4 + 4 * h);
#pragma unroll
        for (int d = 0; d < 4; ++d)
#pragma unroll
            for (int g4 = 0; g4 < 4; ++g4) { const int dv = 32 * d + 8 * g4 + 4 * h; const f32x4 gg = ggv[d][g4];
                u32x2 w; w.x = pk2(o[d][4 * g4] * rn * gg[0], o[d][4 * g4 + 1] * rn * gg[1]); w.y = pk2(o[d][4 * g4 + 2] * rn * gg[2], o[d][4 * g4 + 3] * rn * gg[3]);
                *(GAS u32x2*)((GAS bf16_t*)orow + dv) = w; }
    }
    __syncthreads();
}
__device__ __forceinline__ void cross_unit(Frame& F, const Params& p, int u) {
    REFRAME(F);
    const bf16_t* Q = (const bf16_t*)(p.ws + WS_Q); const bf16_t* KV = (const bf16_t*)(p.ws + WS_KV); bf16_t* O = (bf16_t*)(p.ws + WS_O);
    const int b = u >> 5, hd = (u >> 3) & 3, qb = u & 7, r = F.lane & 31, h = F.lane >> 5;
    const size_t tok = (size_t)b * SEQ + qb * 256 + F.wave * 32 + r;
    bf16x8 qf[8]; load_q<128>(qf, Q + tok * XW + hd * 128, h, 0.08838834764831845f * LOG2E);
    float m = -1e30f, ls = 0.f;
    f32x16 o[4];
#pragma unroll
    for (int d = 0; d < 4; ++d)
#pragma unroll
        for (int i = 0; i < 16; ++i) o[d][i] = 0.f;
    const bf16_t* Kg = KV + ((size_t)b * NMEM) * 1024 + hd * 128;
    attn_loop_dma<128, 0, 1024, 512>(F.lds, F.wave, Kg, 4, qf, 0, 0.f, 0, m, ls, o);
    const float lt = ls + xhalf(ls);
    store_o<128>(o, 1.f / lt, O + tok * XW + hd * 128, h);
}

constexpr int CF_STR = 772, PREP_AW = 32 * CF_STR * 4, PREP_AA = PREP_AW + 32 * 72 * 2, PREP_AG = PREP_AA + 32 * 72 * 2;
__device__ __forceinline__ void prep_unit(Frame& F, const Params& p, int l, const bf16_t* wb, int u) {
    REFRAME(F);
    const bf16_t* ZC = (const bf16_t*)(p.ws + WS_ZC);
    const int t0 = u * 32, b = t0 / SEQ;
    LAS float* CF = (LAS float*)F.lds; LAS bf16_t* AW = (LAS bf16_t*)(F.lds + PREP_AW); LAS bf16_t* AA = (LAS bf16_t*)(F.lds + PREP_AA); LAS bf16_t* AG = (LAS bf16_t*)(F.lds + PREP_AG);
    const float* conv = p.in[10] + (size_t)l * 3 * 1024;
    LAS float* PAR = (LAS float*)(F.lds + PREP_AG + 32 * 136 * 2);
    if (F.tid < 448) { const int i = F.tid; const GAS f32x4* src;
        if (i < 64) src = (const GAS f32x4*)((const GAS float*)p.in[16] + l * 256) + i;
        else if (i < 128) src = (const GAS f32x4*)((const GAS float*)p.in[17] + l * 256) + (i - 64);
        else if (i < 192) src = (const GAS f32x4*)((const GAS float*)p.in[18] + l * 256) + (i - 128);
        else if (i < 320) src = (const GAS f32x4*)((const GAS float*)p.in[11] + l * 512) + (i - 192);
        else src = (const GAS f32x4*)((const GAS float*)p.in[13] + l * 512) + (i - 320);
        ((LAS f32x4*)PAR)[i] = *src; }
#pragma unroll 4
    for (int i = 0; i < 8; ++i) {
        const int id = F.tid + i * 512, tk = id >> 7, ch = id & 127, tg = t0 + tk, tpos = tg - b * SEQ;
        const GAS bf16_t* zp = (const GAS bf16_t*)ZC + (size_t)tg * 1024 + ch * 8;
        const u32x4 zc = *(const GAS u32x4*)zp;
        u32x4 zl = {0u, 0u, 0u, 0u}, zr = {0u, 0u, 0u, 0u};
        if (tpos > 0) zl = *(const GAS u32x4*)(zp - 1024);
        if (tpos < SEQ - 1) zr = *(const GAS u32x4*)(zp + 1024);
        float v[8];
#pragma unroll
        for (int q = 0; q < 4; ++q) {
            const f32x2 c0 = *(const GAS f32x2*)((const GAS float*)conv + ch * 8 + 2 * q), c1 = *(const GAS f32x2*)((const GAS float*)conv + 1024 + ch * 8 + 2 * q), c2 = *(const GAS f32x2*)((const GAS float*)conv + 2048 + ch * 8 + 2 * q);
            v[2 * q] = bflo(zl[q]) * c0[0] + bflo(zc[q]) * c1[0] + bflo(zr[q]) * c2[0];
            v[2 * q + 1] = bfhi(zl[q]) * c0[1] + bfhi(zc[q]) * c1[1] + bfhi(zr[q]) * c2[1];
        }
        if (ch < 96) { *(LAS f32x4*)(CF + tk * CF_STR + ch * 8) = (f32x4){v[0], v[1], v[2], v[3]}; *(LAS f32x4*)(CF + tk * CF_STR + ch * 8 + 4) = (f32x4){v[4], v[5], v[6], v[7]}; }
        else {
            u32x4 w;
            if (ch < 104) {
#pragma unroll
                for (int q = 0; q < 8; ++q) v[q] = 1.f - 2.f * __builtin_amdgcn_rcpf(__expf(2.f * v[q]) + 1.f);
                w.x = pk2(v[0], v[1]); w.y = pk2(v[2], v[3]); w.z = pk2(v[4], v[5]); w.w = pk2(v[6], v[7]);
                *(LAS u32x4*)(AW + tk * 72 + (ch - 96) * 8) = w;
            } else if (ch < 112) {
                w.x = pk2(v[0], v[1]); w.y = pk2(v[2], v[3]); w.z = pk2(v[4], v[5]); w.w = pk2(v[6], v[7]);
                *(LAS u32x4*)(AA + tk * 72 + (ch - 104) * 8) = w;
            } else {
#pragma unroll
                for (int q = 0; q < 8; ++q) v[q] = sigmoidf_(v[q]);
                w.x = pk2(v[0], v[1]); w.y = pk2(v[2], v[3]); w.z = pk2(v[4], v[5]); w.w = pk2(v[6], v[7]);
                *(LAS u32x4*)(AG + tk * 136 + (ch - 112) * 8) = w;
            }
        }
    }
    __syncthreads();
    const int hh = F.wave & 3, dir = F.wave >> 2, tk = F.lane & 31, h2 = F.lane >> 5;
    const size_t tok = (size_t)t0 + tk;
    const GAS bf16_t* Wup = (const GAS bf16_t*)wb + WO_WUP + (size_t)(dir * 256 + hh * 64) * 64;
    const GAS bf16_t* Aup = (const GAS bf16_t*)wb + WO_AUP + (size_t)(dir * 256 + hh * 64) * 64;
    f32x16 aw[2], aa[2];
#pragma unroll
    for (int rb = 0; rb < 2; ++rb)
#pragma unroll
        for (int i = 0; i < 16; ++i) { aw[rb][i] = 0.f; aa[rb][i] = 0.f; }
#pragma unroll
    for (int ks = 0; ks < 4; ++ks) {
        const bf16x8 bw = *(const LAS bf16x8*)(AW + tk * 72 + 16 * ks + 8 * h2), ba = *(const LAS bf16x8*)(AA + tk * 72 + 16 * ks + 8 * h2);
#pragma unroll
        for (int rb = 0; rb < 2; ++rb) {
            const bf16x8 fw = *(const GAS bf16x8*)(Wup + (size_t)(rb * 32 + tk) * 64 + 16 * ks + 8 * h2), fa = *(const GAS bf16x8*)(Aup + (size_t)(rb * 32 + tk) * 64 + 16 * ks + 8 * h2);
            aw[rb] = __builtin_amdgcn_mfma_f32_32x32x16_bf16(fw, bw, aw[rb], 0, 0, 0);
            aa[rb] = __builtin_amdgcn_mfma_f32_32x32x16_bf16(fa, ba, aa[rb], 0, 0, 0);
        }
    }
    const LAS float* k_k = PAR + hh * 64; const LAS float* k_a = PAR + 256 + hh * 64; const LAS float* r_k = PAR + 512 + hh * 64;
    const LAS float* w0 = PAR + 768 + dir * 256 + hh * 64; const LAS float* a0 = PAR + 1280 + dir * 256 + hh * 64;
    float ssq = 0.f;
#pragma unroll
    for (int rb = 0; rb < 2; ++rb)
#pragma unroll
        for (int g4 = 0; g4 < 4; ++g4) { const int c0 = rb * 32 + 8 * g4 + 4 * h2;
            const f32x4 kv = *(const LAS f32x4*)(CF + tk * CF_STR + 256 + hh * 64 + c0), kkw = *(const LAS f32x4*)(k_k + c0);
            const f32x4 q = kv * kkw; ssq += (q[0] * q[0] + q[1] * q[1]) + (q[2] * q[2] + q[3] * q[3]); }
    ssq += xhalf(ssq);
    const float kinv = 1.f / fmaxf(sqrtf(ssq), 1e-12f);
    float bon = 0.f;
    GAS bf16_t* OM = (GAS bf16_t*)(p.ws + WS_OM) + ((size_t)dir * MTOK + tok) * 256 + hh * 64;
    GAS bf16_t* KA = (GAS bf16_t*)(p.ws + WS_KA) + ((size_t)dir * MTOK + tok) * 256 + hh * 64;
    GAS bf16_t* KD = (GAS bf16_t*)(p.ws + WS_KD) + ((size_t)dir * MTOK + tok) * 256 + hh * 64;
    GAS bf16_t* KK = (GAS bf16_t*)(p.ws + WS_KK) + tok * 256 + hh * 64;
    GAS bf16_t* VV = (GAS bf16_t*)(p.ws + WS_V) + tok * 256 + hh * 64;
    GAS bf16_t* RR = (GAS bf16_t*)(p.ws + WS_R) + tok * 256 + hh * 64;
#pragma unroll
    for (int rb = 0; rb < 2; ++rb)
#pragma unroll
        for (int g4 = 0; g4 < 4; ++g4) { const int c0 = rb * 32 + 8 * g4 + 4 * h2;
            const f32x4 kv = *(const LAS f32x4*)(CF + tk * CF_STR + 256 + hh * 64 + c0), rv = *(const LAS f32x4*)(CF + tk * CF_STR + hh * 64 + c0);
            const f32x4 kkw = *(const LAS f32x4*)(k_k + c0), kaw = *(const LAS f32x4*)(k_a + c0), rkw = *(const LAS f32x4*)(r_k + c0), w0v = *(const LAS f32x4*)(w0 + c0), a0v = *(const LAS f32x4*)(a0 + c0);
            float om[4], ka[4], kd[4], kk[4];
#pragma unroll
            for (int j = 0; j < 4; ++j) {
                const float wp = aw[rb][4 * g4 + j] + w0v[j], ap = aa[rb][4 * g4 + j] + a0v[j];
                om[j] = 1.f - __expf(-0.6065306597126334f * sigmoidf_(wp));
                const float a = sigmoidf_(ap);
                kk[j] = kv[j] * kkw[j] * kinv; ka[j] = kk[j] * a; kd[j] = kv[j] * (1.f + (a - 1.f) * kaw[j]);
                bon += rv[j] * kd[j] * rkw[j];
            }
            u32x2 w; w.x = pk2(om[0], om[1]); w.y = pk2(om[2], om[3]); *(GAS u32x2*)(OM + c0) = w;
            w.x = pk2(ka[0], ka[1]); w.y = pk2(ka[2], ka[3]); *(GAS u32x2*)(KA + c0) = w;
            w.x = pk2(kd[0], kd[1]); w.y = pk2(kd[2], kd[3]); *(GAS u32x2*)(KD + c0) = w;
            if (dir == 0) {
                const f32x4 vv = *(const LAS f32x4*)(CF + tk * CF_STR + 512 + hh * 64 + c0);
                w.x = pk2(kk[0], kk[1]); w.y = pk2(kk[2], kk[3]); *(GAS u32x2*)(KK + c0) = w;
                w.x = pk2(vv[0], vv[1]); w.y = pk2(vv[2], vv[3]); *(GAS u32x2*)(VV + c0) = w;
                w.x = pk2(rv[0], rv[1]); w.y = pk2(rv[2], rv[3]); *(GAS u32x2*)(RR + c0) = w;
            }
        }
    bon += xhalf(bon);
    if (h2 == 0) ((GAS float*)(p.ws + WS_BON))[((size_t)dir * MTOK + tok) * 4 + hh] = bon;
    {
        const GAS bf16_t* Gup = (const GAS bf16_t*)wb + WO_GUP + (size_t)(F.wave * 32 + tk) * 128;
        f32x16 ag;
#pragma unroll
        for (int i = 0; i < 16; ++i) ag[i] = 0.f;
#pragma unroll
        for (int ks = 0; ks < 8; ++ks) {
            const bf16x8 bg = *(const LAS bf16x8*)(AG + tk * 136 + 16 * ks + 8 * h2), fg = *(const GAS bf16x8*)(Gup + 16 * ks + 8 * h2);
            ag = __builtin_amdgcn_mfma_f32_32x32x16_bf16(fg, bg, ag, 0, 0, 0);
        }
        GAS bf16_t* GT = (GAS bf16_t*)(p.ws + WS_GATE) + tok * 256 + F.wave * 32;
#pragma unroll
        for (int g4 = 0; g4 < 4; ++g4) { u32x2 w; w.x = pk2(ag[4 * g4], ag[4 * g4 + 1]); w.y = pk2(ag[4 * g4 + 2], ag[4 * g4 + 3]); *(GAS u32x2*)(GT + 8 * g4 + 4 * h2) = w; }
    }
    __syncthreads();
}

#define CBAR() asm volatile("" ::: "memory")
#define LROW(M, i, r) do { const LAS f32x4* _q = (const LAS f32x4*)((M) + (i) * 16); const f32x4 _a = _q[0], _b = _q[1], _c = _q[2], _d = _q[3]; \
        r[0] = _a[0]; r[1] = _a[1]; r[2] = _a[2]; r[3] = _a[3]; r[4] = _b[0]; r[5] = _b[1]; r[6] = _b[2]; r[7] = _b[3]; \
        r[8] = _c[0]; r[9] = _c[1]; r[10] = _c[2]; r[11] = _c[3]; r[12] = _d[0]; r[13] = _d[1]; r[14] = _d[2]; r[15] = _d[3]; } while (0)
template <int DIR> __device__ __forceinline__ void chunkprep_wave(Frame& F, const Params& p, int task) {
    const int dbh = task >> 7, ct = task & 127, b = (dbh >> 2) & 7, hh = dbh & 3, ch = F.lane, r32 = F.lane & 31, h = F.lane >> 5;
    LAS unsigned char* wl = F.lds + F.wave * 16384;
    LAS bf16_t* X = (LAS bf16_t*)wl;
    LAS bf16_t* Yt = (LAS bf16_t*)(wl + 4608);
    LAS float* MTt = (LAS float*)(wl + 9216);
    LAS float* MBt = MTt + 256;
    LAS float* MC = MTt + 512; LAS float* MD = MTt + 768; LAS float* MT = MTt + 1024; LAS float* MA = MTt + 1280;
    constexpr int step = DIR ? -256 : 256;
    typedef const __attribute__((address_space(1))) bf16_t* gbf;
    const size_t ou = ((size_t)b * SEQ + ct * 16 + (DIR ? 15 : 0)) * 256 + hh * 64;
    const gbf OM = (gbf)(p.ws + WS_OM) + (size_t)DIR * MTOK * 256 + ou + ch; const gbf KA = (gbf)(p.ws + WS_KA) + (size_t)DIR * MTOK * 256 + ou + ch;
    const gbf KD = (gbf)(p.ws + WS_KD) + (size_t)DIR * MTOK * 256 + ou + ch; const gbf KK = (gbf)(p.ws + WS_KK) + ou + ch;
    const gbf RR = (gbf)(p.ws + WS_R) + ou + ch; const gbf VV = (gbf)(p.ws + WS_V) + ou + ch;
    float pc = 1.f;
    float qt[16], rt[16], at[16], kt[16], vv[16];
    {
        unsigned short rw[16], rk[16], ra_[16], rd[16], rr_[16], rv[16];
#pragma unroll
        for (int i = 0; i < 16; ++i) { rw[i] = OM[i * step]; rk[i] = KK[i * step]; ra_[i] = KA[i * step]; rd[i] = KD[i * step]; rr_[i] = RR[i * step]; rv[i] = VV[i * step]; }
#pragma unroll
        for (int i = 0; i < 16; ++i) {
            const float w = 1.f - bf2f(rw[i]);
            qt[i] = bf2f(rk[i]) * pc; pc *= w; const float ip = __builtin_amdgcn_rcpf(pc);
            rt[i] = bf2f(rr_[i]) * pc; at[i] = bf2f(ra_[i]) * ip; kt[i] = bf2f(rd[i]) * ip; vv[i] = bf2f(rv[i]);
            X[i * 72 + ch] = (bf16_t)(pk2(qt[i], 0.f) & 0xffffu); X[(16 + i) * 72 + ch] = (bf16_t)(pk2(rt[i], 0.f) & 0xffffu);
            Yt[i * 72 + ch] = (bf16_t)(pk2(at[i], 0.f) & 0xffffu); Yt[(16 + i) * 72 + ch] = (bf16_t)(pk2(kt[i], 0.f) & 0xffffu);
        }
    }
    const float p15 = pc;
    asm volatile("s_waitcnt lgkmcnt(0)" ::: "memory");
    {
        f32x16 g;
#pragma unroll
        for (int i = 0; i < 16; ++i) g[i] = 0.f;
#pragma unroll
        for (int ks = 0; ks < 4; ++ks) {
            const bf16x8 a = *(const LAS bf16x8*)(X + r32 * 72 + 16 * ks + 8 * h), bb = *(const LAS bf16x8*)(Yt + r32 * 72 + 16 * ks + 8 * h);
            g = __builtin_amdgcn_mfma_f32_32x32x16_bf16(a, bb, g, 0, 0, 0);
        }
        const int sidx = r32 & 15;
#pragma unroll
        for (int reg = 0; reg < 8; ++reg) { const int i = (reg & 3) + 8 * (reg >> 2) + 4 * h;
            const float lo = (sidx < i) ? g[reg] : 0.f, hi2 = (sidx <= i) ? g[8 + reg] : 0.f;
            if (r32 < 16) { MA[i * 16 + sidx] = lo; MD[i * 16 + sidx] = hi2; } else { MBt[sidx * 16 + i] = lo; MC[i * 16 + sidx] = hi2; } }
    }
    asm volatile("s_waitcnt lgkmcnt(0)" ::: "memory");
    {
        const int c = F.lane & 15; float Tc[16];
#pragma unroll
        for (int i = 0; i < 16; ++i) { float acc = (i == c) ? 1.f : 0.f; float ra[16]; LROW(MA, i, ra);
#pragma unroll
            for (int s2 = 0; s2 < i; ++s2) acc -= ra[s2] * Tc[s2];
            Tc[i] = acc; MT[i * 16 + c] = acc; MTt[c * 16 + i] = acc; CBAR(); }
    }
    asm volatile("s_waitcnt lgkmcnt(0)" ::: "memory");
    float Qh[16], W2[16];
    {
        float BV[16];
#pragma unroll
        for (int i = 0; i < 16; ++i) { Qh[i] = 0.f; BV[i] = 0.f; }
#pragma unroll
        for (int s2 = 0; s2 < 16; ++s2) {
            float ct_[16], cb_[16]; LROW(MTt, s2, ct_); LROW(MBt, s2, cb_);
#pragma unroll
            for (int i = s2; i < 16; ++i) { Qh[i] += ct_[i] * qt[s2]; if (i > s2) BV[i] += cb_[i] * vv[s2]; }
            CBAR();
        }
#pragma unroll
        for (int i = 0; i < 16; ++i) { float aw = 0.f; float rt_[16]; LROW(MT, i, rt_);
#pragma unroll
            for (int s2 = 0; s2 <= i; ++s2) aw += rt_[s2] * BV[s2];
            W2[i] = aw; CBAR(); }
    }
    LAS bf16_t* ST = (LAS bf16_t*)wl;
    {
        const int ks = ch >> 4, w16 = ch & 15, jq = (w16 >> 3) * 4 + (w16 & 3), hq = (w16 >> 2) & 1;
        LAS bf16_t* qrp = ST + (ks * 64 + hq * 32) * 8 + jq;
        LAS bf16_t* wyp = ST + 2048 + ((ch >> 5) * 64 + r32) * 16;
#pragma unroll
        for (int i = 0; i < 16; ++i) {
            float ar = rt[i], ay = 0.f; float rd_[16], rc_[16]; LROW(MD, i, rd_); LROW(MC, i, rc_);
#pragma unroll
            for (int s2 = 0; s2 <= i; ++s2) { ar -= rd_[s2] * Qh[s2]; ay += rc_[s2] * vv[s2] - rd_[s2] * W2[s2]; }
            qrp[i * 8] = (bf16_t)(pk2(Qh[i], 0.f) & 0xffffu); qrp[(16 + i) * 8] = (bf16_t)(pk2(ar, 0.f) & 0xffffu);
            wyp[512 * ((i >> 2) & 1) + (i & 3) + 4 * (i >> 3)] = (bf16_t)(pk2(W2[i], 0.f) & 0xffffu);
            wyp[512 * ((i >> 2) & 1) + (i & 3) + 4 * ((16 + i) >> 3)] = (bf16_t)(pk2(ay, 0.f) & 0xffffu);
            CBAR(); }
    }
    asm volatile("s_waitcnt lgkmcnt(0)" ::: "memory");
    {
        GAS u32x4* gq = (GAS u32x4*)((GAS bf16_t*)(p.ws + WS_FQR) + (size_t)task * 2048); GAS u32x4* gw = (GAS u32x4*)((GAS bf16_t*)(p.ws + WS_FWY) + (size_t)task * 2048);
        u32x4 tq[4], tw[4];
#pragma unroll
        for (int q = 0; q < 4; ++q) { tq[q] = *(const LAS u32x4*)(wl + (F.lane + 64 * q) * 16); tw[q] = *(const LAS u32x4*)(wl + 4096 + (F.lane + 64 * q) * 16); }
#pragma unroll
        for (int q = 0; q < 4; ++q) { gq[F.lane + 64 * q] = tq[q]; gw[F.lane + 64 * q] = tw[q]; }
    }
    asm volatile("s_waitcnt lgkmcnt(0)" ::: "memory");
    {
        LAS bf16_t* nap = ST + ((ch >> 5) * 64 + r32) * 8; LAS bf16_t* khp = nap + 1024;
#pragma unroll
        for (int s2 = 0; s2 < 16; ++s2) {
            const int off = 256 * ((s2 >> 2) & 1) + (s2 >> 3) * 4 + (s2 & 3);
            nap[off] = (bf16_t)(pk2(-at[s2] * p15, 0.f) & 0xffffu); khp[off] = (bf16_t)(pk2(kt[s2] * p15, 0.f) & 0xffffu); }
        asm volatile("s_waitcnt lgkmcnt(0)" ::: "memory");
        GAS u32x4* gn = (GAS u32x4*)((GAS bf16_t*)(p.ws + WS_FNA) + (size_t)task * 1024); GAS u32x4* gk = (GAS u32x4*)((GAS bf16_t*)(p.ws + WS_FKH) + (size_t)task * 1024);
        u32x4 tn[2], tk2[2];
#pragma unroll
        for (int q = 0; q < 2; ++q) { tn[q] = *(const LAS u32x4*)(wl + (F.lane + 64 * q) * 16); tk2[q] = *(const LAS u32x4*)(wl + 2048 + (F.lane + 64 * q) * 16); }
#pragma unroll
        for (int q = 0; q < 2; ++q) { gn[F.lane + 64 * q] = tn[q]; gk[F.lane + 64 * q] = tk2[q]; }
        ((GAS float*)(p.ws + WS_FP15))[(size_t)task * 64 + ch] = p15;
    }
    asm volatile("s_waitcnt lgkmcnt(0)" ::: "memory");
}
constexpr int PB_SLOT = 15360, PB_NSLOT = 4, PB_QR = 0, PB_WY = 4096, PB_NA = 8192, PB_KH = 10240, PB_P15 = 12288, PB_V = 13312;
__device__ __forceinline__ unsigned lds_ld_u32(unsigned addr) { unsigned v; asm volatile("ds_read_b32 %0, %1\n\ts_waitcnt lgkmcnt(0)" : "=v"(v) : "v"(addr) : "memory"); return v; }
__device__ __forceinline__ void lds_st_u32(unsigned addr, unsigned v) { asm volatile("ds_write_b32 %0, %1" :: "v"(addr), "v"(v) : "memory"); }
__device__ __forceinline__ void pb_dma(const Params& p, int dbh, int ct, int lane, LAS unsigned char* slot) {
    const size_t task = (size_t)dbh * 128 + ct; const int b = (dbh >> 2) & 7, hh = dbh & 3;
    const unsigned char* q = (const unsigned char*)((const bf16_t*)(p.ws + WS_FQR) + task * 2048) + lane * 16; const unsigned char* w = (const unsigned char*)((const bf16_t*)(p.ws + WS_FWY) + task * 2048) + lane * 16;
    const unsigned char* na = (const unsigned char*)((const bf16_t*)(p.ws + WS_FNA) + task * 1024) + lane * 16; const unsigned char* kh = (const unsigned char*)((const bf16_t*)(p.ws + WS_FKH) + task * 1024) + lane * 16;
#pragma unroll
    for (int i = 0; i < 4; ++i) {
        __builtin_amdgcn_global_load_lds((const unsigned*)(q + 1024 * i), (LAS unsigned*)(slot + PB_QR + 1024 * i), 16, 0, 0);
        __builtin_amdgcn_global_load_lds((const unsigned*)(w + 1024 * i), (LAS unsigned*)(slot + PB_WY + 1024 * i), 16, 0, 0); }
    __builtin_amdgcn_global_load_lds((const unsigned*)na, (LAS unsigned*)(slot + PB_NA), 16, 0, 0); __builtin_amdgcn_global_load_lds((const unsigned*)(na + 1024), (LAS unsigned*)(slot + PB_NA + 1024), 16, 0, 0);
    __builtin_amdgcn_global_load_lds((const unsigned*)kh, (LAS unsigned*)(slot + PB_KH), 16, 0, 0); __builtin_amdgcn_global_load_lds((const unsigned*)(kh + 1024), (LAS unsigned*)(slot + PB_KH + 1024), 16, 0, 0);
    __builtin_amdgcn_global_load_lds((const unsigned*)((const unsigned char*)((const float*)(p.ws + WS_FP15) + task * 64) + lane * 16), (LAS unsigned*)(slot + PB_P15), 16, 0, 0);
    const unsigned char* V = (const unsigned char*)((const bf16_t*)(p.ws + WS_V) + ((size_t)b * SEQ + ct * 16) * 256 + hh * 64) + (size_t)(lane >> 3) * 512 + (lane & 7) * 16;
    __builtin_amdgcn_global_load_lds((const unsigned*)V, (LAS unsigned*)(slot + PB_V), 16, 0, 0); __builtin_amdgcn_global_load_lds((const unsigned*)(V + 8 * 512), (LAS unsigned*)(slot + PB_V + 1024), 16, 0, 0);
}
__device__ __forceinline__ void phaseb_unit(Frame& F, const Params& p, int u) {
    const unsigned flag_base = (unsigned)(size_t)(F.lds + 131072 + 128);
    if (F.tid < 8) lds_st_u32(flag_base + 4 * F.tid, 0u);
    __syncthreads();
    const int pair = F.wave & 3;
    if (pair >= 2) return;
    const int dbh = u * 2 + pair, dir = dbh >> 5;
    LAS unsigned char* ring = F.lds + pair * (PB_NSLOT * PB_SLOT);
    const unsigned f_pub = flag_base + 8 * pair, f_con = f_pub + 4;
    if (F.wave >= 4) {
        for (int c = 0; c < 128; ++c) {
            while ((int)lds_ld_u32(f_con) < c - (PB_NSLOT - 1)) __builtin_amdgcn_s_sleep(1);
            pb_dma(p, dbh, dir ? 127 - c : c, F.lane, ring + (c & (PB_NSLOT - 1)) * PB_SLOT);
            if (c >= 3) { asm volatile("s_waitcnt vmcnt(45)" ::: "memory"); if (F.lane == 0) lds_st_u32(f_pub, (unsigned)(c - 2)); }
        }
        asm volatile("s_waitcnt vmcnt(30)" ::: "memory"); if (F.lane == 0) lds_st_u32(f_pub, 126u);
        asm volatile("s_waitcnt vmcnt(15)" ::: "memory"); if (F.lane == 0) lds_st_u32(f_pub, 127u);
        asm volatile("s_waitcnt vmcnt(0)" ::: "memory"); if (F.lane == 0) lds_st_u32(f_pub, 128u);
        return;
    }
    const int b = (dbh >> 2) & 7, hh = dbh & 3, r = F.lane & 31, h = F.lane >> 5;
    GAS bf16_t* Y = (GAS bf16_t*)(p.ws + WS_Y) + ((size_t)dir * MTOK + (size_t)b * SEQ) * 256 + hh * 64 + r;
    f32x16 accS[2][2];
#pragma unroll
    for (int rb = 0; rb < 2; ++rb)
#pragma unroll
        for (int cb = 0; cb < 2; ++cb)
#pragma unroll
            for (int i = 0; i < 16; ++i) accS[rb][cb][i] = 0.f;
    for (int cc = 0; cc < 128; ++cc) {
        const int ct = dir ? 127 - cc : cc;
        const LAS unsigned char* slot = ring + (cc & (PB_NSLOT - 1)) * PB_SLOT;
        bf16x8 sb[4][2];
#pragma unroll
        for (int rb = 0; rb < 2; ++rb)
#pragma unroll
            for (int s2 = 0; s2 < 2; ++s2)
#pragma unroll
                for (int cb = 0; cb < 2; ++cb) { const f32x16& a = accS[rb][cb]; u32x4 w;
                    w.x = pk2(a[8 * s2 + 0], a[8 * s2 + 1]); w.y = pk2(a[8 * s2 + 2], a[8 * s2 + 3]); w.z = pk2(a[8 * s2 + 4], a[8 * s2 + 5]); w.w = pk2(a[8 * s2 + 6], a[8 * s2 + 7]);
                    sb[2 * rb + s2][cb] = __builtin_bit_cast(bf16x8, w); }
        while ((int)lds_ld_u32(f_pub) < cc + 1) __builtin_amdgcn_s_sleep(1);
        asm volatile("" ::: "memory");
        f32x16 D[2];
#pragma unroll
        for (int cb = 0; cb < 2; ++cb) { const LAS u32x4* wp = (const LAS u32x4*)(slot + PB_WY + (cb * 64 + F.lane) * 32); const u32x4 w0 = wp[0], w1 = wp[1];
            D[cb][0] = bflo(w0.x); D[cb][1] = bfhi(w0.x); D[cb][2] = bflo(w0.y); D[cb][3] = bfhi(w0.y); D[cb][4] = bflo(w0.z); D[cb][5] = bfhi(w0.z); D[cb][6] = bflo(w0.w); D[cb][7] = bfhi(w0.w);
            D[cb][8] = bflo(w1.x); D[cb][9] = bfhi(w1.x); D[cb][10] = bflo(w1.y); D[cb][11] = bfhi(w1.y); D[cb][12] = bflo(w1.z); D[cb][13] = bfhi(w1.z); D[cb][14] = bflo(w1.w); D[cb][15] = bfhi(w1.w); }
#pragma unroll
        for (int ks = 0; ks < 4; ++ks) { const bf16x8 qa = *(const LAS bf16x8*)(slot + PB_QR + (ks * 64 + F.lane) * 16);
            D[0] = __builtin_amdgcn_mfma_f32_32x32x16_bf16(qa, sb[ks][0], D[0], 0, 0, 0);
            D[1] = __builtin_amdgcn_mfma_f32_32x32x16_bf16(qa, sb[ks][1], D[1], 0, 0, 0); }
#pragma unroll
        for (int rb = 0; rb < 2; ++rb)
#pragma unroll
            for (int g4 = 0; g4 < 4; ++g4) { const f32x4 pv = *(const LAS f32x4*)(slot + PB_P15 + (32 * rb + 8 * g4 + 4 * h) * 4);
#pragma unroll
                for (int cb = 0; cb < 2; ++cb)
#pragma unroll
                    for (int q = 0; q < 4; ++q) accS[rb][cb][4 * g4 + q] *= pv[q]; }
        bf16x8 ub[2], vb[2];
#pragma unroll
        for (int cb = 0; cb < 2; ++cb) {
            unsigned short vt[8];
#pragma unroll
            for (int j = 0; j < 8; ++j) { const int s2 = 8 * (j >> 2) + 4 * h + (j & 3); const int tau = dir ? 15 - s2 : s2;
                vt[j] = *(const LAS unsigned short*)(slot + PB_V + tau * 128 + (32 * cb + r) * 2);
                Y[(size_t)(ct * 16 + tau) * 256 + 32 * cb] = (bf16_t)(pk2(D[cb][8 + j], 0.f) & 0xffffu); }
            vb[cb] = (bf16x8){(short)vt[0], (short)vt[1], (short)vt[2], (short)vt[3], (short)vt[4], (short)vt[5], (short)vt[6], (short)vt[7]};
            u32x4 w; w.x = pk2(D[cb][0], D[cb][1]); w.y = pk2(D[cb][2], D[cb][3]); w.z = pk2(D[cb][4], D[cb][5]); w.w = pk2(D[cb][6], D[cb][7]);
            ub[cb] = __builtin_bit_cast(bf16x8, w);
        }
        bf16x8 na[2], kh[2];
#pragma unroll
        for (int rb = 0; rb < 2; ++rb) { na[rb] = *(const LAS bf16x8*)(slot + PB_NA + (rb * 64 + F.lane) * 16); kh[rb] = *(const LAS bf16x8*)(slot + PB_KH + (rb * 64 + F.lane) * 16); }
        asm volatile("s_waitcnt lgkmcnt(0)" ::: "memory");
        if (F.lane == 0) lds_st_u32(f_con, (unsigned)(cc + 1));
#pragma unroll
        for (int rb = 0; rb < 2; ++rb)
#pragma unroll
            for (int cb = 0; cb < 2; ++cb) {
                accS[rb][cb] = __builtin_amdgcn_mfma_f32_32x32x16_bf16(na[rb], ub[cb], accS[rb][cb], 0, 0, 0);
                accS[rb][cb] = __builtin_amdgcn_mfma_f32_32x32x16_bf16(kh[rb], vb[cb], accS[rb][cb], 0, 0, 0);
            }
    }
}

__device__ __forceinline__ void post_unit(Frame& F, const Params& p, int l, int u) {
    REFRAME(F);
    const bf16_t* Y0 = (const bf16_t*)(p.ws + WS_Y); const bf16_t* Y1 = Y0 + (size_t)MTOK * 256;
    const bf16_t* VV = (const bf16_t*)(p.ws + WS_V); const bf16_t* GT = (const bf16_t*)(p.ws + WS_GATE);
    const float* BON = (const float*)(p.ws + WS_BON); bf16_t* MIX = (bf16_t*)(p.ws + WS_MIX);
    const f32x4 lg = *(const f32x4*)(p.in[19] + l * 256 + 4 * F.lane), lb = *(const f32x4*)(p.in[20] + l * 256 + 4 * F.lane);
    for (int tok = u * 64 + F.wave * 8, te = tok + 8; tok < te; ++tok) {
        const u32x2 a = *(const GAS u32x2*)((const GAS bf16_t*)Y0 + (size_t)tok * 256 + 4 * F.lane), c = *(const GAS u32x2*)((const GAS bf16_t*)Y1 + (size_t)tok * 256 + 4 * F.lane);
        const u32x2 vv = *(const GAS u32x2*)((const GAS bf16_t*)VV + (size_t)tok * 256 + 4 * F.lane), gg = *(const GAS u32x2*)((const GAS bf16_t*)GT + (size_t)tok * 256 + 4 * F.lane);
        float y[4] = {bflo(a.x) + bflo(c.x), bfhi(a.x) + bfhi(c.x), bflo(a.y) + bflo(c.y), bfhi(a.y) + bfhi(c.y)};
        float s = (y[0] + y[1]) + (y[2] + y[3]);
#pragma unroll
        for (int o = 1; o < 16; o <<= 1) s += __shfl_xor(s, o);
        const float mu = s * (1.f / 64.f);
        float q = 0.f;
#pragma unroll
        for (int i = 0; i < 4; ++i) { y[i] -= mu; q += y[i] * y[i]; }
#pragma unroll
        for (int o = 1; o < 16; o <<= 1) q += __shfl_xor(q, o);
        const float rstd = rsqrtf(q * (1.f / 64.f) + 64e-5f);
        const int hh = F.lane >> 4;
        const float bon = ((const GAS float*)BON)[(size_t)tok * 4 + hh] + ((const GAS float*)BON)[((size_t)MTOK + tok) * 4 + hh];
        const float v4[4] = {bflo(vv.x), bfhi(vv.x), bflo(vv.y), bfhi(vv.y)}, g4[4] = {bflo(gg.x), bfhi(gg.x), bflo(gg.y), bfhi(gg.y)};
        float o4[4];
#pragma unroll
        for (int i = 0; i < 4; ++i) o4[i] = (y[i] * rstd * lg[i] + lb[i] + bon * v4[i]) * g4[i];
        u32x2 w; w.x = pk2(o4[0], o4[1]); w.y = pk2(o4[2], o4[3]);
        *(GAS u32x2*)((GAS bf16_t*)MIX + (size_t)tok * DM + 768 + 4 * F.lane) = w;
    }
}

__device__ __forceinline__ void prologue(Frame& F, const Params& p) {
    REFRAME(F);
    LAS float* scr = (LAS float*)(F.lds + F.wave * 16384);
    const int gw = F.bid * 8 + F.wave, NGW = F.G * 8;
    bf16_t* wb = (bf16_t*)(p.ws + WS_W);
    for (int it = gw; it < CV_TOTAL; it += NGW) { if (it < CV_A) cvt_item_a(p, 0, wb, scr, it, F.lane); else cvt_item_b(p, 0, wb, scr, it - CV_A, F.lane); }
    const float* x = p.in[0]; float* X = p.out; bf16_t* XB = (bf16_t*)(p.ws + WS_XB); float* rowss = (float*)(p.ws + WS_RP);
    for (int m = gw; m < MTOK; m += NGW) {
        const f32x4* xr = (const f32x4*)(x + (size_t)m * DM) + F.lane; f32x4* xo = (f32x4*)(X + (size_t)m * DM) + F.lane; u32x2* bo = (u32x2*)(XB + (size_t)m * DM) + F.lane;
        float s = 0.f;
#pragma unroll
        for (int jj = 0; jj < 4; ++jj) { const f32x4 v = xr[64 * jj]; xo[64 * jj] = v; s += (v[0] * v[0] + v[1] * v[1]) + (v[2] * v[2] + v[3] * v[3]);
            u32x2 w; w.x = pk2(v[0], v[1]); w.y = pk2(v[2], v[3]); bo[64 * jj] = w; }
        s = wave_sum(s);
        if (F.lane < 16) rowss[(size_t)m * 16 + F.lane] = (F.lane == 0) ? s : 0.f;
    }
    const float* mem = p.in[1]; const float* gm = p.in[23]; bf16_t* MN = (bf16_t*)(p.ws + WS_MEMN);
    for (int m = gw; m < MMEM; m += NGW) {
        const f32x4* xr = (const f32x4*)(mem + (size_t)m * DM) + F.lane; u32x2* bo = (u32x2*)(MN + (size_t)m * DM) + F.lane;
        f32x4 v[4]; float s = 0.f;
#pragma unroll
        for (int jj = 0; jj < 4; ++jj) { v[jj] = xr[64 * jj]; s += (v[jj][0] * v[jj][0] + v[jj][1] * v[jj][1]) + (v[jj][2] * v[jj][2] + v[jj][3] * v[jj][3]); }
        const float rstd = rsqrtf(wave_sum(s) * (1.f / 1024.f) + 1e-6f);
#pragma unroll
        for (int jj = 0; jj < 4; ++jj) { const f32x4 g = *((const f32x4*)gm + F.lane + 64 * jj); const f32x4 t = v[jj] * rstd * g;
            u32x2 w; w.x = pk2(t[0], t[1]); w.y = pk2(t[2], t[3]); bo[64 * jj] = w; }
    }
}
__device__ __forceinline__ void final_norm(Frame& F, const Params& p) {
    REFRAME(F);
    const int gw = F.bid * 8 + F.wave, NGW = F.G * 8;
    const float* rowss = (const float*)(p.ws + WS_RP) + (size_t)12 * MTOK * 16; const float* gf = p.in[30];
    for (int m = gw; m < MTOK; m += NGW) {
        f32x4* xo = (f32x4*)(p.out + (size_t)m * DM) + F.lane;
        const float rstd = row_rstd(rowss, m);
#pragma unroll
        for (int jj = 0; jj < 4; ++jj) { const f32x4 g = *((const f32x4*)gf + F.lane + 64 * jj); xo[64 * jj] = xo[64 * jj] * rstd * g; }
#ifdef TPROBE
        { const unsigned* c_ = (const unsigned*)(p.ws + WS_CTL); const float A_ = (float)c_[32] * 1e-4f, B_ = (float)c_[33] * 1e-4f;
          if (m >= 1024 && m < 2048) {
#pragma unroll
              for (int jj = 0; jj < 4; ++jj) xo[64 * jj] = xo[64 * jj] + B_; }
          if (m == 0 && F.lane == 0) { f32x4 v = xo[0]; v[0] += A_; xo[0] = v; } }
#endif
    }
}

#define XB_TMO      128
#define XB_XCNT(j)  (256  + 64 * (j))
#define XB_XSUB(j)  (1280 + 64 * (j))
#define XB_XGEN(j)  (2304 + 64 * (j))
#define XB_TOP      3328
#define XB_TOPGEN   3392
#define XB_SPIN_CAP (1u << 22)
constexpr int CW_BAR = 4096;
__device__ __forceinline__ unsigned xb_ld(unsigned* p)              { return __hip_atomic_load(p, __ATOMIC_RELAXED, __HIP_MEMORY_SCOPE_AGENT); }
__device__ __forceinline__ unsigned xb_add(unsigned* p, unsigned v) { return __hip_atomic_fetch_add(p, v, __ATOMIC_RELAXED, __HIP_MEMORY_SCOPE_AGENT); }
__device__ __forceinline__ unsigned xb_xcc_id() { return (unsigned)__builtin_amdgcn_s_getreg((3 << 11) | 20) & 0xFu; }
#define XB_SPIN(cond, bar) do { unsigned _sp = 0; while (cond) { __builtin_amdgcn_s_sleep(1); \
    if ((++_sp & 255u) == 0u) { if (xb_ld(&(bar)[XB_TMO])) break; if (_sp > XB_SPIN_CAP) { atomicAdd(&(bar)[XB_TMO], 1u); break; } } } } while (0)
__device__ __forceinline__ void xcd_barrier_complete(unsigned* bar, unsigned x, unsigned& nloc, unsigned& nx) {
    const unsigned G = gridDim.x;
    unsigned sum, cnt, mine, sp = 0u;
    for (;;) {
        sum = 0u; cnt = 0u; mine = 0u;
#pragma unroll
        for (unsigned j = 0; j < 16; ++j) { const unsigned c = xb_ld(&bar[XB_XCNT(j)]); sum += c; cnt += (c > 0u) ? 1u : 0u; mine = (j == x) ? c : mine; }
        if (sum == G) break;
        __builtin_amdgcn_s_sleep(1);
        if ((++sp & 255u) == 0u) { if (xb_ld(&bar[XB_TMO])) break; if (sp > XB_SPIN_CAP) { atomicAdd(&bar[XB_TMO], 1u); break; } }
    }
    nloc = mine > 0u ? mine : 1u; nx = cnt > 0u ? cnt : 1u;
}
__device__ __forceinline__ void gsync(volatile LAS unsigned* st) {
    unsigned* bar = (unsigned*)(make_params().ws + WS_CTL) + CW_BAR;
    asm volatile("s_waitcnt vmcnt(0)" ::: "memory");
    __syncthreads();
    if (threadIdx.x == 0) {
        const unsigned x = xb_xcc_id();
        __builtin_amdgcn_s_waitcnt(0);
        unsigned nloc = st[0], nx = st[1];
        if (nloc == 0u) { xcd_barrier_complete(bar, x, nloc, nx); st[0] = nloc; st[1] = nx; }
        const unsigned old = xb_add(&bar[XB_XSUB(x)], 1u);
        const unsigned gen = old / nloc;
        if (old + 1u == (gen + 1u) * nloc) {
            __builtin_amdgcn_fence(__ATOMIC_RELEASE, "agent");
            asm volatile("s_waitcnt vmcnt(0)" ::: "memory");
            const unsigned og = xb_add(&bar[XB_TOP], 1u);
            const unsigned tg = og / nx;
            if (og + 1u == (tg + 1u) * nx) xb_add(&bar[XB_TOPGEN], 1u);
            else XB_SPIN(xb_ld(&bar[XB_TOPGEN]) == tg, bar);
            __builtin_amdgcn_fence(__ATOMIC_ACQUIRE, "agent");
            xb_add(&bar[XB_XGEN(x)], 1u);
            asm volatile("s_waitcnt vmcnt(0)" ::: "memory");
        } else {
            XB_SPIN(xb_ld(&bar[XB_XGEN(x)]) == gen, bar);
            __builtin_amdgcn_fence(__ATOMIC_ACQUIRE, "agent");
            asm volatile("s_waitcnt vmcnt(0)" ::: "memory");
        }
    }
    __syncthreads();
}
#ifdef TPROBE
#define STAMP(id) do { if (blockIdx.x == 0 && threadIdx.x == 0) { LAS unsigned long long* ts_ = (LAS unsigned long long*)(F.lds + 131072 + 64); const unsigned long long now_ = __builtin_amdgcn_s_memrealtime(); \
    const unsigned long long dt_ = now_ - ts_[0]; ts_[0] = now_; if ((TA_MASK >> (id)) & 1) ts_[1] += dt_; if ((TB_MASK >> (id)) & 1) ts_[2] += dt_; } } while (0)
#else
#define STAMP(id) do { } while (0)
#endif
#ifndef PH_MASK
#define PH_MASK 0xFFFF
#endif
#ifndef REP_MASK
#define REP_MASK 0
#endif
#define NREP(k) ((((REP_MASK) >> (k)) & 1) ? 2 : 1)
constexpr int NCP = 1024, NDIFF_A = 0, NPB = 32;
__global__ void __launch_bounds__(512, 2) fwd_megakernel(KArgs kargs_unused) {
    extern __shared__ __attribute__((aligned(16))) unsigned char lds_raw[];
    cg::grid_group grid = cg::this_grid();
    Frame F; F.lds = (LAS unsigned char*)lds_raw; F.tid = threadIdx.x; F.lane = F.tid & 63; F.wave = __builtin_amdgcn_readfirstlane(F.tid >> 6); F.G = gridDim.x; F.bid = blockIdx.x;
    LAS int* qslot = (LAS int*)(F.lds + 131072);
    volatile LAS unsigned* bst = (volatile LAS unsigned*)(F.lds + 131072 + 32);
    { unsigned* bar0 = (unsigned*)(make_params().ws + WS_CTL) + CW_BAR;
      if (threadIdx.x == 0) { bst[0] = 0u; bst[1] = 0u; (void)xb_add(bar0 + XB_XCNT(xb_xcc_id()), 1u); } }
    __syncthreads();
#define PHASE_VARS() const Params p = make_params(); unsigned* ctl = (unsigned*)(p.ws + WS_CTL); float* rowss = (float*)(p.ws + WS_RP); \
    bf16_t* XB = (bf16_t*)(p.ws + WS_XB); bf16_t* Z = (bf16_t*)(p.ws + WS_Z); bf16_t* MIX = (bf16_t*)(p.ws + WS_MIX); \
    bf16_t* wb = (bf16_t*)(p.ws + WS_W); int bid_ = F.bid, G_ = F.G; asm volatile("" : "+s"(bid_), "+s"(G_)); (void)bid_; (void)G_; (void)ctl; (void)rowss; (void)XB; (void)Z; (void)MIX; (void)wb

#ifdef TPROBE
    if (blockIdx.x == 0 && threadIdx.x == 0) { LAS unsigned long long* ts_ = (LAS unsigned long long*)(F.lds + 131072 + 64); ts_[0] = __builtin_amdgcn_s_memrealtime(); ts_[1] = 0; ts_[2] = 0; }
#endif
    if (PH_MASK & 1) { const Params p = make_params(); prologue(F, p); }
    grid.sync();
    STAMP(0);

    for (int l = 0; l < NL; ++l) {
        for (int rep = 0; rep < NREP(1); ++rep) {
        if (PH_MASK & 2) {
            PHASE_VARS();
            pg8::StaticOrder S; S.init(MTOK, INW, G_, bid_);
            pg8::gemm_phase(F.lds, pg8::Gemm{XB, wb + WO_IN, MTOK, INW, DM}, S, pg8::EpiScaleBf16{Z, ZP, rowss + (size_t)(3 * l) * MTOK * 16, (bf16_t*)(p.ws + WS_ZC), 1024, 8, (bf16_t*)(p.ws + WS_KD2)});
        }
        gsync(bst); STAMP(1);
        }
        for (int rep = 0; rep < NREP(2); ++rep) {
        for (int u = F.bid; u < 768; u += F.G) {
            PHASE_VARS();
            if (u < 512) { if (PH_MASK & 4) prep_unit(F, p, l, wb, u); } else if (PH_MASK & 8) win_unit(F, p, l, u - 512);
        }
        gsync(bst); STAMP(2);
        }
        for (int rep = 0; rep < NREP(3); ++rep) {
        {
            PHASE_VARS();
            const int ntot = NCP + NDIFF_A;
            for (;;) {
                __syncthreads();
                if (F.tid == 0) *qslot = (int)atomicAdd(ctl + CW_Q + 16 * l + 4 * rep, 1u);
                __syncthreads();
                const int u = *qslot;
                if (u >= ntot) break;
                if (u < NCP) { if (PH_MASK & 16) { REFRAME(F); if (u >= NCP / 2) chunkprep_wave<1>(F, p, u * 8 + F.wave); else chunkprep_wave<0>(F, p, u * 8 + F.wave); } }
                else if (PH_MASK & 32) diff_unit(F, p, l, u - NCP);
            }
        }
        gsync(bst); STAMP(11);
        }
        for (int rep = 0; rep < NREP(4); ++rep) {
        {
            PHASE_VARS();
            const int ncva = (l + 1 < NL) ? CV_A / 8 : 0, ncvb = (l > 0) ? CV_B / 8 : 0, ncv = NPB + ncva + ncvb, ntot = ncv + 256;
            unsigned* pbdone = ctl + 3072 + (l * 2 + rep) * 16;
            unsigned* gq = ctl + CW_Q + 16 * l + 8 + 4 * rep; unsigned* dq = ctl + 2048 + (l * 2 + rep) * 16;
            const int myx = (int)(xb_xcc_id() & 7u);
            int stage = 0, pend = -1, xi = 0;
            for (;;) {
                __syncthreads();
                if (F.tid == 0) {
                    int code = -1;
                    if (stage == 0) { const int g = (int)atomicAdd(gq, 1u); if (g < NPB) code = g; else { pend = g; stage = 1; } }
                    if (stage == 1) {
                        while (xi < 8) { const int x = (myx + xi) & 7; const int tk = (int)atomicAdd(dq + x, 1u); if (tk < 64) { code = -2 - ((4 * x + (tk >> 4)) * 16 + (tk & 15)); break; } ++xi; }
                        if (xi >= 8) stage = 2;
                    }
                    if (stage == 2 && code == -1) { int g = pend; pend = -1; if (g < 0) g = (int)atomicAdd(gq, 1u); if (g < ntot) code = g; }
                    *qslot = code;
                }
                __syncthreads();
                const int u = *qslot;
                if (u == -1) break;
                if (u <= -2) { if (PH_MASK & 32) diff_unit(F, p, l, -2 - u); }
                else if (u < NPB) { if (PH_MASK & 16) { REFRAME(F); phaseb_unit(F, p, u); }
                    __threadfence(); __syncthreads();
                    if (F.tid == 0) __hip_atomic_fetch_add(pbdone, 1u, __ATOMIC_RELEASE, __HIP_MEMORY_SCOPE_AGENT); }
                else if (u >= ncv) {
                    if (F.tid == 0) { while (__hip_atomic_load(pbdone, __ATOMIC_RELAXED, __HIP_MEMORY_SCOPE_AGENT) < (unsigned)NPB) __builtin_amdgcn_s_sleep(8); }
                    __syncthreads(); __builtin_amdgcn_fence(__ATOMIC_ACQUIRE, "agent");
                    if (PH_MASK & 64) post_unit(F, p, l, u - ncv); }
                else if (u < NPB + ncva) { REFRAME(F); cvt_item_a(p, l + 1, wb, (LAS float*)(F.lds + F.wave * 16384), (u - NPB) * 8 + F.wave, F.lane); }
                else { REFRAME(F); cvt_item_b(p, l, wb, (LAS float*)(F.lds + F.wave * 16384), (u - NPB - ncva) * 8 + F.wave, F.lane); }
            }
        }
        gsync(bst); STAMP(3);
        }
        if (PH_MASK & 128) {
            PHASE_VARS();
            pg8::StaticOrder S; S.init(MTOK, DM, G_, bid_);
            pg8::gemm_phase(F.lds, pg8::Gemm{MIX, wb + WO_OUT, MTOK, DM, DM}, S, pg8::EpiResid{p.out, XB, rowss + (size_t)(3 * l + 1) * MTOK * 16});
        }
        gsync(bst); STAMP(5);
        for (int rep = 0; rep < NREP(6); ++rep) {
        if (PH_MASK & 256) {
            PHASE_VARS();
            pg8::StaticOrder S; S.init(MTOK, XW, G_, bid_);
            if (F.bid < 128) {
                pg8::gemm_phase(F.lds, pg8::Gemm{XB, wb + WO_Q, MTOK, XW, DM}, S, pg8::EpiScaleBf16{(bf16_t*)(p.ws + WS_Q), XW, rowss + (size_t)(3 * l + 1) * MTOK * 16, nullptr, 0, 1 << 30, nullptr});
            } else {
                pg8::StaticOrder S2; S2.init(MMEM, 1024, 128, F.bid - 128);
                pg8::gemm_phase(F.lds, pg8::Gemm{(const bf16_t*)(p.ws + WS_MEMN), wb + WO_KV, MMEM, 1024, DM}, S2, pg8::EpiScaleBf16{(bf16_t*)(p.ws + WS_KV), 1024, nullptr, nullptr, 0, 1 << 30, nullptr});
            }
        }
        gsync(bst); STAMP(6);
        }
        for (int rep = 0; rep < NREP(7); ++rep) {
        if (PH_MASK & 512) for (int u = F.bid; u < 256; u += F.G) { PHASE_VARS(); cross_unit(F, p, u); }
        gsync(bst); STAMP(7);
        }
        if (PH_MASK & 1024) {
            PHASE_VARS();
            pg8::StaticOrder S; S.init(MTOK, DM, G_, bid_);
            pg8::gemm_phase(F.lds, pg8::Gemm{(const bf16_t*)(p.ws + WS_O), wb + WO_O, MTOK, DM, XW}, S, pg8::EpiResid{p.out, XB, rowss + (size_t)(3 * l + 2) * MTOK * 16});
        }
        gsync(bst); STAMP(8);
        for (int rep = 0; rep < NREP(9); ++rep) {
        if (PH_MASK & 2048) {
            PHASE_VARS();
            pg8::StaticOrder S; S.init(MTOK, 2 * DFF, G_, bid_);
            pg8::gemm_phase(F.lds, pg8::Gemm{XB, wb + WO_GU, MTOK, 2 * DFF, DM}, S, pg8::EpiSwiGLU{(bf16_t*)(p.ws + WS_G), rowss + (size_t)(3 * l + 2) * MTOK * 16});
        }
        gsync(bst); STAMP(9);
        }
        if (PH_MASK & 4096) {
            PHASE_VARS();
            pg8::StaticOrder S; S.init(MTOK, DM, G_, bid_);
            pg8::gemm_phase(F.lds, pg8::Gemm{(const bf16_t*)(p.ws + WS_G), wb + WO_DOWN, MTOK, DM, DFF}, S, pg8::EpiResid{p.out, XB, rowss + (size_t)(3 * l + 3) * MTOK * 16});
        }

#ifdef TPROBE
        STAMP(10);
        { const Params p = make_params(); if (l == NL - 1 && blockIdx.x == 0 && threadIdx.x == 0) { LAS unsigned long long* ts_ = (LAS unsigned long long*)(F.lds + 131072 + 64); unsigned* c_ = (unsigned*)(p.ws + WS_CTL); c_[32] = (unsigned)ts_[1]; c_[33] = (unsigned)ts_[2]; } }
#endif
        gsync(bst);
    }
    if (PH_MASK & 8192) { const Params p = make_params(); final_norm(F, p); }
}

extern "C" void kernel_launch(void* const* d_in, const int* in_sizes, int n_in, void* d_out, int out_size, void* d_ws, size_t ws_size, hipStream_t stream) {
    static int grid = 0;
    if (grid == 0) {
        if (n_in != 31 || out_size != MTOK * DM || ws_size < WS_END) { fprintf(stderr, "kernel_launch: unexpected problem shape (n_in %d out %d ws %zu)\n", n_in, out_size, ws_size); grid = -1; return; }
        int dev = 0, cus = 0, per_cu = 0;
        hipGetDevice(&dev);
        hipDeviceGetAttribute(&cus, hipDeviceAttributeMultiprocessorCount, dev);
        hipFuncSetAttribute((const void*)fwd_megakernel, hipFuncAttributeMaxDynamicSharedMemorySize, LDS_BYTES);
        hipOccupancyMaxActiveBlocksPerMultiprocessor(&per_cu, (const void*)fwd_megakernel, 512, LDS_BYTES);
        if (per_cu < 1) { fprintf(stderr, "kernel_launch: occupancy query returned %d\n", per_cu); per_cu = 1; }
        (void)hipGetLastError();
        grid = cus * per_cu;
    }
    if (grid < 0) return;
    hipMemsetAsync((char*)d_ws + WS_CTL, 0, CTL_ZERO_BYTES, stream);
    KArgs p{};
    for (int i = 0; i < 31; ++i) p.in[i] = (const float*)d_in[i];
    p.out = (float*)d_out; p.ws = (unsigned char*)d_ws;
    void* args[] = {&p};
    hipError_t e = hipLaunchCooperativeKernel((const void*)fwd_megakernel, dim3(grid), dim3(512), args, LDS_BYTES, stream);
    if (e != hipSuccess) fprintf(stderr, "cooperative launch failed: %s (grid %d)\n", hipGetErrorString(e), grid);
}
```

```cpp
#include <hip/hip_runtime.h>
#include <hip/hip_cooperative_groups.h>
#include <cstdio>
#include <cstdint>
namespace cg = cooperative_groups;

#define LAS __attribute__((address_space(3)))
#define GAS __attribute__((address_space(1)))
typedef unsigned short bf16_t;
typedef short bf16x8 __attribute__((ext_vector_type(8)));
typedef short s16x4 __attribute__((ext_vector_type(4)));
typedef short v4i16_t __attribute__((ext_vector_type(4)));
typedef float f32x4 __attribute__((ext_vector_type(4)));
typedef float f32x2 __attribute__((ext_vector_type(2)));
typedef float f32x16 __attribute__((ext_vector_type(16)));
typedef unsigned u32x4 __attribute__((ext_vector_type(4)));
typedef unsigned u32x2 __attribute__((ext_vector_type(2)));
typedef __bf16 bf16x2_t __attribute__((ext_vector_type(2)));

constexpr int DM = 1024, NB = 8, SEQ = 2048, NL = 4, MTOK = NB * SEQ;
constexpr int NMEM = 256, MMEM = NB * NMEM;
constexpr int INW = 3072, DFF = 2816, XW = 512;
constexpr float LOG2E = 1.4426950408889634f;

constexpr size_t MiB = 1u << 20;
constexpr size_t WS_CTL = 0, CTL_ZERO_BYTES = 1 * MiB;
constexpr size_t WS_W = 1 * MiB;
constexpr size_t WS_Z = 30 * MiB;
constexpr size_t WS_ZC = 94 * MiB;
constexpr size_t WS_XB = 126 * MiB;
constexpr size_t WS_FQR = 94 * MiB, WS_FWY = 126 * MiB, WS_FNA = 158 * MiB, WS_FKH = 174 * MiB, WS_FP15 = 190 * MiB;
constexpr size_t WS_MIX = 192 * MiB;
constexpr size_t WS_OM = 224 * MiB, WS_KA = 240 * MiB, WS_KD = 256 * MiB, WS_KK = 272 * MiB, WS_V = 280 * MiB, WS_R = 288 * MiB;
constexpr size_t WS_GATE = 296 * MiB, WS_Y = 304 * MiB, WS_BON = 320 * MiB, WS_KV = 321 * MiB, WS_MEMN = 325 * MiB;
constexpr size_t WS_RP = 329 * MiB;
constexpr size_t WS_END = 342 * MiB;
constexpr size_t WS_Q = WS_Z, WS_O = WS_Z + 16 * MiB, WS_G = WS_Z;
constexpr int ZP = 1024;
constexpr size_t WS_KD2 = WS_Z + 32 * MiB, WS_VD2 = WS_Z + 48 * MiB;
constexpr size_t WO_IN = 0, WO_OUT = 3145728, WO_Q = 4194304, WO_KV = 4718592, WO_O = 5767168, WO_GU = 6291456, WO_DOWN = 12058624;
constexpr size_t WO_WUP = 14942208, WO_AUP = 14974976, WO_GUP = 15007744;
constexpr int CW_Q = 64;

constexpr int LDS_BYTES = 135168;

__device__ __forceinline__ float bf2f(unsigned b) { return __uint_as_float(b << 16); }
__device__ __forceinline__ unsigned pk2(float lo, float hi) { f32x2 v = {lo, hi}; bf16x2_t b = __builtin_convertvector(v, bf16x2_t); return __builtin_bit_cast(unsigned, b); }
__device__ __forceinline__ float bflo(unsigned u) { return __uint_as_float(u << 16); }
__device__ __forceinline__ float bfhi(unsigned u) { return __uint_as_float(u & 0xffff0000u); }
__device__ __forceinline__ float wave_sum(float v) {
#pragma unroll
    for (int o = 1; o < 64; o <<= 1) v += __shfl_xor(v, o);
    return v;
}
__device__ __forceinline__ float xhalf(float v) {
    return __shfl_xor(v, 32);
}
__device__ __forceinline__ float row_rstd(const float* rp, int row) {
    const f32x4* q = (const f32x4*)(rp + (size_t)row * 16); const f32x4 a = q[0], b = q[1], c = q[2], d = q[3];
    const float s = (((a[0] + a[1]) + (a[2] + a[3])) + ((b[0] + b[1]) + (b[2] + b[3]))) + (((c[0] + c[1]) + (c[2] + c[3])) + ((d[0] + d[1]) + (d[2] + d[3])));
    return rsqrtf(s * (1.f / 1024.f) + 1e-6f);
}
__device__ __forceinline__ float sigmoidf_(float x) { return __builtin_amdgcn_rcpf(1.f + __expf(-x)); }

__device__ __forceinline__ int hw_lane() { int l = (int)__builtin_amdgcn_mbcnt_hi(~0u, __builtin_amdgcn_mbcnt_lo(~0u, 0u)); asm volatile("" : "+v"(l)); return l; }
namespace pg8 {
constexpr int BM = 256, BK = 64, HALF = 128, HTB = HALF * BK * 2, NXCD = 8, WGM = 8;
__host__ __device__ __forceinline__ int lds_byte(int r, int c) { const int st = (r >> 4) * 2 + (c >> 5), rr = r & 15, cc = c & 31, ob = rr * 64 + cc * 2; return st * 1024 + (ob ^ (((ob >> 9) & 1) << 5)); }
__host__ __device__ __forceinline__ void stage_rc(int b, int& R, int& C) { const int st = b / 1024, sb = b % 1024, swz = sb ^ (((sb >> 9) & 1) << 5); R = (st >> 1) * 16 + swz / 64; C = (st & 1) * 32 + (swz % 64) / 2; }
__host__ __device__ __forceinline__ int perm32(int rho) { const int n = rho >> 4, i = rho & 15; return 8 * (i >> 2) + 4 * n + (i & 3); }
struct Unit { int pm, pn; };
struct Gemm { const bf16_t* A; const bf16_t* Bt; int M, N, K; };
struct StaticOrder {
    int nM, nN, nwg, G, c;
    __device__ void init(int M, int N, int G_, int c_) { nM = M / BM; nN = N / BM; nwg = nM * nN; G = G_; c = c_; }
    __device__ bool next(int i, Unit& u) const {
        const long L = (long)i * G + c; if (L >= nwg) return false;
        int wgid = (int)L; { const int q = nwg / NXCD, r = nwg % NXCD, xcd = wgid % NXCD, off = wgid / NXCD; wgid = (xcd < r ? xcd * (q + 1) : r * (q + 1) + (xcd - r) * q) + off; }
        const int nig = WGM * nN, gid = wgid / nig, fm = gid * WGM, gsz = (nM - fm) < WGM ? (nM - fm) : WGM;
        u.pm = fm + ((wgid % nig) % gsz); u.pn = (wgid % nig) / gsz; return true;
    }
};
template <class Epi>
__device__ __forceinline__ void gemm_phase(LAS unsigned char* lds, const Gemm g, const StaticOrder& S, const Epi& E) {
    int tid_ = threadIdx.x; asm volatile("" : "+v"(tid_));
    const int tid = tid_, wid = __builtin_amdgcn_readfirstlane(tid >> 6), lane = tid & 63, wr = wid >> 2, wc = wid & 3, fr = lane & 15, fq = lane >> 4;
    const int K = g.K, nt = K / BK;
    unsigned voffA[2], voffB[2];
#pragma unroll
    for (int i = 0; i < 2; ++i) { int R, C; stage_rc(tid * 16 + i * 8192, R, C); const int Rb = (R & ~31) + perm32(R & 31);
        voffA[i] = (unsigned)(R * K + C) * 2u; voffB[i] = (unsigned)(Rb * K + C) * 2u; }
    const size_t kstep = (size_t)(BK * 2);
    const size_t hstep = (size_t)HALF * K * 2;
    const size_t tstep = 2 * hstep;
    const unsigned ldsw = (unsigned)wid * 1024u;
    const int aoff = lds_byte(wr * 64 + fr, fq * 8), boff = lds_byte(wc * 32 + fr, fq * 8);
#define PG8_SA(b, h) (((b) * 2 + (h)) * HTB)
#define PG8_SB(b, h) ((4 + (b) * 2 + (h)) * HTB)
#define PG8_STAGE(bufoff, gbase, voff) do { _Pragma("unroll") for (int _i = 0; _i < 2; ++_i) \
        __builtin_amdgcn_global_load_lds((const unsigned*)((const char*)(gbase) + (voff)[_i]), (LAS unsigned*)(lds + (bufoff) + ldsw + _i * 8192), 16, 0, 0); } while (0)
#define PG8_LDA(dst, b, h) do { _Pragma("unroll") for (int m = 0; m < 4; ++m) _Pragma("unroll") for (int k = 0; k < 2; ++k) dst[m][k] = *(const LAS bf16x8*)(lds + PG8_SA(b, h) + aoff + m * 2048 + k * 1024); } while (0)
#define PG8_LDB(dst, b, h) do { _Pragma("unroll") for (int n = 0; n < 2; ++n) _Pragma("unroll") for (int k = 0; k < 2; ++k) dst[n][k] = *(const LAS bf16x8*)(lds + PG8_SB(b, h) + boff + n * 2048 + k * 1024); } while (0)
#define PG8_MMA(ai, bj, At, Bt) do { __builtin_amdgcn_s_setprio(1); _Pragma("unroll") for (int m = 0; m < 4; ++m) _Pragma("unroll") for (int n = 0; n < 2; ++n) _Pragma("unroll") for (int k = 0; k < 2; ++k) \
        acc[ai][bj][m][n] = __builtin_amdgcn_mfma_f32_16x16x32_bf16(Bt[n][k], At[m][k], acc[ai][bj][m][n], 0, 0, 0); __builtin_amdgcn_s_setprio(0); } while (0)
#define PG8_WAIT_V(n) asm volatile("s_waitcnt vmcnt(" #n ")" ::: "memory")
#define PG8_WAIT_L(n) asm volatile("s_waitcnt lgkmcnt(" #n ")" ::: "memory")
#define PG8_BAR __builtin_amdgcn_s_barrier()
#define PG8_SCHED __builtin_amdgcn_sched_barrier(0)
    Unit cur, nxt; int ui = 0;
    if (!S.next(0, cur)) return;
    f32x4 acc[2][2][4][2];
#pragma unroll
    for (int a = 0; a < 2; ++a)
#pragma unroll
        for (int b = 0; b < 2; ++b)
#pragma unroll
            for (int m = 0; m < 4; ++m)
#pragma unroll
                for (int n = 0; n < 2; ++n) acc[a][b][m][n] = (f32x4){0.f, 0.f, 0.f, 0.f};
    bf16x8 At[4][2], B0[2][2], B1[2][2];
    const char* cA = (const char*)g.A + (size_t)cur.pm * tstep; const char* cB = (const char*)g.Bt + (size_t)cur.pn * tstep;
    {
        PG8_STAGE(PG8_SB(0, 0), cB, voffB); PG8_STAGE(PG8_SB(0, 1), cB + hstep, voffB); PG8_STAGE(PG8_SA(0, 0), cA, voffA); PG8_STAGE(PG8_SA(0, 1), cA + hstep, voffA);
        if (wr == 1) PG8_BAR;
        PG8_WAIT_V(2); PG8_BAR;
        PG8_STAGE(PG8_SB(1, 0), cB + kstep, voffB); PG8_STAGE(PG8_SA(1, 0), cA + kstep, voffA); PG8_STAGE(PG8_SB(1, 1), cB + hstep + kstep, voffB);
        PG8_WAIT_V(6); PG8_BAR;
    }
    for (;;) {
        const bool has_next = S.next(ui + 1, nxt);
        const char* nA = has_next ? (const char*)g.A + (size_t)nxt.pm * tstep : cA; const char* nB = has_next ? (const char*)g.Bt + (size_t)nxt.pn * tstep : cB;
        for (int t = 0; t < nt; t += 2) {
            const bool last = (t == nt - 2);
            const char* a1 = cA + (size_t)(t + 1) * kstep;
            const char* a2 = last ? nA : cA + (size_t)(t + 2) * kstep; const char* b2 = last ? nB : cB + (size_t)(t + 2) * kstep;
            const char* a3 = a2 + kstep; const char* b3 = b2 + kstep;
            PG8_LDB(B0, 0, 0); PG8_LDB(B1, 0, 1); PG8_SCHED; PG8_LDA(At, 0, 0); PG8_STAGE(PG8_SA(1, 1), a1 + hstep, voffA);
            PG8_WAIT_V(8); PG8_WAIT_L(0); PG8_BAR; PG8_MMA(0, 0, At, B0); PG8_MMA(0, 1, At, B1); PG8_BAR; PG8_SCHED;
            PG8_LDA(At, 0, 1); PG8_STAGE(PG8_SB(0, 0), b2, voffB); PG8_STAGE(PG8_SB(0, 1), b2 + hstep, voffB); PG8_STAGE(PG8_SA(0, 0), a2, voffA);
            PG8_WAIT_V(8); PG8_WAIT_L(0); PG8_BAR; PG8_MMA(1, 0, At, B0); PG8_MMA(1, 1, At, B1); PG8_BAR; PG8_SCHED;
            PG8_LDB(B0, 1, 0); PG8_LDB(B1, 1, 1); PG8_SCHED; PG8_LDA(At, 1, 0); PG8_STAGE(PG8_SA(0, 1), a2 + hstep, voffA);
            PG8_WAIT_V(8); PG8_WAIT_L(0); PG8_BAR; PG8_MMA(0, 0, At, B0); PG8_MMA(0, 1, At, B1); PG8_BAR; PG8_SCHED;
            PG8_LDA(At, 1, 1); PG8_STAGE(PG8_SB(1, 0), b3, voffB); PG8_STAGE(PG8_SB(1, 1), b3 + hstep, voffB); PG8_STAGE(PG8_SA(1, 0), a3, voffA);
            PG8_WAIT_V(8); PG8_WAIT_L(0); PG8_BAR; PG8_MMA(1, 0, At, B0); PG8_MMA(1, 1, At, B1); PG8_BAR; PG8_SCHED;
        }
        if (wr == 0) PG8_BAR;
        E(acc, cur, wr, wc, fr, fq);
        if (!has_next) break;
#pragma unroll
        for (int a = 0; a < 2; ++a)
#pragma unroll
            for (int b = 0; b < 2; ++b)
#pragma unroll
                for (int m = 0; m < 4; ++m)
#pragma unroll
                    for (int n = 0; n < 2; ++n) acc[a][b][m][n] = (f32x4){0.f, 0.f, 0.f, 0.f};
        cur = nxt; cA = nA; cB = nB; ++ui;
        if (wr == 1) PG8_BAR;
    }
    PG8_WAIT_V(0);
    PG8_BAR;
#undef PG8_SA
#undef PG8_SB
#undef PG8_STAGE
#undef PG8_LDA
#undef PG8_LDB
#undef PG8_MMA
#undef PG8_WAIT_V
#undef PG8_WAIT_L
#undef PG8_BAR
#undef PG8_SCHED
}

struct EpiScaleBf16 {
    bf16_t* O; int ldc; const float* rowss; bf16_t* O2; int ldc2; int split_tile; bf16_t* KD2;
    __device__ __forceinline__ void operator()(const f32x4 (&acc)[2][2][4][2], const Unit& u, int wr, int wc, int fr, int fq) const {
        const bool hi = u.pn >= split_tile, mid = (split_tile == 8) && u.pn >= 4 && u.pn < 8;
        const int row0 = u.pm * BM + wr * 64 + fr, col0 = (hi ? u.pn - split_tile : u.pn) * BM + wc * 32 + 8 * fq;
        bf16_t* const Ob = hi ? O2 : O; const int ld = hi ? ldc2 : ldc;
#pragma unroll
        for (int ai = 0; ai < 2; ++ai)
#pragma unroll
            for (int m = 0; m < 4; ++m) { const int row = row0 + ai * HALF + m * 16;
                const float sc = rowss ? row_rstd(rowss, row) : 1.f;
                bf16_t* rowp = Ob + (size_t)row * ld + col0;
#pragma unroll
                for (int bj = 0; bj < 2; ++bj) { const f32x4 v0 = acc[ai][bj][m][0] * sc, v1 = acc[ai][bj][m][1] * sc;
                    u32x4 w; w.x = pk2(v0[0], v0[1]); w.y = pk2(v0[2], v0[3]); w.z = pk2(v1[0], v1[1]); w.w = pk2(v1[2], v1[3]);
                    bf16_t* dst = rowp + bj * HALF;
                    if (mid) dst = KD2 + (u.pn >= 6 ? (size_t)8388608 : (size_t)0) + ((size_t)(((row >> 11) * 4 + 2 * (u.pn & 1) + bj) * 2048 + (row & 2047))) * 128 + wc * 32 + 8 * fq;
                    *(u32x4*)dst = w; } }
    }
};
struct EpiSwiGLU {
    bf16_t* O; const float* rowss;
    __device__ __forceinline__ void operator()(const f32x4 (&acc)[2][2][4][2], const Unit& u, int wr, int wc, int fr, int fq) const {
        const int row0 = u.pm * BM + wr * 64 + fr, col0 = u.pn * HALF + wc * 32 + 8 * fq;
#pragma unroll
        for (int ai = 0; ai < 2; ++ai)
#pragma unroll
            for (int m = 0; m < 4; ++m) { const int row = row0 + ai * HALF + m * 16;
                const float sc = row_rstd(rowss, row);
                float h[8];
#pragma unroll
                for (int n = 0; n < 2; ++n)
#pragma unroll
                    for (int j = 0; j < 4; ++j) { const float gt = acc[ai][0][m][n][j] * sc, up = acc[ai][1][m][n][j] * sc; h[n * 4 + j] = gt * __builtin_amdgcn_rcpf(1.f + __expf(-gt)) * up; }
                u32x4 w; w.x = pk2(h[0], h[1]); w.y = pk2(h[2], h[3]); w.z = pk2(h[4], h[5]); w.w = pk2(h[6], h[7]);
                *(u32x4*)(O + (size_t)row * DFF + col0) = w; }
    }
};
struct EpiResid {
    float* X; bf16_t* XB; float* rowss_next;
    __device__ __forceinline__ void operator()(const f32x4 (&acc)[2][2][4][2], const Unit& u, int wr, int wc, int fr, int fq) const {
        const int row0 = u.pm * BM + wr * 64 + fr, col0 = u.pn * BM + wc * 32 + 8 * fq;
#pragma unroll
        for (int ai = 0; ai < 2; ++ai)
#pragma unroll
            for (int m = 0; m < 4; ++m) { const int row = row0 + ai * HALF + m * 16; float ss = 0.f;
                float* xp = X + (size_t)row * DM + col0; bf16_t* bp = XB + (size_t)row * DM + col0;
#pragma unroll
                for (int bj = 0; bj < 2; ++bj) {
                    f32x4 x0 = *(f32x4*)(xp + bj * HALF), x1 = *(f32x4*)(xp + bj * HALF + 4);
                    x0 = x0 + acc[ai][bj][m][0]; x1 = x1 + acc[ai][bj][m][1];
                    *(f32x4*)(xp + bj * HALF) = x0; *(f32x4*)(xp + bj * HALF + 4) = x1;
                    ss += (x0[0] * x0[0] + x0[1] * x0[1]) + (x0[2] * x0[2] + x0[3] * x0[3]) + (x1[0] * x1[0] + x1[1] * x1[1]) + (x1[2] * x1[2] + x1[3] * x1[3]);
                    u32x4 w; w.x = pk2(x0[0], x0[1]); w.y = pk2(x0[2], x0[3]); w.z = pk2(x1[0], x1[1]); w.w = pk2(x1[2], x1[3]);
                    *(u32x4*)(bp + bj * HALF) = w; }
                ss += __shfl_xor(ss, 16); ss += __shfl_xor(ss, 32);
                if (fq == 0) rowss_next[(size_t)row * 16 + u.pn * 4 + wc] = ss; }
    }
};
}

struct KArgs { const float* in[31]; float* out; unsigned char* ws; };
#define CAS __attribute__((address_space(4)))
struct InProxy { const CAS unsigned long long* k; __device__ __forceinline__ const float* operator[](int i) const { return (const float*)k[i]; } };
struct Params { InProxy in; float* out; unsigned char* ws; };
__device__ __forceinline__ Params make_params() {
    unsigned long long kv = (unsigned long long)__builtin_amdgcn_kernarg_segment_ptr();
    asm volatile("" : "+s"(kv));
    const CAS unsigned long long* k = (const CAS unsigned long long*)kv;
    Params p; p.in.k = k; p.out = (float*)k[31]; p.ws = (unsigned char*)k[32]; return p;
}

struct Frame {
    LAS unsigned char* lds;
    int tid, lane, wave, G, bid;
};

#define REFRAME(F) do { int _t = threadIdx.x; asm volatile("" : "+v"(_t)); (F).tid = _t; (F).lane = _t & 63; (F).wave = __builtin_amdgcn_readfirstlane(_t >> 6); } while (0)
__device__ __forceinline__ void cvt_item(const float* W_, int K, int ldn, int nblk, bf16_t* WT_, const float* gain_, bool perm_gu, LAS float* scr, int item, int lane) {
    const GAS float* W = (const GAS float*)W_; const GAS float* gain = (const GAS float*)gain_; GAS bf16_t* WT = (GAS bf16_t*)WT_;
    const int kb = item / nblk, nb = item % nblk, k0 = 64 * kb, n0d = 32 * nb;
    const int n0s = perm_gu ? (((n0d & 255) >> 7) * DFF + (n0d >> 8) * 128 + (n0d & 127)) : n0d;
    float v[32];
#pragma unroll
    for (int i = 0; i < 32; ++i) v[i] = W[(size_t)(k0 + 2 * i + (lane >> 5)) * ldn + n0s + (lane & 31)];
    if (gain_) {
#pragma unroll
        for (int i = 0; i < 32; ++i) v[i] *= gain[k0 + 2 * i + (lane >> 5)];
    }
#pragma unroll
    for (int i = 0; i < 32; ++i) scr[(2 * i + (lane >> 5)) * 33 + (lane & 31)] = v[i];
    asm volatile("s_waitcnt lgkmcnt(0)" ::: "memory");
    const int c = lane & 7;
#pragma unroll
    for (int j = 0; j < 4; ++j) { const int n = (lane >> 3) + 8 * j; const LAS float* sp = scr + (8 * c) * 33 + n;
        u32x4 o; o.x = pk2(sp[0 * 33], sp[1 * 33]); o.y = pk2(sp[2 * 33], sp[3 * 33]); o.z = pk2(sp[4 * 33], sp[5 * 33]); o.w = pk2(sp[6 * 33], sp[7 * 33]);
        *(GAS u32x4*)(WT + (size_t)(n0d + n) * K + k0 + 8 * c) = o; }
    asm volatile("s_waitcnt lgkmcnt(0)" ::: "memory");
}
constexpr int CV_IN = 1536, CV_OUT = 512, CV_Q = 256, CV_KV = 512, CV_O = 256, CV_GU = 2816, CV_DOWN = 1408, CV_L = 8;
constexpr int CV_TOTAL = CV_IN + CV_OUT + CV_Q + CV_KV + CV_O + CV_GU + CV_DOWN + 2 * CV_L + 2 * CV_L + 16;

static_assert(CV_TOTAL % 8 == 0, "conversion items per layer");
constexpr int CV_A = CV_IN + 2 * CV_L + 2 * CV_L + 16, CV_B = CV_KV + CV_OUT + CV_Q + CV_O + CV_GU + CV_DOWN;
static_assert(CV_A % 8 == 0 && CV_B % 8 == 0 && CV_A + CV_B == CV_TOTAL, "conversion lists");
__device__ __forceinline__ void cvt_item_a(const Params& p, int l, bf16_t* wb, LAS float* scr, int it, int lane) {
    int r = it;
    if (r < CV_IN) { cvt_item(p.in[3] + (size_t)l * DM * INW, DM, INW, INW / 32, wb + WO_IN, p.in[2] + l * DM, false, scr, r, lane); return; } r -= CV_IN;
    if (r < 2 * CV_L) { const int d = r / CV_L; cvt_item(p.in[12] + ((size_t)l * 2 + d) * 64 * 256, 64, 256, 8, wb + WO_WUP + d * 256 * 64, nullptr, false, scr, r % CV_L, lane); return; } r -= 2 * CV_L;
    if (r < 2 * CV_L) { const int d = r / CV_L; cvt_item(p.in[14] + ((size_t)l * 2 + d) * 64 * 256, 64, 256, 8, wb + WO_AUP + d * 256 * 64, nullptr, false, scr, r % CV_L, lane); return; } r -= 2 * CV_L;
    cvt_item(p.in[15] + (size_t)l * 128 * 256, 128, 256, 8, wb + WO_GUP, nullptr, false, scr, r, lane);
}
__device__ __forceinline__ void cvt_item_b(const Params& p, int l, bf16_t* wb, LAS float* scr, int it, int lane) {
    int r = it;
    if (r < CV_KV) { cvt_item(p.in[25] + (size_t)l * DM * 1024, DM, 1024, 32, wb + WO_KV, nullptr, false, scr, r, lane); return; } r -= CV_KV;
    if (r < CV_OUT) { cvt_item(p.in[21] + (size_t)l * DM * DM, DM, DM, DM / 32, wb + WO_OUT, nullptr, false, scr, r, lane); return; } r -= CV_OUT;
    if (r < CV_Q) { cvt_item(p.in[24] + (size_t)l * DM * XW, DM, XW, XW / 32, wb + WO_Q, p.in[22] + l * DM, false, scr, r, lane); return; } r -= CV_Q;
    if (r < CV_O) { cvt_item(p.in[26] + (size_t)l * XW * DM, XW, DM, 32, wb + WO_O, nullptr, false, scr, r, lane); return; } r -= CV_O;
    if (r < CV_GU) { cvt_item(p.in[28] + (size_t)l * DM * 2 * DFF, DM, 2 * DFF, 2 * DFF / 32, wb + WO_GU, p.in[27] + l * DM, true, scr, r, lane); return; } r -= CV_GU;
    cvt_item(p.in[29] + (size_t)l * DFF * DM, DFF, DM, 32, wb + WO_DOWN, nullptr, false, scr, r, lane);
}

__device__ __forceinline__ s16x4 vtr(const LAS unsigned char* p) { return __builtin_bit_cast(s16x4, __builtin_amdgcn_ds_read_tr16_b64_v4i16((LAS v4i16_t*)p)); }
__device__ __forceinline__ int crow(int r, int hi) { return (r & 3) + 8 * (r >> 2) + 4 * hi; }

template <int W> __device__ __forceinline__ void tile_load(u32x4 (&r)[W / 64], const bf16_t* g, int pitch, int tid) {
#pragma unroll
    for (int i = 0; i < W / 64; ++i) { const int id = tid + i * 512, row = id / (W / 8), ch = id % (W / 8); r[i] = *(const GAS u32x4*)((const GAS bf16_t*)g + (size_t)row * pitch + ch * 8); }
}
template <int W, int STR> __device__ __forceinline__ void tile_store(const u32x4 (&r)[W / 64], LAS unsigned char* buf, int tid) {
#pragma unroll
    for (int i = 0; i < W / 64; ++i) { const int id = tid + i * 512, row = id / (W / 8), ch = id % (W / 8); *(LAS u32x4*)(buf + row * STR + ch * 16) = r[i]; }
}
template <int DQK> __device__ __forceinline__ void load_q(bf16x8 (&qf)[DQK / 16], const bf16_t* qrow, int h, float sc) {
#pragma unroll
    for (int ks = 0; ks < DQK / 16; ++ks) { const u32x4 v = *(const GAS u32x4*)((const GAS bf16_t*)qrow + 16 * ks + 8 * h);
        u32x4 o; o.x = pk2(bflo(v.x) * sc, bfhi(v.x) * sc); o.y = pk2(bflo(v.y) * sc, bfhi(v.y) * sc); o.z = pk2(bflo(v.z) * sc, bfhi(v.z) * sc); o.w = pk2(bflo(v.w) * sc, bfhi(v.w) * sc);
        qf[ks] = __builtin_bit_cast(bf16x8, o); }
}
template <int DQK, int KW, int DV, int MODE>
__device__ __forceinline__ void attn_loop(LAS unsigned char* lds, const bf16_t* Kg, int kpitch, const bf16_t* Vg, int vpitch, int ntiles,
                                          const bf16x8 (&qf)[DQK / 16], int koff, float nslope2, int qrel, float& m, float& lsum, f32x16 (&o)[DV / 32]) {
    constexpr int KSTR = (KW + 8) * 2, VSTR = DV * 2 + 64, KBUF = 64 * KSTR, VBUF = 64 * VSTR;
    int tid_ = threadIdx.x; asm volatile("" : "+v"(tid_));
    const int tid = tid_, lane = tid & 63, r = lane & 31, h = lane >> 5;
    LAS unsigned char* K0 = lds; LAS unsigned char* V0 = lds + 2 * KBUF;
    u32x4 kr[KW / 64], vr[DV / 64];
    tile_load<KW>(kr, Kg, kpitch, tid); tile_load<DV>(vr, Vg, vpitch, tid);
    tile_store<KW, KSTR>(kr, K0, tid); tile_store<DV, VSTR>(vr, V0, tid);
    __syncthreads();
    const int vlane = ((lane & 15) >> 2) * VSTR + (16 * ((lane >> 4) & 1) + 4 * (lane & 3)) * 2 + 4 * h * VSTR;
    for (int t = 0; t < ntiles; ++t) {
        const int cur = t & 1;
        if (t + 1 < ntiles) { tile_load<KW>(kr, Kg + (size_t)(t + 1) * 64 * kpitch, kpitch, tid); tile_load<DV>(vr, Vg + (size_t)(t + 1) * 64 * vpitch, vpitch, tid); }
        const LAS unsigned char* Kb = K0 + cur * KBUF + r * KSTR + (koff + 8 * h) * 2;
        const LAS unsigned char* Vb = V0 + cur * VBUF + vlane;
        f32x16 s0, s1;
#pragma unroll
        for (int i = 0; i < 16; ++i) { s0[i] = 0.f; s1[i] = 0.f; }
#pragma unroll
        for (int ks = 0; ks < DQK / 16; ++ks) {
            const bf16x8 k0 = *(const LAS bf16x8*)(Kb + ks * 32), k1 = *(const LAS bf16x8*)(Kb + 32 * KSTR + ks * 32);
            s0 = __builtin_amdgcn_mfma_f32_32x32x16_bf16(k0, qf[ks], s0, 0, 0, 0);
            s1 = __builtin_amdgcn_mfma_f32_32x32x16_bf16(k1, qf[ks], s1, 0, 0, 0);
        }
        float Aoff = 0.f;
        if (MODE >= 1) {
            const int qrel0 = __builtin_amdgcn_readfirstlane(qrel - r);
            const int T0 = t * 64;
            if (MODE == 1 && (T0 + 64 <= qrel0 || T0 > qrel0 + 31)) {
                const bool left = (T0 + 64 <= qrel0);
                const float sl = left ? -nslope2 : nslope2;
                Aoff = left ? nslope2 * (float)(qrel - T0 - 4 * h) : nslope2 * (float)(T0 + 4 * h - qrel);
#pragma unroll
                for (int i = 0; i < 16; ++i) { s0[i] = __builtin_fmaf(sl, (float)((i & 3) + 8 * (i >> 2)), s0[i]); s1[i] = __builtin_fmaf(sl, (float)(32 + (i & 3) + 8 * (i >> 2)), s1[i]); }
            } else {
                const float base = (float)(T0 + 4 * h - qrel);
#pragma unroll
                for (int i = 0; i < 16; ++i) {
                    const float d0 = fabsf(base + (float)((i & 3) + 8 * (i >> 2))), d1 = fabsf(base + (float)(32 + (i & 3) + 8 * (i >> 2)));
                    s0[i] = __builtin_fmaf(d0, nslope2, s0[i]); s1[i] = __builtin_fmaf(d1, nslope2, s1[i]);
                    if (MODE == 2) { if (d0 > 128.f) s0[i] = -1e30f; if (d1 > 128.f) s1[i] = -1e30f; }
                }
            }
        }
        float mx = fmaxf(s0[0], s1[0]);
#pragma unroll
        for (int i = 1; i < 16; ++i) mx = fmaxf(fmaxf(mx, s0[i]), s1[i]);
        mx += Aoff;
        mx = fmaxf(mx, xhalf(mx));
        const float mnew = fmaxf(m, mx);
        if (__builtin_amdgcn_ballot_w64(mnew > m) != 0ull) {
            const float alpha = __builtin_amdgcn_exp2f(m - mnew);
            lsum *= alpha;
#pragma unroll
            for (int d = 0; d < DV / 32; ++d) o[d] = o[d] * alpha;
        }
        m = mnew;
        const float mm = mnew - Aoff;
        float rs = 0.f;
#pragma unroll
        for (int i = 0; i < 16; ++i) { s0[i] = __builtin_amdgcn_exp2f(s0[i] - mm); s1[i] = __builtin_amdgcn_exp2f(s1[i] - mm); rs += s0[i] + s1[i]; }
        lsum += rs;
        bf16x8 pf[4];
#pragma unroll
        for (int s2 = 0; s2 < 2; ++s2) {
            u32x4 a, b;
            a.x = pk2(s0[8 * s2 + 0], s0[8 * s2 + 1]); a.y = pk2(s0[8 * s2 + 2], s0[8 * s2 + 3]); a.z = pk2(s0[8 * s2 + 4], s0[8 * s2 + 5]); a.w = pk2(s0[8 * s2 + 6], s0[8 * s2 + 7]);
            b.x = pk2(s1[8 * s2 + 0], s1[8 * s2 + 1]); b.y = pk2(s1[8 * s2 + 2], s1[8 * s2 + 3]); b.z = pk2(s1[8 * s2 + 4], s1[8 * s2 + 5]); b.w = pk2(s1[8 * s2 + 6], s1[8 * s2 + 7]);
            pf[s2] = __builtin_bit_cast(bf16x8, a); pf[2 + s2] = __builtin_bit_cast(bf16x8, b);
        }
#pragma unroll
        for (int d = 0; d < DV / 32; ++d) {
#pragma unroll
            for (int kk = 0; kk < 4; ++kk) {
                const s16x4 lo = vtr(Vb + (16 * kk) * VSTR + d * 64), hi = vtr(Vb + (16 * kk + 8) * VSTR + d * 64);
                const bf16x8 vf = {lo[0], lo[1], lo[2], lo[3], hi[0], hi[1], hi[2], hi[3]};
                o[d] = __builtin_amdgcn_mfma_f32_32x32x16_bf16(vf, pf[kk], o[d], 0, 0, 0);
            }
        }
        if (t + 1 < ntiles) { tile_store<KW, KSTR>(kr, K0 + (cur ^ 1) * KBUF, tid); tile_store<DV, VSTR>(vr, V0 + (cur ^ 1) * VBUF, tid); }
        __syncthreads();
    }
}
__device__ __forceinline__ int swz(int row) { return ((row & 3) << 2) | ((row >> 2) & 3); }
template <int DQK, int MODE, int pitch, int voff>
__device__ __forceinline__ void attn_loop_dma(LAS unsigned char* lds, const int wave, const bf16_t* Kg, int ntiles,
                                              const bf16x8 (&qf)[DQK / 16], int koff, float nslope2, int qrel, float& m, float& lsum, f32x16 (&o)[4]) {
    constexpr int DV = 128, STAGE = 32768, VOFFB = 16384;
    const int lane = hw_lane(), r = lane & 31, h = lane >> 5;
    unsigned gk[2];
#pragma unroll
    for (int i = 0; i < 2; ++i) { const int row = 4 * (2 * wave + i) + (lane >> 4), c = (lane & 15) ^ swz(row); gk[i] = (unsigned)(row * pitch + c * 8); }
    unsigned kad[DQK / 16], vad[4][2];
#pragma unroll
    for (int ks = 0; ks < DQK / 16; ++ks) kad[ks] = (unsigned)(r * 256 + 16 * (((koff >> 3) + 2 * ks + h) ^ swz(r)));
    { const int q_ = (lane & 15) >> 2, pp = lane & 3, g1 = (lane >> 4) & 1;
#pragma unroll
      for (int d = 0; d < 4; ++d)
#pragma unroll
          for (int hi = 0; hi < 2; ++hi) { const int f = (q_ << 2) | ((2 * hi + h) & 3), c = (4 * d + 2 * g1 + (pp >> 1)) ^ f;
              vad[d][hi] = (unsigned)(VOFFB + (4 * h + q_) * 256 + 16 * c + 8 * (pp & 1) + hi * 2048); } }
#define ATT_DMA(tt, st) do { const bf16_t* kg_ = Kg + (size_t)(tt) * 64 * pitch; _Pragma("unroll") for (int i_ = 0; i_ < 2; ++i_) { \
        __builtin_amdgcn_global_load_lds((const unsigned*)(kg_ + gk[i_]), (LAS unsigned*)(lds + (st) * STAGE + (2 * wave + i_) * 1024), 16, 0, 0); \
        __builtin_amdgcn_global_load_lds((const unsigned*)(kg_ + voff + gk[i_]), (LAS unsigned*)(lds + (st) * STAGE + VOFFB + (2 * wave + i_) * 1024), 16, 0, 0); } } while (0)
    ATT_DMA(0, 0);
    if (ntiles > 1) ATT_DMA(1, 1);
    if (ntiles > 2) { ATT_DMA(2, 2); asm volatile("s_waitcnt vmcnt(4)" ::: "memory"); } else asm volatile("s_waitcnt vmcnt(0)" ::: "memory");
    __builtin_amdgcn_s_barrier();
    f32x16 s0, s1;
#pragma unroll
    for (int i = 0; i < 16; ++i) { s0[i] = 0.f; s1[i] = 0.f; }
#pragma unroll
    for (int ks = 0; ks < DQK / 16; ++ks) {
        const bf16x8 k0 = *(const LAS bf16x8*)(lds + kad[ks]), k1 = *(const LAS bf16x8*)(lds + kad[ks] + 8192);
        s0 = __builtin_amdgcn_mfma_f32_32x32x16_bf16(k0, qf[ks], s0, 0, 0, 0);
        s1 = __builtin_amdgcn_mfma_f32_32x32x16_bf16(k1, qf[ks], s1, 0, 0, 0);
    }
#define LDS_RD128(dst, addr, off) asm volatile("ds_read_b128 %0, %1 offset:%c2" : "=&v"(dst) : "v"(addr), "i"(off) : "memory")
#define LDS_RDTR(dst, addr, off) asm volatile("ds_read_b64_tr_b16 %0, %1 offset:%c2" : "=&v"(dst) : "v"(addr), "i"(off) : "memory")
#define LDS_WAIT0() do { asm volatile("s_waitcnt lgkmcnt(0)" ::: "memory"); __builtin_amdgcn_sched_barrier(0); } while (0)
    for (int t = 0; t < ntiles; ++t) {
        if (t + 3 < ntiles) ATT_DMA(t + 3, (t + 3) & 3);
        const unsigned sba = (unsigned)(size_t)(lds + (t & 3) * STAGE), sna = (unsigned)(size_t)(lds + ((t + 1) & 3) * STAGE);
        constexpr int KH = (DQK == 64) ? 4 : 4;
        bf16x8 kf0[KH], kf1[KH];
        s16x4 va_lo[4], va_hi[4], vb_lo[4], vb_hi[4];
        if (DQK == 64) {
#pragma unroll
            for (int ks = 0; ks < KH; ++ks) { const unsigned ka = sna + kad[ks]; LDS_RD128(kf0[ks], ka, 0); } }
        __builtin_amdgcn_sched_barrier(0);
        float Aoff = 0.f;
        if (MODE >= 1) {
            const int qrel0 = __builtin_amdgcn_readfirstlane(qrel - r);
            const int T0 = t * 64;
            if (MODE == 1 && (T0 + 64 <= qrel0 || T0 > qrel0 + 31)) {
                const bool left = (T0 + 64 <= qrel0);
                const float sl = left ? -nslope2 : nslope2;
                Aoff = left ? nslope2 * (float)(qrel - T0 - 4 * h) : nslope2 * (float)(T0 + 4 * h - qrel);
#pragma unroll
                for (int i = 0; i < 16; ++i) { s0[i] = __builtin_fmaf(sl, (float)((i & 3) + 8 * (i >> 2)), s0[i]); s1[i] = __builtin_fmaf(sl, (float)(32 + (i & 3) + 8 * (i >> 2)), s1[i]); }
            } else {
                const float base = (float)(T0 + 4 * h - qrel);
#pragma unroll
                for (int i = 0; i < 16; ++i) {
                    const float d0 = fabsf(base + (float)((i & 3) + 8 * (i >> 2))), d1 = fabsf(base + (float)(32 + (i & 3) + 8 * (i >> 2)));
                    s0[i] = __builtin_fmaf(d0, nslope2, s0[i]); s1[i] = __builtin_fmaf(d1, nslope2, s1[i]);
                    if (MODE == 2) { if (d0 > 128.f) s0[i] = -1e30f; if (d1 > 128.f) s1[i] = -1e30f; }
                }
            }
        }
        float mx = fmaxf(s0[0], s1[0]);
#pragma unroll
        for (int i = 1; i < 16; ++i) mx = fmaxf(fmaxf(mx, s0[i]), s1[i]);
        mx += Aoff;
        mx = fmaxf(mx, xhalf(mx));
        const float mnew = fmaxf(m, mx);
        if (__builtin_amdgcn_ballot_w64(mnew > m) != 0ull) {
            const float alpha = __builtin_amdgcn_exp2f(m - mnew);
            lsum *= alpha;
#pragma unroll
            for (int d = 0; d < DV / 32; ++d) o[d] = o[d] * alpha;
        }
        m = mnew;
        const float mm = mnew - Aoff;
        float rs = 0.f;
#pragma unroll
        for (int i = 0; i < 16; ++i) { s0[i] = __builtin_amdgcn_exp2f(s0[i] - mm); s1[i] = __builtin_amdgcn_exp2f(s1[i] - mm); rs += s0[i] + s1[i]; }
        lsum += rs;
        bf16x8 pf[4];
#pragma unroll
        for (int s2 = 0; s2 < 2; ++s2) {
            u32x4 a, b;
            a.x = pk2(s0[8 * s2 + 0], s0[8 * s2 + 1]); a.y = pk2(s0[8 * s2 + 2], s0[8 * s2 + 3]); a.z = pk2(s0[8 * s2 + 4], s0[8 * s2 + 5]); a.w = pk2(s0[8 * s2 + 6], s0[8 * s2 + 7]);
            b.x = pk2(s1[8 * s2 + 0], s1[8 * s2 + 1]); b.y = pk2(s1[8 * s2 + 2], s1[8 * s2 + 3]); b.z = pk2(s1[8 * s2 + 4], s1[8 * s2 + 5]); b.w = pk2(s1[8 * s2 + 6], s1[8 * s2 + 7]);
            pf[s2] = __builtin_bit_cast(bf16x8, a); pf[2 + s2] = __builtin_bit_cast(bf16x8, b);
        }
        LDS_WAIT0();
        if (DQK == 64) {
#pragma unroll
            for (int ks = 0; ks < KH; ++ks) { const unsigned ka = sna + kad[ks]; LDS_RD128(kf1[ks], ka, 8192); } }
        { const unsigned alo = sba + vad[0][0], ahi = sba + vad[0][1];
#pragma unroll
          for (int kk = 0; kk < 4; ++kk) { LDS_RDTR(va_lo[kk], alo, kk * 4096); LDS_RDTR(va_hi[kk], ahi, kk * 4096); } }
        __builtin_amdgcn_sched_barrier(0);
        f32x16 n0, n1;
#pragma unroll
        for (int i = 0; i < 16; ++i) { n0[i] = 0.f; n1[i] = 0.f; }
#pragma unroll
        for (int g = 0; g < DQK / 64; ++g) {
            if (DQK != 64) {
#pragma unroll
                for (int ks = 0; ks < KH; ++ks) { const unsigned ka = sna + kad[g * KH + ks]; LDS_RD128(kf0[ks], ka, 0); LDS_RD128(kf1[ks], ka, 8192); }
                LDS_WAIT0(); }
#pragma unroll
            for (int ks = 0; ks < KH; ++ks) n0 = __builtin_amdgcn_mfma_f32_32x32x16_bf16(kf0[ks], qf[g * KH + ks], n0, 0, 0, 0);
            if (DQK == 64) LDS_WAIT0();
#pragma unroll
            for (int ks = 0; ks < KH; ++ks) n1 = __builtin_amdgcn_mfma_f32_32x32x16_bf16(kf1[ks], qf[g * KH + ks], n1, 0, 0, 0);
        }
#define PV_BLOCK(d, lo, hi) do { _Pragma("unroll") for (int kk = 0; kk < 4; ++kk) { const bf16x8 vf = {lo[kk][0], lo[kk][1], lo[kk][2], lo[kk][3], hi[kk][0], hi[kk][1], hi[kk][2], hi[kk][3]}; \
            o[d] = __builtin_amdgcn_mfma_f32_32x32x16_bf16(vf, pf[kk], o[d], 0, 0, 0); } } while (0)
#define V_ISSUE(d, lo, hi) do { const unsigned alo_ = sba + vad[d][0], ahi_ = sba + vad[d][1]; _Pragma("unroll") for (int kk = 0; kk < 4; ++kk) { LDS_RDTR(lo[kk], alo_, kk * 4096); LDS_RDTR(hi[kk], ahi_, kk * 4096); } } while (0)
        LDS_WAIT0();
        V_ISSUE(1, vb_lo, vb_hi); __builtin_amdgcn_sched_barrier(0);
        PV_BLOCK(0, va_lo, va_hi);
        LDS_WAIT0();
        V_ISSUE(2, va_lo, va_hi); __builtin_amdgcn_sched_barrier(0);
        PV_BLOCK(1, vb_lo, vb_hi);
        LDS_WAIT0();
        V_ISSUE(3, vb_lo, vb_hi); __builtin_amdgcn_sched_barrier(0);
        PV_BLOCK(2, va_lo, va_hi);
        LDS_WAIT0();
        PV_BLOCK(3, vb_lo, vb_hi);
#undef PV_BLOCK
#undef V_ISSUE
        s0 = n0; s1 = n1;
        if (t + 3 < ntiles) asm volatile("s_waitcnt vmcnt(4)" ::: "memory"); else asm volatile("s_waitcnt vmcnt(0)" ::: "memory");
        __builtin_amdgcn_s_barrier();
    }
#undef LDS_RD128
#undef LDS_RDTR
#undef LDS_WAIT0
#undef ATT_DMA
}
template <int DV> __device__ __forceinline__ void store_o(const f32x16 (&o)[DV / 32], float sc, bf16_t* orow, int h) {
#pragma unroll
    for (int d = 0; d < DV / 32; ++d)
#pragma unroll
        for (int g4 = 0; g4 < 4; ++g4) { u32x2 w; w.x = pk2(o[d][4 * g4] * sc, o[d][4 * g4 + 1] * sc); w.y = pk2(o[d][4 * g4 + 2] * sc, o[d][4 * g4 + 3] * sc);
            *(GAS u32x2*)((GAS bf16_t*)orow + 32 * d + 8 * g4 + 4 * h) = w; }
}

__device__ __forceinline__ void win_unit(Frame& F, const Params& p, int l, int u) {
    REFRAME(F);
    const bf16_t* Z = (const bf16_t*)(p.ws + WS_Z); bf16_t* MIX = (bf16_t*)(p.ws + WS_MIX);
    const int b = u >> 5, kvh = (u >> 4) & 1, nb = u & 15, r = F.lane & 31, h = F.lane >> 5;
    const int g = F.wave >> 2, hq = kvh * 2 + g, qpos = nb * 128 + (F.wave & 3) * 32 + r;
    const size_t tok = (size_t)b * SEQ + qpos;
    bf16x8 qf[4]; load_q<64>(qf, Z + tok * ZP + hq * 64, h, 0.125f * LOG2E);
    const int first = (2 * nb - 2 < 0) ? 0 : 2 * nb - 2, lastx = (2 * nb + 4 > 32) ? 32 : 2 * nb + 4, nt = lastx - first;
    const float slope = exp2f(-(float)(2 * hq + 1));
    float m = p.in[4][l * 4 + hq] * LOG2E, ls = (h == 0) ? 1.f : 0.f;
    f32x16 o[2];
#pragma unroll
    for (int d = 0; d < 2; ++d)
#pragma unroll
        for (int i = 0; i < 16; ++i) o[d][i] = 0.f;
    const bf16_t* Kg = Z + ((size_t)b * SEQ + first * 64) * ZP + 256 + kvh * 64;
    attn_loop<64, 64, 64, 2>(F.lds, Kg, ZP, Kg + 128, ZP, nt, qf, 0, -slope * LOG2E, qpos - first * 64, m, ls, o);
    const float lt = ls + xhalf(ls);
    store_o<64>(o, 1.f / lt, MIX + tok * DM + hq * 64, h);
}
__device__ __forceinline__ void diff_unit(Frame& F, const Params& p, int l, int u) {
    REFRAME(F);
    const bf16_t* Z = (const bf16_t*)(p.ws + WS_Z); bf16_t* MIX = (bf16_t*)(p.ws + WS_MIX);
    const int b = u >> 6, hh = (u >> 4) & 3, qb = u & 15, r = F.lane & 31, h = F.lane >> 5;
    const int c = F.wave >> 2, qpos = qb * 128 + (F.wave & 3) * 32 + r;
    const size_t tok = (size_t)b * SEQ + qpos;
    float lam, lam_init;
    {
        const float a1 = wave_sum(p.in[5][l * 64 + F.lane] * p.in[6][l * 64 + F.lane]), a2 = wave_sum(p.in[7][l * 64 + F.lane] * p.in[8][l * 64 + F.lane]);
        lam_init = 0.8f - 0.6f * expf(-0.3f * (float)l);
        lam = expf(a1) - expf(a2) + lam_init;
    }
    bf16x8 qf[4]; load_q<64>(qf, Z + tok * ZP + 512 + hh * 128 + c * 64, h, 0.125f * LOG2E);
    const float slope = exp2f(-(float)(2 * hh + 2));
    float m = -1e30f, ls = 0.f;
    f32x16 o[4];
#pragma unroll
    for (int d = 0; d < 4; ++d)
#pragma unroll
        for (int i = 0; i < 16; ++i) o[d][i] = 0.f;
    const bf16_t* Kg = (const bf16_t*)(p.ws + WS_KD2) + (size_t)(b * 4 + hh) * 2048 * 128;
    attn_loop_dma<64, 1, 128, 8388608>(F.lds, F.wave, Kg, 32, qf, c * 64, -slope * LOG2E, qpos, m, ls, o);
    const float inv = 1.f / (ls + xhalf(ls));
    LAS float* comb = (LAS float*)F.lds + (size_t)(F.wave & 3) * 64 * 64 + F.lane;
    if (c == 1) {
#pragma unroll
        for (int d = 0; d < 4; ++d)
#pragma unroll
            for (int i = 0; i < 16; ++i) comb[(d * 16 + i) * 64] = o[d][i] * inv;
    }
    __syncthreads();
    if (c == 0) {
        float ss = 0.f;
#pragma unroll
        for (int d = 0; d < 4; ++d)
#pragma unroll
            for (int i = 0; i < 16; ++i) { const float a = o[d][i] * inv - lam * comb[(d * 16 + i) * 64]; o[d][i] = a; ss += a * a; }
        ss += xhalf(ss);
        const float rn = rsqrtf(ss * (1.f / 128.f) + 1e-6f) * (1.f - lam_init);
        const float* sg = p.in[9] + l * 128;
        bf16_t* orow = MIX + tok * DM + 256 + hh * 128;
        f32x4 ggv[4][4];
#pragma unroll
        for (int d = 0; d < 4; ++d)
#pragma unroll
            for (int g4 = 0; g4 < 4; ++g4) ggv[d][g4] = *(const GAS f32x4*)((const GAS float*)sg + 32 * d + 8 * g4 + 4 * h);
#pragma unroll
        for (int d = 0; d < 4; ++d)
#pragma unroll
            for (int g4 = 0; g4 < 4; ++g4) { const int dv = 32 * d + 8 * g4 + 4 * h; const f32x4 gg = ggv[d][g4];
                u32x2 w; w.x = pk2(o[d][4 * g4] * rn * gg[0], o[d][4 * g4 + 1] * rn * gg[1]); w.y = pk2(o[d][4 * g4 + 2] * rn * gg[2], o[d][4 * g4 + 3] * rn * gg[3]);
                *(GAS u32x2*)((GAS bf16_t*)orow + dv) = w; }
    }
    __syncthreads();
}
__device__ __forceinline__ void cross_unit(Frame& F, const Params& p, int u) {
    REFRAME(F);
    const bf16_t* Q = (const bf16_t*)(p.ws + WS_Q); const bf16_t* KV = (const bf16_t*)(p.ws + WS_KV); bf16_t* O = (bf16_t*)(p.ws + WS_O);
    const int b = u >> 5, hd = (u >> 3) & 3, qb = u & 7, r = F.lane & 31, h = F.lane >> 5;
    const size_t tok = (size_t)b * SEQ + qb * 256 + F.wave * 32 + r;
    bf16x8 qf[8]; load_q<128>(qf, Q + tok * XW + hd * 128, h, 0.08838834764831845f * LOG2E);
    float m = -1e30f, ls = 0.f;
    f32x16 o[4];
#pragma unroll
    for (int d = 0; d < 4; ++d)
#pragma unroll
        for (int i = 0; i < 16; ++i) o[d][i] = 0.f;
    const bf16_t* Kg = KV + ((size_t)b * NMEM) * 1024 + hd * 128;
    attn_loop_dma<128, 0, 1024, 512>(F.lds, F.wave, Kg, 4, qf, 0, 0.f, 0, m, ls, o);
    const float lt = ls + xhalf(ls);
    store_o<128>(o, 1.f / lt, O + tok * XW + hd * 128, h);
}

constexpr int CF_STR = 772, PREP_AW = 32 * CF_STR * 4, PREP_AA = PREP_AW + 32 * 72 * 2, PREP_AG = PREP_AA + 32 * 72 * 2;
__device__ __forceinline__ void prep_unit(Frame& F, const Params& p, int l, const bf16_t* wb, int u) {
    REFRAME(F);
    const bf16_t* ZC = (const bf16_t*)(p.ws + WS_ZC);
    const int t0 = u * 32, b = t0 / SEQ;
    LAS float* CF = (LAS float*)F.lds; LAS bf16_t* AW = (LAS bf16_t*)(F.lds + PREP_AW); LAS bf16_t* AA = (LAS bf16_t*)(F.lds + PREP_AA); LAS bf16_t* AG = (LAS bf16_t*)(F.lds + PREP_AG);
    const float* conv = p.in[10] + (size_t)l * 3 * 1024;
    LAS float* PAR = (LAS float*)(F.lds + PREP_AG + 32 * 136 * 2);
    if (F.tid < 448) { const int i = F.tid; const GAS f32x4* src;
        if (i < 64) src = (const GAS f32x4*)((const GAS float*)p.in[16] + l * 256) + i;
        else if (i < 128) src = (const GAS f32x4*)((const GAS float*)p.in[17] + l * 256) + (i - 64);
        else if (i < 192) src = (const GAS f32x4*)((const GAS float*)p.in[18] + l * 256) + (i - 128);
        else if (i < 320) src = (const GAS f32x4*)((const GAS float*)p.in[11] + l * 512) + (i - 192);
        else src = (const GAS f32x4*)((const GAS float*)p.in[13] + l * 512) + (i - 320);
        ((LAS f32x4*)PAR)[i] = *src; }
#pragma unroll 4
    for (int i = 0; i < 8; ++i) {
        const int id = F.tid + i * 512, tk = id >> 7, ch = id & 127, tg = t0 + tk, tpos = tg - b * SEQ;
        const GAS bf16_t* zp = (const GAS bf16_t*)ZC + (size_t)tg * 1024 + ch * 8;
        const u32x4 zc = *(const GAS u32x4*)zp;
        u32x4 zl = {0u, 0u, 0u, 0u}, zr = {0u, 0u, 0u, 0u};
        if (tpos > 0) zl = *(const GAS u32x4*)(zp - 1024);
        if (tpos < SEQ - 1) zr = *(const GAS u32x4*)(zp + 1024);
        float v[8];
#pragma unroll
        for (int q = 0; q < 4; ++q) {
            const f32x2 c0 = *(const GAS f32x2*)((const GAS float*)conv + ch * 8 + 2 * q), c1 = *(const GAS f32x2*)((const GAS float*)conv + 1024 + ch * 8 + 2 * q), c2 = *(const GAS f32x2*)((const GAS float*)conv + 2048 + ch * 8 + 2 * q);
            v[2 * q] = bflo(zl[q]) * c0[0] + bflo(zc[q]) * c1[0] + bflo(zr[q]) * c2[0];
            v[2 * q + 1] = bfhi(zl[q]) * c0[1] + bfhi(zc[q]) * c1[1] + bfhi(zr[q]) * c2[1];
        }
        if (ch < 96) { *(LAS f32x4*)(CF + tk * CF_STR + ch * 8) = (f32x4){v[0], v[1], v[2], v[3]}; *(LAS f32x4*)(CF + tk * CF_STR + ch * 8 + 4) = (f32x4){v[4], v[5], v[6], v[7]}; }
        else {
            u32x4 w;
            if (ch < 104) {
#pragma unroll
                for (int q = 0; q < 8; ++q) v[q] = 1.f - 2.f * __builtin_amdgcn_rcpf(__expf(2.f * v[q]) + 1.f);
                w.x = pk2(v[0], v[1]); w.y = pk2(v[2], v[3]); w.z = pk2(v[4], v[5]); w.w = pk2(v[6], v[7]);
                *(LAS u32x4*)(AW + tk * 72 + (ch - 96) * 8) = w;
            } else if (ch < 112) {
                w.x = pk2(v[0], v[1]); w.y = pk2(v[2], v[3]); w.z = pk2(v[4], v[5]); w.w = pk2(v[6], v[7]);
                *(LAS u32x4*)(AA + tk * 72 + (ch - 104) * 8) = w;
            } else {
#pragma unroll
                for (int q = 0; q < 8; ++q) v[q] = sigmoidf_(v[q]);
                w.x = pk2(v[0], v[1]); w.y = pk2(v[2], v[3]); w.z = pk2(v[4], v[5]); w.w = pk2(v[6], v[7]);
                *(LAS u32x4*)(AG + tk * 136 + (ch - 112) * 8) = w;
            }
        }
    }
    __syncthreads();
    const int hh = F.wave & 3, dir = F.wave >> 2, tk = F.lane & 31, h2 = F.lane >> 5;
    const size_t tok = (size_t)t0 + tk;
    const GAS bf16_t* Wup = (const GAS bf16_t*)wb + WO_WUP + (size_t)(dir * 256 + hh * 64) * 64;
    const GAS bf16_t* Aup = (const GAS bf16_t*)wb + WO_AUP + (size_t)(dir * 256 + hh * 64) * 64;
    f32x16 aw[2], aa[2];
#pragma unroll
    for (int rb = 0; rb < 2; ++rb)
#pragma unroll
        for (int i = 0; i < 16; ++i) { aw[rb][i] = 0.f; aa[rb][i] = 0.f; }
#pragma unroll
    for (int ks = 0; ks < 4; ++ks) {
        const bf16x8 bw = *(const LAS bf16x8*)(AW + tk * 72 + 16 * ks + 8 * h2), ba = *(const LAS bf16x8*)(AA + tk * 72 + 16 * ks + 8 * h2);
#pragma unroll
        for (int rb = 0; rb < 2; ++rb) {
            const bf16x8 fw = *(const GAS bf16x8*)(Wup + (size_t)(rb * 32 + tk) * 64 + 16 * ks + 8 * h2), fa = *(const GAS bf16x8*)(Aup + (size_t)(rb * 32 + tk) * 64 + 16 * ks + 8 * h2);
            aw[rb] = __builtin_amdgcn_mfma_f32_32x32x16_bf16(fw, bw, aw[rb], 0, 0, 0);
            aa[rb] = __builtin_amdgcn_mfma_f32_32x32x16_bf16(fa, ba, aa[rb], 0, 0, 0);
        }
    }
    const LAS float* k_k = PAR + hh * 64; const LAS float* k_a = PAR + 256 + hh * 64; const LAS float* r_k = PAR + 512 + hh * 64;
    const LAS float* w0 = PAR + 768 + dir * 256 + hh * 64; const LAS float* a0 = PAR + 1280 + dir * 256 + hh * 64;
    float ssq = 0.f;
#pragma unroll
    for (int rb = 0; rb < 2; ++rb)
#pragma unroll
        for (int g4 = 0; g4 < 4; ++g4) { const int c0 = rb * 32 + 8 * g4 + 4 * h2;
            const f32x4 kv = *(const LAS f32x4*)(CF + tk * CF_STR + 256 + hh * 64 + c0), kkw = *(const LAS f32x4*)(k_k + c0);
            const f32x4 q = kv * kkw; ssq += (q[0] * q[0] + q[1] * q[1]) + (q[2] * q[2] + q[3] * q[3]); }
    ssq += xhalf(ssq);
    const float kinv = 1.f / fmaxf(sqrtf(ssq), 1e-12f);
    float bon = 0.f;
    GAS bf16_t* OM = (GAS bf16_t*)(p.ws + WS_OM) + ((size_t)dir * MTOK + tok) * 256 + hh * 64;
    GAS bf16_t* KA = (GAS bf16_t*)(p.ws + WS_KA) + ((size_t)dir * MTOK + tok) * 256 + hh * 64;
    GAS bf16_t* KD = (GAS bf16_t*)(p.ws + WS_KD) + ((size_t)dir * MTOK + tok) * 256 + hh * 64;
    GAS bf16_t* KK = (GAS bf16_t*)(p.ws + WS_KK) + tok * 256 + hh * 64;
    GAS bf16_t* VV = (GAS bf16_t*)(p.ws + WS_V) + tok * 256 + hh * 64;
    GAS bf16_t* RR = (GAS bf16_t*)(p.ws + WS_R) + tok * 256 + hh * 64;
#pragma unroll
    for (int rb = 0; rb < 2; ++rb)
#pragma unroll
        for (int g4 = 0; g4 < 4; ++g4) { const int c0 = rb * 32 + 8 * g4 + 4 * h2;
            const f32x4 kv = *(const LAS f32x4*)(CF + tk * CF_STR + 256 + hh * 64 + c0), rv = *(const LAS f32x4*)(CF + tk * CF_STR + hh * 64 + c0);
            const f32x4 kkw = *(const LAS f32x4*)(k_k + c0), kaw = *(const LAS f32x4*)(k_a + c0), rkw = *(const LAS f32x4*)(r_k + c0), w0v = *(const LAS f32x4*)(w0 + c0), a0v = *(const LAS f32x4*)(a0 + c0);
            float om[4], ka[4], kd[4], kk[4];
#pragma unroll
            for (int j = 0; j < 4; ++j) {
                const float wp = aw[rb][4 * g4 + j] + w0v[j], ap = aa[rb][4 * g4 + j] + a0v[j];
                om[j] = 1.f - __expf(-0.6065306597126334f * sigmoidf_(wp));
                const float a = sigmoidf_(ap);
                kk[j] = kv[j] * kkw[j] * kinv; ka[j] = kk[j] * a; kd[j] = kv[j] * (1.f + (a - 1.f) * kaw[j]);
                bon += rv[j] * kd[j] * rkw[j];
            }
            u32x2 w; w.x = pk2(om[0], om[1]); w.y = pk2(om[2], om[3]); *(GAS u32x2*)(OM + c0) = w;
            w.x = pk2(ka[0], ka[1]); w.y = pk2(ka[2], ka[3]); *(GAS u32x2*)(KA + c0) = w;
            w.x = pk2(kd[0], kd[1]); w.y = pk2(kd[2], kd[3]); *(GAS u32x2*)(KD + c0) = w;
            if (dir == 0) {
                const f32x4 vv = *(const LAS f32x4*)(CF + tk * CF_STR + 512 + hh * 64 + c0);
                w.x = pk2(kk[0], kk[1]); w.y = pk2(kk[2], kk[3]); *(GAS u32x2*)(KK + c0) = w;
                w.x = pk2(vv[0], vv[1]); w.y = pk2(vv[2], vv[3]); *(GAS u32x2*)(VV + c0) = w;
                w.x = pk2(rv[0], rv[1]); w.y = pk2(rv[2], rv[3]); *(GAS u32x2*)(RR + c0) = w;
            }
        }
    bon += xhalf(bon);
    if (h2 == 0) ((GAS float*)(p.ws + WS_BON))[((size_t)dir * MTOK + tok) * 4 + hh] = bon;
    {
        const GAS bf16_t* Gup = (const GAS bf16_t*)wb + WO_GUP + (size_t)(F.wave * 32 + tk) * 128;
        f32x16 ag;
#pragma unroll
        for (int i = 0; i < 16; ++i) ag[i] = 0.f;
#pragma unroll
        for (int ks = 0; ks < 8; ++ks) {
            const bf16x8 bg = *(const LAS bf16x8*)(AG + tk * 136 + 16 * ks + 8 * h2), fg = *(const GAS bf16x8*)(Gup + 16 * ks + 8 * h2);
            ag = __builtin_amdgcn_mfma_f32_32x32x16_bf16(fg, bg, ag, 0, 0, 0);
        }
        GAS bf16_t* GT = (GAS bf16_t*)(p.ws + WS_GATE) + tok * 256 + F.wave * 32;
#pragma unroll
        for (int g4 = 0; g4 < 4; ++g4) { u32x2 w; w.x = pk2(ag[4 * g4], ag[4 * g4 + 1]); w.y = pk2(ag[4 * g4 + 2], ag[4 * g4 + 3]); *(GAS u32x2*)(GT + 8 * g4 + 4 * h2) = w; }
    }
    __syncthreads();
}

#define CBAR() asm volatile("" ::: "memory")
#define LROW(M, i, r) do { const LAS f32x4* _q = (const LAS f32x4*)((M) + (i) * 16); const f32x4 _a = _q[0], _b = _q[1], _c = _q[2], _d = _q[3]; \
        r[0] = _a[0]; r[1] = _a[1]; r[2] = _a[2]; r[3] = _a[3]; r[4] = _b[0]; r[5] = _b[1]; r[6] = _b[2]; r[7] = _b[3]; \
        r[8] = _c[0]; r[9] = _c[1]; r[10] = _c[2]; r[11] = _c[3]; r[12] = _d[0]; r[13] = _d[1]; r[14] = _d[2]; r[15] = _d[3]; } while (0)
template <int DIR> __device__ __forceinline__ void chunkprep_wave(Frame& F, const Params& p, int task) {
    const int dbh = task >> 7, ct = task & 127, b = (dbh >> 2) & 7, hh = dbh & 3, ch = F.lane, r32 = F.lane & 31, h = F.lane >> 5;
    LAS unsigned char* wl = F.lds + F.wave * 16384;
    LAS bf16_t* X = (LAS bf16_t*)wl;
    LAS bf16_t* Yt = (LAS bf16_t*)(wl + 4608);
    LAS float* MTt = (LAS float*)(wl + 9216);
    LAS float* MBt = MTt + 256;
    LAS float* MC = MTt + 512; LAS float* MD = MTt + 768; LAS float* MT = MTt + 1024; LAS float* MA = MTt + 1280;
    constexpr int step = DIR ? -256 : 256;
    typedef const __attribute__((address_space(1))) bf16_t* gbf;
    const size_t ou = ((size_t)b * SEQ + ct * 16 + (DIR ? 15 : 0)) * 256 + hh * 64;
    const gbf OM = (gbf)(p.ws + WS_OM) + (size_t)DIR * MTOK * 256 + ou + ch; const gbf KA = (gbf)(p.ws + WS_KA) + (size_t)DIR * MTOK * 256 + ou + ch;
    const gbf KD = (gbf)(p.ws + WS_KD) + (size_t)DIR * MTOK * 256 + ou + ch; const gbf KK = (gbf)(p.ws + WS_KK) + ou + ch;
    const gbf RR = (gbf)(p.ws + WS_R) + ou + ch; const gbf VV = (gbf)(p.ws + WS_V) + ou + ch;
    float pc = 1.f;
    float qt[16], rt[16], at[16], kt[16], vv[16];
    {
        unsigned short rw[16], rk[16], ra_[16], rd[16], rr_[16], rv[16];
#pragma unroll
        for (int i = 0; i < 16; ++i) { rw[i] = OM[i * step]; rk[i] = KK[i * step]; ra_[i] = KA[i * step]; rd[i] = KD[i * step]; rr_[i] = RR[i * step]; rv[i] = VV[i * step]; }
#pragma unroll
        for (int i = 0; i < 16; ++i) {
            const float w = 1.f - bf2f(rw[i]);
            qt[i] = bf2f(rk[i]) * pc; pc *= w; const float ip = __builtin_amdgcn_rcpf(pc);
            rt[i] = bf2f(rr_[i]) * pc; at[i] = bf2f(ra_[i]) * ip; kt[i] = bf2f(rd[i]) * ip; vv[i] = bf2f(rv[i]);
            X[i * 72 + ch] = (bf16_t)(pk2(qt[i], 0.f) & 0xffffu); X[(16 + i) * 72 + ch] = (bf16_t)(pk2(rt[i], 0.f) & 0xffffu);
            Yt[i * 72 + ch] = (bf16_t)(pk2(at[i], 0.f) & 0xffffu); Yt[(16 + i) * 72 + ch] = (bf16_t)(pk2(kt[i], 0.f) & 0xffffu);
        }
    }
    const float p15 = pc;
    asm volatile("s_waitcnt lgkmcnt(0)" ::: "memory");
    {
        f32x16 g;
#pragma unroll
        for (int i = 0; i < 16; ++i) g[i] = 0.f;
#pragma unroll
        for (int ks = 0; ks < 4; ++ks) {
            const bf16x8 a = *(const LAS bf16x8*)(X + r32 * 72 + 16 * ks + 8 * h), bb = *(const LAS bf16x8*)(Yt + r32 * 72 + 16 * ks + 8 * h);
            g = __builtin_amdgcn_mfma_f32_32x32x16_bf16(a, bb, g, 0, 0, 0);
        }
        const int sidx = r32 & 15;
#pragma unroll
        for (int reg = 0; reg < 8; ++reg) { const int i = (reg & 3) + 8 * (reg >> 2) + 4 * h;
            const float lo = (sidx < i) ? g[reg] : 0.f, hi2 = (sidx <= i) ? g[8 + reg] : 0.f;
            if (r32 < 16) { MA[i * 16 + sidx] = lo; MD[i * 16 + sidx] = hi2; } else { MBt[sidx * 16 + i] = lo; MC[i * 16 + sidx] = hi2; } }
    }
    asm volatile("s_waitcnt lgkmcnt(0)" ::: "memory");
    {
        const int c = F.lane & 15; float Tc[16];
#pragma unroll
        for (int i = 0; i < 16; ++i) { float acc = (i == c) ? 1.f : 0.f; float ra[16]; LROW(MA, i, ra);
#pragma unroll
            for (int s2 = 0; s2 < i; ++s2) acc -= ra[s2] * Tc[s2];
            Tc[i] = acc; MT[i * 16 + c] = acc; MTt[c * 16 + i] = acc; CBAR(); }
    }
    asm volatile("s_waitcnt lgkmcnt(0)" ::: "memory");
    float Qh[16], W2[16];
    {
        float BV[16];
#pragma unroll
        for (int i = 0; i < 16; ++i) { Qh[i] = 0.f; BV[i] = 0.f; }
#pragma unroll
        for (int s2 = 0; s2 < 16; ++s2) {
            float ct_[16], cb_[16]; LROW(MTt, s2, ct_); LROW(MBt, s2, cb_);
#pragma unroll
            for (int i = s2; i < 16; ++i) { Qh[i] += ct_[i] * qt[s2]; if (i > s2) BV[i] += cb_[i] * vv[s2]; }
            CBAR();
        }
#pragma unroll
        for (int i = 0; i < 16; ++i) { float aw = 0.f; float rt_[16]; LROW(MT, i, rt_);
#pragma unroll
            for (int s2 = 0; s2 <= i; ++s2) aw += rt_[s2] * BV[s2];
            W2[i] = aw; CBAR(); }
    }
    LAS bf16_t* ST = (LAS bf16_t*)wl;
    {
        const int ks = ch >> 4, w16 = ch & 15, jq = (w16 >> 3) * 4 + (w16 & 3), hq = (w16 >> 2) & 1;
        LAS bf16_t* qrp = ST + (ks * 64 + hq * 32) * 8 + jq;
        LAS bf16_t* wyp = ST + 2048 + ((ch >> 5) * 64 + r32) * 16;
#pragma unroll
        for (int i = 0; i < 16; ++i) {
            float ar = rt[i], ay = 0.f; float rd_[16], rc_[16]; LROW(MD, i, rd_); LROW(MC, i, rc_);
#pragma unroll
            for (int s2 = 0; s2 <= i; ++s2) { ar -= rd_[s2] * Qh[s2]; ay += rc_[s2] * vv[s2] - rd_[s2] * W2[s2]; }
            qrp[i * 8] = (bf16_t)(pk2(Qh[i], 0.f) & 0xffffu); qrp[(16 + i) * 8] = (bf16_t)(pk2(ar, 0.f) & 0xffffu);
            wyp[512 * ((i >> 2) & 1) + (i & 3) + 4 * (i >> 3)] = (bf16_t)(pk2(W2[i], 0.f) & 0xffffu);
            wyp[512 * ((i >> 2) & 1) + (i & 3) + 4 * ((16 + i) >> 3)] = (bf16_t)(pk2(ay, 0.f) & 0xffffu);
            CBAR(); }
    }
    asm volatile("s_waitcnt lgkmcnt(0)" ::: "memory");
    {
        GAS u32x4* gq = (GAS u32x4*)((GAS bf16_t*)(p.ws + WS_FQR) + (size_t)task * 2048); GAS u32x4* gw = (GAS u32x4*)((GAS bf16_t*)(p.ws + WS_FWY) + (size_t)task * 2048);
        u32x4 tq[4], tw[4];
#pragma unroll
        for (int q = 0; q < 4; ++q) { tq[q] = *(const LAS u32x4*)(wl + (F.lane + 64 * q) * 16); tw[q] = *(const LAS u32x4*)(wl + 4096 + (F.lane + 64 * q) * 16); }
#pragma unroll
        for (int q = 0; q < 4; ++q) { gq[F.lane + 64 * q] = tq[q]; gw[F.lane + 64 * q] = tw[q]; }
    }
    asm volatile("s_waitcnt lgkmcnt(0)" ::: "memory");
    {
        LAS bf16_t* nap = ST + ((ch >> 5) * 64 + r32) * 8; LAS bf16_t* khp = nap + 1024;
#pragma unroll
        for (int s2 = 0; s2 < 16; ++s2) {
            const int off = 256 * ((s2 >> 2) & 1) + (s2 >> 3) * 4 + (s2 & 3);
            nap[off] = (bf16_t)(pk2(-at[s2] * p15, 0.f) & 0xffffu); khp[off] = (bf16_t)(pk2(kt[s2] * p15, 0.f) & 0xffffu); }
        asm volatile("s_waitcnt lgkmcnt(0)" ::: "memory");
        GAS u32x4* gn = (GAS u32x4*)((GAS bf16_t*)(p.ws + WS_FNA) + (size_t)task * 1024); GAS u32x4* gk = (GAS u32x4*)((GAS bf16_t*)(p.ws + WS_FKH) + (size_t)task * 1024);
        u32x4 tn[2], tk2[2];
#pragma unroll
        for (int q = 0; q < 2; ++q) { tn[q] = *(const LAS u32x4*)(wl + (F.lane + 64 * q) * 16); tk2[q] = *(const LAS u32x4*)(wl + 2048 + (F.lane + 64 * q) * 16); }
#pragma unroll
        for (int q = 0; q < 2; ++q) { gn[F.lane + 64 * q] = tn[q]; gk[F.lane + 64 * q] = tk2[q]; }
        ((GAS float*)(p.ws + WS_FP15))[(size_t)task * 64 + ch] = p15;
    }
    asm volatile("s_waitcnt lgkmcnt(0)" ::: "memory");
}
constexpr int PB_SLOT = 15360, PB_NSLOT = 4, PB_QR = 0, PB_WY = 4096, PB_NA = 8192, PB_KH = 10240, PB_P15 = 12288, PB_V = 13312;
__device__ __forceinline__ unsigned lds_ld_u32(unsigned addr) { unsigned v; asm volatile("ds_read_b32 %0, %1\n\ts_waitcnt lgkmcnt(0)" : "=v"(v) : "v"(addr) : "memory"); return v; }
__device__ __forceinline__ void lds_st_u32(unsigned addr, unsigned v) { asm volatile("ds_write_b32 %0, %1" :: "v"(addr), "v"(v) : "memory"); }
__device__ __forceinline__ void pb_dma(const Params& p, int dbh, int ct, int lane, LAS unsigned char* slot) {
    const size_t task = (size_t)dbh * 128 + ct; const int b = (dbh >> 2) & 7, hh = dbh & 3;
    const unsigned char* q = (const unsigned char*)((const bf16_t*)(p.ws + WS_FQR) + task * 2048) + lane * 16; const unsigned char* w = (const unsigned char*)((const bf16_t*)(p.ws + WS_FWY) + task * 2048) + lane * 16;
    const unsigned char* na = (const unsigned char*)((const bf16_t*)(p.ws + WS_FNA) + task * 1024) + lane * 16; const unsigned char* kh = (const unsigned char*)((const bf16_t*)(p.ws + WS_FKH) + task * 1024) + lane * 16;
#pragma unroll
    for (int i = 0; i < 4; ++i) {
        __builtin_amdgcn_global_load_lds((const unsigned*)(q + 1024 * i), (LAS unsigned*)(slot + PB_QR + 1024 * i), 16, 0, 0);
        __builtin_amdgcn_global_load_lds((const unsigned*)(w + 1024 * i), (LAS unsigned*)(slot + PB_WY + 1024 * i), 16, 0, 0); }
    __builtin_amdgcn_global_load_lds((const unsigned*)na, (LAS unsigned*)(slot + PB_NA), 16, 0, 0); __builtin_amdgcn_global_load_lds((const unsigned*)(na + 1024), (LAS unsigned*)(slot + PB_NA + 1024), 16, 0, 0);
    __builtin_amdgcn_global_load_lds((const unsigned*)kh, (LAS unsigned*)(slot + PB_KH), 16, 0, 0); __builtin_amdgcn_global_load_lds((const unsigned*)(kh + 1024), (LAS unsigned*)(slot + PB_KH + 1024), 16, 0, 0);
    __builtin_amdgcn_global_load_lds((const unsigned*)((const unsigned char*)((const float*)(p.ws + WS_FP15) + task * 64) + lane * 16), (LAS unsigned*)(slot + PB_P15), 16, 0, 0);
    const unsigned char* V = (const unsigned char*)((const bf16_t*)(p.ws + WS_V) + ((size_t)b * SEQ + ct * 16) * 256 + hh * 64) + (size_t)(lane >> 3) * 512 + (lane & 7) * 16;
    __builtin_amdgcn_global_load_lds((const unsigned*)V, (LAS unsigned*)(slot + PB_V), 16, 0, 0); __builtin_amdgcn_global_load_lds((const unsigned*)(V + 8 * 512), (LAS unsigned*)(slot + PB_V + 1024), 16, 0, 0);
}
__device__ __forceinline__ void phaseb_unit(Frame& F, const Params& p, int u) {
    const unsigned flag_base = (unsigned)(size_t)(F.lds + 131072 + 128);
    if (F.tid < 8) lds_st_u32(flag_base + 4 * F.tid, 0u);
    __syncthreads();
    const int pair = F.wave & 3;
    if (pair >= 2) return;
    const int dbh = u * 2 + pair, dir = dbh >> 5;
    LAS unsigned char* ring = F.lds + pair * (PB_NSLOT * PB_SLOT);
    const unsigned f_pub = flag_base + 8 * pair, f_con = f_pub + 4;
    if (F.wave >= 4) {
        for (int c = 0; c < 128; ++c) {
            while ((int)lds_ld_u32(f_con) < c - (PB_NSLOT - 1)) __builtin_amdgcn_s_sleep(1);
            pb_dma(p, dbh, dir ? 127 - c : c, F.lane, ring + (c & (PB_NSLOT - 1)) * PB_SLOT);
            if (c >= 3) { asm volatile("s_waitcnt vmcnt(45)" ::: "memory"); if (F.lane == 0) lds_st_u32(f_pub, (unsigned)(c - 2)); }
        }
        asm volatile("s_waitcnt vmcnt(30)" ::: "memory"); if (F.lane == 0) lds_st_u32(f_pub, 126u);
        asm volatile("s_waitcnt vmcnt(15)" ::: "memory"); if (F.lane == 0) lds_st_u32(f_pub, 127u);
        asm volatile("s_waitcnt vmcnt(0)" ::: "memory"); if (F.lane == 0) lds_st_u32(f_pub, 128u);
        return;
    }
    const int b = (dbh >> 2) & 7, hh = dbh & 3, r = F.lane & 31, h = F.lane >> 5;
    GAS bf16_t* Y = (GAS bf16_t*)(p.ws + WS_Y) + ((size_t)dir * MTOK + (size_t)b * SEQ) * 256 + hh * 64 + r;
    f32x16 accS[2][2];
#pragma unroll
    for (int rb = 0; rb < 2; ++rb)
#pragma unroll
        for (int cb = 0; cb < 2; ++cb)
#pragma unroll
            for (int i = 0; i < 16; ++i) accS[rb][cb][i] = 0.f;
    for (int cc = 0; cc < 128; ++cc) {
        const int ct = dir ? 127 - cc : cc;
        const LAS unsigned char* slot = ring + (cc & (PB_NSLOT - 1)) * PB_SLOT;
        bf16x8 sb[4][2];
#pragma unroll
        for (int rb = 0; rb < 2; ++rb)
#pragma unroll
            for (int s2 = 0; s2 < 2; ++s2)
#pragma unroll
                for (int cb = 0; cb < 2; ++cb) { const f32x16& a = accS[rb][cb]; u32x4 w;
                    w.x = pk2(a[8 * s2 + 0], a[8 * s2 + 1]); w.y = pk2(a[8 * s2 + 2], a[8 * s2 + 3]); w.z = pk2(a[8 * s2 + 4], a[8 * s2 + 5]); w.w = pk2(a[8 * s2 + 6], a[8 * s2 + 7]);
                    sb[2 * rb + s2][cb] = __builtin_bit_cast(bf16x8, w); }
        while ((int)lds_ld_u32(f_pub) < cc + 1) __builtin_amdgcn_s_sleep(1);
        asm volatile("" ::: "memory");
        f32x16 D[2];
#pragma unroll
        for (int cb = 0; cb < 2; ++cb) { const LAS u32x4* wp = (const LAS u32x4*)(slot + PB_WY + (cb * 64 + F.lane) * 32); const u32x4 w0 = wp[0], w1 = wp[1];
            D[cb][0] = bflo(w0.x); D[cb][1] = bfhi(w0.x); D[cb][2] = bflo(w0.y); D[cb][3] = bfhi(w0.y); D[cb][4] = bflo(w0.z); D[cb][5] = bfhi(w0.z); D[cb][6] = bflo(w0.w); D[cb][7] = bfhi(w0.w);
            D[cb][8] = bflo(w1.x); D[cb][9] = bfhi(w1.x); D[cb][10] = bflo(w1.y); D[cb][11] = bfhi(w1.y); D[cb][12] = bflo(w1.z); D[cb][13] = bfhi(w1.z); D[cb][14] = bflo(w1.w); D[cb][15] = bfhi(w1.w); }
#pragma unroll
        for (int ks = 0; ks < 4; ++ks) { const bf16x8 qa = *(const LAS bf16x8*)(slot + PB_QR + (ks * 64 + F.lane) * 16);
            D[0] = __builtin_amdgcn_mfma_f32_32x32x16_bf16(qa, sb[ks][0], D[0], 0, 0, 0);
            D[1] = __builtin_amdgcn_mfma_f32_32x32x16_bf16(qa, sb[ks][1], D[1], 0, 0, 0); }
#pragma unroll
        for (int rb = 0; rb < 2; ++rb)
#pragma unroll
            for (int g4 = 0; g4 < 4; ++g4) { const f32x4 pv = *(const LAS f32x4*)(slot + PB_P15 + (32 * rb + 8 * g4 + 4 * h) * 4);
#pragma unroll
                for (int cb = 0; cb < 2; ++cb)
#pragma unroll
                    for (int q = 0; q < 4; ++q) accS[rb][cb][4 * g4 + q] *= pv[q]; }
        bf16x8 ub[2], vb[2];
#pragma unroll
        for (int cb = 0; cb < 2; ++cb) {
            unsigned short vt[8];
#pragma unroll
            for (int j = 0; j < 8; ++j) { const int s2 = 8 * (j >> 2) + 4 * h + (j & 3); const int tau = dir ? 15 - s2 : s2;
                vt[j] = *(const LAS unsigned short*)(slot + PB_V + tau * 128 + (32 * cb + r) * 2);
                Y[(size_t)(ct * 16 + tau) * 256 + 32 * cb] = (bf16_t)(pk2(D[cb][8 + j], 0.f) & 0xffffu); }
            vb[cb] = (bf16x8){(short)vt[0], (short)vt[1], (short)vt[2], (short)vt[3], (short)vt[4], (short)vt[5], (short)vt[6], (short)vt[7]};
            u32x4 w; w.x = pk2(D[cb][0], D[cb][1]); w.y = pk2(D[cb][2], D[cb][3]); w.z = pk2(D[cb][4], D[cb][5]); w.w = pk2(D[cb][6], D[cb][7]);
            ub[cb] = __builtin_bit_cast(bf16x8, w);
        }
        bf16x8 na[2], kh[2];
#pragma unroll
        for (int rb = 0; rb < 2; ++rb) { na[rb] = *(const LAS bf16x8*)(slot + PB_NA + (rb * 64 + F.lane) * 16); kh[rb] = *(const LAS bf16x8*)(slot + PB_KH + (rb * 64 + F.lane) * 16); }
        asm volatile("s_waitcnt lgkmcnt(0)" ::: "memory");
        if (F.lane == 0) lds_st_u32(f_con, (unsigned)(cc + 1));
#pragma unroll
        for (int rb = 0; rb < 2; ++rb)
#pragma unroll
            for (int cb = 0; cb < 2; ++cb) {
                accS[rb][cb] = __builtin_amdgcn_mfma_f32_32x32x16_bf16(na[rb], ub[cb], accS[rb][cb], 0, 0, 0);
                accS[rb][cb] = __builtin_amdgcn_mfma_f32_32x32x16_bf16(kh[rb], vb[cb], accS[rb][cb], 0, 0, 0);
            }
    }
}

__device__ __forceinline__ void post_unit(Frame& F, const Params& p, int l, int u) {
    REFRAME(F);
    const bf16_t* Y0 = (const bf16_t*)(p.ws + WS_Y); const bf16_t* Y1 = Y0 + (size_t)MTOK * 256;
    const bf16_t* VV = (const bf16_t*)(p.ws + WS_V); const bf16_t* GT = (const bf16_t*)(p.ws + WS_GATE);
    const float* BON = (const float*)(p.ws + WS_BON); bf16_t* MIX = (bf16_t*)(p.ws + WS_MIX);
    const f32x4 lg = *(const f32x4*)(p.in[19] + l * 256 + 4 * F.lane), lb = *(const f32x4*)(p.in[20] + l * 256 + 4 * F.lane);
    for (int tok = u * 64 + F.wave * 8, te = tok + 8; tok < te; ++tok) {
        const u32x2 a = *(const GAS u32x2*)((const GAS bf16_t*)Y0 + (size_t)tok * 256 + 4 * F.lane), c = *(const GAS u32x2*)((const GAS bf16_t*)Y1 + (size_t)tok * 256 + 4 * F.lane);
        const u32x2 vv = *(const GAS u32x2*)((const GAS bf16_t*)VV + (size_t)tok * 256 + 4 * F.lane), gg = *(const GAS u32x2*)((const GAS bf16_t*)GT + (size_t)tok * 256 + 4 * F.lane);
        float y[4] = {bflo(a.x) + bflo(c.x), bfhi(a.x) + bfhi(c.x), bflo(a.y) + bflo(c.y), bfhi(a.y) + bfhi(c.y)};
        float s = (y[0] + y[1]) + (y[2] + y[3]);
#pragma unroll
        for (int o = 1; o < 16; o <<= 1) s += __shfl_xor(s, o);
        const float mu = s * (1.f / 64.f);
        float q = 0.f;
#pragma unroll
        for (int i = 0; i < 4; ++i) { y[i] -= mu; q += y[i] * y[i]; }
#pragma unroll
        for (int o = 1; o < 16; o <<= 1) q += __shfl_xor(q, o);
        const float rstd = rsqrtf(q * (1.f / 64.f) + 64e-5f);
        const int hh = F.lane >> 4;
        const float bon = ((const GAS float*)BON)[(size_t)tok * 4 + hh] + ((const GAS float*)BON)[((size_t)MTOK + tok) * 4 + hh];
        const float v4[4] = {bflo(vv.x), bfhi(vv.x), bflo(vv.y), bfhi(vv.y)}, g4[4] = {bflo(gg.x), bfhi(gg.x), bflo(gg.y), bfhi(gg.y)};
        float o4[4];
#pragma unroll
        for (int i = 0; i < 4; ++i) o4[i] = (y[i] * rstd * lg[i] + lb[i] + bon * v4[i]) * g4[i];
        u32x2 w; w.x = pk2(o4[0], o4[1]); w.y = pk2(o4[2], o4[3]);
        *(GAS u32x2*)((GAS bf16_t*)MIX + (size_t)tok * DM + 768 + 4 * F.lane) = w;
    }
}

__device__ __forceinline__ void prologue(Frame& F, const Params& p) {
    REFRAME(F);
    LAS float* scr = (LAS float*)(F.lds + F.wave * 16384);
    const int gw = F.bid * 8 + F.wave, NGW = F.G * 8;
    bf16_t* wb = (bf16_t*)(p.ws + WS_W);
    for (int it = gw; it < CV_TOTAL; it += NGW) { if (it < CV_A) cvt_item_a(p, 0, wb, scr, it, F.lane); else cvt_item_b(p, 0, wb, scr, it - CV_A, F.lane); }
    const float* x = p.in[0]; float* X = p.out; bf16_t* XB = (bf16_t*)(p.ws + WS_XB); float* rowss = (float*)(p.ws + WS_RP);
    for (int m = gw; m < MTOK; m += 2 * NGW) {
        const int m2 = m + NGW; const bool has2 = m2 < MTOK; const int mb = has2 ? m2 : m;
        const GAS f32x4* xra = (const GAS f32x4*)(x + (size_t)m * DM) + F.lane; const GAS f32x4* xrb = (const GAS f32x4*)(x + (size_t)mb * DM) + F.lane;
        f32x4 va[4], vb[4];
#pragma unroll
        for (int jj = 0; jj < 4; ++jj) { va[jj] = xra[64 * jj]; vb[jj] = xrb[64 * jj]; }
        float sa = 0.f, sb = 0.f;
#pragma unroll
        for (int jj = 0; jj < 4; ++jj) { sa += (va[jj][0] * va[jj][0] + va[jj][1] * va[jj][1]) + (va[jj][2] * va[jj][2] + va[jj][3] * va[jj][3]); sb += (vb[jj][0] * vb[jj][0] + vb[jj][1] * vb[jj][1]) + (vb[jj][2] * vb[jj][2] + vb[jj][3] * vb[jj][3]); }
        sa = wave_sum(sa); sb = wave_sum(sb);
        { GAS f32x4* xo = (GAS f32x4*)(X + (size_t)m * DM) + F.lane; GAS u32x2* bo = (GAS u32x2*)(XB + (size_t)m * DM) + F.lane;
#pragma unroll
          for (int jj = 0; jj < 4; ++jj) { xo[64 * jj] = va[jj]; u32x2 w; w.x = pk2(va[jj][0], va[jj][1]); w.y = pk2(va[jj][2], va[jj][3]); bo[64 * jj] = w; }
          if (F.lane < 16) ((GAS float*)rowss)[(size_t)m * 16 + F.lane] = (F.lane == 0) ? sa : 0.f; }
        if (has2) { GAS f32x4* xo = (GAS f32x4*)(X + (size_t)m2 * DM) + F.lane; GAS u32x2* bo = (GAS u32x2*)(XB + (size_t)m2 * DM) + F.lane;
#pragma unroll
          for (int jj = 0; jj < 4; ++jj) { xo[64 * jj] = vb[jj]; u32x2 w; w.x = pk2(vb[jj][0], vb[jj][1]); w.y = pk2(vb[jj][2], vb[jj][3]); bo[64 * jj] = w; }
          if (F.lane < 16) ((GAS float*)rowss)[(size_t)m2 * 16 + F.lane] = (F.lane == 0) ? sb : 0.f; }
    }
    const float* mem = p.in[1]; const float* gm = p.in[23]; bf16_t* MN = (bf16_t*)(p.ws + WS_MEMN);
    for (int m = gw; m < MMEM; m += NGW) {
        const f32x4* xr = (const f32x4*)(mem + (size_t)m * DM) + F.lane; u32x2* bo = (u32x2*)(MN + (size_t)m * DM) + F.lane;
        f32x4 v[4]; float s = 0.f;
#pragma unroll
        for (int jj = 0; jj < 4; ++jj) { v[jj] = xr[64 * jj]; s += (v[jj][0] * v[jj][0] + v[jj][1] * v[jj][1]) + (v[jj][2] * v[jj][2] + v[jj][3] * v[jj][3]); }
        const float rstd = rsqrtf(wave_sum(s) * (1.f / 1024.f) + 1e-6f);
#pragma unroll
        for (int jj = 0; jj < 4; ++jj) { const f32x4 g = *((const f32x4*)gm + F.lane + 64 * jj); const f32x4 t = v[jj] * rstd * g;
            u32x2 w; w.x = pk2(t[0], t[1]); w.y = pk2(t[2], t[3]); bo[64 * jj] = w; }
    }
}
__device__ __forceinline__ void final_norm(Frame& F, const Params& p) {
    REFRAME(F);
    const int gw = F.bid * 8 + F.wave, NGW = F.G * 8;
    const float* rowss = (const float*)(p.ws + WS_RP) + (size_t)12 * MTOK * 16; const GAS float* gf = (const GAS float*)p.in[30];
    f32x4 g[4];
#pragma unroll
    for (int jj = 0; jj < 4; ++jj) g[jj] = *((const GAS f32x4*)gf + F.lane + 64 * jj);
    for (int m = gw; m < MTOK; m += 2 * NGW) {
        const int m2 = m + NGW; const bool has2 = m2 < MTOK;
        GAS f32x4* xa = (GAS f32x4*)(p.out + (size_t)m * DM) + F.lane; GAS f32x4* xb = (GAS f32x4*)(p.out + (size_t)(has2 ? m2 : m) * DM) + F.lane;
        f32x4 va[4], vb[4];
#pragma unroll
        for (int jj = 0; jj < 4; ++jj) { va[jj] = xa[64 * jj]; vb[jj] = xb[64 * jj]; }
        const float ra = row_rstd(rowss, m), rb = row_rstd(rowss, has2 ? m2 : m);
#pragma unroll
        for (int jj = 0; jj < 4; ++jj) xa[64 * jj] = va[jj] * ra * g[jj];
        if (has2) {
#pragma unroll
            for (int jj = 0; jj < 4; ++jj) xb[64 * jj] = vb[jj] * rb * g[jj]; }
    }
}

#define XB_TMO      128
#define XB_XCNT(j)  (256  + 64 * (j))
#define XB_XSUB(j)  (1280 + 64 * (j))
#define XB_XGEN(j)  (2304 + 64 * (j))
#define XB_TOP      3328
#define XB_TOPGEN   3392
#define XB_SPIN_CAP (1u << 22)
constexpr int CW_BAR = 4096;
__device__ __forceinline__ unsigned xb_ld(unsigned* p)              { return __hip_atomic_load(p, __ATOMIC_RELAXED, __HIP_MEMORY_SCOPE_AGENT); }
__device__ __forceinline__ unsigned xb_add(unsigned* p, unsigned v) { return __hip_atomic_fetch_add(p, v, __ATOMIC_RELAXED, __HIP_MEMORY_SCOPE_AGENT); }
__device__ __forceinline__ unsigned xb_xcc_id() { return (unsigned)__builtin_amdgcn_s_getreg((3 << 11) | 20) & 0xFu; }
#define XB_SPIN(cond, bar) do { unsigned _sp = 0; while (cond) { __builtin_amdgcn_s_sleep(1); \
    if ((++_sp & 255u) == 0u) { if (xb_ld(&(bar)[XB_TMO])) break; if (_sp > XB_SPIN_CAP) { atomicAdd(&(bar)[XB_TMO], 1u); break; } } } } while (0)
__device__ __forceinline__ void xcd_barrier_complete(unsigned* bar, unsigned x, unsigned& nloc, unsigned& nx) {
    const unsigned G = gridDim.x;
    unsigned sum, cnt, mine, sp = 0u;
    for (;;) {
        sum = 0u; cnt = 0u; mine = 0u;
#pragma unroll
        for (unsigned j = 0; j < 16; ++j) { const unsigned c = xb_ld(&bar[XB_XCNT(j)]); sum += c; cnt += (c > 0u) ? 1u : 0u; mine = (j == x) ? c : mine; }
        if (sum == G) break;
        __builtin_amdgcn_s_sleep(1);
        if ((++sp & 255u) == 0u) { if (xb_ld(&bar[XB_TMO])) break; if (sp > XB_SPIN_CAP) { atomicAdd(&bar[XB_TMO], 1u); break; } }
    }
    nloc = mine > 0u ? mine : 1u; nx = cnt > 0u ? cnt : 1u;
}
__device__ __forceinline__ void gsync(volatile LAS unsigned* st) {
    unsigned* bar = (unsigned*)(make_params().ws + WS_CTL) + CW_BAR;
    asm volatile("s_waitcnt vmcnt(0)" ::: "memory");
    __syncthreads();
    if (threadIdx.x == 0) {
        const unsigned x = xb_xcc_id();
        __builtin_amdgcn_s_waitcnt(0);
        unsigned nloc = st[0], nx = st[1];
        if (nloc == 0u) { xcd_barrier_complete(bar, x, nloc, nx); st[0] = nloc; st[1] = nx; }
        const unsigned old = xb_add(&bar[XB_XSUB(x)], 1u);
        const unsigned gen = old / nloc;
        if (old + 1u == (gen + 1u) * nloc) {
            __builtin_amdgcn_fence(__ATOMIC_RELEASE, "agent");
            asm volatile("s_waitcnt vmcnt(0)" ::: "memory");
            const unsigned og = xb_add(&bar[XB_TOP], 1u);
            const unsigned tg = og / nx;
            if (og + 1u == (tg + 1u) * nx) xb_add(&bar[XB_TOPGEN], 1u);
            else XB_SPIN(xb_ld(&bar[XB_TOPGEN]) == tg, bar);
            __builtin_amdgcn_fence(__ATOMIC_ACQUIRE, "agent");
            xb_add(&bar[XB_XGEN(x)], 1u);
            asm volatile("s_waitcnt vmcnt(0)" ::: "memory");
        } else {
            XB_SPIN(xb_ld(&bar[XB_XGEN(x)]) == gen, bar);
            __builtin_amdgcn_fence(__ATOMIC_ACQUIRE, "agent");
            asm volatile("s_waitcnt vmcnt(0)" ::: "memory");
        }
    }
    __syncthreads();
}
#ifdef TPROBE
#define STAMP(id) do { if (blockIdx.x == 0 && threadIdx.x == 0) { LAS unsigned long long* ts_ = (LAS unsigned long long*)(F.lds + 131072 + 64); const unsigned long long now_ = __builtin_amdgcn_s_memrealtime(); \
    const unsigned long long dt_ = now_ - ts_[0]; ts_[0] = now_; if ((TA_MASK >> (id)) & 1) ts_[1] += dt_; if ((TB_MASK >> (id)) & 1) ts_[2] += dt_; } } while (0)
#else
#define STAMP(id) do { } while (0)
#endif
#ifndef PH_MASK
#define PH_MASK 0xFFFF
#endif
#ifndef REP_MASK
#define REP_MASK 0
#endif
#define NREP(k) ((((REP_MASK) >> (k)) & 1) ? 2 : 1)
constexpr int NCP = 1024, NDIFF_A = 0, NPB = 32;
__global__ void __launch_bounds__(512, 2) fwd_megakernel(KArgs kargs_unused) {
    extern __shared__ __attribute__((aligned(16))) unsigned char lds_raw[];
    cg::grid_group grid = cg::this_grid();
    Frame F; F.lds = (LAS unsigned char*)lds_raw; F.tid = threadIdx.x; F.lane = F.tid & 63; F.wave = __builtin_amdgcn_readfirstlane(F.tid >> 6); F.G = gridDim.x; F.bid = blockIdx.x;
    LAS int* qslot = (LAS int*)(F.lds + 131072);
    volatile LAS unsigned* bst = (volatile LAS unsigned*)(F.lds + 131072 + 32);
    { unsigned* bar0 = (unsigned*)(make_params().ws + WS_CTL) + CW_BAR;
      if (threadIdx.x == 0) { bst[0] = 0u; bst[1] = 0u; (void)xb_add(bar0 + XB_XCNT(xb_xcc_id()), 1u); } }
    __syncthreads();
#define PHASE_VARS() const Params p = make_params(); unsigned* ctl = (unsigned*)(p.ws + WS_CTL); float* rowss = (float*)(p.ws + WS_RP); \
    bf16_t* XB = (bf16_t*)(p.ws + WS_XB); bf16_t* Z = (bf16_t*)(p.ws + WS_Z); bf16_t* MIX = (bf16_t*)(p.ws + WS_MIX); \
    bf16_t* wb = (bf16_t*)(p.ws + WS_W); int bid_ = F.bid, G_ = F.G; asm volatile("" : "+s"(bid_), "+s"(G_)); (void)bid_; (void)G_; (void)ctl; (void)rowss; (void)XB; (void)Z; (void)MIX; (void)wb

#ifdef TPROBE
    if (blockIdx.x == 0 && threadIdx.x == 0) { LAS unsigned long long* ts_ = (LAS unsigned long long*)(F.lds + 131072 + 64); ts_[0] = __builtin_amdgcn_s_memrealtime(); ts_[1] = 0; ts_[2] = 0; }
#endif
    if (PH_MASK & 1) { const Params p = make_params(); prologue(F, p); }
    grid.sync();
    STAMP(0);

    for (int l = 0; l < NL; ++l) {
        for (int rep = 0; rep < NREP(1); ++rep) {
        if (PH_MASK & 2) {
            PHASE_VARS();
            pg8::StaticOrder S; S.init(MTOK, INW, G_, bid_);
            pg8::gemm_phase(F.lds, pg8::Gemm{XB, wb + WO_IN, MTOK, INW, DM}, S, pg8::EpiScaleBf16{Z, ZP, rowss + (size_t)(3 * l) * MTOK * 16, (bf16_t*)(p.ws + WS_ZC), 1024, 8, (bf16_t*)(p.ws + WS_KD2)});
        }
        gsync(bst); STAMP(1);
        }
        for (int rep = 0; rep < NREP(2); ++rep) {
        for (int u = F.bid; u < 768; u += F.G) {
            PHASE_VARS();
            if (u < 512) { if (PH_MASK & 4) prep_unit(F, p, l, wb, u); } else if (PH_MASK & 8) win_unit(F, p, l, u - 512);
        }
        gsync(bst); STAMP(2);
        }
        for (int rep = 0; rep < NREP(3); ++rep) {
        {
            PHASE_VARS();
            const int ntot = NCP + NDIFF_A;
            for (;;) {
                __syncthreads();
                if (F.tid == 0) *qslot = (int)atomicAdd(ctl + CW_Q + 16 * l + 4 * rep, 1u);
                __syncthreads();
                const int u = *qslot;
                if (u >= ntot) break;
                if (u < NCP) { if (PH_MASK & 16) { REFRAME(F); if (u >= NCP / 2) chunkprep_wave<1>(F, p, u * 8 + F.wave); else chunkprep_wave<0>(F, p, u * 8 + F.wave); } }
                else if (PH_MASK & 32) diff_unit(F, p, l, u - NCP);
            }
        }
        gsync(bst); STAMP(11);
        }
        for (int rep = 0; rep < NREP(4); ++rep) {
        {
            PHASE_VARS();
            const int ncva = (l + 1 < NL) ? CV_A / 8 : 0, ncvb = (l > 0) ? CV_B / 8 : 0, ncv = NPB + ncva + ncvb, ntot = ncv + 256;
            unsigned* pbdone = ctl + 3072 + (l * 2 + rep) * 16;
            unsigned* gq = ctl + CW_Q + 16 * l + 8 + 4 * rep; unsigned* dq = ctl + 2048 + (l * 2 + rep) * 16;
            const int myx = (int)(xb_xcc_id() & 7u);
            int stage = 0, pend = -1, xi = 0;
            for (;;) {
                __syncthreads();
                if (F.tid == 0) {
                    int code = -1;
                    if (stage == 0) { const int g = (int)atomicAdd(gq, 1u); if (g < NPB) code = g; else { pend = g; stage = 1; } }
                    if (stage == 1) {
                        while (xi < 8) { const int x = (myx + xi) & 7; const int tk = (int)atomicAdd(dq + x, 1u); if (tk < 64) { code = -2 - ((4 * x + (tk >> 4)) * 16 + (tk & 15)); break; } ++xi; }
                        if (xi >= 8) stage = 2;
                    }
                    if (stage == 2 && code == -1) { int g = pend; pend = -1; if (g < 0) g = (int)atomicAdd(gq, 1u); if (g < ntot) code = g; }
                    *qslot = code;
                }
                __syncthreads();
                const int u = *qslot;
                if (u == -1) break;
                if (u <= -2) { if (PH_MASK & 32) diff_unit(F, p, l, -2 - u); }
                else if (u < NPB) { if (PH_MASK & 16) { REFRAME(F); phaseb_unit(F, p, u); }
                    __threadfence(); __syncthreads();
                    if (F.tid == 0) __hip_atomic_fetch_add(pbdone, 1u, __ATOMIC_RELEASE, __HIP_MEMORY_SCOPE_AGENT); }
                else if (u >= ncv) {
                    if (F.tid == 0) { while (__hip_atomic_load(pbdone, __ATOMIC_RELAXED, __HIP_MEMORY_SCOPE_AGENT) < (unsigned)NPB) __builtin_amdgcn_s_sleep(8); }
                    __syncthreads(); __builtin_amdgcn_fence(__ATOMIC_ACQUIRE, "agent");
                    if (PH_MASK & 64) post_unit(F, p, l, u - ncv); }
                else if (u < NPB + ncva) { REFRAME(F); cvt_item_a(p, l + 1, wb, (LAS float*)(F.lds + F.wave * 16384), (u - NPB) * 8 + F.wave, F.lane); }
                else { REFRAME(F); cvt_item_b(p, l, wb, (LAS float*)(F.lds + F.wave * 16384), (u - NPB - ncva) * 8 + F.wave, F.lane); }
            }
        }
        gsync(bst); STAMP(3);
        }
        if (PH_MASK & 128) {
            PHASE_VARS();
            pg8::StaticOrder S; S.init(MTOK, DM, G_, bid_);
            pg8::gemm_phase(F.lds, pg8::Gemm{MIX, wb + WO_OUT, MTOK, DM, DM}, S, pg8::EpiResid{p.out, XB, rowss + (size_t)(3 * l + 1) * MTOK * 16});
        }
        gsync(bst); STAMP(5);
        for (int rep = 0; rep < NREP(6); ++rep) {
        if (PH_MASK & 256) {
            PHASE_VARS();
            pg8::StaticOrder S; S.init(MTOK, XW, G_, bid_);
            if (F.bid < 128) {
                pg8::gemm_phase(F.lds, pg8::Gemm{XB, wb + WO_Q, MTOK, XW, DM}, S, pg8::EpiScaleBf16{(bf16_t*)(p.ws + WS_Q), XW, rowss + (size_t)(3 * l + 1) * MTOK * 16, nullptr, 0, 1 << 30, nullptr});
            } else {
                pg8::StaticOrder S2; S2.init(MMEM, 1024, 128, F.bid - 128);
                pg8::gemm_phase(F.lds, pg8::Gemm{(const bf16_t*)(p.ws + WS_MEMN), wb + WO_KV, MMEM, 1024, DM}, S2, pg8::EpiScaleBf16{(bf16_t*)(p.ws + WS_KV), 1024, nullptr, nullptr, 0, 1 << 30, nullptr});
            }
        }
        gsync(bst); STAMP(6);
        }
        for (int rep = 0; rep < NREP(7); ++rep) {
        if (PH_MASK & 512) for (int u = F.bid; u < 256; u += F.G) { PHASE_VARS(); cross_unit(F, p, u); }
        gsync(bst); STAMP(7);
        }
        if (PH_MASK & 1024) {
            PHASE_VARS();
            pg8::StaticOrder S; S.init(MTOK, DM, G_, bid_);
            pg8::gemm_phase(F.lds, pg8::Gemm{(const bf16_t*)(p.ws + WS_O), wb + WO_O, MTOK, DM, XW}, S, pg8::EpiResid{p.out, XB, rowss + (size_t)(3 * l + 2) * MTOK * 16});
        }
        gsync(bst); STAMP(8);
        for (int rep = 0; rep < NREP(9); ++rep) {
        if (PH_MASK & 2048) {
            PHASE_VARS();
            pg8::StaticOrder S; S.init(MTOK, 2 * DFF, G_, bid_);
            pg8::gemm_phase(F.lds, pg8::Gemm{XB, wb + WO_GU, MTOK, 2 * DFF, DM}, S, pg8::EpiSwiGLU{(bf16_t*)(p.ws + WS_G), rowss + (size_t)(3 * l + 2) * MTOK * 16});
        }
        gsync(bst); STAMP(9);
        }
        if (PH_MASK & 4096) {
            PHASE_VARS();
            pg8::StaticOrder S; S.init(MTOK, DM, G_, bid_);
            pg8::gemm_phase(F.lds, pg8::Gemm{(const bf16_t*)(p.ws + WS_G), wb + WO_DOWN, MTOK, DM, DFF}, S, pg8::EpiResid{p.out, XB, rowss + (size_t)(3 * l + 3) * MTOK * 16});
        }

#ifdef TPROBE
        STAMP(10);
        { const Params p = make_params(); if (l == NL - 1 && blockIdx.x == 0 && threadIdx.x == 0) { LAS unsigned long long* ts_ = (LAS unsigned long long*)(F.lds + 131072 + 64); unsigned* c_ = (unsigned*)(p.ws + WS_CTL); c_[32] = (unsigned)ts_[1]; c_[33] = (unsigned)ts_[2]; } }
#endif
        gsync(bst);
    }
    if (PH_MASK & 8192) { const Params p = make_params(); final_norm(F, p); }
}

extern "C" void kernel_launch(void* const* d_in, const int* in_sizes, int n_in, void* d_out, int out_size, void* d_ws, size_t ws_size, hipStream_t stream) {
    static int grid = 0;
    if (grid == 0) {
        if (n_in != 31 || out_size != MTOK * DM || ws_size < WS_END) { fprintf(stderr, "kernel_launch: unexpected problem shape (n_in %d out %d ws %zu)\n", n_in, out_size, ws_size); grid = -1; return; }
        int dev = 0, cus = 0, per_cu = 0;
        hipGetDevice(&dev);
        hipDeviceGetAttribute(&cus, hipDeviceAttributeMultiprocessorCount, dev);
        hipFuncSetAttribute((const void*)fwd_megakernel, hipFuncAttributeMaxDynamicSharedMemorySize, LDS_BYTES);
        hipOccupancyMaxActiveBlocksPerMultiprocessor(&per_cu, (const void*)fwd_megakernel, 512, LDS_BYTES);
        if (per_cu < 1) { fprintf(stderr, "kernel_launch: occupancy query returned %d\n", per_cu); per_cu = 1; }
        (void)hipGetLastError();
        grid = cus * per_cu;
    }
    if (grid < 0) return;
    hipMemsetAsync((char*)d_ws + WS_CTL, 0, CTL_ZERO_BYTES, stream);
    KArgs p{};
    for (int i = 0; i < 31; ++i) p.in[i] = (const float*)d_in[i];
    p.out = (float*)d_out; p.ws = (unsigned char*)d_ws;
    void* args[] = {&p};
    hipError_t e = hipLaunchCooperativeKernel((const void*)fwd_megakernel, dim3(grid), dim3(512), args, LDS_BYTES, stream);
    if (e != hipSuccess) fprintf(stderr, "cooperative launch failed: %s (grid %d)\n", hipGetErrorString(e), grid);
}
```

```cpp
#include <hip/hip_runtime.h>
#include <hip/hip_cooperative_groups.h>
#include <cstdio>
#include <cstdint>
namespace cg = cooperative_groups;

#define LAS __attribute__((address_space(3)))
#define GAS __attribute__((address_space(1)))
typedef unsigned short bf16_t;
typedef short bf16x8 __attribute__((ext_vector_type(8)));
typedef short s16x4 __attribute__((ext_vector_type(4)));
typedef short v4i16_t __attribute__((ext_vector_type(4)));
typedef float f32x4 __attribute__((ext_vector_type(4)));
typedef float f32x2 __attribute__((ext_vector_type(2)));
typedef float f32x16 __attribute__((ext_vector_type(16)));
typedef unsigned u32x4 __attribute__((ext_vector_type(4)));
typedef unsigned u32x2 __attribute__((ext_vector_type(2)));
typedef __bf16 bf16x2_t __attribute__((ext_vector_type(2)));

constexpr int DM = 1024, NB = 8, SEQ = 2048, NL = 4, MTOK = NB * SEQ;
constexpr int NMEM = 256, MMEM = NB * NMEM;
constexpr int INW = 3072, DFF = 2816, XW = 512;
constexpr float LOG2E = 1.4426950408889634f;

constexpr size_t MiB = 1u << 20;
constexpr size_t WS_CTL = 0, CTL_ZERO_BYTES = 1 * MiB;
constexpr size_t WS_W = 1 * MiB;
constexpr size_t WS_Z = 30 * MiB;
constexpr size_t WS_ZC = 94 * MiB;
constexpr size_t WS_XB = 126 * MiB;
constexpr size_t WS_FQR = 94 * MiB, WS_FWY = 126 * MiB, WS_FNA = 158 * MiB, WS_FKH = 174 * MiB, WS_FP15 = 190 * MiB;
constexpr size_t WS_MIX = 192 * MiB;
constexpr size_t WS_OM = 224 * MiB, WS_KA = 240 * MiB, WS_KD = 256 * MiB, WS_KK = 272 * MiB, WS_V = 280 * MiB, WS_R = 288 * MiB;
constexpr size_t WS_GATE = 296 * MiB, WS_Y = 304 * MiB, WS_BON = 320 * MiB, WS_KV = 321 * MiB, WS_MEMN = 325 * MiB;
constexpr size_t WS_RP = 329 * MiB;
constexpr size_t WS_END = 342 * MiB;
constexpr size_t WS_Q = WS_Z, WS_O = WS_Z + 16 * MiB, WS_G = WS_Z;
constexpr int ZP = 1024;
constexpr size_t WS_KD2 = WS_Z + 32 * MiB, WS_VD2 = WS_Z + 48 * MiB;
constexpr size_t WO_IN = 0, WO_OUT = 3145728, WO_Q = 4194304, WO_KV = 4718592, WO_O = 5767168, WO_GU = 6291456, WO_DOWN = 12058624;
constexpr size_t WO_WUP = 14942208, WO_AUP = 14974976, WO_GUP = 15007744;
constexpr int CW_Q = 64;

constexpr int LDS_BYTES = 135168;

__device__ __forceinline__ float bf2f(unsigned b) { return __uint_as_float(b << 16); }
__device__ __forceinline__ unsigned pk2(float lo, float hi) { f32x2 v = {lo, hi}; bf16x2_t b = __builtin_convertvector(v, bf16x2_t); return __builtin_bit_cast(unsigned, b); }
__device__ __forceinline__ float bflo(unsigned u) { return __uint_as_float(u << 16); }
__device__ __forceinline__ float bfhi(unsigned u) { return __uint_as_float(u & 0xffff0000u); }
__device__ __forceinline__ float wave_sum(float v) {
#pragma unroll
    for (int o = 1; o < 64; o <<= 1) v += __shfl_xor(v, o);
    return v;
}
__device__ __forceinline__ float xhalf(float v) {
    return __shfl_xor(v, 32);
}
__device__ __forceinline__ float row_rstd(const float* rp, int row) {
    const f32x4* q = (const f32x4*)(rp + (size_t)row * 16); const f32x4 a = q[0], b = q[1], c = q[2], d = q[3];
    const float s = (((a[0] + a[1]) + (a[2] + a[3])) + ((b[0] + b[1]) + (b[2] + b[3]))) + (((c[0] + c[1]) + (c[2] + c[3])) + ((d[0] + d[1]) + (d[2] + d[3])));
    return rsqrtf(s * (1.f / 1024.f) + 1e-6f);
}
__device__ __forceinline__ float sigmoidf_(float x) { return __builtin_amdgcn_rcpf(1.f + __expf(-x)); }

__device__ __forceinline__ int hw_lane() { int l = (int)__builtin_amdgcn_mbcnt_hi(~0u, __builtin_amdgcn_mbcnt_lo(~0u, 0u)); asm volatile("" : "+v"(l)); return l; }
namespace pg8 {
constexpr int BM = 256, BK = 64, HALF = 128, HTB = HALF * BK * 2, NXCD = 8, WGM = 8;
__host__ __device__ __forceinline__ int lds_byte(int r, int c) { const int st = (r >> 4) * 2 + (c >> 5), rr = r & 15, cc = c & 31, ob = rr * 64 + cc * 2; return st * 1024 + (ob ^ (((ob >> 9) & 1) << 5)); }
__host__ __device__ __forceinline__ void stage_rc(int b, int& R, int& C) { const int st = b / 1024, sb = b % 1024, swz = sb ^ (((sb >> 9) & 1) << 5); R = (st >> 1) * 16 + swz / 64; C = (st & 1) * 32 + (swz % 64) / 2; }
__host__ __device__ __forceinline__ int perm32(int rho) { const int n = rho >> 4, i = rho & 15; return 8 * (i >> 2) + 4 * n + (i & 3); }
struct Unit { int pm, pn; };
struct Gemm { const bf16_t* A; const bf16_t* Bt; int M, N, K; };
struct StaticOrder {
    int nM, nN, nwg, G, c;
    __device__ void init(int M, int N, int G_, int c_) { nM = M / BM; nN = N / BM; nwg = nM * nN; G = G_; c = c_; }
    __device__ bool next(int i, Unit& u) const {
        const long L = (long)i * G + c; if (L >= nwg) return false;
        int wgid = (int)L; { const int q = nwg / NXCD, r = nwg % NXCD, xcd = wgid % NXCD, off = wgid / NXCD; wgid = (xcd < r ? xcd * (q + 1) : r * (q + 1) + (xcd - r) * q) + off; }
        const int nig = WGM * nN, gid = wgid / nig, fm = gid * WGM, gsz = (nM - fm) < WGM ? (nM - fm) : WGM;
        u.pm = fm + ((wgid % nig) % gsz); u.pn = (wgid % nig) / gsz; return true;
    }
};
template <class Epi>
__device__ __forceinline__ void gemm_phase(LAS unsigned char* lds, const Gemm g, const StaticOrder& S, const Epi& E) {
    int tid_ = threadIdx.x; asm volatile("" : "+v"(tid_));
    const int tid = tid_, wid = __builtin_amdgcn_readfirstlane(tid >> 6), lane = tid & 63, wr = wid >> 2, wc = wid & 3, fr = lane & 15, fq = lane >> 4;
    const int K = g.K, nt = K / BK;
    unsigned voffA[2], voffB[2];
#pragma unroll
    for (int i = 0; i < 2; ++i) { int R, C; stage_rc(tid * 16 + i * 8192, R, C); const int Rb = (R & ~31) + perm32(R & 31);
        voffA[i] = (unsigned)(R * K + C) * 2u; voffB[i] = (unsigned)(Rb * K + C) * 2u; }
    const size_t kstep = (size_t)(BK * 2);
    const size_t hstep = (size_t)HALF * K * 2;
    const size_t tstep = 2 * hstep;
    const unsigned ldsw = (unsigned)wid * 1024u;
    const int aoff = lds_byte(wr * 64 + fr, fq * 8), boff = lds_byte(wc * 32 + fr, fq * 8);
#define PG8_SA(b, h) (((b) * 2 + (h)) * HTB)
#define PG8_SB(b, h) ((4 + (b) * 2 + (h)) * HTB)
#define PG8_STAGE(bufoff, gbase, voff) do { _Pragma("unroll") for (int _i = 0; _i < 2; ++_i) \
        __builtin_amdgcn_global_load_lds((const unsigned*)((const char*)(gbase) + (voff)[_i]), (LAS unsigned*)(lds + (bufoff) + ldsw + _i * 8192), 16, 0, 0); } while (0)
#define PG8_LDA(dst, b, h) do { _Pragma("unroll") for (int m = 0; m < 4; ++m) _Pragma("unroll") for (int k = 0; k < 2; ++k) dst[m][k] = *(const LAS bf16x8*)(lds + PG8_SA(b, h) + aoff + m * 2048 + k * 1024); } while (0)
#define PG8_LDB(dst, b, h) do { _Pragma("unroll") for (int n = 0; n < 2; ++n) _Pragma("unroll") for (int k = 0; k < 2; ++k) dst[n][k] = *(const LAS bf16x8*)(lds + PG8_SB(b, h) + boff + n * 2048 + k * 1024); } while (0)
#define PG8_MMA(ai, bj, At, Bt) do { __builtin_amdgcn_s_setprio(1); _Pragma("unroll") for (int m = 0; m < 4; ++m) _Pragma("unroll") for (int n = 0; n < 2; ++n) _Pragma("unroll") for (int k = 0; k < 2; ++k) \
        acc[ai][bj][m][n] = __builtin_amdgcn_mfma_f32_16x16x32_bf16(Bt[n][k], At[m][k], acc[ai][bj][m][n], 0, 0, 0); __builtin_amdgcn_s_setprio(0); } while (0)
#define PG8_WAIT_V(n) asm volatile("s_waitcnt vmcnt(" #n ")" ::: "memory")
#define PG8_WAIT_L(n) asm volatile("s_waitcnt lgkmcnt(" #n ")" ::: "memory")
#define PG8_BAR __builtin_amdgcn_s_barrier()
#define PG8_SCHED __builtin_amdgcn_sched_barrier(0)
    Unit cur, nxt; int ui = 0;
    if (!S.next(0, cur)) return;
    f32x4 acc[2][2][4][2];
#pragma unroll
    for (int a = 0; a < 2; ++a)
#pragma unroll
        for (int b = 0; b < 2; ++b)
#pragma unroll
            for (int m = 0; m < 4; ++m)
#pragma unroll
                for (int n = 0; n < 2; ++n) acc[a][b][m][n] = (f32x4){0.f, 0.f, 0.f, 0.f};
    bf16x8 At[4][2], B0[2][2], B1[2][2];
    const char* cA = (const char*)g.A + (size_t)cur.pm * tstep; const char* cB = (const char*)g.Bt + (size_t)cur.pn * tstep;
    {
        PG8_STAGE(PG8_SB(0, 0), cB, voffB); PG8_STAGE(PG8_SB(0, 1), cB + hstep, voffB); PG8_STAGE(PG8_SA(0, 0), cA, voffA); PG8_STAGE(PG8_SA(0, 1), cA + hstep, voffA);
        if (wr == 1) PG8_BAR;
        PG8_WAIT_V(2); PG8_BAR;
        PG8_STAGE(PG8_SB(1, 0), cB + kstep, voffB); PG8_STAGE(PG8_SA(1, 0), cA + kstep, voffA); PG8_STAGE(PG8_SB(1, 1), cB + hstep + kstep, voffB);
        PG8_WAIT_V(6); PG8_BAR;
    }
    for (;;) {
        const bool has_next = S.next(ui + 1, nxt);
        const char* nA = has_next ? (const char*)g.A + (size_t)nxt.pm * tstep : cA; const char* nB = has_next ? (const char*)g.Bt + (size_t)nxt.pn * tstep : cB;
        for (int t = 0; t < nt; t += 2) {
            const bool last = (t == nt - 2);
            const char* a1 = cA + (size_t)(t + 1) * kstep;
            const char* a2 = last ? nA : cA + (size_t)(t + 2) * kstep; const char* b2 = last ? nB : cB + (size_t)(t + 2) * kstep;
            const char* a3 = a2 + kstep; const char* b3 = b2 + kstep;
            PG8_LDB(B0, 0, 0); PG8_LDB(B1, 0, 1); PG8_SCHED; PG8_LDA(At, 0, 0); PG8_STAGE(PG8_SA(1, 1), a1 + hstep, voffA);
            PG8_WAIT_V(8); PG8_WAIT_L(0); PG8_BAR; PG8_MMA(0, 0, At, B0); PG8_MMA(0, 1, At, B1); PG8_BAR; PG8_SCHED;
            PG8_LDA(At, 0, 1); PG8_STAGE(PG8_SB(0, 0), b2, voffB); PG8_STAGE(PG8_SB(0, 1), b2 + hstep, voffB); PG8_STAGE(PG8_SA(0, 0), a2, voffA);
            PG8_WAIT_V(8); PG8_WAIT_L(0); PG8_BAR; PG8_MMA(1, 0, At, B0); PG8_MMA(1, 1, At, B1); PG8_BAR; PG8_SCHED;
            PG8_LDB(B0, 1, 0); PG8_LDB(B1, 1, 1); PG8_SCHED; PG8_LDA(At, 1, 0); PG8_STAGE(PG8_SA(0, 1), a2 + hstep, voffA);
            PG8_WAIT_V(8); PG8_WAIT_L(0); PG8_BAR; PG8_MMA(0, 0, At, B0); PG8_MMA(0, 1, At, B1); PG8_BAR; PG8_SCHED;
            PG8_LDA(At, 1, 1); PG8_STAGE(PG8_SB(1, 0), b3, voffB); PG8_STAGE(PG8_SB(1, 1), b3 + hstep, voffB); PG8_STAGE(PG8_SA(1, 0), a3, voffA);
            PG8_WAIT_V(8); PG8_WAIT_L(0); PG8_BAR; PG8_MMA(1, 0, At, B0); PG8_MMA(1, 1, At, B1); PG8_BAR; PG8_SCHED;
        }
        if (wr == 0) PG8_BAR;
        E(acc, cur, wr, wc, fr, fq);
        if (!has_next) break;
#pragma unroll
        for (int a = 0; a < 2; ++a)
#pragma unroll
            for (int b = 0; b < 2; ++b)
#pragma unroll
                for (int m = 0; m < 4; ++m)
#pragma unroll
                    for (int n = 0; n < 2; ++n) acc[a][b][m][n] = (f32x4){0.f, 0.f, 0.f, 0.f};
        cur = nxt; cA = nA; cB = nB; ++ui;
        if (wr == 1) PG8_BAR;
    }
    PG8_WAIT_V(0);
    PG8_BAR;
#undef PG8_SA
#undef PG8_SB
#undef PG8_STAGE
#undef PG8_LDA
#undef PG8_LDB
#undef PG8_MMA
#undef PG8_WAIT_V
#undef PG8_WAIT_L
#undef PG8_BAR
#undef PG8_SCHED
}

struct EpiScaleBf16 {
    bf16_t* O; int ldc; const float* rowss; bf16_t* O2; int ldc2; int split_tile; bf16_t* KD2;
    const LAS float* tab; int pm0;
    __device__ __forceinline__ void operator()(const f32x4 (&acc)[2][2][4][2], const Unit& u, int wr, int wc, int fr, int fq) const {
        const bool hi = u.pn >= split_tile, mid = (split_tile == 8) && u.pn >= 4 && u.pn < 8;
        const int row0 = u.pm * BM + wr * 64 + fr, col0 = (hi ? u.pn - split_tile : u.pn) * BM + wc * 32 + 8 * fq;
        bf16_t* const Ob = hi ? O2 : O; const int ld = hi ? ldc2 : ldc;
#pragma unroll
        for (int ai = 0; ai < 2; ++ai)
#pragma unroll
            for (int m = 0; m < 4; ++m) { const int row = row0 + ai * HALF + m * 16;
                const float sc = !rowss ? 1.f : ((tab && u.pm == pm0) ? tab[row & 255] : row_rstd(rowss, row));
                bf16_t* rowp = Ob + (size_t)row * ld + col0;
#pragma unroll
                for (int bj = 0; bj < 2; ++bj) { const f32x4 v0 = acc[ai][bj][m][0] * sc, v1 = acc[ai][bj][m][1] * sc;
                    u32x4 w; w.x = pk2(v0[0], v0[1]); w.y = pk2(v0[2], v0[3]); w.z = pk2(v1[0], v1[1]); w.w = pk2(v1[2], v1[3]);
                    bf16_t* dst = rowp + bj * HALF;
                    if (mid) dst = KD2 + (u.pn >= 6 ? (size_t)8388608 : (size_t)0) + ((size_t)(((row >> 11) * 4 + 2 * (u.pn & 1) + bj) * 2048 + (row & 2047))) * 128 + wc * 32 + 8 * fq;
                    *(u32x4*)dst = w; } }
    }
};
struct EpiSwiGLU {
    bf16_t* O; const float* rowss; const LAS float* tab; int pm0;
    __device__ __forceinline__ void operator()(const f32x4 (&acc)[2][2][4][2], const Unit& u, int wr, int wc, int fr, int fq) const {
        const int row0 = u.pm * BM + wr * 64 + fr, col0 = u.pn * HALF + wc * 32 + 8 * fq;
#pragma unroll
        for (int ai = 0; ai < 2; ++ai)
#pragma unroll
            for (int m = 0; m < 4; ++m) { const int row = row0 + ai * HALF + m * 16;
                const float sc = (tab && u.pm == pm0) ? tab[row & 255] : row_rstd(rowss, row);
                float h[8];
#pragma unroll
                for (int n = 0; n < 2; ++n)
#pragma unroll
                    for (int j = 0; j < 4; ++j) { const float gt = acc[ai][0][m][n][j] * sc, up = acc[ai][1][m][n][j] * sc; h[n * 4 + j] = gt * __builtin_amdgcn_rcpf(1.f + __expf(-gt)) * up; }
                u32x4 w; w.x = pk2(h[0], h[1]); w.y = pk2(h[2], h[3]); w.z = pk2(h[4], h[5]); w.w = pk2(h[6], h[7]);
                *(u32x4*)(O + (size_t)row * DFF + col0) = w; }
    }
};
struct EpiResid {
    float* X; bf16_t* XB; float* rowss_next;
    __device__ __forceinline__ void operator()(const f32x4 (&acc)[2][2][4][2], const Unit& u, int wr, int wc, int fr, int fq) const {
        const int row0 = u.pm * BM + wr * 64 + fr, col0 = u.pn * BM + wc * 32 + 8 * fq;
#pragma unroll
        for (int ai = 0; ai < 2; ++ai)
#pragma unroll
            for (int m = 0; m < 4; ++m) { const int row = row0 + ai * HALF + m * 16; float ss = 0.f;
                float* xp = X + (size_t)row * DM + col0; bf16_t* bp = XB + (size_t)row * DM + col0;
#pragma unroll
                for (int bj = 0; bj < 2; ++bj) {
                    f32x4 x0 = *(f32x4*)(xp + bj * HALF), x1 = *(f32x4*)(xp + bj * HALF + 4);
                    x0 = x0 + acc[ai][bj][m][0]; x1 = x1 + acc[ai][bj][m][1];
                    *(f32x4*)(xp + bj * HALF) = x0; *(f32x4*)(xp + bj * HALF + 4) = x1;
                    ss += (x0[0] * x0[0] + x0[1] * x0[1]) + (x0[2] * x0[2] + x0[3] * x0[3]) + (x1[0] * x1[0] + x1[1] * x1[1]) + (x1[2] * x1[2] + x1[3] * x1[3]);
                    u32x4 w; w.x = pk2(x0[0], x0[1]); w.y = pk2(x0[2], x0[3]); w.z = pk2(x1[0], x1[1]); w.w = pk2(x1[2], x1[3]);
                    *(u32x4*)(bp + bj * HALF) = w; }
                ss += __shfl_xor(ss, 16); ss += __shfl_xor(ss, 32);
                if (fq == 0) rowss_next[(size_t)row * 16 + u.pn * 4 + wc] = ss; }
    }
};
}

struct KArgs { const float* in[31]; float* out; unsigned char* ws; };
#define CAS __attribute__((address_space(4)))
struct InProxy { const CAS unsigned long long* k; __device__ __forceinline__ const float* operator[](int i) const { return (const float*)k[i]; } };
struct Params { InProxy in; float* out; unsigned char* ws; };
__device__ __forceinline__ Params make_params() {
    unsigned long long kv = (unsigned long long)__builtin_amdgcn_kernarg_segment_ptr();
    asm volatile("" : "+s"(kv));
    const CAS unsigned long long* k = (const CAS unsigned long long*)kv;
    Params p; p.in.k = k; p.out = (float*)k[31]; p.ws = (unsigned char*)k[32]; return p;
}

struct Frame {
    LAS unsigned char* lds;
    int tid, lane, wave, G, bid;
};

#define REFRAME(F) do { int _t = threadIdx.x; asm volatile("" : "+v"(_t)); (F).tid = _t; (F).lane = _t & 63; (F).wave = __builtin_amdgcn_readfirstlane(_t >> 6); } while (0)
__device__ __forceinline__ void cvt_item(const float* W_, int K, int ldn, int nblk, bf16_t* WT_, const float* gain_, bool perm_gu, LAS float* scr, int item, int lane) {
    const GAS float* W = (const GAS float*)W_; const GAS float* gain = (const GAS float*)gain_; GAS bf16_t* WT = (GAS bf16_t*)WT_;
    const int kb = item / nblk, nb = item % nblk, k0 = 64 * kb, n0d = 32 * nb;
    const int n0s = perm_gu ? (((n0d & 255) >> 7) * DFF + (n0d >> 8) * 128 + (n0d & 127)) : n0d;
    float v[32];
#pragma unroll
    for (int i = 0; i < 32; ++i) v[i] = W[(size_t)(k0 + 2 * i + (lane >> 5)) * ldn + n0s + (lane & 31)];
    if (gain_) {
#pragma unroll
        for (int i = 0; i < 32; ++i) v[i] *= gain[k0 + 2 * i + (lane >> 5)];
    }
#pragma unroll
    for (int i = 0; i < 32; ++i) scr[(2 * i + (lane >> 5)) * 33 + (lane & 31)] = v[i];
    asm volatile("s_waitcnt lgkmcnt(0)" ::: "memory");
    const int c = lane & 7;
#pragma unroll
    for (int j = 0; j < 4; ++j) { const int n = (lane >> 3) + 8 * j; const LAS float* sp = scr + (8 * c) * 33 + n;
        u32x4 o; o.x = pk2(sp[0 * 33], sp[1 * 33]); o.y = pk2(sp[2 * 33], sp[3 * 33]); o.z = pk2(sp[4 * 33], sp[5 * 33]); o.w = pk2(sp[6 * 33], sp[7 * 33]);
        *(GAS u32x4*)(WT + (size_t)(n0d + n) * K + k0 + 8 * c) = o; }
    asm volatile("s_waitcnt lgkmcnt(0)" ::: "memory");
}
constexpr int CV_IN = 1536, CV_OUT = 512, CV_Q = 256, CV_KV = 512, CV_O = 256, CV_GU = 2816, CV_DOWN = 1408, CV_L = 8;
constexpr int CV_TOTAL = CV_IN + CV_OUT + CV_Q + CV_KV + CV_O + CV_GU + CV_DOWN + 2 * CV_L + 2 * CV_L + 16;

static_assert(CV_TOTAL % 8 == 0, "conversion items per layer");
constexpr int CV_A = CV_IN + 2 * CV_L + 2 * CV_L + 16, CV_B = CV_KV + CV_OUT + CV_Q + CV_O + CV_GU + CV_DOWN;
static_assert(CV_A % 8 == 0 && CV_B % 8 == 0 && CV_A + CV_B == CV_TOTAL, "conversion lists");
__device__ __forceinline__ void cvt_item_a(const Params& p, int l, bf16_t* wb, LAS float* scr, int it, int lane) {
    int r = it;
    if (r < CV_IN) { cvt_item(p.in[3] + (size_t)l * DM * INW, DM, INW, INW / 32, wb + WO_IN, p.in[2] + l * DM, false, scr, r, lane); return; } r -= CV_IN;
    if (r < 2 * CV_L) { const int d = r / CV_L; cvt_item(p.in[12] + ((size_t)l * 2 + d) * 64 * 256, 64, 256, 8, wb + WO_WUP + d * 256 * 64, nullptr, false, scr, r % CV_L, lane); return; } r -= 2 * CV_L;
    if (r < 2 * CV_L) { const int d = r / CV_L; cvt_item(p.in[14] + ((size_t)l * 2 + d) * 64 * 256, 64, 256, 8, wb + WO_AUP + d * 256 * 64, nullptr, false, scr, r % CV_L, lane); return; } r -= 2 * CV_L;
    cvt_item(p.in[15] + (size_t)l * 128 * 256, 128, 256, 8, wb + WO_GUP, nullptr, false, scr, r, lane);
}
__device__ __forceinline__ void cvt_item_b(const Params& p, int l, bf16_t* wb, LAS float* scr, int it, int lane) {
    int r = it;
    if (r < CV_KV) { cvt_item(p.in[25] + (size_t)l * DM * 1024, DM, 1024, 32, wb + WO_KV, nullptr, false, scr, r, lane); return; } r -= CV_KV;
    if (r < CV_OUT) { cvt_item(p.in[21] + (size_t)l * DM * DM, DM, DM, DM / 32, wb + WO_OUT, nullptr, false, scr, r, lane); return; } r -= CV_OUT;
    if (r < CV_Q) { cvt_item(p.in[24] + (size_t)l * DM * XW, DM, XW, XW / 32, wb + WO_Q, p.in[22] + l * DM, false, scr, r, lane); return; } r -= CV_Q;
    if (r < CV_O) { cvt_item(p.in[26] + (size_t)l * XW * DM, XW, DM, 32, wb + WO_O, nullptr, false, scr, r, lane); return; } r -= CV_O;
    if (r < CV_GU) { cvt_item(p.in[28] + (size_t)l * DM * 2 * DFF, DM, 2 * DFF, 2 * DFF / 32, wb + WO_GU, p.in[27] + l * DM, true, scr, r, lane); return; } r -= CV_GU;
    cvt_item(p.in[29] + (size_t)l * DFF * DM, DFF, DM, 32, wb + WO_DOWN, nullptr, false, scr, r, lane);
}

__device__ __forceinline__ s16x4 vtr(const LAS unsigned char* p) { return __builtin_bit_cast(s16x4, __builtin_amdgcn_ds_read_tr16_b64_v4i16((LAS v4i16_t*)p)); }
__device__ __forceinline__ int crow(int r, int hi) { return (r & 3) + 8 * (r >> 2) + 4 * hi; }

template <int W> __device__ __forceinline__ void tile_load(u32x4 (&r)[W / 64], const bf16_t* g, int pitch, int tid) {
#pragma unroll
    for (int i = 0; i < W / 64; ++i) { const int id = tid + i * 512, row = id / (W / 8), ch = id % (W / 8); r[i] = *(const GAS u32x4*)((const GAS bf16_t*)g + (size_t)row * pitch + ch * 8); }
}
template <int W, int STR> __device__ __forceinline__ void tile_store(const u32x4 (&r)[W / 64], LAS unsigned char* buf, int tid) {
#pragma unroll
    for (int i = 0; i < W / 64; ++i) { const int id = tid + i * 512, row = id / (W / 8), ch = id % (W / 8); *(LAS u32x4*)(buf + row * STR + ch * 16) = r[i]; }
}
template <int DQK> __device__ __forceinline__ void load_q(bf16x8 (&qf)[DQK / 16], const bf16_t* qrow, int h, float sc) {
#pragma unroll
    for (int ks = 0; ks < DQK / 16; ++ks) { const u32x4 v = *(const GAS u32x4*)((const GAS bf16_t*)qrow + 16 * ks + 8 * h);
        u32x4 o; o.x = pk2(bflo(v.x) * sc, bfhi(v.x) * sc); o.y = pk2(bflo(v.y) * sc, bfhi(v.y) * sc); o.z = pk2(bflo(v.z) * sc, bfhi(v.z) * sc); o.w = pk2(bflo(v.w) * sc, bfhi(v.w) * sc);
        qf[ks] = __builtin_bit_cast(bf16x8, o); }
}
template <int DQK, int KW, int DV, int MODE>
__device__ __forceinline__ void attn_loop(LAS unsigned char* lds, const bf16_t* Kg, int kpitch, const bf16_t* Vg, int vpitch, int ntiles,
                                          const bf16x8 (&qf)[DQK / 16], int koff, float nslope2, int qrel, float& m, float& lsum, f32x16 (&o)[DV / 32]) {
    constexpr int KSTR = (KW + 8) * 2, VSTR = DV * 2 + 64, KBUF = 64 * KSTR, VBUF = 64 * VSTR;
    int tid_ = threadIdx.x; asm volatile("" : "+v"(tid_));
    const int tid = tid_, lane = tid & 63, r = lane & 31, h = lane >> 5;
    LAS unsigned char* K0 = lds; LAS unsigned char* V0 = lds + 2 * KBUF;
    u32x4 kr[KW / 64], vr[DV / 64];
    tile_load<KW>(kr, Kg, kpitch, tid); tile_load<DV>(vr, Vg, vpitch, tid);
    tile_store<KW, KSTR>(kr, K0, tid); tile_store<DV, VSTR>(vr, V0, tid);
    __syncthreads();
    const int vlane = ((lane & 15) >> 2) * VSTR + (16 * ((lane >> 4) & 1) + 4 * (lane & 3)) * 2 + 4 * h * VSTR;
    for (int t = 0; t < ntiles; ++t) {
        const int cur = t & 1;
        if (t + 1 < ntiles) { tile_load<KW>(kr, Kg + (size_t)(t + 1) * 64 * kpitch, kpitch, tid); tile_load<DV>(vr, Vg + (size_t)(t + 1) * 64 * vpitch, vpitch, tid); }
        const LAS unsigned char* Kb = K0 + cur * KBUF + r * KSTR + (koff + 8 * h) * 2;
        const LAS unsigned char* Vb = V0 + cur * VBUF + vlane;
        f32x16 s0, s1;
#pragma unroll
        for (int i = 0; i < 16; ++i) { s0[i] = 0.f; s1[i] = 0.f; }
#pragma unroll
        for (int ks = 0; ks < DQK / 16; ++ks) {
            const bf16x8 k0 = *(const LAS bf16x8*)(Kb + ks * 32), k1 = *(const LAS bf16x8*)(Kb + 32 * KSTR + ks * 32);
            s0 = __builtin_amdgcn_mfma_f32_32x32x16_bf16(k0, qf[ks], s0, 0, 0, 0);
            s1 = __builtin_amdgcn_mfma_f32_32x32x16_bf16(k1, qf[ks], s1, 0, 0, 0);
        }
        float Aoff = 0.f;
        if (MODE >= 1) {
            const int qrel0 = __builtin_amdgcn_readfirstlane(qrel - r);
            const int T0 = t * 64;
            if (MODE == 1 && (T0 + 64 <= qrel0 || T0 > qrel0 + 31)) {
                const bool left = (T0 + 64 <= qrel0);
                const float sl = left ? -nslope2 : nslope2;
                Aoff = left ? nslope2 * (float)(qrel - T0 - 4 * h) : nslope2 * (float)(T0 + 4 * h - qrel);
#pragma unroll
                for (int i = 0; i < 16; ++i) { s0[i] = __builtin_fmaf(sl, (float)((i & 3) + 8 * (i >> 2)), s0[i]); s1[i] = __builtin_fmaf(sl, (float)(32 + (i & 3) + 8 * (i >> 2)), s1[i]); }
            } else {
                const float base = (float)(T0 + 4 * h - qrel);
#pragma unroll
                for (int i = 0; i < 16; ++i) {
                    const float d0 = fabsf(base + (float)((i & 3) + 8 * (i >> 2))), d1 = fabsf(base + (float)(32 + (i & 3) + 8 * (i >> 2)));
                    s0[i] = __builtin_fmaf(d0, nslope2, s0[i]); s1[i] = __builtin_fmaf(d1, nslope2, s1[i]);
                    if (MODE == 2) { if (d0 > 128.f) s0[i] = -1e30f; if (d1 > 128.f) s1[i] = -1e30f; }
                }
            }
        }
        float mx = fmaxf(s0[0], s1[0]);
#pragma unroll
        for (int i = 1; i < 16; ++i) mx = fmaxf(fmaxf(mx, s0[i]), s1[i]);
        mx += Aoff;
        mx = fmaxf(mx, xhalf(mx));
        const float mnew = fmaxf(m, mx);
        if (__builtin_amdgcn_ballot_w64(mnew > m) != 0ull) {
            const float alpha = __builtin_amdgcn_exp2f(m - mnew);
            lsum *= alpha;
#pragma unroll
            for (int d = 0; d < DV / 32; ++d) o[d] = o[d] * alpha;
        }
        m = mnew;
        const float mm = mnew - Aoff;
        float rs = 0.f;
#pragma unroll
        for (int i = 0; i < 16; ++i) { s0[i] = __builtin_amdgcn_exp2f(s0[i] - mm); s1[i] = __builtin_amdgcn_exp2f(s1[i] - mm); rs += s0[i] + s1[i]; }
        lsum += rs;
        bf16x8 pf[4];
#pragma unroll
        for (int s2 = 0; s2 < 2; ++s2) {
            u32x4 a, b;
            a.x = pk2(s0[8 * s2 + 0], s0[8 * s2 + 1]); a.y = pk2(s0[8 * s2 + 2], s0[8 * s2 + 3]); a.z = pk2(s0[8 * s2 + 4], s0[8 * s2 + 5]); a.w = pk2(s0[8 * s2 + 6], s0[8 * s2 + 7]);
            b.x = pk2(s1[8 * s2 + 0], s1[8 * s2 + 1]); b.y = pk2(s1[8 * s2 + 2], s1[8 * s2 + 3]); b.z = pk2(s1[8 * s2 + 4], s1[8 * s2 + 5]); b.w = pk2(s1[8 * s2 + 6], s1[8 * s2 + 7]);
            pf[s2] = __builtin_bit_cast(bf16x8, a); pf[2 + s2] = __builtin_bit_cast(bf16x8, b);
        }
#pragma unroll
        for (int d = 0; d < DV / 32; ++d) {
#pragma unroll
            for (int kk = 0; kk < 4; ++kk) {
                const s16x4 lo = vtr(Vb + (16 * kk) * VSTR + d * 64), hi = vtr(Vb + (16 * kk + 8) * VSTR + d * 64);
                const bf16x8 vf = {lo[0], lo[1], lo[2], lo[3], hi[0], hi[1], hi[2], hi[3]};
                o[d] = __builtin_amdgcn_mfma_f32_32x32x16_bf16(vf, pf[kk], o[d], 0, 0, 0);
            }
        }
        if (t + 1 < ntiles) { tile_store<KW, KSTR>(kr, K0 + (cur ^ 1) * KBUF, tid); tile_store<DV, VSTR>(vr, V0 + (cur ^ 1) * VBUF, tid); }
        __syncthreads();
    }
}
__device__ __forceinline__ int swz(int row) { return ((row & 3) << 2) | ((row >> 2) & 3); }
template <int DQK, int MODE, int pitch, int voff>
__device__ __forceinline__ void attn_loop_dma(LAS unsigned char* lds, const int wave, const bf16_t* Kg, int ntiles,
                                              const bf16x8 (&qf)[DQK / 16], int koff, float nslope2, int qrel, float& m, float& lsum, f32x16 (&o)[4]) {
    constexpr int DV = 128, STAGE = 32768, VOFFB = 16384;
    const int lane = hw_lane(), r = lane & 31, h = lane >> 5;
    unsigned gk[2];
#pragma unroll
    for (int i = 0; i < 2; ++i) { const int row = 4 * (2 * wave + i) + (lane >> 4), c = (lane & 15) ^ swz(row); gk[i] = (unsigned)(row * pitch + c * 8); }
    unsigned kad[DQK / 16], vad[4][2];
#pragma unroll
    for (int ks = 0; ks < DQK / 16; ++ks) kad[ks] = (unsigned)(r * 256 + 16 * (((koff >> 3) + 2 * ks + h) ^ swz(r)));
    { const int q_ = (lane & 15) >> 2, pp = lane & 3, g1 = (lane >> 4) & 1;
#pragma unroll
      for (int d = 0; d < 4; ++d)
#pragma unroll
          for (int hi = 0; hi < 2; ++hi) { const int f = (q_ << 2) | ((2 * hi + h) & 3), c = (4 * d + 2 * g1 + (pp >> 1)) ^ f;
              vad[d][hi] = (unsigned)(VOFFB + (4 * h + q_) * 256 + 16 * c + 8 * (pp & 1) + hi * 2048); } }
#define ATT_DMA(tt, st) do { const bf16_t* kg_ = Kg + (size_t)(tt) * 64 * pitch; _Pragma("unroll") for (int i_ = 0; i_ < 2; ++i_) { \
        __builtin_amdgcn_global_load_lds((const unsigned*)(kg_ + gk[i_]), (LAS unsigned*)(lds + (st) * STAGE + (2 * wave + i_) * 1024), 16, 0, 0); \
        __builtin_amdgcn_global_load_lds((const unsigned*)(kg_ + voff + gk[i_]), (LAS unsigned*)(lds + (st) * STAGE + VOFFB + (2 * wave + i_) * 1024), 16, 0, 0); } } while (0)
    ATT_DMA(0, 0);
    if (ntiles > 1) ATT_DMA(1, 1);
    if (ntiles > 2) { ATT_DMA(2, 2); asm volatile("s_waitcnt vmcnt(4)" ::: "memory"); } else asm volatile("s_waitcnt vmcnt(0)" ::: "memory");
    __builtin_amdgcn_s_barrier();
    f32x16 s0, s1;
#pragma unroll
    for (int i = 0; i < 16; ++i) { s0[i] = 0.f; s1[i] = 0.f; }
#pragma unroll
    for (int ks = 0; ks < DQK / 16; ++ks) {
        const bf16x8 k0 = *(const LAS bf16x8*)(lds + kad[ks]), k1 = *(const LAS bf16x8*)(lds + kad[ks] + 8192);
        s0 = __builtin_amdgcn_mfma_f32_32x32x16_bf16(k0, qf[ks], s0, 0, 0, 0);
        s1 = __builtin_amdgcn_mfma_f32_32x32x16_bf16(k1, qf[ks], s1, 0, 0, 0);
    }
#define LDS_RD128(dst, addr, off) asm volatile("ds_read_b128 %0, %1 offset:%c2" : "=&v"(dst) : "v"(addr), "i"(off) : "memory")
#define LDS_RDTR(dst, addr, off) asm volatile("ds_read_b64_tr_b16 %0, %1 offset:%c2" : "=&v"(dst) : "v"(addr), "i"(off) : "memory")
#define LDS_WAIT0() do { asm volatile("s_waitcnt lgkmcnt(0)" ::: "memory"); __builtin_amdgcn_sched_barrier(0); } while (0)
    for (int t = 0; t < ntiles; ++t) {
        if (t + 3 < ntiles) ATT_DMA(t + 3, (t + 3) & 3);
        const unsigned sba = (unsigned)(size_t)(lds + (t & 3) * STAGE), sna = (unsigned)(size_t)(lds + ((t + 1) & 3) * STAGE);
        constexpr int KH = (DQK == 64) ? 4 : 4;
        bf16x8 kf0[KH], kf1[KH];
        s16x4 va_lo[4], va_hi[4], vb_lo[4], vb_hi[4];
        if (DQK == 64) {
#pragma unroll
            for (int ks = 0; ks < KH; ++ks) { const unsigned ka = sna + kad[ks]; LDS_RD128(kf0[ks], ka, 0); } }
        __builtin_amdgcn_sched_barrier(0);
        float Aoff = 0.f;
        if (MODE >= 1) {
            const int qrel0 = __builtin_amdgcn_readfirstlane(qrel - r);
            const int T0 = t * 64;
            if (MODE == 1 && (T0 + 64 <= qrel0 || T0 > qrel0 + 31)) {
                const bool left = (T0 + 64 <= qrel0);
                const float sl = left ? -nslope2 : nslope2;
                Aoff = left ? nslope2 * (float)(qrel - T0 - 4 * h) : nslope2 * (float)(T0 + 4 * h - qrel);
#pragma unroll
                for (int i = 0; i < 16; ++i) { s0[i] = __builtin_fmaf(sl, (float)((i & 3) + 8 * (i >> 2)), s0[i]); s1[i] = __builtin_fmaf(sl, (float)(32 + (i & 3) + 8 * (i >> 2)), s1[i]); }
            } else {
                const float base = (float)(T0 + 4 * h - qrel);
#pragma unroll
                for (int i = 0; i < 16; ++i) {
                    const float d0 = fabsf(base + (float)((i & 3) + 8 * (i >> 2))), d1 = fabsf(base + (float)(32 + (i & 3) + 8 * (i >> 2)));
                    s0[i] = __builtin_fmaf(d0, nslope2, s0[i]); s1[i] = __builtin_fmaf(d1, nslope2, s1[i]);
                    if (MODE == 2) { if (d0 > 128.f) s0[i] = -1e30f; if (d1 > 128.f) s1[i] = -1e30f; }
                }
            }
        }
        float mx = fmaxf(s0[0], s1[0]);
#pragma unroll
        for (int i = 1; i < 16; ++i) mx = fmaxf(fmaxf(mx, s0[i]), s1[i]);
        mx += Aoff;
        mx = fmaxf(mx, xhalf(mx));
        const float mnew = fmaxf(m, mx);
        if (__builtin_amdgcn_ballot_w64(mnew > m) != 0ull) {
            const float alpha = __builtin_amdgcn_exp2f(m - mnew);
            lsum *= alpha;
#pragma unroll
            for (int d = 0; d < DV / 32; ++d) o[d] = o[d] * alpha;
        }
        m = mnew;
        const float mm = mnew - Aoff;
        float rs = 0.f;
#pragma unroll
        for (int i = 0; i < 16; ++i) { s0[i] = __builtin_amdgcn_exp2f(s0[i] - mm); s1[i] = __builtin_amdgcn_exp2f(s1[i] - mm); rs += s0[i] + s1[i]; }
        lsum += rs;
        bf16x8 pf[4];
#pragma unroll
        for (int s2 = 0; s2 < 2; ++s2) {
            u32x4 a, b;
            a.x = pk2(s0[8 * s2 + 0], s0[8 * s2 + 1]); a.y = pk2(s0[8 * s2 + 2], s0[8 * s2 + 3]); a.z = pk2(s0[8 * s2 + 4], s0[8 * s2 + 5]); a.w = pk2(s0[8 * s2 + 6], s0[8 * s2 + 7]);
            b.x = pk2(s1[8 * s2 + 0], s1[8 * s2 + 1]); b.y = pk2(s1[8 * s2 + 2], s1[8 * s2 + 3]); b.z = pk2(s1[8 * s2 + 4], s1[8 * s2 + 5]); b.w = pk2(s1[8 * s2 + 6], s1[8 * s2 + 7]);
            pf[s2] = __builtin_bit_cast(bf16x8, a); pf[2 + s2] = __builtin_bit_cast(bf16x8, b);
        }
        LDS_WAIT0();
        if (DQK == 64) {
#pragma unroll
            for (int ks = 0; ks < KH; ++ks) { const unsigned ka = sna + kad[ks]; LDS_RD128(kf1[ks], ka, 8192); } }
        { const unsigned alo = sba + vad[0][0], ahi = sba + vad[0][1];
#pragma unroll
          for (int kk = 0; kk < 4; ++kk) { LDS_RDTR(va_lo[kk], alo, kk * 4096); LDS_RDTR(va_hi[kk], ahi, kk * 4096); } }
        __builtin_amdgcn_sched_barrier(0);
        f32x16 n0, n1;
#pragma unroll
        for (int i = 0; i < 16; ++i) { n0[i] = 0.f; n1[i] = 0.f; }
#pragma unroll
        for (int g = 0; g < DQK / 64; ++g) {
            if (DQK != 64) {
#pragma unroll
                for (int ks = 0; ks < KH; ++ks) { const unsigned ka = sna + kad[g * KH + ks]; LDS_RD128(kf0[ks], ka, 0); LDS_RD128(kf1[ks], ka, 8192); }
                LDS_WAIT0(); }
#pragma unroll
            for (int ks = 0; ks < KH; ++ks) n0 = __builtin_amdgcn_mfma_f32_32x32x16_bf16(kf0[ks], qf[g * KH + ks], n0, 0, 0, 0);
            if (DQK == 64) LDS_WAIT0();
#pragma unroll
            for (int ks = 0; ks < KH; ++ks) n1 = __builtin_amdgcn_mfma_f32_32x32x16_bf16(kf1[ks], qf[g * KH + ks], n1, 0, 0, 0);
        }
#define PV_BLOCK(d, lo, hi) do { _Pragma("unroll") for (int kk = 0; kk < 4; ++kk) { const bf16x8 vf = {lo[kk][0], lo[kk][1], lo[kk][2], lo[kk][3], hi[kk][0], hi[kk][1], hi[kk][2], hi[kk][3]}; \
            o[d] = __builtin_amdgcn_mfma_f32_32x32x16_bf16(vf, pf[kk], o[d], 0, 0, 0); } } while (0)
#define V_ISSUE(d, lo, hi) do { const unsigned alo_ = sba + vad[d][0], ahi_ = sba + vad[d][1]; _Pragma("unroll") for (int kk = 0; kk < 4; ++kk) { LDS_RDTR(lo[kk], alo_, kk * 4096); LDS_RDTR(hi[kk], ahi_, kk * 4096); } } while (0)
        LDS_WAIT0();
        V_ISSUE(1, vb_lo, vb_hi); __builtin_amdgcn_sched_barrier(0);
        PV_BLOCK(0, va_lo, va_hi);
        LDS_WAIT0();
        V_ISSUE(2, va_lo, va_hi); __builtin_amdgcn_sched_barrier(0);
        PV_BLOCK(1, vb_lo, vb_hi);
        LDS_WAIT0();
        V_ISSUE(3, vb_lo, vb_hi); __builtin_amdgcn_sched_barrier(0);
        PV_BLOCK(2, va_lo, va_hi);
        LDS_WAIT0();
        PV_BLOCK(3, vb_lo, vb_hi);
#undef PV_BLOCK
#undef V_ISSUE
        s0 = n0; s1 = n1;
        if (t + 3 < ntiles) asm volatile("s_waitcnt vmcnt(4)" ::: "memory"); else asm volatile("s_waitcnt vmcnt(0)" ::: "memory");
        __builtin_amdgcn_s_barrier();
    }
#undef LDS_RD128
#undef LDS_RDTR
#undef LDS_WAIT0
#undef ATT_DMA
}
template <int DV> __device__ __forceinline__ void store_o(const f32x16 (&o)[DV / 32], float sc, bf16_t* orow, int h) {
#pragma unroll
    for (int d = 0; d < DV / 32; ++d)
#pragma unroll
        for (int g4 = 0; g4 < 4; ++g4) { u32x2 w; w.x = pk2(o[d][4 * g4] * sc, o[d][4 * g4 + 1] * sc); w.y = pk2(o[d][4 * g4 + 2] * sc, o[d][4 * g4 + 3] * sc);
            *(GAS u32x2*)((GAS bf16_t*)orow + 32 * d + 8 * g4 + 4 * h) = w; }
}

__device__ __forceinline__ void win_unit(Frame& F, const Params& p, int l, int u) {
    REFRAME(F);
    const bf16_t* Z = (const bf16_t*)(p.ws + WS_Z); bf16_t* MIX = (bf16_t*)(p.ws + WS_MIX);
    const int b = u >> 5, kvh = (u >> 4) & 1, nb = u & 15, r = F.lane & 31, h = F.lane >> 5;
    const int g = F.wave >> 2, hq = kvh * 2 + g, qpos = nb * 128 + (F.wave & 3) * 32 + r;
    const size_t tok = (size_t)b * SEQ + qpos;
    bf16x8 qf[4]; load_q<64>(qf, Z + tok * ZP + hq * 64, h, 0.125f * LOG2E);
    const int first = (2 * nb - 2 < 0) ? 0 : 2 * nb - 2, lastx = (2 * nb + 4 > 32) ? 32 : 2 * nb + 4, nt = lastx - first;
    const float slope = exp2f(-(float)(2 * hq + 1));
    float m = p.in[4][l * 4 + hq] * LOG2E, ls = (h == 0) ? 1.f : 0.f;
    f32x16 o[2];
#pragma unroll
    for (int d = 0; d < 2; ++d)
#pragma unroll
        for (int i = 0; i < 16; ++i) o[d][i] = 0.f;
    const bf16_t* Kg = Z + ((size_t)b * SEQ + first * 64) * ZP + 256 + kvh * 64;
    attn_loop<64, 64, 64, 2>(F.lds, Kg, ZP, Kg + 128, ZP, nt, qf, 0, -slope * LOG2E, qpos - first * 64, m, ls, o);
    const float lt = ls + xhalf(ls);
    store_o<64>(o, 1.f / lt, MIX + tok * DM + hq * 64, h);
}
__device__ __forceinline__ void diff_unit(Frame& F, const Params& p, int l, int u) {
    REFRAME(F);
    const bf16_t* Z = (const bf16_t*)(p.ws + WS_Z); bf16_t* MIX = (bf16_t*)(p.ws + WS_MIX);
    const int b = u >> 6, hh = (u >> 4) & 3, qb = u & 15, r = F.lane & 31, h = F.lane >> 5;
    const int c = F.wave >> 2, qpos = qb * 128 + (F.wave & 3) * 32 + r;
    const size_t tok = (size_t)b * SEQ + qpos;
    float lam, lam_init;
    {
        const float a1 = wave_sum(p.in[5][l * 64 + F.lane] * p.in[6][l * 64 + F.lane]), a2 = wave_sum(p.in[7][l * 64 + F.lane] * p.in[8][l * 64 + F.lane]);
        lam_init = 0.8f - 0.6f * expf(-0.3f * (float)l);
        lam = expf(a1) - expf(a2) + lam_init;
    }
    bf16x8 qf[4]; load_q<64>(qf, Z + tok * ZP + 512 + hh * 128 + c * 64, h, 0.125f * LOG2E);
    const float slope = exp2f(-(float)(2 * hh + 2));
    float m = -1e30f, ls = 0.f;
    f32x16 o[4];
#pragma unroll
    for (int d = 0; d < 4; ++d)
#pragma unroll
        for (int i = 0; i < 16; ++i) o[d][i] = 0.f;
    const bf16_t* Kg = (const bf16_t*)(p.ws + WS_KD2) + (size_t)(b * 4 + hh) * 2048 * 128;
    attn_loop_dma<64, 1, 128, 8388608>(F.lds, F.wave, Kg, 32, qf, c * 64, -slope * LOG2E, qpos, m, ls, o);
    const float inv = 1.f / (ls + xhalf(ls));
    LAS float* comb = (LAS float*)F.lds + (size_t)(F.wave & 3) * 64 * 64 + F.lane;
    if (c == 1) {
#pragma unroll
        for (int d = 0; d < 4; ++d)
#pragma unroll
            for (int i = 0; i < 16; ++i) comb[(d * 16 + i) * 64] = o[d][i] * inv;
    }
    __syncthreads();
    if (c == 0) {
        float ss = 0.f;
#pragma unroll
        for (int d = 0; d < 4; ++d)
#pragma unroll
            for (int i = 0; i < 16; ++i) { const float a = o[d][i] * inv - lam * comb[(d * 16 + i) * 64]; o[d][i] = a; ss += a * a; }
        ss += xhalf(ss);
        const float rn = rsqrtf(ss * (1.f / 128.f) + 1e-6f) * (1.f - lam_init);
        const float* sg = p.in[9] + l * 128;
        bf16_t* orow = MIX + tok * DM + 256 + hh * 128;
        f32x4 ggv[4][4];
#pragma unroll
        for (int d = 0; d < 4; ++d)
#pragma unroll
            for (int g4 = 0; g4 < 4; ++g4) ggv[d][g4] = *(const GAS f32x4*)((const GAS float*)sg + 32 * d + 8 * g4 + 4 * h);
#pragma unroll
        for (int d = 0; d < 4; ++d)
#pragma unroll
            for (int g4 = 0; g4 < 4; ++g4) { const int dv = 32 * d + 8 * g4 + 4 * h; const f32x4 gg = ggv[d][g4];
                u32x2 w; w.x = pk2(o[d][4 * g4] * rn * gg[0], o[d][4 * g4 + 1] * rn * gg[1]); w.y = pk2(o[d][4 * g4 + 2] * rn * gg[2], o[d][4 * g4 + 3] * rn * gg[3]);
                *(GAS u32x2*)((GAS bf16_t*)orow + dv) = w; }
    }
    __syncthreads();
}
__device__ __forceinline__ void cross_unit(Frame& F, const Params& p, int u) {
    REFRAME(F);
    const bf16_t* Q = (const bf16_t*)(p.ws + WS_Q); const bf16_t* KV = (const bf16_t*)(p.ws + WS_KV); bf16_t* O = (bf16_t*)(p.ws + WS_O);
    const int b = u >> 5, hd = (u >> 3) & 3, qb = u & 7, r = F.lane & 31, h = F.lane >> 5;
    const size_t tok = (size_t)b * SEQ + qb * 256 + F.wave * 32 + r;
    bf16x8 qf[8]; load_q<128>(qf, Q + tok * XW + hd * 128, h, 0.08838834764831845f * LOG2E);
    float m = -1e30f, ls = 0.f;
    f32x16 o[4];
#pragma unroll
    for (int d = 0; d < 4; ++d)
#pragma unroll
        for (int i = 0; i < 16; ++i) o[d][i] = 0.f;
    const bf16_t* Kg = KV + ((size_t)b * NMEM) * 1024 + hd * 128;
    attn_loop_dma<128, 0, 1024, 512>(F.lds, F.wave, Kg, 4, qf, 0, 0.f, 0, m, ls, o);
    const float lt = ls + xhalf(ls);
    store_o<128>(o, 1.f / lt, O + tok * XW + hd * 128, h);
}

constexpr int CF_STR = 772, PREP_AW = 32 * CF_STR * 4, PREP_AA = PREP_AW + 32 * 72 * 2, PREP_AG = PREP_AA + 32 * 72 * 2;
__device__ __forceinline__ void prep_unit(Frame& F, const Params& p, int l, const bf16_t* wb, int u) {
    REFRAME(F);
    const bf16_t* ZC = (const bf16_t*)(p.ws + WS_ZC);
    const int t0 = u * 32, b = t0 / SEQ;
    LAS float* CF = (LAS float*)F.lds; LAS bf16_t* AW = (LAS bf16_t*)(F.lds + PREP_AW); LAS bf16_t* AA = (LAS bf16_t*)(F.lds + PREP_AA); LAS bf16_t* AG = (LAS bf16_t*)(F.lds + PREP_AG);
    const float* conv = p.in[10] + (size_t)l * 3 * 1024;
    LAS float* PAR = (LAS float*)(F.lds + PREP_AG + 32 * 136 * 2);
    if (F.tid < 448) { const int i = F.tid; const GAS f32x4* src;
        if (i < 64) src = (const GAS f32x4*)((const GAS float*)p.in[16] + l * 256) + i;
        else if (i < 128) src = (const GAS f32x4*)((const GAS float*)p.in[17] + l * 256) + (i - 64);
        else if (i < 192) src = (const GAS f32x4*)((const GAS float*)p.in[18] + l * 256) + (i - 128);
        else if (i < 320) src = (const GAS f32x4*)((const GAS float*)p.in[11] + l * 512) + (i - 192);
        else src = (const GAS f32x4*)((const GAS float*)p.in[13] + l * 512) + (i - 320);
        ((LAS f32x4*)PAR)[i] = *src; }
#pragma unroll 4
    for (int i = 0; i < 8; ++i) {
        const int id = F.tid + i * 512, tk = id >> 7, ch = id & 127, tg = t0 + tk, tpos = tg - b * SEQ;
        const GAS bf16_t* zp = (const GAS bf16_t*)ZC + (size_t)tg * 1024 + ch * 8;
        const u32x4 zc = *(const GAS u32x4*)zp;
        u32x4 zl = {0u, 0u, 0u, 0u}, zr = {0u, 0u, 0u, 0u};
        if (tpos > 0) zl = *(const GAS u32x4*)(zp - 1024);
        if (tpos < SEQ - 1) zr = *(const GAS u32x4*)(zp + 1024);
        float v[8];
#pragma unroll
        for (int q = 0; q < 4; ++q) {
            const f32x2 c0 = *(const GAS f32x2*)((const GAS float*)conv + ch * 8 + 2 * q), c1 = *(const GAS f32x2*)((const GAS float*)conv + 1024 + ch * 8 + 2 * q), c2 = *(const GAS f32x2*)((const GAS float*)conv + 2048 + ch * 8 + 2 * q);
            v[2 * q] = bflo(zl[q]) * c0[0] + bflo(zc[q]) * c1[0] + bflo(zr[q]) * c2[0];
            v[2 * q + 1] = bfhi(zl[q]) * c0[1] + bfhi(zc[q]) * c1[1] + bfhi(zr[q]) * c2[1];
        }
        if (ch < 96) { *(LAS f32x4*)(CF + tk * CF_STR + ch * 8) = (f32x4){v[0], v[1], v[2], v[3]}; *(LAS f32x4*)(CF + tk * CF_STR + ch * 8 + 4) = (f32x4){v[4], v[5], v[6], v[7]}; }
        else {
            u32x4 w;
            if (ch < 104) {
#pragma unroll
                for (int q = 0; q < 8; ++q) v[q] = 1.f - 2.f * __builtin_amdgcn_rcpf(__expf(2.f * v[q]) + 1.f);
                w.x = pk2(v[0], v[1]); w.y = pk2(v[2], v[3]); w.z = pk2(v[4], v[5]); w.w = pk2(v[6], v[7]);
                *(LAS u32x4*)(AW + tk * 72 + (ch - 96) * 8) = w;
            } else if (ch < 112) {
                w.x = pk2(v[0], v[1]); w.y = pk2(v[2], v[3]); w.z = pk2(v[4], v[5]); w.w = pk2(v[6], v[7]);
                *(LAS u32x4*)(AA + tk * 72 + (ch - 104) * 8) = w;
            } else {
#pragma unroll
                for (int q = 0; q < 8; ++q) v[q] = sigmoidf_(v[q]);
                w.x = pk2(v[0], v[1]); w.y = pk2(v[2], v[3]); w.z = pk2(v[4], v[5]); w.w = pk2(v[6], v[7]);
                *(LAS u32x4*)(AG + tk * 136 + (ch - 112) * 8) = w;
            }
        }
    }
    __syncthreads();
    const int hh = F.wave & 3, dir = F.wave >> 2, tk = F.lane & 31, h2 = F.lane >> 5;
    const size_t tok = (size_t)t0 + tk;
    const GAS bf16_t* Wup = (const GAS bf16_t*)wb + WO_WUP + (size_t)(dir * 256 + hh * 64) * 64;
    const GAS bf16_t* Aup = (const GAS bf16_t*)wb + WO_AUP + (size_t)(dir * 256 + hh * 64) * 64;
    f32x16 aw[2], aa[2];
#pragma unroll
    for (int rb = 0; rb < 2; ++rb)
#pragma unroll
        for (int i = 0; i < 16; ++i) { aw[rb][i] = 0.f; aa[rb][i] = 0.f; }
#pragma unroll
    for (int ks = 0; ks < 4; ++ks) {
        const bf16x8 bw = *(const LAS bf16x8*)(AW + tk * 72 + 16 * ks + 8 * h2), ba = *(const LAS bf16x8*)(AA + tk * 72 + 16 * ks + 8 * h2);
#pragma unroll
        for (int rb = 0; rb < 2; ++rb) {
            const bf16x8 fw = *(const GAS bf16x8*)(Wup + (size_t)(rb * 32 + tk) * 64 + 16 * ks + 8 * h2), fa = *(const GAS bf16x8*)(Aup + (size_t)(rb * 32 + tk) * 64 + 16 * ks + 8 * h2);
            aw[rb] = __builtin_amdgcn_mfma_f32_32x32x16_bf16(fw, bw, aw[rb], 0, 0, 0);
            aa[rb] = __builtin_amdgcn_mfma_f32_32x32x16_bf16(fa, ba, aa[rb], 0, 0, 0);
        }
    }
    const LAS float* k_k = PAR + hh * 64; const LAS float* k_a = PAR + 256 + hh * 64; const LAS float* r_k = PAR + 512 + hh * 64;
    const LAS float* w0 = PAR + 768 + dir * 256 + hh * 64; const LAS float* a0 = PAR + 1280 + dir * 256 + hh * 64;
    float ssq = 0.f;
#pragma unroll
    for (int rb = 0; rb < 2; ++rb)
#pragma unroll
        for (int g4 = 0; g4 < 4; ++g4) { const int c0 = rb * 32 + 8 * g4 + 4 * h2;
            const f32x4 kv = *(const LAS f32x4*)(CF + tk * CF_STR + 256 + hh * 64 + c0), kkw = *(const LAS f32x4*)(k_k + c0);
            const f32x4 q = kv * kkw; ssq += (q[0] * q[0] + q[1] * q[1]) + (q[2] * q[2] + q[3] * q[3]); }
    ssq += xhalf(ssq);
    const float kinv = 1.f / fmaxf(sqrtf(ssq), 1e-12f);
    float bon = 0.f;
    GAS bf16_t* OM = (GAS bf16_t*)(p.ws + WS_OM) + ((size_t)dir * MTOK + tok) * 256 + hh * 64;
    GAS bf16_t* KA = (GAS bf16_t*)(p.ws + WS_KA) + ((size_t)dir * MTOK + tok) * 256 + hh * 64;
    GAS bf16_t* KD = (GAS bf16_t*)(p.ws + WS_KD) + ((size_t)dir * MTOK + tok) * 256 + hh * 64;
    GAS bf16_t* KK = (GAS bf16_t*)(p.ws + WS_KK) + tok * 256 + hh * 64;
    GAS bf16_t* VV = (GAS bf16_t*)(p.ws + WS_V) + tok * 256 + hh * 64;
    GAS bf16_t* RR = (GAS bf16_t*)(p.ws + WS_R) + tok * 256 + hh * 64;
#pragma unroll
    for (int rb = 0; rb < 2; ++rb)
#pragma unroll
        for (int g4 = 0; g4 < 4; ++g4) { const int c0 = rb * 32 + 8 * g4 + 4 * h2;
            const f32x4 kv = *(const LAS f32x4*)(CF + tk * CF_STR + 256 + hh * 64 + c0), rv = *(const LAS f32x4*)(CF + tk * CF_STR + hh * 64 + c0);
            const f32x4 kkw = *(const LAS f32x4*)(k_k + c0), kaw = *(const LAS f32x4*)(k_a + c0), rkw = *(const LAS f32x4*)(r_k + c0), w0v = *(const LAS f32x4*)(w0 + c0), a0v = *(const LAS f32x4*)(a0 + c0);
            float om[4], ka[4], kd[4], kk[4];
#pragma unroll
            for (int j = 0; j < 4; ++j) {
                const float wp = aw[rb][4 * g4 + j] + w0v[j], ap = aa[rb][4 * g4 + j] + a0v[j];
                om[j] = 1.f - __expf(-0.6065306597126334f * sigmoidf_(wp));
                const float a = sigmoidf_(ap);
                kk[j] = kv[j] * kkw[j] * kinv; ka[j] = kk[j] * a; kd[j] = kv[j] * (1.f + (a - 1.f) * kaw[j]);
                bon += rv[j] * kd[j] * rkw[j];
            }
            u32x2 w; w.x = pk2(om[0], om[1]); w.y = pk2(om[2], om[3]); *(GAS u32x2*)(OM + c0) = w;
            w.x = pk2(ka[0], ka[1]); w.y = pk2(ka[2], ka[3]); *(GAS u32x2*)(KA + c0) = w;
            w.x = pk2(kd[0], kd[1]); w.y = pk2(kd[2], kd[3]); *(GAS u32x2*)(KD + c0) = w;
            if (dir == 0) {
                const f32x4 vv = *(const LAS f32x4*)(CF + tk * CF_STR + 512 + hh * 64 + c0);
                w.x = pk2(kk[0], kk[1]); w.y = pk2(kk[2], kk[3]); *(GAS u32x2*)(KK + c0) = w;
                w.x = pk2(vv[0], vv[1]); w.y = pk2(vv[2], vv[3]); *(GAS u32x2*)(VV + c0) = w;
                w.x = pk2(rv[0], rv[1]); w.y = pk2(rv[2], rv[3]); *(GAS u32x2*)(RR + c0) = w;
            }
        }
    bon += xhalf(bon);
    if (h2 == 0) ((GAS float*)(p.ws + WS_BON))[((size_t)dir * MTOK + tok) * 4 + hh] = bon;
    {
        const GAS bf16_t* Gup = (const GAS bf16_t*)wb + WO_GUP + (size_t)(F.wave * 32 + tk) * 128;
        f32x16 ag;
#pragma unroll
        for (int i = 0; i < 16; ++i) ag[i] = 0.f;
#pragma unroll
        for (int ks = 0; ks < 8; ++ks) {
            const bf16x8 bg = *(const LAS bf16x8*)(AG + tk * 136 + 16 * ks + 8 * h2), fg = *(const GAS bf16x8*)(Gup + 16 * ks + 8 * h2);
            ag = __builtin_amdgcn_mfma_f32_32x32x16_bf16(fg, bg, ag, 0, 0, 0);
        }
        GAS bf16_t* GT = (GAS bf16_t*)(p.ws + WS_GATE) + tok * 256 + F.wave * 32;
#pragma unroll
        for (int g4 = 0; g4 < 4; ++g4) { u32x2 w; w.x = pk2(ag[4 * g4], ag[4 * g4 + 1]); w.y = pk2(ag[4 * g4 + 2], ag[4 * g4 + 3]); *(GAS u32x2*)(GT + 8 * g4 + 4 * h2) = w; }
    }
    __syncthreads();
}

#define CBAR() asm volatile("" ::: "memory")
#define LROW(M, i, r) do { const LAS f32x4* _q = (const LAS f32x4*)((M) + (i) * 16); const f32x4 _a = _q[0], _b = _q[1], _c = _q[2], _d = _q[3]; \
        r[0] = _a[0]; r[1] = _a[1]; r[2] = _a[2]; r[3] = _a[3]; r[4] = _b[0]; r[5] = _b[1]; r[6] = _b[2]; r[7] = _b[3]; \
        r[8] = _c[0]; r[9] = _c[1]; r[10] = _c[2]; r[11] = _c[3]; r[12] = _d[0]; r[13] = _d[1]; r[14] = _d[2]; r[15] = _d[3]; } while (0)
template <int DIR> __device__ __forceinline__ void chunkprep_wave(Frame& F, const Params& p, int task) {
    const int dbh = task >> 7, ct = task & 127, b = (dbh >> 2) & 7, hh = dbh & 3, ch = F.lane, r32 = F.lane & 31, h = F.lane >> 5;
    LAS unsigned char* wl = F.lds + F.wave * 16384;
    LAS bf16_t* X = (LAS bf16_t*)wl;
    LAS bf16_t* Yt = (LAS bf16_t*)(wl + 4608);
    LAS float* MTt = (LAS float*)(wl + 9216);
    LAS float* MBt = MTt + 256;
    LAS float* MC = MTt + 512; LAS float* MD = MTt + 768; LAS float* MT = MTt + 1024; LAS float* MA = MTt + 1280;
    constexpr int step = DIR ? -256 : 256;
    typedef const __attribute__((address_space(1))) bf16_t* gbf;
    const size_t ou = ((size_t)b * SEQ + ct * 16 + (DIR ? 15 : 0)) * 256 + hh * 64;
    const gbf OM = (gbf)(p.ws + WS_OM) + (size_t)DIR * MTOK * 256 + ou + ch; const gbf KA = (gbf)(p.ws + WS_KA) + (size_t)DIR * MTOK * 256 + ou + ch;
    const gbf KD = (gbf)(p.ws + WS_KD) + (size_t)DIR * MTOK * 256 + ou + ch; const gbf KK = (gbf)(p.ws + WS_KK) + ou + ch;
    const gbf RR = (gbf)(p.ws + WS_R) + ou + ch; const gbf VV = (gbf)(p.ws + WS_V) + ou + ch;
    float pc = 1.f;
    float qt[16], rt[16], at[16], kt[16], vv[16];
    {
        unsigned short rw[16], rk[16], ra_[16], rd[16], rr_[16], rv[16];
#pragma unroll
        for (int i = 0; i < 16; ++i) { rw[i] = OM[i * step]; rk[i] = KK[i * step]; ra_[i] = KA[i * step]; rd[i] = KD[i * step]; rr_[i] = RR[i * step]; rv[i] = VV[i * step]; }
#pragma unroll
        for (int i = 0; i < 16; ++i) {
            const float w = 1.f - bf2f(rw[i]);
            qt[i] = bf2f(rk[i]) * pc; pc *= w; const float ip = __builtin_amdgcn_rcpf(pc);
            rt[i] = bf2f(rr_[i]) * pc; at[i] = bf2f(ra_[i]) * ip; kt[i] = bf2f(rd[i]) * ip; vv[i] = bf2f(rv[i]);
            X[i * 72 + ch] = (bf16_t)(pk2(qt[i], 0.f) & 0xffffu); X[(16 + i) * 72 + ch] = (bf16_t)(pk2(rt[i], 0.f) & 0xffffu);
            Yt[i * 72 + ch] = (bf16_t)(pk2(at[i], 0.f) & 0xffffu); Yt[(16 + i) * 72 + ch] = (bf16_t)(pk2(kt[i], 0.f) & 0xffffu);
        }
    }
    const float p15 = pc;
    asm volatile("s_waitcnt lgkmcnt(0)" ::: "memory");
    {
        f32x16 g;
#pragma unroll
        for (int i = 0; i < 16; ++i) g[i] = 0.f;
#pragma unroll
        for (int ks = 0; ks < 4; ++ks) {
            const bf16x8 a = *(const LAS bf16x8*)(X + r32 * 72 + 16 * ks + 8 * h), bb = *(const LAS bf16x8*)(Yt + r32 * 72 + 16 * ks + 8 * h);
            g = __builtin_amdgcn_mfma_f32_32x32x16_bf16(a, bb, g, 0, 0, 0);
        }
        const int sidx = r32 & 15;
#pragma unroll
        for (int reg = 0; reg < 8; ++reg) { const int i = (reg & 3) + 8 * (reg >> 2) + 4 * h;
            const float lo = (sidx < i) ? g[reg] : 0.f, hi2 = (sidx <= i) ? g[8 + reg] : 0.f;
            if (r32 < 16) { MA[i * 16 + sidx] = lo; MD[i * 16 + sidx] = hi2; } else { MBt[sidx * 16 + i] = lo; MC[i * 16 + sidx] = hi2; } }
    }
    asm volatile("s_waitcnt lgkmcnt(0)" ::: "memory");
    {
        const int c = F.lane & 15; float Tc[16];
#pragma unroll
        for (int i = 0; i < 16; ++i) { float acc = (i == c) ? 1.f : 0.f; float ra[16]; LROW(MA, i, ra);
#pragma unroll
            for (int s2 = 0; s2 < i; ++s2) acc -= ra[s2] * Tc[s2];
            Tc[i] = acc; MT[i * 16 + c] = acc; MTt[c * 16 + i] = acc; CBAR(); }
    }
    asm volatile("s_waitcnt lgkmcnt(0)" ::: "memory");
    float Qh[16], W2[16];
    {
        float BV[16];
#pragma unroll
        for (int i = 0; i < 16; ++i) { Qh[i] = 0.f; BV[i] = 0.f; }
#pragma unroll
        for (int s2 = 0; s2 < 16; ++s2) {
            float ct_[16], cb_[16]; LROW(MTt, s2, ct_); LROW(MBt, s2, cb_);
#pragma unroll
            for (int i = s2; i < 16; ++i) { Qh[i] += ct_[i] * qt[s2]; if (i > s2) BV[i] += cb_[i] * vv[s2]; }
            CBAR();
        }
#pragma unroll
        for (int i = 0; i < 16; ++i) { float aw = 0.f; float rt_[16]; LROW(MT, i, rt_);
#pragma unroll
            for (int s2 = 0; s2 <= i; ++s2) aw += rt_[s2] * BV[s2];
            W2[i] = aw; CBAR(); }
    }
    LAS bf16_t* ST = (LAS bf16_t*)wl;
    {
        const int ks = ch >> 4, w16 = ch & 15, jq = (w16 >> 3) * 4 + (w16 & 3), hq = (w16 >> 2) & 1;
        LAS bf16_t* qrp = ST + (ks * 64 + hq * 32) * 8 + jq;
        LAS bf16_t* wyp = ST + 2048 + ((ch >> 5) * 64 + r32) * 16;
#pragma unroll
        for (int i = 0; i < 16; ++i) {
            float ar = rt[i], ay = 0.f; float rd_[16], rc_[16]; LROW(MD, i, rd_); LROW(MC, i, rc_);
#pragma unroll
            for (int s2 = 0; s2 <= i; ++s2) { ar -= rd_[s2] * Qh[s2]; ay += rc_[s2] * vv[s2] - rd_[s2] * W2[s2]; }
            qrp[i * 8] = (bf16_t)(pk2(Qh[i], 0.f) & 0xffffu); qrp[(16 + i) * 8] = (bf16_t)(pk2(ar, 0.f) & 0xffffu);
            wyp[512 * ((i >> 2) & 1) + (i & 3) + 4 * (i >> 3)] = (bf16_t)(pk2(W2[i], 0.f) & 0xffffu);
            wyp[512 * ((i >> 2) & 1) + (i & 3) + 4 * ((16 + i) >> 3)] = (bf16_t)(pk2(ay, 0.f) & 0xffffu);
            CBAR(); }
    }
    asm volatile("s_waitcnt lgkmcnt(0)" ::: "memory");
    {
        GAS u32x4* gq = (GAS u32x4*)((GAS bf16_t*)(p.ws + WS_FQR) + (size_t)task * 2048); GAS u32x4* gw = (GAS u32x4*)((GAS bf16_t*)(p.ws + WS_FWY) + (size_t)task * 2048);
        u32x4 tq[4], tw[4];
#pragma unroll
        for (int q = 0; q < 4; ++q) { tq[q] = *(const LAS u32x4*)(wl + (F.lane + 64 * q) * 16); tw[q] = *(const LAS u32x4*)(wl + 4096 + (F.lane + 64 * q) * 16); }
#pragma unroll
        for (int q = 0; q < 4; ++q) { gq[F.lane + 64 * q] = tq[q]; gw[F.lane + 64 * q] = tw[q]; }
    }
    asm volatile("s_waitcnt lgkmcnt(0)" ::: "memory");
    {
        LAS bf16_t* nap = ST + ((ch >> 5) * 64 + r32) * 8; LAS bf16_t* khp = nap + 1024;
#pragma unroll
        for (int s2 = 0; s2 < 16; ++s2) {
            const int off = 256 * ((s2 >> 2) & 1) + (s2 >> 3) * 4 + (s2 & 3);
            nap[off] = (bf16_t)(pk2(-at[s2] * p15, 0.f) & 0xffffu); khp[off] = (bf16_t)(pk2(kt[s2] * p15, 0.f) & 0xffffu); }
        asm volatile("s_waitcnt lgkmcnt(0)" ::: "memory");
        GAS u32x4* gn = (GAS u32x4*)((GAS bf16_t*)(p.ws + WS_FNA) + (size_t)task * 1024); GAS u32x4* gk = (GAS u32x4*)((GAS bf16_t*)(p.ws + WS_FKH) + (size_t)task * 1024);
        u32x4 tn[2], tk2[2];
#pragma unroll
        for (int q = 0; q < 2; ++q) { tn[q] = *(const LAS u32x4*)(wl + (F.lane + 64 * q) * 16); tk2[q] = *(const LAS u32x4*)(wl + 2048 + (F.lane + 64 * q) * 16); }
#pragma unroll
        for (int q = 0; q < 2; ++q) { gn[F.lane + 64 * q] = tn[q]; gk[F.lane + 64 * q] = tk2[q]; }
        ((GAS float*)(p.ws + WS_FP15))[(size_t)task * 64 + ch] = p15;
    }
    asm volatile("s_waitcnt lgkmcnt(0)" ::: "memory");
}
constexpr int PB_SLOT = 15360, PB_NSLOT = 4, PB_QR = 0, PB_WY = 4096, PB_NA = 8192, PB_KH = 10240, PB_P15 = 12288, PB_V = 13312;
__device__ __forceinline__ unsigned lds_ld_u32(unsigned addr) { unsigned v; asm volatile("ds_read_b32 %0, %1\n\ts_waitcnt lgkmcnt(0)" : "=v"(v) : "v"(addr) : "memory"); return v; }
__device__ __forceinline__ void lds_st_u32(unsigned addr, unsigned v) { asm volatile("ds_write_b32 %0, %1" :: "v"(addr), "v"(v) : "memory"); }
__device__ __forceinline__ void pb_dma(const Params& p, int dbh, int ct, int lane, LAS unsigned char* slot) {
    const size_t task = (size_t)dbh * 128 + ct; const int b = (dbh >> 2) & 7, hh = dbh & 3;
    const unsigned char* q = (const unsigned char*)((const bf16_t*)(p.ws + WS_FQR) + task * 2048) + lane * 16; const unsigned char* w = (const unsigned char*)((const bf16_t*)(p.ws + WS_FWY) + task * 2048) + lane * 16;
    const unsigned char* na = (const unsigned char*)((const bf16_t*)(p.ws + WS_FNA) + task * 1024) + lane * 16; const unsigned char* kh = (const unsigned char*)((const bf16_t*)(p.ws + WS_FKH) + task * 1024) + lane * 16;
#pragma unroll
    for (int i = 0; i < 4; ++i) {
        __builtin_amdgcn_global_load_lds((const unsigned*)(q + 1024 * i), (LAS unsigned*)(slot + PB_QR + 1024 * i), 16, 0, 0);
        __builtin_amdgcn_global_load_lds((const unsigned*)(w + 1024 * i), (LAS unsigned*)(slot + PB_WY + 1024 * i), 16, 0, 0); }
    __builtin_amdgcn_global_load_lds((const unsigned*)na, (LAS unsigned*)(slot + PB_NA), 16, 0, 0); __builtin_amdgcn_global_load_lds((const unsigned*)(na + 1024), (LAS unsigned*)(slot + PB_NA + 1024), 16, 0, 0);
    __builtin_amdgcn_global_load_lds((const unsigned*)kh, (LAS unsigned*)(slot + PB_KH), 16, 0, 0); __builtin_amdgcn_global_load_lds((const unsigned*)(kh + 1024), (LAS unsigned*)(slot + PB_KH + 1024), 16, 0, 0);
    __builtin_amdgcn_global_load_lds((const unsigned*)((const unsigned char*)((const float*)(p.ws + WS_FP15) + task * 64) + lane * 16), (LAS unsigned*)(slot + PB_P15), 16, 0, 0);
    const unsigned char* V = (const unsigned char*)((const bf16_t*)(p.ws + WS_V) + ((size_t)b * SEQ + ct * 16) * 256 + hh * 64) + (size_t)(lane >> 3) * 512 + (lane & 7) * 16;
    __builtin_amdgcn_global_load_lds((const unsigned*)V, (LAS unsigned*)(slot + PB_V), 16, 0, 0); __builtin_amdgcn_global_load_lds((const unsigned*)(V + 8 * 512), (LAS unsigned*)(slot + PB_V + 1024), 16, 0, 0);
}
__device__ __forceinline__ void phaseb_unit(Frame& F, const Params& p, int u) {
    const unsigned flag_base = (unsigned)(size_t)(F.lds + 131072 + 128);
    if (F.tid < 8) lds_st_u32(flag_base + 4 * F.tid, 0u);
    __syncthreads();
    const int pair = F.wave & 3;
    if (pair >= 2) return;
    const int dbh = u * 2 + pair, dir = dbh >> 5;
    LAS unsigned char* ring = F.lds + pair * (PB_NSLOT * PB_SLOT);
    const unsigned f_pub = flag_base + 8 * pair, f_con = f_pub + 4;
    if (F.wave >= 4) {
        for (int c = 0; c < 128; ++c) {
            while ((int)lds_ld_u32(f_con) < c - (PB_NSLOT - 1)) __builtin_amdgcn_s_sleep(1);
            pb_dma(p, dbh, dir ? 127 - c : c, F.lane, ring + (c & (PB_NSLOT - 1)) * PB_SLOT);
            if (c >= 3) { asm volatile("s_waitcnt vmcnt(45)" ::: "memory"); if (F.lane == 0) lds_st_u32(f_pub, (unsigned)(c - 2)); }
        }
        asm volatile("s_waitcnt vmcnt(30)" ::: "memory"); if (F.lane == 0) lds_st_u32(f_pub, 126u);
        asm volatile("s_waitcnt vmcnt(15)" ::: "memory"); if (F.lane == 0) lds_st_u32(f_pub, 127u);
        asm volatile("s_waitcnt vmcnt(0)" ::: "memory"); if (F.lane == 0) lds_st_u32(f_pub, 128u);
        return;
    }
    const int b = (dbh >> 2) & 7, hh = dbh & 3, r = F.lane & 31, h = F.lane >> 5;
    GAS bf16_t* Y = (GAS bf16_t*)(p.ws + WS_Y) + ((size_t)dir * MTOK + (size_t)b * SEQ) * 256 + hh * 64 + r;
    f32x16 accS[2][2];
#pragma unroll
    for (int rb = 0; rb < 2; ++rb)
#pragma unroll
        for (int cb = 0; cb < 2; ++cb)
#pragma unroll
            for (int i = 0; i < 16; ++i) accS[rb][cb][i] = 0.f;
    for (int cc = 0; cc < 128; ++cc) {
        const int ct = dir ? 127 - cc : cc;
        const LAS unsigned char* slot = ring + (cc & (PB_NSLOT - 1)) * PB_SLOT;
        bf16x8 sb[4][2];
#pragma unroll
        for (int rb = 0; rb < 2; ++rb)
#pragma unroll
            for (int s2 = 0; s2 < 2; ++s2)
#pragma unroll
                for (int cb = 0; cb < 2; ++cb) { const f32x16& a = accS[rb][cb]; u32x4 w;
                    w.x = pk2(a[8 * s2 + 0], a[8 * s2 + 1]); w.y = pk2(a[8 * s2 + 2], a[8 * s2 + 3]); w.z = pk2(a[8 * s2 + 4], a[8 * s2 + 5]); w.w = pk2(a[8 * s2 + 6], a[8 * s2 + 7]);
                    sb[2 * rb + s2][cb] = __builtin_bit_cast(bf16x8, w); }
        while ((int)lds_ld_u32(f_pub) < cc + 1) __builtin_amdgcn_s_sleep(1);
        asm volatile("" ::: "memory");
        f32x16 D[2];
#pragma unroll
        for (int cb = 0; cb < 2; ++cb) { const LAS u32x4* wp = (const LAS u32x4*)(slot + PB_WY + (cb * 64 + F.lane) * 32); const u32x4 w0 = wp[0], w1 = wp[1];
            D[cb][0] = bflo(w0.x); D[cb][1] = bfhi(w0.x); D[cb][2] = bflo(w0.y); D[cb][3] = bfhi(w0.y); D[cb][4] = bflo(w0.z); D[cb][5] = bfhi(w0.z); D[cb][6] = bflo(w0.w); D[cb][7] = bfhi(w0.w);
            D[cb][8] = bflo(w1.x); D[cb][9] = bfhi(w1.x); D[cb][10] = bflo(w1.y); D[cb][11] = bfhi(w1.y); D[cb][12] = bflo(w1.z); D[cb][13] = bfhi(w1.z); D[cb][14] = bflo(w1.w); D[cb][15] = bfhi(w1.w); }
#pragma unroll
        for (int ks = 0; ks < 4; ++ks) { const bf16x8 qa = *(const LAS bf16x8*)(slot + PB_QR + (ks * 64 + F.lane) * 16);
            D[0] = __builtin_amdgcn_mfma_f32_32x32x16_bf16(qa, sb[ks][0], D[0], 0, 0, 0);
            D[1] = __builtin_amdgcn_mfma_f32_32x32x16_bf16(qa, sb[ks][1], D[1], 0, 0, 0); }
#pragma unroll
        for (int rb = 0; rb < 2; ++rb)
#pragma unroll
            for (int g4 = 0; g4 < 4; ++g4) { const f32x4 pv = *(const LAS f32x4*)(slot + PB_P15 + (32 * rb + 8 * g4 + 4 * h) * 4);
#pragma unroll
                for (int cb = 0; cb < 2; ++cb)
#pragma unroll
                    for (int q = 0; q < 4; ++q) accS[rb][cb][4 * g4 + q] *= pv[q]; }
        bf16x8 ub[2], vb[2];
#pragma unroll
        for (int cb = 0; cb < 2; ++cb) {
            unsigned short vt[8];
#pragma unroll
            for (int j = 0; j < 8; ++j) { const int s2 = 8 * (j >> 2) + 4 * h + (j & 3); const int tau = dir ? 15 - s2 : s2;
                vt[j] = *(const LAS unsigned short*)(slot + PB_V + tau * 128 + (32 * cb + r) * 2);
                Y[(size_t)(ct * 16 + tau) * 256 + 32 * cb] = (bf16_t)(pk2(D[cb][8 + j], 0.f) & 0xffffu); }
            vb[cb] = (bf16x8){(short)vt[0], (short)vt[1], (short)vt[2], (short)vt[3], (short)vt[4], (short)vt[5], (short)vt[6], (short)vt[7]};
            u32x4 w; w.x = pk2(D[cb][0], D[cb][1]); w.y = pk2(D[cb][2], D[cb][3]); w.z = pk2(D[cb][4], D[cb][5]); w.w = pk2(D[cb][6], D[cb][7]);
            ub[cb] = __builtin_bit_cast(bf16x8, w);
        }
        bf16x8 na[2], kh[2];
#pragma unroll
        for (int rb = 0; rb < 2; ++rb) { na[rb] = *(const LAS bf16x8*)(slot + PB_NA + (rb * 64 + F.lane) * 16); kh[rb] = *(const LAS bf16x8*)(slot + PB_KH + (rb * 64 + F.lane) * 16); }
        asm volatile("s_waitcnt lgkmcnt(0)" ::: "memory");
        if (F.lane == 0) lds_st_u32(f_con, (unsigned)(cc + 1));
#pragma unroll
        for (int rb = 0; rb < 2; ++rb)
#pragma unroll
            for (int cb = 0; cb < 2; ++cb) {
                accS[rb][cb] = __builtin_amdgcn_mfma_f32_32x32x16_bf16(na[rb], ub[cb], accS[rb][cb], 0, 0, 0);
                accS[rb][cb] = __builtin_amdgcn_mfma_f32_32x32x16_bf16(kh[rb], vb[cb], accS[rb][cb], 0, 0, 0);
            }
    }
}

__device__ __forceinline__ void post_unit(Frame& F, const Params& p, int l, int u) {
    REFRAME(F);
    const bf16_t* Y0 = (const bf16_t*)(p.ws + WS_Y); const bf16_t* Y1 = Y0 + (size_t)MTOK * 256;
    const bf16_t* VV = (const bf16_t*)(p.ws + WS_V); const bf16_t* GT = (const bf16_t*)(p.ws + WS_GATE);
    const float* BON = (const float*)(p.ws + WS_BON); bf16_t* MIX = (bf16_t*)(p.ws + WS_MIX);
    const f32x4 lg = *(const f32x4*)(p.in[19] + l * 256 + 4 * F.lane), lb = *(const f32x4*)(p.in[20] + l * 256 + 4 * F.lane);
    for (int tok = u * 64 + F.wave * 8, te = tok + 8; tok < te; ++tok) {
        const u32x2 a = *(const GAS u32x2*)((const GAS bf16_t*)Y0 + (size_t)tok * 256 + 4 * F.lane), c = *(const GAS u32x2*)((const GAS bf16_t*)Y1 + (size_t)tok * 256 + 4 * F.lane);
        const u32x2 vv = *(const GAS u32x2*)((const GAS bf16_t*)VV + (size_t)tok * 256 + 4 * F.lane), gg = *(const GAS u32x2*)((const GAS bf16_t*)GT + (size_t)tok * 256 + 4 * F.lane);
        float y[4] = {bflo(a.x) + bflo(c.x), bfhi(a.x) + bfhi(c.x), bflo(a.y) + bflo(c.y), bfhi(a.y) + bfhi(c.y)};
        float s = (y[0] + y[1]) + (y[2] + y[3]);
#pragma unroll
        for (int o = 1; o < 16; o <<= 1) s += __shfl_xor(s, o);
        const float mu = s * (1.f / 64.f);
        float q = 0.f;
#pragma unroll
        for (int i = 0; i < 4; ++i) { y[i] -= mu; q += y[i] * y[i]; }
#pragma unroll
        for (int o = 1; o < 16; o <<= 1) q += __shfl_xor(q, o);
        const float rstd = rsqrtf(q * (1.f / 64.f) + 64e-5f);
        const int hh = F.lane >> 4;
        const float bon = ((const GAS float*)BON)[(size_t)tok * 4 + hh] + ((const GAS float*)BON)[((size_t)MTOK + tok) * 4 + hh];
        const float v4[4] = {bflo(vv.x), bfhi(vv.x), bflo(vv.y), bfhi(vv.y)}, g4[4] = {bflo(gg.x), bfhi(gg.x), bflo(gg.y), bfhi(gg.y)};
        float o4[4];
#pragma unroll
        for (int i = 0; i < 4; ++i) o4[i] = (y[i] * rstd * lg[i] + lb[i] + bon * v4[i]) * g4[i];
        u32x2 w; w.x = pk2(o4[0], o4[1]); w.y = pk2(o4[2], o4[3]);
        *(GAS u32x2*)((GAS bf16_t*)MIX + (size_t)tok * DM + 768 + 4 * F.lane) = w;
    }
}

__device__ __forceinline__ void prologue(Frame& F, const Params& p) {
    REFRAME(F);
    LAS float* scr = (LAS float*)(F.lds + F.wave * 16384);
    const int gw = F.bid * 8 + F.wave, NGW = F.G * 8;
    bf16_t* wb = (bf16_t*)(p.ws + WS_W);
    for (int it = gw; it < CV_TOTAL; it += NGW) { if (it < CV_A) cvt_item_a(p, 0, wb, scr, it, F.lane); else cvt_item_b(p, 0, wb, scr, it - CV_A, F.lane); }
    const float* x = p.in[0]; float* X = p.out; bf16_t* XB = (bf16_t*)(p.ws + WS_XB); float* rowss = (float*)(p.ws + WS_RP);
    for (int m = gw; m < MTOK; m += 2 * NGW) {
        const int m2 = m + NGW; const bool has2 = m2 < MTOK; const int mb = has2 ? m2 : m;
        const GAS f32x4* xra = (const GAS f32x4*)(x + (size_t)m * DM) + F.lane; const GAS f32x4* xrb = (const GAS f32x4*)(x + (size_t)mb * DM) + F.lane;
        f32x4 va[4], vb[4];
#pragma unroll
        for (int jj = 0; jj < 4; ++jj) { va[jj] = xra[64 * jj]; vb[jj] = xrb[64 * jj]; }
        float sa = 0.f, sb = 0.f;
#pragma unroll
        for (int jj = 0; jj < 4; ++jj) { sa += (va[jj][0] * va[jj][0] + va[jj][1] * va[jj][1]) + (va[jj][2] * va[jj][2] + va[jj][3] * va[jj][3]); sb += (vb[jj][0] * vb[jj][0] + vb[jj][1] * vb[jj][1]) + (vb[jj][2] * vb[jj][2] + vb[jj][3] * vb[jj][3]); }
        sa = wave_sum(sa); sb = wave_sum(sb);
        { GAS f32x4* xo = (GAS f32x4*)(X + (size_t)m * DM) + F.lane; GAS u32x2* bo = (GAS u32x2*)(XB + (size_t)m * DM) + F.lane;
#pragma unroll
          for (int jj = 0; jj < 4; ++jj) { xo[64 * jj] = va[jj]; u32x2 w; w.x = pk2(va[jj][0], va[jj][1]); w.y = pk2(va[jj][2], va[jj][3]); bo[64 * jj] = w; }
          if (F.lane < 16) ((GAS float*)rowss)[(size_t)m * 16 + F.lane] = (F.lane == 0) ? sa : 0.f; }
        if (has2) { GAS f32x4* xo = (GAS f32x4*)(X + (size_t)m2 * DM) + F.lane; GAS u32x2* bo = (GAS u32x2*)(XB + (size_t)m2 * DM) + F.lane;
#pragma unroll
          for (int jj = 0; jj < 4; ++jj) { xo[64 * jj] = vb[jj]; u32x2 w; w.x = pk2(vb[jj][0], vb[jj][1]); w.y = pk2(vb[jj][2], vb[jj][3]); bo[64 * jj] = w; }
          if (F.lane < 16) ((GAS float*)rowss)[(size_t)m2 * 16 + F.lane] = (F.lane == 0) ? sb : 0.f; }
    }
    const float* mem = p.in[1]; const float* gm = p.in[23]; bf16_t* MN = (bf16_t*)(p.ws + WS_MEMN);
    for (int m = gw; m < MMEM; m += NGW) {
        const f32x4* xr = (const f32x4*)(mem + (size_t)m * DM) + F.lane; u32x2* bo = (u32x2*)(MN + (size_t)m * DM) + F.lane;
        f32x4 v[4]; float s = 0.f;
#pragma unroll
        for (int jj = 0; jj < 4; ++jj) { v[jj] = xr[64 * jj]; s += (v[jj][0] * v[jj][0] + v[jj][1] * v[jj][1]) + (v[jj][2] * v[jj][2] + v[jj][3] * v[jj][3]); }
        const float rstd = rsqrtf(wave_sum(s) * (1.f / 1024.f) + 1e-6f);
#pragma unroll
        for (int jj = 0; jj < 4; ++jj) { const f32x4 g = *((const f32x4*)gm + F.lane + 64 * jj); const f32x4 t = v[jj] * rstd * g;
            u32x2 w; w.x = pk2(t[0], t[1]); w.y = pk2(t[2], t[3]); bo[64 * jj] = w; }
    }
}
__device__ __forceinline__ void final_norm(Frame& F, const Params& p) {
    REFRAME(F);
    const int gw = F.bid * 8 + F.wave, NGW = F.G * 8;
    const float* rowss = (const float*)(p.ws + WS_RP) + (size_t)12 * MTOK * 16; const GAS float* gf = (const GAS float*)p.in[30];
    f32x4 g[4];
#pragma unroll
    for (int jj = 0; jj < 4; ++jj) g[jj] = *((const GAS f32x4*)gf + F.lane + 64 * jj);
    for (int m = gw; m < MTOK; m += 2 * NGW) {
        const int m2 = m + NGW; const bool has2 = m2 < MTOK;
        GAS f32x4* xa = (GAS f32x4*)(p.out + (size_t)m * DM) + F.lane; GAS f32x4* xb = (GAS f32x4*)(p.out + (size_t)(has2 ? m2 : m) * DM) + F.lane;
        f32x4 va[4], vb[4];
#pragma unroll
        for (int jj = 0; jj < 4; ++jj) { va[jj] = xa[64 * jj]; vb[jj] = xb[64 * jj]; }
        const float ra = row_rstd(rowss, m), rb = row_rstd(rowss, has2 ? m2 : m);
#pragma unroll
        for (int jj = 0; jj < 4; ++jj) xa[64 * jj] = va[jj] * ra * g[jj];
        if (has2) {
#pragma unroll
            for (int jj = 0; jj < 4; ++jj) xb[64 * jj] = vb[jj] * rb * g[jj]; }
    }
}

#define XB_TMO      128
#define XB_XCNT(j)  (256  + 64 * (j))
#define XB_XSUB(j)  (1280 + 64 * (j))
#define XB_XGEN(j)  (2304 + 64 * (j))
#define XB_TOP      3328
#define XB_TOPGEN   3392
#define XB_SPIN_CAP (1u << 22)
constexpr int CW_BAR = 4096;
__device__ __forceinline__ unsigned xb_ld(unsigned* p)              { return __hip_atomic_load(p, __ATOMIC_RELAXED, __HIP_MEMORY_SCOPE_AGENT); }
__device__ __forceinline__ unsigned xb_add(unsigned* p, unsigned v) { return __hip_atomic_fetch_add(p, v, __ATOMIC_RELAXED, __HIP_MEMORY_SCOPE_AGENT); }
__device__ __forceinline__ unsigned xb_xcc_id() { return (unsigned)__builtin_amdgcn_s_getreg((3 << 11) | 20) & 0xFu; }
#define XB_SPIN(cond, bar) do { unsigned _sp = 0; while (cond) { __builtin_amdgcn_s_sleep(1); \
    if ((++_sp & 255u) == 0u) { if (xb_ld(&(bar)[XB_TMO])) break; if (_sp > XB_SPIN_CAP) { atomicAdd(&(bar)[XB_TMO], 1u); break; } } } } while (0)
__device__ __forceinline__ void xcd_barrier_complete(unsigned* bar, unsigned x, unsigned& nloc, unsigned& nx) {
    const unsigned G = gridDim.x;
    unsigned sum, cnt, mine, sp = 0u;
    for (;;) {
        sum = 0u; cnt = 0u; mine = 0u;
#pragma unroll
        for (unsigned j = 0; j < 16; ++j) { const unsigned c = xb_ld(&bar[XB_XCNT(j)]); sum += c; cnt += (c > 0u) ? 1u : 0u; mine = (j == x) ? c : mine; }
        if (sum == G) break;
        __builtin_amdgcn_s_sleep(1);
        if ((++sp & 255u) == 0u) { if (xb_ld(&bar[XB_TMO])) break; if (sp > XB_SPIN_CAP) { atomicAdd(&bar[XB_TMO], 1u); break; } }
    }
    nloc = mine > 0u ? mine : 1u; nx = cnt > 0u ? cnt : 1u;
}
__device__ __forceinline__ void gsync(volatile LAS unsigned* st) {
    unsigned* bar = (unsigned*)(make_params().ws + WS_CTL) + CW_BAR;
    asm volatile("s_waitcnt vmcnt(0)" ::: "memory");
    __syncthreads();
    if (threadIdx.x == 0) {
        const unsigned x = xb_xcc_id();
        __builtin_amdgcn_s_waitcnt(0);
        unsigned nloc = st[0], nx = st[1];
        if (nloc == 0u) { xcd_barrier_complete(bar, x, nloc, nx); st[0] = nloc; st[1] = nx; }
        const unsigned old = xb_add(&bar[XB_XSUB(x)], 1u);
        const unsigned gen = old / nloc;
        if (old + 1u == (gen + 1u) * nloc) {
            __builtin_amdgcn_fence(__ATOMIC_RELEASE, "agent");
            asm volatile("s_waitcnt vmcnt(0)" ::: "memory");
            const unsigned og = xb_add(&bar[XB_TOP], 1u);
            const unsigned tg = og / nx;
            if (og + 1u == (tg + 1u) * nx) xb_add(&bar[XB_TOPGEN], 1u);
            else XB_SPIN(xb_ld(&bar[XB_TOPGEN]) == tg, bar);
            __builtin_amdgcn_fence(__ATOMIC_ACQUIRE, "agent");
            xb_add(&bar[XB_XGEN(x)], 1u);
            asm volatile("s_waitcnt vmcnt(0)" ::: "memory");
        } else {
            XB_SPIN(xb_ld(&bar[XB_XGEN(x)]) == gen, bar);
            __builtin_amdgcn_fence(__ATOMIC_ACQUIRE, "agent");
            asm volatile("s_waitcnt vmcnt(0)" ::: "memory");
        }
    }
    __syncthreads();
}
__device__ __forceinline__ int rstd_table(LAS unsigned char* lds, const pg8::StaticOrder& S, const float* rowss, int tid) {
    pg8::Unit u0; int pm0 = -1;
    if (S.next(0, u0)) { pm0 = u0.pm; if (tid < 256) ((LAS float*)(lds + 131072 + 2048))[tid] = row_rstd(rowss, pm0 * 256 + tid); }
    __syncthreads();
    return pm0;
}
#ifdef TPROBE
#define STAMP(id) do { if (blockIdx.x == 0 && threadIdx.x == 0) { LAS unsigned long long* ts_ = (LAS unsigned long long*)(F.lds + 131072 + 64); const unsigned long long now_ = __builtin_amdgcn_s_memrealtime(); \
    const unsigned long long dt_ = now_ - ts_[0]; ts_[0] = now_; if ((TA_MASK >> (id)) & 1) ts_[1] += dt_; if ((TB_MASK >> (id)) & 1) ts_[2] += dt_; } } while (0)
#else
#define STAMP(id) do { } while (0)
#endif
#ifndef PH_MASK
#define PH_MASK 0xFFFF
#endif
#ifndef REP_MASK
#define REP_MASK 0
#endif
#define NREP(k) ((((REP_MASK) >> (k)) & 1) ? 2 : 1)
constexpr int NCP = 1024, NDIFF_A = 0, NPB = 32;
__global__ void __launch_bounds__(512, 2) fwd_megakernel(KArgs kargs_unused) {
    extern __shared__ __attribute__((aligned(16))) unsigned char lds_raw[];
    cg::grid_group grid = cg::this_grid();
    Frame F; F.lds = (LAS unsigned char*)lds_raw; F.tid = threadIdx.x; F.lane = F.tid & 63; F.wave = __builtin_amdgcn_readfirstlane(F.tid >> 6); F.G = gridDim.x; F.bid = blockIdx.x;
    LAS int* qslot = (LAS int*)(F.lds + 131072);
    volatile LAS unsigned* bst = (volatile LAS unsigned*)(F.lds + 131072 + 32);
    { unsigned* bar0 = (unsigned*)(make_params().ws + WS_CTL) + CW_BAR;
      if (threadIdx.x == 0) { bst[0] = 0u; bst[1] = 0u; (void)xb_add(bar0 + XB_XCNT(xb_xcc_id()), 1u); } }
    __syncthreads();
#define PHASE_VARS() const Params p = make_params(); unsigned* ctl = (unsigned*)(p.ws + WS_CTL); float* rowss = (float*)(p.ws + WS_RP); \
    bf16_t* XB = (bf16_t*)(p.ws + WS_XB); bf16_t* Z = (bf16_t*)(p.ws + WS_Z); bf16_t* MIX = (bf16_t*)(p.ws + WS_MIX); \
    bf16_t* wb = (bf16_t*)(p.ws + WS_W); int bid_ = F.bid, G_ = F.G; asm volatile("" : "+s"(bid_), "+s"(G_)); (void)bid_; (void)G_; (void)ctl; (void)rowss; (void)XB; (void)Z; (void)MIX; (void)wb

#ifdef TPROBE
    if (blockIdx.x == 0 && threadIdx.x == 0) { LAS unsigned long long* ts_ = (LAS unsigned long long*)(F.lds + 131072 + 64); ts_[0] = __builtin_amdgcn_s_memrealtime(); ts_[1] = 0; ts_[2] = 0; }
#endif
    if (PH_MASK & 1) { const Params p = make_params(); prologue(F, p); }
    grid.sync();
    STAMP(0);

    for (int l = 0; l < NL; ++l) {
        for (int rep = 0; rep < NREP(1); ++rep) {
        if (PH_MASK & 2) {
            PHASE_VARS();
            pg8::StaticOrder S; S.init(MTOK, INW, G_, bid_);
            const int pm0 = rstd_table(F.lds, S, rowss + (size_t)(3 * l) * MTOK * 16, F.tid);
            pg8::gemm_phase(F.lds, pg8::Gemm{XB, wb + WO_IN, MTOK, INW, DM}, S, pg8::EpiScaleBf16{Z, ZP, rowss + (size_t)(3 * l) * MTOK * 16, (bf16_t*)(p.ws + WS_ZC), 1024, 8, (bf16_t*)(p.ws + WS_KD2), (const LAS float*)(F.lds + 131072 + 2048), pm0});
        }
        gsync(bst); STAMP(1);
        }
        for (int rep = 0; rep < NREP(2); ++rep) {
        for (int u = F.bid; u < 768; u += F.G) {
            PHASE_VARS();
            if (u < 512) { if (PH_MASK & 4) prep_unit(F, p, l, wb, u); } else if (PH_MASK & 8) win_unit(F, p, l, u - 512);
        }
        gsync(bst); STAMP(2);
        }
        for (int rep = 0; rep < NREP(3); ++rep) {
        {
            PHASE_VARS();
            const int ntot = NCP + NDIFF_A;
            for (;;) {
                __syncthreads();
                if (F.tid == 0) *qslot = (int)atomicAdd(ctl + CW_Q + 16 * l + 4 * rep, 1u);
                __syncthreads();
                const int u = *qslot;
                if (u >= ntot) break;
                if (u < NCP) { if (PH_MASK & 16) { REFRAME(F); if (u >= NCP / 2) chunkprep_wave<1>(F, p, u * 8 + F.wave); else chunkprep_wave<0>(F, p, u * 8 + F.wave); } }
                else if (PH_MASK & 32) diff_unit(F, p, l, u - NCP);
            }
        }
        gsync(bst); STAMP(11);
        }
        for (int rep = 0; rep < NREP(4); ++rep) {
        {
            PHASE_VARS();
            const int ncva = (l + 1 < NL) ? CV_A / 8 : 0, ncvb = (l > 0) ? CV_B / 8 : 0, ncv = NPB + ncva + ncvb, ntot = ncv + 256;
            unsigned* pbdone = ctl + 3072 + (l * 2 + rep) * 16;
            unsigned* gq = ctl + CW_Q + 16 * l + 8 + 4 * rep; unsigned* dq = ctl + 2048 + (l * 2 + rep) * 16;
            const int myx = (int)(xb_xcc_id() & 7u);
            int stage = 0, pend = -1, xi = 0;
            for (;;) {
                __syncthreads();
                if (F.tid == 0) {
                    int code = -1;
                    if (stage == 0) { const int g = (int)atomicAdd(gq, 1u); if (g < NPB) code = g; else { pend = g; stage = 1; } }
                    if (stage == 1) {
                        while (xi < 8) { const int x = (myx + xi) & 7; const int tk = (int)atomicAdd(dq + x, 1u); if (tk < 64) { code = -2 - ((4 * x + (tk >> 4)) * 16 + (tk & 15)); break; } ++xi; }
                        if (xi >= 8) stage = 2;
                    }
                    if (stage == 2 && code == -1) { int g = pend; pend = -1; if (g < 0) g = (int)atomicAdd(gq, 1u); if (g < ntot) code = g; }
                    *qslot = code;
                }
                __syncthreads();
                const int u = *qslot;
                if (u == -1) break;
                if (u <= -2) { if (PH_MASK & 32) diff_unit(F, p, l, -2 - u); }
                else if (u < NPB) { if (PH_MASK & 16) { REFRAME(F); phaseb_unit(F, p, u); }
                    __threadfence(); __syncthreads();
                    if (F.tid == 0) __hip_atomic_fetch_add(pbdone, 1u, __ATOMIC_RELEASE, __HIP_MEMORY_SCOPE_AGENT); }
                else if (u >= ncv) {
                    if (F.tid == 0) { while (__hip_atomic_load(pbdone, __ATOMIC_RELAXED, __HIP_MEMORY_SCOPE_AGENT) < (unsigned)NPB) __builtin_amdgcn_s_sleep(8); }
                    __syncthreads(); __builtin_amdgcn_fence(__ATOMIC_ACQUIRE, "agent");
                    if (PH_MASK & 64) post_unit(F, p, l, u - ncv); }
                else if (u < NPB + ncva) { REFRAME(F); cvt_item_a(p, l + 1, wb, (LAS float*)(F.lds + F.wave * 16384), (u - NPB) * 8 + F.wave, F.lane); }
                else { REFRAME(F); cvt_item_b(p, l, wb, (LAS float*)(F.lds + F.wave * 16384), (u - NPB - ncva) * 8 + F.wave, F.lane); }
            }
        }
        gsync(bst); STAMP(3);
        }
        if (PH_MASK & 128) {
            PHASE_VARS();
            pg8::StaticOrder S; S.init(MTOK, DM, G_, bid_);
            pg8::gemm_phase(F.lds, pg8::Gemm{MIX, wb + WO_OUT, MTOK, DM, DM}, S, pg8::EpiResid{p.out, XB, rowss + (size_t)(3 * l + 1) * MTOK * 16});
        }
        gsync(bst); STAMP(5);
        for (int rep = 0; rep < NREP(6); ++rep) {
        if (PH_MASK & 256) {
            PHASE_VARS();
            pg8::StaticOrder S; S.init(MTOK, XW, G_, bid_);
            if (F.bid < 128) {
                pg8::gemm_phase(F.lds, pg8::Gemm{XB, wb + WO_Q, MTOK, XW, DM}, S, pg8::EpiScaleBf16{(bf16_t*)(p.ws + WS_Q), XW, rowss + (size_t)(3 * l + 1) * MTOK * 16, nullptr, 0, 1 << 30, nullptr, nullptr, -1});
            } else {
                pg8::StaticOrder S2; S2.init(MMEM, 1024, 128, F.bid - 128);
                pg8::gemm_phase(F.lds, pg8::Gemm{(const bf16_t*)(p.ws + WS_MEMN), wb + WO_KV, MMEM, 1024, DM}, S2, pg8::EpiScaleBf16{(bf16_t*)(p.ws + WS_KV), 1024, nullptr, nullptr, 0, 1 << 30, nullptr, nullptr, -1});
            }
        }
        gsync(bst); STAMP(6);
        }
        for (int rep = 0; rep < NREP(7); ++rep) {
        if (PH_MASK & 512) for (int u = F.bid; u < 256; u += F.G) { PHASE_VARS(); cross_unit(F, p, u); }
        gsync(bst); STAMP(7);
        }
        if (PH_MASK & 1024) {
            PHASE_VARS();
            pg8::StaticOrder S; S.init(MTOK, DM, G_, bid_);
            pg8::gemm_phase(F.lds, pg8::Gemm{(const bf16_t*)(p.ws + WS_O), wb + WO_O, MTOK, DM, XW}, S, pg8::EpiResid{p.out, XB, rowss + (size_t)(3 * l + 2) * MTOK * 16});
        }
        gsync(bst); STAMP(8);
        for (int rep = 0; rep < NREP(9); ++rep) {
        if (PH_MASK & 2048) {
            PHASE_VARS();
            pg8::StaticOrder S; S.init(MTOK, 2 * DFF, G_, bid_);
            const int pm0 = rstd_table(F.lds, S, rowss + (size_t)(3 * l + 2) * MTOK * 16, F.tid);
            pg8::gemm_phase(F.lds, pg8::Gemm{XB, wb + WO_GU, MTOK, 2 * DFF, DM}, S, pg8::EpiSwiGLU{(bf16_t*)(p.ws + WS_G), rowss + (size_t)(3 * l + 2) * MTOK * 16, (const LAS float*)(F.lds + 131072 + 2048), pm0});
        }
        gsync(bst); STAMP(9);
        }
        if (PH_MASK & 4096) {
            PHASE_VARS();
            pg8::StaticOrder S; S.init(MTOK, DM, G_, bid_);
            pg8::gemm_phase(F.lds, pg8::Gemm{(const bf16_t*)(p.ws + WS_G), wb + WO_DOWN, MTOK, DM, DFF}, S, pg8::EpiResid{p.out, XB, rowss + (size_t)(3 * l + 3) * MTOK * 16});
        }

#ifdef TPROBE
        STAMP(10);
        { const Params p = make_params(); if (l == NL - 1 && blockIdx.x == 0 && threadIdx.x == 0) { LAS unsigned long long* ts_ = (LAS unsigned long long*)(F.lds + 131072 + 64); unsigned* c_ = (unsigned*)(p.ws + WS_CTL); c_[32] = (unsigned)ts_[1]; c_[33] = (unsigned)ts_[2]; } }
#endif
        gsync(bst);
    }
    if (PH_MASK & 8192) { const Params p = make_params(); final_norm(F, p); }
}

extern "C" void kernel_launch(void* const* d_in, const int* in_sizes, int n_in, void* d_out, int out_size, void* d_ws, size_t ws_size, hipStream_t stream) {
    static int grid = 0;
    if (grid == 0) {
        if (n_in != 31 || out_size != MTOK * DM || ws_size < WS_END) { fprintf(stderr, "kernel_launch: unexpected problem shape (n_in %d out %d ws %zu)\n", n_in, out_size, ws_size); grid = -1; return; }
        int dev = 0, cus = 0, per_cu = 0;
        hipGetDevice(&dev);
        hipDeviceGetAttribute(&cus, hipDeviceAttributeMultiprocessorCount, dev);
        hipFuncSetAttribute((const void*)fwd_megakernel, hipFuncAttributeMaxDynamicSharedMemorySize, LDS_BYTES);
        hipOccupancyMaxActiveBlocksPerMultiprocessor(&per_cu, (const void*)fwd_megakernel, 512, LDS_BYTES);
        if (per_cu < 1) { fprintf(stderr, "kernel_launch: occupancy query returned %d\n", per_cu); per_cu = 1; }
        (void)hipGetLastError();
        grid = cus * per_cu;
    }
    if (grid < 0) return;
    hipMemsetAsync((char*)d_ws + WS_CTL, 0, CTL_ZERO_BYTES, stream);
    KArgs p{};
    for (int i = 0; i < 31; ++i) p.in[i] = (const float*)d_in[i];
    p.out = (float*)d_out; p.ws = (unsigned char*)d_ws;
    void* args[] = {&p};
    hipError_t e = hipLaunchCooperativeKernel((const void*)fwd_megakernel, dim3(grid), dim3(512), args, LDS_BYTES, stream);
    if (e != hipSuccess) fprintf(stderr, "cooperative launch failed: %s (grid %d)\n", hipGetErrorString(e), grid);
}
```

```cpp
#include <hip/hip_runtime.h>
#include <hip/hip_cooperative_groups.h>
#include <cstdio>
#include <cstdint>
namespace cg = cooperative_groups;

#define LAS __attribute__((address_space(3)))
#define GAS __attribute__((address_space(1)))
typedef unsigned short bf16_t;
typedef short bf16x8 __attribute__((ext_vector_type(8)));
typedef short s16x4 __attribute__((ext_vector_type(4)));
typedef short v4i16_t __attribute__((ext_vector_type(4)));
typedef float f32x4 __attribute__((ext_vector_type(4)));
typedef float f32x2 __attribute__((ext_vector_type(2)));
typedef float f32x16 __attribute__((ext_vector_type(16)));
typedef unsigned u32x4 __attribute__((ext_vector_type(4)));
typedef unsigned u32x2 __attribute__((ext_vector_type(2)));
typedef __bf16 bf16x2_t __attribute__((ext_vector_type(2)));

constexpr int DM = 1024, NB = 8, SEQ = 2048, NL = 4, MTOK = NB * SEQ;
constexpr int NMEM = 256, MMEM = NB * NMEM;
constexpr int INW = 3072, DFF = 2816, XW = 512;
constexpr float LOG2E = 1.4426950408889634f;

constexpr size_t MiB = 1u << 20;
constexpr size_t WS_CTL = 0, CTL_ZERO_BYTES = 1 * MiB;
constexpr size_t WS_W = 1 * MiB;
constexpr size_t WS_Z = 30 * MiB;
constexpr size_t WS_ZC = 94 * MiB;
constexpr size_t WS_XB = 126 * MiB;
constexpr size_t WS_FQR = 94 * MiB, WS_FWY = 126 * MiB, WS_FNA = 158 * MiB, WS_FKH = 174 * MiB, WS_FP15 = 190 * MiB;
constexpr size_t WS_MIX = 192 * MiB;
constexpr size_t WS_OM = 224 * MiB, WS_KA = 240 * MiB, WS_KD = 256 * MiB, WS_KK = 272 * MiB, WS_V = 280 * MiB, WS_R = 288 * MiB;
constexpr size_t WS_GATE = 296 * MiB, WS_Y = 304 * MiB, WS_BON = 320 * MiB, WS_KV = 321 * MiB, WS_MEMN = 325 * MiB;
constexpr size_t WS_RP = 329 * MiB;
constexpr size_t WS_END = 342 * MiB;
constexpr size_t WS_Q = WS_Z, WS_O = WS_Z + 16 * MiB, WS_G = WS_Z;
constexpr int ZP = 1024;
constexpr size_t WS_KD2 = WS_Z + 32 * MiB, WS_VD2 = WS_Z + 48 * MiB;
constexpr size_t WO_IN = 0, WO_OUT = 3145728, WO_Q = 4194304, WO_KV = 4718592, WO_O = 5767168, WO_GU = 6291456, WO_DOWN = 12058624;
constexpr size_t WO_WUP = 14942208, WO_AUP = 14974976, WO_GUP = 15007744;
constexpr int CW_Q = 64;

constexpr int LDS_BYTES = 135168;

__device__ __forceinline__ float bf2f(unsigned b) { return __uint_as_float(b << 16); }
__device__ __forceinline__ unsigned pk2(float lo, float hi) { f32x2 v = {lo, hi}; bf16x2_t b = __builtin_convertvector(v, bf16x2_t); return __builtin_bit_cast(unsigned, b); }
__device__ __forceinline__ float bflo(unsigned u) { return __uint_as_float(u << 16); }
__device__ __forceinline__ float bfhi(unsigned u) { return __uint_as_float(u & 0xffff0000u); }
__device__ __forceinline__ float wave_sum(float v) {
#pragma unroll
    for (int o = 1; o < 64; o <<= 1) v += __shfl_xor(v, o);
    return v;
}
__device__ __forceinline__ float xhalf(float v) {
    return __shfl_xor(v, 32);
}
__device__ __forceinline__ float row_rstd(const float* rp, int row) {
    const f32x4* q = (const f32x4*)(rp + (size_t)row * 16); const f32x4 a = q[0], b = q[1], c = q[2], d = q[3];
    const float s = (((a[0] + a[1]) + (a[2] + a[3])) + ((b[0] + b[1]) + (b[2] + b[3]))) + (((c[0] + c[1]) + (c[2] + c[3])) + ((d[0] + d[1]) + (d[2] + d[3])));
    return rsqrtf(s * (1.f / 1024.f) + 1e-6f);
}
__device__ __forceinline__ float sigmoidf_(float x) { return __builtin_amdgcn_rcpf(1.f + __expf(-x)); }

__device__ __forceinline__ int hw_lane() { int l = (int)__builtin_amdgcn_mbcnt_hi(~0u, __builtin_amdgcn_mbcnt_lo(~0u, 0u)); asm volatile("" : "+v"(l)); return l; }
namespace pg8 {
constexpr int BM = 256, BK = 64, HALF = 128, HTB = HALF * BK * 2, NXCD = 8, WGM = 8;
__host__ __device__ __forceinline__ int lds_byte(int r, int c) { const int st = (r >> 4) * 2 + (c >> 5), rr = r & 15, cc = c & 31, ob = rr * 64 + cc * 2; return st * 1024 + (ob ^ (((ob >> 9) & 1) << 5)); }
__host__ __device__ __forceinline__ void stage_rc(int b, int& R, int& C) { const int st = b / 1024, sb = b % 1024, swz = sb ^ (((sb >> 9) & 1) << 5); R = (st >> 1) * 16 + swz / 64; C = (st & 1) * 32 + (swz % 64) / 2; }
__host__ __device__ __forceinline__ int perm32(int rho) { const int n = rho >> 4, i = rho & 15; return 8 * (i >> 2) + 4 * n + (i & 3); }
struct Unit { int pm, pn; };
struct Gemm { const bf16_t* A; const bf16_t* Bt; int M, N, K; };
struct StaticOrder {
    int nM, nN, nwg, G, c;
    __device__ void init(int M, int N, int G_, int c_) { nM = M / BM; nN = N / BM; nwg = nM * nN; G = G_; c = c_; }
    __device__ bool next(int i, Unit& u) const {
        const long L = (long)i * G + c; if (L >= nwg) return false;
        int wgid = (int)L; { const int q = nwg / NXCD, r = nwg % NXCD, xcd = wgid % NXCD, off = wgid / NXCD; wgid = (xcd < r ? xcd * (q + 1) : r * (q + 1) + (xcd - r) * q) + off; }
        const int nig = WGM * nN, gid = wgid / nig, fm = gid * WGM, gsz = (nM - fm) < WGM ? (nM - fm) : WGM;
        u.pm = fm + ((wgid % nig) % gsz); u.pn = (wgid % nig) / gsz; return true;
    }
};
template <class Epi>
__device__ __forceinline__ void gemm_phase(LAS unsigned char* lds, const Gemm g, const StaticOrder& S, const Epi& E) {
    int tid_ = threadIdx.x; asm volatile("" : "+v"(tid_));
    const int tid = tid_, wid = __builtin_amdgcn_readfirstlane(tid >> 6), lane = tid & 63, wr = wid >> 2, wc = wid & 3, fr = lane & 15, fq = lane >> 4;
    const int K = g.K, nt = K / BK;
    unsigned voffA[2], voffB[2];
#pragma unroll
    for (int i = 0; i < 2; ++i) { int R, C; stage_rc(tid * 16 + i * 8192, R, C); const int Rb = (R & ~31) + perm32(R & 31);
        voffA[i] = (unsigned)(R * K + C) * 2u; voffB[i] = (unsigned)(Rb * K + C) * 2u; }
    const size_t kstep = (size_t)(BK * 2);
    const size_t hstep = (size_t)HALF * K * 2;
    const size_t tstep = 2 * hstep;
    const unsigned ldsw = (unsigned)wid * 1024u;
    const int aoff = lds_byte(wr * 64 + fr, fq * 8), boff = lds_byte(wc * 32 + fr, fq * 8);
#define PG8_SA(b, h) (((b) * 2 + (h)) * HTB)
#define PG8_SB(b, h) ((4 + (b) * 2 + (h)) * HTB)
#define PG8_STAGE(bufoff, gbase, voff) do { _Pragma("unroll") for (int _i = 0; _i < 2; ++_i) \
        __builtin_amdgcn_global_load_lds((const unsigned*)((const char*)(gbase) + (voff)[_i]), (LAS unsigned*)(lds + (bufoff) + ldsw + _i * 8192), 16, 0, 0); } while (0)
#define PG8_LDA(dst, b, h) do { _Pragma("unroll") for (int m = 0; m < 4; ++m) _Pragma("unroll") for (int k = 0; k < 2; ++k) dst[m][k] = *(const LAS bf16x8*)(lds + PG8_SA(b, h) + aoff + m * 2048 + k * 1024); } while (0)
#define PG8_LDB(dst, b, h) do { _Pragma("unroll") for (int n = 0; n < 2; ++n) _Pragma("unroll") for (int k = 0; k < 2; ++k) dst[n][k] = *(const LAS bf16x8*)(lds + PG8_SB(b, h) + boff + n * 2048 + k * 1024); } while (0)
#define PG8_MMA(ai, bj, At, Bt) do { __builtin_amdgcn_s_setprio(1); _Pragma("unroll") for (int m = 0; m < 4; ++m) _Pragma("unroll") for (int n = 0; n < 2; ++n) _Pragma("unroll") for (int k = 0; k < 2; ++k) \
        acc[ai][bj][m][n] = __builtin_amdgcn_mfma_f32_16x16x32_bf16(Bt[n][k], At[m][k], acc[ai][bj][m][n], 0, 0, 0); __builtin_amdgcn_s_setprio(0); } while (0)
#define PG8_WAIT_V(n) asm volatile("s_waitcnt vmcnt(" #n ")" ::: "memory")
#define PG8_WAIT_L(n) asm volatile("s_waitcnt lgkmcnt(" #n ")" ::: "memory")
#define PG8_BAR __builtin_amdgcn_s_barrier()
#define PG8_SCHED __builtin_amdgcn_sched_barrier(0)
    Unit cur, nxt; int ui = 0;
    if (!S.next(0, cur)) return;
    f32x4 acc[2][2][4][2];
#pragma unroll
    for (int a = 0; a < 2; ++a)
#pragma unroll
        for (int b = 0; b < 2; ++b)
#pragma unroll
            for (int m = 0; m < 4; ++m)
#pragma unroll
                for (int n = 0; n < 2; ++n) acc[a][b][m][n] = (f32x4){0.f, 0.f, 0.f, 0.f};
    bf16x8 At[4][2], B0[2][2], B1[2][2];
    const char* cA = (const char*)g.A + (size_t)cur.pm * tstep; const char* cB = (const char*)g.Bt + (size_t)cur.pn * tstep;
    {
        PG8_STAGE(PG8_SB(0, 0), cB, voffB); PG8_STAGE(PG8_SB(0, 1), cB + hstep, voffB); PG8_STAGE(PG8_SA(0, 0), cA, voffA); PG8_STAGE(PG8_SA(0, 1), cA + hstep, voffA);
        if (wr == 1) PG8_BAR;
        PG8_WAIT_V(2); PG8_BAR;
        PG8_STAGE(PG8_SB(1, 0), cB + kstep, voffB); PG8_STAGE(PG8_SA(1, 0), cA + kstep, voffA); PG8_STAGE(PG8_SB(1, 1), cB + hstep + kstep, voffB);
        PG8_WAIT_V(6); PG8_BAR;
    }
    for (;;) {
        const bool has_next = S.next(ui + 1, nxt);
        const char* nA = has_next ? (const char*)g.A + (size_t)nxt.pm * tstep : cA; const char* nB = has_next ? (const char*)g.Bt + (size_t)nxt.pn * tstep : cB;
        for (int t = 0; t < nt; t += 2) {
            const bool last = (t == nt - 2);
            const char* a1 = cA + (size_t)(t + 1) * kstep;
            const char* a2 = last ? nA : cA + (size_t)(t + 2) * kstep; const char* b2 = last ? nB : cB + (size_t)(t + 2) * kstep;
            const char* a3 = a2 + kstep; const char* b3 = b2 + kstep;
            PG8_LDB(B0, 0, 0); PG8_LDB(B1, 0, 1); PG8_SCHED; PG8_LDA(At, 0, 0); PG8_STAGE(PG8_SA(1, 1), a1 + hstep, voffA);
            PG8_WAIT_V(8); PG8_WAIT_L(0); PG8_BAR; PG8_MMA(0, 0, At, B0); PG8_MMA(0, 1, At, B1); PG8_BAR; PG8_SCHED;
            PG8_LDA(At, 0, 1); PG8_STAGE(PG8_SB(0, 0), b2, voffB); PG8_STAGE(PG8_SB(0, 1), b2 + hstep, voffB); PG8_STAGE(PG8_SA(0, 0), a2, voffA);
            PG8_WAIT_V(8); PG8_WAIT_L(0); PG8_BAR; PG8_MMA(1, 0, At, B0); PG8_MMA(1, 1, At, B1); PG8_BAR; PG8_SCHED;
            PG8_LDB(B0, 1, 0); PG8_LDB(B1, 1, 1); PG8_SCHED; PG8_LDA(At, 1, 0); PG8_STAGE(PG8_SA(0, 1), a2 + hstep, voffA);
            PG8_WAIT_V(8); PG8_WAIT_L(0); PG8_BAR; PG8_MMA(0, 0, At, B0); PG8_MMA(0, 1, At, B1); PG8_BAR; PG8_SCHED;
            PG8_LDA(At, 1, 1); PG8_STAGE(PG8_SB(1, 0), b3, voffB); PG8_STAGE(PG8_SB(1, 1), b3 + hstep, voffB); PG8_STAGE(PG8_SA(1, 0), a3, voffA);
            PG8_WAIT_V(8); PG8_WAIT_L(0); PG8_BAR; PG8_MMA(1, 0, At, B0); PG8_MMA(1, 1, At, B1); PG8_BAR; PG8_SCHED;
        }
        if (wr == 0) PG8_BAR;
        E(acc, cur, wr, wc, fr, fq);
        if (!has_next) break;
#pragma unroll
        for (int a = 0; a < 2; ++a)
#pragma unroll
            for (int b = 0; b < 2; ++b)
#pragma unroll
                for (int m = 0; m < 4; ++m)
#pragma unroll
                    for (int n = 0; n < 2; ++n) acc[a][b][m][n] = (f32x4){0.f, 0.f, 0.f, 0.f};
        cur = nxt; cA = nA; cB = nB; ++ui;
        if (wr == 1) PG8_BAR;
    }
    PG8_WAIT_V(0);
    PG8_BAR;
#undef PG8_SA
#undef PG8_SB
#undef PG8_STAGE
#undef PG8_LDA
#undef PG8_LDB
#undef PG8_MMA
#undef PG8_WAIT_V
#undef PG8_WAIT_L
#undef PG8_BAR
#undef PG8_SCHED
}

struct EpiScaleBf16 {
    bf16_t* O; int ldc; const float* rowss; bf16_t* O2; int ldc2; int split_tile; bf16_t* KD2;
    const LAS float* tab; int pm0;
    __device__ __forceinline__ void operator()(const f32x4 (&acc)[2][2][4][2], const Unit& u, int wr, int wc, int fr, int fq) const {
        const bool hi = u.pn >= split_tile, mid = (split_tile == 8) && u.pn >= 4 && u.pn < 8;
        const int row0 = u.pm * BM + wr * 64 + fr, col0 = (hi ? u.pn - split_tile : u.pn) * BM + wc * 32 + 8 * fq;
        bf16_t* const Ob = hi ? O2 : O; const int ld = hi ? ldc2 : ldc;
#pragma unroll
        for (int ai = 0; ai < 2; ++ai)
#pragma unroll
            for (int m = 0; m < 4; ++m) { const int row = row0 + ai * HALF + m * 16;
                const float sc = !rowss ? 1.f : ((tab && u.pm == pm0) ? tab[row & 255] : row_rstd(rowss, row));
                bf16_t* rowp = Ob + (size_t)row * ld + col0;
#pragma unroll
                for (int bj = 0; bj < 2; ++bj) { const f32x4 v0 = acc[ai][bj][m][0] * sc, v1 = acc[ai][bj][m][1] * sc;
                    u32x4 w; w.x = pk2(v0[0], v0[1]); w.y = pk2(v0[2], v0[3]); w.z = pk2(v1[0], v1[1]); w.w = pk2(v1[2], v1[3]);
                    bf16_t* dst = rowp + bj * HALF;
                    if (mid) dst = KD2 + (u.pn >= 6 ? (size_t)8388608 : (size_t)0) + ((size_t)(((row >> 11) * 4 + 2 * (u.pn & 1) + bj) * 2048 + (row & 2047))) * 128 + wc * 32 + 8 * fq;
                    *(u32x4*)dst = w; } }
    }
};
struct EpiSwiGLU {
    bf16_t* O; const float* rowss; const LAS float* tab; int pm0;
    __device__ __forceinline__ void operator()(const f32x4 (&acc)[2][2][4][2], const Unit& u, int wr, int wc, int fr, int fq) const {
        const int row0 = u.pm * BM + wr * 64 + fr, col0 = u.pn * HALF + wc * 32 + 8 * fq;
#pragma unroll
        for (int ai = 0; ai < 2; ++ai)
#pragma unroll
            for (int m = 0; m < 4; ++m) { const int row = row0 + ai * HALF + m * 16;
                const float sc = (tab && u.pm == pm0) ? tab[row & 255] : row_rstd(rowss, row);
                float h[8];
#pragma unroll
                for (int n = 0; n < 2; ++n)
#pragma unroll
                    for (int j = 0; j < 4; ++j) { const float gt = acc[ai][0][m][n][j] * sc, up = acc[ai][1][m][n][j] * sc; h[n * 4 + j] = gt * __builtin_amdgcn_rcpf(1.f + __expf(-gt)) * up; }
                u32x4 w; w.x = pk2(h[0], h[1]); w.y = pk2(h[2], h[3]); w.z = pk2(h[4], h[5]); w.w = pk2(h[6], h[7]);
                *(u32x4*)(O + (size_t)row * DFF + col0) = w; }
    }
};
struct EpiResid {
    float* X; bf16_t* XB; float* rowss_next;
    __device__ __forceinline__ void operator()(const f32x4 (&acc)[2][2][4][2], const Unit& u, int wr, int wc, int fr, int fq) const {
        const int row0 = u.pm * BM + wr * 64 + fr, col0 = u.pn * BM + wc * 32 + 8 * fq;
#pragma unroll
        for (int ai = 0; ai < 2; ++ai)
#pragma unroll
            for (int m = 0; m < 4; ++m) { const int row = row0 + ai * HALF + m * 16; float ss = 0.f;
                float* xp = X + (size_t)row * DM + col0; bf16_t* bp = XB + (size_t)row * DM + col0;
#pragma unroll
                for (int bj = 0; bj < 2; ++bj) {
                    f32x4 x0 = *(f32x4*)(xp + bj * HALF), x1 = *(f32x4*)(xp + bj * HALF + 4);
                    x0 = x0 + acc[ai][bj][m][0]; x1 = x1 + acc[ai][bj][m][1];
                    *(f32x4*)(xp + bj * HALF) = x0; *(f32x4*)(xp + bj * HALF + 4) = x1;
                    ss += (x0[0] * x0[0] + x0[1] * x0[1]) + (x0[2] * x0[2] + x0[3] * x0[3]) + (x1[0] * x1[0] + x1[1] * x1[1]) + (x1[2] * x1[2] + x1[3] * x1[3]);
                    u32x4 w; w.x = pk2(x0[0], x0[1]); w.y = pk2(x0[2], x0[3]); w.z = pk2(x1[0], x1[1]); w.w = pk2(x1[2], x1[3]);
                    *(u32x4*)(bp + bj * HALF) = w; }
                ss += __shfl_xor(ss, 16); ss += __shfl_xor(ss, 32);
                if (fq == 0) rowss_next[(size_t)row * 16 + u.pn * 4 + wc] = ss; }
    }
};
}

struct KArgs { const float* in[31]; float* out; unsigned char* ws; };
#define CAS __attribute__((address_space(4)))
struct InProxy { const CAS unsigned long long* k; __device__ __forceinline__ const float* operator[](int i) const { return (const float*)k[i]; } };
struct Params { InProxy in; float* out; unsigned char* ws; };
__device__ __forceinline__ Params make_params() {
    unsigned long long kv = (unsigned long long)__builtin_amdgcn_kernarg_segment_ptr();
    asm volatile("" : "+s"(kv));
    const CAS unsigned long long* k = (const CAS unsigned long long*)kv;
    Params p; p.in.k = k; p.out = (float*)k[31]; p.ws = (unsigned char*)k[32]; return p;
}

struct Frame {
    LAS unsigned char* lds;
    int tid, lane, wave, G, bid;
};

#define REFRAME(F) do { int _t = threadIdx.x; asm volatile("" : "+v"(_t)); (F).tid = _t; (F).lane = _t & 63; (F).wave = __builtin_amdgcn_readfirstlane(_t >> 6); } while (0)
__device__ __forceinline__ void cvt_item(const float* W_, int K, int ldn, int nblk, bf16_t* WT_, const float* gain_, bool perm_gu, LAS float* scr, int item, int lane) {
    const GAS float* W = (const GAS float*)W_; const GAS float* gain = (const GAS float*)gain_; GAS bf16_t* WT = (GAS bf16_t*)WT_;
    const int kb = item / nblk, nb = item % nblk, k0 = 64 * kb, n0d = 32 * nb;
    const int n0s = perm_gu ? (((n0d & 255) >> 7) * DFF + (n0d >> 8) * 128 + (n0d & 127)) : n0d;
    float v[32];
#pragma unroll
    for (int i = 0; i < 32; ++i) v[i] = W[(size_t)(k0 + 2 * i + (lane >> 5)) * ldn + n0s + (lane & 31)];
    if (gain_) {
#pragma unroll
        for (int i = 0; i < 32; ++i) v[i] *= gain[k0 + 2 * i + (lane >> 5)];
    }
#pragma unroll
    for (int i = 0; i < 32; ++i) scr[(2 * i + (lane >> 5)) * 33 + (lane & 31)] = v[i];
    asm volatile("s_waitcnt lgkmcnt(0)" ::: "memory");
    const int c = lane & 7;
#pragma unroll
    for (int j = 0; j < 4; ++j) { const int n = (lane >> 3) + 8 * j; const LAS float* sp = scr + (8 * c) * 33 + n;
        u32x4 o; o.x = pk2(sp[0 * 33], sp[1 * 33]); o.y = pk2(sp[2 * 33], sp[3 * 33]); o.z = pk2(sp[4 * 33], sp[5 * 33]); o.w = pk2(sp[6 * 33], sp[7 * 33]);
        *(GAS u32x4*)(WT + (size_t)(n0d + n) * K + k0 + 8 * c) = o; }
    asm volatile("s_waitcnt lgkmcnt(0)" ::: "memory");
}
constexpr int CV_IN = 1536, CV_OUT = 512, CV_Q = 256, CV_KV = 512, CV_O = 256, CV_GU = 2816, CV_DOWN = 1408, CV_L = 8;
constexpr int CV_TOTAL = CV_IN + CV_OUT + CV_Q + CV_KV + CV_O + CV_GU + CV_DOWN + 2 * CV_L + 2 * CV_L + 16;

static_assert(CV_TOTAL % 8 == 0, "conversion items per layer");
constexpr int CV_A = CV_IN + 2 * CV_L + 2 * CV_L + 16, CV_B = CV_KV + CV_OUT + CV_Q + CV_O + CV_GU + CV_DOWN;
static_assert(CV_A % 8 == 0 && CV_B % 8 == 0 && CV_A + CV_B == CV_TOTAL, "conversion lists");
__device__ __forceinline__ void cvt_item_a(const Params& p, int l, bf16_t* wb, LAS float* scr, int it, int lane) {
    int r = it;
    if (r < CV_IN) { cvt_item(p.in[3] + (size_t)l * DM * INW, DM, INW, INW / 32, wb + WO_IN, p.in[2] + l * DM, false, scr, r, lane); return; } r -= CV_IN;
    if (r < 2 * CV_L) { const int d = r / CV_L; cvt_item(p.in[12] + ((size_t)l * 2 + d) * 64 * 256, 64, 256, 8, wb + WO_WUP + d * 256 * 64, nullptr, false, scr, r % CV_L, lane); return; } r -= 2 * CV_L;
    if (r < 2 * CV_L) { const int d = r / CV_L; cvt_item(p.in[14] + ((size_t)l * 2 + d) * 64 * 256, 64, 256, 8, wb + WO_AUP + d * 256 * 64, nullptr, false, scr, r % CV_L, lane); return; } r -= 2 * CV_L;
    cvt_item(p.in[15] + (size_t)l * 128 * 256, 128, 256, 8, wb + WO_GUP, nullptr, false, scr, r, lane);
}
__device__ __forceinline__ void cvt_item_b(const Params& p, int l, bf16_t* wb, LAS float* scr, int it, int lane) {
    int r = it;
    if (r < CV_KV) { cvt_item(p.in[25] + (size_t)l * DM * 1024, DM, 1024, 32, wb + WO_KV, nullptr, false, scr, r, lane); return; } r -= CV_KV;
    if (r < CV_OUT) { cvt_item(p.in[21] + (size_t)l * DM * DM, DM, DM, DM / 32, wb + WO_OUT, nullptr, false, scr, r, lane); return; } r -= CV_OUT;
    if (r < CV_Q) { cvt_item(p.in[24] + (size_t)l * DM * XW, DM, XW, XW / 32, wb + WO_Q, p.in[22] + l * DM, false, scr, r, lane); return; } r -= CV_Q;
    if (r < CV_O) { cvt_item(p.in[26] + (size_t)l * XW * DM, XW, DM, 32, wb + WO_O, nullptr, false, scr, r, lane); return; } r -= CV_O;
    if (r < CV_GU) { cvt_item(p.in[28] + (size_t)l * DM * 2 * DFF, DM, 2 * DFF, 2 * DFF / 32, wb + WO_GU, p.in[27] + l * DM, true, scr, r, lane); return; } r -= CV_GU;
    cvt_item(p.in[29] + (size_t)l * DFF * DM, DFF, DM, 32, wb + WO_DOWN, nullptr, false, scr, r, lane);
}

__device__ __forceinline__ s16x4 vtr(const LAS unsigned char* p) { return __builtin_bit_cast(s16x4, __builtin_amdgcn_ds_read_tr16_b64_v4i16((LAS v4i16_t*)p)); }
__device__ __forceinline__ int crow(int r, int hi) { return (r & 3) + 8 * (r >> 2) + 4 * hi; }

template <int W> __device__ __forceinline__ void tile_load(u32x4 (&r)[W / 64], const bf16_t* g, int pitch, int tid) {
#pragma unroll
    for (int i = 0; i < W / 64; ++i) { const int id = tid + i * 512, row = id / (W / 8), ch = id % (W / 8); r[i] = *(const GAS u32x4*)((const GAS bf16_t*)g + (size_t)row * pitch + ch * 8); }
}
template <int W, int STR> __device__ __forceinline__ void tile_store(const u32x4 (&r)[W / 64], LAS unsigned char* buf, int tid) {
#pragma unroll
    for (int i = 0; i < W / 64; ++i) { const int id = tid + i * 512, row = id / (W / 8), ch = id % (W / 8); *(LAS u32x4*)(buf + row * STR + ch * 16) = r[i]; }
}
template <int DQK> __device__ __forceinline__ void load_q(bf16x8 (&qf)[DQK / 16], const bf16_t* qrow, int h, float sc) {
#pragma unroll
    for (int ks = 0; ks < DQK / 16; ++ks) { const u32x4 v = *(const GAS u32x4*)((const GAS bf16_t*)qrow + 16 * ks + 8 * h);
        u32x4 o; o.x = pk2(bflo(v.x) * sc, bfhi(v.x) * sc); o.y = pk2(bflo(v.y) * sc, bfhi(v.y) * sc); o.z = pk2(bflo(v.z) * sc, bfhi(v.z) * sc); o.w = pk2(bflo(v.w) * sc, bfhi(v.w) * sc);
        qf[ks] = __builtin_bit_cast(bf16x8, o); }
}
template <int DQK, int KW, int DV, int MODE>
__device__ __forceinline__ void attn_loop(LAS unsigned char* lds, const bf16_t* Kg, int kpitch, const bf16_t* Vg, int vpitch, int ntiles,
                                          const bf16x8 (&qf)[DQK / 16], int koff, float nslope2, int qrel, float& m, float& lsum, f32x16 (&o)[DV / 32]) {
    constexpr int KSTR = (KW + 8) * 2, VSTR = DV * 2 + 64, KBUF = 64 * KSTR, VBUF = 64 * VSTR;
    int tid_ = threadIdx.x; asm volatile("" : "+v"(tid_));
    const int tid = tid_, lane = tid & 63, r = lane & 31, h = lane >> 5;
    LAS unsigned char* K0 = lds; LAS unsigned char* V0 = lds + 2 * KBUF;
    u32x4 kr[KW / 64], vr[DV / 64];
    tile_load<KW>(kr, Kg, kpitch, tid); tile_load<DV>(vr, Vg, vpitch, tid);
    tile_store<KW, KSTR>(kr, K0, tid); tile_store<DV, VSTR>(vr, V0, tid);
    __syncthreads();
    const int vlane = ((lane & 15) >> 2) * VSTR + (16 * ((lane >> 4) & 1) + 4 * (lane & 3)) * 2 + 4 * h * VSTR;
    for (int t = 0; t < ntiles; ++t) {
        const int cur = t & 1;
        if (t + 1 < ntiles) { tile_load<KW>(kr, Kg + (size_t)(t + 1) * 64 * kpitch, kpitch, tid); tile_load<DV>(vr, Vg + (size_t)(t + 1) * 64 * vpitch, vpitch, tid); }
        const LAS unsigned char* Kb = K0 + cur * KBUF + r * KSTR + (koff + 8 * h) * 2;
        const LAS unsigned char* Vb = V0 + cur * VBUF + vlane;
        f32x16 s0, s1;
#pragma unroll
        for (int i = 0; i < 16; ++i) { s0[i] = 0.f; s1[i] = 0.f; }
#pragma unroll
        for (int ks = 0; ks < DQK / 16; ++ks) {
            const bf16x8 k0 = *(const LAS bf16x8*)(Kb + ks * 32), k1 = *(const LAS bf16x8*)(Kb + 32 * KSTR + ks * 32);
            s0 = __builtin_amdgcn_mfma_f32_32x32x16_bf16(k0, qf[ks], s0, 0, 0, 0);
            s1 = __builtin_amdgcn_mfma_f32_32x32x16_bf16(k1, qf[ks], s1, 0, 0, 0);
        }
        float Aoff = 0.f;
        if (MODE >= 1) {
            const int qrel0 = __builtin_amdgcn_readfirstlane(qrel - r);
            const int T0 = t * 64;
            if (MODE == 1 && (T0 + 64 <= qrel0 || T0 > qrel0 + 31)) {
                const bool left = (T0 + 64 <= qrel0);
                const float sl = left ? -nslope2 : nslope2;
                Aoff = left ? nslope2 * (float)(qrel - T0 - 4 * h) : nslope2 * (float)(T0 + 4 * h - qrel);
#pragma unroll
                for (int i = 0; i < 16; ++i) { s0[i] = __builtin_fmaf(sl, (float)((i & 3) + 8 * (i >> 2)), s0[i]); s1[i] = __builtin_fmaf(sl, (float)(32 + (i & 3) + 8 * (i >> 2)), s1[i]); }
            } else {
                const float base = (float)(T0 + 4 * h - qrel);
#pragma unroll
                for (int i = 0; i < 16; ++i) {
                    const float d0 = fabsf(base + (float)((i & 3) + 8 * (i >> 2))), d1 = fabsf(base + (float)(32 + (i & 3) + 8 * (i >> 2)));
                    s0[i] = __builtin_fmaf(d0, nslope2, s0[i]); s1[i] = __builtin_fmaf(d1, nslope2, s1[i]);
                    if (MODE == 2) { if (d0 > 128.f) s0[i] = -1e30f; if (d1 > 128.f) s1[i] = -1e30f; }
                }
            }
        }
        float mx = fmaxf(s0[0], s1[0]);
#pragma unroll
        for (int i = 1; i < 16; ++i) mx = fmaxf(fmaxf(mx, s0[i]), s1[i]);
        mx += Aoff;
        mx = fmaxf(mx, xhalf(mx));
        const float mnew = fmaxf(m, mx);
        if (__builtin_amdgcn_ballot_w64(mnew > m) != 0ull) {
            const float alpha = __builtin_amdgcn_exp2f(m - mnew);
            lsum *= alpha;
#pragma unroll
            for (int d = 0; d < DV / 32; ++d) o[d] = o[d] * alpha;
        }
        m = mnew;
        const float mm = mnew - Aoff;
        float rs = 0.f;
#pragma unroll
        for (int i = 0; i < 16; ++i) { s0[i] = __builtin_amdgcn_exp2f(s0[i] - mm); s1[i] = __builtin_amdgcn_exp2f(s1[i] - mm); rs += s0[i] + s1[i]; }
        lsum += rs;
        bf16x8 pf[4];
#pragma unroll
        for (int s2 = 0; s2 < 2; ++s2) {
            u32x4 a, b;
            a.x = pk2(s0[8 * s2 + 0], s0[8 * s2 + 1]); a.y = pk2(s0[8 * s2 + 2], s0[8 * s2 + 3]); a.z = pk2(s0[8 * s2 + 4], s0[8 * s2 + 5]); a.w = pk2(s0[8 * s2 + 6], s0[8 * s2 + 7]);
            b.x = pk2(s1[8 * s2 + 0], s1[8 * s2 + 1]); b.y = pk2(s1[8 * s2 + 2], s1[8 * s2 + 3]); b.z = pk2(s1[8 * s2 + 4], s1[8 * s2 + 5]); b.w = pk2(s1[8 * s2 + 6], s1[8 * s2 + 7]);
            pf[s2] = __builtin_bit_cast(bf16x8, a); pf[2 + s2] = __builtin_bit_cast(bf16x8, b);
        }
#pragma unroll
        for (int d = 0; d < DV / 32; ++d) {
#pragma unroll
            for (int kk = 0; kk < 4; ++kk) {
                const s16x4 lo = vtr(Vb + (16 * kk) * VSTR + d * 64), hi = vtr(Vb + (16 * kk + 8) * VSTR + d * 64);
                const bf16x8 vf = {lo[0], lo[1], lo[2], lo[3], hi[0], hi[1], hi[2], hi[3]};
                o[d] = __builtin_amdgcn_mfma_f32_32x32x16_bf16(vf, pf[kk], o[d], 0, 0, 0);
            }
        }
        if (t + 1 < ntiles) { tile_store<KW, KSTR>(kr, K0 + (cur ^ 1) * KBUF, tid); tile_store<DV, VSTR>(vr, V0 + (cur ^ 1) * VBUF, tid); }
        __syncthreads();
    }
}
__device__ __forceinline__ int swz(int row) { return ((row & 3) << 2) | ((row >> 2) & 3); }
template <int DQK, int MODE, int pitch, int voff>
__device__ __forceinline__ void attn_loop_dma(LAS unsigned char* lds, const int wave, const bf16_t* Kg, int ntiles,
                                              const bf16x8 (&qf)[DQK / 16], int koff, float nslope2, int qrel, float& m, float& lsum, f32x16 (&o)[4]) {
    constexpr int DV = 128, STAGE = 32768, VOFFB = 16384;
    const int lane = hw_lane(), r = lane & 31, h = lane >> 5;
    unsigned gk[2];
#pragma unroll
    for (int i = 0; i < 2; ++i) { const int row = 4 * (2 * wave + i) + (lane >> 4), c = (lane & 15) ^ swz(row); gk[i] = (unsigned)(row * pitch + c * 8); }
    unsigned kad[DQK / 16], vad[4][2];
#pragma unroll
    for (int ks = 0; ks < DQK / 16; ++ks) kad[ks] = (unsigned)(r * 256 + 16 * (((koff >> 3) + 2 * ks + h) ^ swz(r)));
    { const int q_ = (lane & 15) >> 2, pp = lane & 3, g1 = (lane >> 4) & 1;
#pragma unroll
      for (int d = 0; d < 4; ++d)
#pragma unroll
          for (int hi = 0; hi < 2; ++hi) { const int f = (q_ << 2) | ((2 * hi + h) & 3), c = (4 * d + 2 * g1 + (pp >> 1)) ^ f;
              vad[d][hi] = (unsigned)(VOFFB + (4 * h + q_) * 256 + 16 * c + 8 * (pp & 1) + hi * 2048); } }
#define ATT_DMA(tt, st) do { const bf16_t* kg_ = Kg + (size_t)(tt) * 64 * pitch; _Pragma("unroll") for (int i_ = 0; i_ < 2; ++i_) { \
        __builtin_amdgcn_global_load_lds((const unsigned*)(kg_ + gk[i_]), (LAS unsigned*)(lds + (st) * STAGE + (2 * wave + i_) * 1024), 16, 0, 0); \
        __builtin_amdgcn_global_load_lds((const unsigned*)(kg_ + voff + gk[i_]), (LAS unsigned*)(lds + (st) * STAGE + VOFFB + (2 * wave + i_) * 1024), 16, 0, 0); } } while (0)
    ATT_DMA(0, 0);
    if (ntiles > 1) ATT_DMA(1, 1);
    if (ntiles > 2) { ATT_DMA(2, 2); asm volatile("s_waitcnt vmcnt(4)" ::: "memory"); } else asm volatile("s_waitcnt vmcnt(0)" ::: "memory");
    __builtin_amdgcn_s_barrier();
    f32x16 s0, s1;
#pragma unroll
    for (int i = 0; i < 16; ++i) { s0[i] = 0.f; s1[i] = 0.f; }
#pragma unroll
    for (int ks = 0; ks < DQK / 16; ++ks) {
        const bf16x8 k0 = *(const LAS bf16x8*)(lds + kad[ks]), k1 = *(const LAS bf16x8*)(lds + kad[ks] + 8192);
        s0 = __builtin_amdgcn_mfma_f32_32x32x16_bf16(k0, qf[ks], s0, 0, 0, 0);
        s1 = __builtin_amdgcn_mfma_f32_32x32x16_bf16(k1, qf[ks], s1, 0, 0, 0);
    }
#define LDS_RD128(dst, addr, off) asm volatile("ds_read_b128 %0, %1 offset:%c2" : "=&v"(dst) : "v"(addr), "i"(off) : "memory")
#define LDS_RDTR(dst, addr, off) asm volatile("ds_read_b64_tr_b16 %0, %1 offset:%c2" : "=&v"(dst) : "v"(addr), "i"(off) : "memory")
#define LDS_WAIT0() do { asm volatile("s_waitcnt lgkmcnt(0)" ::: "memory"); __builtin_amdgcn_sched_barrier(0); } while (0)
    for (int t = 0; t < ntiles; ++t) {
        if (t + 3 < ntiles) ATT_DMA(t + 3, (t + 3) & 3);
        const unsigned sba = (unsigned)(size_t)(lds + (t & 3) * STAGE), sna = (unsigned)(size_t)(lds + ((t + 1) & 3) * STAGE);
        constexpr int KH = (DQK == 64) ? 4 : 4;
        bf16x8 kf0[KH], kf1[KH];
        s16x4 va_lo[4], va_hi[4], vb_lo[4], vb_hi[4];
        if (DQK == 64) {
#pragma unroll
            for (int ks = 0; ks < KH; ++ks) { const unsigned ka = sna + kad[ks]; LDS_RD128(kf0[ks], ka, 0); } }
        __builtin_amdgcn_sched_barrier(0);
        float Aoff = 0.f;
        if (MODE >= 1) {
            const int qrel0 = __builtin_amdgcn_readfirstlane(qrel - r);
            const int T0 = t * 64;
            if (MODE == 1 && (T0 + 64 <= qrel0 || T0 > qrel0 + 31)) {
                const bool left = (T0 + 64 <= qrel0);
                const float sl = left ? -nslope2 : nslope2;
                Aoff = left ? nslope2 * (float)(qrel - T0 - 4 * h) : nslope2 * (float)(T0 + 4 * h - qrel);
#pragma unroll
                for (int i = 0; i < 16; ++i) { s0[i] = __builtin_fmaf(sl, (float)((i & 3) + 8 * (i >> 2)), s0[i]); s1[i] = __builtin_fmaf(sl, (float)(32 + (i & 3) + 8 * (i >> 2)), s1[i]); }
            } else {
                const float base = (float)(T0 + 4 * h - qrel);
#pragma unroll
                for (int i = 0; i < 16; ++i) {
                    const float d0 = fabsf(base + (float)((i & 3) + 8 * (i >> 2))), d1 = fabsf(base + (float)(32 + (i & 3) + 8 * (i >> 2)));
                    s0[i] = __builtin_fmaf(d0, nslope2, s0[i]); s1[i] = __builtin_fmaf(d1, nslope2, s1[i]);
                    if (MODE == 2) { if (d0 > 128.f) s0[i] = -1e30f; if (d1 > 128.f) s1[i] = -1e30f; }
                }
            }
        }
        float mx = fmaxf(s0[0], s1[0]);
#pragma unroll
        for (int i = 1; i < 16; ++i) mx = fmaxf(fmaxf(mx, s0[i]), s1[i]);
        mx += Aoff;
        mx = fmaxf(mx, xhalf(mx));
        const float mnew = fmaxf(m, mx);
        if (__builtin_amdgcn_ballot_w64(mnew > m) != 0ull) {
            const float alpha = __builtin_amdgcn_exp2f(m - mnew);
            lsum *= alpha;
#pragma unroll
            for (int d = 0; d < DV / 32; ++d) o[d] = o[d] * alpha;
        }
        m = mnew;
        const float mm = mnew - Aoff;
        float rs = 0.f;
#pragma unroll
        for (int i = 0; i < 16; ++i) { s0[i] = __builtin_amdgcn_exp2f(s0[i] - mm); s1[i] = __builtin_amdgcn_exp2f(s1[i] - mm); rs += s0[i] + s1[i]; }
        lsum += rs;
        bf16x8 pf[4];
#pragma unroll
        for (int s2 = 0; s2 < 2; ++s2) {
            u32x4 a, b;
            a.x = pk2(s0[8 * s2 + 0], s0[8 * s2 + 1]); a.y = pk2(s0[8 * s2 + 2], s0[8 * s2 + 3]); a.z = pk2(s0[8 * s2 + 4], s0[8 * s2 + 5]); a.w = pk2(s0[8 * s2 + 6], s0[8 * s2 + 7]);
            b.x = pk2(s1[8 * s2 + 0], s1[8 * s2 + 1]); b.y = pk2(s1[8 * s2 + 2], s1[8 * s2 + 3]); b.z = pk2(s1[8 * s2 + 4], s1[8 * s2 + 5]); b.w = pk2(s1[8 * s2 + 6], s1[8 * s2 + 7]);
            pf[s2] = __builtin_bit_cast(bf16x8, a); pf[2 + s2] = __builtin_bit_cast(bf16x8, b);
        }
        LDS_WAIT0();
        if (DQK == 64) {
#pragma unroll
            for (int ks = 0; ks < KH; ++ks) { const unsigned ka = sna + kad[ks]; LDS_RD128(kf1[ks], ka, 8192); } }
        { const unsigned alo = sba + vad[0][0], ahi = sba + vad[0][1];
#pragma unroll
          for (int kk = 0; kk < 4; ++kk) { LDS_RDTR(va_lo[kk], alo, kk * 4096); LDS_RDTR(va_hi[kk], ahi, kk * 4096); } }
        __builtin_amdgcn_sched_barrier(0);
        f32x16 n0, n1;
#pragma unroll
        for (int i = 0; i < 16; ++i) { n0[i] = 0.f; n1[i] = 0.f; }
#pragma unroll
        for (int g = 0; g < DQK / 64; ++g) {
            if (DQK != 64) {
#pragma unroll
                for (int ks = 0; ks < KH; ++ks) { const unsigned ka = sna + kad[g * KH + ks]; LDS_RD128(kf0[ks], ka, 0); LDS_RD128(kf1[ks], ka, 8192); }
                LDS_WAIT0(); }
#pragma unroll
            for (int ks = 0; ks < KH; ++ks) n0 = __builtin_amdgcn_mfma_f32_32x32x16_bf16(kf0[ks], qf[g * KH + ks], n0, 0, 0, 0);
            if (DQK == 64) LDS_WAIT0();
#pragma unroll
            for (int ks = 0; ks < KH; ++ks) n1 = __builtin_amdgcn_mfma_f32_32x32x16_bf16(kf1[ks], qf[g * KH + ks], n1, 0, 0, 0);
        }
#define PV_BLOCK(d, lo, hi) do { _Pragma("unroll") for (int kk = 0; kk < 4; ++kk) { const bf16x8 vf = {lo[kk][0], lo[kk][1], lo[kk][2], lo[kk][3], hi[kk][0], hi[kk][1], hi[kk][2], hi[kk][3]}; \
            o[d] = __builtin_amdgcn_mfma_f32_32x32x16_bf16(vf, pf[kk], o[d], 0, 0, 0); } } while (0)
#define V_ISSUE(d, lo, hi) do { const unsigned alo_ = sba + vad[d][0], ahi_ = sba + vad[d][1]; _Pragma("unroll") for (int kk = 0; kk < 4; ++kk) { LDS_RDTR(lo[kk], alo_, kk * 4096); LDS_RDTR(hi[kk], ahi_, kk * 4096); } } while (0)
        LDS_WAIT0();
        V_ISSUE(1, vb_lo, vb_hi); __builtin_amdgcn_sched_barrier(0);
        PV_BLOCK(0, va_lo, va_hi);
        LDS_WAIT0();
        V_ISSUE(2, va_lo, va_hi); __builtin_amdgcn_sched_barrier(0);
        PV_BLOCK(1, vb_lo, vb_hi);
        LDS_WAIT0();
        V_ISSUE(3, vb_lo, vb_hi); __builtin_amdgcn_sched_barrier(0);
        PV_BLOCK(2, va_lo, va_hi);
        LDS_WAIT0();
        PV_BLOCK(3, vb_lo, vb_hi);
#undef PV_BLOCK
#undef V_ISSUE
        s0 = n0; s1 = n1;
        if (t + 3 < ntiles) asm volatile("s_waitcnt vmcnt(4)" ::: "memory"); else asm volatile("s_waitcnt vmcnt(0)" ::: "memory");
        __builtin_amdgcn_s_barrier();
    }
#undef LDS_RD128
#undef LDS_RDTR
#undef LDS_WAIT0
#undef ATT_DMA
}
template <int DV> __device__ __forceinline__ void store_o(const f32x16 (&o)[DV / 32], float sc, bf16_t* orow, int h) {
#pragma unroll
    for (int d = 0; d < DV / 32; ++d)
#pragma unroll
        for (int g4 = 0; g4 < 4; ++g4) { u32x2 w; w.x = pk2(o[d][4 * g4] * sc, o[d][4 * g4 + 1] * sc); w.y = pk2(o[d][4 * g4 + 2] * sc, o[d][4 * g4 + 3] * sc);
            *(GAS u32x2*)((GAS bf16_t*)orow + 32 * d + 8 * g4 + 4 * h) = w; }
}

__device__ __forceinline__ void win_unit(Frame& F, const Params& p, int l, int u) {
    REFRAME(F);
    const bf16_t* Z = (const bf16_t*)(p.ws + WS_Z); bf16_t* MIX = (bf16_t*)(p.ws + WS_MIX);
    const int b = u >> 5, kvh = (u >> 4) & 1, nb = u & 15, r = F.lane & 31, h = F.lane >> 5;
    const int g = F.wave >> 2, hq = kvh * 2 + g, qpos = nb * 128 + (F.wave & 3) * 32 + r;
    const size_t tok = (size_t)b * SEQ + qpos;
    bf16x8 qf[4]; load_q<64>(qf, Z + tok * ZP + hq * 64, h, 0.125f * LOG2E);
    const int first = (2 * nb - 2 < 0) ? 0 : 2 * nb - 2, lastx = (2 * nb + 4 > 32) ? 32 : 2 * nb + 4, nt = lastx - first;
    const float slope = exp2f(-(float)(2 * hq + 1));
    float m = p.in[4][l * 4 + hq] * LOG2E, ls = (h == 0) ? 1.f : 0.f;
    f32x16 o[2];
#pragma unroll
    for (int d = 0; d < 2; ++d)
#pragma unroll
        for (int i = 0; i < 16; ++i) o[d][i] = 0.f;
    const bf16_t* Kg = Z + ((size_t)b * SEQ + first * 64) * ZP + 256 + kvh * 64;
    attn_loop<64, 64, 64, 2>(F.lds, Kg, ZP, Kg + 128, ZP, nt, qf, 0, -slope * LOG2E, qpos - first * 64, m, ls, o);
    const float lt = ls + xhalf(ls);
    store_o<64>(o, 1.f / lt, MIX + tok * DM + hq * 64, h);
}
__device__ __forceinline__ void diff_unit(Frame& F, const Params& p, int l, int u) {
    REFRAME(F);
    const bf16_t* Z = (const bf16_t*)(p.ws + WS_Z); bf16_t* MIX = (bf16_t*)(p.ws + WS_MIX);
    const int b = u >> 6, hh = (u >> 4) & 3, qb = u & 15, r = F.lane & 31, h = F.lane >> 5;
    const int c = F.wave >> 2, qpos = qb * 128 + (F.wave & 3) * 32 + r;
    const size_t tok = (size_t)b * SEQ + qpos;
    float lam, lam_init;
    {
        const float a1 = wave_sum(p.in[5][l * 64 + F.lane] * p.in[6][l * 64 + F.lane]), a2 = wave_sum(p.in[7][l * 64 + F.lane] * p.in[8][l * 64 + F.lane]);
        lam_init = 0.8f - 0.6f * expf(-0.3f * (float)l);
        lam = expf(a1) - expf(a2) + lam_init;
    }
    bf16x8 qf[4]; load_q<64>(qf, Z + tok * ZP + 512 + hh * 128 + c * 64, h, 0.125f * LOG2E);
    const float slope = exp2f(-(float)(2 * hh + 2));
    float m = -1e30f, ls = 0.f;
    f32x16 o[4];
#pragma unroll
    for (int d = 0; d < 4; ++d)
#pragma unroll
        for (int i = 0; i < 16; ++i) o[d][i] = 0.f;
    const bf16_t* Kg = (const bf16_t*)(p.ws + WS_KD2) + (size_t)(b * 4 + hh) * 2048 * 128;
    attn_loop_dma<64, 1, 128, 8388608>(F.lds, F.wave, Kg, 32, qf, c * 64, -slope * LOG2E, qpos, m, ls, o);
    const float inv = 1.f / (ls + xhalf(ls));
    LAS float* comb = (LAS float*)F.lds + (size_t)(F.wave & 3) * 64 * 64 + F.lane;
    if (c == 1) {
#pragma unroll
        for (int d = 0; d < 4; ++d)
#pragma unroll
            for (int i = 0; i < 16; ++i) comb[(d * 16 + i) * 64] = o[d][i] * inv;
    }
    __syncthreads();
    if (c == 0) {
        float ss = 0.f;
#pragma unroll
        for (int d = 0; d < 4; ++d)
#pragma unroll
            for (int i = 0; i < 16; ++i) { const float a = o[d][i] * inv - lam * comb[(d * 16 + i) * 64]; o[d][i] = a; ss += a * a; }
        ss += xhalf(ss);
        const float rn = rsqrtf(ss * (1.f / 128.f) + 1e-6f) * (1.f - lam_init);
        const float* sg = p.in[9] + l * 128;
        bf16_t* orow = MIX + tok * DM + 256 + hh * 128;
        f32x4 ggv[4][4];
#pragma unroll
        for (int d = 0; d < 4; ++d)
#pragma unroll
            for (int g4 = 0; g4 < 4; ++g4) ggv[d][g4] = *(const GAS f32x4*)((const GAS float*)sg + 32 * d + 8 * g4 + 4 * h);
#pragma unroll
        for (int d = 0; d < 4; ++d)
#pragma unroll
            for (int g4 = 0; g4 < 4; ++g4) { const int dv = 32 * d + 8 * g4 + 4 * h; const f32x4 gg = ggv[d][g4];
                u32x2 w; w.x = pk2(o[d][4 * g4] * rn * gg[0], o[d][4 * g4 + 1] * rn * gg[1]); w.y = pk2(o[d][4 * g4 + 2] * rn * gg[2], o[d][4 * g4 + 3] * rn * gg[3]);
                *(GAS u32x2*)((GAS bf16_t*)orow + dv) = w; }
    }
    __syncthreads();
}
__device__ __forceinline__ void cross_unit(Frame& F, const Params& p, int u) {
    REFRAME(F);
    const bf16_t* Q = (const bf16_t*)(p.ws + WS_Q); const bf16_t* KV = (const bf16_t*)(p.ws + WS_KV); bf16_t* O = (bf16_t*)(p.ws + WS_O);
    const int b = u >> 5, hd = (u >> 3) & 3, qb = u & 7, r = F.lane & 31, h = F.lane >> 5;
    const size_t tok = (size_t)b * SEQ + qb * 256 + F.wave * 32 + r;
    bf16x8 qf[8]; load_q<128>(qf, Q + tok * XW + hd * 128, h, 0.08838834764831845f * LOG2E);
    float m = -1e30f, ls = 0.f;
    f32x16 o[4];
#pragma unroll
    for (int d = 0; d < 4; ++d)
#pragma unroll
        for (int i = 0; i < 16; ++i) o[d][i] = 0.f;
    const bf16_t* Kg = KV + ((size_t)b * NMEM) * 1024 + hd * 128;
    attn_loop_dma<128, 0, 1024, 512>(F.lds, F.wave, Kg, 4, qf, 0, 0.f, 0, m, ls, o);
    const float lt = ls + xhalf(ls);
    store_o<128>(o, 1.f / lt, O + tok * XW + hd * 128, h);
}

constexpr int CF_STR = 772, PREP_AW = 32 * CF_STR * 4, PREP_AA = PREP_AW + 32 * 72 * 2, PREP_AG = PREP_AA + 32 * 72 * 2;
__device__ __forceinline__ void prep_unit(Frame& F, const Params& p, int l, const bf16_t* wb, int u) {
    REFRAME(F);
    const bf16_t* ZC = (const bf16_t*)(p.ws + WS_ZC);
    const int t0 = u * 32, b = t0 / SEQ;
    LAS float* CF = (LAS float*)F.lds; LAS bf16_t* AW = (LAS bf16_t*)(F.lds + PREP_AW); LAS bf16_t* AA = (LAS bf16_t*)(F.lds + PREP_AA); LAS bf16_t* AG = (LAS bf16_t*)(F.lds + PREP_AG);
    const float* conv = p.in[10] + (size_t)l * 3 * 1024;
    LAS float* PAR = (LAS float*)(F.lds + PREP_AG + 32 * 136 * 2);
    if (F.tid < 448) { const int i = F.tid; const GAS f32x4* src;
        if (i < 64) src = (const GAS f32x4*)((const GAS float*)p.in[16] + l * 256) + i;
        else if (i < 128) src = (const GAS f32x4*)((const GAS float*)p.in[17] + l * 256) + (i - 64);
        else if (i < 192) src = (const GAS f32x4*)((const GAS float*)p.in[18] + l * 256) + (i - 128);
        else if (i < 320) src = (const GAS f32x4*)((const GAS float*)p.in[11] + l * 512) + (i - 192);
        else src = (const GAS f32x4*)((const GAS float*)p.in[13] + l * 512) + (i - 320);
        ((LAS f32x4*)PAR)[i] = *src; }
#pragma unroll 4
    for (int i = 0; i < 8; ++i) {
        const int id = F.tid + i * 512, tk = id >> 7, ch = id & 127, tg = t0 + tk, tpos = tg - b * SEQ;
        const GAS bf16_t* zp = (const GAS bf16_t*)ZC + (size_t)tg * 1024 + ch * 8;
        const u32x4 zc = *(const GAS u32x4*)zp;
        u32x4 zl = {0u, 0u, 0u, 0u}, zr = {0u, 0u, 0u, 0u};
        if (tpos > 0) zl = *(const GAS u32x4*)(zp - 1024);
        if (tpos < SEQ - 1) zr = *(const GAS u32x4*)(zp + 1024);
        float v[8];
#pragma unroll
        for (int q = 0; q < 4; ++q) {
            const f32x2 c0 = *(const GAS f32x2*)((const GAS float*)conv + ch * 8 + 2 * q), c1 = *(const GAS f32x2*)((const GAS float*)conv + 1024 + ch * 8 + 2 * q), c2 = *(const GAS f32x2*)((const GAS float*)conv + 2048 + ch * 8 + 2 * q);
            v[2 * q] = bflo(zl[q]) * c0[0] + bflo(zc[q]) * c1[0] + bflo(zr[q]) * c2[0];
            v[2 * q + 1] = bfhi(zl[q]) * c0[1] + bfhi(zc[q]) * c1[1] + bfhi(zr[q]) * c2[1];
        }
        if (ch < 96) { *(LAS f32x4*)(CF + tk * CF_STR + ch * 8) = (f32x4){v[0], v[1], v[2], v[3]}; *(LAS f32x4*)(CF + tk * CF_STR + ch * 8 + 4) = (f32x4){v[4], v[5], v[6], v[7]}; }
        else {
            u32x4 w;
            if (ch < 104) {
#pragma unroll
                for (int q = 0; q < 8; ++q) v[q] = 1.f - 2.f * __builtin_amdgcn_rcpf(__expf(2.f * v[q]) + 1.f);
                w.x = pk2(v[0], v[1]); w.y = pk2(v[2], v[3]); w.z = pk2(v[4], v[5]); w.w = pk2(v[6], v[7]);
                *(LAS u32x4*)(AW + tk * 72 + (ch - 96) * 8) = w;
            } else if (ch < 112) {
                w.x = pk2(v[0], v[1]); w.y = pk2(v[2], v[3]); w.z = pk2(v[4], v[5]); w.w = pk2(v[6], v[7]);
                *(LAS u32x4*)(AA + tk * 72 + (ch - 104) * 8) = w;
            } else {
#pragma unroll
                for (int q = 0; q < 8; ++q) v[q] = sigmoidf_(v[q]);
                w.x = pk2(v[0], v[1]); w.y = pk2(v[2], v[3]); w.z = pk2(v[4], v[5]); w.w = pk2(v[6], v[7]);
                *(LAS u32x4*)(AG + tk * 136 + (ch - 112) * 8) = w;
            }
        }
    }
    __syncthreads();
    const int hh = F.wave & 3, dir = F.wave >> 2, tk = F.lane & 31, h2 = F.lane >> 5;
    const size_t tok = (size_t)t0 + tk;
    const GAS bf16_t* Wup = (const GAS bf16_t*)wb + WO_WUP + (size_t)(dir * 256 + hh * 64) * 64;
    const GAS bf16_t* Aup = (const GAS bf16_t*)wb + WO_AUP + (size_t)(dir * 256 + hh * 64) * 64;
    f32x16 aw[2], aa[2];
#pragma unroll
    for (int rb = 0; rb < 2; ++rb)
#pragma unroll
        for (int i = 0; i < 16; ++i) { aw[rb][i] = 0.f; aa[rb][i] = 0.f; }
#pragma unroll
    for (int ks = 0; ks < 4; ++ks) {
        const bf16x8 bw = *(const LAS bf16x8*)(AW + tk * 72 + 16 * ks + 8 * h2), ba = *(const LAS bf16x8*)(AA + tk * 72 + 16 * ks + 8 * h2);
#pragma unroll
        for (int rb = 0; rb < 2; ++rb) {
            const bf16x8 fw = *(const GAS bf16x8*)(Wup + (size_t)(rb * 32 + tk) * 64 + 16 * ks + 8 * h2), fa = *(const GAS bf16x8*)(Aup + (size_t)(rb * 32 + tk) * 64 + 16 * ks + 8 * h2);
            aw[rb] = __builtin_amdgcn_mfma_f32_32x32x16_bf16(fw, bw, aw[rb], 0, 0, 0);
            aa[rb] = __builtin_amdgcn_mfma_f32_32x32x16_bf16(fa, ba, aa[rb], 0, 0, 0);
        }
    }
    const LAS float* k_k = PAR + hh * 64; const LAS float* k_a = PAR + 256 + hh * 64; const LAS float* r_k = PAR + 512 + hh * 64;
    const LAS float* w0 = PAR + 768 + dir * 256 + hh * 64; const LAS float* a0 = PAR + 1280 + dir * 256 + hh * 64;
    float ssq = 0.f;
#pragma unroll
    for (int rb = 0; rb < 2; ++rb)
#pragma unroll
        for (int g4 = 0; g4 < 4; ++g4) { const int c0 = rb * 32 + 8 * g4 + 4 * h2;
            const f32x4 kv = *(const LAS f32x4*)(CF + tk * CF_STR + 256 + hh * 64 + c0), kkw = *(const LAS f32x4*)(k_k + c0);
            const f32x4 q = kv * kkw; ssq += (q[0] * q[0] + q[1] * q[1]) + (q[2] * q[2] + q[3] * q[3]); }
    ssq += xhalf(ssq);
    const float kinv = 1.f / fmaxf(sqrtf(ssq), 1e-12f);
    float bon = 0.f;
    GAS bf16_t* OM = (GAS bf16_t*)(p.ws + WS_OM) + ((size_t)dir * MTOK + tok) * 256 + hh * 64;
    GAS bf16_t* KA = (GAS bf16_t*)(p.ws + WS_KA) + ((size_t)dir * MTOK + tok) * 256 + hh * 64;
    GAS bf16_t* KD = (GAS bf16_t*)(p.ws + WS_KD) + ((size_t)dir * MTOK + tok) * 256 + hh * 64;
    GAS bf16_t* KK = (GAS bf16_t*)(p.ws + WS_KK) + tok * 256 + hh * 64;
    GAS bf16_t* VV = (GAS bf16_t*)(p.ws + WS_V) + tok * 256 + hh * 64;
    GAS bf16_t* RR = (GAS bf16_t*)(p.ws + WS_R) + tok * 256 + hh * 64;
#pragma unroll
    for (int rb = 0; rb < 2; ++rb)
#pragma unroll
        for (int g4 = 0; g4 < 4; ++g4) { const int c0 = rb * 32 + 8 * g4 + 4 * h2;
            const f32x4 kv = *(const LAS f32x4*)(CF + tk * CF_STR + 256 + hh * 64 + c0), rv = *(const LAS f32x4*)(CF + tk * CF_STR + hh * 64 + c0);
            const f32x4 kkw = *(const LAS f32x4*)(k_k + c0), kaw = *(const LAS f32x4*)(k_a + c0), rkw = *(const LAS f32x4*)(r_k + c0), w0v = *(const LAS f32x4*)(w0 + c0), a0v = *(const LAS f32x4*)(a0 + c0);
            float om[4], ka[4], kd[4], kk[4];
#pragma unroll
            for (int j = 0; j < 4; ++j) {
                const float wp = aw[rb][4 * g4 + j] + w0v[j], ap = aa[rb][4 * g4 + j] + a0v[j];
                om[j] = 1.f - __expf(-0.6065306597126334f * sigmoidf_(wp));
                const float a = sigmoidf_(ap);
                kk[j] = kv[j] * kkw[j] * kinv; ka[j] = kk[j] * a; kd[j] = kv[j] * (1.f + (a - 1.f) * kaw[j]);
                bon += rv[j] * kd[j] * rkw[j];
            }
            u32x2 w; w.x = pk2(om[0], om[1]); w.y = pk2(om[2], om[3]); *(GAS u32x2*)(OM + c0) = w;
            w.x = pk2(ka[0], ka[1]); w.y = pk2(ka[2], ka[3]); *(GAS u32x2*)(KA + c0) = w;
            w.x = pk2(kd[0], kd[1]); w.y = pk2(kd[2], kd[3]); *(GAS u32x2*)(KD + c0) = w;
            if (dir == 0) {
                const f32x4 vv = *(const LAS f32x4*)(CF + tk * CF_STR + 512 + hh * 64 + c0);
                w.x = pk2(kk[0], kk[1]); w.y = pk2(kk[2], kk[3]); *(GAS u32x2*)(KK + c0) = w;
                w.x = pk2(vv[0], vv[1]); w.y = pk2(vv[2], vv[3]); *(GAS u32x2*)(VV + c0) = w;
                w.x = pk2(rv[0], rv[1]); w.y = pk2(rv[2], rv[3]); *(GAS u32x2*)(RR + c0) = w;
            }
        }
    bon += xhalf(bon);
    if (h2 == 0) ((GAS float*)(p.ws + WS_BON))[((size_t)dir * MTOK + tok) * 4 + hh] = bon;
    {
        const GAS bf16_t* Gup = (const GAS bf16_t*)wb + WO_GUP + (size_t)(F.wave * 32 + tk) * 128;
        f32x16 ag;
#pragma unroll
        for (int i = 0; i < 16; ++i) ag[i] = 0.f;
#pragma unroll
        for (int ks = 0; ks < 8; ++ks) {
            const bf16x8 bg = *(const LAS bf16x8*)(AG + tk * 136 + 16 * ks + 8 * h2), fg = *(const GAS bf16x8*)(Gup + 16 * ks + 8 * h2);
            ag = __builtin_amdgcn_mfma_f32_32x32x16_bf16(fg, bg, ag, 0, 0, 0);
        }
        GAS bf16_t* GT = (GAS bf16_t*)(p.ws + WS_GATE) + tok * 256 + F.wave * 32;
#pragma unroll
        for (int g4 = 0; g4 < 4; ++g4) { u32x2 w; w.x = pk2(ag[4 * g4], ag[4 * g4 + 1]); w.y = pk2(ag[4 * g4 + 2], ag[4 * g4 + 3]); *(GAS u32x2*)(GT + 8 * g4 + 4 * h2) = w; }
    }
    __syncthreads();
}

#define CBAR() asm volatile("" ::: "memory")
#define LROW(M, i, r) do { const LAS f32x4* _q = (const LAS f32x4*)((M) + (i) * 16); const f32x4 _a = _q[0], _b = _q[1], _c = _q[2], _d = _q[3]; \
        r[0] = _a[0]; r[1] = _a[1]; r[2] = _a[2]; r[3] = _a[3]; r[4] = _b[0]; r[5] = _b[1]; r[6] = _b[2]; r[7] = _b[3]; \
        r[8] = _c[0]; r[9] = _c[1]; r[10] = _c[2]; r[11] = _c[3]; r[12] = _d[0]; r[13] = _d[1]; r[14] = _d[2]; r[15] = _d[3]; } while (0)
template <int DIR> __device__ __forceinline__ void chunkprep_wave(Frame& F, const Params& p, int task) {
    const int dbh = task >> 7, ct = task & 127, b = (dbh >> 2) & 7, hh = dbh & 3, ch = F.lane, r32 = F.lane & 31, h = F.lane >> 5;
    LAS unsigned char* wl = F.lds + F.wave * 16384;
    LAS bf16_t* X = (LAS bf16_t*)wl;
    LAS bf16_t* Yt = (LAS bf16_t*)(wl + 4608);
    LAS float* MTt = (LAS float*)(wl + 9216);
    LAS float* MBt = MTt + 256;
    LAS float* MC = MTt + 512; LAS float* MD = MTt + 768; LAS float* MT = MTt + 1024; LAS float* MA = MTt + 1280;
    constexpr int step = DIR ? -256 : 256;
    typedef const __attribute__((address_space(1))) bf16_t* gbf;
    const size_t ou = ((size_t)b * SEQ + ct * 16 + (DIR ? 15 : 0)) * 256 + hh * 64;
    const gbf OM = (gbf)(p.ws + WS_OM) + (size_t)DIR * MTOK * 256 + ou + ch; const gbf KA = (gbf)(p.ws + WS_KA) + (size_t)DIR * MTOK * 256 + ou + ch;
    const gbf KD = (gbf)(p.ws + WS_KD) + (size_t)DIR * MTOK * 256 + ou + ch; const gbf KK = (gbf)(p.ws + WS_KK) + ou + ch;
    const gbf RR = (gbf)(p.ws + WS_R) + ou + ch; const gbf VV = (gbf)(p.ws + WS_V) + ou + ch;
    float pc = 1.f;
    float qt[16], rt[16], at[16], kt[16], vv[16];
    {
        unsigned short rw[16], rk[16], ra_[16], rd[16], rr_[16], rv[16];
#pragma unroll
        for (int i = 0; i < 16; ++i) { rw[i] = OM[i * step]; rk[i] = KK[i * step]; ra_[i] = KA[i * step]; rd[i] = KD[i * step]; rr_[i] = RR[i * step]; rv[i] = VV[i * step]; }
#pragma unroll
        for (int i = 0; i < 16; ++i) {
            const float w = 1.f - bf2f(rw[i]);
            qt[i] = bf2f(rk[i]) * pc; pc *= w; const float ip = __builtin_amdgcn_rcpf(pc);
            rt[i] = bf2f(rr_[i]) * pc; at[i] = bf2f(ra_[i]) * ip; kt[i] = bf2f(rd[i]) * ip; vv[i] = bf2f(rv[i]);
            X[i * 72 + ch] = (bf16_t)(pk2(qt[i], 0.f) & 0xffffu); X[(16 + i) * 72 + ch] = (bf16_t)(pk2(rt[i], 0.f) & 0xffffu);
            Yt[i * 72 + ch] = (bf16_t)(pk2(at[i], 0.f) & 0xffffu); Yt[(16 + i) * 72 + ch] = (bf16_t)(pk2(kt[i], 0.f) & 0xffffu);
        }
    }
    const float p15 = pc;
    asm volatile("s_waitcnt lgkmcnt(0)" ::: "memory");
    {
        f32x16 g;
#pragma unroll
        for (int i = 0; i < 16; ++i) g[i] = 0.f;
#pragma unroll
        for (int ks = 0; ks < 4; ++ks) {
            const bf16x8 a = *(const LAS bf16x8*)(X + r32 * 72 + 16 * ks + 8 * h), bb = *(const LAS bf16x8*)(Yt + r32 * 72 + 16 * ks + 8 * h);
            g = __builtin_amdgcn_mfma_f32_32x32x16_bf16(a, bb, g, 0, 0, 0);
        }
        const int sidx = r32 & 15;
#pragma unroll
        for (int reg = 0; reg < 8; ++reg) { const int i = (reg & 3) + 8 * (reg >> 2) + 4 * h;
            const float lo = (sidx < i) ? g[reg] : 0.f, hi2 = (sidx <= i) ? g[8 + reg] : 0.f;
            if (r32 < 16) { MA[i * 16 + sidx] = lo; MD[i * 16 + sidx] = hi2; } else { MBt[sidx * 16 + i] = lo; MC[i * 16 + sidx] = hi2; } }
    }
    asm volatile("s_waitcnt lgkmcnt(0)" ::: "memory");
    {
        const int c = F.lane & 15; float Tc[16];
#pragma unroll
        for (int i = 0; i < 16; ++i) { float acc = (i == c) ? 1.f : 0.f; float ra[16]; LROW(MA, i, ra);
#pragma unroll
            for (int s2 = 0; s2 < i; ++s2) acc -= ra[s2] * Tc[s2];
            Tc[i] = acc; MT[i * 16 + c] = acc; MTt[c * 16 + i] = acc; CBAR(); }
    }
    asm volatile("s_waitcnt lgkmcnt(0)" ::: "memory");
    float Qh[16], W2[16];
    {
        float BV[16];
#pragma unroll
        for (int i = 0; i < 16; ++i) { Qh[i] = 0.f; BV[i] = 0.f; }
#pragma unroll
        for (int s2 = 0; s2 < 16; ++s2) {
            float ct_[16], cb_[16]; LROW(MTt, s2, ct_); LROW(MBt, s2, cb_);
#pragma unroll
            for (int i = s2; i < 16; ++i) { Qh[i] += ct_[i] * qt[s2]; if (i > s2) BV[i] += cb_[i] * vv[s2]; }
            CBAR();
        }
#pragma unroll
        for (int i = 0; i < 16; ++i) { float aw = 0.f; float rt_[16]; LROW(MT, i, rt_);
#pragma unroll
            for (int s2 = 0; s2 <= i; ++s2) aw += rt_[s2] * BV[s2];
            W2[i] = aw; CBAR(); }
    }
    LAS bf16_t* ST = (LAS bf16_t*)wl;
    {
        const int ks = ch >> 4, w16 = ch & 15, jq = (w16 >> 3) * 4 + (w16 & 3), hq = (w16 >> 2) & 1;
        LAS bf16_t* qrp = ST + (ks * 64 + hq * 32) * 8 + jq;
        LAS bf16_t* wyp = ST + 2048 + ((ch >> 5) * 64 + r32) * 16;
#pragma unroll
        for (int i = 0; i < 16; ++i) {
            float ar = rt[i], ay = 0.f; float rd_[16], rc_[16]; LROW(MD, i, rd_); LROW(MC, i, rc_);
#pragma unroll
            for (int s2 = 0; s2 <= i; ++s2) { ar -= rd_[s2] * Qh[s2]; ay += rc_[s2] * vv[s2] - rd_[s2] * W2[s2]; }
            qrp[i * 8] = (bf16_t)(pk2(Qh[i], 0.f) & 0xffffu); qrp[(16 + i) * 8] = (bf16_t)(pk2(ar, 0.f) & 0xffffu);
            wyp[512 * ((i >> 2) & 1) + (i & 3) + 4 * (i >> 3)] = (bf16_t)(pk2(W2[i], 0.f) & 0xffffu);
            wyp[512 * ((i >> 2) & 1) + (i & 3) + 4 * ((16 + i) >> 3)] = (bf16_t)(pk2(ay, 0.f) & 0xffffu);
            CBAR(); }
    }
    asm volatile("s_waitcnt lgkmcnt(0)" ::: "memory");
    {
        GAS u32x4* gq = (GAS u32x4*)((GAS bf16_t*)(p.ws + WS_FQR) + (size_t)task * 2048); GAS u32x4* gw = (GAS u32x4*)((GAS bf16_t*)(p.ws + WS_FWY) + (size_t)task * 2048);
        u32x4 tq[4], tw[4];
#pragma unroll
        for (int q = 0; q < 4; ++q) { tq[q] = *(const LAS u32x4*)(wl + (F.lane + 64 * q) * 16); tw[q] = *(const LAS u32x4*)(wl + 4096 + (F.lane + 64 * q) * 16); }
#pragma unroll
        for (int q = 0; q < 4; ++q) { gq[F.lane + 64 * q] = tq[q]; gw[F.lane + 64 * q] = tw[q]; }
    }
    asm volatile("s_waitcnt lgkmcnt(0)" ::: "memory");
    {
        LAS bf16_t* nap = ST + ((ch >> 5) * 64 + r32) * 8; LAS bf16_t* khp = nap + 1024;
#pragma unroll
        for (int s2 = 0; s2 < 16; ++s2) {
            const int off = 256 * ((s2 >> 2) & 1) + (s2 >> 3) * 4 + (s2 & 3);
            nap[off] = (bf16_t)(pk2(-at[s2] * p15, 0.f) & 0xffffu); khp[off] = (bf16_t)(pk2(kt[s2] * p15, 0.f) & 0xffffu); }
        asm volatile("s_waitcnt lgkmcnt(0)" ::: "memory");
        GAS u32x4* gn = (GAS u32x4*)((GAS bf16_t*)(p.ws + WS_FNA) + (size_t)task * 1024); GAS u32x4* gk = (GAS u32x4*)((GAS bf16_t*)(p.ws + WS_FKH) + (size_t)task * 1024);
        u32x4 tn[2], tk2[2];
#pragma unroll
        for (int q = 0; q < 2; ++q) { tn[q] = *(const LAS u32x4*)(wl + (F.lane + 64 * q) * 16); tk2[q] = *(const LAS u32x4*)(wl + 2048 + (F.lane + 64 * q) * 16); }
#pragma unroll
        for (int q = 0; q < 2; ++q) { gn[F.lane + 64 * q] = tn[q]; gk[F.lane + 64 * q] = tk2[q]; }
        ((GAS float*)(p.ws + WS_FP15))[(size_t)task * 64 + ch] = p15;
    }
    asm volatile("s_waitcnt lgkmcnt(0)" ::: "memory");
}
constexpr int PB_SLOT = 15360, PB_NSLOT = 4, PB_QR = 0, PB_WY = 4096, PB_NA = 8192, PB_KH = 10240, PB_P15 = 12288, PB_V = 13312;
__device__ __forceinline__ unsigned lds_ld_u32(unsigned addr) { unsigned v; asm volatile("ds_read_b32 %0, %1\n\ts_waitcnt lgkmcnt(0)" : "=v"(v) : "v"(addr) : "memory"); return v; }
__device__ __forceinline__ void lds_st_u32(unsigned addr, unsigned v) { asm volatile("ds_write_b32 %0, %1" :: "v"(addr), "v"(v) : "memory"); }
__device__ __forceinline__ void pb_dma(const Params& p, int dbh, int ct, int lane, LAS unsigned char* slot) {
    const size_t task = (size_t)dbh * 128 + ct; const int b = (dbh >> 2) & 7, hh = dbh & 3;
    const unsigned char* q = (const unsigned char*)((const bf16_t*)(p.ws + WS_FQR) + task * 2048) + lane * 16; const unsigned char* w = (const unsigned char*)((const bf16_t*)(p.ws + WS_FWY) + task * 2048) + lane * 16;
    const unsigned char* na = (const unsigned char*)((const bf16_t*)(p.ws + WS_FNA) + task * 1024) + lane * 16; const unsigned char* kh = (const unsigned char*)((const bf16_t*)(p.ws + WS_FKH) + task * 1024) + lane * 16;
#pragma unroll
    for (int i = 0; i < 4; ++i) {
        __builtin_amdgcn_global_load_lds((const unsigned*)(q + 1024 * i), (LAS unsigned*)(slot + PB_QR + 1024 * i), 16, 0, 0);
        __builtin_amdgcn_global_load_lds((const unsigned*)(w + 1024 * i), (LAS unsigned*)(slot + PB_WY + 1024 * i), 16, 0, 0); }
    __builtin_amdgcn_global_load_lds((const unsigned*)na, (LAS unsigned*)(slot + PB_NA), 16, 0, 0); __builtin_amdgcn_global_load_lds((const unsigned*)(na + 1024), (LAS unsigned*)(slot + PB_NA + 1024), 16, 0, 0);
    __builtin_amdgcn_global_load_lds((const unsigned*)kh, (LAS unsigned*)(slot + PB_KH), 16, 0, 0); __builtin_amdgcn_global_load_lds((const unsigned*)(kh + 1024), (LAS unsigned*)(slot + PB_KH + 1024), 16, 0, 0);
    __builtin_amdgcn_global_load_lds((const unsigned*)((const unsigned char*)((const float*)(p.ws + WS_FP15) + task * 64) + lane * 16), (LAS unsigned*)(slot + PB_P15), 16, 0, 0);
    const unsigned char* V = (const unsigned char*)((const bf16_t*)(p.ws + WS_V) + ((size_t)b * SEQ + ct * 16) * 256 + hh * 64) + (size_t)(lane >> 3) * 512 + (lane & 7) * 16;
    __builtin_amdgcn_global_load_lds((const unsigned*)V, (LAS unsigned*)(slot + PB_V), 16, 0, 0); __builtin_amdgcn_global_load_lds((const unsigned*)(V + 8 * 512), (LAS unsigned*)(slot + PB_V + 1024), 16, 0, 0);
}
__device__ __forceinline__ void phaseb_unit(Frame& F, const Params& p, int u) {
    const unsigned flag_base = (unsigned)(size_t)(F.lds + 131072 + 128);
    if (F.tid < 8) lds_st_u32(flag_base + 4 * F.tid, 0u);
    __syncthreads();
    const int pair = F.wave & 3;
    if (pair >= 2) return;
    const int dbh = u * 2 + pair, dir = dbh >> 5;
    LAS unsigned char* ring = F.lds + pair * (PB_NSLOT * PB_SLOT);
    const unsigned f_pub = flag_base + 8 * pair, f_con = f_pub + 4;
    if (F.wave >= 4) {
        for (int c = 0; c < 128; ++c) {
            while ((int)lds_ld_u32(f_con) < c - (PB_NSLOT - 1)) __builtin_amdgcn_s_sleep(1);
            pb_dma(p, dbh, dir ? 127 - c : c, F.lane, ring + (c & (PB_NSLOT - 1)) * PB_SLOT);
            if (c >= 3) { asm volatile("s_waitcnt vmcnt(45)" ::: "memory"); if (F.lane == 0) lds_st_u32(f_pub, (unsigned)(c - 2)); }
        }
        asm volatile("s_waitcnt vmcnt(30)" ::: "memory"); if (F.lane == 0) lds_st_u32(f_pub, 126u);
        asm volatile("s_waitcnt vmcnt(15)" ::: "memory"); if (F.lane == 0) lds_st_u32(f_pub, 127u);
        asm volatile("s_waitcnt vmcnt(0)" ::: "memory"); if (F.lane == 0) lds_st_u32(f_pub, 128u);
        return;
    }
    const int b = (dbh >> 2) & 7, hh = dbh & 3, r = F.lane & 31, h = F.lane >> 5;
    GAS bf16_t* Y = (GAS bf16_t*)(p.ws + WS_Y) + ((size_t)dir * MTOK + (size_t)b * SEQ) * 256 + hh * 64 + r;
    f32x16 accS[2][2];
#pragma unroll
    for (int rb = 0; rb < 2; ++rb)
#pragma unroll
        for (int cb = 0; cb < 2; ++cb)
#pragma unroll
            for (int i = 0; i < 16; ++i) accS[rb][cb][i] = 0.f;
    for (int cc = 0; cc < 128; ++cc) {
        const int ct = dir ? 127 - cc : cc;
        const LAS unsigned char* slot = ring + (cc & (PB_NSLOT - 1)) * PB_SLOT;
        bf16x8 sb[4][2];
#pragma unroll
        for (int rb = 0; rb < 2; ++rb)
#pragma unroll
            for (int s2 = 0; s2 < 2; ++s2)
#pragma unroll
                for (int cb = 0; cb < 2; ++cb) { const f32x16& a = accS[rb][cb]; u32x4 w;
                    w.x = pk2(a[8 * s2 + 0], a[8 * s2 + 1]); w.y = pk2(a[8 * s2 + 2], a[8 * s2 + 3]); w.z = pk2(a[8 * s2 + 4], a[8 * s2 + 5]); w.w = pk2(a[8 * s2 + 6], a[8 * s2 + 7]);
                    sb[2 * rb + s2][cb] = __builtin_bit_cast(bf16x8, w); }
        while ((int)lds_ld_u32(f_pub) < cc + 1) __builtin_amdgcn_s_sleep(1);
        asm volatile("" ::: "memory");
        f32x16 D[2];
#pragma unroll
        for (int cb = 0; cb < 2; ++cb) { const LAS u32x4* wp = (const LAS u32x4*)(slot + PB_WY + (cb * 64 + F.lane) * 32); const u32x4 w0 = wp[0], w1 = wp[1];
            D[cb][0] = bflo(w0.x); D[cb][1] = bfhi(w0.x); D[cb][2] = bflo(w0.y); D[cb][3] = bfhi(w0.y); D[cb][4] = bflo(w0.z); D[cb][5] = bfhi(w0.z); D[cb][6] = bflo(w0.w); D[cb][7] = bfhi(w0.w);
            D[cb][8] = bflo(w1.x); D[cb][9] = bfhi(w1.x); D[cb][10] = bflo(w1.y); D[cb][11] = bfhi(w1.y); D[cb][12] = bflo(w1.z); D[cb][13] = bfhi(w1.z); D[cb][14] = bflo(w1.w); D[cb][15] = bfhi(w1.w); }
#pragma unroll
        for (int ks = 0; ks < 4; ++ks) { const bf16x8 qa = *(const LAS bf16x8*)(slot + PB_QR + (ks * 64 + F.lane) * 16);
            D[0] = __builtin_amdgcn_mfma_f32_32x32x16_bf16(qa, sb[ks][0], D[0], 0, 0, 0);
            D[1] = __builtin_amdgcn_mfma_f32_32x32x16_bf16(qa, sb[ks][1], D[1], 0, 0, 0); }
#pragma unroll
        for (int rb = 0; rb < 2; ++rb)
#pragma unroll
            for (int g4 = 0; g4 < 4; ++g4) { const f32x4 pv = *(const LAS f32x4*)(slot + PB_P15 + (32 * rb + 8 * g4 + 4 * h) * 4);
#pragma unroll
                for (int cb = 0; cb < 2; ++cb)
#pragma unroll
                    for (int q = 0; q < 4; ++q) accS[rb][cb][4 * g4 + q] *= pv[q]; }
        bf16x8 ub[2], vb[2];
#pragma unroll
        for (int cb = 0; cb < 2; ++cb) {
            unsigned short vt[8];
#pragma unroll
            for (int j = 0; j < 8; ++j) { const int s2 = 8 * (j >> 2) + 4 * h + (j & 3); const int tau = dir ? 15 - s2 : s2;
                vt[j] = *(const LAS unsigned short*)(slot + PB_V + tau * 128 + (32 * cb + r) * 2);
                Y[(size_t)(ct * 16 + tau) * 256 + 32 * cb] = (bf16_t)(pk2(D[cb][8 + j], 0.f) & 0xffffu); }
            vb[cb] = (bf16x8){(short)vt[0], (short)vt[1], (short)vt[2], (short)vt[3], (short)vt[4], (short)vt[5], (short)vt[6], (short)vt[7]};
            u32x4 w; w.x = pk2(D[cb][0], D[cb][1]); w.y = pk2(D[cb][2], D[cb][3]); w.z = pk2(D[cb][4], D[cb][5]); w.w = pk2(D[cb][6], D[cb][7]);
            ub[cb] = __builtin_bit_cast(bf16x8, w);
        }
        bf16x8 na[2], kh[2];
#pragma unroll
        for (int rb = 0; rb < 2; ++rb) { na[rb] = *(const LAS bf16x8*)(slot + PB_NA + (rb * 64 + F.lane) * 16); kh[rb] = *(const LAS bf16x8*)(slot + PB_KH + (rb * 64 + F.lane) * 16); }
        asm volatile("s_waitcnt lgkmcnt(0)" ::: "memory");
        if (F.lane == 0) lds_st_u32(f_con, (unsigned)(cc + 1));
#pragma unroll
        for (int rb = 0; rb < 2; ++rb)
#pragma unroll
            for (int cb = 0; cb < 2; ++cb) {
                accS[rb][cb] = __builtin_amdgcn_mfma_f32_32x32x16_bf16(na[rb], ub[cb], accS[rb][cb], 0, 0, 0);
                accS[rb][cb] = __builtin_amdgcn_mfma_f32_32x32x16_bf16(kh[rb], vb[cb], accS[rb][cb], 0, 0, 0);
            }
    }
}

__device__ __forceinline__ void post_unit(Frame& F, const Params& p, int l, int u) {
    REFRAME(F);
    const bf16_t* Y0 = (const bf16_t*)(p.ws + WS_Y); const bf16_t* Y1 = Y0 + (size_t)MTOK * 256;
    const bf16_t* VV = (const bf16_t*)(p.ws + WS_V); const bf16_t* GT = (const bf16_t*)(p.ws + WS_GATE);
    const float* BON = (const float*)(p.ws + WS_BON); bf16_t* MIX = (bf16_t*)(p.ws + WS_MIX);
    const f32x4 lg = *(const f32x4*)(p.in[19] + l * 256 + 4 * F.lane), lb = *(const f32x4*)(p.in[20] + l * 256 + 4 * F.lane);
    for (int tok = u * 64 + F.wave * 8, te = tok + 8; tok < te; ++tok) {
        const u32x2 a = *(const GAS u32x2*)((const GAS bf16_t*)Y0 + (size_t)tok * 256 + 4 * F.lane), c = *(const GAS u32x2*)((const GAS bf16_t*)Y1 + (size_t)tok * 256 + 4 * F.lane);
        const u32x2 vv = *(const GAS u32x2*)((const GAS bf16_t*)VV + (size_t)tok * 256 + 4 * F.lane), gg = *(const GAS u32x2*)((const GAS bf16_t*)GT + (size_t)tok * 256 + 4 * F.lane);
        float y[4] = {bflo(a.x) + bflo(c.x), bfhi(a.x) + bfhi(c.x), bflo(a.y) + bflo(c.y), bfhi(a.y) + bfhi(c.y)};
        float s = (y[0] + y[1]) + (y[2] + y[3]);
#pragma unroll
        for (int o = 1; o < 16; o <<= 1) s += __shfl_xor(s, o);
        const float mu = s * (1.f / 64.f);
        float q = 0.f;
#pragma unroll
        for (int i = 0; i < 4; ++i) { y[i] -= mu; q += y[i] * y[i]; }
#pragma unroll
        for (int o = 1; o < 16; o <<= 1) q += __shfl_xor(q, o);
        const float rstd = rsqrtf(q * (1.f / 64.f) + 64e-5f);
        const int hh = F.lane >> 4;
        const float bon = ((const GAS float*)BON)[(size_t)tok * 4 + hh] + ((const GAS float*)BON)[((size_t)MTOK + tok) * 4 + hh];
        const float v4[4] = {bflo(vv.x), bfhi(vv.x), bflo(vv.y), bfhi(vv.y)}, g4[4] = {bflo(gg.x), bfhi(gg.x), bflo(gg.y), bfhi(gg.y)};
        float o4[4];
#pragma unroll
        for (int i = 0; i < 4; ++i) o4[i] = (y[i] * rstd * lg[i] + lb[i] + bon * v4[i]) * g4[i];
        u32x2 w; w.x = pk2(o4[0], o4[1]); w.y = pk2(o4[2], o4[3]);
        *(GAS u32x2*)((GAS bf16_t*)MIX + (size_t)tok * DM + 768 + 4 * F.lane) = w;
    }
}

__device__ __forceinline__ void prologue(Frame& F, const Params& p) {
    REFRAME(F);
    LAS float* scr = (LAS float*)(F.lds + F.wave * 16384);
    const int gw = F.bid * 8 + F.wave, NGW = F.G * 8;
    bf16_t* wb = (bf16_t*)(p.ws + WS_W);
    for (int it = gw; it < CV_TOTAL; it += NGW) { if (it < CV_A) cvt_item_a(p, 0, wb, scr, it, F.lane); else cvt_item_b(p, 0, wb, scr, it - CV_A, F.lane); }
    const float* x = p.in[0]; float* X = p.out; bf16_t* XB = (bf16_t*)(p.ws + WS_XB); float* rowss = (float*)(p.ws + WS_RP);
    for (int m = gw; m < MTOK; m += 2 * NGW) {
        const int m2 = m + NGW; const bool has2 = m2 < MTOK; const int mb = has2 ? m2 : m;
        const GAS f32x4* xra = (const GAS f32x4*)(x + (size_t)m * DM) + F.lane; const GAS f32x4* xrb = (const GAS f32x4*)(x + (size_t)mb * DM) + F.lane;
        f32x4 va[4], vb[4];
#pragma unroll
        for (int jj = 0; jj < 4; ++jj) { va[jj] = xra[64 * jj]; vb[jj] = xrb[64 * jj]; }
        float sa = 0.f, sb = 0.f;
#pragma unroll
        for (int jj = 0; jj < 4; ++jj) { sa += (va[jj][0] * va[jj][0] + va[jj][1] * va[jj][1]) + (va[jj][2] * va[jj][2] + va[jj][3] * va[jj][3]); sb += (vb[jj][0] * vb[jj][0] + vb[jj][1] * vb[jj][1]) + (vb[jj][2] * vb[jj][2] + vb[jj][3] * vb[jj][3]); }
        sa = wave_sum(sa); sb = wave_sum(sb);
        { GAS f32x4* xo = (GAS f32x4*)(X + (size_t)m * DM) + F.lane; GAS u32x2* bo = (GAS u32x2*)(XB + (size_t)m * DM) + F.lane;
#pragma unroll
          for (int jj = 0; jj < 4; ++jj) { xo[64 * jj] = va[jj]; u32x2 w; w.x = pk2(va[jj][0], va[jj][1]); w.y = pk2(va[jj][2], va[jj][3]); bo[64 * jj] = w; }
          if (F.lane < 16) ((GAS float*)rowss)[(size_t)m * 16 + F.lane] = (F.lane == 0) ? sa : 0.f; }
        if (has2) { GAS f32x4* xo = (GAS f32x4*)(X + (size_t)m2 * DM) + F.lane; GAS u32x2* bo = (GAS u32x2*)(XB + (size_t)m2 * DM) + F.lane;
#pragma unroll
          for (int jj = 0; jj < 4; ++jj) { xo[64 * jj] = vb[jj]; u32x2 w; w.x = pk2(vb[jj][0], vb[jj][1]); w.y = pk2(vb[jj][2], vb[jj][3]); bo[64 * jj] = w; }
          if (F.lane < 16) ((GAS float*)rowss)[(size_t)m2 * 16 + F.lane] = (F.lane == 0) ? sb : 0.f; }
    }
    const float* mem = p.in[1]; const float* gm = p.in[23]; bf16_t* MN = (bf16_t*)(p.ws + WS_MEMN);
    for (int m = gw; m < MMEM; m += NGW) {
        const f32x4* xr = (const f32x4*)(mem + (size_t)m * DM) + F.lane; u32x2* bo = (u32x2*)(MN + (size_t)m * DM) + F.lane;
        f32x4 v[4]; float s = 0.f;
#pragma unroll
        for (int jj = 0; jj < 4; ++jj) { v[jj] = xr[64 * jj]; s += (v[jj][0] * v[jj][0] + v[jj][1] * v[jj][1]) + (v[jj][2] * v[jj][2] + v[jj][3] * v[jj][3]); }
        const float rstd = rsqrtf(wave_sum(s) * (1.f / 1024.f) + 1e-6f);
#pragma unroll
        for (int jj = 0; jj < 4; ++jj) { const f32x4 g = *((const f32x4*)gm + F.lane + 64 * jj); const f32x4 t = v[jj] * rstd * g;
            u32x2 w; w.x = pk2(t[0], t[1]); w.y = pk2(t[2], t[3]); bo[64 * jj] = w; }
    }
}
__device__ __forceinline__ void final_norm(Frame& F, const Params& p) {
    REFRAME(F);
    const int gw = F.bid * 8 + F.wave, NGW = F.G * 8;
    const float* rowss = (const float*)(p.ws + WS_RP) + (size_t)12 * MTOK * 16; const GAS float* gf = (const GAS float*)p.in[30];
    f32x4 g[4];
#pragma unroll
    for (int jj = 0; jj < 4; ++jj) g[jj] = *((const GAS f32x4*)gf + F.lane + 64 * jj);
    for (int m = gw; m < MTOK; m += 2 * NGW) {
        const int m2 = m + NGW; const bool has2 = m2 < MTOK;
        GAS f32x4* xa = (GAS f32x4*)(p.out + (size_t)m * DM) + F.lane; GAS f32x4* xb = (GAS f32x4*)(p.out + (size_t)(has2 ? m2 : m) * DM) + F.lane;
        f32x4 va[4], vb[4];
#pragma unroll
        for (int jj = 0; jj < 4; ++jj) { va[jj] = xa[64 * jj]; vb[jj] = xb[64 * jj]; }
        const float ra = row_rstd(rowss, m), rb = row_rstd(rowss, has2 ? m2 : m);
#pragma unroll
        for (int jj = 0; jj < 4; ++jj) xa[64 * jj] = va[jj] * ra * g[jj];
        if (has2) {
#pragma unroll
            for (int jj = 0; jj < 4; ++jj) xb[64 * jj] = vb[jj] * rb * g[jj]; }
    }
}

#define XB_TMO      128
#define XB_XCNT(j)  (256  + 64 * (j))
#define XB_XSUB(j)  (1280 + 64 * (j))
#define XB_XGEN(j)  (2304 + 64 * (j))
#define XB_TOP      3328
#define XB_TOPGEN   3392
#define XB_SPIN_CAP (1u << 22)
constexpr int CW_BAR = 4096;
__device__ __forceinline__ unsigned xb_ld(unsigned* p)              { return __hip_atomic_load(p, __ATOMIC_RELAXED, __HIP_MEMORY_SCOPE_AGENT); }
__device__ __forceinline__ unsigned xb_add(unsigned* p, unsigned v) { return __hip_atomic_fetch_add(p, v, __ATOMIC_RELAXED, __HIP_MEMORY_SCOPE_AGENT); }
__device__ __forceinline__ unsigned xb_xcc_id() { return (unsigned)__builtin_amdgcn_s_getreg((3 << 11) | 20) & 0xFu; }
#define XB_SPIN(cond, bar) do { unsigned _sp = 0; while (cond) { __builtin_amdgcn_s_sleep(1); \
    if ((++_sp & 255u) == 0u) { if (xb_ld(&(bar)[XB_TMO])) break; if (_sp > XB_SPIN_CAP) { atomicAdd(&(bar)[XB_TMO], 1u); break; } } } } while (0)
__device__ __forceinline__ void xcd_barrier_complete(unsigned* bar, unsigned x, unsigned& nloc, unsigned& nx) {
    const unsigned G = gridDim.x;
    unsigned sum, cnt, mine, sp = 0u;
    for (;;) {
        sum = 0u; cnt = 0u; mine = 0u;
#pragma unroll
        for (unsigned j = 0; j < 16; ++j) { const unsigned c = xb_ld(&bar[XB_XCNT(j)]); sum += c; cnt += (c > 0u) ? 1u : 0u; mine = (j == x) ? c : mine; }
        if (sum == G) break;
        __builtin_amdgcn_s_sleep(1);
        if ((++sp & 255u) == 0u) { if (xb_ld(&bar[XB_TMO])) break; if (sp > XB_SPIN_CAP) { atomicAdd(&bar[XB_TMO], 1u); break; } }
    }
    nloc = mine > 0u ? mine : 1u; nx = cnt > 0u ? cnt : 1u;
}
__device__ __forceinline__ void gsync(volatile LAS unsigned* st) {
    unsigned* bar = (unsigned*)(make_params().ws + WS_CTL) + CW_BAR;
    asm volatile("s_waitcnt vmcnt(0)" ::: "memory");
    __syncthreads();
    if (threadIdx.x == 0) {
        const unsigned x = xb_xcc_id();
        __builtin_amdgcn_s_waitcnt(0);
        unsigned nloc = st[0], nx = st[1];
        if (nloc == 0u) { xcd_barrier_complete(bar, x, nloc, nx); st[0] = nloc; st[1] = nx; }
        const unsigned old = xb_add(&bar[XB_XSUB(x)], 1u);
        const unsigned gen = old / nloc;
        if (old + 1u == (gen + 1u) * nloc) {
            __builtin_amdgcn_fence(__ATOMIC_RELEASE, "agent");
            asm volatile("s_waitcnt vmcnt(0)" ::: "memory");
            const unsigned og = xb_add(&bar[XB_TOP], 1u);
            const unsigned tg = og / nx;
            if (og + 1u == (tg + 1u) * nx) xb_add(&bar[XB_TOPGEN], 1u);
            else XB_SPIN(xb_ld(&bar[XB_TOPGEN]) == tg, bar);
            __builtin_amdgcn_fence(__ATOMIC_ACQUIRE, "agent");
            xb_add(&bar[XB_XGEN(x)], 1u);
            asm volatile("s_waitcnt vmcnt(0)" ::: "memory");
        } else {
            XB_SPIN(xb_ld(&bar[XB_XGEN(x)]) == gen, bar);
            __builtin_amdgcn_fence(__ATOMIC_ACQUIRE, "agent");
            asm volatile("s_waitcnt vmcnt(0)" ::: "memory");
        }
    }
    __syncthreads();
}
__device__ __forceinline__ int rstd_table(LAS unsigned char* lds, const pg8::StaticOrder& S, const float* rowss, int tid) {
    pg8::Unit u0; int pm0 = -1;
    if (S.next(0, u0)) { pm0 = u0.pm; if (tid < 256) ((LAS float*)(lds + 131072 + 2048))[tid] = row_rstd(rowss, pm0 * 256 + tid); }
    __syncthreads();
    return pm0;
}
#ifdef TPROBE
#define STAMP(id) do { if (blockIdx.x == 0 && threadIdx.x == 0) { LAS unsigned long long* ts_ = (LAS unsigned long long*)(F.lds + 131072 + 64); const unsigned long long now_ = __builtin_amdgcn_s_memrealtime(); \
    const unsigned long long dt_ = now_ - ts_[0]; ts_[0] = now_; if ((TA_MASK >> (id)) & 1) ts_[1] += dt_; if ((TB_MASK >> (id)) & 1) ts_[2] += dt_; } } while (0)
#else
#define STAMP(id) do { } while (0)
#endif
#ifndef PH_MASK
#define PH_MASK 0xFFFF
#endif
#ifndef REP_MASK
#define REP_MASK 0
#endif
#define NREP(k) ((((REP_MASK) >> (k)) & 1) ? 2 : 1)
constexpr int NCP = 1024, NDIFF_A = 0, NPB = 32;
__global__ void __launch_bounds__(512, 2) fwd_megakernel(KArgs kargs_unused) {
    extern __shared__ __attribute__((aligned(16))) unsigned char lds_raw[];
    cg::grid_group grid = cg::this_grid();
    Frame F; F.lds = (LAS unsigned char*)lds_raw; F.tid = threadIdx.x; F.lane = F.tid & 63; F.wave = __builtin_amdgcn_readfirstlane(F.tid >> 6); F.G = gridDim.x; F.bid = blockIdx.x;
    LAS int* qslot = (LAS int*)(F.lds + 131072);
    volatile LAS unsigned* bst = (volatile LAS unsigned*)(F.lds + 131072 + 32);
    { unsigned* bar0 = (unsigned*)(make_params().ws + WS_CTL) + CW_BAR;
      if (threadIdx.x == 0) { bst[0] = 0u; bst[1] = 0u; (void)xb_add(bar0 + XB_XCNT(xb_xcc_id()), 1u); } }
    __syncthreads();
#define PHASE_VARS() const Params p = make_params(); unsigned* ctl = (unsigned*)(p.ws + WS_CTL); float* rowss = (float*)(p.ws + WS_RP); \
    bf16_t* XB = (bf16_t*)(p.ws + WS_XB); bf16_t* Z = (bf16_t*)(p.ws + WS_Z); bf16_t* MIX = (bf16_t*)(p.ws + WS_MIX); \
    bf16_t* wb = (bf16_t*)(p.ws + WS_W); int bid_ = F.bid, G_ = F.G; asm volatile("" : "+s"(bid_), "+s"(G_)); (void)bid_; (void)G_; (void)ctl; (void)rowss; (void)XB; (void)Z; (void)MIX; (void)wb

#ifdef TPROBE
    if (blockIdx.x == 0 && threadIdx.x == 0) { LAS unsigned long long* ts_ = (LAS unsigned long long*)(F.lds + 131072 + 64); ts_[0] = __builtin_amdgcn_s_memrealtime(); ts_[1] = 0; ts_[2] = 0; }
#endif
    if (PH_MASK & 1) { const Params p = make_params(); prologue(F, p); }
    grid.sync();
    STAMP(0);

    for (int l = 0; l < NL; ++l) {
        for (int rep = 0; rep < NREP(1); ++rep) {
        if (PH_MASK & 2) {
            PHASE_VARS();
            pg8::StaticOrder S; S.init(MTOK, INW, G_, bid_);
            const int pm0 = rstd_table(F.lds, S, rowss + (size_t)(3 * l) * MTOK * 16, F.tid);
            pg8::gemm_phase(F.lds, pg8::Gemm{XB, wb + WO_IN, MTOK, INW, DM}, S, pg8::EpiScaleBf16{Z, ZP, rowss + (size_t)(3 * l) * MTOK * 16, (bf16_t*)(p.ws + WS_ZC), 1024, 8, (bf16_t*)(p.ws + WS_KD2), (const LAS float*)(F.lds + 131072 + 2048), pm0});
        }
        gsync(bst); STAMP(1);
        }
        for (int rep = 0; rep < NREP(2); ++rep) {
        for (int u = F.bid; u < 768; u += F.G) {
            PHASE_VARS();
            if (u < 512) { if (PH_MASK & 4) prep_unit(F, p, l, wb, u); } else if (PH_MASK & 8) win_unit(F, p, l, u - 512);
        }
        gsync(bst); STAMP(2);
        }
        for (int rep = 0; rep < NREP(3); ++rep) {
        {
            PHASE_VARS();
            for (int u = bid_; u < NCP; u += G_) {
                if (PH_MASK & 16) { REFRAME(F); if (u >= NCP / 2) chunkprep_wave<1>(F, p, u * 8 + F.wave); else chunkprep_wave<0>(F, p, u * 8 + F.wave); }
            }
        }
        gsync(bst); STAMP(11);
        }
        for (int rep = 0; rep < NREP(4); ++rep) {
        {
            PHASE_VARS();
            const int ncva = (l + 1 < NL) ? CV_A / 8 : 0, ncvb = (l > 0) ? CV_B / 8 : 0, ncv = NPB + ncva + ncvb, ntot = ncv + 256;
            unsigned* pbdone = ctl + 3072 + (l * 2 + rep) * 16;
            unsigned* gq = ctl + CW_Q + 16 * l + 8 + 4 * rep; unsigned* dq = ctl + 2048 + (l * 2 + rep) * 16;
            const int myx = (int)(xb_xcc_id() & 7u);
            int stage = 0, pend = -1, xi = 0;
            for (;;) {
                __syncthreads();
                if (F.tid == 0) {
                    int code = -1;
                    if (stage == 0) { const int g = (int)atomicAdd(gq, 1u); if (g < NPB) code = g; else { pend = g; stage = 1; } }
                    if (stage == 1) {
                        while (xi < 8) { const int x = (myx + xi) & 7; const int tk = (int)atomicAdd(dq + x, 1u); if (tk < 64) { code = -2 - ((4 * x + (tk >> 4)) * 16 + (tk & 15)); break; } ++xi; }
                        if (xi >= 8) stage = 2;
                    }
                    if (stage == 2 && code == -1) { int g = pend; pend = -1; if (g < 0) g = (int)atomicAdd(gq, 1u); if (g < ntot) code = g; }
                    *qslot = code;
                }
                __syncthreads();
                const int u = *qslot;
                if (u == -1) break;
                if (u <= -2) { if (PH_MASK & 32) diff_unit(F, p, l, -2 - u); }
                else if (u < NPB) { if (PH_MASK & 16) { REFRAME(F); phaseb_unit(F, p, u); }
                    __threadfence(); __syncthreads();
                    if (F.tid == 0) __hip_atomic_fetch_add(pbdone, 1u, __ATOMIC_RELEASE, __HIP_MEMORY_SCOPE_AGENT); }
                else if (u >= ncv) {
                    if (F.tid == 0) { while (__hip_atomic_load(pbdone, __ATOMIC_RELAXED, __HIP_MEMORY_SCOPE_AGENT) < (unsigned)NPB) __builtin_amdgcn_s_sleep(8); }
                    __syncthreads(); __builtin_amdgcn_fence(__ATOMIC_ACQUIRE, "agent");
                    if (PH_MASK & 64) post_unit(F, p, l, u - ncv); }
                else if (u < NPB + ncva) { REFRAME(F); cvt_item_a(p, l + 1, wb, (LAS float*)(F.lds + F.wave * 16384), (u - NPB) * 8 + F.wave, F.lane); }
                else { REFRAME(F); cvt_item_b(p, l, wb, (LAS float*)(F.lds + F.wave * 16384), (u - NPB - ncva) * 8 + F.wave, F.lane); }
            }
        }
        gsync(bst); STAMP(3);
        }
        if (PH_MASK & 128) {
            PHASE_VARS();
            pg8::StaticOrder S; S.init(MTOK, DM, G_, bid_);
            pg8::gemm_phase(F.lds, pg8::Gemm{MIX, wb + WO_OUT, MTOK, DM, DM}, S, pg8::EpiResid{p.out, XB, rowss + (size_t)(3 * l + 1) * MTOK * 16});
        }
        gsync(bst); STAMP(5);
        for (int rep = 0; rep < NREP(6); ++rep) {
        if (PH_MASK & 256) {
            PHASE_VARS();
            pg8::StaticOrder S; S.init(MTOK, XW, G_, bid_);
            if (F.bid < 128) {
                pg8::gemm_phase(F.lds, pg8::Gemm{XB, wb + WO_Q, MTOK, XW, DM}, S, pg8::EpiScaleBf16{(bf16_t*)(p.ws + WS_Q), XW, rowss + (size_t)(3 * l + 1) * MTOK * 16, nullptr, 0, 1 << 30, nullptr, nullptr, -1});
            } else {
                pg8::StaticOrder S2; S2.init(MMEM, 1024, 128, F.bid - 128);
                pg8::gemm_phase(F.lds, pg8::Gemm{(const bf16_t*)(p.ws + WS_MEMN), wb + WO_KV, MMEM, 1024, DM}, S2, pg8::EpiScaleBf16{(bf16_t*)(p.ws + WS_KV), 1024, nullptr, nullptr, 0, 1 << 30, nullptr, nullptr, -1});
            }
        }
        gsync(bst); STAMP(6);
        }
        for (int rep = 0; rep < NREP(7); ++rep) {
        if (PH_MASK & 512) for (int u = F.bid; u < 256; u += F.G) { PHASE_VARS(); cross_unit(F, p, u); }
        gsync(bst); STAMP(7);
        }
        if (PH_MASK & 1024) {
            PHASE_VARS();
            pg8::StaticOrder S; S.init(MTOK, DM, G_, bid_);
            pg8::gemm_phase(F.lds, pg8::Gemm{(const bf16_t*)(p.ws + WS_O), wb + WO_O, MTOK, DM, XW}, S, pg8::EpiResid{p.out, XB, rowss + (size_t)(3 * l + 2) * MTOK * 16});
        }
        gsync(bst); STAMP(8);
        for (int rep = 0; rep < NREP(9); ++rep) {
        if (PH_MASK & 2048) {
            PHASE_VARS();
            pg8::StaticOrder S; S.init(MTOK, 2 * DFF, G_, bid_);
            const int pm0 = rstd_table(F.lds, S, rowss + (size_t)(3 * l + 2) * MTOK * 16, F.tid);
            pg8::gemm_phase(F.lds, pg8::Gemm{XB, wb + WO_GU, MTOK, 2 * DFF, DM}, S, pg8::EpiSwiGLU{(bf16_t*)(p.ws + WS_G), rowss + (size_t)(3 * l + 2) * MTOK * 16, (const LAS float*)(F.lds + 131072 + 2048), pm0});
        }
        gsync(bst); STAMP(9);
        }
        if (PH_MASK & 4096) {
            PHASE_VARS();
            pg8::StaticOrder S; S.init(MTOK, DM, G_, bid_);
            pg8::gemm_phase(F.lds, pg8::Gemm{(const bf16_t*)(p.ws + WS_G), wb + WO_DOWN, MTOK, DM, DFF}, S, pg8::EpiResid{p.out, XB, rowss + (size_t)(3 * l + 3) * MTOK * 16});
        }

#ifdef TPROBE
        STAMP(10);
        { const Params p = make_params(); if (l == NL - 1 && blockIdx.x == 0 && threadIdx.x == 0) { LAS unsigned long long* ts_ = (LAS unsigned long long*)(F.lds + 131072 + 64); unsigned* c_ = (unsigned*)(p.ws + WS_CTL); c_[32] = (unsigned)ts_[1]; c_[33] = (unsigned)ts_[2]; } }
#endif
        gsync(bst);
    }
    if (PH_MASK & 8192) { const Params p = make_params(); final_norm(F, p); }
}

extern "C" void kernel_launch(void* const* d_in, const int* in_sizes, int n_in, void* d_out, int out_size, void* d_ws, size_t ws_size, hipStream_t stream) {
    static int grid = 0;
    if (grid == 0) {
        if (n_in != 31 || out_size != MTOK * DM || ws_size < WS_END) { fprintf(stderr, "kernel_launch: unexpected problem shape (n_in %d out %d ws %zu)\n", n_in, out_size, ws_size); grid = -1; return; }
        int dev = 0, cus = 0, per_cu = 0;
        hipGetDevice(&dev);
        hipDeviceGetAttribute(&cus, hipDeviceAttributeMultiprocessorCount, dev);
        hipFuncSetAttribute((const void*)fwd_megakernel, hipFuncAttributeMaxDynamicSharedMemorySize, LDS_BYTES);
        hipOccupancyMaxActiveBlocksPerMultiprocessor(&per_cu, (const void*)fwd_megakernel, 512, LDS_BYTES);
        if (per_cu < 1) { fprintf(stderr, "kernel_launch: occupancy query returned %d\n", per_cu); per_cu = 1; }
        (void)hipGetLastError();
        grid = cus * per_cu;
    }
    if (grid < 0) return;
    hipMemsetAsync((char*)d_ws + WS_CTL, 0, CTL_ZERO_BYTES, stream);
    KArgs p{};
    for (int i = 0; i < 31; ++i) p.in[i] = (const float*)d_in[i];
    p.out = (float*)d_out; p.ws = (unsigned char*)d_ws;
    void* args[] = {&p};
    hipError_t e = hipLaunchCooperativeKernel((const void*)fwd_megakernel, dim3(grid), dim3(512), args, LDS_BYTES, stream);
    if (e != hipSuccess) fprintf(stderr, "cooperative launch failed: %s (grid %d)\n", hipGetErrorString(e), grid);
}
```

```cpp
#include <hip/hip_runtime.h>
#include <hip/hip_cooperative_groups.h>
#include <cstdio>
#include <cstdint>
namespace cg = cooperative_groups;

#define LAS __attribute__((address_space(3)))
#define GAS __attribute__((address_space(1)))
typedef unsigned short bf16_t;
typedef short bf16x8 __attribute__((ext_vector_type(8)));
typedef short s16x4 __attribute__((ext_vector_type(4)));
typedef short v4i16_t __attribute__((ext_vector_type(4)));
typedef float f32x4 __attribute__((ext_vector_type(4)));
typedef float f32x2 __attribute__((ext_vector_type(2)));
typedef float f32x16 __attribute__((ext_vector_type(16)));
typedef unsigned u32x4 __attribute__((ext_vector_type(4)));
typedef unsigned u32x2 __attribute__((ext_vector_type(2)));
typedef __bf16 bf16x2_t __attribute__((ext_vector_type(2)));

constexpr int DM = 1024, NB = 8, SEQ = 2048, NL = 4, MTOK = NB * SEQ;
constexpr int NMEM = 256, MMEM = NB * NMEM;
constexpr int INW = 3072, DFF = 2816, XW = 512;
constexpr float LOG2E = 1.4426950408889634f;

constexpr size_t MiB = 1u << 20;
constexpr size_t WS_CTL = 0, CTL_ZERO_BYTES = 1 * MiB;
constexpr size_t WS_W = 1 * MiB;
constexpr size_t WS_Z = 30 * MiB;
constexpr size_t WS_ZC = 94 * MiB;
constexpr size_t WS_XB = 126 * MiB;
constexpr size_t WS_FQR = 94 * MiB, WS_FWY = 126 * MiB, WS_FNA = 158 * MiB, WS_FKH = 174 * MiB, WS_FP15 = 190 * MiB;
constexpr size_t WS_MIX = 192 * MiB;
constexpr size_t WS_OM = 224 * MiB, WS_KA = 240 * MiB, WS_KD = 256 * MiB, WS_KK = 272 * MiB, WS_V = 280 * MiB, WS_R = 288 * MiB;
constexpr size_t WS_GATE = 296 * MiB, WS_Y = 304 * MiB, WS_BON = 320 * MiB, WS_KV = 321 * MiB, WS_MEMN = 325 * MiB;
constexpr size_t WS_RP = 329 * MiB;
constexpr size_t WS_END = 342 * MiB;
constexpr size_t WS_Q = WS_Z, WS_O = WS_Z + 16 * MiB, WS_G = WS_Z;
constexpr int ZP = 1024;
constexpr size_t WS_KD2 = WS_Z + 32 * MiB, WS_VD2 = WS_Z + 48 * MiB;
constexpr size_t WO_IN = 0, WO_OUT = 3145728, WO_Q = 4194304, WO_KV = 4718592, WO_O = 5767168, WO_GU = 6291456, WO_DOWN = 12058624;
constexpr size_t WO_WUP = 14942208, WO_AUP = 14974976, WO_GUP = 15007744;
constexpr int CW_Q = 64;

constexpr int LDS_BYTES = 135168;

__device__ __forceinline__ float bf2f(unsigned b) { return __uint_as_float(b << 16); }
__device__ __forceinline__ unsigned pk2(float lo, float hi) { f32x2 v = {lo, hi}; bf16x2_t b = __builtin_convertvector(v, bf16x2_t); return __builtin_bit_cast(unsigned, b); }
__device__ __forceinline__ float bflo(unsigned u) { return __uint_as_float(u << 16); }
__device__ __forceinline__ float bfhi(unsigned u) { return __uint_as_float(u & 0xffff0000u); }
__device__ __forceinline__ float wave_sum(float v) {
#pragma unroll
    for (int o = 1; o < 64; o <<= 1) v += __shfl_xor(v, o);
    return v;
}
__device__ __forceinline__ float xhalf(float v) {
    return __shfl_xor(v, 32);
}
__device__ __forceinline__ float row_rstd(const float* rp, int row) {
    const f32x4* q = (const f32x4*)(rp + (size_t)row * 16); const f32x4 a = q[0], b = q[1], c = q[2], d = q[3];
    const float s = (((a[0] + a[1]) + (a[2] + a[3])) + ((b[0] + b[1]) + (b[2] + b[3]))) + (((c[0] + c[1]) + (c[2] + c[3])) + ((d[0] + d[1]) + (d[2] + d[3])));
    return rsqrtf(s * (1.f / 1024.f) + 1e-6f);
}
__device__ __forceinline__ float sigmoidf_(float x) { return __builtin_amdgcn_rcpf(1.f + __expf(-x)); }

__device__ __forceinline__ int hw_lane() { int l = (int)__builtin_amdgcn_mbcnt_hi(~0u, __builtin_amdgcn_mbcnt_lo(~0u, 0u)); asm volatile("" : "+v"(l)); return l; }
namespace pg8 {
constexpr int BM = 256, BK = 64, HALF = 128, HTB = HALF * BK * 2, NXCD = 8, WGM = 8;
__host__ __device__ __forceinline__ int lds_byte(int r, int c) { const int st = (r >> 4) * 2 + (c >> 5), rr = r & 15, cc = c & 31, ob = rr * 64 + cc * 2; return st * 1024 + (ob ^ (((ob >> 9) & 1) << 5)); }
__host__ __device__ __forceinline__ void stage_rc(int b, int& R, int& C) { const int st = b / 1024, sb = b % 1024, swz = sb ^ (((sb >> 9) & 1) << 5); R = (st >> 1) * 16 + swz / 64; C = (st & 1) * 32 + (swz % 64) / 2; }
__host__ __device__ __forceinline__ int perm32(int rho) { const int n = rho >> 4, i = rho & 15; return 8 * (i >> 2) + 4 * n + (i & 3); }
struct Unit { int pm, pn; };
struct Gemm { const bf16_t* A; const bf16_t* Bt; int M, N, K; };
struct StaticOrder {
    int nM, nN, nwg, G, c;
    __device__ void init(int M, int N, int G_, int c_) { nM = M / BM; nN = N / BM; nwg = nM * nN; G = G_; c = c_; }
    __device__ bool next(int i, Unit& u) const {
        const long L = (long)i * G + c; if (L >= nwg) return false;
        int wgid = (int)L; { const int q = nwg / NXCD, r = nwg % NXCD, xcd = wgid % NXCD, off = wgid / NXCD; wgid = (xcd < r ? xcd * (q + 1) : r * (q + 1) + (xcd - r) * q) + off; }
        const int nig = WGM * nN, gid = wgid / nig, fm = gid * WGM, gsz = (nM - fm) < WGM ? (nM - fm) : WGM;
        u.pm = fm + ((wgid % nig) % gsz); u.pn = (wgid % nig) / gsz; return true;
    }
};
template <class Epi>
__device__ __forceinline__ void gemm_phase(LAS unsigned char* lds, const Gemm g, const StaticOrder& S, const Epi& E) {
    int tid_ = threadIdx.x; asm volatile("" : "+v"(tid_));
    const int tid = tid_, wid = __builtin_amdgcn_readfirstlane(tid >> 6), lane = tid & 63, wr = wid >> 2, wc = wid & 3, fr = lane & 15, fq = lane >> 4;
    const int K = g.K, nt = K / BK;
    unsigned voffA[2], voffB[2];
#pragma unroll
    for (int i = 0; i < 2; ++i) { int R, C; stage_rc(tid * 16 + i * 8192, R, C); const int Rb = (R & ~31) + perm32(R & 31);
        voffA[i] = (unsigned)(R * K + C) * 2u; voffB[i] = (unsigned)(Rb * K + C) * 2u; }
    const size_t kstep = (size_t)(BK * 2);
    const size_t hstep = (size_t)HALF * K * 2;
    const size_t tstep = 2 * hstep;
    const unsigned ldsw = (unsigned)wid * 1024u;
    const int aoff = lds_byte(wr * 64 + fr, fq * 8), boff = lds_byte(wc * 32 + fr, fq * 8);
#define PG8_SA(b, h) (((b) * 2 + (h)) * HTB)
#define PG8_SB(b, h) ((4 + (b) * 2 + (h)) * HTB)
#define PG8_STAGE(bufoff, gbase, voff) do { _Pragma("unroll") for (int _i = 0; _i < 2; ++_i) \
        __builtin_amdgcn_global_load_lds((const unsigned*)((const char*)(gbase) + (voff)[_i]), (LAS unsigned*)(lds + (bufoff) + ldsw + _i * 8192), 16, 0, 0); } while (0)
#define PG8_LDA(dst, b, h) do { _Pragma("unroll") for (int m = 0; m < 4; ++m) _Pragma("unroll") for (int k = 0; k < 2; ++k) dst[m][k] = *(const LAS bf16x8*)(lds + PG8_SA(b, h) + aoff + m * 2048 + k * 1024); } while (0)
#define PG8_LDB(dst, b, h) do { _Pragma("unroll") for (int n = 0; n < 2; ++n) _Pragma("unroll") for (int k = 0; k < 2; ++k) dst[n][k] = *(const LAS bf16x8*)(lds + PG8_SB(b, h) + boff + n * 2048 + k * 1024); } while (0)
#define PG8_MMA(ai, bj, At, Bt) do { __builtin_amdgcn_s_setprio(1); _Pragma("unroll") for (int m = 0; m < 4; ++m) _Pragma("unroll") for (int n = 0; n < 2; ++n) _Pragma("unroll") for (int k = 0; k < 2; ++k) \
        acc[ai][bj][m][n] = __builtin_amdgcn_mfma_f32_16x16x32_bf16(Bt[n][k], At[m][k], acc[ai][bj][m][n], 0, 0, 0); __builtin_amdgcn_s_setprio(0); } while (0)
#define PG8_WAIT_V(n) asm volatile("s_waitcnt vmcnt(" #n ")" ::: "memory")
#define PG8_WAIT_L(n) asm volatile("s_waitcnt lgkmcnt(" #n ")" ::: "memory")
#define PG8_BAR __builtin_amdgcn_s_barrier()
#define PG8_SCHED __builtin_amdgcn_sched_barrier(0)
    Unit cur, nxt; int ui = 0;
    if (!S.next(0, cur)) return;
    f32x4 acc[2][2][4][2];
#pragma unroll
    for (int a = 0; a < 2; ++a)
#pragma unroll
        for (int b = 0; b < 2; ++b)
#pragma unroll
            for (int m = 0; m < 4; ++m)
#pragma unroll
                for (int n = 0; n < 2; ++n) acc[a][b][m][n] = (f32x4){0.f, 0.f, 0.f, 0.f};
    bf16x8 At[4][2], B0[2][2], B1[2][2];
    const char* cA = (const char*)g.A + (size_t)cur.pm * tstep; const char* cB = (const char*)g.Bt + (size_t)cur.pn * tstep;
    {
        PG8_STAGE(PG8_SB(0, 0), cB, voffB); PG8_STAGE(PG8_SB(0, 1), cB + hstep, voffB); PG8_STAGE(PG8_SA(0, 0), cA, voffA); PG8_STAGE(PG8_SA(0, 1), cA + hstep, voffA);
        if (wr == 1) PG8_BAR;
        PG8_WAIT_V(2); PG8_BAR;
        PG8_STAGE(PG8_SB(1, 0), cB + kstep, voffB); PG8_STAGE(PG8_SA(1, 0), cA + kstep, voffA); PG8_STAGE(PG8_SB(1, 1), cB + hstep + kstep, voffB);
        PG8_WAIT_V(6); PG8_BAR;
    }
    for (;;) {
        const bool has_next = S.next(ui + 1, nxt);
        const char* nA = has_next ? (const char*)g.A + (size_t)nxt.pm * tstep : cA; const char* nB = has_next ? (const char*)g.Bt + (size_t)nxt.pn * tstep : cB;
        for (int t = 0; t < nt; t += 2) {
            const bool last = (t == nt - 2);
            const char* a1 = cA + (size_t)(t + 1) * kstep;
            const char* a2 = last ? nA : cA + (size_t)(t + 2) * kstep; const char* b2 = last ? nB : cB + (size_t)(t + 2) * kstep;
            const char* a3 = a2 + kstep; const char* b3 = b2 + kstep;
            PG8_LDB(B0, 0, 0); PG8_LDB(B1, 0, 1); PG8_SCHED; PG8_LDA(At, 0, 0); PG8_STAGE(PG8_SA(1, 1), a1 + hstep, voffA);
            PG8_WAIT_V(8); PG8_WAIT_L(0); PG8_BAR; PG8_MMA(0, 0, At, B0); PG8_MMA(0, 1, At, B1); PG8_BAR; PG8_SCHED;
            PG8_LDA(At, 0, 1); PG8_STAGE(PG8_SB(0, 0), b2, voffB); PG8_STAGE(PG8_SB(0, 1), b2 + hstep, voffB); PG8_STAGE(PG8_SA(0, 0), a2, voffA);
            PG8_WAIT_V(8); PG8_WAIT_L(0); PG8_BAR; PG8_MMA(1, 0, At, B0); PG8_MMA(1, 1, At, B1); PG8_BAR; PG8_SCHED;
            PG8_LDB(B0, 1, 0); PG8_LDB(B1, 1, 1); PG8_SCHED; PG8_LDA(At, 1, 0); PG8_STAGE(PG8_SA(0, 1), a2 + hstep, voffA);
            PG8_WAIT_V(8); PG8_WAIT_L(0); PG8_BAR; PG8_MMA(0, 0, At, B0); PG8_MMA(0, 1, At, B1); PG8_BAR; PG8_SCHED;
            PG8_LDA(At, 1, 1); PG8_STAGE(PG8_SB(1, 0), b3, voffB); PG8_STAGE(PG8_SB(1, 1), b3 + hstep, voffB); PG8_STAGE(PG8_SA(1, 0), a3, voffA);
            PG8_WAIT_V(8); PG8_WAIT_L(0); PG8_BAR; PG8_MMA(1, 0, At, B0); PG8_MMA(1, 1, At, B1); PG8_BAR; PG8_SCHED;
        }
        if (wr == 0) PG8_BAR;
        E(acc, cur, wr, wc, fr, fq);
        if (!has_next) break;
#pragma unroll
        for (int a = 0; a < 2; ++a)
#pragma unroll
            for (int b = 0; b < 2; ++b)
#pragma unroll
                for (int m = 0; m < 4; ++m)
#pragma unroll
                    for (int n = 0; n < 2; ++n) acc[a][b][m][n] = (f32x4){0.f, 0.f, 0.f, 0.f};
        cur = nxt; cA = nA; cB = nB; ++ui;
        if (wr == 1) PG8_BAR;
    }
    PG8_WAIT_V(0);
    PG8_BAR;
#undef PG8_SA
#undef PG8_SB
#undef PG8_STAGE
#undef PG8_LDA
#undef PG8_LDB
#undef PG8_MMA
#undef PG8_WAIT_V
#undef PG8_WAIT_L
#undef PG8_BAR
#undef PG8_SCHED
}

struct EpiScaleBf16 {
    bf16_t* O; int ldc; const float* rowss; bf16_t* O2; int ldc2; int split_tile; bf16_t* KD2;
    const LAS float* tab; int pm0;
    __device__ __forceinline__ void operator()(const f32x4 (&acc)[2][2][4][2], const Unit& u, int wr, int wc, int fr, int fq) const {
        const bool hi = u.pn >= split_tile, mid = (split_tile == 8) && u.pn >= 4 && u.pn < 8;
        const int row0 = u.pm * BM + wr * 64 + fr, col0 = (hi ? u.pn - split_tile : u.pn) * BM + wc * 32 + 8 * fq;
        bf16_t* const Ob = hi ? O2 : O; const int ld = hi ? ldc2 : ldc;
#pragma unroll
        for (int ai = 0; ai < 2; ++ai)
#pragma unroll
            for (int m = 0; m < 4; ++m) { const int row = row0 + ai * HALF + m * 16;
                const float sc = !rowss ? 1.f : ((tab && u.pm == pm0) ? tab[row & 255] : row_rstd(rowss, row));
                bf16_t* rowp = Ob + (size_t)row * ld + col0;
#pragma unroll
                for (int bj = 0; bj < 2; ++bj) { const f32x4 v0 = acc[ai][bj][m][0] * sc, v1 = acc[ai][bj][m][1] * sc;
                    u32x4 w; w.x = pk2(v0[0], v0[1]); w.y = pk2(v0[2], v0[3]); w.z = pk2(v1[0], v1[1]); w.w = pk2(v1[2], v1[3]);
                    bf16_t* dst = rowp + bj * HALF;
                    if (mid) dst = KD2 + (u.pn >= 6 ? (size_t)8388608 : (size_t)0) + ((size_t)(((row >> 11) * 4 + 2 * (u.pn & 1) + bj) * 2048 + (row & 2047))) * 128 + wc * 32 + 8 * fq;
                    *(u32x4*)dst = w; } }
    }
};
struct EpiSwiGLU {
    bf16_t* O; const float* rowss; const LAS float* tab; int pm0;
    __device__ __forceinline__ void operator()(const f32x4 (&acc)[2][2][4][2], const Unit& u, int wr, int wc, int fr, int fq) const {
        const int row0 = u.pm * BM + wr * 64 + fr, col0 = u.pn * HALF + wc * 32 + 8 * fq;
#pragma unroll
        for (int ai = 0; ai < 2; ++ai)
#pragma unroll
            for (int m = 0; m < 4; ++m) { const int row = row0 + ai * HALF + m * 16;
                const float sc = (tab && u.pm == pm0) ? tab[row & 255] : row_rstd(rowss, row);
                float h[8];
#pragma unroll
                for (int n = 0; n < 2; ++n)
#pragma unroll
                    for (int j = 0; j < 4; ++j) { const float gt = acc[ai][0][m][n][j] * sc, up = acc[ai][1][m][n][j] * sc; h[n * 4 + j] = gt * __builtin_amdgcn_rcpf(1.f + __expf(-gt)) * up; }
                u32x4 w; w.x = pk2(h[0], h[1]); w.y = pk2(h[2], h[3]); w.z = pk2(h[4], h[5]); w.w = pk2(h[6], h[7]);
                *(u32x4*)(O + (size_t)row * DFF + col0) = w; }
    }
};
struct EpiResid {
    float* X; bf16_t* XB; float* rowss_next;
    __device__ __forceinline__ void operator()(const f32x4 (&acc)[2][2][4][2], const Unit& u, int wr, int wc, int fr, int fq) const {
        const int row0 = u.pm * BM + wr * 64 + fr, col0 = u.pn * BM + wc * 32 + 8 * fq;
#pragma unroll
        for (int ai = 0; ai < 2; ++ai)
#pragma unroll
            for (int m = 0; m < 4; ++m) { const int row = row0 + ai * HALF + m * 16; float ss = 0.f;
                float* xp = X + (size_t)row * DM + col0; bf16_t* bp = XB + (size_t)row * DM + col0;
#pragma unroll
                for (int bj = 0; bj < 2; ++bj) {
                    f32x4 x0 = *(f32x4*)(xp + bj * HALF), x1 = *(f32x4*)(xp + bj * HALF + 4);
                    x0 = x0 + acc[ai][bj][m][0]; x1 = x1 + acc[ai][bj][m][1];
                    *(f32x4*)(xp + bj * HALF) = x0; *(f32x4*)(xp + bj * HALF + 4) = x1;
                    ss += (x0[0] * x0[0] + x0[1] * x0[1]) + (x0[2] * x0[2] + x0[3] * x0[3]) + (x1[0] * x1[0] + x1[1] * x1[1]) + (x1[2] * x1[2] + x1[3] * x1[3]);
                    u32x4 w; w.x = pk2(x0[0], x0[1]); w.y = pk2(x0[2], x0[3]); w.z = pk2(x1[0], x1[1]); w.w = pk2(x1[2], x1[3]);
                    *(u32x4*)(bp + bj * HALF) = w; }
                ss += __shfl_xor(ss, 16); ss += __shfl_xor(ss, 32);
                if (fq == 0) rowss_next[(size_t)row * 16 + u.pn * 4 + wc] = ss; }
    }
};
}

struct KArgs { const float* in[31]; float* out; unsigned char* ws; };
#define CAS __attribute__((address_space(4)))
struct InProxy { const CAS unsigned long long* k; __device__ __forceinline__ const float* operator[](int i) const { return (const float*)k[i]; } };
struct Params { InProxy in; float* out; unsigned char* ws; };
__device__ __forceinline__ Params make_params() {
    unsigned long long kv = (unsigned long long)__builtin_amdgcn_kernarg_segment_ptr();
    asm volatile("" : "+s"(kv));
    const CAS unsigned long long* k = (const CAS unsigned long long*)kv;
    Params p; p.in.k = k; p.out = (float*)k[31]; p.ws = (unsigned char*)k[32]; return p;
}

struct Frame {
    LAS unsigned char* lds;
    int tid, lane, wave, G, bid;
};

#define REFRAME(F) do { int _t = threadIdx.x; asm volatile("" : "+v"(_t)); (F).tid = _t; (F).lane = _t & 63; (F).wave = __builtin_amdgcn_readfirstlane(_t >> 6); } while (0)
__device__ __forceinline__ void cvt_item(const float* W_, int K, int ldn, int nblk, bf16_t* WT_, const float* gain_, bool perm_gu, LAS float* scr, int item, int lane) {
    const GAS float* W = (const GAS float*)W_; const GAS float* gain = (const GAS float*)gain_; GAS bf16_t* WT = (GAS bf16_t*)WT_;
    const int kb = item / nblk, nb = item % nblk, k0 = 64 * kb, n0d = 32 * nb;
    const int n0s = perm_gu ? (((n0d & 255) >> 7) * DFF + (n0d >> 8) * 128 + (n0d & 127)) : n0d;
    float v[32];
#pragma unroll
    for (int i = 0; i < 32; ++i) v[i] = W[(size_t)(k0 + 2 * i + (lane >> 5)) * ldn + n0s + (lane & 31)];
    if (gain_) {
#pragma unroll
        for (int i = 0; i < 32; ++i) v[i] *= gain[k0 + 2 * i + (lane >> 5)];
    }
#pragma unroll
    for (int i = 0; i < 32; ++i) scr[(2 * i + (lane >> 5)) * 33 + (lane & 31)] = v[i];
    asm volatile("s_waitcnt lgkmcnt(0)" ::: "memory");
    const int c = lane & 7;
#pragma unroll
    for (int j = 0; j < 4; ++j) { const int n = (lane >> 3) + 8 * j; const LAS float* sp = scr + (8 * c) * 33 + n;
        u32x4 o; o.x = pk2(sp[0 * 33], sp[1 * 33]); o.y = pk2(sp[2 * 33], sp[3 * 33]); o.z = pk2(sp[4 * 33], sp[5 * 33]); o.w = pk2(sp[6 * 33], sp[7 * 33]);
        *(GAS u32x4*)(WT + (size_t)(n0d + n) * K + k0 + 8 * c) = o; }
    asm volatile("s_waitcnt lgkmcnt(0)" ::: "memory");
}
constexpr int CV_IN = 1536, CV_OUT = 512, CV_Q = 256, CV_KV = 512, CV_O = 256, CV_GU = 2816, CV_DOWN = 1408, CV_L = 8;
constexpr int CV_TOTAL = CV_IN + CV_OUT + CV_Q + CV_KV + CV_O + CV_GU + CV_DOWN + 2 * CV_L + 2 * CV_L + 16;

static_assert(CV_TOTAL % 8 == 0, "conversion items per layer");
constexpr int CV_A = CV_IN + 2 * CV_L + 2 * CV_L + 16, CV_B = CV_KV + CV_OUT + CV_Q + CV_O + CV_GU + CV_DOWN;
static_assert(CV_A % 8 == 0 && CV_B % 8 == 0 && CV_A + CV_B == CV_TOTAL, "conversion lists");
__device__ __forceinline__ void cvt_item_a(const Params& p, int l, bf16_t* wb, LAS float* scr, int it, int lane) {
    int r = it;
    if (r < CV_IN) { cvt_item(p.in[3] + (size_t)l * DM * INW, DM, INW, INW / 32, wb + WO_IN, p.in[2] + l * DM, false, scr, r, lane); return; } r -= CV_IN;
    if (r < 2 * CV_L) { const int d = r / CV_L; cvt_item(p.in[12] + ((size_t)l * 2 + d) * 64 * 256, 64, 256, 8, wb + WO_WUP + d * 256 * 64, nullptr, false, scr, r % CV_L, lane); return; } r -= 2 * CV_L;
    if (r < 2 * CV_L) { const int d = r / CV_L; cvt_item(p.in[14] + ((size_t)l * 2 + d) * 64 * 256, 64, 256, 8, wb + WO_AUP + d * 256 * 64, nullptr, false, scr, r % CV_L, lane); return; } r -= 2 * CV_L;
    cvt_item(p.in[15] + (size_t)l * 128 * 256, 128, 256, 8, wb + WO_GUP, nullptr, false, scr, r, lane);
}
__device__ __forceinline__ void cvt_item_b(const Params& p, int l, bf16_t* wb, LAS float* scr, int it, int lane) {
    int r = it;
    if (r < CV_KV) { cvt_item(p.in[25] + (size_t)l * DM * 1024, DM, 1024, 32, wb + WO_KV, nullptr, false, scr, r, lane); return; } r -= CV_KV;
    if (r < CV_OUT) { cvt_item(p.in[21] + (size_t)l * DM * DM, DM, DM, DM / 32, wb + WO_OUT, nullptr, false, scr, r, lane); return; } r -= CV_OUT;
    if (r < CV_Q) { cvt_item(p.in[24] + (size_t)l * DM * XW, DM, XW, XW / 32, wb + WO_Q, p.in[22] + l * DM, false, scr, r, lane); return; } r -= CV_Q;
    if (r < CV_O) { cvt_item(p.in[26] + (size_t)l * XW * DM, XW, DM, 32, wb + WO_O, nullptr, false, scr, r, lane); return; } r -= CV_O;
    if (r < CV_GU) { cvt_item(p.in[28] + (size_t)l * DM * 2 * DFF, DM, 2 * DFF, 2 * DFF / 32, wb + WO_GU, p.in[27] + l * DM, true, scr, r, lane); return; } r -= CV_GU;
    cvt_item(p.in[29] + (size_t)l * DFF * DM, DFF, DM, 32, wb + WO_DOWN, nullptr, false, scr, r, lane);
}

__device__ __forceinline__ s16x4 vtr(const LAS unsigned char* p) { return __builtin_bit_cast(s16x4, __builtin_amdgcn_ds_read_tr16_b64_v4i16((LAS v4i16_t*)p)); }
__device__ __forceinline__ int crow(int r, int hi) { return (r & 3) + 8 * (r >> 2) + 4 * hi; }

template <int W> __device__ __forceinline__ void tile_load(u32x4 (&r)[W / 64], const bf16_t* g, int pitch, int tid) {
#pragma unroll
    for (int i = 0; i < W / 64; ++i) { const int id = tid + i * 512, row = id / (W / 8), ch = id % (W / 8); r[i] = *(const GAS u32x4*)((const GAS bf16_t*)g + (size_t)row * pitch + ch * 8); }
}
template <int W, int STR> __device__ __forceinline__ void tile_store(const u32x4 (&r)[W / 64], LAS unsigned char* buf, int tid) {
#pragma unroll
    for (int i = 0; i < W / 64; ++i) { const int id = tid + i * 512, row = id / (W / 8), ch = id % (W / 8); *(LAS u32x4*)(buf + row * STR + ch * 16) = r[i]; }
}
template <int DQK> __device__ __forceinline__ void load_q(bf16x8 (&qf)[DQK / 16], const bf16_t* qrow, int h, float sc) {
#pragma unroll
    for (int ks = 0; ks < DQK / 16; ++ks) { const u32x4 v = *(const GAS u32x4*)((const GAS bf16_t*)qrow + 16 * ks + 8 * h);
        u32x4 o; o.x = pk2(bflo(v.x) * sc, bfhi(v.x) * sc); o.y = pk2(bflo(v.y) * sc, bfhi(v.y) * sc); o.z = pk2(bflo(v.z) * sc, bfhi(v.z) * sc); o.w = pk2(bflo(v.w) * sc, bfhi(v.w) * sc);
        qf[ks] = __builtin_bit_cast(bf16x8, o); }
}
template <int DQK, int KW, int DV, int MODE>
__device__ __forceinline__ void attn_loop(LAS unsigned char* lds, const bf16_t* Kg, int kpitch, const bf16_t* Vg, int vpitch, int ntiles,
                                          const bf16x8 (&qf)[DQK / 16], int koff, float nslope2, int qrel, float& m, float& lsum, f32x16 (&o)[DV / 32]) {
    constexpr int KSTR = (KW + 8) * 2, VSTR = DV * 2 + 64, KBUF = 64 * KSTR, VBUF = 64 * VSTR;
    int tid_ = threadIdx.x; asm volatile("" : "+v"(tid_));
    const int tid = tid_, lane = tid & 63, r = lane & 31, h = lane >> 5;
    LAS unsigned char* K0 = lds; LAS unsigned char* V0 = lds + 2 * KBUF;
    u32x4 kr[KW / 64], vr[DV / 64];
    tile_load<KW>(kr, Kg, kpitch, tid); tile_load<DV>(vr, Vg, vpitch, tid);
    tile_store<KW, KSTR>(kr, K0, tid); tile_store<DV, VSTR>(vr, V0, tid);
    __syncthreads();
    const int vlane = ((lane & 15) >> 2) * VSTR + (16 * ((lane >> 4) & 1) + 4 * (lane & 3)) * 2 + 4 * h * VSTR;
    for (int t = 0; t < ntiles; ++t) {
        const int cur = t & 1;
        if (t + 1 < ntiles) { tile_load<KW>(kr, Kg + (size_t)(t + 1) * 64 * kpitch, kpitch, tid); tile_load<DV>(vr, Vg + (size_t)(t + 1) * 64 * vpitch, vpitch, tid); }
        const LAS unsigned char* Kb = K0 + cur * KBUF + r * KSTR + (koff + 8 * h) * 2;
        const LAS unsigned char* Vb = V0 + cur * VBUF + vlane;
        f32x16 s0, s1;
#pragma unroll
        for (int i = 0; i < 16; ++i) { s0[i] = 0.f; s1[i] = 0.f; }
#pragma unroll
        for (int ks = 0; ks < DQK / 16; ++ks) {
            const bf16x8 k0 = *(const LAS bf16x8*)(Kb + ks * 32), k1 = *(const LAS bf16x8*)(Kb + 32 * KSTR + ks * 32);
            s0 = __builtin_amdgcn_mfma_f32_32x32x16_bf16(k0, qf[ks], s0, 0, 0, 0);
            s1 = __builtin_amdgcn_mfma_f32_32x32x16_bf16(k1, qf[ks], s1, 0, 0, 0);
        }
        float Aoff = 0.f;
        if (MODE >= 1) {
            const int qrel0 = __builtin_amdgcn_readfirstlane(qrel - r);
            const int T0 = t * 64;
            if (MODE == 1 && (T0 + 64 <= qrel0 || T0 > qrel0 + 31)) {
                const bool left = (T0 + 64 <= qrel0);
                const float sl = left ? -nslope2 : nslope2;
                Aoff = left ? nslope2 * (float)(qrel - T0 - 4 * h) : nslope2 * (float)(T0 + 4 * h - qrel);
#pragma unroll
                for (int i = 0; i < 16; ++i) { s0[i] = __builtin_fmaf(sl, (float)((i & 3) + 8 * (i >> 2)), s0[i]); s1[i] = __builtin_fmaf(sl, (float)(32 + (i & 3) + 8 * (i >> 2)), s1[i]); }
            } else {
                const float base = (float)(T0 + 4 * h - qrel);
#pragma unroll
                for (int i = 0; i < 16; ++i) {
                    const float d0 = fabsf(base + (float)((i & 3) + 8 * (i >> 2))), d1 = fabsf(base + (float)(32 + (i & 3) + 8 * (i >> 2)));
                    s0[i] = __builtin_fmaf(d0, nslope2, s0[i]); s1[i] = __builtin_fmaf(d1, nslope2, s1[i]);
                    if (MODE == 2) { if (d0 > 128.f) s0[i] = -1e30f; if (d1 > 128.f) s1[i] = -1e30f; }
                }
            }
        }
        float mx = fmaxf(s0[0], s1[0]);
#pragma unroll
        for (int i = 1; i < 16; ++i) mx = fmaxf(fmaxf(mx, s0[i]), s1[i]);
        mx += Aoff;
        mx = fmaxf(mx, xhalf(mx));
        const float mnew = fmaxf(m, mx);
        if (__builtin_amdgcn_ballot_w64(mnew > m) != 0ull) {
            const float alpha = __builtin_amdgcn_exp2f(m - mnew);
            lsum *= alpha;
#pragma unroll
            for (int d = 0; d < DV / 32; ++d) o[d] = o[d] * alpha;
        }
        m = mnew;
        const float mm = mnew - Aoff;
        float rs = 0.f;
#pragma unroll
        for (int i = 0; i < 16; ++i) { s0[i] = __builtin_amdgcn_exp2f(s0[i] - mm); s1[i] = __builtin_amdgcn_exp2f(s1[i] - mm); rs += s0[i] + s1[i]; }
        lsum += rs;
        bf16x8 pf[4];
#pragma unroll
        for (int s2 = 0; s2 < 2; ++s2) {
            u32x4 a, b;
            a.x = pk2(s0[8 * s2 + 0], s0[8 * s2 + 1]); a.y = pk2(s0[8 * s2 + 2], s0[8 * s2 + 3]); a.z = pk2(s0[8 * s2 + 4], s0[8 * s2 + 5]); a.w = pk2(s0[8 * s2 + 6], s0[8 * s2 + 7]);
            b.x = pk2(s1[8 * s2 + 0], s1[8 * s2 + 1]); b.y = pk2(s1[8 * s2 + 2], s1[8 * s2 + 3]); b.z = pk2(s1[8 * s2 + 4], s1[8 * s2 + 5]); b.w = pk2(s1[8 * s2 + 6], s1[8 * s2 + 7]);
            pf[s2] = __builtin_bit_cast(bf16x8, a); pf[2 + s2] = __builtin_bit_cast(bf16x8, b);
        }
#pragma unroll
        for (int d = 0; d < DV / 32; ++d) {
#pragma unroll
            for (int kk = 0; kk < 4; ++kk) {
                const s16x4 lo = vtr(Vb + (16 * kk) * VSTR + d * 64), hi = vtr(Vb + (16 * kk + 8) * VSTR + d * 64);
                const bf16x8 vf = {lo[0], lo[1], lo[2], lo[3], hi[0], hi[1], hi[2], hi[3]};
                o[d] = __builtin_amdgcn_mfma_f32_32x32x16_bf16(vf, pf[kk], o[d], 0, 0, 0);
            }
        }
        if (t + 1 < ntiles) { tile_store<KW, KSTR>(kr, K0 + (cur ^ 1) * KBUF, tid); tile_store<DV, VSTR>(vr, V0 + (cur ^ 1) * VBUF, tid); }
        __syncthreads();
    }
}
__device__ __forceinline__ int swz(int row) { return ((row & 3) << 2) | ((row >> 2) & 3); }
template <int DQK, int MODE, int pitch, int voff>
__device__ __forceinline__ void attn_loop_dma(LAS unsigned char* lds, const int wave, const bf16_t* Kg, int ntiles,
                                              const bf16x8 (&qf)[DQK / 16], int koff, float nslope2, int qrel, float& m, float& lsum, f32x16 (&o)[4]) {
    constexpr int DV = 128, STAGE = 32768, VOFFB = 16384;
    const int lane = hw_lane(), r = lane & 31, h = lane >> 5;
    unsigned gk[2];
#pragma unroll
    for (int i = 0; i < 2; ++i) { const int row = 4 * (2 * wave + i) + (lane >> 4), c = (lane & 15) ^ swz(row); gk[i] = (unsigned)(row * pitch + c * 8); }
    unsigned kad[DQK / 16], vad[4][2];
#pragma unroll
    for (int ks = 0; ks < DQK / 16; ++ks) kad[ks] = (unsigned)(r * 256 + 16 * (((koff >> 3) + 2 * ks + h) ^ swz(r)));
    { const int q_ = (lane & 15) >> 2, pp = lane & 3, g1 = (lane >> 4) & 1;
#pragma unroll
      for (int d = 0; d < 4; ++d)
#pragma unroll
          for (int hi = 0; hi < 2; ++hi) { const int f = (q_ << 2) | ((2 * hi + h) & 3), c = (4 * d + 2 * g1 + (pp >> 1)) ^ f;
              vad[d][hi] = (unsigned)(VOFFB + (4 * h + q_) * 256 + 16 * c + 8 * (pp & 1) + hi * 2048); } }
#define ATT_DMA(tt, st) do { const bf16_t* kg_ = Kg + (size_t)(tt) * 64 * pitch; _Pragma("unroll") for (int i_ = 0; i_ < 2; ++i_) { \
        __builtin_amdgcn_global_load_lds((const unsigned*)(kg_ + gk[i_]), (LAS unsigned*)(lds + (st) * STAGE + (2 * wave + i_) * 1024), 16, 0, 0); \
        __builtin_amdgcn_global_load_lds((const unsigned*)(kg_ + voff + gk[i_]), (LAS unsigned*)(lds + (st) * STAGE + VOFFB + (2 * wave + i_) * 1024), 16, 0, 0); } } while (0)
    ATT_DMA(0, 0);
    if (ntiles > 1) ATT_DMA(1, 1);
    if (ntiles > 2) { ATT_DMA(2, 2); asm volatile("s_waitcnt vmcnt(4)" ::: "memory"); } else asm volatile("s_waitcnt vmcnt(0)" ::: "memory");
    __builtin_amdgcn_s_barrier();
    f32x16 s0, s1;
#pragma unroll
    for (int i = 0; i < 16; ++i) { s0[i] = 0.f; s1[i] = 0.f; }
#pragma unroll
    for (int ks = 0; ks < DQK / 16; ++ks) {
        const bf16x8 k0 = *(const LAS bf16x8*)(lds + kad[ks]), k1 = *(const LAS bf16x8*)(lds + kad[ks] + 8192);
        s0 = __builtin_amdgcn_mfma_f32_32x32x16_bf16(k0, qf[ks], s0, 0, 0, 0);
        s1 = __builtin_amdgcn_mfma_f32_32x32x16_bf16(k1, qf[ks], s1, 0, 0, 0);
    }
#define LDS_RD128(dst, addr, off) asm volatile("ds_read_b128 %0, %1 offset:%c2" : "=&v"(dst) : "v"(addr), "i"(off) : "memory")
#define LDS_RDTR(dst, addr, off) asm volatile("ds_read_b64_tr_b16 %0, %1 offset:%c2" : "=&v"(dst) : "v"(addr), "i"(off) : "memory")
#define LDS_WAIT0() do { asm volatile("s_waitcnt lgkmcnt(0)" ::: "memory"); __builtin_amdgcn_sched_barrier(0); } while (0)
    for (int t = 0; t < ntiles; ++t) {
        if (t + 3 < ntiles) ATT_DMA(t + 3, (t + 3) & 3);
        const unsigned sba = (unsigned)(size_t)(lds + (t & 3) * STAGE), sna = (unsigned)(size_t)(lds + ((t + 1) & 3) * STAGE);
        constexpr int KH = (DQK == 64) ? 4 : 4;
        bf16x8 kf0[KH], kf1[KH];
        s16x4 va_lo[4], va_hi[4], vb_lo[4], vb_hi[4];
        if (DQK == 64) {
#pragma unroll
            for (int ks = 0; ks < KH; ++ks) { const unsigned ka = sna + kad[ks]; LDS_RD128(kf0[ks], ka, 0); } }
        __builtin_amdgcn_sched_barrier(0);
        float Aoff = 0.f;
        if (MODE >= 1) {
            const int qrel0 = __builtin_amdgcn_readfirstlane(qrel - r);
            const int T0 = t * 64;
            if (MODE == 1 && (T0 + 64 <= qrel0 || T0 > qrel0 + 31)) {
                const bool left = (T0 + 64 <= qrel0);
                const float sl = left ? -nslope2 : nslope2;
                Aoff = left ? nslope2 * (float)(qrel - T0 - 4 * h) : nslope2 * (float)(T0 + 4 * h - qrel);
#pragma unroll
                for (int i = 0; i < 16; ++i) { s0[i] = __builtin_fmaf(sl, (float)((i & 3) + 8 * (i >> 2)), s0[i]); s1[i] = __builtin_fmaf(sl, (float)(32 + (i & 3) + 8 * (i >> 2)), s1[i]); }
            } else {
                const float base = (float)(T0 + 4 * h - qrel);
#pragma unroll
                for (int i = 0; i < 16; ++i) {
                    const float d0 = fabsf(base + (float)((i & 3) + 8 * (i >> 2))), d1 = fabsf(base + (float)(32 + (i & 3) + 8 * (i >> 2)));
                    s0[i] = __builtin_fmaf(d0, nslope2, s0[i]); s1[i] = __builtin_fmaf(d1, nslope2, s1[i]);
                    if (MODE == 2) { if (d0 > 128.f) s0[i] = -1e30f; if (d1 > 128.f) s1[i] = -1e30f; }
                }
            }
        }
        float mx = fmaxf(s0[0], s1[0]);
#pragma unroll
        for (int i = 1; i < 16; ++i) mx = fmaxf(fmaxf(mx, s0[i]), s1[i]);
        mx += Aoff;
        mx = fmaxf(mx, xhalf(mx));
        const float mnew = fmaxf(m, mx);
        if (__builtin_amdgcn_ballot_w64(mnew > m) != 0ull) {
            const float alpha = __builtin_amdgcn_exp2f(m - mnew);
            lsum *= alpha;
#pragma unroll
            for (int d = 0; d < DV / 32; ++d) o[d] = o[d] * alpha;
        }
        m = mnew;
        const float mm = mnew - Aoff;
        float rs = 0.f;
#pragma unroll
        for (int i = 0; i < 16; ++i) { s0[i] = __builtin_amdgcn_exp2f(s0[i] - mm); s1[i] = __builtin_amdgcn_exp2f(s1[i] - mm); rs += s0[i] + s1[i]; }
        lsum += rs;
        bf16x8 pf[4];
#pragma unroll
        for (int s2 = 0; s2 < 2; ++s2) {
            u32x4 a, b;
            a.x = pk2(s0[8 * s2 + 0], s0[8 * s2 + 1]); a.y = pk2(s0[8 * s2 + 2], s0[8 * s2 + 3]); a.z = pk2(s0[8 * s2 + 4], s0[8 * s2 + 5]); a.w = pk2(s0[8 * s2 + 6], s0[8 * s2 + 7]);
            b.x = pk2(s1[8 * s2 + 0], s1[8 * s2 + 1]); b.y = pk2(s1[8 * s2 + 2], s1[8 * s2 + 3]); b.z = pk2(s1[8 * s2 + 4], s1[8 * s2 + 5]); b.w = pk2(s1[8 * s2 + 6], s1[8 * s2 + 7]);
            pf[s2] = __builtin_bit_cast(bf16x8, a); pf[2 + s2] = __builtin_bit_cast(bf16x8, b);
        }
        LDS_WAIT0();
        if (DQK == 64) {
#pragma unroll
            for (int ks = 0; ks < KH; ++ks) { const unsigned ka = sna + kad[ks]; LDS_RD128(kf1[ks], ka, 8192); } }
        { const unsigned alo = sba + vad[0][0], ahi = sba + vad[0][1];
#pragma unroll
          for (int kk = 0; kk < 4; ++kk) { LDS_RDTR(va_lo[kk], alo, kk * 4096); LDS_RDTR(va_hi[kk], ahi, kk * 4096); } }
        __builtin_amdgcn_sched_barrier(0);
        f32x16 n0, n1;
#pragma unroll
        for (int i = 0; i < 16; ++i) { n0[i] = 0.f; n1[i] = 0.f; }
#pragma unroll
        for (int g = 0; g < DQK / 64; ++g) {
            if (DQK != 64) {
#pragma unroll
                for (int ks = 0; ks < KH; ++ks) { const unsigned ka = sna + kad[g * KH + ks]; LDS_RD128(kf0[ks], ka, 0); LDS_RD128(kf1[ks], ka, 8192); }
                LDS_WAIT0(); }
#pragma unroll
            for (int ks = 0; ks < KH; ++ks) n0 = __builtin_amdgcn_mfma_f32_32x32x16_bf16(kf0[ks], qf[g * KH + ks], n0, 0, 0, 0);
            if (DQK == 64) LDS_WAIT0();
#pragma unroll
            for (int ks = 0; ks < KH; ++ks) n1 = __builtin_amdgcn_mfma_f32_32x32x16_bf16(kf1[ks], qf[g * KH + ks], n1, 0, 0, 0);
        }
#define PV_BLOCK(d, lo, hi) do { _Pragma("unroll") for (int kk = 0; kk < 4; ++kk) { const bf16x8 vf = {lo[kk][0], lo[kk][1], lo[kk][2], lo[kk][3], hi[kk][0], hi[kk][1], hi[kk][2], hi[kk][3]}; \
            o[d] = __builtin_amdgcn_mfma_f32_32x32x16_bf16(vf, pf[kk], o[d], 0, 0, 0); } } while (0)
#define V_ISSUE(d, lo, hi) do { const unsigned alo_ = sba + vad[d][0], ahi_ = sba + vad[d][1]; _Pragma("unroll") for (int kk = 0; kk < 4; ++kk) { LDS_RDTR(lo[kk], alo_, kk * 4096); LDS_RDTR(hi[kk], ahi_, kk * 4096); } } while (0)
        LDS_WAIT0();
        V_ISSUE(1, vb_lo, vb_hi); __builtin_amdgcn_sched_barrier(0);
        PV_BLOCK(0, va_lo, va_hi);
        LDS_WAIT0();
        V_ISSUE(2, va_lo, va_hi); __builtin_amdgcn_sched_barrier(0);
        PV_BLOCK(1, vb_lo, vb_hi);
        LDS_WAIT0();
        V_ISSUE(3, vb_lo, vb_hi); __builtin_amdgcn_sched_barrier(0);
        PV_BLOCK(2, va_lo, va_hi);
        LDS_WAIT0();
        PV_BLOCK(3, vb_lo, vb_hi);
#undef PV_BLOCK
#undef V_ISSUE
        s0 = n0; s1 = n1;
        if (t + 3 < ntiles) asm volatile("s_waitcnt vmcnt(4)" ::: "memory"); else asm volatile("s_waitcnt vmcnt(0)" ::: "memory");
        __builtin_amdgcn_s_barrier();
    }
#undef LDS_RD128
#undef LDS_RDTR
#undef LDS_WAIT0
#undef ATT_DMA
}
template <int DV> __device__ __forceinline__ void store_o(const f32x16 (&o)[DV / 32], float sc, bf16_t* orow, int h) {
#pragma unroll
    for (int d = 0; d < DV / 32; ++d)
#pragma unroll
        for (int g4 = 0; g4 < 4; ++g4) { u32x2 w; w.x = pk2(o[d][4 * g4] * sc, o[d][4 * g4 + 1] * sc); w.y = pk2(o[d][4 * g4 + 2] * sc, o[d][4 * g4 + 3] * sc);
            *(GAS u32x2*)((GAS bf16_t*)orow + 32 * d + 8 * g4 + 4 * h) = w; }
}

__device__ __forceinline__ void win_unit(Frame& F, const Params& p, int l, int u) {
    REFRAME(F);
    const bf16_t* Z = (const bf16_t*)(p.ws + WS_Z); bf16_t* MIX = (bf16_t*)(p.ws + WS_MIX);
    const int b = u >> 5, kvh = (u >> 4) & 1, nb = u & 15, r = F.lane & 31, h = F.lane >> 5;
    const int g = F.wave >> 2, hq = kvh * 2 + g, qpos = nb * 128 + (F.wave & 3) * 32 + r;
    const size_t tok = (size_t)b * SEQ + qpos;
    bf16x8 qf[4]; load_q<64>(qf, Z + tok * ZP + hq * 64, h, 0.125f * LOG2E);
    const int first = (2 * nb - 2 < 0) ? 0 : 2 * nb - 2, lastx = (2 * nb + 4 > 32) ? 32 : 2 * nb + 4, nt = lastx - first;
    const float slope = exp2f(-(float)(2 * hq + 1));
    float m = p.in[4][l * 4 + hq] * LOG2E, ls = (h == 0) ? 1.f : 0.f;
    f32x16 o[2];
#pragma unroll
    for (int d = 0; d < 2; ++d)
#pragma unroll
        for (int i = 0; i < 16; ++i) o[d][i] = 0.f;
    const bf16_t* Kg = Z + ((size_t)b * SEQ + first * 64) * ZP + 256 + kvh * 64;
    attn_loop<64, 64, 64, 2>(F.lds, Kg, ZP, Kg + 128, ZP, nt, qf, 0, -slope * LOG2E, qpos - first * 64, m, ls, o);
    const float lt = ls + xhalf(ls);
    store_o<64>(o, 1.f / lt, MIX + tok * DM + hq * 64, h);
}
__device__ __forceinline__ void diff_unit(Frame& F, const Params& p, int l, int u) {
    REFRAME(F);
    const bf16_t* Z = (const bf16_t*)(p.ws + WS_Z); bf16_t* MIX = (bf16_t*)(p.ws + WS_MIX);
    const int b = u >> 6, hh = (u >> 4) & 3, qb = u & 15, r = F.lane & 31, h = F.lane >> 5;
    const int c = F.wave >> 2, qpos = qb * 128 + (F.wave & 3) * 32 + r;
    const size_t tok = (size_t)b * SEQ + qpos;
    float lam, lam_init;
    {
        const float a1 = wave_sum(p.in[5][l * 64 + F.lane] * p.in[6][l * 64 + F.lane]), a2 = wave_sum(p.in[7][l * 64 + F.lane] * p.in[8][l * 64 + F.lane]);
        lam_init = 0.8f - 0.6f * expf(-0.3f * (float)l);
        lam = expf(a1) - expf(a2) + lam_init;
    }
    bf16x8 qf[4]; load_q<64>(qf, Z + tok * ZP + 512 + hh * 128 + c * 64, h, 0.125f * LOG2E);
    const float slope = exp2f(-(float)(2 * hh + 2));
    float m = -1e30f, ls = 0.f;
    f32x16 o[4];
#pragma unroll
    for (int d = 0; d < 4; ++d)
#pragma unroll
        for (int i = 0; i < 16; ++i) o[d][i] = 0.f;
    const bf16_t* Kg = (const bf16_t*)(p.ws + WS_KD2) + (size_t)(b * 4 + hh) * 2048 * 128;
    attn_loop_dma<64, 1, 128, 8388608>(F.lds, F.wave, Kg, 32, qf, c * 64, -slope * LOG2E, qpos, m, ls, o);
    const float inv = 1.f / (ls + xhalf(ls));
    LAS float* comb = (LAS float*)F.lds + (size_t)(F.wave & 3) * 64 * 64 + F.lane;
    if (c == 1) {
#pragma unroll
        for (int d = 0; d < 4; ++d)
#pragma unroll
            for (int i = 0; i < 16; ++i) comb[(d * 16 + i) * 64] = o[d][i] * inv;
    }
    __syncthreads();
    if (c == 0) {
        float ss = 0.f;
#pragma unroll
        for (int d = 0; d < 4; ++d)
#pragma unroll
            for (int i = 0; i < 16; ++i) { const float a = o[d][i] * inv - lam * comb[(d * 16 + i) * 64]; o[d][i] = a; ss += a * a; }
        ss += xhalf(ss);
        const float rn = rsqrtf(ss * (1.f / 128.f) + 1e-6f) * (1.f - lam_init);
        const float* sg = p.in[9] + l * 128;
        bf16_t* orow = MIX + tok * DM + 256 + hh * 128;
        f32x4 ggv[4][4];
#pragma unroll
        for (int d = 0; d < 4; ++d)
#pragma unroll
            for (int g4 = 0; g4 < 4; ++g4) ggv[d][g4] = *(const GAS f32x4*)((const GAS float*)sg + 32 * d + 8 * g4 + 4 * h);
#pragma unroll
        for (int d = 0; d < 4; ++d)
#pragma unroll
            for (int g4 = 0; g4 < 4; ++g4) { const int dv = 32 * d + 8 * g4 + 4 * h; const f32x4 gg = ggv[d][g4];
                u32x2 w; w.x = pk2(o[d][4 * g4] * rn * gg[0], o[d][4 * g4 + 1] * rn * gg[1]); w.y = pk2(o[d][4 * g4 + 2] * rn * gg[2], o[d][4 * g4 + 3] * rn * gg[3]);
                *(GAS u32x2*)((GAS bf16_t*)orow + dv) = w; }
    }
    __syncthreads();
}
__device__ __forceinline__ void cross_unit(Frame& F, const Params& p, int u) {
    REFRAME(F);
    const bf16_t* Q = (const bf16_t*)(p.ws + WS_Q); const bf16_t* KV = (const bf16_t*)(p.ws + WS_KV); bf16_t* O = (bf16_t*)(p.ws + WS_O);
    const int b = u >> 5, hd = (u >> 3) & 3, qb = u & 7, r = F.lane & 31, h = F.lane >> 5;
    const size_t tok = (size_t)b * SEQ + qb * 256 + F.wave * 32 + r;
    bf16x8 qf[8]; load_q<128>(qf, Q + tok * XW + hd * 128, h, 0.08838834764831845f * LOG2E);
    float m = -1e30f, ls = 0.f;
    f32x16 o[4];
#pragma unroll
    for (int d = 0; d < 4; ++d)
#pragma unroll
        for (int i = 0; i < 16; ++i) o[d][i] = 0.f;
    const bf16_t* Kg = KV + ((size_t)b * NMEM) * 1024 + hd * 128;
    attn_loop_dma<128, 0, 1024, 512>(F.lds, F.wave, Kg, 4, qf, 0, 0.f, 0, m, ls, o);
    const float lt = ls + xhalf(ls);
    store_o<128>(o, 1.f / lt, O + tok * XW + hd * 128, h);
}

constexpr int CF_STR = 772, PREP_AW = 32 * CF_STR * 4, PREP_AA = PREP_AW + 32 * 72 * 2, PREP_AG = PREP_AA + 32 * 72 * 2;
__device__ __forceinline__ void prep_unit(Frame& F, const Params& p, int l, const bf16_t* wb, int u) {
    REFRAME(F);
    const bf16_t* ZC = (const bf16_t*)(p.ws + WS_ZC);
    const int t0 = u * 32, b = t0 / SEQ;
    LAS float* CF = (LAS float*)F.lds; LAS bf16_t* AW = (LAS bf16_t*)(F.lds + PREP_AW); LAS bf16_t* AA = (LAS bf16_t*)(F.lds + PREP_AA); LAS bf16_t* AG = (LAS bf16_t*)(F.lds + PREP_AG);
    const float* conv = p.in[10] + (size_t)l * 3 * 1024;
    LAS float* PAR = (LAS float*)(F.lds + PREP_AG + 32 * 136 * 2);
    if (F.tid < 448) { const int i = F.tid; const GAS f32x4* src;
        if (i < 64) src = (const GAS f32x4*)((const GAS float*)p.in[16] + l * 256) + i;
        else if (i < 128) src = (const GAS f32x4*)((const GAS float*)p.in[17] + l * 256) + (i - 64);
        else if (i < 192) src = (const GAS f32x4*)((const GAS float*)p.in[18] + l * 256) + (i - 128);
        else if (i < 320) src = (const GAS f32x4*)((const GAS float*)p.in[11] + l * 512) + (i - 192);
        else src = (const GAS f32x4*)((const GAS float*)p.in[13] + l * 512) + (i - 320);
        ((LAS f32x4*)PAR)[i] = *src; }
#pragma unroll 4
    for (int i = 0; i < 8; ++i) {
        const int id = F.tid + i * 512, tk = id >> 7, ch = id & 127, tg = t0 + tk, tpos = tg - b * SEQ;
        const GAS bf16_t* zp = (const GAS bf16_t*)ZC + (size_t)tg * 1024 + ch * 8;
        const u32x4 zc = *(const GAS u32x4*)zp;
        u32x4 zl = {0u, 0u, 0u, 0u}, zr = {0u, 0u, 0u, 0u};
        if (tpos > 0) zl = *(const GAS u32x4*)(zp - 1024);
        if (tpos < SEQ - 1) zr = *(const GAS u32x4*)(zp + 1024);
        float v[8];
#pragma unroll
        for (int q = 0; q < 4; ++q) {
            const f32x2 c0 = *(const GAS f32x2*)((const GAS float*)conv + ch * 8 + 2 * q), c1 = *(const GAS f32x2*)((const GAS float*)conv + 1024 + ch * 8 + 2 * q), c2 = *(const GAS f32x2*)((const GAS float*)conv + 2048 + ch * 8 + 2 * q);
            v[2 * q] = bflo(zl[q]) * c0[0] + bflo(zc[q]) * c1[0] + bflo(zr[q]) * c2[0];
            v[2 * q + 1] = bfhi(zl[q]) * c0[1] + bfhi(zc[q]) * c1[1] + bfhi(zr[q]) * c2[1];
        }
        if (ch < 96) { *(LAS f32x4*)(CF + tk * CF_STR + ch * 8) = (f32x4){v[0], v[1], v[2], v[3]}; *(LAS f32x4*)(CF + tk * CF_STR + ch * 8 + 4) = (f32x4){v[4], v[5], v[6], v[7]}; }
        else {
            u32x4 w;
            if (ch < 104) {
#pragma unroll
                for (int q = 0; q < 8; ++q) v[q] = 1.f - 2.f * __builtin_amdgcn_rcpf(__expf(2.f * v[q]) + 1.f);
                w.x = pk2(v[0], v[1]); w.y = pk2(v[2], v[3]); w.z = pk2(v[4], v[5]); w.w = pk2(v[6], v[7]);
                *(LAS u32x4*)(AW + tk * 72 + (ch - 96) * 8) = w;
            } else if (ch < 112) {
                w.x = pk2(v[0], v[1]); w.y = pk2(v[2], v[3]); w.z = pk2(v[4], v[5]); w.w = pk2(v[6], v[7]);
                *(LAS u32x4*)(AA + tk * 72 + (ch - 104) * 8) = w;
            } else {
#pragma unroll
                for (int q = 0; q < 8; ++q) v[q] = sigmoidf_(v[q]);
                w.x = pk2(v[0], v[1]); w.y = pk2(v[2], v[3]); w.z = pk2(v[4], v[5]); w.w = pk2(v[6], v[7]);
                *(LAS u32x4*)(AG + tk * 136 + (ch - 112) * 8) = w;
            }
        }
    }
    __syncthreads();
    const int hh = F.wave & 3, dir = F.wave >> 2, tk = F.lane & 31, h2 = F.lane >> 5;
    const size_t tok = (size_t)t0 + tk;
    const GAS bf16_t* Wup = (const GAS bf16_t*)wb + WO_WUP + (size_t)(dir * 256 + hh * 64) * 64;
    const GAS bf16_t* Aup = (const GAS bf16_t*)wb + WO_AUP + (size_t)(dir * 256 + hh * 64) * 64;
    f32x16 aw[2], aa[2];
#pragma unroll
    for (int rb = 0; rb < 2; ++rb)
#pragma unroll
        for (int i = 0; i < 16; ++i) { aw[rb][i] = 0.f; aa[rb][i] = 0.f; }
#pragma unroll
    for (int ks = 0; ks < 4; ++ks) {
        const bf16x8 bw = *(const LAS bf16x8*)(AW + tk * 72 + 16 * ks + 8 * h2), ba = *(const LAS bf16x8*)(AA + tk * 72 + 16 * ks + 8 * h2);
#pragma unroll
        for (int rb = 0; rb < 2; ++rb) {
            const bf16x8 fw = *(const GAS bf16x8*)(Wup + (size_t)(rb * 32 + tk) * 64 + 16 * ks + 8 * h2), fa = *(const GAS bf16x8*)(Aup + (size_t)(rb * 32 + tk) * 64 + 16 * ks + 8 * h2);
            aw[rb] = __builtin_amdgcn_mfma_f32_32x32x16_bf16(fw, bw, aw[rb], 0, 0, 0);
            aa[rb] = __builtin_amdgcn_mfma_f32_32x32x16_bf16(fa, ba, aa[rb], 0, 0, 0);
        }
    }
    const LAS float* k_k = PAR + hh * 64; const LAS float* k_a = PAR + 256 + hh * 64; const LAS float* r_k = PAR + 512 + hh * 64;
    const LAS float* w0 = PAR + 768 + dir * 256 + hh * 64; const LAS float* a0 = PAR + 1280 + dir * 256 + hh * 64;
    float ssq = 0.f;
#pragma unroll
    for (int rb = 0; rb < 2; ++rb)
#pragma unroll
        for (int g4 = 0; g4 < 4; ++g4) { const int c0 = rb * 32 + 8 * g4 + 4 * h2;
            const f32x4 kv = *(const LAS f32x4*)(CF + tk * CF_STR + 256 + hh * 64 + c0), kkw = *(const LAS f32x4*)(k_k + c0);
            const f32x4 q = kv * kkw; ssq += (q[0] * q[0] + q[1] * q[1]) + (q[2] * q[2] + q[3] * q[3]); }
    ssq += xhalf(ssq);
    const float kinv = 1.f / fmaxf(sqrtf(ssq), 1e-12f);
    float bon = 0.f;
    GAS bf16_t* OM = (GAS bf16_t*)(p.ws + WS_OM) + ((size_t)dir * MTOK + tok) * 256 + hh * 64;
    GAS bf16_t* KA = (GAS bf16_t*)(p.ws + WS_KA) + ((size_t)dir * MTOK + tok) * 256 + hh * 64;
    GAS bf16_t* KD = (GAS bf16_t*)(p.ws + WS_KD) + ((size_t)dir * MTOK + tok) * 256 + hh * 64;
    GAS bf16_t* KK = (GAS bf16_t*)(p.ws + WS_KK) + tok * 256 + hh * 64;
    GAS bf16_t* VV = (GAS bf16_t*)(p.ws + WS_V) + tok * 256 + hh * 64;
    GAS bf16_t* RR = (GAS bf16_t*)(p.ws + WS_R) + tok * 256 + hh * 64;
#pragma unroll
    for (int rb = 0; rb < 2; ++rb)
#pragma unroll
        for (int g4 = 0; g4 < 4; ++g4) { const int c0 = rb * 32 + 8 * g4 + 4 * h2;
            const f32x4 kv = *(const LAS f32x4*)(CF + tk * CF_STR + 256 + hh * 64 + c0), rv = *(const LAS f32x4*)(CF + tk * CF_STR + hh * 64 + c0);
            const f32x4 kkw = *(const LAS f32x4*)(k_k + c0), kaw = *(const LAS f32x4*)(k_a + c0), rkw = *(const LAS f32x4*)(r_k + c0), w0v = *(const LAS f32x4*)(w0 + c0), a0v = *(const LAS f32x4*)(a0 + c0);
            float om[4], ka[4], kd[4], kk[4];
#pragma unroll
            for (int j = 0; j < 4; ++j) {
                const float wp = aw[rb][4 * g4 + j] + w0v[j], ap = aa[rb][4 * g4 + j] + a0v[j];
                om[j] = 1.f - __expf(-0.6065306597126334f * sigmoidf_(wp));
                const float a = sigmoidf_(ap);
                kk[j] = kv[j] * kkw[j] * kinv; ka[j] = kk[j] * a; kd[j] = kv[j] * (1.f + (a - 1.f) * kaw[j]);
                bon += rv[j] * kd[j] * rkw[j];
            }
            u32x2 w; w.x = pk2(om[0], om[1]); w.y = pk2(om[2], om[3]); *(GAS u32x2*)(OM + c0) = w;
            w.x = pk2(ka[0], ka[1]); w.y = pk2(ka[2], ka[3]); *(GAS u32x2*)(KA + c0) = w;
            w.x = pk2(kd[0], kd[1]); w.y = pk2(kd[2], kd[3]); *(GAS u32x2*)(KD + c0) = w;
            if (dir == 0) {
                const f32x4 vv = *(const LAS f32x4*)(CF + tk * CF_STR + 512 + hh * 64 + c0);
                w.x = pk2(kk[0], kk[1]); w.y = pk2(kk[2], kk[3]); *(GAS u32x2*)(KK + c0) = w;
                w.x = pk2(vv[0], vv[1]); w.y = pk2(vv[2], vv[3]); *(GAS u32x2*)(VV + c0) = w;
                w.x = pk2(rv[0], rv[1]); w.y = pk2(rv[2], rv[3]); *(GAS u32x2*)(RR + c0) = w;
            }
        }
    bon += xhalf(bon);
    if (h2 == 0) ((GAS float*)(p.ws + WS_BON))[((size_t)dir * MTOK + tok) * 4 + hh] = bon;
    {
        const GAS bf16_t* Gup = (const GAS bf16_t*)wb + WO_GUP + (size_t)(F.wave * 32 + tk) * 128;
        f32x16 ag;
#pragma unroll
        for (int i = 0; i < 16; ++i) ag[i] = 0.f;
#pragma unroll
        for (int ks = 0; ks < 8; ++ks) {
            const bf16x8 bg = *(const LAS bf16x8*)(AG + tk * 136 + 16 * ks + 8 * h2), fg = *(const GAS bf16x8*)(Gup + 16 * ks + 8 * h2);
            ag = __builtin_amdgcn_mfma_f32_32x32x16_bf16(fg, bg, ag, 0, 0, 0);
        }
        GAS bf16_t* GT = (GAS bf16_t*)(p.ws + WS_GATE) + tok * 256 + F.wave * 32;
#pragma unroll
        for (int g4 = 0; g4 < 4; ++g4) { u32x2 w; w.x = pk2(ag[4 * g4], ag[4 * g4 + 1]); w.y = pk2(ag[4 * g4 + 2], ag[4 * g4 + 3]); *(GAS u32x2*)(GT + 8 * g4 + 4 * h2) = w; }
    }
    __syncthreads();
}

#define CBAR() asm volatile("" ::: "memory")
#define LROW(M, i, r) do { const LAS f32x4* _q = (const LAS f32x4*)((M) + (i) * 16); const f32x4 _a = _q[0], _b = _q[1], _c = _q[2], _d = _q[3]; \
        r[0] = _a[0]; r[1] = _a[1]; r[2] = _a[2]; r[3] = _a[3]; r[4] = _b[0]; r[5] = _b[1]; r[6] = _b[2]; r[7] = _b[3]; \
        r[8] = _c[0]; r[9] = _c[1]; r[10] = _c[2]; r[11] = _c[3]; r[12] = _d[0]; r[13] = _d[1]; r[14] = _d[2]; r[15] = _d[3]; } while (0)
template <int DIR> __device__ __forceinline__ void chunkprep_wave(Frame& F, const Params& p, int task) {
    const int dbh = task >> 7, ct = task & 127, b = (dbh >> 2) & 7, hh = dbh & 3, ch = F.lane, r32 = F.lane & 31, h = F.lane >> 5;
    LAS unsigned char* wl = F.lds + F.wave * 16384;
    LAS bf16_t* X = (LAS bf16_t*)wl;
    LAS bf16_t* Yt = (LAS bf16_t*)(wl + 4608);
    LAS float* MTt = (LAS float*)(wl + 9216);
    LAS float* MBt = MTt + 256;
    LAS float* MC = MTt + 512; LAS float* MD = MTt + 768; LAS float* MT = MTt + 1024; LAS float* MA = MTt + 1280;
    constexpr int step = DIR ? -256 : 256;
    typedef const __attribute__((address_space(1))) bf16_t* gbf;
    const size_t ou = ((size_t)b * SEQ + ct * 16 + (DIR ? 15 : 0)) * 256 + hh * 64;
    const gbf OM = (gbf)(p.ws + WS_OM) + (size_t)DIR * MTOK * 256 + ou + ch; const gbf KA = (gbf)(p.ws + WS_KA) + (size_t)DIR * MTOK * 256 + ou + ch;
    const gbf KD = (gbf)(p.ws + WS_KD) + (size_t)DIR * MTOK * 256 + ou + ch; const gbf KK = (gbf)(p.ws + WS_KK) + ou + ch;
    const gbf RR = (gbf)(p.ws + WS_R) + ou + ch; const gbf VV = (gbf)(p.ws + WS_V) + ou + ch;
    float pc = 1.f;
    float qt[16], rt[16], at[16], kt[16], vv[16];
    {
        unsigned short rw[16], rk[16], ra_[16], rd[16], rr_[16], rv[16];
#pragma unroll
        for (int i = 0; i < 16; ++i) { rw[i] = OM[i * step]; rk[i] = KK[i * step]; ra_[i] = KA[i * step]; rd[i] = KD[i * step]; rr_[i] = RR[i * step]; rv[i] = VV[i * step]; }
#pragma unroll
        for (int i = 0; i < 16; ++i) {
            const float w = 1.f - bf2f(rw[i]);
            qt[i] = bf2f(rk[i]) * pc; pc *= w; const float ip = __builtin_amdgcn_rcpf(pc);
            rt[i] = bf2f(rr_[i]) * pc; at[i] = bf2f(ra_[i]) * ip; kt[i] = bf2f(rd[i]) * ip; vv[i] = bf2f(rv[i]);
            X[i * 72 + ch] = (bf16_t)(pk2(qt[i], 0.f) & 0xffffu); X[(16 + i) * 72 + ch] = (bf16_t)(pk2(rt[i], 0.f) & 0xffffu);
            Yt[i * 72 + ch] = (bf16_t)(pk2(at[i], 0.f) & 0xffffu); Yt[(16 + i) * 72 + ch] = (bf16_t)(pk2(kt[i], 0.f) & 0xffffu);
        }
    }
    const float p15 = pc;
    asm volatile("s_waitcnt lgkmcnt(0)" ::: "memory");
    {
        f32x16 g;
#pragma unroll
        for (int i = 0; i < 16; ++i) g[i] = 0.f;
#pragma unroll
        for (int ks = 0; ks < 4; ++ks) {
            const bf16x8 a = *(const LAS bf16x8*)(X + r32 * 72 + 16 * ks + 8 * h), bb = *(const LAS bf16x8*)(Yt + r32 * 72 + 16 * ks + 8 * h);
            g = __builtin_amdgcn_mfma_f32_32x32x16_bf16(a, bb, g, 0, 0, 0);
        }
        const int sidx = r32 & 15;
#pragma unroll
        for (int reg = 0; reg < 8; ++reg) { const int i = (reg & 3) + 8 * (reg >> 2) + 4 * h;
            const float lo = (sidx < i) ? g[reg] : 0.f, hi2 = (sidx <= i) ? g[8 + reg] : 0.f;
            if (r32 < 16) { MA[i * 16 + sidx] = lo; MD[i * 16 + sidx] = hi2; } else { MBt[sidx * 16 + i] = lo; MC[i * 16 + sidx] = hi2; } }
    }
    asm volatile("s_waitcnt lgkmcnt(0)" ::: "memory");
    {
        const int c = F.lane & 15; float Tc[16];
#pragma unroll
        for (int i = 0; i < 16; ++i) { float acc = (i == c) ? 1.f : 0.f; float ra[16]; LROW(MA, i, ra);
#pragma unroll
            for (int s2 = 0; s2 < i; ++s2) acc -= ra[s2] * Tc[s2];
            Tc[i] = acc; MT[i * 16 + c] = acc; MTt[c * 16 + i] = acc; CBAR(); }
    }
    asm volatile("s_waitcnt lgkmcnt(0)" ::: "memory");
    float Qh[16], W2[16];
    {
        float BV[16];
#pragma unroll
        for (int i = 0; i < 16; ++i) { Qh[i] = 0.f; BV[i] = 0.f; }
#pragma unroll
        for (int s2 = 0; s2 < 16; ++s2) {
            float ct_[16], cb_[16]; LROW(MTt, s2, ct_); LROW(MBt, s2, cb_);
#pragma unroll
            for (int i = s2; i < 16; ++i) { Qh[i] += ct_[i] * qt[s2]; if (i > s2) BV[i] += cb_[i] * vv[s2]; }
            CBAR();
        }
#pragma unroll
        for (int i = 0; i < 16; ++i) { float aw = 0.f; float rt_[16]; LROW(MT, i, rt_);
#pragma unroll
            for (int s2 = 0; s2 <= i; ++s2) aw += rt_[s2] * BV[s2];
            W2[i] = aw; CBAR(); }
    }
    LAS bf16_t* ST = (LAS bf16_t*)wl;
    {
        const int ks = ch >> 4, w16 = ch & 15, jq = (w16 >> 3) * 4 + (w16 & 3), hq = (w16 >> 2) & 1;
        LAS bf16_t* qrp = ST + (ks * 64 + hq * 32) * 8 + jq;
        LAS bf16_t* wyp = ST + 2048 + ((ch >> 5) * 64 + r32) * 16;
#pragma unroll
        for (int i = 0; i < 16; ++i) {
            float ar = rt[i], ay = 0.f; float rd_[16], rc_[16]; LROW(MD, i, rd_); LROW(MC, i, rc_);
#pragma unroll
            for (int s2 = 0; s2 <= i; ++s2) { ar -= rd_[s2] * Qh[s2]; ay += rc_[s2] * vv[s2] - rd_[s2] * W2[s2]; }
            qrp[i * 8] = (bf16_t)(pk2(Qh[i], 0.f) & 0xffffu); qrp[(16 + i) * 8] = (bf16_t)(pk2(ar, 0.f) & 0xffffu);
            wyp[512 * ((i >> 2) & 1) + (i & 3) + 4 * (i >> 3)] = (bf16_t)(pk2(W2[i], 0.f) & 0xffffu);
            wyp[512 * ((i >> 2) & 1) + (i & 3) + 4 * ((16 + i) >> 3)] = (bf16_t)(pk2(ay, 0.f) & 0xffffu);
            CBAR(); }
    }
    asm volatile("s_waitcnt lgkmcnt(0)" ::: "memory");
    {
        GAS u32x4* gq = (GAS u32x4*)((GAS bf16_t*)(p.ws + WS_FQR) + (size_t)task * 2048); GAS u32x4* gw = (GAS u32x4*)((GAS bf16_t*)(p.ws + WS_FWY) + (size_t)task * 2048);
        u32x4 tq[4], tw[4];
#pragma unroll
        for (int q = 0; q < 4; ++q) { tq[q] = *(const LAS u32x4*)(wl + (F.lane + 64 * q) * 16); tw[q] = *(const LAS u32x4*)(wl + 4096 + (F.lane + 64 * q) * 16); }
#pragma unroll
        for (int q = 0; q < 4; ++q) { gq[F.lane + 64 * q] = tq[q]; gw[F.lane + 64 * q] = tw[q]; }
    }
    asm volatile("s_waitcnt lgkmcnt(0)" ::: "memory");
    {
        LAS bf16_t* nap = ST + ((ch >> 5) * 64 + r32) * 8; LAS bf16_t* khp = nap + 1024;
#pragma unroll
        for (int s2 = 0; s2 < 16; ++s2) {
            const int off = 256 * ((s2 >> 2) & 1) + (s2 >> 3) * 4 + (s2 & 3);
            nap[off] = (bf16_t)(pk2(-at[s2] * p15, 0.f) & 0xffffu); khp[off] = (bf16_t)(pk2(kt[s2] * p15, 0.f) & 0xffffu); }
        asm volatile("s_waitcnt lgkmcnt(0)" ::: "memory");
        GAS u32x4* gn = (GAS u32x4*)((GAS bf16_t*)(p.ws + WS_FNA) + (size_t)task * 1024); GAS u32x4* gk = (GAS u32x4*)((GAS bf16_t*)(p.ws + WS_FKH) + (size_t)task * 1024);
        u32x4 tn[2], tk2[2];
#pragma unroll
        for (int q = 0; q < 2; ++q) { tn[q] = *(const LAS u32x4*)(wl + (F.lane + 64 * q) * 16); tk2[q] = *(const LAS u32x4*)(wl + 2048 + (F.lane + 64 * q) * 16); }
#pragma unroll
        for (int q = 0; q < 2; ++q) { gn[F.lane + 64 * q] = tn[q]; gk[F.lane + 64 * q] = tk2[q]; }
        ((GAS float*)(p.ws + WS_FP15))[(size_t)task * 64 + ch] = p15;
    }
    asm volatile("s_waitcnt lgkmcnt(0)" ::: "memory");
}
constexpr int PB_SLOT = 15360, PB_NSLOT = 4, PB_QR = 0, PB_WY = 4096, PB_NA = 8192, PB_KH = 10240, PB_P15 = 12288, PB_V = 13312;
__device__ __forceinline__ unsigned lds_ld_u32(unsigned addr) { unsigned v; asm volatile("ds_read_b32 %0, %1\n\ts_waitcnt lgkmcnt(0)" : "=v"(v) : "v"(addr) : "memory"); return v; }
__device__ __forceinline__ void lds_st_u32(unsigned addr, unsigned v) { asm volatile("ds_write_b32 %0, %1" :: "v"(addr), "v"(v) : "memory"); }
__device__ __forceinline__ void pb_dma(const Params& p, int dbh, int ct, int lane, LAS unsigned char* slot) {
    const size_t task = (size_t)dbh * 128 + ct; const int b = (dbh >> 2) & 7, hh = dbh & 3;
    const unsigned char* q = (const unsigned char*)((const bf16_t*)(p.ws + WS_FQR) + task * 2048) + lane * 16; const unsigned char* w = (const unsigned char*)((const bf16_t*)(p.ws + WS_FWY) + task * 2048) + lane * 16;
    const unsigned char* na = (const unsigned char*)((const bf16_t*)(p.ws + WS_FNA) + task * 1024) + lane * 16; const unsigned char* kh = (const unsigned char*)((const bf16_t*)(p.ws + WS_FKH) + task * 1024) + lane * 16;
#pragma unroll
    for (int i = 0; i < 4; ++i) {
        __builtin_amdgcn_global_load_lds((const unsigned*)(q + 1024 * i), (LAS unsigned*)(slot + PB_QR + 1024 * i), 16, 0, 0);
        __builtin_amdgcn_global_load_lds((const unsigned*)(w + 1024 * i), (LAS unsigned*)(slot + PB_WY + 1024 * i), 16, 0, 0); }
    __builtin_amdgcn_global_load_lds((const unsigned*)na, (LAS unsigned*)(slot + PB_NA), 16, 0, 0); __builtin_amdgcn_global_load_lds((const unsigned*)(na + 1024), (LAS unsigned*)(slot + PB_NA + 1024), 16, 0, 0);
    __builtin_amdgcn_global_load_lds((const unsigned*)kh, (LAS unsigned*)(slot + PB_KH), 16, 0, 0); __builtin_amdgcn_global_load_lds((const unsigned*)(kh + 1024), (LAS unsigned*)(slot + PB_KH + 1024), 16, 0, 0);
    __builtin_amdgcn_global_load_lds((const unsigned*)((const unsigned char*)((const float*)(p.ws + WS_FP15) + task * 64) + lane * 16), (LAS unsigned*)(slot + PB_P15), 16, 0, 0);
    const unsigned char* V = (const unsigned char*)((const bf16_t*)(p.ws + WS_V) + ((size_t)b * SEQ + ct * 16) * 256 + hh * 64) + (size_t)(lane >> 3) * 512 + (lane & 7) * 16;
    __builtin_amdgcn_global_load_lds((const unsigned*)V, (LAS unsigned*)(slot + PB_V), 16, 0, 0); __builtin_amdgcn_global_load_lds((const unsigned*)(V + 8 * 512), (LAS unsigned*)(slot + PB_V + 1024), 16, 0, 0);
}
__device__ __forceinline__ void phaseb_unit(Frame& F, const Params& p, int u) {
    const unsigned flag_base = (unsigned)(size_t)(F.lds + 131072 + 128);
    if (F.tid < 8) lds_st_u32(flag_base + 4 * F.tid, 0u);
    __syncthreads();
    const int pair = F.wave & 3;
    if (pair >= 2) return;
    const int dbh = u * 2 + pair, dir = dbh >> 5;
    LAS unsigned char* ring = F.lds + pair * (PB_NSLOT * PB_SLOT);
    const unsigned f_pub = flag_base + 8 * pair, f_con = f_pub + 4;
    if (F.wave >= 4) {
        for (int c = 0; c < 128; ++c) {
            while ((int)lds_ld_u32(f_con) < c - (PB_NSLOT - 1)) __builtin_amdgcn_s_sleep(1);
            pb_dma(p, dbh, dir ? 127 - c : c, F.lane, ring + (c & (PB_NSLOT - 1)) * PB_SLOT);
            if (c >= 3) { asm volatile("s_waitcnt vmcnt(45)" ::: "memory"); if (F.lane == 0) lds_st_u32(f_pub, (unsigned)(c - 2)); }
        }
        asm volatile("s_waitcnt vmcnt(30)" ::: "memory"); if (F.lane == 0) lds_st_u32(f_pub, 126u);
        asm volatile("s_waitcnt vmcnt(15)" ::: "memory"); if (F.lane == 0) lds_st_u32(f_pub, 127u);
        asm volatile("s_waitcnt vmcnt(0)" ::: "memory"); if (F.lane == 0) lds_st_u32(f_pub, 128u);
        return;
    }
    const int b = (dbh >> 2) & 7, hh = dbh & 3, r = F.lane & 31, h = F.lane >> 5;
    GAS bf16_t* Y = (GAS bf16_t*)(p.ws + WS_Y) + ((size_t)dir * MTOK + (size_t)b * SEQ) * 256 + hh * 64 + r;
    f32x16 accS[2][2];
#pragma unroll
    for (int rb = 0; rb < 2; ++rb)
#pragma unroll
        for (int cb = 0; cb < 2; ++cb)
#pragma unroll
            for (int i = 0; i < 16; ++i) accS[rb][cb][i] = 0.f;
    for (int cc = 0; cc < 128; ++cc) {
        const int ct = dir ? 127 - cc : cc;
        const LAS unsigned char* slot = ring + (cc & (PB_NSLOT - 1)) * PB_SLOT;
        bf16x8 sb[4][2];
#pragma unroll
        for (int rb = 0; rb < 2; ++rb)
#pragma unroll
            for (int s2 = 0; s2 < 2; ++s2)
#pragma unroll
                for (int cb = 0; cb < 2; ++cb) { const f32x16& a = accS[rb][cb]; u32x4 w;
                    w.x = pk2(a[8 * s2 + 0], a[8 * s2 + 1]); w.y = pk2(a[8 * s2 + 2], a[8 * s2 + 3]); w.z = pk2(a[8 * s2 + 4], a[8 * s2 + 5]); w.w = pk2(a[8 * s2 + 6], a[8 * s2 + 7]);
                    sb[2 * rb + s2][cb] = __builtin_bit_cast(bf16x8, w); }
        while ((int)lds_ld_u32(f_pub) < cc + 1) __builtin_amdgcn_s_sleep(1);
        asm volatile("" ::: "memory");
        f32x16 D[2];
#pragma unroll
        for (int cb = 0; cb < 2; ++cb) { const LAS u32x4* wp = (const LAS u32x4*)(slot + PB_WY + (cb * 64 + F.lane) * 32); const u32x4 w0 = wp[0], w1 = wp[1];
            D[cb][0] = bflo(w0.x); D[cb][1] = bfhi(w0.x); D[cb][2] = bflo(w0.y); D[cb][3] = bfhi(w0.y); D[cb][4] = bflo(w0.z); D[cb][5] = bfhi(w0.z); D[cb][6] = bflo(w0.w); D[cb][7] = bfhi(w0.w);
            D[cb][8] = bflo(w1.x); D[cb][9] = bfhi(w1.x); D[cb][10] = bflo(w1.y); D[cb][11] = bfhi(w1.y); D[cb][12] = bflo(w1.z); D[cb][13] = bfhi(w1.z); D[cb][14] = bflo(w1.w); D[cb][15] = bfhi(w1.w); }
#pragma unroll
        for (int ks = 0; ks < 4; ++ks) { const bf16x8 qa = *(const LAS bf16x8*)(slot + PB_QR + (ks * 64 + F.lane) * 16);
            D[0] = __builtin_amdgcn_mfma_f32_32x32x16_bf16(qa, sb[ks][0], D[0], 0, 0, 0);
            D[1] = __builtin_amdgcn_mfma_f32_32x32x16_bf16(qa, sb[ks][1], D[1], 0, 0, 0); }
#pragma unroll
        for (int rb = 0; rb < 2; ++rb)
#pragma unroll
            for (int g4 = 0; g4 < 4; ++g4) { const f32x4 pv = *(const LAS f32x4*)(slot + PB_P15 + (32 * rb + 8 * g4 + 4 * h) * 4);
#pragma unroll
                for (int cb = 0; cb < 2; ++cb)
#pragma unroll
                    for (int q = 0; q < 4; ++q) accS[rb][cb][4 * g4 + q] *= pv[q]; }
        bf16x8 ub[2], vb[2];
#pragma unroll
        for (int cb = 0; cb < 2; ++cb) {
            unsigned short vt[8];
#pragma unroll
            for (int j = 0; j < 8; ++j) { const int s2 = 8 * (j >> 2) + 4 * h + (j & 3); const int tau = dir ? 15 - s2 : s2;
                vt[j] = *(const LAS unsigned short*)(slot + PB_V + tau * 128 + (32 * cb + r) * 2);
                Y[(size_t)(ct * 16 + tau) * 256 + 32 * cb] = (bf16_t)(pk2(D[cb][8 + j], 0.f) & 0xffffu); }
            vb[cb] = (bf16x8){(short)vt[0], (short)vt[1], (short)vt[2], (short)vt[3], (short)vt[4], (short)vt[5], (short)vt[6], (short)vt[7]};
            u32x4 w; w.x = pk2(D[cb][0], D[cb][1]); w.y = pk2(D[cb][2], D[cb][3]); w.z = pk2(D[cb][4], D[cb][5]); w.w = pk2(D[cb][6], D[cb][7]);
            ub[cb] = __builtin_bit_cast(bf16x8, w);
        }
        bf16x8 na[2], kh[2];
#pragma unroll
        for (int rb = 0; rb < 2; ++rb) { na[rb] = *(const LAS bf16x8*)(slot + PB_NA + (rb * 64 + F.lane) * 16); kh[rb] = *(const LAS bf16x8*)(slot + PB_KH + (rb * 64 + F.lane) * 16); }
        asm volatile("s_waitcnt lgkmcnt(0)" ::: "memory");
        if (F.lane == 0) lds_st_u32(f_con, (unsigned)(cc + 1));
#pragma unroll
        for (int rb = 0; rb < 2; ++rb)
#pragma unroll
            for (int cb = 0; cb < 2; ++cb) {
                accS[rb][cb] = __builtin_amdgcn_mfma_f32_32x32x16_bf16(na[rb], ub[cb], accS[rb][cb], 0, 0, 0);
                accS[rb][cb] = __builtin_amdgcn_mfma_f32_32x32x16_bf16(kh[rb], vb[cb], accS[rb][cb], 0, 0, 0);
            }
    }
}

__device__ __forceinline__ void post_unit(Frame& F, const Params& p, int l, int u) {
    REFRAME(F);
    const bf16_t* Y0 = (const bf16_t*)(p.ws + WS_Y); const bf16_t* Y1 = Y0 + (size_t)MTOK * 256;
    const bf16_t* VV = (const bf16_t*)(p.ws + WS_V); const bf16_t* GT = (const bf16_t*)(p.ws + WS_GATE);
    const float* BON = (const float*)(p.ws + WS_BON); bf16_t* MIX = (bf16_t*)(p.ws + WS_MIX);
    const f32x4 lg = *(const f32x4*)(p.in[19] + l * 256 + 4 * F.lane), lb = *(const f32x4*)(p.in[20] + l * 256 + 4 * F.lane);
    for (int tok = u * 64 + F.wave * 8, te = tok + 8; tok < te; ++tok) {
        const u32x2 a = *(const GAS u32x2*)((const GAS bf16_t*)Y0 + (size_t)tok * 256 + 4 * F.lane), c = *(const GAS u32x2*)((const GAS bf16_t*)Y1 + (size_t)tok * 256 + 4 * F.lane);
        const u32x2 vv = *(const GAS u32x2*)((const GAS bf16_t*)VV + (size_t)tok * 256 + 4 * F.lane), gg = *(const GAS u32x2*)((const GAS bf16_t*)GT + (size_t)tok * 256 + 4 * F.lane);
        float y[4] = {bflo(a.x) + bflo(c.x), bfhi(a.x) + bfhi(c.x), bflo(a.y) + bflo(c.y), bfhi(a.y) + bfhi(c.y)};
        float s = (y[0] + y[1]) + (y[2] + y[3]);
#pragma unroll
        for (int o = 1; o < 16; o <<= 1) s += __shfl_xor(s, o);
        const float mu = s * (1.f / 64.f);
        float q = 0.f;
#pragma unroll
        for (int i = 0; i < 4; ++i) { y[i] -= mu; q += y[i] * y[i]; }
#pragma unroll
        for (int o = 1; o < 16; o <<= 1) q += __shfl_xor(q, o);
        const float rstd = rsqrtf(q * (1.f / 64.f) + 64e-5f);
        const int hh = F.lane >> 4;
        const float bon = ((const GAS float*)BON)[(size_t)tok * 4 + hh] + ((const GAS float*)BON)[((size_t)MTOK + tok) * 4 + hh];
        const float v4[4] = {bflo(vv.x), bfhi(vv.x), bflo(vv.y), bfhi(vv.y)}, g4[4] = {bflo(gg.x), bfhi(gg.x), bflo(gg.y), bfhi(gg.y)};
        float o4[4];
#pragma unroll
        for (int i = 0; i < 4; ++i) o4[i] = (y[i] * rstd * lg[i] + lb[i] + bon * v4[i]) * g4[i];
        u32x2 w; w.x = pk2(o4[0], o4[1]); w.y = pk2(o4[2], o4[3]);
        *(GAS u32x2*)((GAS bf16_t*)MIX + (size_t)tok * DM + 768 + 4 * F.lane) = w;
    }
}

__device__ __forceinline__ void prologue(Frame& F, const Params& p) {
    REFRAME(F);
    LAS float* scr = (LAS float*)(F.lds + F.wave * 16384);
    const int gw = F.bid * 8 + F.wave, NGW = F.G * 8;
    bf16_t* wb = (bf16_t*)(p.ws + WS_W);
    for (int it = gw; it < CV_TOTAL; it += NGW) { if (it < CV_A) cvt_item_a(p, 0, wb, scr, it, F.lane); else cvt_item_b(p, 0, wb, scr, it - CV_A, F.lane); }
    const float* x = p.in[0]; float* X = p.out; bf16_t* XB = (bf16_t*)(p.ws + WS_XB); float* rowss = (float*)(p.ws + WS_RP);
    for (int m = gw; m < MTOK; m += 2 * NGW) {
        const int m2 = m + NGW; const bool has2 = m2 < MTOK; const int mb = has2 ? m2 : m;
        const GAS f32x4* xra = (const GAS f32x4*)(x + (size_t)m * DM) + F.lane; const GAS f32x4* xrb = (const GAS f32x4*)(x + (size_t)mb * DM) + F.lane;
        f32x4 va[4], vb[4];
#pragma unroll
        for (int jj = 0; jj < 4; ++jj) { va[jj] = xra[64 * jj]; vb[jj] = xrb[64 * jj]; }
        float sa = 0.f, sb = 0.f;
#pragma unroll
        for (int jj = 0; jj < 4; ++jj) { sa += (va[jj][0] * va[jj][0] + va[jj][1] * va[jj][1]) + (va[jj][2] * va[jj][2] + va[jj][3] * va[jj][3]); sb += (vb[jj][0] * vb[jj][0] + vb[jj][1] * vb[jj][1]) + (vb[jj][2] * vb[jj][2] + vb[jj][3] * vb[jj][3]); }
        sa = wave_sum(sa); sb = wave_sum(sb);
        { GAS f32x4* xo = (GAS f32x4*)(X + (size_t)m * DM) + F.lane; GAS u32x2* bo = (GAS u32x2*)(XB + (size_t)m * DM) + F.lane;
#pragma unroll
          for (int jj = 0; jj < 4; ++jj) { xo[64 * jj] = va[jj]; u32x2 w; w.x = pk2(va[jj][0], va[jj][1]); w.y = pk2(va[jj][2], va[jj][3]); bo[64 * jj] = w; }
          if (F.lane < 16) ((GAS float*)rowss)[(size_t)m * 16 + F.lane] = (F.lane == 0) ? sa : 0.f; }
        if (has2) { GAS f32x4* xo = (GAS f32x4*)(X + (size_t)m2 * DM) + F.lane; GAS u32x2* bo = (GAS u32x2*)(XB + (size_t)m2 * DM) + F.lane;
#pragma unroll
          for (int jj = 0; jj < 4; ++jj) { xo[64 * jj] = vb[jj]; u32x2 w; w.x = pk2(vb[jj][0], vb[jj][1]); w.y = pk2(vb[jj][2], vb[jj][3]); bo[64 * jj] = w; }
          if (F.lane < 16) ((GAS float*)rowss)[(size_t)m2 * 16 + F.lane] = (F.lane == 0) ? sb : 0.f; }
    }
    const float* mem = p.in[1]; const float* gm = p.in[23]; bf16_t* MN = (bf16_t*)(p.ws + WS_MEMN);
    for (int m = gw; m < MMEM; m += NGW) {
        const f32x4* xr = (const f32x4*)(mem + (size_t)m * DM) + F.lane; u32x2* bo = (u32x2*)(MN + (size_t)m * DM) + F.lane;
        f32x4 v[4]; float s = 0.f;
#pragma unroll
        for (int jj = 0; jj < 4; ++jj) { v[jj] = xr[64 * jj]; s += (v[jj][0] * v[jj][0] + v[jj][1] * v[jj][1]) + (v[jj][2] * v[jj][2] + v[jj][3] * v[jj][3]); }
        const float rstd = rsqrtf(wave_sum(s) * (1.f / 1024.f) + 1e-6f);
#pragma unroll
        for (int jj = 0; jj < 4; ++jj) { const f32x4 g = *((const f32x4*)gm + F.lane + 64 * jj); const f32x4 t = v[jj] * rstd * g;
            u32x2 w; w.x = pk2(t[0], t[1]); w.y = pk2(t[2], t[3]); bo[64 * jj] = w; }
    }
}
__device__ __forceinline__ void final_norm(Frame& F, const Params& p) {
    REFRAME(F);
    const int gw = F.bid * 8 + F.wave, NGW = F.G * 8;
    const float* rowss = (const float*)(p.ws + WS_RP) + (size_t)12 * MTOK * 16; const GAS float* gf = (const GAS float*)p.in[30];
    f32x4 g[4];
#pragma unroll
    for (int jj = 0; jj < 4; ++jj) g[jj] = *((const GAS f32x4*)gf + F.lane + 64 * jj);
    for (int m = gw; m < MTOK; m += 2 * NGW) {
        const int m2 = m + NGW; const bool has2 = m2 < MTOK;
        GAS f32x4* xa = (GAS f32x4*)(p.out + (size_t)m * DM) + F.lane; GAS f32x4* xb = (GAS f32x4*)(p.out + (size_t)(has2 ? m2 : m) * DM) + F.lane;
        f32x4 va[4], vb[4];
#pragma unroll
        for (int jj = 0; jj < 4; ++jj) { va[jj] = xa[64 * jj]; vb[jj] = xb[64 * jj]; }
        const float ra = row_rstd(rowss, m), rb = row_rstd(rowss, has2 ? m2 : m);
#pragma unroll
        for (int jj = 0; jj < 4; ++jj) xa[64 * jj] = va[jj] * ra * g[jj];
        if (has2) {
#pragma unroll
            for (int jj = 0; jj < 4; ++jj) xb[64 * jj] = vb[jj] * rb * g[jj]; }
    }
}

#define XB_TMO      128
#define XB_XCNT(j)  (256  + 64 * (j))
#define XB_XSUB(j)  (1280 + 64 * (j))
#define XB_XGEN(j)  (2304 + 64 * (j))
#define XB_TOP      3328
#define XB_TOPGEN   3392
#define XB_SPIN_CAP (1u << 22)
constexpr int CW_BAR = 4096;
__device__ __forceinline__ unsigned xb_ld(unsigned* p)              { return __hip_atomic_load(p, __ATOMIC_RELAXED, __HIP_MEMORY_SCOPE_AGENT); }
__device__ __forceinline__ unsigned xb_add(unsigned* p, unsigned v) { return __hip_atomic_fetch_add(p, v, __ATOMIC_RELAXED, __HIP_MEMORY_SCOPE_AGENT); }
__device__ __forceinline__ unsigned xb_xcc_id() { return (unsigned)__builtin_amdgcn_s_getreg((3 << 11) | 20) & 0xFu; }
#define XB_SPIN(cond, bar) do { unsigned _sp = 0; while (cond) { __builtin_amdgcn_s_sleep(1); \
    if ((++_sp & 255u) == 0u) { if (xb_ld(&(bar)[XB_TMO])) break; if (_sp > XB_SPIN_CAP) { atomicAdd(&(bar)[XB_TMO], 1u); break; } } } } while (0)
__device__ __forceinline__ void xcd_barrier_complete(unsigned* bar, unsigned x, unsigned& nloc, unsigned& nx) {
    const unsigned G = gridDim.x;
    unsigned sum, cnt, mine, sp = 0u;
    for (;;) {
        sum = 0u; cnt = 0u; mine = 0u;
#pragma unroll
        for (unsigned j = 0; j < 16; ++j) { const unsigned c = xb_ld(&bar[XB_XCNT(j)]); sum += c; cnt += (c > 0u) ? 1u : 0u; mine = (j == x) ? c : mine; }
        if (sum == G) break;
        __builtin_amdgcn_s_sleep(1);
        if ((++sp & 255u) == 0u) { if (xb_ld(&bar[XB_TMO])) break; if (sp > XB_SPIN_CAP) { atomicAdd(&bar[XB_TMO], 1u); break; } }
    }
    nloc = mine > 0u ? mine : 1u; nx = cnt > 0u ? cnt : 1u;
}
__device__ __forceinline__ void gsync(volatile LAS unsigned* st) {
    unsigned* bar = (unsigned*)(make_params().ws + WS_CTL) + CW_BAR;
    asm volatile("s_waitcnt vmcnt(0)" ::: "memory");
    __syncthreads();
    if (threadIdx.x == 0) {
        const unsigned x = xb_xcc_id();
        __builtin_amdgcn_s_waitcnt(0);
        unsigned nloc = st[0], nx = st[1];
        if (nloc == 0u) { xcd_barrier_complete(bar, x, nloc, nx); st[0] = nloc; st[1] = nx; }
        const unsigned old = xb_add(&bar[XB_XSUB(x)], 1u);
        const unsigned gen = old / nloc;
        if (old + 1u == (gen + 1u) * nloc) {
            __builtin_amdgcn_fence(__ATOMIC_RELEASE, "agent");
            asm volatile("s_waitcnt vmcnt(0)" ::: "memory");
            const unsigned og = xb_add(&bar[XB_TOP], 1u);
            const unsigned tg = og / nx;
            if (og + 1u == (tg + 1u) * nx) xb_add(&bar[XB_TOPGEN], 1u);
            else XB_SPIN(xb_ld(&bar[XB_TOPGEN]) == tg, bar);
            __builtin_amdgcn_fence(__ATOMIC_ACQUIRE, "agent");
            xb_add(&bar[XB_XGEN(x)], 1u);
            asm volatile("s_waitcnt vmcnt(0)" ::: "memory");
        } else {
            XB_SPIN(xb_ld(&bar[XB_XGEN(x)]) == gen, bar);
            __builtin_amdgcn_fence(__ATOMIC_ACQUIRE, "agent");
            asm volatile("s_waitcnt vmcnt(0)" ::: "memory");
        }
    }
    __syncthreads();
}
__device__ __forceinline__ int rstd_table(LAS unsigned char* lds, const pg8::StaticOrder& S, const float* rowss, int tid) {
    pg8::Unit u0; int pm0 = -1;
    if (S.next(0, u0)) { pm0 = u0.pm; if (tid < 256) ((LAS float*)(lds + 131072 + 2048))[tid] = row_rstd(rowss, pm0 * 256 + tid); }
    __syncthreads();
    return pm0;
}
#ifdef TPROBE
#define STAMP(id) do { if (blockIdx.x == 0 && threadIdx.x == 0) { LAS unsigned long long* ts_ = (LAS unsigned long long*)(F.lds + 131072 + 64); const unsigned long long now_ = __builtin_amdgcn_s_memrealtime(); \
    const unsigned long long dt_ = now_ - ts_[0]; ts_[0] = now_; if ((TA_MASK >> (id)) & 1) ts_[1] += dt_; if ((TB_MASK >> (id)) & 1) ts_[2] += dt_; } } while (0)
#else
#define STAMP(id) do { } while (0)
#endif
#ifndef PH_MASK
#define PH_MASK 0xFFFF
#endif
#ifndef REP_MASK
#define REP_MASK 0
#endif
#define NREP(k) ((((REP_MASK) >> (k)) & 1) ? 2 : 1)
constexpr int NCP = 1024, NDIFF_A = 0, NPB = 32;
__global__ void __launch_bounds__(512, 2) fwd_megakernel(KArgs kargs_unused) {
    extern __shared__ __attribute__((aligned(16))) unsigned char lds_raw[];
    cg::grid_group grid = cg::this_grid();
    Frame F; F.lds = (LAS unsigned char*)lds_raw; F.tid = threadIdx.x; F.lane = F.tid & 63; F.wave = __builtin_amdgcn_readfirstlane(F.tid >> 6); F.G = gridDim.x; F.bid = blockIdx.x;
    LAS int* qslot = (LAS int*)(F.lds + 131072);
    volatile LAS unsigned* bst = (volatile LAS unsigned*)(F.lds + 131072 + 32);
    { unsigned* bar0 = (unsigned*)(make_params().ws + WS_CTL) + CW_BAR;
      if (threadIdx.x == 0) { bst[0] = 0u; bst[1] = 0u; (void)xb_add(bar0 + XB_XCNT(xb_xcc_id()), 1u); } }
    __syncthreads();
#define PHASE_VARS() const Params p = make_params(); unsigned* ctl = (unsigned*)(p.ws + WS_CTL); float* rowss = (float*)(p.ws + WS_RP); \
    bf16_t* XB = (bf16_t*)(p.ws + WS_XB); bf16_t* Z = (bf16_t*)(p.ws + WS_Z); bf16_t* MIX = (bf16_t*)(p.ws + WS_MIX); \
    bf16_t* wb = (bf16_t*)(p.ws + WS_W); int bid_ = F.bid, G_ = F.G; asm volatile("" : "+s"(bid_), "+s"(G_)); (void)bid_; (void)G_; (void)ctl; (void)rowss; (void)XB; (void)Z; (void)MIX; (void)wb

#ifdef TPROBE
    if (blockIdx.x == 0 && threadIdx.x == 0) { LAS unsigned long long* ts_ = (LAS unsigned long long*)(F.lds + 131072 + 64); ts_[0] = __builtin_amdgcn_s_memrealtime(); ts_[1] = 0; ts_[2] = 0; }
#endif
    if (PH_MASK & 1) { const Params p = make_params(); prologue(F, p); }
    grid.sync();
    STAMP(0);

    for (int l = 0; l < NL; ++l) {
        for (int rep = 0; rep < NREP(1); ++rep) {
        if (PH_MASK & 2) {
            PHASE_VARS();
            pg8::StaticOrder S; S.init(MTOK, INW, G_, bid_);
            const int pm0 = rstd_table(F.lds, S, rowss + (size_t)(3 * l) * MTOK * 16, F.tid);
            pg8::gemm_phase(F.lds, pg8::Gemm{XB, wb + WO_IN, MTOK, INW, DM}, S, pg8::EpiScaleBf16{Z, ZP, rowss + (size_t)(3 * l) * MTOK * 16, (bf16_t*)(p.ws + WS_ZC), 1024, 8, (bf16_t*)(p.ws + WS_KD2), (const LAS float*)(F.lds + 131072 + 2048), pm0});
        }
        gsync(bst); STAMP(1);
        }
        for (int rep = 0; rep < NREP(2); ++rep) {
        for (int u = F.bid; u < 768; u += F.G) {
            PHASE_VARS();
            if (u < 512) { if (PH_MASK & 4) prep_unit(F, p, l, wb, u); } else if (PH_MASK & 8) win_unit(F, p, l, u - 512);
        }
        gsync(bst); STAMP(2);
        }
        for (int rep = 0; rep < NREP(3); ++rep) {
        {
            PHASE_VARS();
            for (int u = bid_; u < NCP; u += G_) {
                if (PH_MASK & 16) { REFRAME(F); if (u >= NCP / 2) chunkprep_wave<1>(F, p, u * 8 + F.wave); else chunkprep_wave<0>(F, p, u * 8 + F.wave); }
            }
        }
        gsync(bst); STAMP(11);
        }
        for (int rep = 0; rep < NREP(4); ++rep) {
        {
            PHASE_VARS();
            const int ncva = (l + 1 < NL) ? CV_A / 8 : 0, ncvb = (l > 0) ? CV_B / 8 : 0, ncv = NPB + ncva + ncvb, ntot = ncv + 256;
            unsigned* pbdone = ctl + 3072 + (l * 2 + rep) * 16;
            unsigned* gq = ctl + CW_Q + 16 * l + 8 + 4 * rep; unsigned* dq = ctl + 2048 + (l * 2 + rep) * 16;
            const int myx = (int)(xb_xcc_id() & 7u);
            int stage = (bid_ < NPB) ? 0 : 1, pend = -1, xi = 0;
            for (;;) {
                __syncthreads();
                if (F.tid == 0) {
                    int code = -1;
                    if (stage == 0) { const int g = (int)atomicAdd(gq, 1u); if (g < NPB) code = g; else { pend = g; stage = 1; } }
                    if (stage == 1) {
                        while (xi < 8) { const int x = (myx + xi) & 7; const int tk = (int)atomicAdd(dq + x, 1u); if (tk < 64) { code = -2 - ((4 * x + (tk >> 4)) * 16 + (tk & 15)); break; } ++xi; }
                        if (xi >= 8) stage = 2;
                    }
                    if (stage == 2 && code == -1) { int g = pend; pend = -1; if (g < 0) g = (int)atomicAdd(gq, 1u); if (g < ntot) code = g; }
                    *qslot = code;
                }
                __syncthreads();
                const int u = *qslot;
                if (u == -1) break;
                if (u <= -2) { if (PH_MASK & 32) diff_unit(F, p, l, -2 - u); }
                else if (u < NPB) { if (PH_MASK & 16) { REFRAME(F); phaseb_unit(F, p, u); }
                    __threadfence(); __syncthreads();
                    if (F.tid == 0) __hip_atomic_fetch_add(pbdone, 1u, __ATOMIC_RELEASE, __HIP_MEMORY_SCOPE_AGENT); }
                else if (u >= ncv) {
                    if (F.tid == 0) { while (__hip_atomic_load(pbdone, __ATOMIC_RELAXED, __HIP_MEMORY_SCOPE_AGENT) < (unsigned)NPB) __builtin_amdgcn_s_sleep(8); }
                    __syncthreads(); __builtin_amdgcn_fence(__ATOMIC_ACQUIRE, "agent");
                    if (PH_MASK & 64) post_unit(F, p, l, u - ncv); }
                else if (u < NPB + ncva) { REFRAME(F); cvt_item_a(p, l + 1, wb, (LAS float*)(F.lds + F.wave * 16384), (u - NPB) * 8 + F.wave, F.lane); }
                else { REFRAME(F); cvt_item_b(p, l, wb, (LAS float*)(F.lds + F.wave * 16384), (u - NPB - ncva) * 8 + F.wave, F.lane); }
            }
        }
        gsync(bst); STAMP(3);
        }
        if (PH_MASK & 128) {
            PHASE_VARS();
            pg8::StaticOrder S; S.init(MTOK, DM, G_, bid_);
            pg8::gemm_phase(F.lds, pg8::Gemm{MIX, wb + WO_OUT, MTOK, DM, DM}, S, pg8::EpiResid{p.out, XB, rowss + (size_t)(3 * l + 1) * MTOK * 16});
        }
        gsync(bst); STAMP(5);
        for (int rep = 0; rep < NREP(6); ++rep) {
        if (PH_MASK & 256) {
            PHASE_VARS();
            pg8::StaticOrder S; S.init(MTOK, XW, G_, bid_);
            if (F.bid < 128) {
                pg8::gemm_phase(F.lds, pg8::Gemm{XB, wb + WO_Q, MTOK, XW, DM}, S, pg8::EpiScaleBf16{(bf16_t*)(p.ws + WS_Q), XW, rowss + (size_t)(3 * l + 1) * MTOK * 16, nullptr, 0, 1 << 30, nullptr, nullptr, -1});
            } else {
                pg8::StaticOrder S2; S2.init(MMEM, 1024, 128, F.bid - 128);
                pg8::gemm_phase(F.lds, pg8::Gemm{(const bf16_t*)(p.ws + WS_MEMN), wb + WO_KV, MMEM, 1024, DM}, S2, pg8::EpiScaleBf16{(bf16_t*)(p.ws + WS_KV), 1024, nullptr, nullptr, 0, 1 << 30, nullptr, nullptr, -1});
            }
        }
        gsync(bst); STAMP(6);
        }
        for (int rep = 0; rep < NREP(7); ++rep) {
        if (PH_MASK & 512) for (int u = F.bid; u < 256; u += F.G) { PHASE_VARS(); cross_unit(F, p, u); }
        gsync(bst); STAMP(7);
        }
        if (PH_MASK & 1024) {
            PHASE_VARS();
            pg8::StaticOrder S; S.init(MTOK, DM, G_, bid_);
            pg8::gemm_phase(F.lds, pg8::Gemm{(const bf16_t*)(p.ws + WS_O), wb + WO_O, MTOK, DM, XW}, S, pg8::EpiResid{p.out, XB, rowss + (size_t)(3 * l + 2) * MTOK * 16});
        }
        gsync(bst); STAMP(8);
        for (int rep = 0; rep < NREP(9); ++rep) {
        if (PH_MASK & 2048) {
            PHASE_VARS();
            pg8::StaticOrder S; S.init(MTOK, 2 * DFF, G_, bid_);
            const int pm0 = rstd_table(F.lds, S, rowss + (size_t)(3 * l + 2) * MTOK * 16, F.tid);
            pg8::gemm_phase(F.lds, pg8::Gemm{XB, wb + WO_GU, MTOK, 2 * DFF, DM}, S, pg8::EpiSwiGLU{(bf16_t*)(p.ws + WS_G), rowss + (size_t)(3 * l + 2) * MTOK * 16, (const LAS float*)(F.lds + 131072 + 2048), pm0});
        }
        gsync(bst); STAMP(9);
        }
        if (PH_MASK & 4096) {
            PHASE_VARS();
            pg8::StaticOrder S; S.init(MTOK, DM, G_, bid_);
            pg8::gemm_phase(F.lds, pg8::Gemm{(const bf16_t*)(p.ws + WS_G), wb + WO_DOWN, MTOK, DM, DFF}, S, pg8::EpiResid{p.out, XB, rowss + (size_t)(3 * l + 3) * MTOK * 16});
        }

#ifdef TPROBE
        STAMP(10);
        { const Params p = make_params(); if (l == NL - 1 && blockIdx.x == 0 && threadIdx.x == 0) { LAS unsigned long long* ts_ = (LAS unsigned long long*)(F.lds + 131072 + 64); unsigned* c_ = (unsigned*)(p.ws + WS_CTL); c_[32] = (unsigned)ts_[1]; c_[33] = (unsigned)ts_[2]; } }
#endif
        gsync(bst);
    }
    if (PH_MASK & 8192) { const Params p = make_params(); final_norm(F, p); }
}

extern "C" void kernel_launch(void* const* d_in, const int* in_sizes, int n_in, void* d_out, int out_size, void* d_ws, size_t ws_size, hipStream_t stream) {
    static int grid = 0;
    if (grid == 0) {
        if (n_in != 31 || out_size != MTOK * DM || ws_size < WS_END) { fprintf(stderr, "kernel_launch: unexpected problem shape (n_in %d out %d ws %zu)\n", n_in, out_size, ws_size); grid = -1; return; }
        int dev = 0, cus = 0, per_cu = 0;
        hipGetDevice(&dev);
        hipDeviceGetAttribute(&cus, hipDeviceAttributeMultiprocessorCount, dev);
        hipFuncSetAttribute((const void*)fwd_megakernel, hipFuncAttributeMaxDynamicSharedMemorySize, LDS_BYTES);
        hipOccupancyMaxActiveBlocksPerMultiprocessor(&per_cu, (const void*)fwd_megakernel, 512, LDS_BYTES);
        if (per_cu < 1) { fprintf(stderr, "kernel_launch: occupancy query returned %d\n", per_cu); per_cu = 1; }
        (void)hipGetLastError();
        grid = cus * per_cu;
    }
    if (grid < 0) return;
    hipMemsetAsync((char*)d_ws + WS_CTL, 0, CTL_ZERO_BYTES, stream);
    KArgs p{};
    for (int i = 0; i < 31; ++i) p.in[i] = (const float*)d_in[i];
    p.out = (float*)d_out; p.ws = (unsigned char*)d_ws;
    void* args[] = {&p};
    hipError_t e = hipLaunchCooperativeKernel((const void*)fwd_megakernel, dim3(grid), dim3(512), args, LDS_BYTES, stream);
    if (e != hipSuccess) fprintf(stderr, "cooperative launch failed: %s (grid %d)\n", hipGetErrorString(e), grid);
}
```

```cpp
#include <hip/hip_runtime.h>
#include <hip/hip_cooperative_groups.h>
#include <cstdio>
#include <cstdint>
namespace cg = cooperative_groups;

#define LAS __attribute__((address_space(3)))
#define GAS __attribute__((address_space(1)))
typedef unsigned short bf16_t;
typedef short bf16x8 __attribute__((ext_vector_type(8)));
typedef short s16x4 __attribute__((ext_vector_type(4)));
typedef short v4i16_t __attribute__((ext_vector_type(4)));
typedef float f32x4 __attribute__((ext_vector_type(4)));
typedef float f32x2 __attribute__((ext_vector_type(2)));
typedef float f32x16 __attribute__((ext_vector_type(16)));
typedef unsigned u32x4 __attribute__((ext_vector_type(4)));
typedef unsigned u32x2 __attribute__((ext_vector_type(2)));
typedef __bf16 bf16x2_t __attribute__((ext_vector_type(2)));

constexpr int DM = 1024, NB = 8, SEQ = 2048, NL = 4, MTOK = NB * SEQ;
constexpr int NMEM = 256, MMEM = NB * NMEM;
constexpr int INW = 3072, DFF = 2816, XW = 512;
constexpr float LOG2E = 1.4426950408889634f;

constexpr size_t MiB = 1u << 20;
constexpr size_t WS_CTL = 0, CTL_ZERO_BYTES = 1 * MiB;
constexpr size_t WS_W = 1 * MiB;
constexpr size_t WS_Z = 30 * MiB;
constexpr size_t WS_ZC = 94 * MiB;
constexpr size_t WS_XB = 126 * MiB;
constexpr size_t WS_FQR = 94 * MiB, WS_FWY = 126 * MiB, WS_FNA = 158 * MiB, WS_FKH = 174 * MiB, WS_FP15 = 190 * MiB;
constexpr size_t WS_MIX = 192 * MiB;
constexpr size_t WS_OM = 224 * MiB, WS_KA = 240 * MiB, WS_KD = 256 * MiB, WS_KK = 272 * MiB, WS_V = 280 * MiB, WS_R = 288 * MiB;
constexpr size_t WS_GATE = 296 * MiB, WS_Y = 304 * MiB, WS_BON = 320 * MiB, WS_KV = 321 * MiB, WS_MEMN = 325 * MiB;
constexpr size_t WS_RP = 329 * MiB;
constexpr size_t WS_END = 342 * MiB;
constexpr size_t WS_Q = WS_Z, WS_O = WS_Z + 16 * MiB, WS_G = WS_Z;
constexpr int ZP = 1024;
constexpr size_t WS_KD2 = WS_Z + 32 * MiB, WS_VD2 = WS_Z + 48 * MiB;
constexpr size_t WO_IN = 0, WO_OUT = 3145728, WO_Q = 4194304, WO_KV = 4718592, WO_O = 5767168, WO_GU = 6291456, WO_DOWN = 12058624;
constexpr size_t WO_WUP = 14942208, WO_AUP = 14974976, WO_GUP = 15007744;
constexpr int CW_Q = 64;

constexpr int LDS_BYTES = 135168;

__device__ __forceinline__ float bf2f(unsigned b) { return __uint_as_float(b << 16); }
__device__ __forceinline__ unsigned pk2(float lo, float hi) { f32x2 v = {lo, hi}; bf16x2_t b = __builtin_convertvector(v, bf16x2_t); return __builtin_bit_cast(unsigned, b); }
__device__ __forceinline__ float bflo(unsigned u) { return __uint_as_float(u << 16); }
__device__ __forceinline__ float bfhi(unsigned u) { return __uint_as_float(u & 0xffff0000u); }
__device__ __forceinline__ float wave_sum(float v) {
#pragma unroll
    for (int o = 1; o < 64; o <<= 1) v += __shfl_xor(v, o);
    return v;
}
__device__ __forceinline__ float xhalf(float v) {
    return __shfl_xor(v, 32);
}
__device__ __forceinline__ float row_rstd(const float* rp, int row) {
    const f32x4* q = (const f32x4*)(rp + (size_t)row * 16); const f32x4 a = q[0], b = q[1], c = q[2], d = q[3];
    const float s = (((a[0] + a[1]) + (a[2] + a[3])) + ((b[0] + b[1]) + (b[2] + b[3]))) + (((c[0] + c[1]) + (c[2] + c[3])) + ((d[0] + d[1]) + (d[2] + d[3])));
    return rsqrtf(s * (1.f / 1024.f) + 1e-6f);
}
__device__ __forceinline__ float sigmoidf_(float x) { return __builtin_amdgcn_rcpf(1.f + __expf(-x)); }

__device__ __forceinline__ int hw_lane() { int l = (int)__builtin_amdgcn_mbcnt_hi(~0u, __builtin_amdgcn_mbcnt_lo(~0u, 0u)); asm volatile("" : "+v"(l)); return l; }
namespace pg8 {
constexpr int BM = 256, BK = 64, HALF = 128, HTB = HALF * BK * 2, NXCD = 8, WGM = 8;
__host__ __device__ __forceinline__ int lds_byte(int r, int c) { const int st = (r >> 4) * 2 + (c >> 5), rr = r & 15, cc = c & 31, ob = rr * 64 + cc * 2; return st * 1024 + (ob ^ (((ob >> 9) & 1) << 5)); }
__host__ __device__ __forceinline__ void stage_rc(int b, int& R, int& C) { const int st = b / 1024, sb = b % 1024, swz = sb ^ (((sb >> 9) & 1) << 5); R = (st >> 1) * 16 + swz / 64; C = (st & 1) * 32 + (swz % 64) / 2; }
__host__ __device__ __forceinline__ int perm32(int rho) { const int n = rho >> 4, i = rho & 15; return 8 * (i >> 2) + 4 * n + (i & 3); }
struct Unit { int pm, pn; };
struct Gemm { const bf16_t* A; const bf16_t* Bt; int M, N, K; };
struct StaticOrder {
    int nM, nN, nwg, G, c;
    __device__ void init(int M, int N, int G_, int c_) { nM = M / BM; nN = N / BM; nwg = nM * nN; G = G_; c = c_; }
    __device__ bool next(int i, Unit& u) const {
        const long L = (long)i * G + c; if (L >= nwg) return false;
        int wgid = (int)L; { const int q = nwg / NXCD, r = nwg % NXCD, xcd = wgid % NXCD, off = wgid / NXCD; wgid = (xcd < r ? xcd * (q + 1) : r * (q + 1) + (xcd - r) * q) + off; }
        const int nig = WGM * nN, gid = wgid / nig, fm = gid * WGM, gsz = (nM - fm) < WGM ? (nM - fm) : WGM;
        u.pm = fm + ((wgid % nig) % gsz); u.pn = (wgid % nig) / gsz; return true;
    }
};
template <class Epi>
__device__ __forceinline__ void gemm_phase(LAS unsigned char* lds, const Gemm g, const StaticOrder& S, const Epi& E) {
    int tid_ = threadIdx.x; asm volatile("" : "+v"(tid_));
    const int tid = tid_, wid = __builtin_amdgcn_readfirstlane(tid >> 6), lane = tid & 63, wr = wid >> 2, wc = wid & 3, fr = lane & 15, fq = lane >> 4;
    const int K = g.K, nt = K / BK;
    unsigned voffA[2], voffB[2];
#pragma unroll
    for (int i = 0; i < 2; ++i) { int R, C; stage_rc(tid * 16 + i * 8192, R, C); const int Rb = (R & ~31) + perm32(R & 31);
        voffA[i] = (unsigned)(R * K + C) * 2u; voffB[i] = (unsigned)(Rb * K + C) * 2u; }
    const size_t kstep = (size_t)(BK * 2);
    const size_t hstep = (size_t)HALF * K * 2;
    const size_t tstep = 2 * hstep;
    const unsigned ldsw = (unsigned)wid * 1024u;
    const int aoff = lds_byte(wr * 64 + fr, fq * 8), boff = lds_byte(wc * 32 + fr, fq * 8);
#define PG8_SA(b, h) (((b) * 2 + (h)) * HTB)
#define PG8_SB(b, h) ((4 + (b) * 2 + (h)) * HTB)
#define PG8_STAGE(bufoff, gbase, voff) do { _Pragma("unroll") for (int _i = 0; _i < 2; ++_i) \
        __builtin_amdgcn_global_load_lds((const unsigned*)((const char*)(gbase) + (voff)[_i]), (LAS unsigned*)(lds + (bufoff) + ldsw + _i * 8192), 16, 0, 0); } while (0)
#define PG8_LDA(dst, b, h) do { _Pragma("unroll") for (int m = 0; m < 4; ++m) _Pragma("unroll") for (int k = 0; k < 2; ++k) dst[m][k] = *(const LAS bf16x8*)(lds + PG8_SA(b, h) + aoff + m * 2048 + k * 1024); } while (0)
#define PG8_LDB(dst, b, h) do { _Pragma("unroll") for (int n = 0; n < 2; ++n) _Pragma("unroll") for (int k = 0; k < 2; ++k) dst[n][k] = *(const LAS bf16x8*)(lds + PG8_SB(b, h) + boff + n * 2048 + k * 1024); } while (0)
#define PG8_MMA(ai, bj, At, Bt) do { __builtin_amdgcn_s_setprio(1); _Pragma("unroll") for (int m = 0; m < 4; ++m) _Pragma("unroll") for (int n = 0; n < 2; ++n) _Pragma("unroll") for (int k = 0; k < 2; ++k) \
        acc[ai][bj][m][n] = __builtin_amdgcn_mfma_f32_16x16x32_bf16(Bt[n][k], At[m][k], acc[ai][bj][m][n], 0, 0, 0); __builtin_amdgcn_s_setprio(0); } while (0)
#define PG8_WAIT_V(n) asm volatile("s_waitcnt vmcnt(" #n ")" ::: "memory")
#define PG8_WAIT_L(n) asm volatile("s_waitcnt lgkmcnt(" #n ")" ::: "memory")
#define PG8_BAR __builtin_amdgcn_s_barrier()
#define PG8_SCHED __builtin_amdgcn_sched_barrier(0)
    Unit cur, nxt; int ui = 0;
    if (!S.next(0, cur)) return;
    f32x4 acc[2][2][4][2];
#pragma unroll
    for (int a = 0; a < 2; ++a)
#pragma unroll
        for (int b = 0; b < 2; ++b)
#pragma unroll
            for (int m = 0; m < 4; ++m)
#pragma unroll
                for (int n = 0; n < 2; ++n) acc[a][b][m][n] = (f32x4){0.f, 0.f, 0.f, 0.f};
    bf16x8 At[4][2], B0[2][2], B1[2][2];
    const char* cA = (const char*)g.A + (size_t)cur.pm * tstep; const char* cB = (const char*)g.Bt + (size_t)cur.pn * tstep;
    {
        PG8_STAGE(PG8_SB(0, 0), cB, voffB); PG8_STAGE(PG8_SB(0, 1), cB + hstep, voffB); PG8_STAGE(PG8_SA(0, 0), cA, voffA); PG8_STAGE(PG8_SA(0, 1), cA + hstep, voffA);
        if (wr == 1) PG8_BAR;
        PG8_WAIT_V(2); PG8_BAR;
        PG8_STAGE(PG8_SB(1, 0), cB + kstep, voffB); PG8_STAGE(PG8_SA(1, 0), cA + kstep, voffA); PG8_STAGE(PG8_SB(1, 1), cB + hstep + kstep, voffB);
        PG8_WAIT_V(6); PG8_BAR;
    }
    for (;;) {
        const bool has_next = S.next(ui + 1, nxt);
        const char* nA = has_next ? (const char*)g.A + (size_t)nxt.pm * tstep : cA; const char* nB = has_next ? (const char*)g.Bt + (size_t)nxt.pn * tstep : cB;
        for (int t = 0; t < nt; t += 2) {
            const bool last = (t == nt - 2);
            const char* a1 = cA + (size_t)(t + 1) * kstep;
            const char* a2 = last ? nA : cA + (size_t)(t + 2) * kstep; const char* b2 = last ? nB : cB + (size_t)(t + 2) * kstep;
            const char* a3 = a2 + kstep; const char* b3 = b2 + kstep;
            PG8_LDB(B0, 0, 0); PG8_LDB(B1, 0, 1); PG8_SCHED; PG8_LDA(At, 0, 0); PG8_STAGE(PG8_SA(1, 1), a1 + hstep, voffA);
            PG8_WAIT_V(8); PG8_WAIT_L(0); PG8_BAR; PG8_MMA(0, 0, At, B0); PG8_MMA(0, 1, At, B1); PG8_BAR; PG8_SCHED;
            PG8_LDA(At, 0, 1); PG8_STAGE(PG8_SB(0, 0), b2, voffB); PG8_STAGE(PG8_SB(0, 1), b2 + hstep, voffB); PG8_STAGE(PG8_SA(0, 0), a2, voffA);
            PG8_WAIT_V(8); PG8_WAIT_L(0); PG8_BAR; PG8_MMA(1, 0, At, B0); PG8_MMA(1, 1, At, B1); PG8_BAR; PG8_SCHED;
            PG8_LDB(B0, 1, 0); PG8_LDB(B1, 1, 1); PG8_SCHED; PG8_LDA(At, 1, 0); PG8_STAGE(PG8_SA(0, 1), a2 + hstep, voffA);
            PG8_WAIT_V(8); PG8_WAIT_L(0); PG8_BAR; PG8_MMA(0, 0, At, B0); PG8_MMA(0, 1, At, B1); PG8_BAR; PG8_SCHED;
            PG8_LDA(At, 1, 1); PG8_STAGE(PG8_SB(1, 0), b3, voffB); PG8_STAGE(PG8_SB(1, 1), b3 + hstep, voffB); PG8_STAGE(PG8_SA(1, 0), a3, voffA);
            PG8_WAIT_V(8); PG8_WAIT_L(0); PG8_BAR; PG8_MMA(1, 0, At, B0); PG8_MMA(1, 1, At, B1); PG8_BAR; PG8_SCHED;
        }
        if (wr == 0) PG8_BAR;
        E(acc, cur, wr, wc, fr, fq);
        if (!has_next) break;
#pragma unroll
        for (int a = 0; a < 2; ++a)
#pragma unroll
            for (int b = 0; b < 2; ++b)
#pragma unroll
                for (int m = 0; m < 4; ++m)
#pragma unroll
                    for (int n = 0; n < 2; ++n) acc[a][b][m][n] = (f32x4){0.f, 0.f, 0.f, 0.f};
        cur = nxt; cA = nA; cB = nB; ++ui;
        if (wr == 1) PG8_BAR;
    }
    PG8_WAIT_V(0);
    PG8_BAR;
#undef PG8_SA
#undef PG8_SB
#undef PG8_STAGE
#undef PG8_LDA
#undef PG8_LDB
#undef PG8_MMA
#undef PG8_WAIT_V
#undef PG8_WAIT_L
#undef PG8_BAR
#undef PG8_SCHED
}

struct EpiScaleBf16 {
    bf16_t* O; int ldc; const float* rowss; bf16_t* O2; int ldc2; int split_tile; bf16_t* KD2;
    const LAS float* tab; int pm0;
    __device__ __forceinline__ void operator()(const f32x4 (&acc)[2][2][4][2], const Unit& u, int wr, int wc, int fr, int fq) const {
        const bool hi = u.pn >= split_tile, mid = (split_tile == 8) && u.pn >= 4 && u.pn < 8;
        const int row0 = u.pm * BM + wr * 64 + fr, col0 = (hi ? u.pn - split_tile : u.pn) * BM + wc * 32 + 8 * fq;
        bf16_t* const Ob = hi ? O2 : O; const int ld = hi ? ldc2 : ldc;
#pragma unroll
        for (int ai = 0; ai < 2; ++ai)
#pragma unroll
            for (int m = 0; m < 4; ++m) { const int row = row0 + ai * HALF + m * 16;
                const float sc = !rowss ? 1.f : ((tab && u.pm == pm0) ? tab[row & 255] : row_rstd(rowss, row));
                bf16_t* rowp = Ob + (size_t)row * ld + col0;
#pragma unroll
                for (int bj = 0; bj < 2; ++bj) { const f32x4 v0 = acc[ai][bj][m][0] * sc, v1 = acc[ai][bj][m][1] * sc;
                    u32x4 w; w.x = pk2(v0[0], v0[1]); w.y = pk2(v0[2], v0[3]); w.z = pk2(v1[0], v1[1]); w.w = pk2(v1[2], v1[3]);
                    bf16_t* dst = rowp + bj * HALF;
                    if (mid) dst = KD2 + (u.pn >= 6 ? (size_t)8388608 : (size_t)0) + ((size_t)(((row >> 11) * 4 + 2 * (u.pn & 1) + bj) * 2048 + (row & 2047))) * 128 + wc * 32 + 8 * fq;
                    *(u32x4*)dst = w; } }
    }
};
struct EpiSwiGLU {
    bf16_t* O; const float* rowss; const LAS float* tab; int pm0;
    __device__ __forceinline__ void operator()(const f32x4 (&acc)[2][2][4][2], const Unit& u, int wr, int wc, int fr, int fq) const {
        const int row0 = u.pm * BM + wr * 64 + fr, col0 = u.pn * HALF + wc * 32 + 8 * fq;
#pragma unroll
        for (int ai = 0; ai < 2; ++ai)
#pragma unroll
            for (int m = 0; m < 4; ++m) { const int row = row0 + ai * HALF + m * 16;
                const float sc = (tab && u.pm == pm0) ? tab[row & 255] : row_rstd(rowss, row);
                float h[8];
#pragma unroll
                for (int n = 0; n < 2; ++n)
#pragma unroll
                    for (int j = 0; j < 4; ++j) { const float gt = acc[ai][0][m][n][j] * sc, up = acc[ai][1][m][n][j] * sc; h[n * 4 + j] = gt * __builtin_amdgcn_rcpf(1.f + __expf(-gt)) * up; }
                u32x4 w; w.x = pk2(h[0], h[1]); w.y = pk2(h[2], h[3]); w.z = pk2(h[4], h[5]); w.w = pk2(h[6], h[7]);
                *(u32x4*)(O + (size_t)row * DFF + col0) = w; }
    }
};
struct EpiResid {
    float* X; bf16_t* XB; float* rowss_next;
    __device__ __forceinline__ void operator()(const f32x4 (&acc)[2][2][4][2], const Unit& u, int wr, int wc, int fr, int fq) const {
        const int row0 = u.pm * BM + wr * 64 + fr, col0 = u.pn * BM + wc * 32 + 8 * fq;
#pragma unroll
        for (int ai = 0; ai < 2; ++ai)
#pragma unroll
            for (int m = 0; m < 4; ++m) { const int row = row0 + ai * HALF + m * 16; float ss = 0.f;
                float* xp = X + (size_t)row * DM + col0; bf16_t* bp = XB + (size_t)row * DM + col0;
#pragma unroll
                for (int bj = 0; bj < 2; ++bj) {
                    f32x4 x0 = *(f32x4*)(xp + bj * HALF), x1 = *(f32x4*)(xp + bj * HALF + 4);
                    x0 = x0 + acc[ai][bj][m][0]; x1 = x1 + acc[ai][bj][m][1];
                    *(f32x4*)(xp + bj * HALF) = x0; *(f32x4*)(xp + bj * HALF + 4) = x1;
                    ss += (x0[0] * x0[0] + x0[1] * x0[1]) + (x0[2] * x0[2] + x0[3] * x0[3]) + (x1[0] * x1[0] + x1[1] * x1[1]) + (x1[2] * x1[2] + x1[3] * x1[3]);
                    u32x4 w; w.x = pk2(x0[0], x0[1]); w.y = pk2(x0[2], x0[3]); w.z = pk2(x1[0], x1[1]); w.w = pk2(x1[2], x1[3]);
                    *(u32x4*)(bp + bj * HALF) = w; }
                ss += __shfl_xor(ss, 16); ss += __shfl_xor(ss, 32);
                if (fq == 0) rowss_next[(size_t)row * 16 + u.pn * 4 + wc] = ss; }
    }
};
}

struct KArgs { const float* in[31]; float* out; unsigned char* ws; };
#define CAS __attribute__((address_space(4)))
struct InProxy { const CAS unsigned long long* k; __device__ __forceinline__ const float* operator[](int i) const { return (const float*)k[i]; } };
struct Params { InProxy in; float* out; unsigned char* ws; };
__device__ __forceinline__ Params make_params() {
    unsigned long long kv = (unsigned long long)__builtin_amdgcn_kernarg_segment_ptr();
    asm volatile("" : "+s"(kv));
    const CAS unsigned long long* k = (const CAS unsigned long long*)kv;
    Params p; p.in.k = k; p.out = (float*)k[31]; p.ws = (unsigned char*)k[32]; return p;
}

struct Frame {
    LAS unsigned char* lds;
    int tid, lane, wave, G, bid;
};

#define REFRAME(F) do { int _t = threadIdx.x; asm volatile("" : "+v"(_t)); (F).tid = _t; (F).lane = _t & 63; (F).wave = __builtin_amdgcn_readfirstlane(_t >> 6); } while (0)
__device__ __forceinline__ void cvt_item(const float* W_, int K, int ldn, int nblk, bf16_t* WT_, const float* gain_, bool perm_gu, LAS float* scr, int item, int lane) {
    const GAS float* W = (const GAS float*)W_; const GAS float* gain = (const GAS float*)gain_; GAS bf16_t* WT = (GAS bf16_t*)WT_;
    const int kb = item / nblk, nb = item % nblk, k0 = 64 * kb, n0d = 32 * nb;
    const int n0s = perm_gu ? (((n0d & 255) >> 7) * DFF + (n0d >> 8) * 128 + (n0d & 127)) : n0d;
    float v[32];
#pragma unroll
    for (int i = 0; i < 32; ++i) v[i] = W[(size_t)(k0 + 2 * i + (lane >> 5)) * ldn + n0s + (lane & 31)];
    if (gain_) {
#pragma unroll
        for (int i = 0; i < 32; ++i) v[i] *= gain[k0 + 2 * i + (lane >> 5)];
    }
#pragma unroll
    for (int i = 0; i < 32; ++i) scr[(2 * i + (lane >> 5)) * 33 + (lane & 31)] = v[i];
    asm volatile("s_waitcnt lgkmcnt(0)" ::: "memory");
    const int c = lane & 7;
#pragma unroll
    for (int j = 0; j < 4; ++j) { const int n = (lane >> 3) + 8 * j; const LAS float* sp = scr + (8 * c) * 33 + n;
        u32x4 o; o.x = pk2(sp[0 * 33], sp[1 * 33]); o.y = pk2(sp[2 * 33], sp[3 * 33]); o.z = pk2(sp[4 * 33], sp[5 * 33]); o.w = pk2(sp[6 * 33], sp[7 * 33]);
        *(GAS u32x4*)(WT + (size_t)(n0d + n) * K + k0 + 8 * c) = o; }
    asm volatile("s_waitcnt lgkmcnt(0)" ::: "memory");
}
constexpr int CV_IN = 1536, CV_OUT = 512, CV_Q = 256, CV_KV = 512, CV_O = 256, CV_GU = 2816, CV_DOWN = 1408, CV_L = 8;
constexpr int CV_TOTAL = CV_IN + CV_OUT + CV_Q + CV_KV + CV_O + CV_GU + CV_DOWN + 2 * CV_L + 2 * CV_L + 16;

static_assert(CV_TOTAL % 8 == 0, "conversion items per layer");
constexpr int CV_A = CV_IN + 2 * CV_L + 2 * CV_L + 16, CV_B = CV_KV + CV_OUT + CV_Q + CV_O + CV_GU + CV_DOWN;
static_assert(CV_A % 8 == 0 && CV_B % 8 == 0 && CV_A + CV_B == CV_TOTAL, "conversion lists");
__device__ __forceinline__ void cvt_item_a(const Params& p, int l, bf16_t* wb, LAS float* scr, int it, int lane) {
    int r = it;
    if (r < CV_IN) { cvt_item(p.in[3] + (size_t)l * DM * INW, DM, INW, INW / 32, wb + WO_IN, p.in[2] + l * DM, false, scr, r, lane); return; } r -= CV_IN;
    if (r < 2 * CV_L) { const int d = r / CV_L; cvt_item(p.in[12] + ((size_t)l * 2 + d) * 64 * 256, 64, 256, 8, wb + WO_WUP + d * 256 * 64, nullptr, false, scr, r % CV_L, lane); return; } r -= 2 * CV_L;
    if (r < 2 * CV_L) { const int d = r / CV_L; cvt_item(p.in[14] + ((size_t)l * 2 + d) * 64 * 256, 64, 256, 8, wb + WO_AUP + d * 256 * 64, nullptr, false, scr, r % CV_L, lane); return; } r -= 2 * CV_L;
    cvt_item(p.in[15] + (size_t)l * 128 * 256, 128, 256, 8, wb + WO_GUP, nullptr, false, scr, r, lane);
}
__device__ __forceinline__ void cvt_item_b(const Params& p, int l, bf16_t* wb, LAS float* scr, int it, int lane) {
    int r = it;
    if (r < CV_KV) { cvt_item(p.in[25] + (size_t)l * DM * 1024, DM, 1024, 32, wb + WO_KV, nullptr, false, scr, r, lane); return; } r -= CV_KV;
    if (r < CV_OUT) { cvt_item(p.in[21] + (size_t)l * DM * DM, DM, DM, DM / 32, wb + WO_OUT, nullptr, false, scr, r, lane); return; } r -= CV_OUT;
    if (r < CV_Q) { cvt_item(p.in[24] + (size_t)l * DM * XW, DM, XW, XW / 32, wb + WO_Q, p.in[22] + l * DM, false, scr, r, lane); return; } r -= CV_Q;
    if (r < CV_O) { cvt_item(p.in[26] + (size_t)l * XW * DM, XW, DM, 32, wb + WO_O, nullptr, false, scr, r, lane); return; } r -= CV_O;
    if (r < CV_GU) { cvt_item(p.in[28] + (size_t)l * DM * 2 * DFF, DM, 2 * DFF, 2 * DFF / 32, wb + WO_GU, p.in[27] + l * DM, true, scr, r, lane); return; } r -= CV_GU;
    cvt_item(p.in[29] + (size_t)l * DFF * DM, DFF, DM, 32, wb + WO_DOWN, nullptr, false, scr, r, lane);
}

__device__ __forceinline__ s16x4 vtr(const LAS unsigned char* p) { return __builtin_bit_cast(s16x4, __builtin_amdgcn_ds_read_tr16_b64_v4i16((LAS v4i16_t*)p)); }
__device__ __forceinline__ int crow(int r, int hi) { return (r & 3) + 8 * (r >> 2) + 4 * hi; }

template <int W> __device__ __forceinline__ void tile_load(u32x4 (&r)[W / 64], const bf16_t* g, int pitch, int tid) {
#pragma unroll
    for (int i = 0; i < W / 64; ++i) { const int id = tid + i * 512, row = id / (W / 8), ch = id % (W / 8); r[i] = *(const GAS u32x4*)((const GAS bf16_t*)g + (size_t)row * pitch + ch * 8); }
}
template <int W, int STR> __device__ __forceinline__ void tile_store(const u32x4 (&r)[W / 64], LAS unsigned char* buf, int tid) {
#pragma unroll
    for (int i = 0; i < W / 64; ++i) { const int id = tid + i * 512, row = id / (W / 8), ch = id % (W / 8); *(LAS u32x4*)(buf + row * STR + ch * 16) = r[i]; }
}
template <int DQK> __device__ __forceinline__ void load_q(bf16x8 (&qf)[DQK / 16], const bf16_t* qrow, int h, float sc) {
#pragma unroll
    for (int ks = 0; ks < DQK / 16; ++ks) { const u32x4 v = *(const GAS u32x4*)((const GAS bf16_t*)qrow + 16 * ks + 8 * h);
        u32x4 o; o.x = pk2(bflo(v.x) * sc, bfhi(v.x) * sc); o.y = pk2(bflo(v.y) * sc, bfhi(v.y) * sc); o.z = pk2(bflo(v.z) * sc, bfhi(v.z) * sc); o.w = pk2(bflo(v.w) * sc, bfhi(v.w) * sc);
        qf[ks] = __builtin_bit_cast(bf16x8, o); }
}
template <int DQK, int KW, int DV, int MODE>
__device__ __forceinline__ void attn_loop(LAS unsigned char* lds, const bf16_t* Kg, int kpitch, const bf16_t* Vg, int vpitch, int ntiles,
                                          const bf16x8 (&qf)[DQK / 16], int koff, float nslope2, int qrel, float& m, float& lsum, f32x16 (&o)[DV / 32]) {
    constexpr int KSTR = (KW + 8) * 2, VSTR = DV * 2 + 64, KBUF = 64 * KSTR, VBUF = 64 * VSTR;
    int tid_ = threadIdx.x; asm volatile("" : "+v"(tid_));
    const int tid = tid_, lane = tid & 63, r = lane & 31, h = lane >> 5;
    LAS unsigned char* K0 = lds; LAS unsigned char* V0 = lds + 2 * KBUF;
    u32x4 kr[KW / 64], vr[DV / 64];
    tile_load<KW>(kr, Kg, kpitch, tid); tile_load<DV>(vr, Vg, vpitch, tid);
    tile_store<KW, KSTR>(kr, K0, tid); tile_store<DV, VSTR>(vr, V0, tid);
    __syncthreads();
    const int vlane = ((lane & 15) >> 2) * VSTR + (16 * ((lane >> 4) & 1) + 4 * (lane & 3)) * 2 + 4 * h * VSTR;
    for (int t = 0; t < ntiles; ++t) {
        const int cur = t & 1;
        if (t + 1 < ntiles) { tile_load<KW>(kr, Kg + (size_t)(t + 1) * 64 * kpitch, kpitch, tid); tile_load<DV>(vr, Vg + (size_t)(t + 1) * 64 * vpitch, vpitch, tid); }
        const LAS unsigned char* Kb = K0 + cur * KBUF + r * KSTR + (koff + 8 * h) * 2;
        const LAS unsigned char* Vb = V0 + cur * VBUF + vlane;
        f32x16 s0, s1;
#pragma unroll
        for (int i = 0; i < 16; ++i) { s0[i] = 0.f; s1[i] = 0.f; }
#pragma unroll
        for (int ks = 0; ks < DQK / 16; ++ks) {
            const bf16x8 k0 = *(const LAS bf16x8*)(Kb + ks * 32), k1 = *(const LAS bf16x8*)(Kb + 32 * KSTR + ks * 32);
            s0 = __builtin_amdgcn_mfma_f32_32x32x16_bf16(k0, qf[ks], s0, 0, 0, 0);
            s1 = __builtin_amdgcn_mfma_f32_32x32x16_bf16(k1, qf[ks], s1, 0, 0, 0);
        }
        float Aoff = 0.f;
        if (MODE >= 1) {
            const int qrel0 = __builtin_amdgcn_readfirstlane(qrel - r);
            const int T0 = t * 64;
            if (MODE == 1 && (T0 + 64 <= qrel0 || T0 > qrel0 + 31)) {
                const bool left = (T0 + 64 <= qrel0);
                const float sl = left ? -nslope2 : nslope2;
                Aoff = left ? nslope2 * (float)(qrel - T0 - 4 * h) : nslope2 * (float)(T0 + 4 * h - qrel);
#pragma unroll
                for (int i = 0; i < 16; ++i) { s0[i] = __builtin_fmaf(sl, (float)((i & 3) + 8 * (i >> 2)), s0[i]); s1[i] = __builtin_fmaf(sl, (float)(32 + (i & 3) + 8 * (i >> 2)), s1[i]); }
            } else {
                const float base = (float)(T0 + 4 * h - qrel);
#pragma unroll
                for (int i = 0; i < 16; ++i) {
                    const float d0 = fabsf(base + (float)((i & 3) + 8 * (i >> 2))), d1 = fabsf(base + (float)(32 + (i & 3) + 8 * (i >> 2)));
                    s0[i] = __builtin_fmaf(d0, nslope2, s0[i]); s1[i] = __builtin_fmaf(d1, nslope2, s1[i]);
                    if (MODE == 2) { if (d0 > 128.f) s0[i] = -1e30f; if (d1 > 128.f) s1[i] = -1e30f; }
                }
            }
        }
        float mx = fmaxf(s0[0], s1[0]);
#pragma unroll
        for (int i = 1; i < 16; ++i) mx = fmaxf(fmaxf(mx, s0[i]), s1[i]);
        mx += Aoff;
        mx = fmaxf(mx, xhalf(mx));
        const float mnew = fmaxf(m, mx);
        if (__builtin_amdgcn_ballot_w64(mnew > m) != 0ull) {
            const float alpha = __builtin_amdgcn_exp2f(m - mnew);
            lsum *= alpha;
#pragma unroll
            for (int d = 0; d < DV / 32; ++d) o[d] = o[d] * alpha;
        }
        m = mnew;
        const float mm = mnew - Aoff;
        float rs = 0.f;
#pragma unroll
        for (int i = 0; i < 16; ++i) { s0[i] = __builtin_amdgcn_exp2f(s0[i] - mm); s1[i] = __builtin_amdgcn_exp2f(s1[i] - mm); rs += s0[i] + s1[i]; }
        lsum += rs;
        bf16x8 pf[4];
#pragma unroll
        for (int s2 = 0; s2 < 2; ++s2) {
            u32x4 a, b;
            a.x = pk2(s0[8 * s2 + 0], s0[8 * s2 + 1]); a.y = pk2(s0[8 * s2 + 2], s0[8 * s2 + 3]); a.z = pk2(s0[8 * s2 + 4], s0[8 * s2 + 5]); a.w = pk2(s0[8 * s2 + 6], s0[8 * s2 + 7]);
            b.x = pk2(s1[8 * s2 + 0], s1[8 * s2 + 1]); b.y = pk2(s1[8 * s2 + 2], s1[8 * s2 + 3]); b.z = pk2(s1[8 * s2 + 4], s1[8 * s2 + 5]); b.w = pk2(s1[8 * s2 + 6], s1[8 * s2 + 7]);
            pf[s2] = __builtin_bit_cast(bf16x8, a); pf[2 + s2] = __builtin_bit_cast(bf16x8, b);
        }
#pragma unroll
        for (int d = 0; d < DV / 32; ++d) {
#pragma unroll
            for (int kk = 0; kk < 4; ++kk) {
                const s16x4 lo = vtr(Vb + (16 * kk) * VSTR + d * 64), hi = vtr(Vb + (16 * kk + 8) * VSTR + d * 64);
                const bf16x8 vf = {lo[0], lo[1], lo[2], lo[3], hi[0], hi[1], hi[2], hi[3]};
                o[d] = __builtin_amdgcn_mfma_f32_32x32x16_bf16(vf, pf[kk], o[d], 0, 0, 0);
            }
        }
        if (t + 1 < ntiles) { tile_store<KW, KSTR>(kr, K0 + (cur ^ 1) * KBUF, tid); tile_store<DV, VSTR>(vr, V0 + (cur ^ 1) * VBUF, tid); }
        __syncthreads();
    }
}
__device__ __forceinline__ int swz(int row) { return ((row & 3) << 2) | ((row >> 2) & 3); }
template <int DQK, int MODE, int pitch, int voff>
__device__ __forceinline__ void attn_loop_dma(LAS unsigned char* lds, const int wave, const bf16_t* Kg, int ntiles,
                                              const bf16x8 (&qf)[DQK / 16], int koff, float nslope2, int qrel, float& m, float& lsum, f32x16 (&o)[4]) {
    constexpr int DV = 128, STAGE = 32768, VOFFB = 16384;
    const int lane = hw_lane(), r = lane & 31, h = lane >> 5;
    unsigned gk[2];
#pragma unroll
    for (int i = 0; i < 2; ++i) { const int row = 4 * (2 * wave + i) + (lane >> 4), c = (lane & 15) ^ swz(row); gk[i] = (unsigned)(row * pitch + c * 8); }
    unsigned kad[DQK / 16], vad[4][2];
#pragma unroll
    for (int ks = 0; ks < DQK / 16; ++ks) kad[ks] = (unsigned)(r * 256 + 16 * (((koff >> 3) + 2 * ks + h) ^ swz(r)));
    { const int q_ = (lane & 15) >> 2, pp = lane & 3, g1 = (lane >> 4) & 1;
#pragma unroll
      for (int d = 0; d < 4; ++d)
#pragma unroll
          for (int hi = 0; hi < 2; ++hi) { const int f = (q_ << 2) | ((2 * hi + h) & 3), c = (4 * d + 2 * g1 + (pp >> 1)) ^ f;
              vad[d][hi] = (unsigned)(VOFFB + (4 * h + q_) * 256 + 16 * c + 8 * (pp & 1) + hi * 2048); } }
#define ATT_DMA(tt, st) do { const bf16_t* kg_ = Kg + (size_t)(tt) * 64 * pitch; _Pragma("unroll") for (int i_ = 0; i_ < 2; ++i_) { \
        __builtin_amdgcn_global_load_lds((const unsigned*)(kg_ + gk[i_]), (LAS unsigned*)(lds + (st) * STAGE + (2 * wave + i_) * 1024), 16, 0, 0); \
        __builtin_amdgcn_global_load_lds((const unsigned*)(kg_ + voff + gk[i_]), (LAS unsigned*)(lds + (st) * STAGE + VOFFB + (2 * wave + i_) * 1024), 16, 0, 0); } } while (0)
    ATT_DMA(0, 0);
    if (ntiles > 1) ATT_DMA(1, 1);
    if (ntiles > 2) { ATT_DMA(2, 2); asm volatile("s_waitcnt vmcnt(4)" ::: "memory"); } else asm volatile("s_waitcnt vmcnt(0)" ::: "memory");
    __builtin_amdgcn_s_barrier();
    f32x16 s0, s1;
#pragma unroll
    for (int i = 0; i < 16; ++i) { s0[i] = 0.f; s1[i] = 0.f; }
#pragma unroll
    for (int ks = 0; ks < DQK / 16; ++ks) {
        const bf16x8 k0 = *(const LAS bf16x8*)(lds + kad[ks]), k1 = *(const LAS bf16x8*)(lds + kad[ks] + 8192);
        s0 = __builtin_amdgcn_mfma_f32_32x32x16_bf16(k0, qf[ks], s0, 0, 0, 0);
        s1 = __builtin_amdgcn_mfma_f32_32x32x16_bf16(k1, qf[ks], s1, 0, 0, 0);
    }
#define LDS_RD128(dst, addr, off) asm volatile("ds_read_b128 %0, %1 offset:%c2" : "=&v"(dst) : "v"(addr), "i"(off) : "memory")
#define LDS_RDTR(dst, addr, off) asm volatile("ds_read_b64_tr_b16 %0, %1 offset:%c2" : "=&v"(dst) : "v"(addr), "i"(off) : "memory")
#define LDS_WAIT0() do { asm volatile("s_waitcnt lgkmcnt(0)" ::: "memory"); __builtin_amdgcn_sched_barrier(0); } while (0)
    for (int t = 0; t < ntiles; ++t) {
        if (t + 3 < ntiles) ATT_DMA(t + 3, (t + 3) & 3);
        const unsigned sba = (unsigned)(size_t)(lds + (t & 3) * STAGE), sna = (unsigned)(size_t)(lds + ((t + 1) & 3) * STAGE);
        constexpr int KH = (DQK == 64) ? 4 : 4;
        bf16x8 kf0[KH], kf1[KH];
        s16x4 va_lo[4], va_hi[4], vb_lo[4], vb_hi[4];
        if (DQK == 64) {
#pragma unroll
            for (int ks = 0; ks < KH; ++ks) { const unsigned ka = sna + kad[ks]; LDS_RD128(kf0[ks], ka, 0); } }
        __builtin_amdgcn_sched_barrier(0);
        float Aoff = 0.f;
        if (MODE >= 1) {
            const int qrel0 = __builtin_amdgcn_readfirstlane(qrel - r);
            const int T0 = t * 64;
            if (MODE == 1 && (T0 + 64 <= qrel0 || T0 > qrel0 + 31)) {
                const bool left = (T0 + 64 <= qrel0);
                const float sl = left ? -nslope2 : nslope2;
                Aoff = left ? nslope2 * (float)(qrel - T0 - 4 * h) : nslope2 * (float)(T0 + 4 * h - qrel);
#pragma unroll
                for (int i = 0; i < 16; ++i) { s0[i] = __builtin_fmaf(sl, (float)((i & 3) + 8 * (i >> 2)), s0[i]); s1[i] = __builtin_fmaf(sl, (float)(32 + (i & 3) + 8 * (i >> 2)), s1[i]); }
            } else {
                const float base = (float)(T0 + 4 * h - qrel);
#pragma unroll
                for (int i = 0; i < 16; ++i) {
                    const float d0 = fabsf(base + (float)((i & 3) + 8 * (i >> 2))), d1 = fabsf(base + (float)(32 + (i & 3) + 8 * (i >> 2)));
                    s0[i] = __builtin_fmaf(d0, nslope2, s0[i]); s1[i] = __builtin_fmaf(d1, nslope2, s1[i]);
                    if (MODE == 2) { if (d0 > 128.f) s0[i] = -1e30f; if (d1 > 128.f) s1[i] = -1e30f; }
                }
            }
        }
        float mx = fmaxf(s0[0], s1[0]);
#pragma unroll
        for (int i = 1; i < 16; ++i) mx = fmaxf(fmaxf(mx, s0[i]), s1[i]);
        mx += Aoff;
        mx = fmaxf(mx, xhalf(mx));
        const float mnew = fmaxf(m, mx);
        if (__builtin_amdgcn_ballot_w64(mnew > m) != 0ull) {
            const float alpha = __builtin_amdgcn_exp2f(m - mnew);
            lsum *= alpha;
#pragma unroll
            for (int d = 0; d < DV / 32; ++d) o[d] = o[d] * alpha;
        }
        m = mnew;
        const float mm = mnew - Aoff;
        float rs = 0.f;
#pragma unroll
        for (int i = 0; i < 16; ++i) { s0[i] = __builtin_amdgcn_exp2f(s0[i] - mm); s1[i] = __builtin_amdgcn_exp2f(s1[i] - mm); rs += s0[i] + s1[i]; }
        lsum += rs;
        bf16x8 pf[4];
#pragma unroll
        for (int s2 = 0; s2 < 2; ++s2) {
            u32x4 a, b;
            a.x = pk2(s0[8 * s2 + 0], s0[8 * s2 + 1]); a.y = pk2(s0[8 * s2 + 2], s0[8 * s2 + 3]); a.z = pk2(s0[8 * s2 + 4], s0[8 * s2 + 5]); a.w = pk2(s0[8 * s2 + 6], s0[8 * s2 + 7]);
            b.x = pk2(s1[8 * s2 + 0], s1[8 * s2 + 1]); b.y = pk2(s1[8 * s2 + 2], s1[8 * s2 + 3]); b.z = pk2(s1[8 * s2 + 4], s1[8 * s2 + 5]); b.w = pk2(s1[8 * s2 + 6], s1[8 * s2 + 7]);
            pf[s2] = __builtin_bit_cast(bf16x8, a); pf[2 + s2] = __builtin_bit_cast(bf16x8, b);
        }
        LDS_WAIT0();
        if (DQK == 64) {
#pragma unroll
            for (int ks = 0; ks < KH; ++ks) { const unsigned ka = sna + kad[ks]; LDS_RD128(kf1[ks], ka, 8192); } }
        { const unsigned alo = sba + vad[0][0], ahi = sba + vad[0][1];
#pragma unroll
          for (int kk = 0; kk < 4; ++kk) { LDS_RDTR(va_lo[kk], alo, kk * 4096); LDS_RDTR(va_hi[kk], ahi, kk * 4096); } }
        __builtin_amdgcn_sched_barrier(0);
        f32x16 n0, n1;
#pragma unroll
        for (int i = 0; i < 16; ++i) { n0[i] = 0.f; n1[i] = 0.f; }
#pragma unroll
        for (int g = 0; g < DQK / 64; ++g) {
            if (DQK != 64) {
#pragma unroll
                for (int ks = 0; ks < KH; ++ks) { const unsigned ka = sna + kad[g * KH + ks]; LDS_RD128(kf0[ks], ka, 0); LDS_RD128(kf1[ks], ka, 8192); }
                LDS_WAIT0(); }
#pragma unroll
            for (int ks = 0; ks < KH; ++ks) n0 = __builtin_amdgcn_mfma_f32_32x32x16_bf16(kf0[ks], qf[g * KH + ks], n0, 0, 0, 0);
            if (DQK == 64) LDS_WAIT0();
#pragma unroll
            for (int ks = 0; ks < KH; ++ks) n1 = __builtin_amdgcn_mfma_f32_32x32x16_bf16(kf1[ks], qf[g * KH + ks], n1, 0, 0, 0);
        }
#define PV_BLOCK(d, lo, hi) do { _Pragma("unroll") for (int kk = 0; kk < 4; ++kk) { const bf16x8 vf = {lo[kk][0], lo[kk][1], lo[kk][2], lo[kk][3], hi[kk][0], hi[kk][1], hi[kk][2], hi[kk][3]}; \
            o[d] = __builtin_amdgcn_mfma_f32_32x32x16_bf16(vf, pf[kk], o[d], 0, 0, 0); } } while (0)
#define V_ISSUE(d, lo, hi) do { const unsigned alo_ = sba + vad[d][0], ahi_ = sba + vad[d][1]; _Pragma("unroll") for (int kk = 0; kk < 4; ++kk) { LDS_RDTR(lo[kk], alo_, kk * 4096); LDS_RDTR(hi[kk], ahi_, kk * 4096); } } while (0)
        LDS_WAIT0();
        V_ISSUE(1, vb_lo, vb_hi); __builtin_amdgcn_sched_barrier(0);
        PV_BLOCK(0, va_lo, va_hi);
        LDS_WAIT0();
        V_ISSUE(2, va_lo, va_hi); __builtin_amdgcn_sched_barrier(0);
        PV_BLOCK(1, vb_lo, vb_hi);
        LDS_WAIT0();
        V_ISSUE(3, vb_lo, vb_hi); __builtin_amdgcn_sched_barrier(0);
        PV_BLOCK(2, va_lo, va_hi);
        LDS_WAIT0();
        PV_BLOCK(3, vb_lo, vb_hi);
#undef PV_BLOCK
#undef V_ISSUE
        s0 = n0; s1 = n1;
        if (t + 3 < ntiles) asm volatile("s_waitcnt vmcnt(4)" ::: "memory"); else asm volatile("s_waitcnt vmcnt(0)" ::: "memory");
        __builtin_amdgcn_s_barrier();
    }
#undef LDS_RD128
#undef LDS_RDTR
#undef LDS_WAIT0
#undef ATT_DMA
}
template <int DV> __device__ __forceinline__ void store_o(const f32x16 (&o)[DV / 32], float sc, bf16_t* orow, int h) {
#pragma unroll
    for (int d = 0; d < DV / 32; ++d)
#pragma unroll
        for (int g4 = 0; g4 < 4; ++g4) { u32x2 w; w.x = pk2(o[d][4 * g4] * sc, o[d][4 * g4 + 1] * sc); w.y = pk2(o[d][4 * g4 + 2] * sc, o[d][4 * g4 + 3] * sc);
            *(GAS u32x2*)((GAS bf16_t*)orow + 32 * d + 8 * g4 + 4 * h) = w; }
}

__device__ __forceinline__ void win_unit(Frame& F, const Params& p, int l, int u) {
    REFRAME(F);
    const bf16_t* Z = (const bf16_t*)(p.ws + WS_Z); bf16_t* MIX = (bf16_t*)(p.ws + WS_MIX);
    const int b = u >> 5, kvh = (u >> 4) & 1, nb = u & 15, r = F.lane & 31, h = F.lane >> 5;
    const int g = F.wave >> 2, hq = kvh * 2 + g, qpos = nb * 128 + (F.wave & 3) * 32 + r;
    const size_t tok = (size_t)b * SEQ + qpos;
    bf16x8 qf[4]; load_q<64>(qf, Z + tok * ZP + hq * 64, h, 0.125f * LOG2E);
    const int first = (2 * nb - 2 < 0) ? 0 : 2 * nb - 2, lastx = (2 * nb + 4 > 32) ? 32 : 2 * nb + 4, nt = lastx - first;
    const float slope = exp2f(-(float)(2 * hq + 1));
    float m = p.in[4][l * 4 + hq] * LOG2E, ls = (h == 0) ? 1.f : 0.f;
    f32x16 o[2];
#pragma unroll
    for (int d = 0; d < 2; ++d)
#pragma unroll
        for (int i = 0; i < 16; ++i) o[d][i] = 0.f;
    const bf16_t* Kg = Z + ((size_t)b * SEQ + first * 64) * ZP + 256 + kvh * 64;
    attn_loop<64, 64, 64, 2>(F.lds, Kg, ZP, Kg + 128, ZP, nt, qf, 0, -slope * LOG2E, qpos - first * 64, m, ls, o);
    const float lt = ls + xhalf(ls);
    store_o<64>(o, 1.f / lt, MIX + tok * DM + hq * 64, h);
}
__device__ __forceinline__ void diff_unit(Frame& F, const Params& p, int l, int u) {
    REFRAME(F);
    const bf16_t* Z = (const bf16_t*)(p.ws + WS_Z); bf16_t* MIX = (bf16_t*)(p.ws + WS_MIX);
    const int b = u >> 6, hh = (u >> 4) & 3, qb = u & 15, r = F.lane & 31, h = F.lane >> 5;
    const int c = F.wave >> 2, qpos = qb * 128 + (F.wave & 3) * 32 + r;
    const size_t tok = (size_t)b * SEQ + qpos;
    float lam, lam_init;
    {
        const float a1 = wave_sum(p.in[5][l * 64 + F.lane] * p.in[6][l * 64 + F.lane]), a2 = wave_sum(p.in[7][l * 64 + F.lane] * p.in[8][l * 64 + F.lane]);
        lam_init = 0.8f - 0.6f * expf(-0.3f * (float)l);
        lam = expf(a1) - expf(a2) + lam_init;
    }
    bf16x8 qf[4]; load_q<64>(qf, Z + tok * ZP + 512 + hh * 128 + c * 64, h, 0.125f * LOG2E);
    const float slope = exp2f(-(float)(2 * hh + 2));
    float m = -1e30f, ls = 0.f;
    f32x16 o[4];
#pragma unroll
    for (int d = 0; d < 4; ++d)
#pragma unroll
        for (int i = 0; i < 16; ++i) o[d][i] = 0.f;
    const bf16_t* Kg = (const bf16_t*)(p.ws + WS_KD2) + (size_t)(b * 4 + hh) * 2048 * 128;
    attn_loop_dma<64, 1, 128, 8388608>(F.lds, F.wave, Kg, 32, qf, c * 64, -slope * LOG2E, qpos, m, ls, o);
    const float inv = 1.f / (ls + xhalf(ls));
    LAS float* comb = (LAS float*)F.lds + (size_t)(F.wave & 3) * 64 * 64 + F.lane;
    if (c == 1) {
#pragma unroll
        for (int d = 0; d < 4; ++d)
#pragma unroll
            for (int i = 0; i < 16; ++i) comb[(d * 16 + i) * 64] = o[d][i] * inv;
    }
    __syncthreads();
    if (c == 0) {
        float ss = 0.f;
#pragma unroll
        for (int d = 0; d < 4; ++d)
#pragma unroll
            for (int i = 0; i < 16; ++i) { const float a = o[d][i] * inv - lam * comb[(d * 16 + i) * 64]; o[d][i] = a; ss += a * a; }
        ss += xhalf(ss);
        const float rn = rsqrtf(ss * (1.f / 128.f) + 1e-6f) * (1.f - lam_init);
        const float* sg = p.in[9] + l * 128;
        bf16_t* orow = MIX + tok * DM + 256 + hh * 128;
        f32x4 ggv[4][4];
#pragma unroll
        for (int d = 0; d < 4; ++d)
#pragma unroll
            for (int g4 = 0; g4 < 4; ++g4) ggv[d][g4] = *(const GAS f32x4*)((const GAS float*)sg + 32 * d + 8 * g4 + 4 * h);
#pragma unroll
        for (int d = 0; d < 4; ++d)
#pragma unroll
            for (int g4 = 0; g4 < 4; ++g4) { const int dv = 32 * d + 8 * g4 + 4 * h; const f32x4 gg = ggv[d][g4];
                u32x2 w; w.x = pk2(o[d][4 * g4] * rn * gg[0], o[d][4 * g4 + 1] * rn * gg[1]); w.y = pk2(o[d][4 * g4 + 2] * rn * gg[2], o[d][4 * g4 + 3] * rn * gg[3]);
                *(GAS u32x2*)((GAS bf16_t*)orow + dv) = w; }
    }
    __syncthreads();
}
__device__ __forceinline__ void cross_unit(Frame& F, const Params& p, int u) {
    REFRAME(F);
    const bf16_t* Q = (const bf16_t*)(p.ws + WS_Q); const bf16_t* KV = (const bf16_t*)(p.ws + WS_KV); bf16_t* O = (bf16_t*)(p.ws + WS_O);
    const int b = u >> 5, hd = (u >> 3) & 3, qb = u & 7, r = F.lane & 31, h = F.lane >> 5;
    const size_t tok = (size_t)b * SEQ + qb * 256 + F.wave * 32 + r;
    bf16x8 qf[8]; load_q<128>(qf, Q + tok * XW + hd * 128, h, 0.08838834764831845f * LOG2E);
    float m = -1e30f, ls = 0.f;
    f32x16 o[4];
#pragma unroll
    for (int d = 0; d < 4; ++d)
#pragma unroll
        for (int i = 0; i < 16; ++i) o[d][i] = 0.f;
    const bf16_t* Kg = KV + ((size_t)b * NMEM) * 1024 + hd * 128;
    attn_loop_dma<128, 0, 1024, 512>(F.lds, F.wave, Kg, 4, qf, 0, 0.f, 0, m, ls, o);
    const float lt = ls + xhalf(ls);
    store_o<128>(o, 1.f / lt, O + tok * XW + hd * 128, h);
}

constexpr int CF_STR = 772, PREP_AW = 32 * CF_STR * 4, PREP_AA = PREP_AW + 32 * 72 * 2, PREP_AG = PREP_AA + 32 * 72 * 2;
__device__ __forceinline__ void prep_unit(Frame& F, const Params& p, int l, const bf16_t* wb, int u) {
    REFRAME(F);
    const bf16_t* ZC = (const bf16_t*)(p.ws + WS_ZC);
    const int t0 = u * 32, b = t0 / SEQ;
    LAS float* CF = (LAS float*)F.lds; LAS bf16_t* AW = (LAS bf16_t*)(F.lds + PREP_AW); LAS bf16_t* AA = (LAS bf16_t*)(F.lds + PREP_AA); LAS bf16_t* AG = (LAS bf16_t*)(F.lds + PREP_AG);
    const float* conv = p.in[10] + (size_t)l * 3 * 1024;
    LAS float* PAR = (LAS float*)(F.lds + PREP_AG + 32 * 136 * 2);
    if (F.tid < 448) { const int i = F.tid; const GAS f32x4* src;
        if (i < 64) src = (const GAS f32x4*)((const GAS float*)p.in[16] + l * 256) + i;
        else if (i < 128) src = (const GAS f32x4*)((const GAS float*)p.in[17] + l * 256) + (i - 64);
        else if (i < 192) src = (const GAS f32x4*)((const GAS float*)p.in[18] + l * 256) + (i - 128);
        else if (i < 320) src = (const GAS f32x4*)((const GAS float*)p.in[11] + l * 512) + (i - 192);
        else src = (const GAS f32x4*)((const GAS float*)p.in[13] + l * 512) + (i - 320);
        ((LAS f32x4*)PAR)[i] = *src; }
#pragma unroll 4
    for (int i = 0; i < 8; ++i) {
        const int id = F.tid + i * 512, tk = id >> 7, ch = id & 127, tg = t0 + tk, tpos = tg - b * SEQ;
        const GAS bf16_t* zp = (const GAS bf16_t*)ZC + (size_t)tg * 1024 + ch * 8;
        const u32x4 zc = *(const GAS u32x4*)zp;
        u32x4 zl = {0u, 0u, 0u, 0u}, zr = {0u, 0u, 0u, 0u};
        if (tpos > 0) zl = *(const GAS u32x4*)(zp - 1024);
        if (tpos < SEQ - 1) zr = *(const GAS u32x4*)(zp + 1024);
        float v[8];
#pragma unroll
        for (int q = 0; q < 4; ++q) {
            const f32x2 c0 = *(const GAS f32x2*)((const GAS float*)conv + ch * 8 + 2 * q), c1 = *(const GAS f32x2*)((const GAS float*)conv + 1024 + ch * 8 + 2 * q), c2 = *(const GAS f32x2*)((const GAS float*)conv + 2048 + ch * 8 + 2 * q);
            v[2 * q] = bflo(zl[q]) * c0[0] + bflo(zc[q]) * c1[0] + bflo(zr[q]) * c2[0];
            v[2 * q + 1] = bfhi(zl[q]) * c0[1] + bfhi(zc[q]) * c1[1] + bfhi(zr[q]) * c2[1];
        }
        if (ch < 96) { *(LAS f32x4*)(CF + tk * CF_STR + ch * 8) = (f32x4){v[0], v[1], v[2], v[3]}; *(LAS f32x4*)(CF + tk * CF_STR + ch * 8 + 4) = (f32x4){v[4], v[5], v[6], v[7]}; }
        else {
            u32x4 w;
            if (ch < 104) {
#pragma unroll
                for (int q = 0; q < 8; ++q) v[q] = 1.f - 2.f * __builtin_amdgcn_rcpf(__expf(2.f * v[q]) + 1.f);
                w.x = pk2(v[0], v[1]); w.y = pk2(v[2], v[3]); w.z = pk2(v[4], v[5]); w.w = pk2(v[6], v[7]);
                *(LAS u32x4*)(AW + tk * 72 + (ch - 96) * 8) = w;
            } else if (ch < 112) {
                w.x = pk2(v[0], v[1]); w.y = pk2(v[2], v[3]); w.z = pk2(v[4], v[5]); w.w = pk2(v[6], v[7]);
                *(LAS u32x4*)(AA + tk * 72 + (ch - 104) * 8) = w;
            } else {
#pragma unroll
                for (int q = 0; q < 8; ++q) v[q] = sigmoidf_(v[q]);
                w.x = pk2(v[0], v[1]); w.y = pk2(v[2], v[3]); w.z = pk2(v[4], v[5]); w.w = pk2(v[6], v[7]);
                *(LAS u32x4*)(AG + tk * 136 + (ch - 112) * 8) = w;
            }
        }
    }
    __syncthreads();
    const int hh = F.wave & 3, dir = F.wave >> 2, tk = F.lane & 31, h2 = F.lane >> 5;
    const size_t tok = (size_t)t0 + tk;
    const GAS bf16_t* Wup = (const GAS bf16_t*)wb + WO_WUP + (size_t)(dir * 256 + hh * 64) * 64;
    const GAS bf16_t* Aup = (const GAS bf16_t*)wb + WO_AUP + (size_t)(dir * 256 + hh * 64) * 64;
    f32x16 aw[2], aa[2];
#pragma unroll
    for (int rb = 0; rb < 2; ++rb)
#pragma unroll
        for (int i = 0; i < 16; ++i) { aw[rb][i] = 0.f; aa[rb][i] = 0.f; }
#pragma unroll
    for (int ks = 0; ks < 4; ++ks) {
        const bf16x8 bw = *(const LAS bf16x8*)(AW + tk * 72 + 16 * ks + 8 * h2), ba = *(const LAS bf16x8*)(AA + tk * 72 + 16 * ks + 8 * h2);
#pragma unroll
        for (int rb = 0; rb < 2; ++rb) {
            const bf16x8 fw = *(const GAS bf16x8*)(Wup + (size_t)(rb * 32 + tk) * 64 + 16 * ks + 8 * h2), fa = *(const GAS bf16x8*)(Aup + (size_t)(rb * 32 + tk) * 64 + 16 * ks + 8 * h2);
            aw[rb] = __builtin_amdgcn_mfma_f32_32x32x16_bf16(fw, bw, aw[rb], 0, 0, 0);
            aa[rb] = __builtin_amdgcn_mfma_f32_32x32x16_bf16(fa, ba, aa[rb], 0, 0, 0);
        }
    }
    const LAS float* k_k = PAR + hh * 64; const LAS float* k_a = PAR + 256 + hh * 64; const LAS float* r_k = PAR + 512 + hh * 64;
    const LAS float* w0 = PAR + 768 + dir * 256 + hh * 64; const LAS float* a0 = PAR + 1280 + dir * 256 + hh * 64;
    float ssq = 0.f;
#pragma unroll
    for (int rb = 0; rb < 2; ++rb)
#pragma unroll
        for (int g4 = 0; g4 < 4; ++g4) { const int c0 = rb * 32 + 8 * g4 + 4 * h2;
            const f32x4 kv = *(const LAS f32x4*)(CF + tk * CF_STR + 256 + hh * 64 + c0), kkw = *(const LAS f32x4*)(k_k + c0);
            const f32x4 q = kv * kkw; ssq += (q[0] * q[0] + q[1] * q[1]) + (q[2] * q[2] + q[3] * q[3]); }
    ssq += xhalf(ssq);
    const float kinv = 1.f / fmaxf(sqrtf(ssq), 1e-12f);
    float bon = 0.f;
    GAS bf16_t* OM = (GAS bf16_t*)(p.ws + WS_OM) + ((size_t)dir * MTOK + tok) * 256 + hh * 64;
    GAS bf16_t* KA = (GAS bf16_t*)(p.ws + WS_KA) + ((size_t)dir * MTOK + tok) * 256 + hh * 64;
    GAS bf16_t* KD = (GAS bf16_t*)(p.ws + WS_KD) + ((size_t)dir * MTOK + tok) * 256 + hh * 64;
    GAS bf16_t* KK = (GAS bf16_t*)(p.ws + WS_KK) + tok * 256 + hh * 64;
    GAS bf16_t* VV = (GAS bf16_t*)(p.ws + WS_V) + tok * 256 + hh * 64;
    GAS bf16_t* RR = (GAS bf16_t*)(p.ws + WS_R) + tok * 256 + hh * 64;
#pragma unroll
    for (int rb = 0; rb < 2; ++rb)
#pragma unroll
        for (int g4 = 0; g4 < 4; ++g4) { const int c0 = rb * 32 + 8 * g4 + 4 * h2;
            const f32x4 kv = *(const LAS f32x4*)(CF + tk * CF_STR + 256 + hh * 64 + c0), rv = *(const LAS f32x4*)(CF + tk * CF_STR + hh * 64 + c0);
            const f32x4 kkw = *(const LAS f32x4*)(k_k + c0), kaw = *(const LAS f32x4*)(k_a + c0), rkw = *(const LAS f32x4*)(r_k + c0), w0v = *(const LAS f32x4*)(w0 + c0), a0v = *(const LAS f32x4*)(a0 + c0);
            float om[4], ka[4], kd[4], kk[4];
#pragma unroll
            for (int j = 0; j < 4; ++j) {
                const float wp = aw[rb][4 * g4 + j] + w0v[j], ap = aa[rb][4 * g4 + j] + a0v[j];
                om[j] = 1.f - __expf(-0.6065306597126334f * sigmoidf_(wp));
                const float a = sigmoidf_(ap);
                kk[j] = kv[j] * kkw[j] * kinv; ka[j] = kk[j] * a; kd[j] = kv[j] * (1.f + (a - 1.f) * kaw[j]);
                bon += rv[j] * kd[j] * rkw[j];
            }
            u32x2 w; w.x = pk2(om[0], om[1]); w.y = pk2(om[2], om[3]); *(GAS u32x2*)(OM + c0) = w;
            w.x = pk2(ka[0], ka[1]); w.y = pk2(ka[2], ka[3]); *(GAS u32x2*)(KA + c0) = w;
            w.x = pk2(kd[0], kd[1]); w.y = pk2(kd[2], kd[3]); *(GAS u32x2*)(KD + c0) = w;
            if (dir == 0) {
                const f32x4 vv = *(const LAS f32x4*)(CF + tk * CF_STR + 512 + hh * 64 + c0);
                w.x = pk2(kk[0], kk[1]); w.y = pk2(kk[2], kk[3]); *(GAS u32x2*)(KK + c0) = w;
                w.x = pk2(vv[0], vv[1]); w.y = pk2(vv[2], vv[3]); *(GAS u32x2*)(VV + c0) = w;
                w.x = pk2(rv[0], rv[1]); w.y = pk2(rv[2], rv[3]); *(GAS u32x2*)(RR + c0) = w;
            }
        }
    bon += xhalf(bon);
    if (h2 == 0) ((GAS float*)(p.ws + WS_BON))[((size_t)dir * MTOK + tok) * 4 + hh] = bon;
    {
        const GAS bf16_t* Gup = (const GAS bf16_t*)wb + WO_GUP + (size_t)(F.wave * 32 + tk) * 128;
        f32x16 ag;
#pragma unroll
        for (int i = 0; i < 16; ++i) ag[i] = 0.f;
#pragma unroll
        for (int ks = 0; ks < 8; ++ks) {
            const bf16x8 bg = *(const LAS bf16x8*)(AG + tk * 136 + 16 * ks + 8 * h2), fg = *(const GAS bf16x8*)(Gup + 16 * ks + 8 * h2);
            ag = __builtin_amdgcn_mfma_f32_32x32x16_bf16(fg, bg, ag, 0, 0, 0);
        }
        GAS bf16_t* GT = (GAS bf16_t*)(p.ws + WS_GATE) + tok * 256 + F.wave * 32;
#pragma unroll
        for (int g4 = 0; g4 < 4; ++g4) { u32x2 w; w.x = pk2(ag[4 * g4], ag[4 * g4 + 1]); w.y = pk2(ag[4 * g4 + 2], ag[4 * g4 + 3]); *(GAS u32x2*)(GT + 8 * g4 + 4 * h2) = w; }
    }
    __syncthreads();
}

#define CBAR() asm volatile("" ::: "memory")
#define LROW(M, i, r) do { const LAS f32x4* _q = (const LAS f32x4*)((M) + (i) * 16); const f32x4 _a = _q[0], _b = _q[1], _c = _q[2], _d = _q[3]; \
        r[0] = _a[0]; r[1] = _a[1]; r[2] = _a[2]; r[3] = _a[3]; r[4] = _b[0]; r[5] = _b[1]; r[6] = _b[2]; r[7] = _b[3]; \
        r[8] = _c[0]; r[9] = _c[1]; r[10] = _c[2]; r[11] = _c[3]; r[12] = _d[0]; r[13] = _d[1]; r[14] = _d[2]; r[15] = _d[3]; } while (0)
template <int DIR> __device__ __forceinline__ void chunkprep_wave(Frame& F, const Params& p, int task) {
    const int dbh = task >> 7, ct = task & 127, b = (dbh >> 2) & 7, hh = dbh & 3, ch = F.lane, r32 = F.lane & 31, h = F.lane >> 5;
    LAS unsigned char* wl = F.lds + F.wave * 16384;
    LAS bf16_t* X = (LAS bf16_t*)wl;
    LAS bf16_t* Yt = (LAS bf16_t*)(wl + 4608);
    LAS float* MTt = (LAS float*)(wl + 9216);
    LAS float* MBt = MTt + 256;
    LAS float* MC = MTt + 512; LAS float* MD = MTt + 768; LAS float* MT = MTt + 1024; LAS float* MA = MTt + 1280;
    constexpr int step = DIR ? -256 : 256;
    typedef const __attribute__((address_space(1))) bf16_t* gbf;
    const size_t ou = ((size_t)b * SEQ + ct * 16 + (DIR ? 15 : 0)) * 256 + hh * 64;
    const gbf OM = (gbf)(p.ws + WS_OM) + (size_t)DIR * MTOK * 256 + ou + ch; const gbf KA = (gbf)(p.ws + WS_KA) + (size_t)DIR * MTOK * 256 + ou + ch;
    const gbf KD = (gbf)(p.ws + WS_KD) + (size_t)DIR * MTOK * 256 + ou + ch; const gbf KK = (gbf)(p.ws + WS_KK) + ou + ch;
    const gbf RR = (gbf)(p.ws + WS_R) + ou + ch; const gbf VV = (gbf)(p.ws + WS_V) + ou + ch;
    float pc = 1.f;
    float qt[16], rt[16], at[16], kt[16], vv[16];
    {
        unsigned short rw[16], rk[16], ra_[16], rd[16], rr_[16], rv[16];
#pragma unroll
        for (int i = 0; i < 16; ++i) { rw[i] = OM[i * step]; rk[i] = KK[i * step]; ra_[i] = KA[i * step]; rd[i] = KD[i * step]; rr_[i] = RR[i * step]; rv[i] = VV[i * step]; }
#pragma unroll
        for (int i = 0; i < 16; ++i) {
            const float w = 1.f - bf2f(rw[i]);
            qt[i] = bf2f(rk[i]) * pc; pc *= w; const float ip = __builtin_amdgcn_rcpf(pc);
            rt[i] = bf2f(rr_[i]) * pc; at[i] = bf2f(ra_[i]) * ip; kt[i] = bf2f(rd[i]) * ip; vv[i] = bf2f(rv[i]);
            X[i * 72 + ch] = (bf16_t)(pk2(qt[i], 0.f) & 0xffffu); X[(16 + i) * 72 + ch] = (bf16_t)(pk2(rt[i], 0.f) & 0xffffu);
            Yt[i * 72 + ch] = (bf16_t)(pk2(at[i], 0.f) & 0xffffu); Yt[(16 + i) * 72 + ch] = (bf16_t)(pk2(kt[i], 0.f) & 0xffffu);
        }
    }
    const float p15 = pc;
    asm volatile("s_waitcnt lgkmcnt(0)" ::: "memory");
    {
        f32x16 g;
#pragma unroll
        for (int i = 0; i < 16; ++i) g[i] = 0.f;
#pragma unroll
        for (int ks = 0; ks < 4; ++ks) {
            const bf16x8 a = *(const LAS bf16x8*)(X + r32 * 72 + 16 * ks + 8 * h), bb = *(const LAS bf16x8*)(Yt + r32 * 72 + 16 * ks + 8 * h);
            g = __builtin_amdgcn_mfma_f32_32x32x16_bf16(a, bb, g, 0, 0, 0);
        }
        const int sidx = r32 & 15;
#pragma unroll
        for (int reg = 0; reg < 8; ++reg) { const int i = (reg & 3) + 8 * (reg >> 2) + 4 * h;
            const float lo = (sidx < i) ? g[reg] : 0.f, hi2 = (sidx <= i) ? g[8 + reg] : 0.f;
            if (r32 < 16) { MA[i * 16 + sidx] = lo; MD[i * 16 + sidx] = hi2; } else { MBt[sidx * 16 + i] = lo; MC[i * 16 + sidx] = hi2; } }
    }
    asm volatile("s_waitcnt lgkmcnt(0)" ::: "memory");
    {
        const int c = F.lane & 15; float Tc[16];
#pragma unroll
        for (int i = 0; i < 16; ++i) { float acc = (i == c) ? 1.f : 0.f; float ra[16]; LROW(MA, i, ra);
#pragma unroll
            for (int s2 = 0; s2 < i; ++s2) acc -= ra[s2] * Tc[s2];
            Tc[i] = acc; MT[i * 16 + c] = acc; MTt[c * 16 + i] = acc; CBAR(); }
    }
    asm volatile("s_waitcnt lgkmcnt(0)" ::: "memory");
    float Qh[16], W2[16];
    {
        float BV[16];
#pragma unroll
        for (int i = 0; i < 16; ++i) { Qh[i] = 0.f; BV[i] = 0.f; }
#pragma unroll
        for (int s2 = 0; s2 < 16; ++s2) {
            float ct_[16], cb_[16]; LROW(MTt, s2, ct_); LROW(MBt, s2, cb_);
#pragma unroll
            for (int i = s2; i < 16; ++i) { Qh[i] += ct_[i] * qt[s2]; if (i > s2) BV[i] += cb_[i] * vv[s2]; }
            CBAR();
        }
#pragma unroll
        for (int i = 0; i < 16; ++i) { float aw = 0.f; float rt_[16]; LROW(MT, i, rt_);
#pragma unroll
            for (int s2 = 0; s2 <= i; ++s2) aw += rt_[s2] * BV[s2];
            W2[i] = aw; CBAR(); }
    }
    LAS bf16_t* ST = (LAS bf16_t*)wl;
    {
        const int ks = ch >> 4, w16 = ch & 15, jq = (w16 >> 3) * 4 + (w16 & 3), hq = (w16 >> 2) & 1;
        LAS bf16_t* qrp = ST + (ks * 64 + hq * 32) * 8 + jq;
        LAS bf16_t* wyp = ST + 2048 + ((ch >> 5) * 64 + r32) * 16;
#pragma unroll
        for (int i = 0; i < 16; ++i) {
            float ar = rt[i], ay = 0.f; float rd_[16], rc_[16]; LROW(MD, i, rd_); LROW(MC, i, rc_);
#pragma unroll
            for (int s2 = 0; s2 <= i; ++s2) { ar -= rd_[s2] * Qh[s2]; ay += rc_[s2] * vv[s2] - rd_[s2] * W2[s2]; }
            qrp[i * 8] = (bf16_t)(pk2(Qh[i], 0.f) & 0xffffu); qrp[(16 + i) * 8] = (bf16_t)(pk2(ar, 0.f) & 0xffffu);
            wyp[512 * ((i >> 2) & 1) + (i & 3) + 4 * (i >> 3)] = (bf16_t)(pk2(W2[i], 0.f) & 0xffffu);
            wyp[512 * ((i >> 2) & 1) + (i & 3) + 4 * ((16 + i) >> 3)] = (bf16_t)(pk2(ay, 0.f) & 0xffffu);
            CBAR(); }
    }
    asm volatile("s_waitcnt lgkmcnt(0)" ::: "memory");
    {
        GAS u32x4* gq = (GAS u32x4*)((GAS bf16_t*)(p.ws + WS_FQR) + (size_t)task * 2048); GAS u32x4* gw = (GAS u32x4*)((GAS bf16_t*)(p.ws + WS_FWY) + (size_t)task * 2048);
        u32x4 tq[4], tw[4];
#pragma unroll
        for (int q = 0; q < 4; ++q) { tq[q] = *(const LAS u32x4*)(wl + (F.lane + 64 * q) * 16); tw[q] = *(const LAS u32x4*)(wl + 4096 + (F.lane + 64 * q) * 16); }
#pragma unroll
        for (int q = 0; q < 4; ++q) { gq[F.lane + 64 * q] = tq[q]; gw[F.lane + 64 * q] = tw[q]; }
    }
    asm volatile("s_waitcnt lgkmcnt(0)" ::: "memory");
    {
        LAS bf16_t* nap = ST + ((ch >> 5) * 64 + r32) * 8; LAS bf16_t* khp = nap + 1024;
#pragma unroll
        for (int s2 = 0; s2 < 16; ++s2) {
            const int off = 256 * ((s2 >> 2) & 1) + (s2 >> 3) * 4 + (s2 & 3);
            nap[off] = (bf16_t)(pk2(-at[s2] * p15, 0.f) & 0xffffu); khp[off] = (bf16_t)(pk2(kt[s2] * p15, 0.f) & 0xffffu); }
        asm volatile("s_waitcnt lgkmcnt(0)" ::: "memory");
        GAS u32x4* gn = (GAS u32x4*)((GAS bf16_t*)(p.ws + WS_FNA) + (size_t)task * 1024); GAS u32x4* gk = (GAS u32x4*)((GAS bf16_t*)(p.ws + WS_FKH) + (size_t)task * 1024);
        u32x4 tn[2], tk2[2];
#pragma unroll
        for (int q = 0; q < 2; ++q) { tn[q] = *(const LAS u32x4*)(wl + (F.lane + 64 * q) * 16); tk2[q] = *(const LAS u32x4*)(wl + 2048 + (F.lane + 64 * q) * 16); }
#pragma unroll
        for (int q = 0; q < 2; ++q) { gn[F.lane + 64 * q] = tn[q]; gk[F.lane + 64 * q] = tk2[q]; }
        ((GAS float*)(p.ws + WS_FP15))[(size_t)task * 64 + ch] = p15;
    }
    asm volatile("s_waitcnt lgkmcnt(0)" ::: "memory");
}
constexpr int PB_SLOT = 15360, PB_NSLOT = 4, PB_QR = 0, PB_WY = 4096, PB_NA = 8192, PB_KH = 10240, PB_P15 = 12288, PB_V = 13312;
__device__ __forceinline__ unsigned lds_ld_u32(unsigned addr) { unsigned v; asm volatile("ds_read_b32 %0, %1\n\ts_waitcnt lgkmcnt(0)" : "=v"(v) : "v"(addr) : "memory"); return v; }
__device__ __forceinline__ void lds_st_u32(unsigned addr, unsigned v) { asm volatile("ds_write_b32 %0, %1" :: "v"(addr), "v"(v) : "memory"); }
__device__ __forceinline__ void pb_dma(const Params& p, int dbh, int ct, int lane, LAS unsigned char* slot) {
    const size_t task = (size_t)dbh * 128 + ct; const int b = (dbh >> 2) & 7, hh = dbh & 3;
    const unsigned char* q = (const unsigned char*)((const bf16_t*)(p.ws + WS_FQR) + task * 2048) + lane * 16; const unsigned char* w = (const unsigned char*)((const bf16_t*)(p.ws + WS_FWY) + task * 2048) + lane * 16;
    const unsigned char* na = (const unsigned char*)((const bf16_t*)(p.ws + WS_FNA) + task * 1024) + lane * 16; const unsigned char* kh = (const unsigned char*)((const bf16_t*)(p.ws + WS_FKH) + task * 1024) + lane * 16;
#pragma unroll
    for (int i = 0; i < 4; ++i) {
        __builtin_amdgcn_global_load_lds((const unsigned*)(q + 1024 * i), (LAS unsigned*)(slot + PB_QR + 1024 * i), 16, 0, 0);
        __builtin_amdgcn_global_load_lds((const unsigned*)(w + 1024 * i), (LAS unsigned*)(slot + PB_WY + 1024 * i), 16, 0, 0); }
    __builtin_amdgcn_global_load_lds((const unsigned*)na, (LAS unsigned*)(slot + PB_NA), 16, 0, 0); __builtin_amdgcn_global_load_lds((const unsigned*)(na + 1024), (LAS unsigned*)(slot + PB_NA + 1024), 16, 0, 0);
    __builtin_amdgcn_global_load_lds((const unsigned*)kh, (LAS unsigned*)(slot + PB_KH), 16, 0, 0); __builtin_amdgcn_global_load_lds((const unsigned*)(kh + 1024), (LAS unsigned*)(slot + PB_KH + 1024), 16, 0, 0);
    __builtin_amdgcn_global_load_lds((const unsigned*)((const unsigned char*)((const float*)(p.ws + WS_FP15) + task * 64) + lane * 16), (LAS unsigned*)(slot + PB_P15), 16, 0, 0);
    const unsigned char* V = (const unsigned char*)((const bf16_t*)(p.ws + WS_V) + ((size_t)b * SEQ + ct * 16) * 256 + hh * 64) + (size_t)(lane >> 3) * 512 + (lane & 7) * 16;
    __builtin_amdgcn_global_load_lds((const unsigned*)V, (LAS unsigned*)(slot + PB_V), 16, 0, 0); __builtin_amdgcn_global_load_lds((const unsigned*)(V + 8 * 512), (LAS unsigned*)(slot + PB_V + 1024), 16, 0, 0);
}
__device__ __forceinline__ void phaseb_unit(Frame& F, const Params& p, int u) {
    const unsigned flag_base = (unsigned)(size_t)(F.lds + 131072 + 128);
    if (F.tid < 8) lds_st_u32(flag_base + 4 * F.tid, 0u);
    __syncthreads();
    const int pair = F.wave & 3;
    if (pair >= 2) return;
    const int dbh = u * 2 + pair, dir = dbh >> 5;
    LAS unsigned char* ring = F.lds + pair * (PB_NSLOT * PB_SLOT);
    const unsigned f_pub = flag_base + 8 * pair, f_con = f_pub + 4;
    if (F.wave >= 4) {
        for (int c = 0; c < 128; ++c) {
            while ((int)lds_ld_u32(f_con) < c - (PB_NSLOT - 1)) __builtin_amdgcn_s_sleep(1);
            pb_dma(p, dbh, dir ? 127 - c : c, F.lane, ring + (c & (PB_NSLOT - 1)) * PB_SLOT);
            if (c >= 3) { asm volatile("s_waitcnt vmcnt(45)" ::: "memory"); if (F.lane == 0) lds_st_u32(f_pub, (unsigned)(c - 2)); }
        }
        asm volatile("s_waitcnt vmcnt(30)" ::: "memory"); if (F.lane == 0) lds_st_u32(f_pub, 126u);
        asm volatile("s_waitcnt vmcnt(15)" ::: "memory"); if (F.lane == 0) lds_st_u32(f_pub, 127u);
        asm volatile("s_waitcnt vmcnt(0)" ::: "memory"); if (F.lane == 0) lds_st_u32(f_pub, 128u);
        return;
    }
    const int b = (dbh >> 2) & 7, hh = dbh & 3, r = F.lane & 31, h = F.lane >> 5;
    GAS bf16_t* Y = (GAS bf16_t*)(p.ws + WS_Y) + ((size_t)dir * MTOK + (size_t)b * SEQ) * 256 + hh * 64 + r;
    f32x16 accS[2][2];
#pragma unroll
    for (int rb = 0; rb < 2; ++rb)
#pragma unroll
        for (int cb = 0; cb < 2; ++cb)
#pragma unroll
            for (int i = 0; i < 16; ++i) accS[rb][cb][i] = 0.f;
    for (int cc = 0; cc < 128; ++cc) {
        const int ct = dir ? 127 - cc : cc;
        const LAS unsigned char* slot = ring + (cc & (PB_NSLOT - 1)) * PB_SLOT;
        bf16x8 sb[4][2];
#pragma unroll
        for (int rb = 0; rb < 2; ++rb)
#pragma unroll
            for (int s2 = 0; s2 < 2; ++s2)
#pragma unroll
                for (int cb = 0; cb < 2; ++cb) { const f32x16& a = accS[rb][cb]; u32x4 w;
                    w.x = pk2(a[8 * s2 + 0], a[8 * s2 + 1]); w.y = pk2(a[8 * s2 + 2], a[8 * s2 + 3]); w.z = pk2(a[8 * s2 + 4], a[8 * s2 + 5]); w.w = pk2(a[8 * s2 + 6], a[8 * s2 + 7]);
                    sb[2 * rb + s2][cb] = __builtin_bit_cast(bf16x8, w); }
        while ((int)lds_ld_u32(f_pub) < cc + 1) __builtin_amdgcn_s_sleep(1);
        asm volatile("" ::: "memory");
        f32x16 D[2];
#pragma unroll
        for (int cb = 0; cb < 2; ++cb) { const LAS u32x4* wp = (const LAS u32x4*)(slot + PB_WY + (cb * 64 + F.lane) * 32); const u32x4 w0 = wp[0], w1 = wp[1];
            D[cb][0] = bflo(w0.x); D[cb][1] = bfhi(w0.x); D[cb][2] = bflo(w0.y); D[cb][3] = bfhi(w0.y); D[cb][4] = bflo(w0.z); D[cb][5] = bfhi(w0.z); D[cb][6] = bflo(w0.w); D[cb][7] = bfhi(w0.w);
            D[cb][8] = bflo(w1.x); D[cb][9] = bfhi(w1.x); D[cb][10] = bflo(w1.y); D[cb][11] = bfhi(w1.y); D[cb][12] = bflo(w1.z); D[cb][13] = bfhi(w1.z); D[cb][14] = bflo(w1.w); D[cb][15] = bfhi(w1.w); }
#pragma unroll
        for (int ks = 0; ks < 4; ++ks) { const bf16x8 qa = *(const LAS bf16x8*)(slot + PB_QR + (ks * 64 + F.lane) * 16);
            D[0] = __builtin_amdgcn_mfma_f32_32x32x16_bf16(qa, sb[ks][0], D[0], 0, 0, 0);
            D[1] = __builtin_amdgcn_mfma_f32_32x32x16_bf16(qa, sb[ks][1], D[1], 0, 0, 0); }
#pragma unroll
        for (int rb = 0; rb < 2; ++rb)
#pragma unroll
            for (int g4 = 0; g4 < 4; ++g4) { const f32x4 pv = *(const LAS f32x4*)(slot + PB_P15 + (32 * rb + 8 * g4 + 4 * h) * 4);
#pragma unroll
                for (int cb = 0; cb < 2; ++cb)
#pragma unroll
                    for (int q = 0; q < 4; ++q) accS[rb][cb][4 * g4 + q] *= pv[q]; }
        bf16x8 ub[2], vb[2];
#pragma unroll
        for (int cb = 0; cb < 2; ++cb) {
            unsigned short vt[8];
#pragma unroll
            for (int j = 0; j < 8; ++j) { const int s2 = 8 * (j >> 2) + 4 * h + (j & 3); const int tau = dir ? 15 - s2 : s2;
                vt[j] = *(const LAS unsigned short*)(slot + PB_V + tau * 128 + (32 * cb + r) * 2);
                Y[(size_t)(ct * 16 + tau) * 256 + 32 * cb] = (bf16_t)(pk2(D[cb][8 + j], 0.f) & 0xffffu); }
            vb[cb] = (bf16x8){(short)vt[0], (short)vt[1], (short)vt[2], (short)vt[3], (short)vt[4], (short)vt[5], (short)vt[6], (short)vt[7]};
            u32x4 w; w.x = pk2(D[cb][0], D[cb][1]); w.y = pk2(D[cb][2], D[cb][3]); w.z = pk2(D[cb][4], D[cb][5]); w.w = pk2(D[cb][6], D[cb][7]);
            ub[cb] = __builtin_bit_cast(bf16x8, w);
        }
        bf16x8 na[2], kh[2];
#pragma unroll
        for (int rb = 0; rb < 2; ++rb) { na[rb] = *(const LAS bf16x8*)(slot + PB_NA + (rb * 64 + F.lane) * 16); kh[rb] = *(const LAS bf16x8*)(slot + PB_KH + (rb * 64 + F.lane) * 16); }
        asm volatile("s_waitcnt lgkmcnt(0)" ::: "memory");
        if (F.lane == 0) lds_st_u32(f_con, (unsigned)(cc + 1));
#pragma unroll
        for (int rb = 0; rb < 2; ++rb)
#pragma unroll
            for (int cb = 0; cb < 2; ++cb) {
                accS[rb][cb] = __builtin_amdgcn_mfma_f32_32x32x16_bf16(na[rb], ub[cb], accS[rb][cb], 0, 0, 0);
                accS[rb][cb] = __builtin_amdgcn_mfma_f32_32x32x16_bf16(kh[rb], vb[cb], accS[rb][cb], 0, 0, 0);
            }
    }
}

__device__ __forceinline__ void post_unit(Frame& F, const Params& p, int l, int u) {
    REFRAME(F);
    const bf16_t* Y0 = (const bf16_t*)(p.ws + WS_Y); const bf16_t* Y1 = Y0 + (size_t)MTOK * 256;
    const bf16_t* VV = (const bf16_t*)(p.ws + WS_V); const bf16_t* GT = (const bf16_t*)(p.ws + WS_GATE);
    const float* BON = (const float*)(p.ws + WS_BON); bf16_t* MIX = (bf16_t*)(p.ws + WS_MIX);
    const f32x4 lg = *(const f32x4*)(p.in[19] + l * 256 + 4 * F.lane), lb = *(const f32x4*)(p.in[20] + l * 256 + 4 * F.lane);
    for (int tok = u * 64 + F.wave * 8, te = tok + 8; tok < te; ++tok) {
        const u32x2 a = *(const GAS u32x2*)((const GAS bf16_t*)Y0 + (size_t)tok * 256 + 4 * F.lane), c = *(const GAS u32x2*)((const GAS bf16_t*)Y1 + (size_t)tok * 256 + 4 * F.lane);
        const u32x2 vv = *(const GAS u32x2*)((const GAS bf16_t*)VV + (size_t)tok * 256 + 4 * F.lane), gg = *(const GAS u32x2*)((const GAS bf16_t*)GT + (size_t)tok * 256 + 4 * F.lane);
        float y[4] = {bflo(a.x) + bflo(c.x), bfhi(a.x) + bfhi(c.x), bflo(a.y) + bflo(c.y), bfhi(a.y) + bfhi(c.y)};
        float s = (y[0] + y[1]) + (y[2] + y[3]);
#pragma unroll
        for (int o = 1; o < 16; o <<= 1) s += __shfl_xor(s, o);
        const float mu = s * (1.f / 64.f);
        float q = 0.f;
#pragma unroll
        for (int i = 0; i < 4; ++i) { y[i] -= mu; q += y[i] * y[i]; }
#pragma unroll
        for (int o = 1; o < 16; o <<= 1) q += __shfl_xor(q, o);
        const float rstd = rsqrtf(q * (1.f / 64.f) + 64e-5f);
        const int hh = F.lane >> 4;
        const float bon = ((const GAS float*)BON)[(size_t)tok * 4 + hh] + ((const GAS float*)BON)[((size_t)MTOK + tok) * 4 + hh];
        const float v4[4] = {bflo(vv.x), bfhi(vv.x), bflo(vv.y), bfhi(vv.y)}, g4[4] = {bflo(gg.x), bfhi(gg.x), bflo(gg.y), bfhi(gg.y)};
        float o4[4];
#pragma unroll
        for (int i = 0; i < 4; ++i) o4[i] = (y[i] * rstd * lg[i] + lb[i] + bon * v4[i]) * g4[i];
        u32x2 w; w.x = pk2(o4[0], o4[1]); w.y = pk2(o4[2], o4[3]);
        *(GAS u32x2*)((GAS bf16_t*)MIX + (size_t)tok * DM + 768 + 4 * F.lane) = w;
    }
}

__device__ __forceinline__ void prologue(Frame& F, const Params& p) {
    REFRAME(F);
    LAS float* scr = (LAS float*)(F.lds + F.wave * 16384);
    const int gw = F.bid * 8 + F.wave, NGW = F.G * 8;
    bf16_t* wb = (bf16_t*)(p.ws + WS_W);
    for (int it = gw; it < CV_TOTAL; it += NGW) { if (it < CV_A) cvt_item_a(p, 0, wb, scr, it, F.lane); else cvt_item_b(p, 0, wb, scr, it - CV_A, F.lane); }
    const float* x = p.in[0]; float* X = p.out; bf16_t* XB = (bf16_t*)(p.ws + WS_XB); float* rowss = (float*)(p.ws + WS_RP);
    for (int m = gw; m < MTOK; m += 2 * NGW) {
        const int m2 = m + NGW; const bool has2 = m2 < MTOK; const int mb = has2 ? m2 : m;
        const GAS f32x4* xra = (const GAS f32x4*)(x + (size_t)m * DM) + F.lane; const GAS f32x4* xrb = (const GAS f32x4*)(x + (size_t)mb * DM) + F.lane;
        f32x4 va[4], vb[4];
#pragma unroll
        for (int jj = 0; jj < 4; ++jj) { va[jj] = xra[64 * jj]; vb[jj] = xrb[64 * jj]; }
        float sa = 0.f, sb = 0.f;
#pragma unroll
        for (int jj = 0; jj < 4; ++jj) { sa += (va[jj][0] * va[jj][0] + va[jj][1] * va[jj][1]) + (va[jj][2] * va[jj][2] + va[jj][3] * va[jj][3]); sb += (vb[jj][0] * vb[jj][0] + vb[jj][1] * vb[jj][1]) + (vb[jj][2] * vb[jj][2] + vb[jj][3] * vb[jj][3]); }
        sa = wave_sum(sa); sb = wave_sum(sb);
        { GAS f32x4* xo = (GAS f32x4*)(X + (size_t)m * DM) + F.lane; GAS u32x2* bo = (GAS u32x2*)(XB + (size_t)m * DM) + F.lane;
#pragma unroll
          for (int jj = 0; jj < 4; ++jj) { xo[64 * jj] = va[jj]; u32x2 w; w.x = pk2(va[jj][0], va[jj][1]); w.y = pk2(va[jj][2], va[jj][3]); bo[64 * jj] = w; }
          if (F.lane < 16) ((GAS float*)rowss)[(size_t)m * 16 + F.lane] = (F.lane == 0) ? sa : 0.f; }
        if (has2) { GAS f32x4* xo = (GAS f32x4*)(X + (size_t)m2 * DM) + F.lane; GAS u32x2* bo = (GAS u32x2*)(XB + (size_t)m2 * DM) + F.lane;
#pragma unroll
          for (int jj = 0; jj < 4; ++jj) { xo[64 * jj] = vb[jj]; u32x2 w; w.x = pk2(vb[jj][0], vb[jj][1]); w.y = pk2(vb[jj][2], vb[jj][3]); bo[64 * jj] = w; }
          if (F.lane < 16) ((GAS float*)rowss)[(size_t)m2 * 16 + F.lane] = (F.lane == 0) ? sb : 0.f; }
    }
    const float* mem = p.in[1]; const float* gm = p.in[23]; bf16_t* MN = (bf16_t*)(p.ws + WS_MEMN);
    for (int m = gw; m < MMEM; m += NGW) {
        const f32x4* xr = (const f32x4*)(mem + (size_t)m * DM) + F.lane; u32x2* bo = (u32x2*)(MN + (size_t)m * DM) + F.lane;
        f32x4 v[4]; float s = 0.f;
#pragma unroll
        for (int jj = 0; jj < 4; ++jj) { v[jj] = xr[64 * jj]; s += (v[jj][0] * v[jj][0] + v[jj][1] * v[jj][1]) + (v[jj][2] * v[jj][2] + v[jj][3] * v[jj][3]); }
        const float rstd = rsqrtf(wave_sum(s) * (1.f / 1024.f) + 1e-6f);
#pragma unroll
        for (int jj = 0; jj < 4; ++jj) { const f32x4 g = *((const f32x4*)gm + F.lane + 64 * jj); const f32x4 t = v[jj] * rstd * g;
            u32x2 w; w.x = pk2(t[0], t[1]); w.y = pk2(t[2], t[3]); bo[64 * jj] = w; }
    }
}
__device__ __forceinline__ void final_norm(Frame& F, const Params& p) {
    REFRAME(F);
    const int gw = F.bid * 8 + F.wave, NGW = F.G * 8;
    const float* rowss = (const float*)(p.ws + WS_RP) + (size_t)12 * MTOK * 16; const GAS float* gf = (const GAS float*)p.in[30];
    f32x4 g[4];
#pragma unroll
    for (int jj = 0; jj < 4; ++jj) g[jj] = *((const GAS f32x4*)gf + F.lane + 64 * jj);
    for (int m = gw; m < MTOK; m += 2 * NGW) {
        const int m2 = m + NGW; const bool has2 = m2 < MTOK;
        GAS f32x4* xa = (GAS f32x4*)(p.out + (size_t)m * DM) + F.lane; GAS f32x4* xb = (GAS f32x4*)(p.out + (size_t)(has2 ? m2 : m) * DM) + F.lane;
        f32x4 va[4], vb[4];
#pragma unroll
        for (int jj = 0; jj < 4; ++jj) { va[jj] = xa[64 * jj]; vb[jj] = xb[64 * jj]; }
        const float ra = row_rstd(rowss, m), rb = row_rstd(rowss, has2 ? m2 : m);
#pragma unroll
        for (int jj = 0; jj < 4; ++jj) xa[64 * jj] = va[jj] * ra * g[jj];
        if (has2) {
#pragma unroll
            for (int jj = 0; jj < 4; ++jj) xb[64 * jj] = vb[jj] * rb * g[jj]; }
    }
}

#define XB_TMO      128
#define XB_XCNT(j)  (256  + 64 * (j))
#define XB_XSUB(j)  (1280 + 64 * (j))
#define XB_XGEN(j)  (2304 + 64 * (j))
#define XB_TOP      3328
#define XB_TOPGEN   3392
#define XB_SPIN_CAP (1u << 22)
constexpr int CW_BAR = 4096;
__device__ __forceinline__ unsigned xb_ld(unsigned* p)              { return __hip_atomic_load(p, __ATOMIC_RELAXED, __HIP_MEMORY_SCOPE_AGENT); }
__device__ __forceinline__ unsigned xb_add(unsigned* p, unsigned v) { return __hip_atomic_fetch_add(p, v, __ATOMIC_RELAXED, __HIP_MEMORY_SCOPE_AGENT); }
__device__ __forceinline__ unsigned xb_xcc_id() { return (unsigned)__builtin_amdgcn_s_getreg((3 << 11) | 20) & 0xFu; }
#define XB_SPIN(cond, bar) do { unsigned _sp = 0; while (cond) { __builtin_amdgcn_s_sleep(1); \
    if ((++_sp & 255u) == 0u) { if (xb_ld(&(bar)[XB_TMO])) break; if (_sp > XB_SPIN_CAP) { atomicAdd(&(bar)[XB_TMO], 1u); break; } } } } while (0)
__device__ __forceinline__ void xcd_barrier_complete(unsigned* bar, unsigned x, unsigned& nloc, unsigned& nx) {
    const unsigned G = gridDim.x;
    unsigned sum, cnt, mine, sp = 0u;
    for (;;) {
        sum = 0u; cnt = 0u; mine = 0u;
#pragma unroll
        for (unsigned j = 0; j < 16; ++j) { const unsigned c = xb_ld(&bar[XB_XCNT(j)]); sum += c; cnt += (c > 0u) ? 1u : 0u; mine = (j == x) ? c : mine; }
        if (sum == G) break;
        __builtin_amdgcn_s_sleep(1);
        if ((++sp & 255u) == 0u) { if (xb_ld(&bar[XB_TMO])) break; if (sp > XB_SPIN_CAP) { atomicAdd(&bar[XB_TMO], 1u); break; } }
    }
    nloc = mine > 0u ? mine : 1u; nx = cnt > 0u ? cnt : 1u;
}
__device__ __forceinline__ void gsync(volatile LAS unsigned* st) {
    unsigned* bar = (unsigned*)(make_params().ws + WS_CTL) + CW_BAR;
    asm volatile("s_waitcnt vmcnt(0)" ::: "memory");
    __syncthreads();
    if (threadIdx.x == 0) {
        const unsigned x = xb_xcc_id();
        __builtin_amdgcn_s_waitcnt(0);
        unsigned nloc = st[0], nx = st[1];
        if (nloc == 0u) { xcd_barrier_complete(bar, x, nloc, nx); st[0] = nloc; st[1] = nx; }
        const unsigned old = xb_add(&bar[XB_XSUB(x)], 1u);
        const unsigned gen = old / nloc;
        if (old + 1u == (gen + 1u) * nloc) {
            __builtin_amdgcn_fence(__ATOMIC_RELEASE, "agent");
            asm volatile("s_waitcnt vmcnt(0)" ::: "memory");
            const unsigned og = xb_add(&bar[XB_TOP], 1u);
            const unsigned tg = og / nx;
            if (og + 1u == (tg + 1u) * nx) xb_add(&bar[XB_TOPGEN], 1u);
            else XB_SPIN(xb_ld(&bar[XB_TOPGEN]) == tg, bar);
            __builtin_amdgcn_fence(__ATOMIC_ACQUIRE, "agent");
            xb_add(&bar[XB_XGEN(x)], 1u);
            asm volatile("s_waitcnt vmcnt(0)" ::: "memory");
        } else {
            XB_SPIN(xb_ld(&bar[XB_XGEN(x)]) == gen, bar);
            __builtin_amdgcn_fence(__ATOMIC_ACQUIRE, "agent");
            asm volatile("s_waitcnt vmcnt(0)" ::: "memory");
        }
    }
    __syncthreads();
}
__device__ __forceinline__ int rstd_table(LAS unsigned char* lds, const pg8::StaticOrder& S, const float* rowss, int tid) {
    pg8::Unit u0; int pm0 = -1;
    if (S.next(0, u0)) { pm0 = u0.pm; if (tid < 256) ((LAS float*)(lds + 131072 + 2048))[tid] = row_rstd(rowss, pm0 * 256 + tid); }
    __syncthreads();
    return pm0;
}
#ifdef TPROBE
#define STAMP(id) do { if (blockIdx.x == 0 && threadIdx.x == 0) { LAS unsigned long long* ts_ = (LAS unsigned long long*)(F.lds + 131072 + 64); const unsigned long long now_ = __builtin_amdgcn_s_memrealtime(); \
    const unsigned long long dt_ = now_ - ts_[0]; ts_[0] = now_; if ((TA_MASK >> (id)) & 1) ts_[1] += dt_; if ((TB_MASK >> (id)) & 1) ts_[2] += dt_; } } while (0)
#else
#define STAMP(id) do { } while (0)
#endif
#ifndef PH_MASK
#define PH_MASK 0xFFFF
#endif
#ifndef REP_MASK
#define REP_MASK 0
#endif
#define NREP(k) ((((REP_MASK) >> (k)) & 1) ? 2 : 1)
constexpr int NCP = 1024, NDIFF_A = 0, NPB = 32;
__global__ void __launch_bounds__(512, 2) fwd_megakernel(KArgs kargs_unused) {
    extern __shared__ __attribute__((aligned(16))) unsigned char lds_raw[];
    cg::grid_group grid = cg::this_grid();
    Frame F; F.lds = (LAS unsigned char*)lds_raw; F.tid = threadIdx.x; F.lane = F.tid & 63; F.wave = __builtin_amdgcn_readfirstlane(F.tid >> 6); F.G = gridDim.x; F.bid = blockIdx.x;
    LAS int* qslot = (LAS int*)(F.lds + 131072);
    volatile LAS unsigned* bst = (volatile LAS unsigned*)(F.lds + 131072 + 32);
    { unsigned* bar0 = (unsigned*)(make_params().ws + WS_CTL) + CW_BAR;
      if (threadIdx.x == 0) { bst[0] = 0u; bst[1] = 0u; (void)xb_add(bar0 + XB_XCNT(xb_xcc_id()), 1u); } }
    __syncthreads();
#define PHASE_VARS() const Params p = make_params(); unsigned* ctl = (unsigned*)(p.ws + WS_CTL); float* rowss = (float*)(p.ws + WS_RP); \
    bf16_t* XB = (bf16_t*)(p.ws + WS_XB); bf16_t* Z = (bf16_t*)(p.ws + WS_Z); bf16_t* MIX = (bf16_t*)(p.ws + WS_MIX); \
    bf16_t* wb = (bf16_t*)(p.ws + WS_W); int bid_ = F.bid, G_ = F.G; asm volatile("" : "+s"(bid_), "+s"(G_)); (void)bid_; (void)G_; (void)ctl; (void)rowss; (void)XB; (void)Z; (void)MIX; (void)wb

#ifdef TPROBE
    if (blockIdx.x == 0 && threadIdx.x == 0) { LAS unsigned long long* ts_ = (LAS unsigned long long*)(F.lds + 131072 + 64); ts_[0] = __builtin_amdgcn_s_memrealtime(); ts_[1] = 0; ts_[2] = 0; }
#endif
    if (PH_MASK & 1) { const Params p = make_params(); prologue(F, p); }
    grid.sync();
    STAMP(0);

    for (int l = 0; l < NL; ++l) {
        for (int rep = 0; rep < NREP(1); ++rep) {
        if (PH_MASK & 2) {
            PHASE_VARS();
            pg8::StaticOrder S; S.init(MTOK, INW, G_, bid_);
            const int pm0 = rstd_table(F.lds, S, rowss + (size_t)(3 * l) * MTOK * 16, F.tid);
            pg8::gemm_phase(F.lds, pg8::Gemm{XB, wb + WO_IN, MTOK, INW, DM}, S, pg8::EpiScaleBf16{Z, ZP, rowss + (size_t)(3 * l) * MTOK * 16, (bf16_t*)(p.ws + WS_ZC), 1024, 8, (bf16_t*)(p.ws + WS_KD2), (const LAS float*)(F.lds + 131072 + 2048), pm0});
        }
        gsync(bst); STAMP(1);
        }
        for (int rep = 0; rep < NREP(2); ++rep) {
        for (int u = F.bid; u < 768; u += F.G) {
            PHASE_VARS();
            if (u < 512) { if (PH_MASK & 4) prep_unit(F, p, l, wb, u); } else if (PH_MASK & 8) win_unit(F, p, l, u - 512);
        }
        gsync(bst); STAMP(2);
        }
        for (int rep = 0; rep < NREP(3); ++rep) {
        {
            PHASE_VARS();
            for (int u = bid_; u < NCP; u += G_) {
                if (PH_MASK & 16) { REFRAME(F); if (u >= NCP / 2) chunkprep_wave<1>(F, p, u * 8 + F.wave); else chunkprep_wave<0>(F, p, u * 8 + F.wave); }
            }
        }
        gsync(bst); STAMP(11);
        }
        for (int rep = 0; rep < NREP(4); ++rep) {
        {
            PHASE_VARS();
            const int ncva = (l + 1 < NL) ? CV_A / 8 : 0, ncvb = (l > 0) ? CV_B / 8 : 0, ncv = NPB + ncva + ncvb, ntot = ncv + 256;
            unsigned* pbdone = ctl + 3072 + (l * 2 + rep) * 16;
            unsigned* gq = ctl + CW_Q + 16 * l + 8 + 4 * rep; unsigned* dq = ctl + 2048 + (l * 2 + rep) * 16;
            const int myx = (int)(xb_xcc_id() & 7u);
            int stage = (bid_ < NPB) ? 0 : 1, pend = -1, xi = 0;
            for (;;) {
                __syncthreads();
                if (F.tid == 0) {
                    int code = -1;
                    if (stage == 0) { const int g = (int)atomicAdd(gq, 1u); if (g < NPB) code = g; else { pend = g; stage = 1; } }
                    if (stage == 1) {
                        while (xi < 8) { const int x = (myx + xi) & 7; const int tk = (int)atomicAdd(dq + x, 1u); if (tk < 64) { code = -2 - ((4 * x + (tk >> 4)) * 16 + (tk & 15)); break; } ++xi; }
                        if (xi >= 8) stage = 2;
                    }
                    if (stage == 2 && code == -1) { int g = pend; pend = -1; if (g < 0) g = (int)atomicAdd(gq, 1u); if (g < ntot) code = g; }
                    *qslot = code;
                }
                __syncthreads();
                const int u = *qslot;
                if (u == -1) break;
                if (u <= -2) { if (PH_MASK & 32) diff_unit(F, p, l, -2 - u); }
                else if (u < NPB) { if (PH_MASK & 16) { REFRAME(F); phaseb_unit(F, p, u); }
                    asm volatile("s_waitcnt vmcnt(0)" ::: "memory"); __syncthreads();
                    if (F.tid == 0) __hip_atomic_fetch_add(pbdone, 1u, __ATOMIC_RELEASE, __HIP_MEMORY_SCOPE_AGENT); }
                else if (u >= ncv) {
                    if (F.tid == 0) { while (__hip_atomic_load(pbdone, __ATOMIC_RELAXED, __HIP_MEMORY_SCOPE_AGENT) < (unsigned)NPB) __builtin_amdgcn_s_sleep(8);
                        __builtin_amdgcn_fence(__ATOMIC_ACQUIRE, "agent"); asm volatile("s_waitcnt vmcnt(0)" ::: "memory"); }
                    __syncthreads();
                    if (PH_MASK & 64) post_unit(F, p, l, u - ncv); }
                else if (u < NPB + ncva) { REFRAME(F); cvt_item_a(p, l + 1, wb, (LAS float*)(F.lds + F.wave * 16384), (u - NPB) * 8 + F.wave, F.lane); }
                else { REFRAME(F); cvt_item_b(p, l, wb, (LAS float*)(F.lds + F.wave * 16384), (u - NPB - ncva) * 8 + F.wave, F.lane); }
            }
        }
        gsync(bst); STAMP(3);
        }
        if (PH_MASK & 128) {
            PHASE_VARS();
            pg8::StaticOrder S; S.init(MTOK, DM, G_, bid_);
            pg8::gemm_phase(F.lds, pg8::Gemm{MIX, wb + WO_OUT, MTOK, DM, DM}, S, pg8::EpiResid{p.out, XB, rowss + (size_t)(3 * l + 1) * MTOK * 16});
        }
        gsync(bst); STAMP(5);
        for (int rep = 0; rep < NREP(6); ++rep) {
        if (PH_MASK & 256) {
            PHASE_VARS();
            pg8::StaticOrder S; S.init(MTOK, XW, G_, bid_);
            if (F.bid < 128) {
                pg8::gemm_phase(F.lds, pg8::Gemm{XB, wb + WO_Q, MTOK, XW, DM}, S, pg8::EpiScaleBf16{(bf16_t*)(p.ws + WS_Q), XW, rowss + (size_t)(3 * l + 1) * MTOK * 16, nullptr, 0, 1 << 30, nullptr, nullptr, -1});
            } else {
                pg8::StaticOrder S2; S2.init(MMEM, 1024, 128, F.bid - 128);
                pg8::gemm_phase(F.lds, pg8::Gemm{(const bf16_t*)(p.ws + WS_MEMN), wb + WO_KV, MMEM, 1024, DM}, S2, pg8::EpiScaleBf16{(bf16_t*)(p.ws + WS_KV), 1024, nullptr, nullptr, 0, 1 << 30, nullptr, nullptr, -1});
            }
        }
        gsync(bst); STAMP(6);
        }
        for (int rep = 0; rep < NREP(7); ++rep) {
        if (PH_MASK & 512) for (int u = F.bid; u < 256; u += F.G) { PHASE_VARS(); cross_unit(F, p, u); }
        gsync(bst); STAMP(7);
        }
        if (PH_MASK & 1024) {
            PHASE_VARS();
            pg8::StaticOrder S; S.init(MTOK, DM, G_, bid_);
            pg8::gemm_phase(F.lds, pg8::Gemm{(const bf16_t*)(p.ws + WS_O), wb + WO_O, MTOK, DM, XW}, S, pg8::EpiResid{p.out, XB, rowss + (size_t)(3 * l + 2) * MTOK * 16});
        }
        gsync(bst); STAMP(8);
        for (int rep = 0; rep < NREP(9); ++rep) {
        if (PH_MASK & 2048) {
            PHASE_VARS();
            pg8::StaticOrder S; S.init(MTOK, 2 * DFF, G_, bid_);
            const int pm0 = rstd_table(F.lds, S, rowss + (size_t)(3 * l + 2) * MTOK * 16, F.tid);
            pg8::gemm_phase(F.lds, pg8::Gemm{XB, wb + WO_GU, MTOK, 2 * DFF, DM}, S, pg8::EpiSwiGLU{(bf16_t*)(p.ws + WS_G), rowss + (size_t)(3 * l + 2) * MTOK * 16, (const LAS float*)(F.lds + 131072 + 2048), pm0});
        }
        gsync(bst); STAMP(9);
        }
        if (PH_MASK & 4096) {
            PHASE_VARS();
            pg8::StaticOrder S; S.init(MTOK, DM, G_, bid_);
            pg8::gemm_phase(F.lds, pg8::Gemm{(const bf16_t*)(p.ws + WS_G), wb + WO_DOWN, MTOK, DM, DFF}, S, pg8::EpiResid{p.out, XB, rowss + (size_t)(3 * l + 3) * MTOK * 16});
        }

#ifdef TPROBE
        STAMP(10);
        { const Params p = make_params(); if (l == NL - 1 && blockIdx.x == 0 && threadIdx.x == 0) { LAS unsigned long long* ts_ = (LAS unsigned long long*)(F.lds + 131072 + 64); unsigned* c_ = (unsigned*)(p.ws + WS_CTL); c_[32] = (unsigned)ts_[1]; c_[33] = (unsigned)ts_[2]; } }
#endif
        gsync(bst);
    }
    if (PH_MASK & 8192) { const Params p = make_params(); final_norm(F, p); }
}

extern "C" void kernel_launch(void* const* d_in, const int* in_sizes, int n_in, void* d_out, int out_size, void* d_ws, size_t ws_size, hipStream_t stream) {
    static int grid = 0;
    if (grid == 0) {
        if (n_in != 31 || out_size != MTOK * DM || ws_size < WS_END) { fprintf(stderr, "kernel_launch: unexpected problem shape (n_in %d out %d ws %zu)\n", n_in, out_size, ws_size); grid = -1; return; }
        int dev = 0, cus = 0, per_cu = 0;
        hipGetDevice(&dev);
        hipDeviceGetAttribute(&cus, hipDeviceAttributeMultiprocessorCount, dev);
        hipFuncSetAttribute((const void*)fwd_megakernel, hipFuncAttributeMaxDynamicSharedMemorySize, LDS_BYTES);
        hipOccupancyMaxActiveBlocksPerMultiprocessor(&per_cu, (const void*)fwd_megakernel, 512, LDS_BYTES);
        if (per_cu < 1) { fprintf(stderr, "kernel_launch: occupancy query returned %d\n", per_cu); per_cu = 1; }
        (void)hipGetLastError();
        grid = cus * per_cu;
    }
    if (grid < 0) return;
    hipMemsetAsync((char*)d_ws + WS_CTL, 0, CTL_ZERO_BYTES, stream);
    KArgs p{};
    for (int i = 0; i < 31; ++i) p.in[i] = (const float*)d_in[i];
    p.out = (float*)d_out; p.ws = (unsigned char*)d_ws;
    void* args[] = {&p};
    hipError_t e = hipLaunchCooperativeKernel((const void*)fwd_megakernel, dim3(grid), dim3(512), args, LDS_BYTES, stream);
    if (e != hipSuccess) fprintf(stderr, "cooperative launch failed: %s (grid %d)\n", hipGetErrorString(e), grid);
}
```

```cpp
#include <hip/hip_runtime.h>
#include <hip/hip_cooperative_groups.h>
#include <cstdio>
#include <cstdint>
namespace cg = cooperative_groups;

#define LAS __attribute__((address_space(3)))
#define GAS __attribute__((address_space(1)))
typedef unsigned short bf16_t;
typedef short bf16x8 __attribute__((ext_vector_type(8)));
typedef short s16x4 __attribute__((ext_vector_type(4)));
typedef short v4i16_t __attribute__((ext_vector_type(4)));
typedef float f32x4 __attribute__((ext_vector_type(4)));
typedef float f32x2 __attribute__((ext_vector_type(2)));
typedef float f32x16 __attribute__((ext_vector_type(16)));
typedef unsigned u32x4 __attribute__((ext_vector_type(4)));
typedef unsigned u32x2 __attribute__((ext_vector_type(2)));
typedef __bf16 bf16x2_t __attribute__((ext_vector_type(2)));

constexpr int DM = 1024, NB = 8, SEQ = 2048, NL = 4, MTOK = NB * SEQ;
constexpr int NMEM = 256, MMEM = NB * NMEM;
constexpr int INW = 3072, DFF = 2816, XW = 512;
constexpr float LOG2E = 1.4426950408889634f;

constexpr size_t MiB = 1u << 20;
constexpr size_t WS_CTL = 0, CTL_ZERO_BYTES = 1 * MiB;
constexpr size_t WS_W = 1 * MiB;
constexpr size_t WS_Z = 30 * MiB;
constexpr size_t WS_ZC = 94 * MiB;
constexpr size_t WS_XB = 126 * MiB;
constexpr size_t WS_FQR = 94 * MiB, WS_FWY = 126 * MiB, WS_FNA = 158 * MiB, WS_FKH = 174 * MiB, WS_FP15 = 190 * MiB;
constexpr size_t WS_MIX = 192 * MiB;
constexpr size_t WS_OM = 224 * MiB, WS_KA = 240 * MiB, WS_KD = 256 * MiB, WS_KK = 272 * MiB, WS_V = 280 * MiB, WS_R = 288 * MiB;
constexpr size_t WS_GATE = 296 * MiB, WS_Y = 304 * MiB, WS_BON = 320 * MiB, WS_KV = 321 * MiB, WS_MEMN = 325 * MiB;
constexpr size_t WS_RP = 329 * MiB;
constexpr size_t WS_END = 342 * MiB;
constexpr size_t WS_Q = WS_Z, WS_O = WS_Z + 16 * MiB, WS_G = WS_Z;
constexpr int ZP = 1024;
constexpr size_t WS_KD2 = WS_Z + 32 * MiB, WS_VD2 = WS_Z + 48 * MiB;
constexpr size_t WO_IN = 0, WO_OUT = 3145728, WO_Q = 4194304, WO_KV = 4718592, WO_O = 5767168, WO_GU = 6291456, WO_DOWN = 12058624;
constexpr size_t WO_WUP = 14942208, WO_AUP = 14974976, WO_GUP = 15007744;
constexpr int CW_Q = 64;

constexpr int LDS_BYTES = 135168;

__device__ __forceinline__ float bf2f(unsigned b) { return __uint_as_float(b << 16); }
__device__ __forceinline__ unsigned pk2(float lo, float hi) { f32x2 v = {lo, hi}; bf16x2_t b = __builtin_convertvector(v, bf16x2_t); return __builtin_bit_cast(unsigned, b); }
__device__ __forceinline__ float bflo(unsigned u) { return __uint_as_float(u << 16); }
__device__ __forceinline__ float bfhi(unsigned u) { return __uint_as_float(u & 0xffff0000u); }
__device__ __forceinline__ float wave_sum(float v) {
#pragma unroll
    for (int o = 1; o < 64; o <<= 1) v += __shfl_xor(v, o);
    return v;
}
__device__ __forceinline__ float xhalf(float v) {
    return __shfl_xor(v, 32);
}
__device__ __forceinline__ float row_rstd(const float* rp, int row) {
    const f32x4* q = (const f32x4*)(rp + (size_t)row * 16); const f32x4 a = q[0], b = q[1], c = q[2], d = q[3];
    const float s = (((a[0] + a[1]) + (a[2] + a[3])) + ((b[0] + b[1]) + (b[2] + b[3]))) + (((c[0] + c[1]) + (c[2] + c[3])) + ((d[0] + d[1]) + (d[2] + d[3])));
    return rsqrtf(s * (1.f / 1024.f) + 1e-6f);
}
__device__ __forceinline__ float sigmoidf_(float x) { return __builtin_amdgcn_rcpf(1.f + __expf(-x)); }

__device__ __forceinline__ int hw_lane() { int l = (int)__builtin_amdgcn_mbcnt_hi(~0u, __builtin_amdgcn_mbcnt_lo(~0u, 0u)); asm volatile("" : "+v"(l)); return l; }
namespace pg8 {
constexpr int BM = 256, BK = 64, HALF = 128, HTB = HALF * BK * 2, NXCD = 8, WGM = 8;
__host__ __device__ __forceinline__ int lds_byte(int r, int c) { const int st = (r >> 4) * 2 + (c >> 5), rr = r & 15, cc = c & 31, ob = rr * 64 + cc * 2; return st * 1024 + (ob ^ (((ob >> 9) & 1) << 5)); }
__host__ __device__ __forceinline__ void stage_rc(int b, int& R, int& C) { const int st = b / 1024, sb = b % 1024, swz = sb ^ (((sb >> 9) & 1) << 5); R = (st >> 1) * 16 + swz / 64; C = (st & 1) * 32 + (swz % 64) / 2; }
__host__ __device__ __forceinline__ int perm32(int rho) { const int n = rho >> 4, i = rho & 15; return 8 * (i >> 2) + 4 * n + (i & 3); }
struct Unit { int pm, pn; };
struct Gemm { const bf16_t* A; const bf16_t* Bt; int M, N, K; };
struct StaticOrder {
    int nM, nN, nwg, G, c;
    __device__ void init(int M, int N, int G_, int c_) { nM = M / BM; nN = N / BM; nwg = nM * nN; G = G_; c = c_; }
    __device__ bool next(int i, Unit& u) const {
        const long L = (long)i * G + c; if (L >= nwg) return false;
        int wgid = (int)L; { const int q = nwg / NXCD, r = nwg % NXCD, xcd = wgid % NXCD, off = wgid / NXCD; wgid = (xcd < r ? xcd * (q + 1) : r * (q + 1) + (xcd - r) * q) + off; }
        const int nig = WGM * nN, gid = wgid / nig, fm = gid * WGM, gsz = (nM - fm) < WGM ? (nM - fm) : WGM;
        u.pm = fm + ((wgid % nig) % gsz); u.pn = (wgid % nig) / gsz; return true;
    }
};
template <class Epi>
__device__ __forceinline__ void gemm_phase(LAS unsigned char* lds, const Gemm g, const StaticOrder& S, const Epi& E) {
    int tid_ = threadIdx.x; asm volatile("" : "+v"(tid_));
    const int tid = tid_, wid = __builtin_amdgcn_readfirstlane(tid >> 6), lane = tid & 63, wr = wid >> 2, wc = wid & 3, fr = lane & 15, fq = lane >> 4;
    const int K = g.K, nt = K / BK;
    unsigned voffA[2], voffB[2];
#pragma unroll
    for (int i = 0; i < 2; ++i) { int R, C; stage_rc(tid * 16 + i * 8192, R, C); const int Rb = (R & ~31) + perm32(R & 31);
        voffA[i] = (unsigned)(R * K + C) * 2u; voffB[i] = (unsigned)(Rb * K + C) * 2u; }
    const size_t kstep = (size_t)(BK * 2);
    const size_t hstep = (size_t)HALF * K * 2;
    const size_t tstep = 2 * hstep;
    const unsigned ldsw = (unsigned)wid * 1024u;
    const int aoff = lds_byte(wr * 64 + fr, fq * 8), boff = lds_byte(wc * 32 + fr, fq * 8);
#define PG8_SA(b, h) (((b) * 2 + (h)) * HTB)
#define PG8_SB(b, h) ((4 + (b) * 2 + (h)) * HTB)
#define PG8_STAGE(bufoff, gbase, voff) do { _Pragma("unroll") for (int _i = 0; _i < 2; ++_i) \
        __builtin_amdgcn_global_load_lds((const unsigned*)((const char*)(gbase) + (voff)[_i]), (LAS unsigned*)(lds + (bufoff) + ldsw + _i * 8192), 16, 0, 0); } while (0)
#define PG8_LDA(dst, b, h) do { _Pragma("unroll") for (int m = 0; m < 4; ++m) _Pragma("unroll") for (int k = 0; k < 2; ++k) dst[m][k] = *(const LAS bf16x8*)(lds + PG8_SA(b, h) + aoff + m * 2048 + k * 1024); } while (0)
#define PG8_LDB(dst, b, h) do { _Pragma("unroll") for (int n = 0; n < 2; ++n) _Pragma("unroll") for (int k = 0; k < 2; ++k) dst[n][k] = *(const LAS bf16x8*)(lds + PG8_SB(b, h) + boff + n * 2048 + k * 1024); } while (0)
#define PG8_MMA(ai, bj, At, Bt) do { __builtin_amdgcn_s_setprio(1); _Pragma("unroll") for (int m = 0; m < 4; ++m) _Pragma("unroll") for (int n = 0; n < 2; ++n) _Pragma("unroll") for (int k = 0; k < 2; ++k) \
        acc[ai][bj][m][n] = __builtin_amdgcn_mfma_f32_16x16x32_bf16(Bt[n][k], At[m][k], acc[ai][bj][m][n], 0, 0, 0); __builtin_amdgcn_s_setprio(0); } while (0)
#define PG8_WAIT_V(n) asm volatile("s_waitcnt vmcnt(" #n ")" ::: "memory")
#define PG8_WAIT_L(n) asm volatile("s_waitcnt lgkmcnt(" #n ")" ::: "memory")
#define PG8_BAR __builtin_amdgcn_s_barrier()
#define PG8_SCHED __builtin_amdgcn_sched_barrier(0)
    Unit cur, nxt; int ui = 0;
    if (!S.next(0, cur)) return;
    f32x4 acc[2][2][4][2];
#pragma unroll
    for (int a = 0; a < 2; ++a)
#pragma unroll
        for (int b = 0; b < 2; ++b)
#pragma unroll
            for (int m = 0; m < 4; ++m)
#pragma unroll
                for (int n = 0; n < 2; ++n) acc[a][b][m][n] = (f32x4){0.f, 0.f, 0.f, 0.f};
    bf16x8 At[4][2], B0[2][2], B1[2][2];
    const char* cA = (const char*)g.A + (size_t)cur.pm * tstep; const char* cB = (const char*)g.Bt + (size_t)cur.pn * tstep;
    {
        PG8_STAGE(PG8_SB(0, 0), cB, voffB); PG8_STAGE(PG8_SB(0, 1), cB + hstep, voffB); PG8_STAGE(PG8_SA(0, 0), cA, voffA); PG8_STAGE(PG8_SA(0, 1), cA + hstep, voffA);
        if (wr == 1) PG8_BAR;
        PG8_WAIT_V(2); PG8_BAR;
        PG8_STAGE(PG8_SB(1, 0), cB + kstep, voffB); PG8_STAGE(PG8_SA(1, 0), cA + kstep, voffA); PG8_STAGE(PG8_SB(1, 1), cB + hstep + kstep, voffB);
        PG8_WAIT_V(6); PG8_BAR;
    }
    for (;;) {
        const bool has_next = S.next(ui + 1, nxt);
        const char* nA = has_next ? (const char*)g.A + (size_t)nxt.pm * tstep : cA; const char* nB = has_next ? (const char*)g.Bt + (size_t)nxt.pn * tstep : cB;
        for (int t = 0; t < nt; t += 2) {
            const bool last = (t == nt - 2);
            const char* a1 = cA + (size_t)(t + 1) * kstep;
            const char* a2 = last ? nA : cA + (size_t)(t + 2) * kstep; const char* b2 = last ? nB : cB + (size_t)(t + 2) * kstep;
            const char* a3 = a2 + kstep; const char* b3 = b2 + kstep;
            PG8_LDB(B0, 0, 0); PG8_LDB(B1, 0, 1); PG8_SCHED; PG8_LDA(At, 0, 0); PG8_STAGE(PG8_SA(1, 1), a1 + hstep, voffA);
            PG8_WAIT_V(8); PG8_WAIT_L(0); PG8_BAR; PG8_MMA(0, 0, At, B0); PG8_MMA(0, 1, At, B1); PG8_BAR; PG8_SCHED;
            PG8_LDA(At, 0, 1); PG8_STAGE(PG8_SB(0, 0), b2, voffB); PG8_STAGE(PG8_SB(0, 1), b2 + hstep, voffB); PG8_STAGE(PG8_SA(0, 0), a2, voffA);
            PG8_WAIT_V(8); PG8_WAIT_L(0); PG8_BAR; PG8_MMA(1, 0, At, B0); PG8_MMA(1, 1, At, B1); PG8_BAR; PG8_SCHED;
            PG8_LDB(B0, 1, 0); PG8_LDB(B1, 1, 1); PG8_SCHED; PG8_LDA(At, 1, 0); PG8_STAGE(PG8_SA(0, 1), a2 + hstep, voffA);
            PG8_WAIT_V(8); PG8_WAIT_L(0); PG8_BAR; PG8_MMA(0, 0, At, B0); PG8_MMA(0, 1, At, B1); PG8_BAR; PG8_SCHED;
            PG8_LDA(At, 1, 1); PG8_STAGE(PG8_SB(1, 0), b3, voffB); PG8_STAGE(PG8_SB(1, 1), b3 + hstep, voffB); PG8_STAGE(PG8_SA(1, 0), a3, voffA);
            PG8_WAIT_V(8); PG8_WAIT_L(0); PG8_BAR; PG8_MMA(1, 0, At, B0); PG8_MMA(1, 1, At, B1); PG8_BAR; PG8_SCHED;
        }
        if (wr == 0) PG8_BAR;
        E(acc, cur, wr, wc, fr, fq);
        if (!has_next) break;
#pragma unroll
        for (int a = 0; a < 2; ++a)
#pragma unroll
            for (int b = 0; b < 2; ++b)
#pragma unroll
                for (int m = 0; m < 4; ++m)
#pragma unroll
                    for (int n = 0; n < 2; ++n) acc[a][b][m][n] = (f32x4){0.f, 0.f, 0.f, 0.f};
        cur = nxt; cA = nA; cB = nB; ++ui;
        if (wr == 1) PG8_BAR;
    }
    PG8_WAIT_V(0);
    PG8_BAR;
#undef PG8_SA
#undef PG8_SB
#undef PG8_STAGE
#undef PG8_LDA
#undef PG8_LDB
#undef PG8_MMA
#undef PG8_WAIT_V
#undef PG8_WAIT_L
#undef PG8_BAR
#undef PG8_SCHED
}

struct EpiScaleBf16 {
    bf16_t* O; int ldc; const float* rowss; bf16_t* O2; int ldc2; int split_tile; bf16_t* KD2;
    const LAS float* tab; int pm0;
    __device__ __forceinline__ void operator()(const f32x4 (&acc)[2][2][4][2], const Unit& u, int wr, int wc, int fr, int fq) const {
        const bool hi = u.pn >= split_tile, mid = (split_tile == 8) && u.pn >= 4 && u.pn < 8;
        const int row0 = u.pm * BM + wr * 64 + fr, col0 = (hi ? u.pn - split_tile : u.pn) * BM + wc * 32 + 8 * fq;
        bf16_t* const Ob = hi ? O2 : O; const int ld = hi ? ldc2 : ldc;
#pragma unroll
        for (int ai = 0; ai < 2; ++ai)
#pragma unroll
            for (int m = 0; m < 4; ++m) { const int row = row0 + ai * HALF + m * 16;
                const float sc = !rowss ? 1.f : ((tab && u.pm == pm0) ? tab[row & 255] : row_rstd(rowss, row));
                bf16_t* rowp = Ob + (size_t)row * ld + col0;
#pragma unroll
                for (int bj = 0; bj < 2; ++bj) { const f32x4 v0 = acc[ai][bj][m][0] * sc, v1 = acc[ai][bj][m][1] * sc;
                    u32x4 w; w.x = pk2(v0[0], v0[1]); w.y = pk2(v0[2], v0[3]); w.z = pk2(v1[0], v1[1]); w.w = pk2(v1[2], v1[3]);
                    bf16_t* dst = rowp + bj * HALF;
                    if (mid) dst = KD2 + (u.pn >= 6 ? (size_t)8388608 : (size_t)0) + ((size_t)(((row >> 11) * 4 + 2 * (u.pn & 1) + bj) * 2048 + (row & 2047))) * 128 + wc * 32 + 8 * fq;
                    *(u32x4*)dst = w; } }
    }
};
struct EpiSwiGLU {
    bf16_t* O; const float* rowss; const LAS float* tab; int pm0;
    __device__ __forceinline__ void operator()(const f32x4 (&acc)[2][2][4][2], const Unit& u, int wr, int wc, int fr, int fq) const {
        const int row0 = u.pm * BM + wr * 64 + fr, col0 = u.pn * HALF + wc * 32 + 8 * fq;
#pragma unroll
        for (int ai = 0; ai < 2; ++ai)
#pragma unroll
            for (int m = 0; m < 4; ++m) { const int row = row0 + ai * HALF + m * 16;
                const float sc = (tab && u.pm == pm0) ? tab[row & 255] : row_rstd(rowss, row);
                float h[8];
#pragma unroll
                for (int n = 0; n < 2; ++n)
#pragma unroll
                    for (int j = 0; j < 4; ++j) { const float gt = acc[ai][0][m][n][j] * sc, up = acc[ai][1][m][n][j] * sc; h[n * 4 + j] = gt * __builtin_amdgcn_rcpf(1.f + __expf(-gt)) * up; }
                u32x4 w; w.x = pk2(h[0], h[1]); w.y = pk2(h[2], h[3]); w.z = pk2(h[4], h[5]); w.w = pk2(h[6], h[7]);
                *(u32x4*)(O + (size_t)row * DFF + col0) = w; }
    }
};
struct EpiResid {
    float* X; bf16_t* XB; float* rowss_next;
    __device__ __forceinline__ void operator()(const f32x4 (&acc)[2][2][4][2], const Unit& u, int wr, int wc, int fr, int fq) const {
        const int row0 = u.pm * BM + wr * 64 + fr, col0 = u.pn * BM + wc * 32 + 8 * fq;
#pragma unroll
        for (int ai = 0; ai < 2; ++ai)
#pragma unroll
            for (int m = 0; m < 4; ++m) { const int row = row0 + ai * HALF + m * 16; float ss = 0.f;
                float* xp = X + (size_t)row * DM + col0; bf16_t* bp = XB + (size_t)row * DM + col0;
#pragma unroll
                for (int bj = 0; bj < 2; ++bj) {
                    f32x4 x0 = *(f32x4*)(xp + bj * HALF), x1 = *(f32x4*)(xp + bj * HALF + 4);
                    x0 = x0 + acc[ai][bj][m][0]; x1 = x1 + acc[ai][bj][m][1];
                    *(f32x4*)(xp + bj * HALF) = x0; *(f32x4*)(xp + bj * HALF + 4) = x1;
                    ss += (x0[0] * x0[0] + x0[1] * x0[1]) + (x0[2] * x0[2] + x0[3] * x0[3]) + (x1[0] * x1[0] + x1[1] * x1[1]) + (x1[2] * x1[2] + x1[3] * x1[3]);
                    u32x4 w; w.x = pk2(x0[0], x0[1]); w.y = pk2(x0[2], x0[3]); w.z = pk2(x1[0], x1[1]); w.w = pk2(x1[2], x1[3]);
                    *(u32x4*)(bp + bj * HALF) = w; }
                ss += __shfl_xor(ss, 16); ss += __shfl_xor(ss, 32);
                if (fq == 0) rowss_next[(size_t)row * 16 + u.pn * 4 + wc] = ss; }
    }
};
}

struct KArgs { const float* in[31]; float* out; unsigned char* ws; };
#define CAS __attribute__((address_space(4)))
struct InProxy { const CAS unsigned long long* k; __device__ __forceinline__ const float* operator[](int i) const { return (const float*)k[i]; } };
struct Params { InProxy in; float* out; unsigned char* ws; };
__device__ __forceinline__ Params make_params() {
    unsigned long long kv = (unsigned long long)__builtin_amdgcn_kernarg_segment_ptr();
    asm volatile("" : "+s"(kv));
    const CAS unsigned long long* k = (const CAS unsigned long long*)kv;
    Params p; p.in.k = k; p.out = (float*)k[31]; p.ws = (unsigned char*)k[32]; return p;
}

struct Frame {
    LAS unsigned char* lds;
    int tid, lane, wave, G, bid;
};

#define REFRAME(F) do { int _t = threadIdx.x; asm volatile("" : "+v"(_t)); (F).tid = _t; (F).lane = _t & 63; (F).wave = __builtin_amdgcn_readfirstlane(_t >> 6); } while (0)
__device__ __forceinline__ void cvt_item(const float* W_, int K, int ldn, int nblk, bf16_t* WT_, const float* gain_, bool perm_gu, LAS float* scr, int item, int lane) {
    const GAS float* W = (const GAS float*)W_; const GAS float* gain = (const GAS float*)gain_; GAS bf16_t* WT = (GAS bf16_t*)WT_;
    const int kb = item / nblk, nb = item % nblk, k0 = 64 * kb, n0d = 32 * nb;
    const int n0s = perm_gu ? (((n0d & 255) >> 7) * DFF + (n0d >> 8) * 128 + (n0d & 127)) : n0d;
    float v[32];
#pragma unroll
    for (int i = 0; i < 32; ++i) v[i] = W[(size_t)(k0 + 2 * i + (lane >> 5)) * ldn + n0s + (lane & 31)];
    if (gain_) {
#pragma unroll
        for (int i = 0; i < 32; ++i) v[i] *= gain[k0 + 2 * i + (lane >> 5)];
    }
#pragma unroll
    for (int i = 0; i < 32; ++i) scr[(2 * i + (lane >> 5)) * 33 + (lane & 31)] = v[i];
    asm volatile("s_waitcnt lgkmcnt(0)" ::: "memory");
    const int c = lane & 7;
#pragma unroll
    for (int j = 0; j < 4; ++j) { const int n = (lane >> 3) + 8 * j; const LAS float* sp = scr + (8 * c) * 33 + n;
        u32x4 o; o.x = pk2(sp[0 * 33], sp[1 * 33]); o.y = pk2(sp[2 * 33], sp[3 * 33]); o.z = pk2(sp[4 * 33], sp[5 * 33]); o.w = pk2(sp[6 * 33], sp[7 * 33]);
        *(GAS u32x4*)(WT + (size_t)(n0d + n) * K + k0 + 8 * c) = o; }
    asm volatile("s_waitcnt lgkmcnt(0)" ::: "memory");
}
constexpr int CV_IN = 1536, CV_OUT = 512, CV_Q = 256, CV_KV = 512, CV_O = 256, CV_GU = 2816, CV_DOWN = 1408, CV_L = 8;
constexpr int CV_TOTAL = CV_IN + CV_OUT + CV_Q + CV_KV + CV_O + CV_GU + CV_DOWN + 2 * CV_L + 2 * CV_L + 16;

static_assert(CV_TOTAL % 8 == 0, "conversion items per layer");
constexpr int CV_A = CV_IN + 2 * CV_L + 2 * CV_L + 16, CV_B = CV_KV + CV_OUT + CV_Q + CV_O + CV_GU + CV_DOWN;
static_assert(CV_A % 8 == 0 && CV_B % 8 == 0 && CV_A + CV_B == CV_TOTAL, "conversion lists");
__device__ __forceinline__ void cvt_item_a(const Params& p, int l, bf16_t* wb, LAS float* scr, int it, int lane) {
    int r = it;
    if (r < CV_IN) { cvt_item(p.in[3] + (size_t)l * DM * INW, DM, INW, INW / 32, wb + WO_IN, p.in[2] + l * DM, false, scr, r, lane); return; } r -= CV_IN;
    if (r < 2 * CV_L) { const int d = r / CV_L; cvt_item(p.in[12] + ((size_t)l * 2 + d) * 64 * 256, 64, 256, 8, wb + WO_WUP + d * 256 * 64, nullptr, false, scr, r % CV_L, lane); return; } r -= 2 * CV_L;
    if (r < 2 * CV_L) { const int d = r / CV_L; cvt_item(p.in[14] + ((size_t)l * 2 + d) * 64 * 256, 64, 256, 8, wb + WO_AUP + d * 256 * 64, nullptr, false, scr, r % CV_L, lane); return; } r -= 2 * CV_L;
    cvt_item(p.in[15] + (size_t)l * 128 * 256, 128, 256, 8, wb + WO_GUP, nullptr, false, scr, r, lane);
}
__device__ __forceinline__ void cvt_item_b(const Params& p, int l, bf16_t* wb, LAS float* scr, int it, int lane) {
    int r = it;
    if (r < CV_KV) { cvt_item(p.in[25] + (size_t)l * DM * 1024, DM, 1024, 32, wb + WO_KV, nullptr, false, scr, r, lane); return; } r -= CV_KV;
    if (r < CV_OUT) { cvt_item(p.in[21] + (size_t)l * DM * DM, DM, DM, DM / 32, wb + WO_OUT, nullptr, false, scr, r, lane); return; } r -= CV_OUT;
    if (r < CV_Q) { cvt_item(p.in[24] + (size_t)l * DM * XW, DM, XW, XW / 32, wb + WO_Q, p.in[22] + l * DM, false, scr, r, lane); return; } r -= CV_Q;
    if (r < CV_O) { cvt_item(p.in[26] + (size_t)l * XW * DM, XW, DM, 32, wb + WO_O, nullptr, false, scr, r, lane); return; } r -= CV_O;
    if (r < CV_GU) { cvt_item(p.in[28] + (size_t)l * DM * 2 * DFF, DM, 2 * DFF, 2 * DFF / 32, wb + WO_GU, p.in[27] + l * DM, true, scr, r, lane); return; } r -= CV_GU;
    cvt_item(p.in[29] + (size_t)l * DFF * DM, DFF, DM, 32, wb + WO_DOWN, nullptr, false, scr, r, lane);
}

__device__ __forceinline__ s16x4 vtr(const LAS unsigned char* p) { return __builtin_bit_cast(s16x4, __builtin_amdgcn_ds_read_tr16_b64_v4i16((LAS v4i16_t*)p)); }
__device__ __forceinline__ int crow(int r, int hi) { return (r & 3) + 8 * (r >> 2) + 4 * hi; }

template <int W> __device__ __forceinline__ void tile_load(u32x4 (&r)[W / 64], const bf16_t* g, int pitch, int tid) {
#pragma unroll
    for (int i = 0; i < W / 64; ++i) { const int id = tid + i * 512, row = id / (W / 8), ch = id % (W / 8); r[i] = *(const GAS u32x4*)((const GAS bf16_t*)g + (size_t)row * pitch + ch * 8); }
}
template <int W, int STR> __device__ __forceinline__ void tile_store(const u32x4 (&r)[W / 64], LAS unsigned char* buf, int tid) {
#pragma unroll
    for (int i = 0; i < W / 64; ++i) { const int id = tid + i * 512, row = id / (W / 8), ch = id % (W / 8); *(LAS u32x4*)(buf + row * STR + ch * 16) = r[i]; }
}
template <int DQK> __device__ __forceinline__ void load_q(bf16x8 (&qf)[DQK / 16], const bf16_t* qrow, int h, float sc) {
#pragma unroll
    for (int ks = 0; ks < DQK / 16; ++ks) { const u32x4 v = *(const GAS u32x4*)((const GAS bf16_t*)qrow + 16 * ks + 8 * h);
        u32x4 o; o.x = pk2(bflo(v.x) * sc, bfhi(v.x) * sc); o.y = pk2(bflo(v.y) * sc, bfhi(v.y) * sc); o.z = pk2(bflo(v.z) * sc, bfhi(v.z) * sc); o.w = pk2(bflo(v.w) * sc, bfhi(v.w) * sc);
        qf[ks] = __builtin_bit_cast(bf16x8, o); }
}
template <int DQK, int KW, int DV, int MODE>
__device__ __forceinline__ void attn_loop(LAS unsigned char* lds, const bf16_t* Kg, int kpitch, const bf16_t* Vg, int vpitch, int ntiles,
                                          const bf16x8 (&qf)[DQK / 16], int koff, float nslope2, int qrel, float& m, float& lsum, f32x16 (&o)[DV / 32]) {
    constexpr int KSTR = (KW + 8) * 2, VSTR = DV * 2 + 64, KBUF = 64 * KSTR, VBUF = 64 * VSTR;
    int tid_ = threadIdx.x; asm volatile("" : "+v"(tid_));
    const int tid = tid_, lane = tid & 63, r = lane & 31, h = lane >> 5;
    LAS unsigned char* K0 = lds; LAS unsigned char* V0 = lds + 2 * KBUF;
    u32x4 kr[KW / 64], vr[DV / 64];
    tile_load<KW>(kr, Kg, kpitch, tid); tile_load<DV>(vr, Vg, vpitch, tid);
    tile_store<KW, KSTR>(kr, K0, tid); tile_store<DV, VSTR>(vr, V0, tid);
    __syncthreads();
    const int vlane = ((lane & 15) >> 2) * VSTR + (16 * ((lane >> 4) & 1) + 4 * (lane & 3)) * 2 + 4 * h * VSTR;
    for (int t = 0; t < ntiles; ++t) {
        const int cur = t & 1;
        if (t + 1 < ntiles) { tile_load<KW>(kr, Kg + (size_t)(t + 1) * 64 * kpitch, kpitch, tid); tile_load<DV>(vr, Vg + (size_t)(t + 1) * 64 * vpitch, vpitch, tid); }
        const LAS unsigned char* Kb = K0 + cur * KBUF + r * KSTR + (koff + 8 * h) * 2;
        const LAS unsigned char* Vb = V0 + cur * VBUF + vlane;
        f32x16 s0, s1;
#pragma unroll
        for (int i = 0; i < 16; ++i) { s0[i] = 0.f; s1[i] = 0.f; }
#pragma unroll
        for (int ks = 0; ks < DQK / 16; ++ks) {
            const bf16x8 k0 = *(const LAS bf16x8*)(Kb + ks * 32), k1 = *(const LAS bf16x8*)(Kb + 32 * KSTR + ks * 32);
            s0 = __builtin_amdgcn_mfma_f32_32x32x16_bf16(k0, qf[ks], s0, 0, 0, 0);
            s1 = __builtin_amdgcn_mfma_f32_32x32x16_bf16(k1, qf[ks], s1, 0, 0, 0);
        }
        float Aoff = 0.f;
        if (MODE >= 1) {
            const int qrel0 = __builtin_amdgcn_readfirstlane(qrel - r);
            const int T0 = t * 64;
            if (MODE == 1 && (T0 + 64 <= qrel0 || T0 > qrel0 + 31)) {
                const bool left = (T0 + 64 <= qrel0);
                const float sl = left ? -nslope2 : nslope2;
                Aoff = left ? nslope2 * (float)(qrel - T0 - 4 * h) : nslope2 * (float)(T0 + 4 * h - qrel);
#pragma unroll
                for (int i = 0; i < 16; ++i) { s0[i] = __builtin_fmaf(sl, (float)((i & 3) + 8 * (i >> 2)), s0[i]); s1[i] = __builtin_fmaf(sl, (float)(32 + (i & 3) + 8 * (i >> 2)), s1[i]); }
            } else {
                const float base = (float)(T0 + 4 * h - qrel);
#pragma unroll
                for (int i = 0; i < 16; ++i) {
                    const float d0 = fabsf(base + (float)((i & 3) + 8 * (i >> 2))), d1 = fabsf(base + (float)(32 + (i & 3) + 8 * (i >> 2)));
                    s0[i] = __builtin_fmaf(d0, nslope2, s0[i]); s1[i] = __builtin_fmaf(d1, nslope2, s1[i]);
                    if (MODE == 2) { if (d0 > 128.f) s0[i] = -1e30f; if (d1 > 128.f) s1[i] = -1e30f; }
                }
            }
        }
        float mx = fmaxf(s0[0], s1[0]);
#pragma unroll
        for (int i = 1; i < 16; ++i) mx = fmaxf(fmaxf(mx, s0[i]), s1[i]);
        mx += Aoff;
        mx = fmaxf(mx, xhalf(mx));
        const float mnew = fmaxf(m, mx);
        if (__builtin_amdgcn_ballot_w64(mnew > m) != 0ull) {
            const float alpha = __builtin_amdgcn_exp2f(m - mnew);
            lsum *= alpha;
#pragma unroll
            for (int d = 0; d < DV / 32; ++d) o[d] = o[d] * alpha;
        }
        m = mnew;
        const float mm = mnew - Aoff;
        float rs = 0.f;
#pragma unroll
        for (int i = 0; i < 16; ++i) { s0[i] = __builtin_amdgcn_exp2f(s0[i] - mm); s1[i] = __builtin_amdgcn_exp2f(s1[i] - mm); rs += s0[i] + s1[i]; }
        lsum += rs;
        bf16x8 pf[4];
#pragma unroll
        for (int s2 = 0; s2 < 2; ++s2) {
            u32x4 a, b;
            a.x = pk2(s0[8 * s2 + 0], s0[8 * s2 + 1]); a.y = pk2(s0[8 * s2 + 2], s0[8 * s2 + 3]); a.z = pk2(s0[8 * s2 + 4], s0[8 * s2 + 5]); a.w = pk2(s0[8 * s2 + 6], s0[8 * s2 + 7]);
            b.x = pk2(s1[8 * s2 + 0], s1[8 * s2 + 1]); b.y = pk2(s1[8 * s2 + 2], s1[8 * s2 + 3]); b.z = pk2(s1[8 * s2 + 4], s1[8 * s2 + 5]); b.w = pk2(s1[8 * s2 + 6], s1[8 * s2 + 7]);
            pf[s2] = __builtin_bit_cast(bf16x8, a); pf[2 + s2] = __builtin_bit_cast(bf16x8, b);
        }
#pragma unroll
        for (int d = 0; d < DV / 32; ++d) {
#pragma unroll
            for (int kk = 0; kk < 4; ++kk) {
                const s16x4 lo = vtr(Vb + (16 * kk) * VSTR + d * 64), hi = vtr(Vb + (16 * kk + 8) * VSTR + d * 64);
                const bf16x8 vf = {lo[0], lo[1], lo[2], lo[3], hi[0], hi[1], hi[2], hi[3]};
                o[d] = __builtin_amdgcn_mfma_f32_32x32x16_bf16(vf, pf[kk], o[d], 0, 0, 0);
            }
        }
        if (t + 1 < ntiles) { tile_store<KW, KSTR>(kr, K0 + (cur ^ 1) * KBUF, tid); tile_store<DV, VSTR>(vr, V0 + (cur ^ 1) * VBUF, tid); }
        __syncthreads();
    }
}
__device__ __forceinline__ int swz(int row) { return ((row & 3) << 2) | ((row >> 2) & 3); }
template <int DQK, int MODE, int pitch, int voff>
__device__ __forceinline__ void attn_loop_dma(LAS unsigned char* lds, const int wave, const bf16_t* Kg, int ntiles,
                                              const bf16x8 (&qf)[DQK / 16], int koff, float nslope2, int qrel, float& m, float& lsum, f32x16 (&o)[4]) {
    constexpr int DV = 128, STAGE = 32768, VOFFB = 16384;
    const int lane = hw_lane(), r = lane & 31, h = lane >> 5;
    unsigned gk[2];
#pragma unroll
    for (int i = 0; i < 2; ++i) { const int row = 4 * (2 * wave + i) + (lane >> 4), c = (lane & 15) ^ swz(row); gk[i] = (unsigned)(row * pitch + c * 8); }
    unsigned kad[DQK / 16], vad[4][2];
#pragma unroll
    for (int ks = 0; ks < DQK / 16; ++ks) kad[ks] = (unsigned)(r * 256 + 16 * (((koff >> 3) + 2 * ks + h) ^ swz(r)));
    { const int q_ = (lane & 15) >> 2, pp = lane & 3, g1 = (lane >> 4) & 1;
#pragma unroll
      for (int d = 0; d < 4; ++d)
#pragma unroll
          for (int hi = 0; hi < 2; ++hi) { const int f = (q_ << 2) | ((2 * hi + h) & 3), c = (4 * d + 2 * g1 + (pp >> 1)) ^ f;
              vad[d][hi] = (unsigned)(VOFFB + (4 * h + q_) * 256 + 16 * c + 8 * (pp & 1) + hi * 2048); } }
#define ATT_DMA(tt, st) do { const bf16_t* kg_ = Kg + (size_t)(tt) * 64 * pitch; _Pragma("unroll") for (int i_ = 0; i_ < 2; ++i_) { \
        __builtin_amdgcn_global_load_lds((const unsigned*)(kg_ + gk[i_]), (LAS unsigned*)(lds + (st) * STAGE + (2 * wave + i_) * 1024), 16, 0, 0); \
        __builtin_amdgcn_global_load_lds((const unsigned*)(kg_ + voff + gk[i_]), (LAS unsigned*)(lds + (st) * STAGE + VOFFB + (2 * wave + i_) * 1024), 16, 0, 0); } } while (0)
    ATT_DMA(0, 0);
    if (ntiles > 1) ATT_DMA(1, 1);
    if (ntiles > 2) { ATT_DMA(2, 2); asm volatile("s_waitcnt vmcnt(4)" ::: "memory"); } else asm volatile("s_waitcnt vmcnt(0)" ::: "memory");
    __builtin_amdgcn_s_barrier();
    f32x16 s0, s1;
#pragma unroll
    for (int i = 0; i < 16; ++i) { s0[i] = 0.f; s1[i] = 0.f; }
#pragma unroll
    for (int ks = 0; ks < DQK / 16; ++ks) {
        const bf16x8 k0 = *(const LAS bf16x8*)(lds + kad[ks]), k1 = *(const LAS bf16x8*)(lds + kad[ks] + 8192);
        s0 = __builtin_amdgcn_mfma_f32_32x32x16_bf16(k0, qf[ks], s0, 0, 0, 0);
        s1 = __builtin_amdgcn_mfma_f32_32x32x16_bf16(k1, qf[ks], s1, 0, 0, 0);
    }
#define LDS_RD128(dst, addr, off) asm volatile("ds_read_b128 %0, %1 offset:%c2" : "=&v"(dst) : "v"(addr), "i"(off) : "memory")
#define LDS_RDTR(dst, addr, off) asm volatile("ds_read_b64_tr_b16 %0, %1 offset:%c2" : "=&v"(dst) : "v"(addr), "i"(off) : "memory")
#define LDS_WAIT0() do { asm volatile("s_waitcnt lgkmcnt(0)" ::: "memory"); __builtin_amdgcn_sched_barrier(0); } while (0)
    for (int t = 0; t < ntiles; ++t) {
        if (t + 3 < ntiles) ATT_DMA(t + 3, (t + 3) & 3);
        const unsigned sba = (unsigned)(size_t)(lds + (t & 3) * STAGE), sna = (unsigned)(size_t)(lds + ((t + 1) & 3) * STAGE);
        constexpr int KH = (DQK == 64) ? 4 : 4;
        bf16x8 kf0[KH], kf1[KH];
        s16x4 va_lo[4], va_hi[4], vb_lo[4], vb_hi[4];
        if (DQK == 64) {
#pragma unroll
            for (int ks = 0; ks < KH; ++ks) { const unsigned ka = sna + kad[ks]; LDS_RD128(kf0[ks], ka, 0); } }
        __builtin_amdgcn_sched_barrier(0);
        float Aoff = 0.f;
        if (MODE >= 1) {
            const int qrel0 = __builtin_amdgcn_readfirstlane(qrel - r);
            const int T0 = t * 64;
            if (MODE == 1 && (T0 + 64 <= qrel0 || T0 > qrel0 + 31)) {
                const bool left = (T0 + 64 <= qrel0);
                const float sl = left ? -nslope2 : nslope2;
                Aoff = left ? nslope2 * (float)(qrel - T0 - 4 * h) : nslope2 * (float)(T0 + 4 * h - qrel);
#pragma unroll
                for (int i = 0; i < 16; ++i) { s0[i] = __builtin_fmaf(sl, (float)((i & 3) + 8 * (i >> 2)), s0[i]); s1[i] = __builtin_fmaf(sl, (float)(32 + (i & 3) + 8 * (i >> 2)), s1[i]); }
            } else {
                const float base = (float)(T0 + 4 * h - qrel);
#pragma unroll
                for (int i = 0; i < 16; ++i) {
                    const float d0 = fabsf(base + (float)((i & 3) + 8 * (i >> 2))), d1 = fabsf(base + (float)(32 + (i & 3) + 8 * (i >> 2)));
                    s0[i] = __builtin_fmaf(d0, nslope2, s0[i]); s1[i] = __builtin_fmaf(d1, nslope2, s1[i]);
                    if (MODE == 2) { if (d0 > 128.f) s0[i] = -1e30f; if (d1 > 128.f) s1[i] = -1e30f; }
                }
            }
        }
        float mx = fmaxf(s0[0], s1[0]);
#pragma unroll
        for (int i = 1; i < 16; ++i) mx = fmaxf(fmaxf(mx, s0[i]), s1[i]);
        mx += Aoff;
        mx = fmaxf(mx, xhalf(mx));
        const float mnew = fmaxf(m, mx);
        if (__builtin_amdgcn_ballot_w64(mnew > m) != 0ull) {
            const float alpha = __builtin_amdgcn_exp2f(m - mnew);
            lsum *= alpha;
#pragma unroll
            for (int d = 0; d < DV / 32; ++d) o[d] = o[d] * alpha;
        }
        m = mnew;
        const float mm = mnew - Aoff;
        float rs = 0.f;
#pragma unroll
        for (int i = 0; i < 16; ++i) { s0[i] = __builtin_amdgcn_exp2f(s0[i] - mm); s1[i] = __builtin_amdgcn_exp2f(s1[i] - mm); rs += s0[i] + s1[i]; }
        lsum += rs;
        bf16x8 pf[4];
#pragma unroll
        for (int s2 = 0; s2 < 2; ++s2) {
            u32x4 a, b;
            a.x = pk2(s0[8 * s2 + 0], s0[8 * s2 + 1]); a.y = pk2(s0[8 * s2 + 2], s0[8 * s2 + 3]); a.z = pk2(s0[8 * s2 + 4], s0[8 * s2 + 5]); a.w = pk2(s0[8 * s2 + 6], s0[8 * s2 + 7]);
            b.x = pk2(s1[8 * s2 + 0], s1[8 * s2 + 1]); b.y = pk2(s1[8 * s2 + 2], s1[8 * s2 + 3]); b.z = pk2(s1[8 * s2 + 4], s1[8 * s2 + 5]); b.w = pk2(s1[8 * s2 + 6], s1[8 * s2 + 7]);
            pf[s2] = __builtin_bit_cast(bf16x8, a); pf[2 + s2] = __builtin_bit_cast(bf16x8, b);
        }
        LDS_WAIT0();
        if (DQK == 64) {
#pragma unroll
            for (int ks = 0; ks < KH; ++ks) { const unsigned ka = sna + kad[ks]; LDS_RD128(kf1[ks], ka, 8192); } }
        { const unsigned alo = sba + vad[0][0], ahi = sba + vad[0][1];
#pragma unroll
          for (int kk = 0; kk < 4; ++kk) { LDS_RDTR(va_lo[kk], alo, kk * 4096); LDS_RDTR(va_hi[kk], ahi, kk * 4096); } }
        __builtin_amdgcn_sched_barrier(0);
        f32x16 n0, n1;
#pragma unroll
        for (int i = 0; i < 16; ++i) { n0[i] = 0.f; n1[i] = 0.f; }
#pragma unroll
        for (int g = 0; g < DQK / 64; ++g) {
            if (DQK != 64) {
#pragma unroll
                for (int ks = 0; ks < KH; ++ks) { const unsigned ka = sna + kad[g * KH + ks]; LDS_RD128(kf0[ks], ka, 0); LDS_RD128(kf1[ks], ka, 8192); }
                LDS_WAIT0(); }
#pragma unroll
            for (int ks = 0; ks < KH; ++ks) n0 = __builtin_amdgcn_mfma_f32_32x32x16_bf16(kf0[ks], qf[g * KH + ks], n0, 0, 0, 0);
            if (DQK == 64) LDS_WAIT0();
#pragma unroll
            for (int ks = 0; ks < KH; ++ks) n1 = __builtin_amdgcn_mfma_f32_32x32x16_bf16(kf1[ks], qf[g * KH + ks], n1, 0, 0, 0);
        }
#define PV_BLOCK(d, lo, hi) do { _Pragma("unroll") for (int kk = 0; kk < 4; ++kk) { const bf16x8 vf = {lo[kk][0], lo[kk][1], lo[kk][2], lo[kk][3], hi[kk][0], hi[kk][1], hi[kk][2], hi[kk][3]}; \
            o[d] = __builtin_amdgcn_mfma_f32_32x32x16_bf16(vf, pf[kk], o[d], 0, 0, 0); } } while (0)
#define V_ISSUE(d, lo, hi) do { const unsigned alo_ = sba + vad[d][0], ahi_ = sba + vad[d][1]; _Pragma("unroll") for (int kk = 0; kk < 4; ++kk) { LDS_RDTR(lo[kk], alo_, kk * 4096); LDS_RDTR(hi[kk], ahi_, kk * 4096); } } while (0)
        LDS_WAIT0();
        V_ISSUE(1, vb_lo, vb_hi); __builtin_amdgcn_sched_barrier(0);
        PV_BLOCK(0, va_lo, va_hi);
        LDS_WAIT0();
        V_ISSUE(2, va_lo, va_hi); __builtin_amdgcn_sched_barrier(0);
        PV_BLOCK(1, vb_lo, vb_hi);
        LDS_WAIT0();
        V_ISSUE(3, vb_lo, vb_hi); __builtin_amdgcn_sched_barrier(0);
        PV_BLOCK(2, va_lo, va_hi);
        LDS_WAIT0();
        PV_BLOCK(3, vb_lo, vb_hi);
#undef PV_BLOCK
#undef V_ISSUE
        s0 = n0; s1 = n1;
        if (t + 3 < ntiles) asm volatile("s_waitcnt vmcnt(4)" ::: "memory"); else asm volatile("s_waitcnt vmcnt(0)" ::: "memory");
        __builtin_amdgcn_s_barrier();
    }
#undef LDS_RD128
#undef LDS_RDTR
#undef LDS_WAIT0
#undef ATT_DMA
}
template <int DV> __device__ __forceinline__ void store_o(const f32x16 (&o)[DV / 32], float sc, bf16_t* orow, int h) {
#pragma unroll
    for (int d = 0; d < DV / 32; ++d)
#pragma unroll
        for (int g4 = 0; g4 < 4; ++g4) { u32x2 w; w.x = pk2(o[d][4 * g4] * sc, o[d][4 * g4 + 1] * sc); w.y = pk2(o[d][4 * g4 + 2] * sc, o[d][4 * g4 + 3] * sc);
            *(GAS u32x2*)((GAS bf16_t*)orow + 32 * d + 8 * g4 + 4 * h) = w; }
}

__device__ __forceinline__ void win_unit(Frame& F, const Params& p, int l, int u) {
    REFRAME(F);
    const bf16_t* Z = (const bf16_t*)(p.ws + WS_Z); bf16_t* MIX = (bf16_t*)(p.ws + WS_MIX);
    const int b = u >> 5, kvh = (u >> 4) & 1, nb = u & 15, r = F.lane & 31, h = F.lane >> 5;
    const int g = F.wave >> 2, hq = kvh * 2 + g, qpos = nb * 128 + (F.wave & 3) * 32 + r;
    const size_t tok = (size_t)b * SEQ + qpos;
    bf16x8 qf[4]; load_q<64>(qf, Z + tok * ZP + hq * 64, h, 0.125f * LOG2E);
    const int first = (2 * nb - 2 < 0) ? 0 : 2 * nb - 2, lastx = (2 * nb + 4 > 32) ? 32 : 2 * nb + 4, nt = lastx - first;
    const float slope = exp2f(-(float)(2 * hq + 1));
    float m = p.in[4][l * 4 + hq] * LOG2E, ls = (h == 0) ? 1.f : 0.f;
    f32x16 o[2];
#pragma unroll
    for (int d = 0; d < 2; ++d)
#pragma unroll
        for (int i = 0; i < 16; ++i) o[d][i] = 0.f;
    const bf16_t* Kg = Z + ((size_t)b * SEQ + first * 64) * ZP + 256 + kvh * 64;
    attn_loop<64, 64, 64, 2>(F.lds, Kg, ZP, Kg + 128, ZP, nt, qf, 0, -slope * LOG2E, qpos - first * 64, m, ls, o);
    const float lt = ls + xhalf(ls);
    store_o<64>(o, 1.f / lt, MIX + tok * DM + hq * 64, h);
}
__device__ __forceinline__ void diff_unit(Frame& F, const Params& p, int l, int u) {
    REFRAME(F);
    const bf16_t* Z = (const bf16_t*)(p.ws + WS_Z); bf16_t* MIX = (bf16_t*)(p.ws + WS_MIX);
    const int b = u >> 6, hh = (u >> 4) & 3, qb = u & 15, r = F.lane & 31, h = F.lane >> 5;
    const int c = F.wave >> 2, qpos = qb * 128 + (F.wave & 3) * 32 + r;
    const size_t tok = (size_t)b * SEQ + qpos;
    float lam, lam_init;
    {
        const float a1 = wave_sum(p.in[5][l * 64 + F.lane] * p.in[6][l * 64 + F.lane]), a2 = wave_sum(p.in[7][l * 64 + F.lane] * p.in[8][l * 64 + F.lane]);
        lam_init = 0.8f - 0.6f * expf(-0.3f * (float)l);
        lam = expf(a1) - expf(a2) + lam_init;
    }
    bf16x8 qf[4]; load_q<64>(qf, Z + tok * ZP + 512 + hh * 128 + c * 64, h, 0.125f * LOG2E);
    const float slope = exp2f(-(float)(2 * hh + 2));
    float m = -1e30f, ls = 0.f;
    f32x16 o[4];
#pragma unroll
    for (int d = 0; d < 4; ++d)
#pragma unroll
        for (int i = 0; i < 16; ++i) o[d][i] = 0.f;
    const bf16_t* Kg = (const bf16_t*)(p.ws + WS_KD2) + (size_t)(b * 4 + hh) * 2048 * 128;
    attn_loop_dma<64, 1, 128, 8388608>(F.lds, F.wave, Kg, 32, qf, c * 64, -slope * LOG2E, qpos, m, ls, o);
    const float inv = 1.f / (ls + xhalf(ls));
    LAS float* comb = (LAS float*)F.lds + (size_t)(F.wave & 3) * 64 * 64 + F.lane;
    if (c == 1) {
#pragma unroll
        for (int d = 0; d < 4; ++d)
#pragma unroll
            for (int i = 0; i < 16; ++i) comb[(d * 16 + i) * 64] = o[d][i] * inv;
    }
    __syncthreads();
    if (c == 0) {
        float ss = 0.f;
#pragma unroll
        for (int d = 0; d < 4; ++d)
#pragma unroll
            for (int i = 0; i < 16; ++i) { const float a = o[d][i] * inv - lam * comb[(d * 16 + i) * 64]; o[d][i] = a; ss += a * a; }
        ss += xhalf(ss);
        const float rn = rsqrtf(ss * (1.f / 128.f) + 1e-6f) * (1.f - lam_init);
        const float* sg = p.in[9] + l * 128;
        bf16_t* orow = MIX + tok * DM + 256 + hh * 128;
        f32x4 ggv[4][4];
#pragma unroll
        for (int d = 0; d < 4; ++d)
#pragma unroll
            for (int g4 = 0; g4 < 4; ++g4) ggv[d][g4] = *(const GAS f32x4*)((const GAS float*)sg + 32 * d + 8 * g4 + 4 * h);
#pragma unroll
        for (int d = 0; d < 4; ++d)
#pragma unroll
            for (int g4 = 0; g4 < 4; ++g4) { const int dv = 32 * d + 8 * g4 + 4 * h; const f32x4 gg = ggv[d][g4];
                u32x2 w; w.x = pk2(o[d][4 * g4] * rn * gg[0], o[d][4 * g4 + 1] * rn * gg[1]); w.y = pk2(o[d][4 * g4 + 2] * rn * gg[2], o[d][4 * g4 + 3] * rn * gg[3]);
                *(GAS u32x2*)((GAS bf16_t*)orow + dv) = w; }
    }
    __syncthreads();
}
__device__ __forceinline__ void cross_unit(Frame& F, const Params& p, int u) {
    REFRAME(F);
    const bf16_t* Q = (const bf16_t*)(p.ws + WS_Q); const bf16_t* KV = (const bf16_t*)(p.ws + WS_KV); bf16_t* O = (bf16_t*)(p.ws + WS_O);
    const int b = u >> 5, hd = (u >> 3) & 3, qb = u & 7, r = F.lane & 31, h = F.lane >> 5;
    const size_t tok = (size_t)b * SEQ + qb * 256 + F.wave * 32 + r;
    bf16x8 qf[8]; load_q<128>(qf, Q + tok * XW + hd * 128, h, 0.08838834764831845f * LOG2E);
    float m = -1e30f, ls = 0.f;
    f32x16 o[4];
#pragma unroll
    for (int d = 0; d < 4; ++d)
#pragma unroll
        for (int i = 0; i < 16; ++i) o[d][i] = 0.f;
    const bf16_t* Kg = KV + ((size_t)b * NMEM) * 1024 + hd * 128;
    attn_loop_dma<128, 0, 1024, 512>(F.lds, F.wave, Kg, 4, qf, 0, 0.f, 0, m, ls, o);
    const float lt = ls + xhalf(ls);
    store_o<128>(o, 1.f / lt, O + tok * XW + hd * 128, h);
}

constexpr int CF_STR = 772, PREP_AW = 32 * CF_STR * 4, PREP_AA = PREP_AW + 32 * 72 * 2, PREP_AG = PREP_AA + 32 * 72 * 2;
__device__ __forceinline__ void prep_unit(Frame& F, const Params& p, int l, const bf16_t* wb, int u) {
    REFRAME(F);
    const bf16_t* ZC = (const bf16_t*)(p.ws + WS_ZC);
    const int t0 = u * 32, b = t0 / SEQ;
    LAS float* CF = (LAS float*)F.lds; LAS bf16_t* AW = (LAS bf16_t*)(F.lds + PREP_AW); LAS bf16_t* AA = (LAS bf16_t*)(F.lds + PREP_AA); LAS bf16_t* AG = (LAS bf16_t*)(F.lds + PREP_AG);
    const float* conv = p.in[10] + (size_t)l * 3 * 1024;
    LAS float* PAR = (LAS float*)(F.lds + PREP_AG + 32 * 136 * 2);
    if (F.tid < 448) { const int i = F.tid; const GAS f32x4* src;
        if (i < 64) src = (const GAS f32x4*)((const GAS float*)p.in[16] + l * 256) + i;
        else if (i < 128) src = (const GAS f32x4*)((const GAS float*)p.in[17] + l * 256) + (i - 64);
        else if (i < 192) src = (const GAS f32x4*)((const GAS float*)p.in[18] + l * 256) + (i - 128);
        else if (i < 320) src = (const GAS f32x4*)((const GAS float*)p.in[11] + l * 512) + (i - 192);
        else src = (const GAS f32x4*)((const GAS float*)p.in[13] + l * 512) + (i - 320);
        ((LAS f32x4*)PAR)[i] = *src; }
#pragma unroll 4
    for (int i = 0; i < 8; ++i) {
        const int id = F.tid + i * 512, tk = id >> 7, ch = id & 127, tg = t0 + tk, tpos = tg - b * SEQ;
        const GAS bf16_t* zp = (const GAS bf16_t*)ZC + (size_t)tg * 1024 + ch * 8;
        const u32x4 zc = *(const GAS u32x4*)zp;
        u32x4 zl = {0u, 0u, 0u, 0u}, zr = {0u, 0u, 0u, 0u};
        if (tpos > 0) zl = *(const GAS u32x4*)(zp - 1024);
        if (tpos < SEQ - 1) zr = *(const GAS u32x4*)(zp + 1024);
        float v[8];
#pragma unroll
        for (int q = 0; q < 4; ++q) {
            const f32x2 c0 = *(const GAS f32x2*)((const GAS float*)conv + ch * 8 + 2 * q), c1 = *(const GAS f32x2*)((const GAS float*)conv + 1024 + ch * 8 + 2 * q), c2 = *(const GAS f32x2*)((const GAS float*)conv + 2048 + ch * 8 + 2 * q);
            v[2 * q] = bflo(zl[q]) * c0[0] + bflo(zc[q]) * c1[0] + bflo(zr[q]) * c2[0];
            v[2 * q + 1] = bfhi(zl[q]) * c0[1] + bfhi(zc[q]) * c1[1] + bfhi(zr[q]) * c2[1];
        }
        if (ch < 96) { *(LAS f32x4*)(CF + tk * CF_STR + ch * 8) = (f32x4){v[0], v[1], v[2], v[3]}; *(LAS f32x4*)(CF + tk * CF_STR + ch * 8 + 4) = (f32x4){v[4], v[5], v[6], v[7]}; }
        else {
            u32x4 w;
            if (ch < 104) {
#pragma unroll
                for (int q = 0; q < 8; ++q) v[q] = 1.f - 2.f * __builtin_amdgcn_rcpf(__expf(2.f * v[q]) + 1.f);
                w.x = pk2(v[0], v[1]); w.y = pk2(v[2], v[3]); w.z = pk2(v[4], v[5]); w.w = pk2(v[6], v[7]);
                *(LAS u32x4*)(AW + tk * 72 + (ch - 96) * 8) = w;
            } else if (ch < 112) {
                w.x = pk2(v[0], v[1]); w.y = pk2(v[2], v[3]); w.z = pk2(v[4], v[5]); w.w = pk2(v[6], v[7]);
                *(LAS u32x4*)(AA + tk * 72 + (ch - 104) * 8) = w;
            } else {
#pragma unroll
                for (int q = 0; q < 8; ++q) v[q] = sigmoidf_(v[q]);
                w.x = pk2(v[0], v[1]); w.y = pk2(v[2], v[3]); w.z = pk2(v[4], v[5]); w.w = pk2(v[6], v[7]);
                *(LAS u32x4*)(AG + tk * 136 + (ch - 112) * 8) = w;
            }
        }
    }
    __syncthreads();
    const int hh = F.wave & 3, dir = F.wave >> 2, tk = F.lane & 31, h2 = F.lane >> 5;
    const size_t tok = (size_t)t0 + tk;
    const GAS bf16_t* Wup = (const GAS bf16_t*)wb + WO_WUP + (size_t)(dir * 256 + hh * 64) * 64;
    const GAS bf16_t* Aup = (const GAS bf16_t*)wb + WO_AUP + (size_t)(dir * 256 + hh * 64) * 64;
    f32x16 aw[2], aa[2];
#pragma unroll
    for (int rb = 0; rb < 2; ++rb)
#pragma unroll
        for (int i = 0; i < 16; ++i) { aw[rb][i] = 0.f; aa[rb][i] = 0.f; }
#pragma unroll
    for (int ks = 0; ks < 4; ++ks) {
        const bf16x8 bw = *(const LAS bf16x8*)(AW + tk * 72 + 16 * ks + 8 * h2), ba = *(const LAS bf16x8*)(AA + tk * 72 + 16 * ks + 8 * h2);
#pragma unroll
        for (int rb = 0; rb < 2; ++rb) {
            const bf16x8 fw = *(const GAS bf16x8*)(Wup + (size_t)(rb * 32 + tk) * 64 + 16 * ks + 8 * h2), fa = *(const GAS bf16x8*)(Aup + (size_t)(rb * 32 + tk) * 64 + 16 * ks + 8 * h2);
            aw[rb] = __builtin_amdgcn_mfma_f32_32x32x16_bf16(fw, bw, aw[rb], 0, 0, 0);
            aa[rb] = __builtin_amdgcn_mfma_f32_32x32x16_bf16(fa, ba, aa[rb], 0, 0, 0);
        }
    }
    const LAS float* k_k = PAR + hh * 64; const LAS float* k_a = PAR + 256 + hh * 64; const LAS float* r_k = PAR + 512 + hh * 64;
    const LAS float* w0 = PAR + 768 + dir * 256 + hh * 64; const LAS float* a0 = PAR + 1280 + dir * 256 + hh * 64;
    float ssq = 0.f;
#pragma unroll
    for (int rb = 0; rb < 2; ++rb)
#pragma unroll
        for (int g4 = 0; g4 < 4; ++g4) { const int c0 = rb * 32 + 8 * g4 + 4 * h2;
            const f32x4 kv = *(const LAS f32x4*)(CF + tk * CF_STR + 256 + hh * 64 + c0), kkw = *(const LAS f32x4*)(k_k + c0);
            const f32x4 q = kv * kkw; ssq += (q[0] * q[0] + q[1] * q[1]) + (q[2] * q[2] + q[3] * q[3]); }
    ssq += xhalf(ssq);
    const float kinv = 1.f / fmaxf(sqrtf(ssq), 1e-12f);
    float bon = 0.f;
    GAS bf16_t* OM = (GAS bf16_t*)(p.ws + WS_OM) + ((size_t)dir * MTOK + tok) * 256 + hh * 64;
    GAS bf16_t* KA = (GAS bf16_t*)(p.ws + WS_KA) + ((size_t)dir * MTOK + tok) * 256 + hh * 64;
    GAS bf16_t* KD = (GAS bf16_t*)(p.ws + WS_KD) + ((size_t)dir * MTOK + tok) * 256 + hh * 64;
    GAS bf16_t* KK = (GAS bf16_t*)(p.ws + WS_KK) + tok * 256 + hh * 64;
    GAS bf16_t* VV = (GAS bf16_t*)(p.ws + WS_V) + tok * 256 + hh * 64;
    GAS bf16_t* RR = (GAS bf16_t*)(p.ws + WS_R) + tok * 256 + hh * 64;
#pragma unroll
    for (int rb = 0; rb < 2; ++rb)
#pragma unroll
        for (int g4 = 0; g4 < 4; ++g4) { const int c0 = rb * 32 + 8 * g4 + 4 * h2;
            const f32x4 kv = *(const LAS f32x4*)(CF + tk * CF_STR + 256 + hh * 64 + c0), rv = *(const LAS f32x4*)(CF + tk * CF_STR + hh * 64 + c0);
            const f32x4 kkw = *(const LAS f32x4*)(k_k + c0), kaw = *(const LAS f32x4*)(k_a + c0), rkw = *(const LAS f32x4*)(r_k + c0), w0v = *(const LAS f32x4*)(w0 + c0), a0v = *(const LAS f32x4*)(a0 + c0);
            float om[4], ka[4], kd[4], kk[4];
#pragma unroll
            for (int j = 0; j < 4; ++j) {
                const float wp = aw[rb][4 * g4 + j] + w0v[j], ap = aa[rb][4 * g4 + j] + a0v[j];
                om[j] = 1.f - __expf(-0.6065306597126334f * sigmoidf_(wp));
                const float a = sigmoidf_(ap);
                kk[j] = kv[j] * kkw[j] * kinv; ka[j] = kk[j] * a; kd[j] = kv[j] * (1.f + (a - 1.f) * kaw[j]);
                bon += rv[j] * kd[j] * rkw[j];
            }
            u32x2 w; w.x = pk2(om[0], om[1]); w.y = pk2(om[2], om[3]); *(GAS u32x2*)(OM + c0) = w;
            w.x = pk2(ka[0], ka[1]); w.y = pk2(ka[2], ka[3]); *(GAS u32x2*)(KA + c0) = w;
            w.x = pk2(kd[0], kd[1]); w.y = pk2(kd[2], kd[3]); *(GAS u32x2*)(KD + c0) = w;
            if (dir == 0) {
                const f32x4 vv = *(const LAS f32x4*)(CF + tk * CF_STR + 512 + hh * 64 + c0);
                w.x = pk2(kk[0], kk[1]); w.y = pk2(kk[2], kk[3]); *(GAS u32x2*)(KK + c0) = w;
                w.x = pk2(vv[0], vv[1]); w.y = pk2(vv[2], vv[3]); *(GAS u32x2*)(VV + c0) = w;
                w.x = pk2(rv[0], rv[1]); w.y = pk2(rv[2], rv[3]); *(GAS u32x2*)(RR + c0) = w;
            }
        }
    bon += xhalf(bon);
    if (h2 == 0) ((GAS float*)(p.ws + WS_BON))[((size_t)dir * MTOK + tok) * 4 + hh] = bon;
    {
        const GAS bf16_t* Gup = (const GAS bf16_t*)wb + WO_GUP + (size_t)(F.wave * 32 + tk) * 128;
        f32x16 ag;
#pragma unroll
        for (int i = 0; i < 16; ++i) ag[i] = 0.f;
#pragma unroll
        for (int ks = 0; ks < 8; ++ks) {
            const bf16x8 bg = *(const LAS bf16x8*)(AG + tk * 136 + 16 * ks + 8 * h2), fg = *(const GAS bf16x8*)(Gup + 16 * ks + 8 * h2);
            ag = __builtin_amdgcn_mfma_f32_32x32x16_bf16(fg, bg, ag, 0, 0, 0);
        }
        GAS bf16_t* GT = (GAS bf16_t*)(p.ws + WS_GATE) + tok * 256 + F.wave * 32;
#pragma unroll
        for (int g4 = 0; g4 < 4; ++g4) { u32x2 w; w.x = pk2(ag[4 * g4], ag[4 * g4 + 1]); w.y = pk2(ag[4 * g4 + 2], ag[4 * g4 + 3]); *(GAS u32x2*)(GT + 8 * g4 + 4 * h2) = w; }
    }
    __syncthreads();
}

#define CBAR() asm volatile("" ::: "memory")
#define LROW(M, i, r) do { const LAS f32x4* _q = (const LAS f32x4*)((M) + (i) * 16); const f32x4 _a = _q[0], _b = _q[1], _c = _q[2], _d = _q[3]; \
        r[0] = _a[0]; r[1] = _a[1]; r[2] = _a[2]; r[3] = _a[3]; r[4] = _b[0]; r[5] = _b[1]; r[6] = _b[2]; r[7] = _b[3]; \
        r[8] = _c[0]; r[9] = _c[1]; r[10] = _c[2]; r[11] = _c[3]; r[12] = _d[0]; r[13] = _d[1]; r[14] = _d[2]; r[15] = _d[3]; } while (0)
template <int DIR> __device__ __forceinline__ void chunkprep_wave(Frame& F, const Params& p, int task) {
    const int dbh = task >> 7, ct = task & 127, b = (dbh >> 2) & 7, hh = dbh & 3, ch = F.lane, r32 = F.lane & 31, h = F.lane >> 5;
    LAS unsigned char* wl = F.lds + F.wave * 16384;
    LAS bf16_t* X = (LAS bf16_t*)wl;
    LAS bf16_t* Yt = (LAS bf16_t*)(wl + 4608);
    LAS float* MTt = (LAS float*)(wl + 9216);
    LAS float* MBt = MTt + 256;
    LAS float* MC = MTt + 512; LAS float* MD = MTt + 768; LAS float* MT = MTt + 1024; LAS float* MA = MTt + 1280;
    constexpr int step = DIR ? -256 : 256;
    typedef const __attribute__((address_space(1))) bf16_t* gbf;
    const size_t ou = ((size_t)b * SEQ + ct * 16 + (DIR ? 15 : 0)) * 256 + hh * 64;
    const gbf OM = (gbf)(p.ws + WS_OM) + (size_t)DIR * MTOK * 256 + ou + ch; const gbf KA = (gbf)(p.ws + WS_KA) + (size_t)DIR * MTOK * 256 + ou + ch;
    const gbf KD = (gbf)(p.ws + WS_KD) + (size_t)DIR * MTOK * 256 + ou + ch; const gbf KK = (gbf)(p.ws + WS_KK) + ou + ch;
    const gbf RR = (gbf)(p.ws + WS_R) + ou + ch; const gbf VV = (gbf)(p.ws + WS_V) + ou + ch;
    float pc = 1.f;
    float qt[16], rt[16], at[16], kt[16], vv[16];
    {
        unsigned short rw[16], rk[16], ra_[16], rd[16], rr_[16], rv[16];
#pragma unroll
        for (int i = 0; i < 16; ++i) { rw[i] = OM[i * step]; rk[i] = KK[i * step]; ra_[i] = KA[i * step]; rd[i] = KD[i * step]; rr_[i] = RR[i * step]; rv[i] = VV[i * step]; }
#pragma unroll
        for (int i = 0; i < 16; ++i) {
            const float w = 1.f - bf2f(rw[i]);
            qt[i] = bf2f(rk[i]) * pc; pc *= w; const float ip = __builtin_amdgcn_rcpf(pc);
            rt[i] = bf2f(rr_[i]) * pc; at[i] = bf2f(ra_[i]) * ip; kt[i] = bf2f(rd[i]) * ip; vv[i] = bf2f(rv[i]);
            X[i * 72 + ch] = (bf16_t)(pk2(qt[i], 0.f) & 0xffffu); X[(16 + i) * 72 + ch] = (bf16_t)(pk2(rt[i], 0.f) & 0xffffu);
            Yt[i * 72 + ch] = (bf16_t)(pk2(at[i], 0.f) & 0xffffu); Yt[(16 + i) * 72 + ch] = (bf16_t)(pk2(kt[i], 0.f) & 0xffffu);
        }
    }
    const float p15 = pc;
    asm volatile("s_waitcnt lgkmcnt(0)" ::: "memory");
    {
        f32x16 g;
#pragma unroll
        for (int i = 0; i < 16; ++i) g[i] = 0.f;
#pragma unroll
        for (int ks = 0; ks < 4; ++ks) {
            const bf16x8 a = *(const LAS bf16x8*)(X + r32 * 72 + 16 * ks + 8 * h), bb = *(const LAS bf16x8*)(Yt + r32 * 72 + 16 * ks + 8 * h);
            g = __builtin_amdgcn_mfma_f32_32x32x16_bf16(a, bb, g, 0, 0, 0);
        }
        const int sidx = r32 & 15;
#pragma unroll
        for (int reg = 0; reg < 8; ++reg) { const int i = (reg & 3) + 8 * (reg >> 2) + 4 * h;
            const float lo = (sidx < i) ? g[reg] : 0.f, hi2 = (sidx <= i) ? g[8 + reg] : 0.f;
            if (r32 < 16) { MA[i * 16 + sidx] = lo; MD[i * 16 + sidx] = hi2; } else { MBt[sidx * 16 + i] = lo; MC[i * 16 + sidx] = hi2; } }
    }
    asm volatile("s_waitcnt lgkmcnt(0)" ::: "memory");
    {
        const int c = F.lane & 15; float Tc[16];
#pragma unroll
        for (int i = 0; i < 16; ++i) { float acc = (i == c) ? 1.f : 0.f; float ra[16]; LROW(MA, i, ra);
#pragma unroll
            for (int s2 = 0; s2 < i; ++s2) acc -= ra[s2] * Tc[s2];
            Tc[i] = acc; MT[i * 16 + c] = acc; MTt[c * 16 + i] = acc; CBAR(); }
    }
    asm volatile("s_waitcnt lgkmcnt(0)" ::: "memory");
    float Qh[16], W2[16];
    {
        float BV[16];
#pragma unroll
        for (int i = 0; i < 16; ++i) { Qh[i] = 0.f; BV[i] = 0.f; }
#pragma unroll
        for (int s2 = 0; s2 < 16; ++s2) {
            float ct_[16], cb_[16]; LROW(MTt, s2, ct_); LROW(MBt, s2, cb_);
#pragma unroll
            for (int i = s2; i < 16; ++i) { Qh[i] += ct_[i] * qt[s2]; if (i > s2) BV[i] += cb_[i] * vv[s2]; }
            CBAR();
        }
#pragma unroll
        for (int i = 0; i < 16; ++i) { float aw = 0.f; float rt_[16]; LROW(MT, i, rt_);
#pragma unroll
            for (int s2 = 0; s2 <= i; ++s2) aw += rt_[s2] * BV[s2];
            W2[i] = aw; CBAR(); }
    }
    LAS bf16_t* ST = (LAS bf16_t*)wl;
    {
        const int ks = ch >> 4, w16 = ch & 15, jq = (w16 >> 3) * 4 + (w16 & 3), hq = (w16 >> 2) & 1;
        LAS bf16_t* qrp = ST + (ks * 64 + hq * 32) * 8 + jq;
        LAS bf16_t* wyp = ST + 2048 + ((ch >> 5) * 64 + r32) * 16;
#pragma unroll
        for (int i = 0; i < 16; ++i) {
            float ar = rt[i], ay = 0.f; float rd_[16], rc_[16]; LROW(MD, i, rd_); LROW(MC, i, rc_);
#pragma unroll
            for (int s2 = 0; s2 <= i; ++s2) { ar -= rd_[s2] * Qh[s2]; ay += rc_[s2] * vv[s2] - rd_[s2] * W2[s2]; }
            qrp[i * 8] = (bf16_t)(pk2(Qh[i], 0.f) & 0xffffu); qrp[(16 + i) * 8] = (bf16_t)(pk2(ar, 0.f) & 0xffffu);
            wyp[512 * ((i >> 2) & 1) + (i & 3) + 4 * (i >> 3)] = (bf16_t)(pk2(W2[i], 0.f) & 0xffffu);
            wyp[512 * ((i >> 2) & 1) + (i & 3) + 4 * ((16 + i) >> 3)] = (bf16_t)(pk2(ay, 0.f) & 0xffffu);
            CBAR(); }
    }
    asm volatile("s_waitcnt lgkmcnt(0)" ::: "memory");
    {
        GAS u32x4* gq = (GAS u32x4*)((GAS bf16_t*)(p.ws + WS_FQR) + (size_t)task * 2048); GAS u32x4* gw = (GAS u32x4*)((GAS bf16_t*)(p.ws + WS_FWY) + (size_t)task * 2048);
        u32x4 tq[4], tw[4];
#pragma unroll
        for (int q = 0; q < 4; ++q) { tq[q] = *(const LAS u32x4*)(wl + (F.lane + 64 * q) * 16); tw[q] = *(const LAS u32x4*)(wl + 4096 + (F.lane + 64 * q) * 16); }
#pragma unroll
        for (int q = 0; q < 4; ++q) { gq[F.lane + 64 * q] = tq[q]; gw[F.lane + 64 * q] = tw[q]; }
    }
    asm volatile("s_waitcnt lgkmcnt(0)" ::: "memory");
    {
        LAS bf16_t* nap = ST + ((ch >> 5) * 64 + r32) * 8; LAS bf16_t* khp = nap + 1024;
#pragma unroll
        for (int s2 = 0; s2 < 16; ++s2) {
            const int off = 256 * ((s2 >> 2) & 1) + (s2 >> 3) * 4 + (s2 & 3);
            nap[off] = (bf16_t)(pk2(-at[s2] * p15, 0.f) & 0xffffu); khp[off] = (bf16_t)(pk2(kt[s2] * p15, 0.f) & 0xffffu); }
        asm volatile("s_waitcnt lgkmcnt(0)" ::: "memory");
        GAS u32x4* gn = (GAS u32x4*)((GAS bf16_t*)(p.ws + WS_FNA) + (size_t)task * 1024); GAS u32x4* gk = (GAS u32x4*)((GAS bf16_t*)(p.ws + WS_FKH) + (size_t)task * 1024);
        u32x4 tn[2], tk2[2];
#pragma unroll
        for (int q = 0; q < 2; ++q) { tn[q] = *(const LAS u32x4*)(wl + (F.lane + 64 * q) * 16); tk2[q] = *(const LAS u32x4*)(wl + 2048 + (F.lane + 64 * q) * 16); }
#pragma unroll
        for (int q = 0; q < 2; ++q) { gn[F.lane + 64 * q] = tn[q]; gk[F.lane + 64 * q] = tk2[q]; }
        ((GAS float*)(p.ws + WS_FP15))[(size_t)task * 64 + ch] = p15;
    }
    asm volatile("s_waitcnt lgkmcnt(0)" ::: "memory");
}
constexpr int PB_SLOT = 15360, PB_NSLOT = 4, PB_QR = 0, PB_WY = 4096, PB_NA = 8192, PB_KH = 10240, PB_P15 = 12288, PB_V = 13312;
__device__ __forceinline__ unsigned lds_ld_u32(unsigned addr) { unsigned v; asm volatile("ds_read_b32 %0, %1\n\ts_waitcnt lgkmcnt(0)" : "=v"(v) : "v"(addr) : "memory"); return v; }
__device__ __forceinline__ void lds_st_u32(unsigned addr, unsigned v) { asm volatile("ds_write_b32 %0, %1" :: "v"(addr), "v"(v) : "memory"); }
__device__ __forceinline__ void pb_dma(const Params& p, int dbh, int ct, int lane, LAS unsigned char* slot) {
    const size_t task = (size_t)dbh * 128 + ct; const int b = (dbh >> 2) & 7, hh = dbh & 3;
    const unsigned char* q = (const unsigned char*)((const bf16_t*)(p.ws + WS_FQR) + task * 2048) + lane * 16; const unsigned char* w = (const unsigned char*)((const bf16_t*)(p.ws + WS_FWY) + task * 2048) + lane * 16;
    const unsigned char* na = (const unsigned char*)((const bf16_t*)(p.ws + WS_FNA) + task * 1024) + lane * 16; const unsigned char* kh = (const unsigned char*)((const bf16_t*)(p.ws + WS_FKH) + task * 1024) + lane * 16;
#pragma unroll
    for (int i = 0; i < 4; ++i) {
        __builtin_amdgcn_global_load_lds((const unsigned*)(q + 1024 * i), (LAS unsigned*)(slot + PB_QR + 1024 * i), 16, 0, 0);
        __builtin_amdgcn_global_load_lds((const unsigned*)(w + 1024 * i), (LAS unsigned*)(slot + PB_WY + 1024 * i), 16, 0, 0); }
    __builtin_amdgcn_global_load_lds((const unsigned*)na, (LAS unsigned*)(slot + PB_NA), 16, 0, 0); __builtin_amdgcn_global_load_lds((const unsigned*)(na + 1024), (LAS unsigned*)(slot + PB_NA + 1024), 16, 0, 0);
    __builtin_amdgcn_global_load_lds((const unsigned*)kh, (LAS unsigned*)(slot + PB_KH), 16, 0, 0); __builtin_amdgcn_global_load_lds((const unsigned*)(kh + 1024), (LAS unsigned*)(slot + PB_KH + 1024), 16, 0, 0);
    __builtin_amdgcn_global_load_lds((const unsigned*)((const unsigned char*)((const float*)(p.ws + WS_FP15) + task * 64) + lane * 16), (LAS unsigned*)(slot + PB_P15), 16, 0, 0);
    const unsigned char* V = (const unsigned char*)((const bf16_t*)(p.ws + WS_V) + ((size_t)b * SEQ + ct * 16) * 256 + hh * 64) + (size_t)(lane >> 3) * 512 + (lane & 7) * 16;
    __builtin_amdgcn_global_load_lds((const unsigned*)V, (LAS unsigned*)(slot + PB_V), 16, 0, 0); __builtin_amdgcn_global_load_lds((const unsigned*)(V + 8 * 512), (LAS unsigned*)(slot + PB_V + 1024), 16, 0, 0);
}
__device__ __forceinline__ void phaseb_unit(Frame& F, const Params& p, int u) {
    const unsigned flag_base = (unsigned)(size_t)(F.lds + 131072 + 128);
    if (F.tid < 8) lds_st_u32(flag_base + 4 * F.tid, 0u);
    __syncthreads();
    const int pair = F.wave & 3;
    if (pair >= 2) return;
    const int dbh = u * 2 + pair, dir = dbh >> 5;
    LAS unsigned char* ring = F.lds + pair * (PB_NSLOT * PB_SLOT);
    const unsigned f_pub = flag_base + 8 * pair, f_con = f_pub + 4;
    if (F.wave >= 4) {
        for (int c = 0; c < 128; ++c) {
            while ((int)lds_ld_u32(f_con) < c - (PB_NSLOT - 1)) __builtin_amdgcn_s_sleep(1);
            pb_dma(p, dbh, dir ? 127 - c : c, F.lane, ring + (c & (PB_NSLOT - 1)) * PB_SLOT);
            if (c >= 3) { asm volatile("s_waitcnt vmcnt(45)" ::: "memory"); if (F.lane == 0) lds_st_u32(f_pub, (unsigned)(c - 2)); }
        }
        asm volatile("s_waitcnt vmcnt(30)" ::: "memory"); if (F.lane == 0) lds_st_u32(f_pub, 126u);
        asm volatile("s_waitcnt vmcnt(15)" ::: "memory"); if (F.lane == 0) lds_st_u32(f_pub, 127u);
        asm volatile("s_waitcnt vmcnt(0)" ::: "memory"); if (F.lane == 0) lds_st_u32(f_pub, 128u);
        return;
    }
    const int b = (dbh >> 2) & 7, hh = dbh & 3, r = F.lane & 31, h = F.lane >> 5;
    GAS bf16_t* Y = (GAS bf16_t*)(p.ws + WS_Y) + ((size_t)dir * MTOK + (size_t)b * SEQ) * 256 + hh * 64 + r;
    f32x16 accS[2][2];
#pragma unroll
    for (int rb = 0; rb < 2; ++rb)
#pragma unroll
        for (int cb = 0; cb < 2; ++cb)
#pragma unroll
            for (int i = 0; i < 16; ++i) accS[rb][cb][i] = 0.f;
    for (int cc = 0; cc < 128; ++cc) {
        const int ct = dir ? 127 - cc : cc;
        const LAS unsigned char* slot = ring + (cc & (PB_NSLOT - 1)) * PB_SLOT;
        bf16x8 sb[4][2];
#pragma unroll
        for (int rb = 0; rb < 2; ++rb)
#pragma unroll
            for (int s2 = 0; s2 < 2; ++s2)
#pragma unroll
                for (int cb = 0; cb < 2; ++cb) { const f32x16& a = accS[rb][cb]; u32x4 w;
                    w.x = pk2(a[8 * s2 + 0], a[8 * s2 + 1]); w.y = pk2(a[8 * s2 + 2], a[8 * s2 + 3]); w.z = pk2(a[8 * s2 + 4], a[8 * s2 + 5]); w.w = pk2(a[8 * s2 + 6], a[8 * s2 + 7]);
                    sb[2 * rb + s2][cb] = __builtin_bit_cast(bf16x8, w); }
        while ((int)lds_ld_u32(f_pub) < cc + 1) __builtin_amdgcn_s_sleep(1);
        asm volatile("" ::: "memory");
        f32x16 D[2];
#pragma unroll
        for (int cb = 0; cb < 2; ++cb) { const LAS u32x4* wp = (const LAS u32x4*)(slot + PB_WY + (cb * 64 + F.lane) * 32); const u32x4 w0 = wp[0], w1 = wp[1];
            D[cb][0] = bflo(w0.x); D[cb][1] = bfhi(w0.x); D[cb][2] = bflo(w0.y); D[cb][3] = bfhi(w0.y); D[cb][4] = bflo(w0.z); D[cb][5] = bfhi(w0.z); D[cb][6] = bflo(w0.w); D[cb][7] = bfhi(w0.w);
            D[cb][8] = bflo(w1.x); D[cb][9] = bfhi(w1.x); D[cb][10] = bflo(w1.y); D[cb][11] = bfhi(w1.y); D[cb][12] = bflo(w1.z); D[cb][13] = bfhi(w1.z); D[cb][14] = bflo(w1.w); D[cb][15] = bfhi(w1.w); }
#pragma unroll
        for (int ks = 0; ks < 4; ++ks) { const bf16x8 qa = *(const LAS bf16x8*)(slot + PB_QR + (ks * 64 + F.lane) * 16);
            D[0] = __builtin_amdgcn_mfma_f32_32x32x16_bf16(qa, sb[ks][0], D[0], 0, 0, 0);
            D[1] = __builtin_amdgcn_mfma_f32_32x32x16_bf16(qa, sb[ks][1], D[1], 0, 0, 0); }
#pragma unroll
        for (int rb = 0; rb < 2; ++rb)
#pragma unroll
            for (int g4 = 0; g4 < 4; ++g4) { const f32x4 pv = *(const LAS f32x4*)(slot + PB_P15 + (32 * rb + 8 * g4 + 4 * h) * 4);
#pragma unroll
                for (int cb = 0; cb < 2; ++cb)
#pragma unroll
                    for (int q = 0; q < 4; ++q) accS[rb][cb][4 * g4 + q] *= pv[q]; }
        bf16x8 ub[2], vb[2];
#pragma unroll
        for (int cb = 0; cb < 2; ++cb) {
            unsigned short vt[8];
#pragma unroll
            for (int j = 0; j < 8; ++j) { const int s2 = 8 * (j >> 2) + 4 * h + (j & 3); const int tau = dir ? 15 - s2 : s2;
                vt[j] = *(const LAS unsigned short*)(slot + PB_V + tau * 128 + (32 * cb + r) * 2);
                Y[(size_t)(ct * 16 + tau) * 256 + 32 * cb] = (bf16_t)(pk2(D[cb][8 + j], 0.f) & 0xffffu); }
            vb[cb] = (bf16x8){(short)vt[0], (short)vt[1], (short)vt[2], (short)vt[3], (short)vt[4], (short)vt[5], (short)vt[6], (short)vt[7]};
            u32x4 w; w.x = pk2(D[cb][0], D[cb][1]); w.y = pk2(D[cb][2], D[cb][3]); w.z = pk2(D[cb][4], D[cb][5]); w.w = pk2(D[cb][6], D[cb][7]);
            ub[cb] = __builtin_bit_cast(bf16x8, w);
        }
        bf16x8 na[2], kh[2];
#pragma unroll
        for (int rb = 0; rb < 2; ++rb) { na[rb] = *(const LAS bf16x8*)(slot + PB_NA + (rb * 64 + F.lane) * 16); kh[rb] = *(const LAS bf16x8*)(slot + PB_KH + (rb * 64 + F.lane) * 16); }
        asm volatile("s_waitcnt lgkmcnt(0)" ::: "memory");
        if (F.lane == 0) lds_st_u32(f_con, (unsigned)(cc + 1));
#pragma unroll
        for (int rb = 0; rb < 2; ++rb)
#pragma unroll
            for (int cb = 0; cb < 2; ++cb) {
                accS[rb][cb] = __builtin_amdgcn_mfma_f32_32x32x16_bf16(na[rb], ub[cb], accS[rb][cb], 0, 0, 0);
                accS[rb][cb] = __builtin_amdgcn_mfma_f32_32x32x16_bf16(kh[rb], vb[cb], accS[rb][cb], 0, 0, 0);
            }
    }
}

__device__ __forceinline__ void post_unit(Frame& F, const Params& p, int l, int u) {
    REFRAME(F);
    const bf16_t* Y0 = (const bf16_t*)(p.ws + WS_Y); const bf16_t* Y1 = Y0 + (size_t)MTOK * 256;
    const bf16_t* VV = (const bf16_t*)(p.ws + WS_V); const bf16_t* GT = (const bf16_t*)(p.ws + WS_GATE);
    const float* BON = (const float*)(p.ws + WS_BON); bf16_t* MIX = (bf16_t*)(p.ws + WS_MIX);
    const f32x4 lg = *(const f32x4*)(p.in[19] + l * 256 + 4 * F.lane), lb = *(const f32x4*)(p.in[20] + l * 256 + 4 * F.lane);
    for (int tok = u * 64 + F.wave * 8, te = tok + 8; tok < te; ++tok) {
        const u32x2 a = *(const GAS u32x2*)((const GAS bf16_t*)Y0 + (size_t)tok * 256 + 4 * F.lane), c = *(const GAS u32x2*)((const GAS bf16_t*)Y1 + (size_t)tok * 256 + 4 * F.lane);
        const u32x2 vv = *(const GAS u32x2*)((const GAS bf16_t*)VV + (size_t)tok * 256 + 4 * F.lane), gg = *(const GAS u32x2*)((const GAS bf16_t*)GT + (size_t)tok * 256 + 4 * F.lane);
        float y[4] = {bflo(a.x) + bflo(c.x), bfhi(a.x) + bfhi(c.x), bflo(a.y) + bflo(c.y), bfhi(a.y) + bfhi(c.y)};
        float s = (y[0] + y[1]) + (y[2] + y[3]);
#pragma unroll
        for (int o = 1; o < 16; o <<= 1) s += __shfl_xor(s, o);
        const float mu = s * (1.f / 64.f);
        float q = 0.f;
#pragma unroll
        for (int i = 0; i < 4; ++i) { y[i] -= mu; q += y[i] * y[i]; }
#pragma unroll
        for (int o = 1; o < 16; o <<= 1) q += __shfl_xor(q, o);
        const float rstd = rsqrtf(q * (1.f / 64.f) + 64e-5f);
        const int hh = F.lane >> 4;
        const float bon = ((const GAS float*)BON)[(size_t)tok * 4 + hh] + ((const GAS float*)BON)[((size_t)MTOK + tok) * 4 + hh];
        const float v4[4] = {bflo(vv.x), bfhi(vv.x), bflo(vv.y), bfhi(vv.y)}, g4[4] = {bflo(gg.x), bfhi(gg.x), bflo(gg.y), bfhi(gg.y)};
        float o4[4];
#pragma unroll
        for (int i = 0; i < 4; ++i) o4[i] = (y[i] * rstd * lg[i] + lb[i] + bon * v4[i]) * g4[i];
        u32x2 w; w.x = pk2(o4[0], o4[1]); w.y = pk2(o4[2], o4[3]);
        *(GAS u32x2*)((GAS bf16_t*)MIX + (size_t)tok * DM + 768 + 4 * F.lane) = w;
    }
}

__device__ __forceinline__ void prologue(Frame& F, const Params& p) {
    REFRAME(F);
    LAS float* scr = (LAS float*)(F.lds + F.wave * 16384);
    const int gw = F.bid * 8 + F.wave, NGW = F.G * 8;
    bf16_t* wb = (bf16_t*)(p.ws + WS_W);
    for (int it = gw; it < CV_TOTAL; it += NGW) { if (it < CV_A) cvt_item_a(p, 0, wb, scr, it, F.lane); else cvt_item_b(p, 0, wb, scr, it - CV_A, F.lane); }
    const float* x = p.in[0]; float* X = p.out; bf16_t* XB = (bf16_t*)(p.ws + WS_XB); float* rowss = (float*)(p.ws + WS_RP);
    for (int m = gw; m < MTOK; m += 2 * NGW) {
        const int m2 = m + NGW; const bool has2 = m2 < MTOK; const int mb = has2 ? m2 : m;
        const GAS f32x4* xra = (const GAS f32x4*)(x + (size_t)m * DM) + F.lane; const GAS f32x4* xrb = (const GAS f32x4*)(x + (size_t)mb * DM) + F.lane;
        f32x4 va[4], vb[4];
#pragma unroll
        for (int jj = 0; jj < 4; ++jj) { va[jj] = xra[64 * jj]; vb[jj] = xrb[64 * jj]; }
        float sa = 0.f, sb = 0.f;
#pragma unroll
        for (int jj = 0; jj < 4; ++jj) { sa += (va[jj][0] * va[jj][0] + va[jj][1] * va[jj][1]) + (va[jj][2] * va[jj][2] + va[jj][3] * va[jj][3]); sb += (vb[jj][0] * vb[jj][0] + vb[jj][1] * vb[jj][1]) + (vb[jj][2] * vb[jj][2] + vb[jj][3] * vb[jj][3]); }
        sa = wave_sum(sa); sb = wave_sum(sb);
        { GAS f32x4* xo = (GAS f32x4*)(X + (size_t)m * DM) + F.lane; GAS u32x2* bo = (GAS u32x2*)(XB + (size_t)m * DM) + F.lane;
#pragma unroll
          for (int jj = 0; jj < 4; ++jj) { xo[64 * jj] = va[jj]; u32x2 w; w.x = pk2(va[jj][0], va[jj][1]); w.y = pk2(va[jj][2], va[jj][3]); bo[64 * jj] = w; }
          if (F.lane < 16) ((GAS float*)rowss)[(size_t)m * 16 + F.lane] = (F.lane == 0) ? sa : 0.f; }
        if (has2) { GAS f32x4* xo = (GAS f32x4*)(X + (size_t)m2 * DM) + F.lane; GAS u32x2* bo = (GAS u32x2*)(XB + (size_t)m2 * DM) + F.lane;
#pragma unroll
          for (int jj = 0; jj < 4; ++jj) { xo[64 * jj] = vb[jj]; u32x2 w; w.x = pk2(vb[jj][0], vb[jj][1]); w.y = pk2(vb[jj][2], vb[jj][3]); bo[64 * jj] = w; }
          if (F.lane < 16) ((GAS float*)rowss)[(size_t)m2 * 16 + F.lane] = (F.lane == 0) ? sb : 0.f; }
    }
    const float* mem = p.in[1]; const float* gm = p.in[23]; bf16_t* MN = (bf16_t*)(p.ws + WS_MEMN);
    for (int m = gw; m < MMEM; m += NGW) {
        const f32x4* xr = (const f32x4*)(mem + (size_t)m * DM) + F.lane; u32x2* bo = (u32x2*)(MN + (size_t)m * DM) + F.lane;
        f32x4 v[4]; float s = 0.f;
#pragma unroll
        for (int jj = 0; jj < 4; ++jj) { v[jj] = xr[64 * jj]; s += (v[jj][0] * v[jj][0] + v[jj][1] * v[jj][1]) + (v[jj][2] * v[jj][2] + v[jj][3] * v[jj][3]); }
        const float rstd = rsqrtf(wave_sum(s) * (1.f / 1024.f) + 1e-6f);
#pragma unroll
        for (int jj = 0; jj < 4; ++jj) { const f32x4 g = *((const f32x4*)gm + F.lane + 64 * jj); const f32x4 t = v[jj] * rstd * g;
            u32x2 w; w.x = pk2(t[0], t[1]); w.y = pk2(t[2], t[3]); bo[64 * jj] = w; }
    }
}
__device__ __forceinline__ void final_norm(Frame& F, const Params& p) {
    REFRAME(F);
    const int gw = F.bid * 8 + F.wave, NGW = F.G * 8;
    const float* rowss = (const float*)(p.ws + WS_RP) + (size_t)12 * MTOK * 16; const GAS float* gf = (const GAS float*)p.in[30];
    f32x4 g[4];
#pragma unroll
    for (int jj = 0; jj < 4; ++jj) g[jj] = *((const GAS f32x4*)gf + F.lane + 64 * jj);
    for (int m = gw; m < MTOK; m += 2 * NGW) {
        const int m2 = m + NGW; const bool has2 = m2 < MTOK;
        GAS f32x4* xa = (GAS f32x4*)(p.out + (size_t)m * DM) + F.lane; GAS f32x4* xb = (GAS f32x4*)(p.out + (size_t)(has2 ? m2 : m) * DM) + F.lane;
        f32x4 va[4], vb[4];
#pragma unroll
        for (int jj = 0; jj < 4; ++jj) { va[jj] = xa[64 * jj]; vb[jj] = xb[64 * jj]; }
        const float ra = row_rstd(rowss, m), rb = row_rstd(rowss, has2 ? m2 : m);
#pragma unroll
        for (int jj = 0; jj < 4; ++jj) xa[64 * jj] = va[jj] * ra * g[jj];
        if (has2) {
#pragma unroll
            for (int jj = 0; jj < 4; ++jj) xb[64 * jj] = vb[jj] * rb * g[jj]; }
    }
}

#define XB_TMO      128
#define XB_XCNT(j)  (256  + 64 * (j))
#define XB_XSUB(j)  (1280 + 64 * (j))
#define XB_XGEN(j)  (2304 + 64 * (j))
#define XB_TOP      3328
#define XB_TOPGEN   3392
#define XB_SPIN_CAP (1u << 22)
constexpr int CW_BAR = 4096;
__device__ __forceinline__ unsigned xb_ld(unsigned* p)              { return __hip_atomic_load(p, __ATOMIC_RELAXED, __HIP_MEMORY_SCOPE_AGENT); }
__device__ __forceinline__ unsigned xb_add(unsigned* p, unsigned v) { return __hip_atomic_fetch_add(p, v, __ATOMIC_RELAXED, __HIP_MEMORY_SCOPE_AGENT); }
__device__ __forceinline__ unsigned xb_xcc_id() { return (unsigned)__builtin_amdgcn_s_getreg((3 << 11) | 20) & 0xFu; }
#define XB_SPIN(cond, bar) do { unsigned _sp = 0; while (cond) { __builtin_amdgcn_s_sleep(1); \
    if ((++_sp & 255u) == 0u) { if (xb_ld(&(bar)[XB_TMO])) break; if (_sp > XB_SPIN_CAP) { atomicAdd(&(bar)[XB_TMO], 1u); break; } } } } while (0)
__device__ __forceinline__ void xcd_barrier_complete(unsigned* bar, unsigned x, unsigned& nloc, unsigned& nx) {
    const unsigned G = gridDim.x;
    unsigned sum, cnt, mine, sp = 0u;
    for (;;) {
        sum = 0u; cnt = 0u; mine = 0u;
#pragma unroll
        for (unsigned j = 0; j < 16; ++j) { const unsigned c = xb_ld(&bar[XB_XCNT(j)]); sum += c; cnt += (c > 0u) ? 1u : 0u; mine = (j == x) ? c : mine; }
        if (sum == G) break;
        __builtin_amdgcn_s_sleep(1);
        if ((++sp & 255u) == 0u) { if (xb_ld(&bar[XB_TMO])) break; if (sp > XB_SPIN_CAP) { atomicAdd(&bar[XB_TMO], 1u); break; } }
    }
    nloc = mine > 0u ? mine : 1u; nx = cnt > 0u ? cnt : 1u;
}
__device__ __forceinline__ void gsync(volatile LAS unsigned* st) {
    unsigned* bar = (unsigned*)(make_params().ws + WS_CTL) + CW_BAR;
    asm volatile("s_waitcnt vmcnt(0)" ::: "memory");
    __syncthreads();
    if (threadIdx.x == 0) {
        const unsigned x = xb_xcc_id();
        __builtin_amdgcn_s_waitcnt(0);
        unsigned nloc = st[0], nx = st[1];
        if (nloc == 0u) { xcd_barrier_complete(bar, x, nloc, nx); st[0] = nloc; st[1] = nx; }
        const unsigned old = xb_add(&bar[XB_XSUB(x)], 1u);
        const unsigned gen = old / nloc;
        if (old + 1u == (gen + 1u) * nloc) {
            __builtin_amdgcn_fence(__ATOMIC_RELEASE, "agent");
            asm volatile("s_waitcnt vmcnt(0)" ::: "memory");
            const unsigned og = xb_add(&bar[XB_TOP], 1u);
            const unsigned tg = og / nx;
            if (og + 1u == (tg + 1u) * nx) xb_add(&bar[XB_TOPGEN], 1u);
            else XB_SPIN(xb_ld(&bar[XB_TOPGEN]) == tg, bar);
            __builtin_amdgcn_fence(__ATOMIC_ACQUIRE, "agent");
            xb_add(&bar[XB_XGEN(x)], 1u);
            asm volatile("s_waitcnt vmcnt(0)" ::: "memory");
        } else {
            XB_SPIN(xb_ld(&bar[XB_XGEN(x)]) == gen, bar);
            __builtin_amdgcn_fence(__ATOMIC_ACQUIRE, "agent");
            asm volatile("s_waitcnt vmcnt(0)" ::: "memory");
        }
    }
    __syncthreads();
}
__device__ __forceinline__ int rstd_table(LAS unsigned char* lds, const pg8::StaticOrder& S, const float* rowss, int tid) {
    pg8::Unit u0; int pm0 = -1;
    if (S.next(0, u0)) { pm0 = u0.pm; if (tid < 256) ((LAS float*)(lds + 131072 + 2048))[tid] = row_rstd(rowss, pm0 * 256 + tid); }
    __syncthreads();
    return pm0;
}
#ifdef TPROBE
#define STAMP(id) do { if (blockIdx.x == 0 && threadIdx.x == 0) { LAS unsigned long long* ts_ = (LAS unsigned long long*)(F.lds + 131072 + 64); const unsigned long long now_ = __builtin_amdgcn_s_memrealtime(); \
    const unsigned long long dt_ = now_ - ts_[0]; ts_[0] = now_; if ((TA_MASK >> (id)) & 1) ts_[1] += dt_; if ((TB_MASK >> (id)) & 1) ts_[2] += dt_; } } while (0)
#else
#define STAMP(id) do { } while (0)
#endif
#ifndef PH_MASK
#define PH_MASK 0xFFFF
#endif
#ifndef REP_MASK
#define REP_MASK 0
#endif
#define NREP(k) ((((REP_MASK) >> (k)) & 1) ? 2 : 1)
constexpr int NCP = 1024, NDIFF_A = 0, NPB = 32;
__global__ void __launch_bounds__(512, 2) fwd_megakernel(KArgs kargs_unused) {
    extern __shared__ __attribute__((aligned(16))) unsigned char lds_raw[];
    cg::grid_group grid = cg::this_grid();
    Frame F; F.lds = (LAS unsigned char*)lds_raw; F.tid = threadIdx.x; F.lane = F.tid & 63; F.wave = __builtin_amdgcn_readfirstlane(F.tid >> 6); F.G = gridDim.x; F.bid = blockIdx.x;
    LAS int* qslot = (LAS int*)(F.lds + 131072);
    volatile LAS unsigned* bst = (volatile LAS unsigned*)(F.lds + 131072 + 32);
    { unsigned* bar0 = (unsigned*)(make_params().ws + WS_CTL) + CW_BAR;
      if (threadIdx.x == 0) { bst[0] = 0u; bst[1] = 0u; (void)xb_add(bar0 + XB_XCNT(xb_xcc_id()), 1u); } }
    __syncthreads();
#define PHASE_VARS() const Params p = make_params(); unsigned* ctl = (unsigned*)(p.ws + WS_CTL); float* rowss = (float*)(p.ws + WS_RP); \
    bf16_t* XB = (bf16_t*)(p.ws + WS_XB); bf16_t* Z = (bf16_t*)(p.ws + WS_Z); bf16_t* MIX = (bf16_t*)(p.ws + WS_MIX); \
    bf16_t* wb = (bf16_t*)(p.ws + WS_W); int bid_ = F.bid, G_ = F.G; asm volatile("" : "+s"(bid_), "+s"(G_)); (void)bid_; (void)G_; (void)ctl; (void)rowss; (void)XB; (void)Z; (void)MIX; (void)wb

#ifdef TPROBE
    if (blockIdx.x == 0 && threadIdx.x == 0) { LAS unsigned long long* ts_ = (LAS unsigned long long*)(F.lds + 131072 + 64); ts_[0] = __builtin_amdgcn_s_memrealtime(); ts_[1] = 0; ts_[2] = 0; }
#endif
    if (PH_MASK & 1) { const Params p = make_params(); prologue(F, p); }
    grid.sync();
    STAMP(0);

    for (int l = 0; l < NL; ++l) {
        for (int rep = 0; rep < NREP(1); ++rep) {
        if (PH_MASK & 2) {
            PHASE_VARS();
            pg8::StaticOrder S; S.init(MTOK, INW, G_, bid_);
            const int pm0 = rstd_table(F.lds, S, rowss + (size_t)(3 * l) * MTOK * 16, F.tid);
            pg8::gemm_phase(F.lds, pg8::Gemm{XB, wb + WO_IN, MTOK, INW, DM}, S, pg8::EpiScaleBf16{Z, ZP, rowss + (size_t)(3 * l) * MTOK * 16, (bf16_t*)(p.ws + WS_ZC), 1024, 8, (bf16_t*)(p.ws + WS_KD2), (const LAS float*)(F.lds + 131072 + 2048), pm0});
        }
        gsync(bst); STAMP(1);
        }
        for (int rep = 0; rep < NREP(2); ++rep) {
        for (int u = F.bid; u < 768; u += F.G) {
            PHASE_VARS();
            if (u < 512) { if (PH_MASK & 4) prep_unit(F, p, l, wb, u); } else if (PH_MASK & 8) win_unit(F, p, l, u - 512);
        }
        gsync(bst); STAMP(2);
        }
        for (int rep = 0; rep < NREP(3); ++rep) {
        {
            PHASE_VARS();
            if (G_ == 256 && bid_ < 64) {
                if (PH_MASK & 32) diff_unit(F, p, l, (4 * (bid_ & 7) + 3) * 16 + 8 + (bid_ >> 3));
                { const int u = 960 + bid_; if (PH_MASK & 16) { REFRAME(F); chunkprep_wave<1>(F, p, u * 8 + F.wave); } }
            } else if (G_ == 256) {
                for (int k = 0; k < 5; ++k) { const int u = (bid_ - 64) + 192 * k;
                    if (PH_MASK & 16) { REFRAME(F); if (u >= NCP / 2) chunkprep_wave<1>(F, p, u * 8 + F.wave); else chunkprep_wave<0>(F, p, u * 8 + F.wave); } }
            } else {
                for (int u = bid_; u < NCP; u += G_) {
                    if (PH_MASK & 16) { REFRAME(F); if (u >= NCP / 2) chunkprep_wave<1>(F, p, u * 8 + F.wave); else chunkprep_wave<0>(F, p, u * 8 + F.wave); } }
            }
        }
        gsync(bst); STAMP(11);
        }
        for (int rep = 0; rep < NREP(4); ++rep) {
        {
            PHASE_VARS();
            const int ncva = (l + 1 < NL) ? CV_A / 8 : 0, ncvb = (l > 0) ? CV_B / 8 : 0, ncv = NPB + ncva + ncvb, ntot = ncv + 256;
            unsigned* pbdone = ctl + 3072 + (l * 2 + rep) * 16;
            unsigned* gq = ctl + CW_Q + 16 * l + 8 + 4 * rep; unsigned* dq = ctl + 2048 + (l * 2 + rep) * 16;
            const int myx = (int)(xb_xcc_id() & 7u);
            int stage = (bid_ < NPB) ? 0 : 1, pend = -1, xi = 0;
            for (;;) {
                __syncthreads();
                if (F.tid == 0) {
                    int code = -1;
                    if (stage == 0) { const int g = (int)atomicAdd(gq, 1u); if (g < NPB) code = g; else { pend = g; stage = 1; } }
                    if (stage == 1) {
                        while (xi < 8) { const int x = (myx + xi) & 7; const int tk = (int)atomicAdd(dq + x, 1u); if (tk < ((F.G == 256) ? 56 : 64)) { code = -2 - ((4 * x + (tk >> 4)) * 16 + (tk & 15)); break; } ++xi; }
                        if (xi >= 8) stage = 2;
                    }
                    if (stage == 2 && code == -1) { int g = pend; pend = -1; if (g < 0) g = (int)atomicAdd(gq, 1u); if (g < ntot) code = g; }
                    *qslot = code;
                }
                __syncthreads();
                const int u = *qslot;
                if (u == -1) break;
                if (u <= -2) { if (PH_MASK & 32) diff_unit(F, p, l, -2 - u); }
                else if (u < NPB) { if (PH_MASK & 16) { REFRAME(F); phaseb_unit(F, p, u); }
                    asm volatile("s_waitcnt vmcnt(0)" ::: "memory"); __syncthreads();
                    if (F.tid == 0) __hip_atomic_fetch_add(pbdone, 1u, __ATOMIC_RELEASE, __HIP_MEMORY_SCOPE_AGENT); }
                else if (u >= ncv) {
                    if (F.tid == 0) { while (__hip_atomic_load(pbdone, __ATOMIC_RELAXED, __HIP_MEMORY_SCOPE_AGENT) < (unsigned)NPB) __builtin_amdgcn_s_sleep(8);
                        __builtin_amdgcn_fence(__ATOMIC_ACQUIRE, "agent"); asm volatile("s_waitcnt vmcnt(0)" ::: "memory"); }
                    __syncthreads();
                    if (PH_MASK & 64) post_unit(F, p, l, u - ncv); }
                else if (u < NPB + ncva) { REFRAME(F); cvt_item_a(p, l + 1, wb, (LAS float*)(F.lds + F.wave * 16384), (u - NPB) * 8 + F.wave, F.lane); }
                else { REFRAME(F); cvt_item_b(p, l, wb, (LAS float*)(F.lds + F.wave * 16384), (u - NPB - ncva) * 8 + F.wave, F.lane); }
            }
        }
        gsync(bst); STAMP(3);
        }
        if (PH_MASK & 128) {
            PHASE_VARS();
            pg8::StaticOrder S; S.init(MTOK, DM, G_, bid_);
            pg8::gemm_phase(F.lds, pg8::Gemm{MIX, wb + WO_OUT, MTOK, DM, DM}, S, pg8::EpiResid{p.out, XB, rowss + (size_t)(3 * l + 1) * MTOK * 16});
        }
        gsync(bst); STAMP(5);
        for (int rep = 0; rep < NREP(6); ++rep) {
        if (PH_MASK & 256) {
            PHASE_VARS();
            pg8::StaticOrder S; S.init(MTOK, XW, G_, bid_);
            if (F.bid < 128) {
                pg8::gemm_phase(F.lds, pg8::Gemm{XB, wb + WO_Q, MTOK, XW, DM}, S, pg8::EpiScaleBf16{(bf16_t*)(p.ws + WS_Q), XW, rowss + (size_t)(3 * l + 1) * MTOK * 16, nullptr, 0, 1 << 30, nullptr, nullptr, -1});
            } else {
                pg8::StaticOrder S2; S2.init(MMEM, 1024, 128, F.bid - 128);
                pg8::gemm_phase(F.lds, pg8::Gemm{(const bf16_t*)(p.ws + WS_MEMN), wb + WO_KV, MMEM, 1024, DM}, S2, pg8::EpiScaleBf16{(bf16_t*)(p.ws + WS_KV), 1024, nullptr, nullptr, 0, 1 << 30, nullptr, nullptr, -1});
            }
        }
        gsync(bst); STAMP(6);
        }
        for (int rep = 0; rep < NREP(7); ++rep) {
        if (PH_MASK & 512) for (int u = F.bid; u < 256; u += F.G) { PHASE_VARS(); cross_unit(F, p, u); }
        gsync(bst); STAMP(7);
        }
        if (PH_MASK & 1024) {
            PHASE_VARS();
            pg8::StaticOrder S; S.init(MTOK, DM, G_, bid_);
            pg8::gemm_phase(F.lds, pg8::Gemm{(const bf16_t*)(p.ws + WS_O), wb + WO_O, MTOK, DM, XW}, S, pg8::EpiResid{p.out, XB, rowss + (size_t)(3 * l + 2) * MTOK * 16});
        }
        gsync(bst); STAMP(8);
        for (int rep = 0; rep < NREP(9); ++rep) {
        if (PH_MASK & 2048) {
            PHASE_VARS();
            pg8::StaticOrder S; S.init(MTOK, 2 * DFF, G_, bid_);
            const int pm0 = rstd_table(F.lds, S, rowss + (size_t)(3 * l + 2) * MTOK * 16, F.tid);
            pg8::gemm_phase(F.lds, pg8::Gemm{XB, wb + WO_GU, MTOK, 2 * DFF, DM}, S, pg8::EpiSwiGLU{(bf16_t*)(p.ws + WS_G), rowss + (size_t)(3 * l + 2) * MTOK * 16, (const LAS float*)(F.lds + 131072 + 2048), pm0});
        }
        gsync(bst); STAMP(9);
        }
        if (PH_MASK & 4096) {
            PHASE_VARS();
            pg8::StaticOrder S; S.init(MTOK, DM, G_, bid_);
            pg8::gemm_phase(F.lds, pg8::Gemm{(const bf16_t*)(p.ws + WS_G), wb + WO_DOWN, MTOK, DM, DFF}, S, pg8::EpiResid{p.out, XB, rowss + (size_t)(3 * l + 3) * MTOK * 16});
        }

#ifdef TPROBE
        STAMP(10);
        { const Params p = make_params(); if (l == NL - 1 && blockIdx.x == 0 && threadIdx.x == 0) { LAS unsigned long long* ts_ = (LAS unsigned long long*)(F.lds + 131072 + 64); unsigned* c_ = (unsigned*)(p.ws + WS_CTL); c_[32] = (unsigned)ts_[1]; c_[33] = (unsigned)ts_[2]; } }
#endif
        gsync(bst);
    }
    if (PH_MASK & 8192) { const Params p = make_params(); final_norm(F, p); }
}

extern "C" void kernel_launch(void* const* d_in, const int* in_sizes, int n_in, void* d_out, int out_size, void* d_ws, size_t ws_size, hipStream_t stream) {
    static int grid = 0;
    if (grid == 0) {
        if (n_in != 31 || out_size != MTOK * DM || ws_size < WS_END) { fprintf(stderr, "kernel_launch: unexpected problem shape (n_in %d out %d ws %zu)\n", n_in, out_size, ws_size); grid = -1; return; }
        int dev = 0, cus = 0, per_cu = 0;
        hipGetDevice(&dev);
        hipDeviceGetAttribute(&cus, hipDeviceAttributeMultiprocessorCount, dev);
        hipFuncSetAttribute((const void*)fwd_megakernel, hipFuncAttributeMaxDynamicSharedMemorySize, LDS_BYTES);
        hipOccupancyMaxActiveBlocksPerMultiprocessor(&per_cu, (const void*)fwd_megakernel, 512, LDS_BYTES);
        if (per_cu < 1) { fprintf(stderr, "kernel_launch: occupancy query returned %d\n", per_cu); per_cu = 1; }
        (void)hipGetLastError();
        grid = cus * per_cu;
    }
    if (grid < 0) return;
    hipMemsetAsync((char*)d_ws + WS_CTL, 0, CTL_ZERO_BYTES, stream);
    KArgs p{};
    for (int i = 0; i < 31; ++i) p.in[i] = (const float*)d_in[i];
    p.out = (float*)d_out; p.ws = (unsigned char*)d_ws;
    void* args[] = {&p};
    hipError_t e = hipLaunchCooperativeKernel((const void*)fwd_megakernel, dim3(grid), dim3(512), args, LDS_BYTES, stream);
    if (e != hipSuccess) fprintf(stderr, "cooperative launch failed: %s (grid %d)\n", hipGetErrorString(e), grid);
}
```

```cpp
#include <hip/hip_runtime.h>
#include <hip/hip_cooperative_groups.h>
#include <cstdio>
#include <cstdint>
namespace cg = cooperative_groups;

#define LAS __attribute__((address_space(3)))
#define GAS __attribute__((address_space(1)))
typedef unsigned short bf16_t;
typedef short bf16x8 __attribute__((ext_vector_type(8)));
typedef short s16x4 __attribute__((ext_vector_type(4)));
typedef short v4i16_t __attribute__((ext_vector_type(4)));
typedef float f32x4 __attribute__((ext_vector_type(4)));
typedef float f32x2 __attribute__((ext_vector_type(2)));
typedef float f32x16 __attribute__((ext_vector_type(16)));
typedef unsigned u32x4 __attribute__((ext_vector_type(4)));
typedef unsigned u32x2 __attribute__((ext_vector_type(2)));
typedef __bf16 bf16x2_t __attribute__((ext_vector_type(2)));

constexpr int DM = 1024, NB = 8, SEQ = 2048, NL = 4, MTOK = NB * SEQ;
constexpr int NMEM = 256, MMEM = NB * NMEM;
constexpr int INW = 3072, DFF = 2816, XW = 512;
constexpr float LOG2E = 1.4426950408889634f;

constexpr size_t MiB = 1u << 20;
constexpr size_t WS_CTL = 0, CTL_ZERO_BYTES = 1 * MiB;
constexpr size_t WS_W = 1 * MiB;
constexpr size_t WS_Z = 30 * MiB;
constexpr size_t WS_ZC = 94 * MiB;
constexpr size_t WS_XB = 126 * MiB;
constexpr size_t WS_FQR = 94 * MiB, WS_FWY = 126 * MiB, WS_FNA = 158 * MiB, WS_FKH = 174 * MiB, WS_FP15 = 190 * MiB;
constexpr size_t WS_MIX = 192 * MiB;
constexpr size_t WS_OM = 224 * MiB, WS_KA = 240 * MiB, WS_KD = 256 * MiB, WS_KK = 272 * MiB, WS_V = 280 * MiB, WS_R = 288 * MiB;
constexpr size_t WS_GATE = 296 * MiB, WS_Y = 304 * MiB, WS_BON = 320 * MiB, WS_KV = 321 * MiB, WS_MEMN = 325 * MiB;
constexpr size_t WS_RP = 329 * MiB;
constexpr size_t WS_END = 342 * MiB;
constexpr size_t WS_Q = WS_Z, WS_O = WS_Z + 16 * MiB, WS_G = WS_Z;
constexpr int ZP = 1024;
constexpr size_t WS_KD2 = WS_Z + 32 * MiB, WS_VD2 = WS_Z + 48 * MiB;
constexpr size_t WO_IN = 0, WO_OUT = 3145728, WO_Q = 4194304, WO_KV = 4718592, WO_O = 5767168, WO_GU = 6291456, WO_DOWN = 12058624;
constexpr size_t WO_WUP = 14942208, WO_AUP = 14974976, WO_GUP = 15007744;
constexpr int CW_Q = 64;

constexpr int LDS_BYTES = 135168;

__device__ __forceinline__ float bf2f(unsigned b) { return __uint_as_float(b << 16); }
__device__ __forceinline__ unsigned pk2(float lo, float hi) { f32x2 v = {lo, hi}; bf16x2_t b = __builtin_convertvector(v, bf16x2_t); return __builtin_bit_cast(unsigned, b); }
__device__ __forceinline__ float bflo(unsigned u) { return __uint_as_float(u << 16); }
__device__ __forceinline__ float bfhi(unsigned u) { return __uint_as_float(u & 0xffff0000u); }
__device__ __forceinline__ float wave_sum(float v) {
#pragma unroll
    for (int o = 1; o < 64; o <<= 1) v += __shfl_xor(v, o);
    return v;
}
__device__ __forceinline__ float xhalf(float v) {
    return __shfl_xor(v, 32);
}
__device__ __forceinline__ float row_rstd(const float* rp, int row) {
    const f32x4* q = (const f32x4*)(rp + (size_t)row * 16); const f32x4 a = q[0], b = q[1], c = q[2], d = q[3];
    const float s = (((a[0] + a[1]) + (a[2] + a[3])) + ((b[0] + b[1]) + (b[2] + b[3]))) + (((c[0] + c[1]) + (c[2] + c[3])) + ((d[0] + d[1]) + (d[2] + d[3])));
    return rsqrtf(s * (1.f / 1024.f) + 1e-6f);
}
__device__ __forceinline__ float sigmoidf_(float x) { return __builtin_amdgcn_rcpf(1.f + __expf(-x)); }

__device__ __forceinline__ int hw_lane() { int l = (int)__builtin_amdgcn_mbcnt_hi(~0u, __builtin_amdgcn_mbcnt_lo(~0u, 0u)); asm volatile("" : "+v"(l)); return l; }
namespace pg8 {
constexpr int BM = 256, BK = 64, HALF = 128, HTB = HALF * BK * 2, NXCD = 8, WGM = 8;
__host__ __device__ __forceinline__ int lds_byte(int r, int c) { const int st = (r >> 4) * 2 + (c >> 5), rr = r & 15, cc = c & 31, ob = rr * 64 + cc * 2; return st * 1024 + (ob ^ (((ob >> 9) & 1) << 5)); }
__host__ __device__ __forceinline__ void stage_rc(int b, int& R, int& C) { const int st = b / 1024, sb = b % 1024, swz = sb ^ (((sb >> 9) & 1) << 5); R = (st >> 1) * 16 + swz / 64; C = (st & 1) * 32 + (swz % 64) / 2; }
__host__ __device__ __forceinline__ int perm32(int rho) { const int n = rho >> 4, i = rho & 15; return 8 * (i >> 2) + 4 * n + (i & 3); }
struct Unit { int pm, pn; };
struct Gemm { const bf16_t* A; const bf16_t* Bt; int M, N, K; };
struct StaticOrder {
    int nM, nN, nwg, G, c;
    __device__ void init(int M, int N, int G_, int c_) { nM = M / BM; nN = N / BM; nwg = nM * nN; G = G_; c = c_; }
    __device__ bool next(int i, Unit& u) const {
        const long L = (long)i * G + c; if (L >= nwg) return false;
        int wgid = (int)L; { const int q = nwg / NXCD, r = nwg % NXCD, xcd = wgid % NXCD, off = wgid / NXCD; wgid = (xcd < r ? xcd * (q + 1) : r * (q + 1) + (xcd - r) * q) + off; }
        const int nig = WGM * nN, gid = wgid / nig, fm = gid * WGM, gsz = (nM - fm) < WGM ? (nM - fm) : WGM;
        u.pm = fm + ((wgid % nig) % gsz); u.pn = (wgid % nig) / gsz; return true;
    }
};
template <class Epi>
__device__ __forceinline__ void gemm_phase(LAS unsigned char* lds, const Gemm g, const StaticOrder& S, const Epi& E) {
    int tid_ = threadIdx.x; asm volatile("" : "+v"(tid_));
    const int tid = tid_, wid = __builtin_amdgcn_readfirstlane(tid >> 6), lane = tid & 63, wr = wid >> 2, wc = wid & 3, fr = lane & 15, fq = lane >> 4;
    const int K = g.K, nt = K / BK;
    unsigned voffA[2], voffB[2];
#pragma unroll
    for (int i = 0; i < 2; ++i) { int R, C; stage_rc(tid * 16 + i * 8192, R, C); const int Rb = (R & ~31) + perm32(R & 31);
        voffA[i] = (unsigned)(R * K + C) * 2u; voffB[i] = (unsigned)(Rb * K + C) * 2u; }
    const size_t kstep = (size_t)(BK * 2);
    const size_t hstep = (size_t)HALF * K * 2;
    const size_t tstep = 2 * hstep;
    const unsigned ldsw = (unsigned)wid * 1024u;
    const int aoff = lds_byte(wr * 64 + fr, fq * 8), boff = lds_byte(wc * 32 + fr, fq * 8);
#define PG8_SA(b, h) (((b) * 2 + (h)) * HTB)
#define PG8_SB(b, h) ((4 + (b) * 2 + (h)) * HTB)
#define PG8_STAGE(bufoff, gbase, voff) do { _Pragma("unroll") for (int _i = 0; _i < 2; ++_i) \
        __builtin_amdgcn_global_load_lds((const unsigned*)((const char*)(gbase) + (voff)[_i]), (LAS unsigned*)(lds + (bufoff) + ldsw + _i * 8192), 16, 0, 0); } while (0)
#define PG8_LDA(dst, b, h) do { _Pragma("unroll") for (int m = 0; m < 4; ++m) _Pragma("unroll") for (int k = 0; k < 2; ++k) dst[m][k] = *(const LAS bf16x8*)(lds + PG8_SA(b, h) + aoff + m * 2048 + k * 1024); } while (0)
#define PG8_LDB(dst, b, h) do { _Pragma("unroll") for (int n = 0; n < 2; ++n) _Pragma("unroll") for (int k = 0; k < 2; ++k) dst[n][k] = *(const LAS bf16x8*)(lds + PG8_SB(b, h) + boff + n * 2048 + k * 1024); } while (0)
#define PG8_MMA(ai, bj, At, Bt) do { __builtin_amdgcn_s_setprio(1); _Pragma("unroll") for (int m = 0; m < 4; ++m) _Pragma("unroll") for (int n = 0; n < 2; ++n) _Pragma("unroll") for (int k = 0; k < 2; ++k) \
        acc[ai][bj][m][n] = __builtin_amdgcn_mfma_f32_16x16x32_bf16(Bt[n][k], At[m][k], acc[ai][bj][m][n], 0, 0, 0); __builtin_amdgcn_s_setprio(0); } while (0)
#define PG8_WAIT_V(n) asm volatile("s_waitcnt vmcnt(" #n ")" ::: "memory")
#define PG8_WAIT_L(n) asm volatile("s_waitcnt lgkmcnt(" #n ")" ::: "memory")
#define PG8_BAR __builtin_amdgcn_s_barrier()
#define PG8_SCHED __builtin_amdgcn_sched_barrier(0)
    Unit cur, nxt; int ui = 0;
    if (!S.next(0, cur)) return;
    f32x4 acc[2][2][4][2];
#pragma unroll
    for (int a = 0; a < 2; ++a)
#pragma unroll
        for (int b = 0; b < 2; ++b)
#pragma unroll
            for (int m = 0; m < 4; ++m)
#pragma unroll
                for (int n = 0; n < 2; ++n) acc[a][b][m][n] = (f32x4){0.f, 0.f, 0.f, 0.f};
    bf16x8 At[4][2], B0[2][2], B1[2][2];
    const char* cA = (const char*)g.A + (size_t)cur.pm * tstep; const char* cB = (const char*)g.Bt + (size_t)cur.pn * tstep;
    {
        PG8_STAGE(PG8_SB(0, 0), cB, voffB); PG8_STAGE(PG8_SB(0, 1), cB + hstep, voffB); PG8_STAGE(PG8_SA(0, 0), cA, voffA); PG8_STAGE(PG8_SA(0, 1), cA + hstep, voffA);
        if (wr == 1) PG8_BAR;
        PG8_WAIT_V(2); PG8_BAR;
        PG8_STAGE(PG8_SB(1, 0), cB + kstep, voffB); PG8_STAGE(PG8_SA(1, 0), cA + kstep, voffA); PG8_STAGE(PG8_SB(1, 1), cB + hstep + kstep, voffB);
        PG8_WAIT_V(6); PG8_BAR;
    }
    for (;;) {
        const bool has_next = S.next(ui + 1, nxt);
        const char* nA = has_next ? (const char*)g.A + (size_t)nxt.pm * tstep : cA; const char* nB = has_next ? (const char*)g.Bt + (size_t)nxt.pn * tstep : cB;
        for (int t = 0; t < nt; t += 2) {
            const bool last = (t == nt - 2);
            const char* a1 = cA + (size_t)(t + 1) * kstep;
            const char* a2 = last ? nA : cA + (size_t)(t + 2) * kstep; const char* b2 = last ? nB : cB + (size_t)(t + 2) * kstep;
            const char* a3 = a2 + kstep; const char* b3 = b2 + kstep;
            PG8_LDB(B0, 0, 0); PG8_LDB(B1, 0, 1); PG8_SCHED; PG8_LDA(At, 0, 0); PG8_STAGE(PG8_SA(1, 1), a1 + hstep, voffA);
            PG8_WAIT_V(8); PG8_WAIT_L(0); PG8_BAR; PG8_MMA(0, 0, At, B0); PG8_MMA(0, 1, At, B1); PG8_BAR; PG8_SCHED;
            PG8_LDA(At, 0, 1); PG8_STAGE(PG8_SB(0, 0), b2, voffB); PG8_STAGE(PG8_SB(0, 1), b2 + hstep, voffB); PG8_STAGE(PG8_SA(0, 0), a2, voffA);
            PG8_WAIT_V(8); PG8_WAIT_L(0); PG8_BAR; PG8_MMA(1, 0, At, B0); PG8_MMA(1, 1, At, B1); PG8_BAR; PG8_SCHED;
            PG8_LDB(B0, 1, 0); PG8_LDB(B1, 1, 1); PG8_SCHED; PG8_LDA(At, 1, 0); PG8_STAGE(PG8_SA(0, 1), a2 + hstep, voffA);
            PG8_WAIT_V(8); PG8_WAIT_L(0); PG8_BAR; PG8_MMA(0, 0, At, B0); PG8_MMA(0, 1, At, B1); PG8_BAR; PG8_SCHED;
            PG8_LDA(At, 1, 1); PG8_STAGE(PG8_SB(1, 0), b3, voffB); PG8_STAGE(PG8_SB(1, 1), b3 + hstep, voffB); PG8_STAGE(PG8_SA(1, 0), a3, voffA);
            PG8_WAIT_V(8); PG8_WAIT_L(0); PG8_BAR; PG8_MMA(1, 0, At, B0); PG8_MMA(1, 1, At, B1); PG8_BAR; PG8_SCHED;
        }
        if (wr == 0) PG8_BAR;
        E(acc, cur, wr, wc, fr, fq);
        if (!has_next) break;
#pragma unroll
        for (int a = 0; a < 2; ++a)
#pragma unroll
            for (int b = 0; b < 2; ++b)
#pragma unroll
                for (int m = 0; m < 4; ++m)
#pragma unroll
                    for (int n = 0; n < 2; ++n) acc[a][b][m][n] = (f32x4){0.f, 0.f, 0.f, 0.f};
        cur = nxt; cA = nA; cB = nB; ++ui;
        if (wr == 1) PG8_BAR;
    }
    PG8_WAIT_V(0);
    PG8_BAR;
#undef PG8_SA
#undef PG8_SB
#undef PG8_STAGE
#undef PG8_LDA
#undef PG8_LDB
#undef PG8_MMA
#undef PG8_WAIT_V
#undef PG8_WAIT_L
#undef PG8_BAR
#undef PG8_SCHED
}

struct EpiScaleBf16 {
    bf16_t* O; int ldc; const float* rowss; bf16_t* O2; int ldc2; int split_tile; bf16_t* KD2;
    const LAS float* tab; int pm0;
    __device__ __forceinline__ void operator()(const f32x4 (&acc)[2][2][4][2], const Unit& u, int wr, int wc, int fr, int fq) const {
        const bool hi = u.pn >= split_tile, mid = (split_tile == 8) && u.pn >= 4 && u.pn < 8;
        const int row0 = u.pm * BM + wr * 64 + fr, col0 = (hi ? u.pn - split_tile : u.pn) * BM + wc * 32 + 8 * fq;
        bf16_t* const Ob = hi ? O2 : O; const int ld = hi ? ldc2 : ldc;
#pragma unroll
        for (int ai = 0; ai < 2; ++ai)
#pragma unroll
            for (int m = 0; m < 4; ++m) { const int row = row0 + ai * HALF + m * 16;
                const float sc = !rowss ? 1.f : ((tab && u.pm == pm0) ? tab[row & 255] : row_rstd(rowss, row));
                bf16_t* rowp = Ob + (size_t)row * ld + col0;
#pragma unroll
                for (int bj = 0; bj < 2; ++bj) { const f32x4 v0 = acc[ai][bj][m][0] * sc, v1 = acc[ai][bj][m][1] * sc;
                    u32x4 w; w.x = pk2(v0[0], v0[1]); w.y = pk2(v0[2], v0[3]); w.z = pk2(v1[0], v1[1]); w.w = pk2(v1[2], v1[3]);
                    bf16_t* dst = rowp + bj * HALF;
                    if (mid) dst = KD2 + (u.pn >= 6 ? (size_t)8388608 : (size_t)0) + ((size_t)(((row >> 11) * 4 + 2 * (u.pn & 1) + bj) * 2048 + (row & 2047))) * 128 + wc * 32 + 8 * fq;
                    *(u32x4*)dst = w; } }
    }
};
struct EpiSwiGLU {
    bf16_t* O; const float* rowss; const LAS float* tab; int pm0;
    __device__ __forceinline__ void operator()(const f32x4 (&acc)[2][2][4][2], const Unit& u, int wr, int wc, int fr, int fq) const {
        const int row0 = u.pm * BM + wr * 64 + fr, col0 = u.pn * HALF + wc * 32 + 8 * fq;
#pragma unroll
        for (int ai = 0; ai < 2; ++ai)
#pragma unroll
            for (int m = 0; m < 4; ++m) { const int row = row0 + ai * HALF + m * 16;
                const float sc = (tab && u.pm == pm0) ? tab[row & 255] : row_rstd(rowss, row);
                float h[8];
#pragma unroll
                for (int n = 0; n < 2; ++n)
#pragma unroll
                    for (int j = 0; j < 4; ++j) { const float gt = acc[ai][0][m][n][j] * sc, up = acc[ai][1][m][n][j] * sc; h[n * 4 + j] = gt * __builtin_amdgcn_rcpf(1.f + __expf(-gt)) * up; }
                u32x4 w; w.x = pk2(h[0], h[1]); w.y = pk2(h[2], h[3]); w.z = pk2(h[4], h[5]); w.w = pk2(h[6], h[7]);
                *(u32x4*)(O + (size_t)row * DFF + col0) = w; }
    }
};
struct EpiResid {
    float* X; bf16_t* XB; float* rowss_next;
    __device__ __forceinline__ void operator()(const f32x4 (&acc)[2][2][4][2], const Unit& u, int wr, int wc, int fr, int fq) const {
        const int row0 = u.pm * BM + wr * 64 + fr, col0 = u.pn * BM + wc * 32 + 8 * fq;
#pragma unroll
        for (int ai = 0; ai < 2; ++ai)
#pragma unroll
            for (int m = 0; m < 4; ++m) { const int row = row0 + ai * HALF + m * 16; float ss = 0.f;
                float* xp = X + (size_t)row * DM + col0; bf16_t* bp = XB + (size_t)row * DM + col0;
#pragma unroll
                for (int bj = 0; bj < 2; ++bj) {
                    f32x4 x0 = *(f32x4*)(xp + bj * HALF), x1 = *(f32x4*)(xp + bj * HALF + 4);
                    x0 = x0 + acc[ai][bj][m][0]; x1 = x1 + acc[ai][bj][m][1];
                    *(f32x4*)(xp + bj * HALF) = x0; *(f32x4*)(xp + bj * HALF + 4) = x1;
                    ss += (x0[0] * x0[0] + x0[1] * x0[1]) + (x0[2] * x0[2] + x0[3] * x0[3]) + (x1[0] * x1[0] + x1[1] * x1[1]) + (x1[2] * x1[2] + x1[3] * x1[3]);
                    u32x4 w; w.x = pk2(x0[0], x0[1]); w.y = pk2(x0[2], x0[3]); w.z = pk2(x1[0], x1[1]); w.w = pk2(x1[2], x1[3]);
                    *(u32x4*)(bp + bj * HALF) = w; }
                ss += __shfl_xor(ss, 16); ss += __shfl_xor(ss, 32);
                if (fq == 0) rowss_next[(size_t)row * 16 + u.pn * 4 + wc] = ss; }
    }
};
}

struct KArgs { const float* in[31]; float* out; unsigned char* ws; };
#define CAS __attribute__((address_space(4)))
struct InProxy { const CAS unsigned long long* k; __device__ __forceinline__ const float* operator[](int i) const { return (const float*)k[i]; } };
struct Params { InProxy in; float* out; unsigned char* ws; };
__device__ __forceinline__ Params make_params() {
    unsigned long long kv = (unsigned long long)__builtin_amdgcn_kernarg_segment_ptr();
    asm volatile("" : "+s"(kv));
    const CAS unsigned long long* k = (const CAS unsigned long long*)kv;
    Params p; p.in.k = k; p.out = (float*)k[31]; p.ws = (unsigned char*)k[32]; return p;
}

struct Frame {
    LAS unsigned char* lds;
    int tid, lane, wave, G, bid;
};

#define REFRAME(F) do { int _t = threadIdx.x; asm volatile("" : "+v"(_t)); (F).tid = _t; (F).lane = _t & 63; (F).wave = __builtin_amdgcn_readfirstlane(_t >> 6); } while (0)
__device__ __forceinline__ void cvt_item(const float* W_, int K, int ldn, int nblk, bf16_t* WT_, const float* gain_, bool perm_gu, LAS float* scr, int item, int lane) {
    const GAS float* W = (const GAS float*)W_; const GAS float* gain = (const GAS float*)gain_; GAS bf16_t* WT = (GAS bf16_t*)WT_;
    const int kb = item / nblk, nb = item % nblk, k0 = 64 * kb, n0d = 32 * nb;
    const int n0s = perm_gu ? (((n0d & 255) >> 7) * DFF + (n0d >> 8) * 128 + (n0d & 127)) : n0d;
    float v[32];
#pragma unroll
    for (int i = 0; i < 32; ++i) v[i] = W[(size_t)(k0 + 2 * i + (lane >> 5)) * ldn + n0s + (lane & 31)];
    if (gain_) {
#pragma unroll
        for (int i = 0; i < 32; ++i) v[i] *= gain[k0 + 2 * i + (lane >> 5)];
    }
#pragma unroll
    for (int i = 0; i < 32; ++i) scr[(2 * i + (lane >> 5)) * 33 + (lane & 31)] = v[i];
    asm volatile("s_waitcnt lgkmcnt(0)" ::: "memory");
    const int c = lane & 7;
#pragma unroll
    for (int j = 0; j < 4; ++j) { const int n = (lane >> 3) + 8 * j; const LAS float* sp = scr + (8 * c) * 33 + n;
        u32x4 o; o.x = pk2(sp[0 * 33], sp[1 * 33]); o.y = pk2(sp[2 * 33], sp[3 * 33]); o.z = pk2(sp[4 * 33], sp[5 * 33]); o.w = pk2(sp[6 * 33], sp[7 * 33]);
        *(GAS u32x4*)(WT + (size_t)(n0d + n) * K + k0 + 8 * c) = o; }
    asm volatile("s_waitcnt lgkmcnt(0)" ::: "memory");
}
constexpr int CV_IN = 1536, CV_OUT = 512, CV_Q = 256, CV_KV = 512, CV_O = 256, CV_GU = 2816, CV_DOWN = 1408, CV_L = 8;
constexpr int CV_TOTAL = CV_IN + CV_OUT + CV_Q + CV_KV + CV_O + CV_GU + CV_DOWN + 2 * CV_L + 2 * CV_L + 16;

static_assert(CV_TOTAL % 8 == 0, "conversion items per layer");
constexpr int CV_A = CV_IN + 2 * CV_L + 2 * CV_L + 16, CV_B = CV_KV + CV_OUT + CV_Q + CV_O + CV_GU + CV_DOWN;
static_assert(CV_A % 8 == 0 && CV_B % 8 == 0 && CV_A + CV_B == CV_TOTAL, "conversion lists");
__device__ __forceinline__ void cvt_item_a(const Params& p, int l, bf16_t* wb, LAS float* scr, int it, int lane) {
    int r = it;
    if (r < CV_IN) { cvt_item(p.in[3] + (size_t)l * DM * INW, DM, INW, INW / 32, wb + WO_IN, p.in[2] + l * DM, false, scr, r, lane); return; } r -= CV_IN;
    if (r < 2 * CV_L) { const int d = r / CV_L; cvt_item(p.in[12] + ((size_t)l * 2 + d) * 64 * 256, 64, 256, 8, wb + WO_WUP + d * 256 * 64, nullptr, false, scr, r % CV_L, lane); return; } r -= 2 * CV_L;
    if (r < 2 * CV_L) { const int d = r / CV_L; cvt_item(p.in[14] + ((size_t)l * 2 + d) * 64 * 256, 64, 256, 8, wb + WO_AUP + d * 256 * 64, nullptr, false, scr, r % CV_L, lane); return; } r -= 2 * CV_L;
    cvt_item(p.in[15] + (size_t)l * 128 * 256, 128, 256, 8, wb + WO_GUP, nullptr, false, scr, r, lane);
}
__device__ __forceinline__ void cvt_item_b(const Params& p, int l, bf16_t* wb, LAS float* scr, int it, int lane) {
    int r = it;
    if (r < CV_KV) { cvt_item(p.in[25] + (size_t)l * DM * 1024, DM, 1024, 32, wb + WO_KV, nullptr, false, scr, r, lane); return; } r -= CV_KV;
    if (r < CV_OUT) { cvt_item(p.in[21] + (size_t)l * DM * DM, DM, DM, DM / 32, wb + WO_OUT, nullptr, false, scr, r, lane); return; } r -= CV_OUT;
    if (r < CV_Q) { cvt_item(p.in[24] + (size_t)l * DM * XW, DM, XW, XW / 32, wb + WO_Q, p.in[22] + l * DM, false, scr, r, lane); return; } r -= CV_Q;
    if (r < CV_O) { cvt_item(p.in[26] + (size_t)l * XW * DM, XW, DM, 32, wb + WO_O, nullptr, false, scr, r, lane); return; } r -= CV_O;
    if (r < CV_GU) { cvt_item(p.in[28] + (size_t)l * DM * 2 * DFF, DM, 2 * DFF, 2 * DFF / 32, wb + WO_GU, p.in[27] + l * DM, true, scr, r, lane); return; } r -= CV_GU;
    cvt_item(p.in[29] + (size_t)l * DFF * DM, DFF, DM, 32, wb + WO_DOWN, nullptr, false, scr, r, lane);
}

__device__ __forceinline__ s16x4 vtr(const LAS unsigned char* p) { return __builtin_bit_cast(s16x4, __builtin_amdgcn_ds_read_tr16_b64_v4i16((LAS v4i16_t*)p)); }
__device__ __forceinline__ int crow(int r, int hi) { return (r & 3) + 8 * (r >> 2) + 4 * hi; }

template <int W> __device__ __forceinline__ void tile_load(u32x4 (&r)[W / 64], const bf16_t* g, int pitch, int tid) {
#pragma unroll
    for (int i = 0; i < W / 64; ++i) { const int id = tid + i * 512, row = id / (W / 8), ch = id % (W / 8); r[i] = *(const GAS u32x4*)((const GAS bf16_t*)g + (size_t)row * pitch + ch * 8); }
}
template <int W, int STR> __device__ __forceinline__ void tile_store(const u32x4 (&r)[W / 64], LAS unsigned char* buf, int tid) {
#pragma unroll
    for (int i = 0; i < W / 64; ++i) { const int id = tid + i * 512, row = id / (W / 8), ch = id % (W / 8); *(LAS u32x4*)(buf + row * STR + ch * 16) = r[i]; }
}
template <int DQK> __device__ __forceinline__ void load_q(bf16x8 (&qf)[DQK / 16], const bf16_t* qrow, int h, float sc) {
#pragma unroll
    for (int ks = 0; ks < DQK / 16; ++ks) { const u32x4 v = *(const GAS u32x4*)((const GAS bf16_t*)qrow + 16 * ks + 8 * h);
        u32x4 o; o.x = pk2(bflo(v.x) * sc, bfhi(v.x) * sc); o.y = pk2(bflo(v.y) * sc, bfhi(v.y) * sc); o.z = pk2(bflo(v.z) * sc, bfhi(v.z) * sc); o.w = pk2(bflo(v.w) * sc, bfhi(v.w) * sc);
        qf[ks] = __builtin_bit_cast(bf16x8, o); }
}
template <int DQK, int KW, int DV, int MODE>
__device__ __forceinline__ void attn_loop(LAS unsigned char* lds, const bf16_t* Kg, int kpitch, const bf16_t* Vg, int vpitch, int ntiles,
                                          const bf16x8 (&qf)[DQK / 16], int koff, float nslope2, int qrel, float& m, float& lsum, f32x16 (&o)[DV / 32]) {
    constexpr int KSTR = (KW + 8) * 2, VSTR = DV * 2 + 64, KBUF = 64 * KSTR, VBUF = 64 * VSTR;
    int tid_ = threadIdx.x; asm volatile("" : "+v"(tid_));
    const int tid = tid_, lane = tid & 63, r = lane & 31, h = lane >> 5;
    LAS unsigned char* K0 = lds; LAS unsigned char* V0 = lds + 2 * KBUF;
    u32x4 kr[KW / 64], vr[DV / 64];
    tile_load<KW>(kr, Kg, kpitch, tid); tile_load<DV>(vr, Vg, vpitch, tid);
    tile_store<KW, KSTR>(kr, K0, tid); tile_store<DV, VSTR>(vr, V0, tid);
    __syncthreads();
    const int vlane = ((lane & 15) >> 2) * VSTR + (16 * ((lane >> 4) & 1) + 4 * (lane & 3)) * 2 + 4 * h * VSTR;
    for (int t = 0; t < ntiles; ++t) {
        const int cur = t & 1;
        if (t + 1 < ntiles) { tile_load<KW>(kr, Kg + (size_t)(t + 1) * 64 * kpitch, kpitch, tid); tile_load<DV>(vr, Vg + (size_t)(t + 1) * 64 * vpitch, vpitch, tid); }
        const LAS unsigned char* Kb = K0 + cur * KBUF + r * KSTR + (koff + 8 * h) * 2;
        const LAS unsigned char* Vb = V0 + cur * VBUF + vlane;
        f32x16 s0, s1;
#pragma unroll
        for (int i = 0; i < 16; ++i) { s0[i] = 0.f; s1[i] = 0.f; }
#pragma unroll
        for (int ks = 0; ks < DQK / 16; ++ks) {
            const bf16x8 k0 = *(const LAS bf16x8*)(Kb + ks * 32), k1 = *(const LAS bf16x8*)(Kb + 32 * KSTR + ks * 32);
            s0 = __builtin_amdgcn_mfma_f32_32x32x16_bf16(k0, qf[ks], s0, 0, 0, 0);
            s1 = __builtin_amdgcn_mfma_f32_32x32x16_bf16(k1, qf[ks], s1, 0, 0, 0);
        }
        float Aoff = 0.f;
        if (MODE >= 1) {
            const int qrel0 = __builtin_amdgcn_readfirstlane(qrel - r);
            const int T0 = t * 64;
            if (MODE == 1 && (T0 + 64 <= qrel0 || T0 > qrel0 + 31)) {
                const bool left = (T0 + 64 <= qrel0);
                const float sl = left ? -nslope2 : nslope2;
                Aoff = left ? nslope2 * (float)(qrel - T0 - 4 * h) : nslope2 * (float)(T0 + 4 * h - qrel);
#pragma unroll
                for (int i = 0; i < 16; ++i) { s0[i] = __builtin_fmaf(sl, (float)((i & 3) + 8 * (i >> 2)), s0[i]); s1[i] = __builtin_fmaf(sl, (float)(32 + (i & 3) + 8 * (i >> 2)), s1[i]); }
            } else {
                const float base = (float)(T0 + 4 * h - qrel);
#pragma unroll
                for (int i = 0; i < 16; ++i) {
                    const float d0 = fabsf(base + (float)((i & 3) + 8 * (i >> 2))), d1 = fabsf(base + (float)(32 + (i & 3) + 8 * (i >> 2)));
                    s0[i] = __builtin_fmaf(d0, nslope2, s0[i]); s1[i] = __builtin_fmaf(d1, nslope2, s1[i]);
                    if (MODE == 2) { if (d0 > 128.f) s0[i] = -1e30f; if (d1 > 128.f) s1[i] = -1e30f; }
                }
            }
        }
        float mx = fmaxf(s0[0], s1[0]);
#pragma unroll
        for (int i = 1; i < 16; ++i) mx = fmaxf(fmaxf(mx, s0[i]), s1[i]);
        mx += Aoff;
        mx = fmaxf(mx, xhalf(mx));
        const float mnew = fmaxf(m, mx);
        if (__builtin_amdgcn_ballot_w64(mnew > m) != 0ull) {
            const float alpha = __builtin_amdgcn_exp2f(m - mnew);
            lsum *= alpha;
#pragma unroll
            for (int d = 0; d < DV / 32; ++d) o[d] = o[d] * alpha;
        }
        m = mnew;
        const float mm = mnew - Aoff;
        float rs = 0.f;
#pragma unroll
        for (int i = 0; i < 16; ++i) { s0[i] = __builtin_amdgcn_exp2f(s0[i] - mm); s1[i] = __builtin_amdgcn_exp2f(s1[i] - mm); rs += s0[i] + s1[i]; }
        lsum += rs;
        bf16x8 pf[4];
#pragma unroll
        for (int s2 = 0; s2 < 2; ++s2) {
            u32x4 a, b;
            a.x = pk2(s0[8 * s2 + 0], s0[8 * s2 + 1]); a.y = pk2(s0[8 * s2 + 2], s0[8 * s2 + 3]); a.z = pk2(s0[8 * s2 + 4], s0[8 * s2 + 5]); a.w = pk2(s0[8 * s2 + 6], s0[8 * s2 + 7]);
            b.x = pk2(s1[8 * s2 + 0], s1[8 * s2 + 1]); b.y = pk2(s1[8 * s2 + 2], s1[8 * s2 + 3]); b.z = pk2(s1[8 * s2 + 4], s1[8 * s2 + 5]); b.w = pk2(s1[8 * s2 + 6], s1[8 * s2 + 7]);
            pf[s2] = __builtin_bit_cast(bf16x8, a); pf[2 + s2] = __builtin_bit_cast(bf16x8, b);
        }
#pragma unroll
        for (int d = 0; d < DV / 32; ++d) {
#pragma unroll
            for (int kk = 0; kk < 4; ++kk) {
                const s16x4 lo = vtr(Vb + (16 * kk) * VSTR + d * 64), hi = vtr(Vb + (16 * kk + 8) * VSTR + d * 64);
                const bf16x8 vf = {lo[0], lo[1], lo[2], lo[3], hi[0], hi[1], hi[2], hi[3]};
                o[d] = __builtin_amdgcn_mfma_f32_32x32x16_bf16(vf, pf[kk], o[d], 0, 0, 0);
            }
        }
        if (t + 1 < ntiles) { tile_store<KW, KSTR>(kr, K0 + (cur ^ 1) * KBUF, tid); tile_store<DV, VSTR>(vr, V0 + (cur ^ 1) * VBUF, tid); }
        __syncthreads();
    }
}
__device__ __forceinline__ int swz(int row) { return ((row & 3) << 2) | ((row >> 2) & 3); }
template <int DQK, int MODE, int pitch, int voff>
__device__ __forceinline__ void attn_loop_dma(LAS unsigned char* lds, const int wave, const bf16_t* Kg, int ntiles,
                                              const bf16x8 (&qf)[DQK / 16], int koff, float nslope2, int qrel, float& m, float& lsum, f32x16 (&o)[4]) {
    constexpr int DV = 128, STAGE = 32768, VOFFB = 16384;
    const int lane = hw_lane(), r = lane & 31, h = lane >> 5;
    unsigned gk[2];
#pragma unroll
    for (int i = 0; i < 2; ++i) { const int row = 4 * (2 * wave + i) + (lane >> 4), c = (lane & 15) ^ swz(row); gk[i] = (unsigned)(row * pitch + c * 8); }
    unsigned kad[DQK / 16], vad[4][2];
#pragma unroll
    for (int ks = 0; ks < DQK / 16; ++ks) kad[ks] = (unsigned)(r * 256 + 16 * (((koff >> 3) + 2 * ks + h) ^ swz(r)));
    { const int q_ = (lane & 15) >> 2, pp = lane & 3, g1 = (lane >> 4) & 1;
#pragma unroll
      for (int d = 0; d < 4; ++d)
#pragma unroll
          for (int hi = 0; hi < 2; ++hi) { const int f = (q_ << 2) | ((2 * hi + h) & 3), c = (4 * d + 2 * g1 + (pp >> 1)) ^ f;
              vad[d][hi] = (unsigned)(VOFFB + (4 * h + q_) * 256 + 16 * c + 8 * (pp & 1) + hi * 2048); } }
#define ATT_DMA(tt, st) do { const bf16_t* kg_ = Kg + (size_t)(tt) * 64 * pitch; _Pragma("unroll") for (int i_ = 0; i_ < 2; ++i_) { \
        __builtin_amdgcn_global_load_lds((const unsigned*)(kg_ + gk[i_]), (LAS unsigned*)(lds + (st) * STAGE + (2 * wave + i_) * 1024), 16, 0, 0); \
        __builtin_amdgcn_global_load_lds((const unsigned*)(kg_ + voff + gk[i_]), (LAS unsigned*)(lds + (st) * STAGE + VOFFB + (2 * wave + i_) * 1024), 16, 0, 0); } } while (0)
    ATT_DMA(0, 0);
    if (ntiles > 1) ATT_DMA(1, 1);
    if (ntiles > 2) { ATT_DMA(2, 2); asm volatile("s_waitcnt vmcnt(4)" ::: "memory"); } else asm volatile("s_waitcnt vmcnt(0)" ::: "memory");
    __builtin_amdgcn_s_barrier();
    f32x16 s0, s1;
#pragma unroll
    for (int i = 0; i < 16; ++i) { s0[i] = 0.f; s1[i] = 0.f; }
#pragma unroll
    for (int ks = 0; ks < DQK / 16; ++ks) {
        const bf16x8 k0 = *(const LAS bf16x8*)(lds + kad[ks]), k1 = *(const LAS bf16x8*)(lds + kad[ks] + 8192);
        s0 = __builtin_amdgcn_mfma_f32_32x32x16_bf16(k0, qf[ks], s0, 0, 0, 0);
        s1 = __builtin_amdgcn_mfma_f32_32x32x16_bf16(k1, qf[ks], s1, 0, 0, 0);
    }
#define LDS_RD128(dst, addr, off) asm volatile("ds_read_b128 %0, %1 offset:%c2" : "=&v"(dst) : "v"(addr), "i"(off) : "memory")
#define LDS_RDTR(dst, addr, off) asm volatile("ds_read_b64_tr_b16 %0, %1 offset:%c2" : "=&v"(dst) : "v"(addr), "i"(off) : "memory")
#define LDS_WAIT0() do { asm volatile("s_waitcnt lgkmcnt(0)" ::: "memory"); __builtin_amdgcn_sched_barrier(0); } while (0)
    for (int t = 0; t < ntiles; ++t) {
        if (t + 3 < ntiles) ATT_DMA(t + 3, (t + 3) & 3);
        const unsigned sba = (unsigned)(size_t)(lds + (t & 3) * STAGE), sna = (unsigned)(size_t)(lds + ((t + 1) & 3) * STAGE);
        constexpr int KH = (DQK == 64) ? 4 : 4;
        bf16x8 kf0[KH], kf1[KH];
        s16x4 va_lo[4], va_hi[4], vb_lo[4], vb_hi[4];
        if (DQK == 64) {
#pragma unroll
            for (int ks = 0; ks < KH; ++ks) { const unsigned ka = sna + kad[ks]; LDS_RD128(kf0[ks], ka, 0); } }
        __builtin_amdgcn_sched_barrier(0);
        float Aoff = 0.f;
        if (MODE >= 1) {
            const int qrel0 = __builtin_amdgcn_readfirstlane(qrel - r);
            const int T0 = t * 64;
            if (MODE == 1 && (T0 + 64 <= qrel0 || T0 > qrel0 + 31)) {
                const bool left = (T0 + 64 <= qrel0);
                const float sl = left ? -nslope2 : nslope2;
                Aoff = left ? nslope2 * (float)(qrel - T0 - 4 * h) : nslope2 * (float)(T0 + 4 * h - qrel);
#pragma unroll
                for (int i = 0; i < 16; ++i) { s0[i] = __builtin_fmaf(sl, (float)((i & 3) + 8 * (i >> 2)), s0[i]); s1[i] = __builtin_fmaf(sl, (float)(32 + (i & 3) + 8 * (i >> 2)), s1[i]); }
            } else {
                const float base = (float)(T0 + 4 * h - qrel);
#pragma unroll
                for (int i = 0; i < 16; ++i) {
                    const float d0 = fabsf(base + (float)((i & 3) + 8 * (i >> 2))), d1 = fabsf(base + (float)(32 + (i & 3) + 8 * (i >> 2)));
                    s0[i] = __builtin_fmaf(d0, nslope2, s0[i]); s1[i] = __builtin_fmaf(d1, nslope2, s1[i]);
                    if (MODE == 2) { if (d0 > 128.f) s0[i] = -1e30f; if (d1 > 128.f) s1[i] = -1e30f; }
                }
            }
        }
        float mx = fmaxf(s0[0], s1[0]);
#pragma unroll
        for (int i = 1; i < 16; ++i) mx = fmaxf(fmaxf(mx, s0[i]), s1[i]);
        mx += Aoff;
        mx = fmaxf(mx, xhalf(mx));
        const float mnew = fmaxf(m, mx);
        if (__builtin_amdgcn_ballot_w64(mnew > m) != 0ull) {
            const float alpha = __builtin_amdgcn_exp2f(m - mnew);
            lsum *= alpha;
#pragma unroll
            for (int d = 0; d < DV / 32; ++d) o[d] = o[d] * alpha;
        }
        m = mnew;
        const float mm = mnew - Aoff;
        float rs = 0.f;
#pragma unroll
        for (int i = 0; i < 16; ++i) { s0[i] = __builtin_amdgcn_exp2f(s0[i] - mm); s1[i] = __builtin_amdgcn_exp2f(s1[i] - mm); rs += s0[i] + s1[i]; }
        lsum += rs;
        bf16x8 pf[4];
#pragma unroll
        for (int s2 = 0; s2 < 2; ++s2) {
            u32x4 a, b;
            a.x = pk2(s0[8 * s2 + 0], s0[8 * s2 + 1]); a.y = pk2(s0[8 * s2 + 2], s0[8 * s2 + 3]); a.z = pk2(s0[8 * s2 + 4], s0[8 * s2 + 5]); a.w = pk2(s0[8 * s2 + 6], s0[8 * s2 + 7]);
            b.x = pk2(s1[8 * s2 + 0], s1[8 * s2 + 1]); b.y = pk2(s1[8 * s2 + 2], s1[8 * s2 + 3]); b.z = pk2(s1[8 * s2 + 4], s1[8 * s2 + 5]); b.w = pk2(s1[8 * s2 + 6], s1[8 * s2 + 7]);
            pf[s2] = __builtin_bit_cast(bf16x8, a); pf[2 + s2] = __builtin_bit_cast(bf16x8, b);
        }
        LDS_WAIT0();
        if (DQK == 64) {
#pragma unroll
            for (int ks = 0; ks < KH; ++ks) { const unsigned ka = sna + kad[ks]; LDS_RD128(kf1[ks], ka, 8192); } }
        { const unsigned alo = sba + vad[0][0], ahi = sba + vad[0][1];
#pragma unroll
          for (int kk = 0; kk < 4; ++kk) { LDS_RDTR(va_lo[kk], alo, kk * 4096); LDS_RDTR(va_hi[kk], ahi, kk * 4096); } }
        __builtin_amdgcn_sched_barrier(0);
        f32x16 n0, n1;
#pragma unroll
        for (int i = 0; i < 16; ++i) { n0[i] = 0.f; n1[i] = 0.f; }
#pragma unroll
        for (int g = 0; g < DQK / 64; ++g) {
            if (DQK != 64) {
#pragma unroll
                for (int ks = 0; ks < KH; ++ks) { const unsigned ka = sna + kad[g * KH + ks]; LDS_RD128(kf0[ks], ka, 0); LDS_RD128(kf1[ks], ka, 8192); }
                LDS_WAIT0(); }
#pragma unroll
            for (int ks = 0; ks < KH; ++ks) n0 = __builtin_amdgcn_mfma_f32_32x32x16_bf16(kf0[ks], qf[g * KH + ks], n0, 0, 0, 0);
            if (DQK == 64) LDS_WAIT0();
#pragma unroll
            for (int ks = 0; ks < KH; ++ks) n1 = __builtin_amdgcn_mfma_f32_32x32x16_bf16(kf1[ks], qf[g * KH + ks], n1, 0, 0, 0);
        }
#define PV_BLOCK(d, lo, hi) do { _Pragma("unroll") for (int kk = 0; kk < 4; ++kk) { const bf16x8 vf = {lo[kk][0], lo[kk][1], lo[kk][2], lo[kk][3], hi[kk][0], hi[kk][1], hi[kk][2], hi[kk][3]}; \
            o[d] = __builtin_amdgcn_mfma_f32_32x32x16_bf16(vf, pf[kk], o[d], 0, 0, 0); } } while (0)
#define V_ISSUE(d, lo, hi) do { const unsigned alo_ = sba + vad[d][0], ahi_ = sba + vad[d][1]; _Pragma("unroll") for (int kk = 0; kk < 4; ++kk) { LDS_RDTR(lo[kk], alo_, kk * 4096); LDS_RDTR(hi[kk], ahi_, kk * 4096); } } while (0)
        LDS_WAIT0();
        V_ISSUE(1, vb_lo, vb_hi); __builtin_amdgcn_sched_barrier(0);
        PV_BLOCK(0, va_lo, va_hi);
        LDS_WAIT0();
        V_ISSUE(2, va_lo, va_hi); __builtin_amdgcn_sched_barrier(0);
        PV_BLOCK(1, vb_lo, vb_hi);
        LDS_WAIT0();
        V_ISSUE(3, vb_lo, vb_hi); __builtin_amdgcn_sched_barrier(0);
        PV_BLOCK(2, va_lo, va_hi);
        LDS_WAIT0();
        PV_BLOCK(3, vb_lo, vb_hi);
#undef PV_BLOCK
#undef V_ISSUE
        s0 = n0; s1 = n1;
        if (t + 3 < ntiles) asm volatile("s_waitcnt vmcnt(4)" ::: "memory"); else asm volatile("s_waitcnt vmcnt(0)" ::: "memory");
        __builtin_amdgcn_s_barrier();
    }
#undef LDS_RD128
#undef LDS_RDTR
#undef LDS_WAIT0
#undef ATT_DMA
}
template <int DV> __device__ __forceinline__ void store_o(const f32x16 (&o)[DV / 32], float sc, bf16_t* orow, int h) {
#pragma unroll
    for (int d = 0; d < DV / 32; ++d)
#pragma unroll
        for (int g4 = 0; g4 < 4; ++g4) { u32x2 w; w.x = pk2(o[d][4 * g4] * sc, o[d][4 * g4 + 1] * sc); w.y = pk2(o[d][4 * g4 + 2] * sc, o[d][4 * g4 + 3] * sc);
            *(GAS u32x2*)((GAS bf16_t*)orow + 32 * d + 8 * g4 + 4 * h) = w; }
}

__device__ __forceinline__ void win_unit(Frame& F, const Params& p, int l, int u) {
    REFRAME(F);
    const bf16_t* Z = (const bf16_t*)(p.ws + WS_Z); bf16_t* MIX = (bf16_t*)(p.ws + WS_MIX);
    const int b = u >> 5, kvh = (u >> 4) & 1, nb = u & 15, r = F.lane & 31, h = F.lane >> 5;
    const int g = F.wave >> 2, hq = kvh * 2 + g, qpos = nb * 128 + (F.wave & 3) * 32 + r;
    const size_t tok = (size_t)b * SEQ + qpos;
    bf16x8 qf[4]; load_q<64>(qf, Z + tok * ZP + hq * 64, h, 0.125f * LOG2E);
    const int first = (2 * nb - 2 < 0) ? 0 : 2 * nb - 2, lastx = (2 * nb + 4 > 32) ? 32 : 2 * nb + 4, nt = lastx - first;
    const float slope = exp2f(-(float)(2 * hq + 1));
    float m = p.in[4][l * 4 + hq] * LOG2E, ls = (h == 0) ? 1.f : 0.f;
    f32x16 o[2];
#pragma unroll
    for (int d = 0; d < 2; ++d)
#pragma unroll
        for (int i = 0; i < 16; ++i) o[d][i] = 0.f;
    const bf16_t* Kg = Z + ((size_t)b * SEQ + first * 64) * ZP + 256 + kvh * 64;
    attn_loop<64, 64, 64, 2>(F.lds, Kg, ZP, Kg + 128, ZP, nt, qf, 0, -slope * LOG2E, qpos - first * 64, m, ls, o);
    const float lt = ls + xhalf(ls);
    store_o<64>(o, 1.f / lt, MIX + tok * DM + hq * 64, h);
}
__device__ __forceinline__ void diff_unit(Frame& F, const Params& p, int l, int u) {
    REFRAME(F);
    const bf16_t* Z = (const bf16_t*)(p.ws + WS_Z); bf16_t* MIX = (bf16_t*)(p.ws + WS_MIX);
    const int b = u >> 6, hh = (u >> 4) & 3, qb = u & 15, r = F.lane & 31, h = F.lane >> 5;
    const int c = F.wave >> 2, qpos = qb * 128 + (F.wave & 3) * 32 + r;
    const size_t tok = (size_t)b * SEQ + qpos;
    float lam, lam_init;
    {
        const float a1 = wave_sum(p.in[5][l * 64 + F.lane] * p.in[6][l * 64 + F.lane]), a2 = wave_sum(p.in[7][l * 64 + F.lane] * p.in[8][l * 64 + F.lane]);
        lam_init = 0.8f - 0.6f * expf(-0.3f * (float)l);
        lam = expf(a1) - expf(a2) + lam_init;
    }
    bf16x8 qf[4]; load_q<64>(qf, Z + tok * ZP + 512 + hh * 128 + c * 64, h, 0.125f * LOG2E);
    const float slope = exp2f(-(float)(2 * hh + 2));
    float m = -1e30f, ls = 0.f;
    f32x16 o[4];
#pragma unroll
    for (int d = 0; d < 4; ++d)
#pragma unroll
        for (int i = 0; i < 16; ++i) o[d][i] = 0.f;
    const bf16_t* Kg = (const bf16_t*)(p.ws + WS_KD2) + (size_t)(b * 4 + hh) * 2048 * 128;
    attn_loop_dma<64, 1, 128, 8388608>(F.lds, F.wave, Kg, 32, qf, c * 64, -slope * LOG2E, qpos, m, ls, o);
    const float inv = 1.f / (ls + xhalf(ls));
    LAS float* comb = (LAS float*)F.lds + (size_t)(F.wave & 3) * 64 * 64 + F.lane;
    if (c == 1) {
#pragma unroll
        for (int d = 0; d < 4; ++d)
#pragma unroll
            for (int i = 0; i < 16; ++i) comb[(d * 16 + i) * 64] = o[d][i] * inv;
    }
    __syncthreads();
    if (c == 0) {
        float ss = 0.f;
#pragma unroll
        for (int d = 0; d < 4; ++d)
#pragma unroll
            for (int i = 0; i < 16; ++i) { const float a = o[d][i] * inv - lam * comb[(d * 16 + i) * 64]; o[d][i] = a; ss += a * a; }
        ss += xhalf(ss);
        const float rn = rsqrtf(ss * (1.f / 128.f) + 1e-6f) * (1.f - lam_init);
        const float* sg = p.in[9] + l * 128;
        bf16_t* orow = MIX + tok * DM + 256 + hh * 128;
        f32x4 ggv[4][4];
#pragma unroll
        for (int d = 0; d < 4; ++d)
#pragma unroll
            for (int g4 = 0; g4 < 4; ++g4) ggv[d][g4] = *(const GAS f32x4*)((const GAS float*)sg + 32 * d + 8 * g4 + 4 * h);
#pragma unroll
        for (int d = 0; d < 4; ++d)
#pragma unroll
            for (int g4 = 0; g4 < 4; ++g4) { const int dv = 32 * d + 8 * g4 + 4 * h; const f32x4 gg = ggv[d][g4];
                u32x2 w; w.x = pk2(o[d][4 * g4] * rn * gg[0], o[d][4 * g4 + 1] * rn * gg[1]); w.y = pk2(o[d][4 * g4 + 2] * rn * gg[2], o[d][4 * g4 + 3] * rn * gg[3]);
                *(GAS u32x2*)((GAS bf16_t*)orow + dv) = w; }
    }
    __syncthreads();
}
__device__ __forceinline__ void cross_unit(Frame& F, const Params& p, int u) {
    REFRAME(F);
    const bf16_t* Q = (const bf16_t*)(p.ws + WS_Q); const bf16_t* KV = (const bf16_t*)(p.ws + WS_KV); bf16_t* O = (bf16_t*)(p.ws + WS_O);
    const int b = u >> 5, hd = (u >> 3) & 3, qb = u & 7, r = F.lane & 31, h = F.lane >> 5;
    const size_t tok = (size_t)b * SEQ + qb * 256 + F.wave * 32 + r;
    bf16x8 qf[8]; load_q<128>(qf, Q + tok * XW + hd * 128, h, 0.08838834764831845f * LOG2E);
    float m = -1e30f, ls = 0.f;
    f32x16 o[4];
#pragma unroll
    for (int d = 0; d < 4; ++d)
#pragma unroll
        for (int i = 0; i < 16; ++i) o[d][i] = 0.f;
    const bf16_t* Kg = KV + ((size_t)b * NMEM) * 1024 + hd * 128;
    attn_loop_dma<128, 0, 1024, 512>(F.lds, F.wave, Kg, 4, qf, 0, 0.f, 0, m, ls, o);
    const float lt = ls + xhalf(ls);
    store_o<128>(o, 1.f / lt, O + tok * XW + hd * 128, h);
}

constexpr int CF_STR = 772, PREP_AW = 32 * CF_STR * 4, PREP_AA = PREP_AW + 32 * 72 * 2, PREP_AG = PREP_AA + 32 * 72 * 2;
__device__ __forceinline__ void prep_unit(Frame& F, const Params& p, int l, const bf16_t* wb, int u) {
    REFRAME(F);
    const bf16_t* ZC = (const bf16_t*)(p.ws + WS_ZC);
    const int t0 = u * 32, b = t0 / SEQ;
    LAS float* CF = (LAS float*)F.lds; LAS bf16_t* AW = (LAS bf16_t*)(F.lds + PREP_AW); LAS bf16_t* AA = (LAS bf16_t*)(F.lds + PREP_AA); LAS bf16_t* AG = (LAS bf16_t*)(F.lds + PREP_AG);
    const float* conv = p.in[10] + (size_t)l * 3 * 1024;
    LAS float* PAR = (LAS float*)(F.lds + PREP_AG + 32 * 136 * 2);
    if (F.tid < 448) { const int i = F.tid; const GAS f32x4* src;
        if (i < 64) src = (const GAS f32x4*)((const GAS float*)p.in[16] + l * 256) + i;
        else if (i < 128) src = (const GAS f32x4*)((const GAS float*)p.in[17] + l * 256) + (i - 64);
        else if (i < 192) src = (const GAS f32x4*)((const GAS float*)p.in[18] + l * 256) + (i - 128);
        else if (i < 320) src = (const GAS f32x4*)((const GAS float*)p.in[11] + l * 512) + (i - 192);
        else src = (const GAS f32x4*)((const GAS float*)p.in[13] + l * 512) + (i - 320);
        ((LAS f32x4*)PAR)[i] = *src; }
#pragma unroll 4
    for (int i = 0; i < 8; ++i) {
        const int id = F.tid + i * 512, tk = id >> 7, ch = id & 127, tg = t0 + tk, tpos = tg - b * SEQ;
        const GAS bf16_t* zp = (const GAS bf16_t*)ZC + (size_t)tg * 1024 + ch * 8;
        const u32x4 zc = *(const GAS u32x4*)zp;
        u32x4 zl = {0u, 0u, 0u, 0u}, zr = {0u, 0u, 0u, 0u};
        if (tpos > 0) zl = *(const GAS u32x4*)(zp - 1024);
        if (tpos < SEQ - 1) zr = *(const GAS u32x4*)(zp + 1024);
        float v[8];
#pragma unroll
        for (int q = 0; q < 4; ++q) {
            const f32x2 c0 = *(const GAS f32x2*)((const GAS float*)conv + ch * 8 + 2 * q), c1 = *(const GAS f32x2*)((const GAS float*)conv + 1024 + ch * 8 + 2 * q), c2 = *(const GAS f32x2*)((const GAS float*)conv + 2048 + ch * 8 + 2 * q);
            v[2 * q] = bflo(zl[q]) * c0[0] + bflo(zc[q]) * c1[0] + bflo(zr[q]) * c2[0];
            v[2 * q + 1] = bfhi(zl[q]) * c0[1] + bfhi(zc[q]) * c1[1] + bfhi(zr[q]) * c2[1];
        }
        if (ch < 96) { *(LAS f32x4*)(CF + tk * CF_STR + ch * 8) = (f32x4){v[0], v[1], v[2], v[3]}; *(LAS f32x4*)(CF + tk * CF_STR + ch * 8 + 4) = (f32x4){v[4], v[5], v[6], v[7]}; }
        else {
            u32x4 w;
            if (ch < 104) {
#pragma unroll
                for (int q = 0; q < 8; ++q) v[q] = 1.f - 2.f * __builtin_amdgcn_rcpf(__expf(2.f * v[q]) + 1.f);
                w.x = pk2(v[0], v[1]); w.y = pk2(v[2], v[3]); w.z = pk2(v[4], v[5]); w.w = pk2(v[6], v[7]);
                *(LAS u32x4*)(AW + tk * 72 + (ch - 96) * 8) = w;
            } else if (ch < 112) {
                w.x = pk2(v[0], v[1]); w.y = pk2(v[2], v[3]); w.z = pk2(v[4], v[5]); w.w = pk2(v[6], v[7]);
                *(LAS u32x4*)(AA + tk * 72 + (ch - 104) * 8) = w;
            } else {
#pragma unroll
                for (int q = 0; q < 8; ++q) v[q] = sigmoidf_(v[q]);
                w.x = pk2(v[0], v[1]); w.y = pk2(v[2], v[3]); w.z = pk2(v[4], v[5]); w.w = pk2(v[6], v[7]);
                *(LAS u32x4*)(AG + tk * 136 + (ch - 112) * 8) = w;
            }
        }
    }
    __syncthreads();
    const int hh = F.wave & 3, dir = F.wave >> 2, tk = F.lane & 31, h2 = F.lane >> 5;
    const size_t tok = (size_t)t0 + tk;
    const GAS bf16_t* Wup = (const GAS bf16_t*)wb + WO_WUP + (size_t)(dir * 256 + hh * 64) * 64;
    const GAS bf16_t* Aup = (const GAS bf16_t*)wb + WO_AUP + (size_t)(dir * 256 + hh * 64) * 64;
    f32x16 aw[2], aa[2];
#pragma unroll
    for (int rb = 0; rb < 2; ++rb)
#pragma unroll
        for (int i = 0; i < 16; ++i) { aw[rb][i] = 0.f; aa[rb][i] = 0.f; }
#pragma unroll
    for (int ks = 0; ks < 4; ++ks) {
        const bf16x8 bw = *(const LAS bf16x8*)(AW + tk * 72 + 16 * ks + 8 * h2), ba = *(const LAS bf16x8*)(AA + tk * 72 + 16 * ks + 8 * h2);
#pragma unroll
        for (int rb = 0; rb < 2; ++rb) {
            const bf16x8 fw = *(const GAS bf16x8*)(Wup + (size_t)(rb * 32 + tk) * 64 + 16 * ks + 8 * h2), fa = *(const GAS bf16x8*)(Aup + (size_t)(rb * 32 + tk) * 64 + 16 * ks + 8 * h2);
            aw[rb] = __builtin_amdgcn_mfma_f32_32x32x16_bf16(fw, bw, aw[rb], 0, 0, 0);
            aa[rb] = __builtin_amdgcn_mfma_f32_32x32x16_bf16(fa, ba, aa[rb], 0, 0, 0);
        }
    }
    const LAS float* k_k = PAR + hh * 64; const LAS float* k_a = PAR + 256 + hh * 64; const LAS float* r_k = PAR + 512 + hh * 64;
    const LAS float* w0 = PAR + 768 + dir * 256 + hh * 64; const LAS float* a0 = PAR + 1280 + dir * 256 + hh * 64;
    float ssq = 0.f;
#pragma unroll
    for (int rb = 0; rb < 2; ++rb)
#pragma unroll
        for (int g4 = 0; g4 < 4; ++g4) { const int c0 = rb * 32 + 8 * g4 + 4 * h2;
            const f32x4 kv = *(const LAS f32x4*)(CF + tk * CF_STR + 256 + hh * 64 + c0), kkw = *(const LAS f32x4*)(k_k + c0);
            const f32x4 q = kv * kkw; ssq += (q[0] * q[0] + q[1] * q[1]) + (q[2] * q[2] + q[3] * q[3]); }
    ssq += xhalf(ssq);
    const float kinv = 1.f / fmaxf(sqrtf(ssq), 1e-12f);
    float bon = 0.f;
    GAS bf16_t* OM = (GAS bf16_t*)(p.ws + WS_OM) + ((size_t)dir * MTOK + tok) * 256 + hh * 64;
    GAS bf16_t* KA = (GAS bf16_t*)(p.ws + WS_KA) + ((size_t)dir * MTOK + tok) * 256 + hh * 64;
    GAS bf16_t* KD = (GAS bf16_t*)(p.ws + WS_KD) + ((size_t)dir * MTOK + tok) * 256 + hh * 64;
    GAS bf16_t* KK = (GAS bf16_t*)(p.ws + WS_KK) + tok * 256 + hh * 64;
    GAS bf16_t* VV = (GAS bf16_t*)(p.ws + WS_V) + tok * 256 + hh * 64;
    GAS bf16_t* RR = (GAS bf16_t*)(p.ws + WS_R) + tok * 256 + hh * 64;
#pragma unroll
    for (int rb = 0; rb < 2; ++rb)
#pragma unroll
        for (int g4 = 0; g4 < 4; ++g4) { const int c0 = rb * 32 + 8 * g4 + 4 * h2;
            const f32x4 kv = *(const LAS f32x4*)(CF + tk * CF_STR + 256 + hh * 64 + c0), rv = *(const LAS f32x4*)(CF + tk * CF_STR + hh * 64 + c0);
            const f32x4 kkw = *(const LAS f32x4*)(k_k + c0), kaw = *(const LAS f32x4*)(k_a + c0), rkw = *(const LAS f32x4*)(r_k + c0), w0v = *(const LAS f32x4*)(w0 + c0), a0v = *(const LAS f32x4*)(a0 + c0);
            float om[4], ka[4], kd[4], kk[4];
#pragma unroll
            for (int j = 0; j < 4; ++j) {
                const float wp = aw[rb][4 * g4 + j] + w0v[j], ap = aa[rb][4 * g4 + j] + a0v[j];
                om[j] = 1.f - __expf(-0.6065306597126334f * sigmoidf_(wp));
                const float a = sigmoidf_(ap);
                kk[j] = kv[j] * kkw[j] * kinv; ka[j] = kk[j] * a; kd[j] = kv[j] * (1.f + (a - 1.f) * kaw[j]);
                bon += rv[j] * kd[j] * rkw[j];
            }
            u32x2 w; w.x = pk2(om[0], om[1]); w.y = pk2(om[2], om[3]); *(GAS u32x2*)(OM + c0) = w;
            w.x = pk2(ka[0], ka[1]); w.y = pk2(ka[2], ka[3]); *(GAS u32x2*)(KA + c0) = w;
            w.x = pk2(kd[0], kd[1]); w.y = pk2(kd[2], kd[3]); *(GAS u32x2*)(KD + c0) = w;
            if (dir == 0) {
                const f32x4 vv = *(const LAS f32x4*)(CF + tk * CF_STR + 512 + hh * 64 + c0);
                w.x = pk2(kk[0], kk[1]); w.y = pk2(kk[2], kk[3]); *(GAS u32x2*)(KK + c0) = w;
                w.x = pk2(vv[0], vv[1]); w.y = pk2(vv[2], vv[3]); *(GAS u32x2*)(VV + c0) = w;
                w.x = pk2(rv[0], rv[1]); w.y = pk2(rv[2], rv[3]); *(GAS u32x2*)(RR + c0) = w;
            }
        }
    bon += xhalf(bon);
    if (h2 == 0) ((GAS float*)(p.ws + WS_BON))[((size_t)dir * MTOK + tok) * 4 + hh] = bon;
    {
        const GAS bf16_t* Gup = (const GAS bf16_t*)wb + WO_GUP + (size_t)(F.wave * 32 + tk) * 128;
        f32x16 ag;
#pragma unroll
        for (int i = 0; i < 16; ++i) ag[i] = 0.f;
#pragma unroll
        for (int ks = 0; ks < 8; ++ks) {
            const bf16x8 bg = *(const LAS bf16x8*)(AG + tk * 136 + 16 * ks + 8 * h2), fg = *(const GAS bf16x8*)(Gup + 16 * ks + 8 * h2);
            ag = __builtin_amdgcn_mfma_f32_32x32x16_bf16(fg, bg, ag, 0, 0, 0);
        }
        GAS bf16_t* GT = (GAS bf16_t*)(p.ws + WS_GATE) + tok * 256 + F.wave * 32;
#pragma unroll
        for (int g4 = 0; g4 < 4; ++g4) { u32x2 w; w.x = pk2(ag[4 * g4], ag[4 * g4 + 1]); w.y = pk2(ag[4 * g4 + 2], ag[4 * g4 + 3]); *(GAS u32x2*)(GT + 8 * g4 + 4 * h2) = w; }
    }
    __syncthreads();
}

#define CBAR() asm volatile("" ::: "memory")
#define LROW(M, i, r) do { const LAS f32x4* _q = (const LAS f32x4*)((M) + (i) * 16); const f32x4 _a = _q[0], _b = _q[1], _c = _q[2], _d = _q[3]; \
        r[0] = _a[0]; r[1] = _a[1]; r[2] = _a[2]; r[3] = _a[3]; r[4] = _b[0]; r[5] = _b[1]; r[6] = _b[2]; r[7] = _b[3]; \
        r[8] = _c[0]; r[9] = _c[1]; r[10] = _c[2]; r[11] = _c[3]; r[12] = _d[0]; r[13] = _d[1]; r[14] = _d[2]; r[15] = _d[3]; } while (0)
template <int DIR> __device__ __forceinline__ void chunkprep_wave(Frame& F, const Params& p, int task) {
    const int dbh = task >> 7, ct = task & 127, b = (dbh >> 2) & 7, hh = dbh & 3, ch = F.lane, r32 = F.lane & 31, h = F.lane >> 5;
    LAS unsigned char* wl = F.lds + F.wave * 16384;
    LAS bf16_t* X = (LAS bf16_t*)wl;
    LAS bf16_t* Yt = (LAS bf16_t*)(wl + 4608);
    LAS float* MTt = (LAS float*)(wl + 9216);
    LAS float* MBt = MTt + 256;
    LAS float* MC = MTt + 512; LAS float* MD = MTt + 768; LAS float* MT = MTt + 1024; LAS float* MA = MTt + 1280;
    constexpr int step = DIR ? -256 : 256;
    typedef const __attribute__((address_space(1))) bf16_t* gbf;
    const size_t ou = ((size_t)b * SEQ + ct * 16 + (DIR ? 15 : 0)) * 256 + hh * 64;
    const gbf OM = (gbf)(p.ws + WS_OM) + (size_t)DIR * MTOK * 256 + ou + ch; const gbf KA = (gbf)(p.ws + WS_KA) + (size_t)DIR * MTOK * 256 + ou + ch;
    const gbf KD = (gbf)(p.ws + WS_KD) + (size_t)DIR * MTOK * 256 + ou + ch; const gbf KK = (gbf)(p.ws + WS_KK) + ou + ch;
    const gbf RR = (gbf)(p.ws + WS_R) + ou + ch; const gbf VV = (gbf)(p.ws + WS_V) + ou + ch;
    float pc = 1.f;
    float qt[16], rt[16], at[16], kt[16], vv[16];
    {
        unsigned short rw[16], rk[16], ra_[16], rd[16], rr_[16], rv[16];
#pragma unroll
        for (int i = 0; i < 16; ++i) { rw[i] = OM[i * step]; rk[i] = KK[i * step]; ra_[i] = KA[i * step]; rd[i] = KD[i * step]; rr_[i] = RR[i * step]; rv[i] = VV[i * step]; }
#pragma unroll
        for (int i = 0; i < 16; ++i) {
            const float w = 1.f - bf2f(rw[i]);
            qt[i] = bf2f(rk[i]) * pc; pc *= w; const float ip = __builtin_amdgcn_rcpf(pc);
            rt[i] = bf2f(rr_[i]) * pc; at[i] = bf2f(ra_[i]) * ip; kt[i] = bf2f(rd[i]) * ip; vv[i] = bf2f(rv[i]);
            X[i * 72 + ch] = (bf16_t)(pk2(qt[i], 0.f) & 0xffffu); X[(16 + i) * 72 + ch] = (bf16_t)(pk2(rt[i], 0.f) & 0xffffu);
            Yt[i * 72 + ch] = (bf16_t)(pk2(at[i], 0.f) & 0xffffu); Yt[(16 + i) * 72 + ch] = (bf16_t)(pk2(kt[i], 0.f) & 0xffffu);
        }
    }
    const float p15 = pc;
    asm volatile("s_waitcnt lgkmcnt(0)" ::: "memory");
    {
        f32x16 g;
#pragma unroll
        for (int i = 0; i < 16; ++i) g[i] = 0.f;
#pragma unroll
        for (int ks = 0; ks < 4; ++ks) {
            const bf16x8 a = *(const LAS bf16x8*)(X + r32 * 72 + 16 * ks + 8 * h), bb = *(const LAS bf16x8*)(Yt + r32 * 72 + 16 * ks + 8 * h);
            g = __builtin_amdgcn_mfma_f32_32x32x16_bf16(a, bb, g, 0, 0, 0);
        }
        const int sidx = r32 & 15;
#pragma unroll
        for (int reg = 0; reg < 8; ++reg) { const int i = (reg & 3) + 8 * (reg >> 2) + 4 * h;
            const float lo = (sidx < i) ? g[reg] : 0.f, hi2 = (sidx <= i) ? g[8 + reg] : 0.f;
            if (r32 < 16) { MA[i * 16 + sidx] = lo; MD[i * 16 + sidx] = hi2; } else { MBt[sidx * 16 + i] = lo; MC[i * 16 + sidx] = hi2; } }
    }
    asm volatile("s_waitcnt lgkmcnt(0)" ::: "memory");
    {
        const int c = F.lane & 15; float Tc[16];
#pragma unroll
        for (int i = 0; i < 16; ++i) { float acc = (i == c) ? 1.f : 0.f; float ra[16]; LROW(MA, i, ra);
#pragma unroll
            for (int s2 = 0; s2 < i; ++s2) acc -= ra[s2] * Tc[s2];
            Tc[i] = acc; MT[i * 16 + c] = acc; MTt[c * 16 + i] = acc; CBAR(); }
    }
    asm volatile("s_waitcnt lgkmcnt(0)" ::: "memory");
    float Qh[16], W2[16];
    {
        float BV[16];
#pragma unroll
        for (int i = 0; i < 16; ++i) { Qh[i] = 0.f; BV[i] = 0.f; }
#pragma unroll
        for (int s2 = 0; s2 < 16; ++s2) {
            float ct_[16], cb_[16]; LROW(MTt, s2, ct_); LROW(MBt, s2, cb_);
#pragma unroll
            for (int i = s2; i < 16; ++i) { Qh[i] += ct_[i] * qt[s2]; if (i > s2) BV[i] += cb_[i] * vv[s2]; }
            CBAR();
        }
#pragma unroll
        for (int i = 0; i < 16; ++i) { float aw = 0.f; float rt_[16]; LROW(MT, i, rt_);
#pragma unroll
            for (int s2 = 0; s2 <= i; ++s2) aw += rt_[s2] * BV[s2];
            W2[i] = aw; CBAR(); }
    }
    LAS bf16_t* ST = (LAS bf16_t*)wl;
    {
        const int ks = ch >> 4, w16 = ch & 15, jq = (w16 >> 3) * 4 + (w16 & 3), hq = (w16 >> 2) & 1;
        LAS bf16_t* qrp = ST + (ks * 64 + hq * 32) * 8 + jq;
        LAS bf16_t* wyp = ST + 2048 + ((ch >> 5) * 64 + r32) * 16;
#pragma unroll
        for (int i = 0; i < 16; ++i) {
            float ar = rt[i], ay = 0.f; float rd_[16], rc_[16]; LROW(MD, i, rd_); LROW(MC, i, rc_);
#pragma unroll
            for (int s2 = 0; s2 <= i; ++s2) { ar -= rd_[s2] * Qh[s2]; ay += rc_[s2] * vv[s2] - rd_[s2] * W2[s2]; }
            qrp[i * 8] = (bf16_t)(pk2(Qh[i], 0.f) & 0xffffu); qrp[(16 + i) * 8] = (bf16_t)(pk2(ar, 0.f) & 0xffffu);
            wyp[512 * ((i >> 2) & 1) + (i & 3) + 4 * (i >> 3)] = (bf16_t)(pk2(W2[i], 0.f) & 0xffffu);
            wyp[512 * ((i >> 2) & 1) + (i & 3) + 4 * ((16 + i) >> 3)] = (bf16_t)(pk2(ay, 0.f) & 0xffffu);
            CBAR(); }
    }
    asm volatile("s_waitcnt lgkmcnt(0)" ::: "memory");
    {
        GAS u32x4* gq = (GAS u32x4*)((GAS bf16_t*)(p.ws + WS_FQR) + (size_t)task * 2048); GAS u32x4* gw = (GAS u32x4*)((GAS bf16_t*)(p.ws + WS_FWY) + (size_t)task * 2048);
        u32x4 tq[4], tw[4];
#pragma unroll
        for (int q = 0; q < 4; ++q) { tq[q] = *(const LAS u32x4*)(wl + (F.lane + 64 * q) * 16); tw[q] = *(const LAS u32x4*)(wl + 4096 + (F.lane + 64 * q) * 16); }
#pragma unroll
        for (int q = 0; q < 4; ++q) { gq[F.lane + 64 * q] = tq[q]; gw[F.lane + 64 * q] = tw[q]; }
    }
    asm volatile("s_waitcnt lgkmcnt(0)" ::: "memory");
    {
        LAS bf16_t* nap = ST + ((ch >> 5) * 64 + r32) * 8; LAS bf16_t* khp = nap + 1024;
#pragma unroll
        for (int s2 = 0; s2 < 16; ++s2) {
            const int off = 256 * ((s2 >> 2) & 1) + (s2 >> 3) * 4 + (s2 & 3);
            nap[off] = (bf16_t)(pk2(-at[s2] * p15, 0.f) & 0xffffu); khp[off] = (bf16_t)(pk2(kt[s2] * p15, 0.f) & 0xffffu); }
        asm volatile("s_waitcnt lgkmcnt(0)" ::: "memory");
        GAS u32x4* gn = (GAS u32x4*)((GAS bf16_t*)(p.ws + WS_FNA) + (size_t)task * 1024); GAS u32x4* gk = (GAS u32x4*)((GAS bf16_t*)(p.ws + WS_FKH) + (size_t)task * 1024);
        u32x4 tn[2], tk2[2];
#pragma unroll
        for (int q = 0; q < 2; ++q) { tn[q] = *(const LAS u32x4*)(wl + (F.lane + 64 * q) * 16); tk2[q] = *(const LAS u32x4*)(wl + 2048 + (F.lane + 64 * q) * 16); }
#pragma unroll
        for (int q = 0; q < 2; ++q) { gn[F.lane + 64 * q] = tn[q]; gk[F.lane + 64 * q] = tk2[q]; }
        ((GAS float*)(p.ws + WS_FP15))[(size_t)task * 64 + ch] = p15;
    }
    asm volatile("s_waitcnt lgkmcnt(0)" ::: "memory");
}
constexpr int PB_SLOT = 15360, PB_NSLOT = 4, PB_QR = 0, PB_WY = 4096, PB_NA = 8192, PB_KH = 10240, PB_P15 = 12288, PB_V = 13312;
__device__ __forceinline__ unsigned lds_ld_u32(unsigned addr) { unsigned v; asm volatile("ds_read_b32 %0, %1\n\ts_waitcnt lgkmcnt(0)" : "=v"(v) : "v"(addr) : "memory"); return v; }
__device__ __forceinline__ void lds_st_u32(unsigned addr, unsigned v) { asm volatile("ds_write_b32 %0, %1" :: "v"(addr), "v"(v) : "memory"); }
__device__ __forceinline__ void pb_dma(const Params& p, int dbh, int ct, int lane, LAS unsigned char* slot) {
    const size_t task = (size_t)dbh * 128 + ct; const int b = (dbh >> 2) & 7, hh = dbh & 3;
    const unsigned char* q = (const unsigned char*)((const bf16_t*)(p.ws + WS_FQR) + task * 2048) + lane * 16; const unsigned char* w = (const unsigned char*)((const bf16_t*)(p.ws + WS_FWY) + task * 2048) + lane * 16;
    const unsigned char* na = (const unsigned char*)((const bf16_t*)(p.ws + WS_FNA) + task * 1024) + lane * 16; const unsigned char* kh = (const unsigned char*)((const bf16_t*)(p.ws + WS_FKH) + task * 1024) + lane * 16;
#pragma unroll
    for (int i = 0; i < 4; ++i) {
        __builtin_amdgcn_global_load_lds((const unsigned*)(q + 1024 * i), (LAS unsigned*)(slot + PB_QR + 1024 * i), 16, 0, 0);
        __builtin_amdgcn_global_load_lds((const unsigned*)(w + 1024 * i), (LAS unsigned*)(slot + PB_WY + 1024 * i), 16, 0, 0); }
    __builtin_amdgcn_global_load_lds((const unsigned*)na, (LAS unsigned*)(slot + PB_NA), 16, 0, 0); __builtin_amdgcn_global_load_lds((const unsigned*)(na + 1024), (LAS unsigned*)(slot + PB_NA + 1024), 16, 0, 0);
    __builtin_amdgcn_global_load_lds((const unsigned*)kh, (LAS unsigned*)(slot + PB_KH), 16, 0, 0); __builtin_amdgcn_global_load_lds((const unsigned*)(kh + 1024), (LAS unsigned*)(slot + PB_KH + 1024), 16, 0, 0);
    __builtin_amdgcn_global_load_lds((const unsigned*)((const unsigned char*)((const float*)(p.ws + WS_FP15) + task * 64) + lane * 16), (LAS unsigned*)(slot + PB_P15), 16, 0, 0);
    const unsigned char* V = (const unsigned char*)((const bf16_t*)(p.ws + WS_V) + ((size_t)b * SEQ + ct * 16) * 256 + hh * 64) + (size_t)(lane >> 3) * 512 + (lane & 7) * 16;
    __builtin_amdgcn_global_load_lds((const unsigned*)V, (LAS unsigned*)(slot + PB_V), 16, 0, 0); __builtin_amdgcn_global_load_lds((const unsigned*)(V + 8 * 512), (LAS unsigned*)(slot + PB_V + 1024), 16, 0, 0);
}
__device__ __forceinline__ void phaseb_unit(Frame& F, const Params& p, int u) {
    const unsigned flag_base = (unsigned)(size_t)(F.lds + 131072 + 128);
    if (F.tid < 8) lds_st_u32(flag_base + 4 * F.tid, 0u);
    __syncthreads();
    const int pair = F.wave & 3;
    if (pair >= 2) return;
    const int dbh = u * 2 + pair, dir = dbh >> 5;
    LAS unsigned char* ring = F.lds + pair * (PB_NSLOT * PB_SLOT);
    const unsigned f_pub = flag_base + 8 * pair, f_con = f_pub + 4;
    if (F.wave >= 4) {
        for (int c = 0; c < 128; ++c) {
            while ((int)lds_ld_u32(f_con) < c - (PB_NSLOT - 1)) __builtin_amdgcn_s_sleep(1);
            pb_dma(p, dbh, dir ? 127 - c : c, F.lane, ring + (c & (PB_NSLOT - 1)) * PB_SLOT);
            if (c >= 3) { asm volatile("s_waitcnt vmcnt(45)" ::: "memory"); if (F.lane == 0) lds_st_u32(f_pub, (unsigned)(c - 2)); }
        }
        asm volatile("s_waitcnt vmcnt(30)" ::: "memory"); if (F.lane == 0) lds_st_u32(f_pub, 126u);
        asm volatile("s_waitcnt vmcnt(15)" ::: "memory"); if (F.lane == 0) lds_st_u32(f_pub, 127u);
        asm volatile("s_waitcnt vmcnt(0)" ::: "memory"); if (F.lane == 0) lds_st_u32(f_pub, 128u);
        return;
    }
    const int b = (dbh >> 2) & 7, hh = dbh & 3, r = F.lane & 31, h = F.lane >> 5;
    GAS bf16_t* Y = (GAS bf16_t*)(p.ws + WS_Y) + ((size_t)dir * MTOK + (size_t)b * SEQ) * 256 + hh * 64 + r;
    f32x16 accS[2][2];
#pragma unroll
    for (int rb = 0; rb < 2; ++rb)
#pragma unroll
        for (int cb = 0; cb < 2; ++cb)
#pragma unroll
            for (int i = 0; i < 16; ++i) accS[rb][cb][i] = 0.f;
    for (int cc = 0; cc < 128; ++cc) {
        const int ct = dir ? 127 - cc : cc;
        const LAS unsigned char* slot = ring + (cc & (PB_NSLOT - 1)) * PB_SLOT;
        bf16x8 sb[4][2];
#pragma unroll
        for (int rb = 0; rb < 2; ++rb)
#pragma unroll
            for (int s2 = 0; s2 < 2; ++s2)
#pragma unroll
                for (int cb = 0; cb < 2; ++cb) { const f32x16& a = accS[rb][cb]; u32x4 w;
                    w.x = pk2(a[8 * s2 + 0], a[8 * s2 + 1]); w.y = pk2(a[8 * s2 + 2], a[8 * s2 + 3]); w.z = pk2(a[8 * s2 + 4], a[8 * s2 + 5]); w.w = pk2(a[8 * s2 + 6], a[8 * s2 + 7]);
                    sb[2 * rb + s2][cb] = __builtin_bit_cast(bf16x8, w); }
        while ((int)lds_ld_u32(f_pub) < cc + 1) __builtin_amdgcn_s_sleep(1);
        asm volatile("" ::: "memory");
        f32x16 D[2];
#pragma unroll
        for (int cb = 0; cb < 2; ++cb) { const LAS u32x4* wp = (const LAS u32x4*)(slot + PB_WY + (cb * 64 + F.lane) * 32); const u32x4 w0 = wp[0], w1 = wp[1];
            D[cb][0] = bflo(w0.x); D[cb][1] = bfhi(w0.x); D[cb][2] = bflo(w0.y); D[cb][3] = bfhi(w0.y); D[cb][4] = bflo(w0.z); D[cb][5] = bfhi(w0.z); D[cb][6] = bflo(w0.w); D[cb][7] = bfhi(w0.w);
            D[cb][8] = bflo(w1.x); D[cb][9] = bfhi(w1.x); D[cb][10] = bflo(w1.y); D[cb][11] = bfhi(w1.y); D[cb][12] = bflo(w1.z); D[cb][13] = bfhi(w1.z); D[cb][14] = bflo(w1.w); D[cb][15] = bfhi(w1.w); }
#pragma unroll
        for (int ks = 0; ks < 4; ++ks) { const bf16x8 qa = *(const LAS bf16x8*)(slot + PB_QR + (ks * 64 + F.lane) * 16);
            D[0] = __builtin_amdgcn_mfma_f32_32x32x16_bf16(qa, sb[ks][0], D[0], 0, 0, 0);
            D[1] = __builtin_amdgcn_mfma_f32_32x32x16_bf16(qa, sb[ks][1], D[1], 0, 0, 0); }
#pragma unroll
        for (int rb = 0; rb < 2; ++rb)
#pragma unroll
            for (int g4 = 0; g4 < 4; ++g4) { const f32x4 pv = *(const LAS f32x4*)(slot + PB_P15 + (32 * rb + 8 * g4 + 4 * h) * 4);
#pragma unroll
                for (int cb = 0; cb < 2; ++cb)
#pragma unroll
                    for (int q = 0; q < 4; ++q) accS[rb][cb][4 * g4 + q] *= pv[q]; }
        bf16x8 ub[2], vb[2];
#pragma unroll
        for (int cb = 0; cb < 2; ++cb) {
            unsigned short vt[8];
#pragma unroll
            for (int j = 0; j < 8; ++j) { const int s2 = 8 * (j >> 2) + 4 * h + (j & 3); const int tau = dir ? 15 - s2 : s2;
                vt[j] = *(const LAS unsigned short*)(slot + PB_V + tau * 128 + (32 * cb + r) * 2);
                Y[(size_t)(ct * 16 + tau) * 256 + 32 * cb] = (bf16_t)(pk2(D[cb][8 + j], 0.f) & 0xffffu); }
            vb[cb] = (bf16x8){(short)vt[0], (short)vt[1], (short)vt[2], (short)vt[3], (short)vt[4], (short)vt[5], (short)vt[6], (short)vt[7]};
            u32x4 w; w.x = pk2(D[cb][0], D[cb][1]); w.y = pk2(D[cb][2], D[cb][3]); w.z = pk2(D[cb][4], D[cb][5]); w.w = pk2(D[cb][6], D[cb][7]);
            ub[cb] = __builtin_bit_cast(bf16x8, w);
        }
        bf16x8 na[2], kh[2];
#pragma unroll
        for (int rb = 0; rb < 2; ++rb) { na[rb] = *(const LAS bf16x8*)(slot + PB_NA + (rb * 64 + F.lane) * 16); kh[rb] = *(const LAS bf16x8*)(slot + PB_KH + (rb * 64 + F.lane) * 16); }
        asm volatile("s_waitcnt lgkmcnt(0)" ::: "memory");
        if (F.lane == 0) lds_st_u32(f_con, (unsigned)(cc + 1));
#pragma unroll
        for (int rb = 0; rb < 2; ++rb)
#pragma unroll
            for (int cb = 0; cb < 2; ++cb) {
                accS[rb][cb] = __builtin_amdgcn_mfma_f32_32x32x16_bf16(na[rb], ub[cb], accS[rb][cb], 0, 0, 0);
                accS[rb][cb] = __builtin_amdgcn_mfma_f32_32x32x16_bf16(kh[rb], vb[cb], accS[rb][cb], 0, 0, 0);
            }
    }
}

__device__ __forceinline__ void post_unit(Frame& F, const Params& p, int l, int u) {
    REFRAME(F);
    const bf16_t* Y0 = (const bf16_t*)(p.ws + WS_Y); const bf16_t* Y1 = Y0 + (size_t)MTOK * 256;
    const bf16_t* VV = (const bf16_t*)(p.ws + WS_V); const bf16_t* GT = (const bf16_t*)(p.ws + WS_GATE);
    const float* BON = (const float*)(p.ws + WS_BON); bf16_t* MIX = (bf16_t*)(p.ws + WS_MIX);
    const f32x4 lg = *(const f32x4*)(p.in[19] + l * 256 + 4 * F.lane), lb = *(const f32x4*)(p.in[20] + l * 256 + 4 * F.lane);
    for (int tok = u * 64 + F.wave * 8, te = tok + 8; tok < te; ++tok) {
        const u32x2 a = *(const GAS u32x2*)((const GAS bf16_t*)Y0 + (size_t)tok * 256 + 4 * F.lane), c = *(const GAS u32x2*)((const GAS bf16_t*)Y1 + (size_t)tok * 256 + 4 * F.lane);
        const u32x2 vv = *(const GAS u32x2*)((const GAS bf16_t*)VV + (size_t)tok * 256 + 4 * F.lane), gg = *(const GAS u32x2*)((const GAS bf16_t*)GT + (size_t)tok * 256 + 4 * F.lane);
        float y[4] = {bflo(a.x) + bflo(c.x), bfhi(a.x) + bfhi(c.x), bflo(a.y) + bflo(c.y), bfhi(a.y) + bfhi(c.y)};
        float s = (y[0] + y[1]) + (y[2] + y[3]);
#pragma unroll
        for (int o = 1; o < 16; o <<= 1) s += __shfl_xor(s, o);
        const float mu = s * (1.f / 64.f);
        float q = 0.f;
#pragma unroll
        for (int i = 0; i < 4; ++i) { y[i] -= mu; q += y[i] * y[i]; }
#pragma unroll
        for (int o = 1; o < 16; o <<= 1) q += __shfl_xor(q, o);
        const float rstd = rsqrtf(q * (1.f / 64.f) + 64e-5f);
        const int hh = F.lane >> 4;
        const float bon = ((const GAS float*)BON)[(size_t)tok * 4 + hh] + ((const GAS float*)BON)[((size_t)MTOK + tok) * 4 + hh];
        const float v4[4] = {bflo(vv.x), bfhi(vv.x), bflo(vv.y), bfhi(vv.y)}, g4[4] = {bflo(gg.x), bfhi(gg.x), bflo(gg.y), bfhi(gg.y)};
        float o4[4];
#pragma unroll
        for (int i = 0; i < 4; ++i) o4[i] = (y[i] * rstd * lg[i] + lb[i] + bon * v4[i]) * g4[i];
        u32x2 w; w.x = pk2(o4[0], o4[1]); w.y = pk2(o4[2], o4[3]);
        *(GAS u32x2*)((GAS bf16_t*)MIX + (size_t)tok * DM + 768 + 4 * F.lane) = w;
    }
}

__device__ __forceinline__ void prologue(Frame& F, const Params& p) {
    REFRAME(F);
    LAS float* scr = (LAS float*)(F.lds + F.wave * 16384);
    const int gw = F.bid * 8 + F.wave, NGW = F.G * 8;
    bf16_t* wb = (bf16_t*)(p.ws + WS_W);
    for (int it = gw; it < CV_TOTAL; it += NGW) { if (it < CV_A) cvt_item_a(p, 0, wb, scr, it, F.lane); else cvt_item_b(p, 0, wb, scr, it - CV_A, F.lane); }
    const float* x = p.in[0]; float* X = p.out; bf16_t* XB = (bf16_t*)(p.ws + WS_XB); float* rowss = (float*)(p.ws + WS_RP);
    for (int m = gw; m < MTOK; m += 2 * NGW) {
        const int m2 = m + NGW; const bool has2 = m2 < MTOK; const int mb = has2 ? m2 : m;
        const GAS f32x4* xra = (const GAS f32x4*)(x + (size_t)m * DM) + F.lane; const GAS f32x4* xrb = (const GAS f32x4*)(x + (size_t)mb * DM) + F.lane;
        f32x4 va[4], vb[4];
#pragma unroll
        for (int jj = 0; jj < 4; ++jj) { va[jj] = xra[64 * jj]; vb[jj] = xrb[64 * jj]; }
        float sa = 0.f, sb = 0.f;
#pragma unroll
        for (int jj = 0; jj < 4; ++jj) { sa += (va[jj][0] * va[jj][0] + va[jj][1] * va[jj][1]) + (va[jj][2] * va[jj][2] + va[jj][3] * va[jj][3]); sb += (vb[jj][0] * vb[jj][0] + vb[jj][1] * vb[jj][1]) + (vb[jj][2] * vb[jj][2] + vb[jj][3] * vb[jj][3]); }
        sa = wave_sum(sa); sb = wave_sum(sb);
        { GAS f32x4* xo = (GAS f32x4*)(X + (size_t)m * DM) + F.lane; GAS u32x2* bo = (GAS u32x2*)(XB + (size_t)m * DM) + F.lane;
#pragma unroll
          for (int jj = 0; jj < 4; ++jj) { xo[64 * jj] = va[jj]; u32x2 w; w.x = pk2(va[jj][0], va[jj][1]); w.y = pk2(va[jj][2], va[jj][3]); bo[64 * jj] = w; }
          if (F.lane < 16) ((GAS float*)rowss)[(size_t)m * 16 + F.lane] = (F.lane == 0) ? sa : 0.f; }
        if (has2) { GAS f32x4* xo = (GAS f32x4*)(X + (size_t)m2 * DM) + F.lane; GAS u32x2* bo = (GAS u32x2*)(XB + (size_t)m2 * DM) + F.lane;
#pragma unroll
          for (int jj = 0; jj < 4; ++jj) { xo[64 * jj] = vb[jj]; u32x2 w; w.x = pk2(vb[jj][0], vb[jj][1]); w.y = pk2(vb[jj][2], vb[jj][3]); bo[64 * jj] = w; }
          if (F.lane < 16) ((GAS float*)rowss)[(size_t)m2 * 16 + F.lane] = (F.lane == 0) ? sb : 0.f; }
    }
    const float* mem = p.in[1]; const float* gm = p.in[23]; bf16_t* MN = (bf16_t*)(p.ws + WS_MEMN);
    for (int m = gw; m < MMEM; m += NGW) {
        const f32x4* xr = (const f32x4*)(mem + (size_t)m * DM) + F.lane; u32x2* bo = (u32x2*)(MN + (size_t)m * DM) + F.lane;
        f32x4 v[4]; float s = 0.f;
#pragma unroll
        for (int jj = 0; jj < 4; ++jj) { v[jj] = xr[64 * jj]; s += (v[jj][0] * v[jj][0] + v[jj][1] * v[jj][1]) + (v[jj][2] * v[jj][2] + v[jj][3] * v[jj][3]); }
        const float rstd = rsqrtf(wave_sum(s) * (1.f / 1024.f) + 1e-6f);
#pragma unroll
        for (int jj = 0; jj < 4; ++jj) { const f32x4 g = *((const f32x4*)gm + F.lane + 64 * jj); const f32x4 t = v[jj] * rstd * g;
            u32x2 w; w.x = pk2(t[0], t[1]); w.y = pk2(t[2], t[3]); bo[64 * jj] = w; }
    }
}
__device__ __forceinline__ void final_norm(Frame& F, const Params& p) {
    REFRAME(F);
    const int gw = F.bid * 8 + F.wave, NGW = F.G * 8;
    const float* rowss = (const float*)(p.ws + WS_RP) + (size_t)12 * MTOK * 16; const GAS float* gf = (const GAS float*)p.in[30];
    f32x4 g[4];
#pragma unroll
    for (int jj = 0; jj < 4; ++jj) g[jj] = *((const GAS f32x4*)gf + F.lane + 64 * jj);
    for (int m = gw; m < MTOK; m += 2 * NGW) {
        const int m2 = m + NGW; const bool has2 = m2 < MTOK;
        GAS f32x4* xa = (GAS f32x4*)(p.out + (size_t)m * DM) + F.lane; GAS f32x4* xb = (GAS f32x4*)(p.out + (size_t)(has2 ? m2 : m) * DM) + F.lane;
        f32x4 va[4], vb[4];
#pragma unroll
        for (int jj = 0; jj < 4; ++jj) { va[jj] = xa[64 * jj]; vb[jj] = xb[64 * jj]; }
        const float ra = row_rstd(rowss, m), rb = row_rstd(rowss, has2 ? m2 : m);
#pragma unroll
        for (int jj = 0; jj < 4; ++jj) xa[64 * jj] = va[jj] * ra * g[jj];
        if (has2) {
#pragma unroll
            for (int jj = 0; jj < 4; ++jj) xb[64 * jj] = vb[jj] * rb * g[jj]; }
    }
}

#define XB_TMO      128
#define XB_XCNT(j)  (256  + 64 * (j))
#define XB_XSUB(j)  (1280 + 64 * (j))
#define XB_XGEN(j)  (2304 + 64 * (j))
#define XB_TOP      3328
#define XB_TOPGEN   3392
#define XB_SPIN_CAP (1u << 22)
constexpr int CW_BAR = 4096;
__device__ __forceinline__ unsigned xb_ld(unsigned* p)              { return __hip_atomic_load(p, __ATOMIC_RELAXED, __HIP_MEMORY_SCOPE_AGENT); }
__device__ __forceinline__ unsigned xb_add(unsigned* p, unsigned v) { return __hip_atomic_fetch_add(p, v, __ATOMIC_RELAXED, __HIP_MEMORY_SCOPE_AGENT); }
__device__ __forceinline__ unsigned xb_xcc_id() { return (unsigned)__builtin_amdgcn_s_getreg((3 << 11) | 20) & 0xFu; }
#define XB_SPIN(cond, bar) do { unsigned _sp = 0; while (cond) { __builtin_amdgcn_s_sleep(1); \
    if ((++_sp & 255u) == 0u) { if (xb_ld(&(bar)[XB_TMO])) break; if (_sp > XB_SPIN_CAP) { atomicAdd(&(bar)[XB_TMO], 1u); break; } } } } while (0)
__device__ __forceinline__ void xcd_barrier_complete(unsigned* bar, unsigned x, unsigned& nloc, unsigned& nx) {
    const unsigned G = gridDim.x;
    unsigned sum, cnt, mine, sp = 0u;
    for (;;) {
        sum = 0u; cnt = 0u; mine = 0u;
#pragma unroll
        for (unsigned j = 0; j < 16; ++j) { const unsigned c = xb_ld(&bar[XB_XCNT(j)]); sum += c; cnt += (c > 0u) ? 1u : 0u; mine = (j == x) ? c : mine; }
        if (sum == G) break;
        __builtin_amdgcn_s_sleep(1);
        if ((++sp & 255u) == 0u) { if (xb_ld(&bar[XB_TMO])) break; if (sp > XB_SPIN_CAP) { atomicAdd(&bar[XB_TMO], 1u); break; } }
    }
    nloc = mine > 0u ? mine : 1u; nx = cnt > 0u ? cnt : 1u;
}
__device__ __forceinline__ void gsync(volatile LAS unsigned* st) {
    unsigned* bar = (unsigned*)(make_params().ws + WS_CTL) + CW_BAR;
    asm volatile("s_waitcnt vmcnt(0)" ::: "memory");
    __syncthreads();
    if (threadIdx.x == 0) {
        const unsigned x = xb_xcc_id();
        __builtin_amdgcn_s_waitcnt(0);
        unsigned nloc = st[0], nx = st[1];
        if (nloc == 0u) { xcd_barrier_complete(bar, x, nloc, nx); st[0] = nloc; st[1] = nx; }
        const unsigned old = xb_add(&bar[XB_XSUB(x)], 1u);
        const unsigned gen = old / nloc;
        if (old + 1u == (gen + 1u) * nloc) {
            __builtin_amdgcn_fence(__ATOMIC_RELEASE, "agent");
            asm volatile("s_waitcnt vmcnt(0)" ::: "memory");
            const unsigned og = xb_add(&bar[XB_TOP], 1u);
            const unsigned tg = og / nx;
            if (og + 1u == (tg + 1u) * nx) xb_add(&bar[XB_TOPGEN], 1u);
            else XB_SPIN(xb_ld(&bar[XB_TOPGEN]) == tg, bar);
            __builtin_amdgcn_fence(__ATOMIC_ACQUIRE, "agent");
            xb_add(&bar[XB_XGEN(x)], 1u);
            asm volatile("s_waitcnt vmcnt(0)" ::: "memory");
        } else {
            XB_SPIN(xb_ld(&bar[XB_XGEN(x)]) == gen, bar);
            __builtin_amdgcn_fence(__ATOMIC_ACQUIRE, "agent");
            asm volatile("s_waitcnt vmcnt(0)" ::: "memory");
        }
    }
    __syncthreads();
}
__device__ __forceinline__ int rstd_table(LAS unsigned char* lds, const pg8::StaticOrder& S, const float* rowss, int tid) {
    pg8::Unit u0; int pm0 = -1;
    if (S.next(0, u0)) { pm0 = u0.pm; if (tid < 256) ((LAS float*)(lds + 131072 + 2048))[tid] = row_rstd(rowss, pm0 * 256 + tid); }
    __syncthreads();
    return pm0;
}
#ifdef TPROBE
#define STAMP(id) do { if (blockIdx.x == 0 && threadIdx.x == 0) { LAS unsigned long long* ts_ = (LAS unsigned long long*)(F.lds + 131072 + 64); const unsigned long long now_ = __builtin_amdgcn_s_memrealtime(); \
    const unsigned long long dt_ = now_ - ts_[0]; ts_[0] = now_; if ((TA_MASK >> (id)) & 1) ts_[1] += dt_; if ((TB_MASK >> (id)) & 1) ts_[2] += dt_; } } while (0)
#else
#define STAMP(id) do { } while (0)
#endif
#ifndef PH_MASK
#define PH_MASK 0xFFFF
#endif
#ifndef REP_MASK
#define REP_MASK 0
#endif
#define NREP(k) ((((REP_MASK) >> (k)) & 1) ? 2 : 1)
constexpr int NCP = 1024, NDIFF_A = 0, NPB = 32;
__global__ void __launch_bounds__(512, 2) fwd_megakernel(KArgs kargs_unused) {
    extern __shared__ __attribute__((aligned(16))) unsigned char lds_raw[];
    cg::grid_group grid = cg::this_grid();
    Frame F; F.lds = (LAS unsigned char*)lds_raw; F.tid = threadIdx.x; F.lane = F.tid & 63; F.wave = __builtin_amdgcn_readfirstlane(F.tid >> 6); F.G = gridDim.x; F.bid = blockIdx.x;
    LAS int* qslot = (LAS int*)(F.lds + 131072);
    volatile LAS unsigned* bst = (volatile LAS unsigned*)(F.lds + 131072 + 32);
    { unsigned* bar0 = (unsigned*)(make_params().ws + WS_CTL) + CW_BAR;
      if (threadIdx.x == 0) { bst[0] = 0u; bst[1] = 0u; (void)xb_add(bar0 + XB_XCNT(xb_xcc_id()), 1u); } }
    __syncthreads();
#define PHASE_VARS() const Params p = make_params(); unsigned* ctl = (unsigned*)(p.ws + WS_CTL); float* rowss = (float*)(p.ws + WS_RP); \
    bf16_t* XB = (bf16_t*)(p.ws + WS_XB); bf16_t* Z = (bf16_t*)(p.ws + WS_Z); bf16_t* MIX = (bf16_t*)(p.ws + WS_MIX); \
    bf16_t* wb = (bf16_t*)(p.ws + WS_W); int bid_ = F.bid, G_ = F.G; asm volatile("" : "+s"(bid_), "+s"(G_)); (void)bid_; (void)G_; (void)ctl; (void)rowss; (void)XB; (void)Z; (void)MIX; (void)wb

#ifdef TPROBE
    if (blockIdx.x == 0 && threadIdx.x == 0) { LAS unsigned long long* ts_ = (LAS unsigned long long*)(F.lds + 131072 + 64); ts_[0] = __builtin_amdgcn_s_memrealtime(); ts_[1] = 0; ts_[2] = 0; }
#endif
    if (PH_MASK & 1) { const Params p = make_params(); prologue(F, p); }
    grid.sync();
    STAMP(0);

    for (int l = 0; l < NL; ++l) {
        for (int rep = 0; rep < NREP(1); ++rep) {
        if (PH_MASK & 2) {
            PHASE_VARS();
            pg8::StaticOrder S; S.init(MTOK, INW, G_, bid_);
            const int pm0 = rstd_table(F.lds, S, rowss + (size_t)(3 * l) * MTOK * 16, F.tid);
            pg8::gemm_phase(F.lds, pg8::Gemm{XB, wb + WO_IN, MTOK, INW, DM}, S, pg8::EpiScaleBf16{Z, ZP, rowss + (size_t)(3 * l) * MTOK * 16, (bf16_t*)(p.ws + WS_ZC), 1024, 8, (bf16_t*)(p.ws + WS_KD2), (const LAS float*)(F.lds + 131072 + 2048), pm0});
        }
        gsync(bst); STAMP(1);
        }
        for (int rep = 0; rep < NREP(2); ++rep) {
        for (int u = F.bid; u < 768; u += F.G) {
            PHASE_VARS();
            if (u < 512) { if (PH_MASK & 4) prep_unit(F, p, l, wb, u); } else if (PH_MASK & 8) win_unit(F, p, l, u - 512);
        }
        gsync(bst); STAMP(2);
        }
        for (int rep = 0; rep < NREP(3); ++rep) {
        {
            PHASE_VARS();
            if (G_ == 256 && bid_ < 64) {
                if (PH_MASK & 32) diff_unit(F, p, l, (4 * (bid_ & 7) + 3) * 16 + 8 + (bid_ >> 3));
                { const int u = 960 + bid_; if (PH_MASK & 16) { REFRAME(F); chunkprep_wave<1>(F, p, u * 8 + F.wave); } }
            } else if (G_ == 256) {
                for (int k = 0; k < 5; ++k) { const int u = (bid_ - 64) + 192 * k;
                    if (PH_MASK & 16) { REFRAME(F); if (u >= NCP / 2) chunkprep_wave<1>(F, p, u * 8 + F.wave); else chunkprep_wave<0>(F, p, u * 8 + F.wave); } }
            } else {
                for (int u = bid_; u < NCP; u += G_) {
                    if (PH_MASK & 16) { REFRAME(F); if (u >= NCP / 2) chunkprep_wave<1>(F, p, u * 8 + F.wave); else chunkprep_wave<0>(F, p, u * 8 + F.wave); } }
            }
        }
        gsync(bst); STAMP(11);
        }
        for (int rep = 0; rep < NREP(4); ++rep) {
        {
            PHASE_VARS();
            const int ncva = (l + 1 < NL) ? CV_A / 8 : 0, ncvb = (l > 0) ? CV_B / 8 : 0, ncv = NPB + ncva + ncvb, ntot = ncv + 256;
            unsigned* pbdone = ctl + 3072 + (l * 2 + rep) * 16;
            unsigned* gq = ctl + CW_Q + 16 * l + 8 + 4 * rep; unsigned* dq = ctl + 2048 + (l * 2 + rep) * 16;
            const int myx = (int)(xb_xcc_id() & 7u);
            int stage = (bid_ < NPB) ? 0 : 1, pend = -1, xi = 0;
            for (;;) {
                __syncthreads();
                if (F.tid == 0) {
                    int code = -1;
                    if (stage == 0) { const int g = (int)atomicAdd(gq, 1u); if (g < NPB) code = g; else { pend = g; stage = 1; } }
                    if (stage == 1) {
                        if (F.G == 256) {
                            if (bid_ >= NPB && xi < 2) { const int x = bid_ & 7, tk = 2 * ((bid_ - NPB) >> 3) + xi; ++xi; code = -2 - ((4 * x + (tk >> 4)) * 16 + (tk & 15)); }
                            else stage = 2;
                        } else {
                            while (xi < 8) { const int x = (myx + xi) & 7; const int tk = (int)atomicAdd(dq + x, 1u); if (tk < 64) { code = -2 - ((4 * x + (tk >> 4)) * 16 + (tk & 15)); break; } ++xi; }
                            if (xi >= 8) stage = 2;
                        }
                    }
                    if (stage == 2 && code == -1) { int g = pend; pend = -1; if (g < 0) g = (int)atomicAdd(gq, 1u); if (g < ntot) code = g; }
                    *qslot = code;
                }
                __syncthreads();
                const int u = *qslot;
                if (u == -1) break;
                if (u <= -2) { if (PH_MASK & 32) diff_unit(F, p, l, -2 - u); }
                else if (u < NPB) { if (PH_MASK & 16) { REFRAME(F); phaseb_unit(F, p, u); }
                    asm volatile("s_waitcnt vmcnt(0)" ::: "memory"); __syncthreads();
                    if (F.tid == 0) __hip_atomic_fetch_add(pbdone, 1u, __ATOMIC_RELEASE, __HIP_MEMORY_SCOPE_AGENT); }
                else if (u >= ncv) {
                    if (F.tid == 0) { while (__hip_atomic_load(pbdone, __ATOMIC_RELAXED, __HIP_MEMORY_SCOPE_AGENT) < (unsigned)NPB) __builtin_amdgcn_s_sleep(8);
                        __builtin_amdgcn_fence(__ATOMIC_ACQUIRE, "agent"); asm volatile("s_waitcnt vmcnt(0)" ::: "memory"); }
                    __syncthreads();
                    if (PH_MASK & 64) post_unit(F, p, l, u - ncv); }
                else if (u < NPB + ncva) { REFRAME(F); cvt_item_a(p, l + 1, wb, (LAS float*)(F.lds + F.wave * 16384), (u - NPB) * 8 + F.wave, F.lane); }
                else { REFRAME(F); cvt_item_b(p, l, wb, (LAS float*)(F.lds + F.wave * 16384), (u - NPB - ncva) * 8 + F.wave, F.lane); }
            }
        }
        gsync(bst); STAMP(3);
        }
        if (PH_MASK & 128) {
            PHASE_VARS();
            pg8::StaticOrder S; S.init(MTOK, DM, G_, bid_);
            pg8::gemm_phase(F.lds, pg8::Gemm{MIX, wb + WO_OUT, MTOK, DM, DM}, S, pg8::EpiResid{p.out, XB, rowss + (size_t)(3 * l + 1) * MTOK * 16});
        }
        gsync(bst); STAMP(5);
        for (int rep = 0; rep < NREP(6); ++rep) {
        if (PH_MASK & 256) {
            PHASE_VARS();
            pg8::StaticOrder S; S.init(MTOK, XW, G_, bid_);
            if (F.bid < 128) {
                pg8::gemm_phase(F.lds, pg8::Gemm{XB, wb + WO_Q, MTOK, XW, DM}, S, pg8::EpiScaleBf16{(bf16_t*)(p.ws + WS_Q), XW, rowss + (size_t)(3 * l + 1) * MTOK * 16, nullptr, 0, 1 << 30, nullptr, nullptr, -1});
            } else {
                pg8::StaticOrder S2; S2.init(MMEM, 1024, 128, F.bid - 128);
                pg8::gemm_phase(F.lds, pg8::Gemm{(const bf16_t*)(p.ws + WS_MEMN), wb + WO_KV, MMEM, 1024, DM}, S2, pg8::EpiScaleBf16{(bf16_t*)(p.ws + WS_KV), 1024, nullptr, nullptr, 0, 1 << 30, nullptr, nullptr, -1});
            }
        }
        gsync(bst); STAMP(6);
        }
        for (int rep = 0; rep < NREP(7); ++rep) {
        if (PH_MASK & 512) for (int u = F.bid; u < 256; u += F.G) { PHASE_VARS(); cross_unit(F, p, u); }
        gsync(bst); STAMP(7);
        }
        if (PH_MASK & 1024) {
            PHASE_VARS();
            pg8::StaticOrder S; S.init(MTOK, DM, G_, bid_);
            pg8::gemm_phase(F.lds, pg8::Gemm{(const bf16_t*)(p.ws + WS_O), wb + WO_O, MTOK, DM, XW}, S, pg8::EpiResid{p.out, XB, rowss + (size_t)(3 * l + 2) * MTOK * 16});
        }
        gsync(bst); STAMP(8);
        for (int rep = 0; rep < NREP(9); ++rep) {
        if (PH_MASK & 2048) {
            PHASE_VARS();
            pg8::StaticOrder S; S.init(MTOK, 2 * DFF, G_, bid_);
            const int pm0 = rstd_table(F.lds, S, rowss + (size_t)(3 * l + 2) * MTOK * 16, F.tid);
            pg8::gemm_phase(F.lds, pg8::Gemm{XB, wb + WO_GU, MTOK, 2 * DFF, DM}, S, pg8::EpiSwiGLU{(bf16_t*)(p.ws + WS_G), rowss + (size_t)(3 * l + 2) * MTOK * 16, (const LAS float*)(F.lds + 131072 + 2048), pm0});
        }
        gsync(bst); STAMP(9);
        }
        if (PH_MASK & 4096) {
            PHASE_VARS();
            pg8::StaticOrder S; S.init(MTOK, DM, G_, bid_);
            pg8::gemm_phase(F.lds, pg8::Gemm{(const bf16_t*)(p.ws + WS_G), wb + WO_DOWN, MTOK, DM, DFF}, S, pg8::EpiResid{p.out, XB, rowss + (size_t)(3 * l + 3) * MTOK * 16});
        }

#ifdef TPROBE
        STAMP(10);
        { const Params p = make_params(); if (l == NL - 1 && blockIdx.x == 0 && threadIdx.x == 0) { LAS unsigned long long* ts_ = (LAS unsigned long long*)(F.lds + 131072 + 64); unsigned* c_ = (unsigned*)(p.ws + WS_CTL); c_[32] = (unsigned)ts_[1]; c_[33] = (unsigned)ts_[2]; } }
#endif
        gsync(bst);
    }
    if (PH_MASK & 8192) { const Params p = make_params(); final_norm(F, p); }
}

extern "C" void kernel_launch(void* const* d_in, const int* in_sizes, int n_in, void* d_out, int out_size, void* d_ws, size_t ws_size, hipStream_t stream) {
    static int grid = 0;
    if (grid == 0) {
        if (n_in != 31 || out_size != MTOK * DM || ws_size < WS_END) { fprintf(stderr, "kernel_launch: unexpected problem shape (n_in %d out %d ws %zu)\n", n_in, out_size, ws_size); grid = -1; return; }
        int dev = 0, cus = 0, per_cu = 0;
        hipGetDevice(&dev);
        hipDeviceGetAttribute(&cus, hipDeviceAttributeMultiprocessorCount, dev);
        hipFuncSetAttribute((const void*)fwd_megakernel, hipFuncAttributeMaxDynamicSharedMemorySize, LDS_BYTES);
        hipOccupancyMaxActiveBlocksPerMultiprocessor(&per_cu, (const void*)fwd_megakernel, 512, LDS_BYTES);
        if (per_cu < 1) { fprintf(stderr, "kernel_launch: occupancy query returned %d\n", per_cu); per_cu = 1; }
        (void)hipGetLastError();
        grid = cus * per_cu;
    }
    if (grid < 0) return;
    hipMemsetAsync((char*)d_ws + WS_CTL, 0, CTL_ZERO_BYTES, stream);
    KArgs p{};
    for (int i = 0; i < 31; ++i) p.in[i] = (const float*)d_in[i];
    p.out = (float*)d_out; p.ws = (unsigned char*)d_ws;
    void* args[] = {&p};
    hipError_t e = hipLaunchCooperativeKernel((const void*)fwd_megakernel, dim3(grid), dim3(512), args, LDS_BYTES, stream);
    if (e != hipSuccess) fprintf(stderr, "cooperative launch failed: %s (grid %d)\n", hipGetErrorString(e), grid);
}
```
